# Optimizing an MI355X kernel written in HIP

```python
import jax, jax.numpy as jnp
from jax import lax
import numpy as np

D_MODEL = 1024
BATCH = 4
SEQ = 8192
DEPTH = 2

GRID_W = 64
CTX_LEN = 256
HEAD_DIM = 64
ATTN_HEADS = 8
KV_HEADS = 2
Q_PER_KV = ATTN_HEADS // KV_HEADS
ATTN_WIDTH = ATTN_HEADS * HEAD_DIM
KV_WIDTH = KV_HEADS * HEAD_DIM
WINDOW = 128
BLOCK = 128
FOURIER_GROUPS = 4
FOURIER_GROUP_DIM = 64
FOURIER_WIDTH = FOURIER_GROUPS * FOURIER_GROUP_DIM
CONV_GROUPS = 4
CONV_WIDTH = 256
CONV_TAPS = 3
MIX_WIDTH = ATTN_WIDTH + FOURIER_WIDTH + CONV_WIDTH
PROJ_SIZES = (ATTN_WIDTH, KV_WIDTH, KV_WIDTH, ATTN_WIDTH,
              FOURIER_WIDTH, FOURIER_WIDTH,
              CONV_WIDTH, CONV_WIDTH, CONV_WIDTH, CONV_WIDTH)
PROJ_WIDTH = 2 * ATTN_WIDTH + 2 * KV_WIDTH + 2 * FOURIER_WIDTH + 4 * CONV_WIDTH
ROPE_FREQS = HEAD_DIM // 4
ROPE_BASE = 10000.0
NORM_EPS = 1e-6

kernel_name = 'hybrid_parallel_groups_flow_block'


def rmsnorm(x, g):
    xf = x.astype(jnp.float32)
    y = xf * lax.rsqrt(jnp.mean(xf * xf, axis=-1, keepdims=True) + NORM_EPS)
    return (y * g.astype(jnp.float32)).astype(x.dtype)


def split_cols(p, sizes):
    out = []
    start = 0
    for s in sizes:
        out.append(p[..., start:start + s])
        start += s
    return out


def axial_rope_tables(n):
    rows = n // GRID_W
    row = jnp.repeat(jnp.arange(rows, dtype=jnp.float32), GRID_W)
    col = jnp.tile(jnp.arange(GRID_W, dtype=jnp.float32), rows)
    inv_freq = jnp.power(ROPE_BASE, -jnp.arange(ROPE_FREQS, dtype=jnp.float32) / ROPE_FREQS)
    ang = jnp.concatenate([row[:, None] * inv_freq, col[:, None] * inv_freq], axis=-1)
    return jnp.cos(ang), jnp.sin(ang)


def apply_axial_rope(x, cos, sin):
    b, n, h, d = x.shape
    xr = x.astype(jnp.float32).reshape(b, n, h, 2, 2, ROPE_FREQS)
    x1 = xr[..., 0, :]
    x2 = xr[..., 1, :]
    cs = cos.reshape(n, 1, 2, ROPE_FREQS)
    sn = sin.reshape(n, 1, 2, ROPE_FREQS)
    out = jnp.stack([x1 * cs - x2 * sn, x1 * sn + x2 * cs], axis=-2)
    return out.reshape(b, n, h, d).astype(x.dtype)


def sink_softmax(s, sink_b):
    m = jnp.maximum(jnp.max(s, axis=-1, keepdims=True), sink_b)
    e = jnp.exp(s - m)
    return e / (jnp.sum(e, axis=-1, keepdims=True) + jnp.exp(sink_b - m))


def window_attention(q, k, v, kc, vc, sink_b):
    b, n = q.shape[:2]
    nb = n // BLOCK
    span = BLOCK + 2 * WINDOW
    nc = kc.shape[1]
    qb = (q * (HEAD_DIM ** -0.5)).reshape(b, nb, BLOCK, KV_HEADS, Q_PER_KV, HEAD_DIM).transpose(1, 0, 2, 3, 4, 5)
    pad = ((0, 0), (WINDOW, WINDOW), (0, 0), (0, 0))
    kp = jnp.pad(k, pad)
    vp = jnp.pad(v, pad)
    offs_q = jnp.arange(BLOCK)
    offs_k = jnp.arange(span) - WINDOW

    def one_block(args):
        qi, i = args
        start = i * BLOCK
        ks = lax.dynamic_slice_in_dim(kp, start, span, axis=1)
        vs = lax.dynamic_slice_in_dim(vp, start, span, axis=1)
        qpos = start + offs_q
        kpos = start + offs_k
        valid = (jnp.abs(qpos[:, None] - kpos[None, :]) <= WINDOW) & (kpos >= 0)[None, :] & (kpos < n)[None, :]
        s_loc = jnp.einsum('bqkgd,bnkd->bkgqn', qi, ks).astype(jnp.float32)
        s_loc = jnp.where(valid, s_loc, -jnp.inf)
        s_ctx = jnp.einsum('bqkgd,bnkd->bkgqn', qi, kc).astype(jnp.float32)
        p = sink_softmax(jnp.concatenate([s_ctx, s_loc], axis=-1), sink_b).astype(v.dtype)
        return (jnp.einsum('bkgqn,bnkd->bqkgd', p[..., :nc], vc)
                + jnp.einsum('bkgqn,bnkd->bqkgd', p[..., nc:], vs))

    o = lax.map(one_block, (qb, jnp.arange(nb)))
    return o.transpose(1, 0, 2, 3, 4, 5).reshape(b, n, ATTN_WIDTH)


def context_attention(q, k, v, sink_b):
    b, n = q.shape[:2]
    qg = (q * (HEAD_DIM ** -0.5)).reshape(b, n, KV_HEADS, Q_PER_KV, HEAD_DIM)
    s = jnp.einsum('bqkgd,bnkd->bkgqn', qg, k).astype(jnp.float32)
    p = sink_softmax(s, sink_b).astype(v.dtype)
    return jnp.einsum('bkgqn,bnkd->bqkgd', p, v).reshape(b, n, ATTN_WIDTH)


def fourier_mix(u, w_f):
    b, n, _ = u.shape
    ug = u.reshape(b, n, FOURIER_GROUPS, FOURIER_GROUP_DIM).astype(jnp.float32)
    f = jnp.fft.fft2(ug, axes=(1, 3), norm='ortho').real.astype(u.dtype)
    return jnp.einsum('bngc,gcd->bngd', f, w_f).reshape(b, n, FOURIER_WIDTH)


def short_conv_mix(z, b_gate, c_gate, w, bias):
    t = c_gate * z
    tp = jnp.pad(t, ((0, 0), (1, 1), (0, 0)))
    y = tp[:, :-2] * w[0] + tp[:, 1:-1] * w[1] + tp[:, 2:] * w[2] + bias
    return b_gate * y


def gated_merge(a, ga, f, gf, s, gc, w_out):
    h = jnp.concatenate([a * jax.nn.silu(ga), f * jax.nn.silu(gf), s * jax.nn.silu(gc)], axis=-1)
    return h @ w_out


def layer(x, ctx, c, c_ctx, w_mod, b_mod, g_pre, g_post, w_in, w_out, sink, w_fourier, conv_w, conv_b,
          cos, sin, update_ctx):
    b, n = x.shape[:2]
    nc = ctx.shape[1]
    shift, scale, gate = jnp.split(jax.nn.silu(c) @ w_mod + b_mod, 3, axis=-1)
    shift_c, scale_c, gate_c = jnp.split(jax.nn.silu(c_ctx) @ w_mod + b_mod, 3, axis=-1)
    sink_b = sink.astype(jnp.float32).reshape(1, KV_HEADS, Q_PER_KV, 1, 1)

    hx = rmsnorm(x, g_pre) * (1 + scale[:, None]) + shift[:, None]
    hc = rmsnorm(ctx, g_pre) * (1 + scale_c) + shift_c

    if update_ctx:
        qc, kc, vc, gac, ufc, gfc, zcc, bcc, ccc, gcc = split_cols(hc @ w_in, PROJ_SIZES)
    else:
        kc, vc = split_cols(hc @ w_in[:, ATTN_WIDTH:ATTN_WIDTH + 2 * KV_WIDTH], (KV_WIDTH, KV_WIDTH))
    kc = kc.reshape(b, nc, KV_HEADS, HEAD_DIM)
    vc = vc.reshape(b, nc, KV_HEADS, HEAD_DIM)

    q, k, v, ga, uf, gf, zc, bc, cc, gc = split_cols(hx @ w_in, PROJ_SIZES)
    q = apply_axial_rope(q.reshape(b, n, ATTN_HEADS, HEAD_DIM), cos, sin)
    k = apply_axial_rope(k.reshape(b, n, KV_HEADS, HEAD_DIM), cos, sin)
    v = v.reshape(b, n, KV_HEADS, HEAD_DIM)
    a = window_attention(q, k, v, kc, vc, sink_b)
    f = fourier_mix(uf, w_fourier)
    s = short_conv_mix(zc, bc, cc, conv_w, conv_b)
    y = gated_merge(a, ga, f, gf, s, gc, w_out)
    x_new = x + gate[:, None] * rmsnorm(y, g_post)

    if update_ctx:
        ac = context_attention(qc.reshape(b, nc, ATTN_HEADS, HEAD_DIM), kc, vc, sink_b)
        fc = fourier_mix(ufc, w_fourier)
        sc = short_conv_mix(zcc, bcc, ccc, conv_w, conv_b)
        yc = gated_merge(ac, gac, fc, gfc, sc, gcc, w_out)
        ctx = ctx + gate_c * rmsnorm(yc, g_post)
    return x_new, ctx


def setup_inputs(seed: int = 0) -> dict:
    key = jax.random.key(seed)
    ks = jax.random.split(key, 14)
    nrm = jax.random.normal
    x = nrm(ks[0], (BATCH, SEQ, D_MODEL), jnp.float32)
    c = nrm(ks[1], (BATCH, D_MODEL), jnp.float32)
    ctx = nrm(ks[2], (BATCH, CTX_LEN, D_MODEL), jnp.float32)
    c_ctx = nrm(ks[3], (D_MODEL,), jnp.float32)
    w_mod = nrm(ks[4], (DEPTH, D_MODEL, 3 * D_MODEL), jnp.float32) * (0.5 * D_MODEL ** -0.5)
    b_mod = 0.01 * nrm(ks[5], (DEPTH, 3 * D_MODEL), jnp.float32)
    g_pre = 1.0 + 0.05 * nrm(ks[6], (DEPTH, D_MODEL), jnp.float32)
    g_post = 1.0 + 0.05 * nrm(ks[7], (DEPTH, D_MODEL), jnp.float32)
    w_in = nrm(ks[8], (DEPTH, D_MODEL, PROJ_WIDTH), jnp.float32) * (D_MODEL ** -0.5)
    w_out = nrm(ks[9], (DEPTH, MIX_WIDTH, D_MODEL), jnp.float32) * (MIX_WIDTH ** -0.5)
    sink = 0.5 * nrm(ks[10], (DEPTH, ATTN_HEADS), jnp.float32)
    w_fourier = nrm(ks[11], (DEPTH, FOURIER_GROUPS, FOURIER_GROUP_DIM, FOURIER_GROUP_DIM), jnp.float32) * (FOURIER_GROUP_DIM ** -0.5)
    conv_w = nrm(ks[12], (DEPTH, CONV_TAPS, CONV_WIDTH), jnp.float32) * (CONV_TAPS ** -0.5)
    conv_b = 0.01 * nrm(ks[13], (DEPTH, CONV_WIDTH), jnp.float32)
    return {'x': x, 'c': c, 'ctx': ctx, 'c_ctx': c_ctx, 'w_mod': w_mod, 'b_mod': b_mod,
            'g_pre': g_pre, 'g_post': g_post, 'w_in': w_in, 'w_out': w_out, 'sink': sink,
            'w_fourier': w_fourier, 'conv_w': conv_w, 'conv_b': conv_b}


def reference(x, c, ctx, c_ctx, w_mod, b_mod, g_pre, g_post, w_in, w_out, sink, w_fourier, conv_w, conv_b):
    cos, sin = axial_rope_tables(x.shape[1])
    for l in range(DEPTH):
        x, ctx = layer(x, ctx, c, c_ctx, w_mod[l], b_mod[l], g_pre[l], g_post[l], w_in[l], w_out[l],
                       sink[l], w_fourier[l], conv_w[l], conv_b[l], cos, sin, l < DEPTH - 1)
    return x
```

```cpp
#include <hip/hip_runtime.h>
#include <hip/hip_cooperative_groups.h>
#include <cstdio>
#include <cstdint>
namespace cg = cooperative_groups;
namespace pg8 {
#define PG8_LAS __attribute__((address_space(3)))
typedef unsigned short bf16_t;
typedef short bf16x8 __attribute__((ext_vector_type(8)));
typedef float f32x4 __attribute__((ext_vector_type(4)));
typedef unsigned u32x4 __attribute__((ext_vector_type(4)));
constexpr int BM = 256, BK = 64, HALF = 128, HTB = HALF * BK * 2  , STAGE_BYTES = 8 * HTB, NXCD = 8, WGM = 8;

__host__ __device__ __forceinline__ int lds_byte(int r, int c) { const int st = (r >> 4) * 2 + (c >> 5), rr = r & 15, cc = c & 31, ob = rr * 64 + cc * 2; return st * 1024 + (ob ^ (((ob >> 9) & 1) << 5)); }
__host__ __device__ __forceinline__ void stage_rc(int b, int& R, int& C) { const int st = b / 1024, sb = b % 1024, swz = sb ^ (((sb >> 9) & 1) << 5); R = (st >> 1) * 16 + swz / 64; C = (st & 1) * 32 + (swz % 64) / 2; }
__host__ __device__ __forceinline__ int perm32(int rho) { const int n = rho >> 4, i = rho & 15; return 8 * (i >> 2) + 4 * n + (i & 3); }

struct Unit { int pm, pn; };
struct Gemm { const bf16_t* A; const bf16_t* Bt; int M, N, K; };

struct StaticOrder {
    int nM, nN, nwg, G, c;
    __host__ __device__ void init(int M, int N, int G_, int c_) { nM = M / BM; nN = N / BM; nwg = nM * nN; G = G_; c = c_; }
    __host__ __device__ bool next(int i, Unit& u) const {
        const long L = (long)i * G + c; if (L >= nwg) return false;
        int wgid = (int)L; { const int q = nwg / NXCD, r = nwg % NXCD, xcd = wgid % NXCD, off = wgid / NXCD; wgid = (xcd < r ? xcd * (q + 1) : r * (q + 1) + (xcd - r) * q) + off; }
        const int nig = WGM * nN, gid = wgid / nig, fm = gid * WGM, gsz = (nM - fm) < WGM ? (nM - fm) : WGM;
        u.pm = fm + ((wgid % nig) % gsz); u.pn = (wgid % nig) / gsz; return true;
    }
    __device__ __forceinline__ void a_ready(const Unit&) const {}
    __device__ __forceinline__ void done(const Unit&) const {}
};

__device__ __forceinline__ unsigned cvt_pk_bf16(float lo, float hi) { unsigned r; asm volatile("v_cvt_pk_bf16_f32 %0, %1, %2" : "=v"(r) : "v"(lo), "v"(hi)); return r; }
typedef unsigned u32x2 __attribute__((ext_vector_type(2)));
__device__ __forceinline__ int swap23(int t) { return (t & ~12) | ((t & 4) << 1) | ((t & 8) >> 1); }
struct EpiProj {
    static constexpr bool PERM = true, AFTER_DRAIN = false;
    bf16_t* P; bf16_t* Vt; const float* rope; float qscale;
    __device__ __forceinline__ void operator()(const f32x4 (&acc)[2][2][4][2], const Unit& u, int wr, int wc, int fr, int fq) const {
        const int row0 = u.pm * BM + wr * 64 + fr;
        const int pn = u.pn;
        const bool ctxrow = u.pm >= 128;
#pragma unroll
        for (int ai = 0; ai < 2; ++ai)
#pragma unroll
            for (int m = 0; m < 4; ++m) {
                const int row = row0 + ai * HALF + m * 16;
                bf16_t* rowp = P + (size_t)row * 2816 + pn * BM + wc * 32 + 8 * fq;
                if (pn > 2) {
#pragma unroll
                    for (int bj = 0; bj < 2; ++bj) { const f32x4 v0 = acc[ai][bj][m][0], v1 = acc[ai][bj][m][1];
                        u32x4 w; w.x = cvt_pk_bf16(v0[0], v0[1]); w.y = cvt_pk_bf16(v0[2], v0[3]); w.z = cvt_pk_bf16(v1[0], v1[1]); w.w = cvt_pk_bf16(v1[2], v1[3]);
                        *(u32x4*)(rowp + bj * HALF) = w; }
                } else {
                    f32x4 cs = (f32x4){1.f, 1.f, 1.f, 1.f}, sn = (f32x4){0.f, 0.f, 0.f, 0.f};
                    if (!ctxrow) { const int t = row & 8191; const int pos = (wc & 1) ? (t & 63) : (t >> 6);
                        cs = *(const f32x4*)(rope + pos * 32 + 4 * fq); sn = *(const f32x4*)(rope + pos * 32 + 16 + 4 * fq); }
#pragma unroll
                    for (int bj = 0; bj < 2; ++bj) {
                        f32x4 v0 = acc[ai][bj][m][0], v1 = acc[ai][bj][m][1];
                        if (pn == 2 && bj == 1) {
                            int b, tok; if (ctxrow) { const int rr = row - 32768; b = rr >> 8; tok = 8192 + (rr & 255); } else { b = row >> 13; tok = row & 8191; }
                            const int ptok = swap23(tok);
                            bf16_t* vp = Vt + ((size_t)((b * 2 + (wc >> 1)) * 64 + 32 * (wc & 1) + 8 * fq)) * 8448 + ptok;
                            const unsigned w0 = cvt_pk_bf16(v0[0], v0[1]), w1 = cvt_pk_bf16(v0[2], v0[3]), w2 = cvt_pk_bf16(v1[0], v1[1]), w3 = cvt_pk_bf16(v1[2], v1[3]);
                            vp[0 * 8448] = (bf16_t)(w0 & 0xffffu); vp[1 * 8448] = (bf16_t)(w0 >> 16); vp[2 * 8448] = (bf16_t)(w1 & 0xffffu); vp[3 * 8448] = (bf16_t)(w1 >> 16);
                            vp[4 * 8448] = (bf16_t)(w2 & 0xffffu); vp[5 * 8448] = (bf16_t)(w2 >> 16); vp[6 * 8448] = (bf16_t)(w3 & 0xffffu); vp[7 * 8448] = (bf16_t)(w3 >> 16);
                        } else {
                            const f32x4 r0 = v0 * cs - v1 * sn, r1 = v0 * sn + v1 * cs;
                            v0 = r0; v1 = r1;
                            if (pn < 2) { v0 = v0 * qscale; v1 = v1 * qscale; }
                            u32x4 w; w.x = cvt_pk_bf16(v0[0], v0[1]); w.y = cvt_pk_bf16(v0[2], v0[3]); w.z = cvt_pk_bf16(v1[0], v1[1]); w.w = cvt_pk_bf16(v1[2], v1[3]);
                            *(u32x4*)(rowp + bj * HALF) = w;
                        }
                    }
                }
            }
    }
};
struct EpiY {
    static constexpr bool PERM = true, AFTER_DRAIN = false;
    bf16_t* Y; float* ssq;
    __device__ __forceinline__ void operator()(const f32x4 (&acc)[2][2][4][2], const Unit& u, int wr, int wc, int fr, int fq) const {
        const int row0 = u.pm * BM + wr * 64 + fr;
#pragma unroll
        for (int ai = 0; ai < 2; ++ai)
#pragma unroll
            for (int m = 0; m < 4; ++m) {
                const int row = row0 + ai * HALF + m * 16;
                bf16_t* rowp = Y + (size_t)row * 1024 + u.pn * BM + wc * 32 + 8 * fq;
                float s = 0.f;
#pragma unroll
                for (int bj = 0; bj < 2; ++bj) { const f32x4 v0 = acc[ai][bj][m][0], v1 = acc[ai][bj][m][1];
                    s += (v0[0] * v0[0] + v0[1] * v0[1]) + (v0[2] * v0[2] + v0[3] * v0[3]) + (v1[0] * v1[0] + v1[1] * v1[1]) + (v1[2] * v1[2] + v1[3] * v1[3]);
                    u32x4 w; w.x = cvt_pk_bf16(v0[0], v0[1]); w.y = cvt_pk_bf16(v0[2], v0[3]); w.z = cvt_pk_bf16(v1[0], v1[1]); w.w = cvt_pk_bf16(v1[2], v1[3]);
                    *(u32x4*)(rowp + bj * HALF) = w; }
                s += __shfl_xor(s, 16); s += __shfl_xor(s, 32);
                if (fq == 0) ssq[(size_t)row * 16 + u.pn * 4 + wc] = s;
            }
    }
};
template <class Epi, class Sched, bool ALIGN_EPI = false, bool SP2 = false>
__device__ __forceinline__ void gemm_phase(PG8_LAS unsigned char* lds, const Gemm g, const Sched& S, const Epi& E) {
    int tid_ = threadIdx.x; asm volatile("" : "+v"(tid_));
    const int tid = tid_, wid = __builtin_amdgcn_readfirstlane(tid >> 6), lane = tid & 63, wr = wid >> 2, wc = wid & 3, fr = lane & 15, fq = lane >> 4;
    const int K = g.K, nt = K / BK;
    unsigned voffA[2], voffB[2];
#pragma unroll
    for (int i = 0; i < 2; ++i) { int R, C; stage_rc(tid * 16 + i * 8192, R, C); const int Rb = Epi::PERM ? ((R & ~31) + perm32(R & 31)) : R;
        voffA[i] = (unsigned)(R * K + C) * 2u; voffB[i] = (unsigned)(Rb * K + C) * 2u; }
    const size_t kstep = (size_t)(BK * 2);
    const size_t hstep = (size_t)HALF * K * 2;
    const size_t tstep = 2 * hstep;
    const unsigned ldsw = (unsigned)wid * 1024u;
    const int aoff = lds_byte(wr * 64 + fr, fq * 8), boff = lds_byte(wc * 32 + fr, fq * 8);
#define PG8_SA(b, h) (((b) * 2 + (h)) * HTB)
#define PG8_SB(b, h) ((4 + (b) * 2 + (h)) * HTB)
#define PG8_STAGE(bufoff, gbase, voff) do { _Pragma("unroll") for (int _i = 0; _i < 2; ++_i) \
        __builtin_amdgcn_global_load_lds((const unsigned*)((const char*)(gbase) + (voff)[_i]), (PG8_LAS unsigned*)(lds + (bufoff) + ldsw + _i * 8192), 16, 0, 0); } while (0)
#define PG8_LDA(dst, b, h) do { _Pragma("unroll") for (int m = 0; m < 4; ++m) _Pragma("unroll") for (int k = 0; k < 2; ++k) dst[m][k] = *(const PG8_LAS bf16x8*)(lds + PG8_SA(b, h) + aoff + m * 2048 + k * 1024); } while (0)
#define PG8_LDB(dst, b, h) do { _Pragma("unroll") for (int n = 0; n < 2; ++n) _Pragma("unroll") for (int k = 0; k < 2; ++k) dst[n][k] = *(const PG8_LAS bf16x8*)(lds + PG8_SB(b, h) + boff + n * 2048 + k * 1024); } while (0)
#define PG8_MMA(ai, bj, At, Bt) do { __builtin_amdgcn_s_setprio(1); _Pragma("unroll") for (int m = 0; m < 4; ++m) _Pragma("unroll") for (int n = 0; n < 2; ++n) _Pragma("unroll") for (int k = 0; k < 2; ++k) \
        acc[ai][bj][m][n] = __builtin_amdgcn_mfma_f32_16x16x32_bf16(Bt[n][k], At[m][k], acc[ai][bj][m][n], 0, 0, 0); __builtin_amdgcn_s_setprio(0); } while (0)
#define PG8_WAIT_V(n) asm volatile("s_waitcnt vmcnt(" #n ")" ::: "memory")
#define PG8_WAIT_L(n) asm volatile("s_waitcnt lgkmcnt(" #n ")" ::: "memory")
#define PG8_BAR __builtin_amdgcn_s_barrier()
#define PG8_SCHED __builtin_amdgcn_sched_barrier(0)
    Unit cur, nxt; int ui = 0;
    if (!S.next(0, cur)) return;
    f32x4 acc[2][2][4][2];
#pragma unroll
    for (int a = 0; a < 2; ++a)
#pragma unroll
        for (int b = 0; b < 2; ++b)
#pragma unroll
            for (int m = 0; m < 4; ++m)
#pragma unroll
                for (int n = 0; n < 2; ++n) acc[a][b][m][n] = (f32x4){0.f, 0.f, 0.f, 0.f};
    bf16x8 At[4][2], B0[2][2], B1[2][2];
    const char* cA = (const char*)g.A + (size_t)cur.pm * tstep; const char* cB = (const char*)g.Bt + (size_t)cur.pn * tstep;
    S.a_ready(cur);
    if constexpr (SP2) {
        PG8_STAGE(PG8_SB(0, 0), cB, voffB); PG8_STAGE(PG8_SB(0, 1), cB + hstep, voffB); PG8_STAGE(PG8_SA(0, 0), cA, voffA); PG8_STAGE(PG8_SA(0, 1), cA + hstep, voffA);
        if (wr == 1) PG8_BAR;
        PG8_WAIT_V(2); PG8_BAR;
        PG8_STAGE(PG8_SB(1, 0), cB + kstep, voffB); PG8_STAGE(PG8_SA(1, 0), cA + kstep, voffA); PG8_STAGE(PG8_SB(1, 1), cB + hstep + kstep, voffB);
        PG8_WAIT_V(6); PG8_BAR;
    } else {
        PG8_STAGE(PG8_SB(0, 0), cB, voffB); PG8_STAGE(PG8_SA(0, 0), cA, voffA); PG8_STAGE(PG8_SB(0, 1), cB + hstep, voffB); PG8_STAGE(PG8_SA(0, 1), cA + hstep, voffA);
        if (wr == 1) PG8_BAR;
        PG8_WAIT_V(4); PG8_BAR;
        PG8_STAGE(PG8_SB(1, 0), cB + kstep, voffB); PG8_STAGE(PG8_SA(1, 0), cA + kstep, voffA); PG8_STAGE(PG8_SB(1, 1), cB + hstep + kstep, voffB);
        PG8_WAIT_V(6); PG8_BAR;
    }
    for (;;) {
        const bool has_next = S.next(ui + 1, nxt);
        const char* nA = has_next ? (const char*)g.A + (size_t)nxt.pm * tstep : cA; const char* nB = has_next ? (const char*)g.Bt + (size_t)nxt.pn * tstep : cB;
        for (int t = 0; t < nt; t += 2) {
            const bool last = (t == nt - 2);
            const char* a1 = cA + (size_t)(t + 1) * kstep;
            const char* a2 = last ? nA : cA + (size_t)(t + 2) * kstep; const char* b2 = last ? nB : cB + (size_t)(t + 2) * kstep;
            const char* a3 = a2 + kstep; const char* b3 = b2 + kstep;
            if (last && has_next) S.a_ready(nxt);
            if constexpr (SP2) {
            PG8_LDB(B0, 0, 0); PG8_LDB(B1, 0, 1); PG8_SCHED; PG8_LDA(At, 0, 0); PG8_STAGE(PG8_SA(1, 1), a1 + hstep, voffA);
            PG8_WAIT_V(8); PG8_WAIT_L(0); PG8_BAR; PG8_MMA(0, 0, At, B0); PG8_MMA(0, 1, At, B1); PG8_BAR; PG8_SCHED;
            PG8_LDA(At, 0, 1); PG8_STAGE(PG8_SB(0, 0), b2, voffB); PG8_STAGE(PG8_SB(0, 1), b2 + hstep, voffB); PG8_STAGE(PG8_SA(0, 0), a2, voffA);
            PG8_WAIT_V(8); PG8_WAIT_L(0); PG8_BAR; PG8_MMA(1, 0, At, B0); PG8_MMA(1, 1, At, B1); PG8_BAR; PG8_SCHED;
            PG8_LDB(B0, 1, 0); PG8_LDB(B1, 1, 1); PG8_SCHED; PG8_LDA(At, 1, 0); PG8_STAGE(PG8_SA(0, 1), a2 + hstep, voffA);
            PG8_WAIT_V(8); PG8_WAIT_L(0); PG8_BAR; PG8_MMA(0, 0, At, B0); PG8_MMA(0, 1, At, B1); PG8_BAR; PG8_SCHED;
            PG8_LDA(At, 1, 1); PG8_STAGE(PG8_SB(1, 0), b3, voffB); PG8_STAGE(PG8_SB(1, 1), b3 + hstep, voffB); PG8_STAGE(PG8_SA(1, 0), a3, voffA);
            PG8_WAIT_V(8); PG8_WAIT_L(0); PG8_BAR; PG8_MMA(1, 0, At, B0); PG8_MMA(1, 1, At, B1); PG8_BAR; PG8_SCHED;
            } else {
            PG8_LDB(B0, 0, 0); PG8_SCHED; PG8_LDA(At, 0, 0); PG8_STAGE(PG8_SA(1, 1), a1 + hstep, voffA);
            PG8_WAIT_L(8); PG8_BAR; PG8_WAIT_L(0); PG8_MMA(0, 0, At, B0); PG8_BAR; PG8_SCHED;
            PG8_LDB(B1, 0, 1); PG8_STAGE(PG8_SB(0, 0), b2, voffB);
            PG8_BAR; PG8_WAIT_L(0); PG8_MMA(0, 1, At, B1); PG8_BAR;
            PG8_LDA(At, 0, 1); PG8_STAGE(PG8_SA(0, 0), a2, voffA);
            PG8_BAR; PG8_WAIT_L(0); PG8_MMA(1, 0, At, B0); PG8_BAR; PG8_SCHED;
            PG8_STAGE(PG8_SB(0, 1), b2 + hstep, voffB);
            PG8_WAIT_V(6); PG8_BAR; PG8_MMA(1, 1, At, B1); PG8_BAR;
            PG8_LDB(B0, 1, 0); PG8_SCHED; PG8_LDA(At, 1, 0); PG8_STAGE(PG8_SA(0, 1), a2 + hstep, voffA);
            PG8_WAIT_L(8); PG8_BAR; PG8_WAIT_L(0); PG8_MMA(0, 0, At, B0); PG8_BAR; PG8_SCHED;
            PG8_LDB(B1, 1, 1); PG8_STAGE(PG8_SB(1, 0), b3, voffB);
            PG8_BAR; PG8_WAIT_L(0); PG8_MMA(0, 1, At, B1); PG8_BAR;
            PG8_LDA(At, 1, 1); PG8_STAGE(PG8_SA(1, 0), a3, voffA);
            PG8_BAR; PG8_WAIT_L(0); PG8_MMA(1, 0, At, B0); PG8_BAR; PG8_SCHED;
            PG8_STAGE(PG8_SB(1, 1), b3 + hstep, voffB);
            PG8_WAIT_V(6); PG8_BAR; PG8_MMA(1, 1, At, B1); PG8_BAR;
            }
        }
        if constexpr (ALIGN_EPI) { if (wr == 0) PG8_BAR; }
        if constexpr (!Epi::AFTER_DRAIN) { E(acc, cur, wr, wc, fr, fq); S.done(cur); }
        if (!has_next) break;
#pragma unroll
        for (int a = 0; a < 2; ++a)
#pragma unroll
            for (int b = 0; b < 2; ++b)
#pragma unroll
                for (int m = 0; m < 4; ++m)
#pragma unroll
                    for (int n = 0; n < 2; ++n) acc[a][b][m][n] = (f32x4){0.f, 0.f, 0.f, 0.f};
        cur = nxt; cA = nA; cB = nB; ++ui;
        if constexpr (ALIGN_EPI) { if (wr == 1) PG8_BAR; }
    }
    PG8_WAIT_V(0);
    if constexpr (!ALIGN_EPI) { if (wr == 0) PG8_BAR; }
    PG8_BAR;
    if constexpr (Epi::AFTER_DRAIN) { E.fused(acc, cur, wr, wc, fr, fq, lds, wid, lane); S.done(cur); }
#undef PG8_SA
#undef PG8_SB
#undef PG8_STAGE
#undef PG8_LDA
#undef PG8_LDB
#undef PG8_MMA
#undef PG8_WAIT_V
#undef PG8_WAIT_L
#undef PG8_BAR
#undef PG8_SCHED
}
}

typedef unsigned short bf16_t;
typedef short bf16x8 __attribute__((ext_vector_type(8)));
typedef float f32x4 __attribute__((ext_vector_type(4)));
typedef float f32x16 __attribute__((ext_vector_type(16)));
typedef unsigned u32x4 __attribute__((ext_vector_type(4)));
typedef unsigned u32x2 __attribute__((ext_vector_type(2)));
#define LAS __attribute__((address_space(3)))
__device__ __forceinline__ int opaque_tid() { int t = threadIdx.x; asm volatile("" : "+v"(t)); return t; }

constexpr int DM = 1024, NBATCH = 4, SEQ = 8192, NTOK = NBATCH * SEQ, CTXL = 256, NCTX = NBATCH * CTXL, MROWS = NTOK + NCTX;
constexpr int PW = 2816;
constexpr int C_Q = 0, C_K = 512, C_V = 640, C_GA = 768, C_UF = 1280, C_GF = 1536, C_ZC = 1792, C_BC = 2048, C_CC = 2304, C_GC = 2560;
constexpr int VT_PITCH = SEQ + CTXL;
constexpr float NORM_EPS = 1e-6f;
constexpr float LOG2E = 1.4426950408889634f;

constexpr size_t KiB = 1024, MiB = 1u << 20;
constexpr size_t WS_CTL = 0;
constexpr size_t WS_BAR = 16 * KiB;
constexpr size_t WS_ZERO_BYTES = 32 * KiB;
constexpr size_t WS_MOD = 64 * KiB;
constexpr size_t WS_ROPE = 256 * KiB;
constexpr size_t WS_TW = 320 * KiB;
constexpr size_t WS_T1R = 384 * KiB, WS_T1I = 416 * KiB;
constexpr size_t WS_T3R = 448 * KiB, WS_T3I = 464 * KiB;
constexpr size_t WS_T256R = 512 * KiB, WS_T256I = 640 * KiB;
constexpr size_t WS_GT = 768 * KiB;
constexpr size_t WS_SSQ = 1 * MiB;
constexpr size_t WS_WIN = 4 * MiB;
constexpr size_t WS_WOUT = 16 * MiB;
constexpr size_t WS_MODP = 24 * MiB;
constexpr size_t WS_HX = 32 * MiB;
constexpr size_t WS_P = 112 * MiB;
constexpr size_t WS_VT = 304 * MiB;
constexpr size_t WS_H = 320 * MiB;
constexpr size_t WS_Y = 392 * MiB;
constexpr size_t WS_YF = 464 * MiB;
constexpr size_t WS_CTX1 = 500 * MiB;
constexpr size_t WS_END = 504 * MiB;
static_assert(WS_BAR + 3456 * 4 <= WS_ZERO_BYTES && WS_MODP + (size_t)2 * 8 * 5 * 3072 * 4 <= WS_HX && WS_SSQ + (size_t)MROWS * 16 * 4 <= WS_WIN && WS_WIN + (size_t)2 * PW * DM * 2 <= WS_WOUT && WS_HX + (size_t)MROWS * DM * 2 <= WS_P && WS_P + (size_t)MROWS * PW * 2 <= WS_VT &&
              WS_VT + (size_t)8 * 64 * VT_PITCH * 2 <= WS_H && WS_H + (size_t)MROWS * DM * 2 <= WS_Y && WS_Y + (size_t)MROWS * DM * 2 <= WS_YF && WS_YF + (size_t)4 * 128 * 64 * 512 * 2 <= WS_CTX1, "ws map");

constexpr int LDS_BYTES = 147456;
constexpr int LDS_SCHED = LDS_BYTES - 64;
constexpr int LDS_BARST = LDS_BYTES - 32;
constexpr int NTHREADS = 512;

__device__ __forceinline__ float bf2f(unsigned h) { return __uint_as_float(h << 16); }
__device__ __forceinline__ unsigned pkbf(float lo, float hi) { unsigned r; asm volatile("v_cvt_pk_bf16_f32 %0, %1, %2" : "=v"(r) : "v"(lo), "v"(hi)); return r; }
__device__ __forceinline__ float silu_f(float x) { return x * __builtin_amdgcn_rcpf(1.f + __builtin_amdgcn_exp2f(-x * LOG2E)); }
__device__ __forceinline__ float wave_sum(float v) {
#pragma unroll
    for (int o = 1; o < 64; o <<= 1) v += __shfl_xor(v, o);
    return v;
}
__device__ __forceinline__ int swap23(int t) { return (t & ~12) | ((t & 4) << 1) | ((t & 8) >> 1); }
__device__ __forceinline__ int crow(int r, int hi) { return (r & 3) + 8 * (r >> 2) + 4 * hi; }
__device__ __forceinline__ bf16x8 pack8(const f32x16& p, int base) {
    u32x4 w; w.x = pkbf(p[base + 0], p[base + 1]); w.y = pkbf(p[base + 2], p[base + 3]); w.z = pkbf(p[base + 4], p[base + 5]); w.w = pkbf(p[base + 6], p[base + 7]);
    return __builtin_bit_cast(bf16x8, w);
}
#define MFMA32(a, b, c) __builtin_amdgcn_mfma_f32_32x32x16_bf16((a), (b), (c), 0, 0, 0)

struct KArgs {
    const float *x, *c, *ctx, *c_ctx, *w_mod, *b_mod, *g_pre, *g_post, *w_in, *w_out, *sink, *w_f, *conv_w, *conv_b;
    float* out; unsigned char* ws; int ph_lo, ph_hi;
};

__device__ __forceinline__ int prow_qk(int n) { return (n & ~31) | (8 * ((n >> 2) & 3) + 4 * ((n >> 4) & 1) + (n & 3)); }
__device__ __forceinline__ void p0_transpose_item(const float* W, int K, int N, bf16_t* WT, int nperm, float* scr, int item, int lane) {
    const int nblk = N / 32, kb = item / nblk, nb = item % nblk, k0 = 64 * kb, n0 = 32 * nb;
#pragma unroll 8
    for (int i = 0; i < 32; ++i) { const int kk = 2 * i + (lane >> 5); scr[kk * 33 + (lane & 31)] = W[(size_t)(k0 + kk) * N + n0 + (lane & 31)]; }
    asm volatile("s_waitcnt lgkmcnt(0)" ::: "memory");
    const int c = lane & 7;
#pragma unroll
    for (int j = 0; j < 4; ++j) { const int n = (lane >> 3) + 8 * j; const float* s = scr + (8 * c) * 33 + n;
        u32x4 o; o.x = pkbf(s[0 * 33], s[1 * 33]); o.y = pkbf(s[2 * 33], s[3 * 33]); o.z = pkbf(s[4 * 33], s[5 * 33]); o.w = pkbf(s[6 * 33], s[7 * 33]);
        const int nl = n0 + n; const int np = nl < nperm ? prow_qk(nl) : nl;
        *(u32x4*)(WT + (size_t)np * K + k0 + 8 * c) = o; }
    asm volatile("s_waitcnt lgkmcnt(0)" ::: "memory");
}

__device__ __forceinline__ void p0_mod_gemv(const KArgs& a, int item, float* ldsf) {
    const int tid = opaque_tid(), lane = tid & 63, wave = tid >> 6;
    const int l = item / 96, col0 = (item % 96) * 32;
    float* s = ldsf;
    float* red = ldsf + 5 * 1024;
    for (int i = tid; i < 5 * 1024; i += NTHREADS) { const int bb = i >> 10, k = i & 1023; const float v = bb < 4 ? a.c[bb * 1024 + k] : a.c_ctx[k]; s[i] = v / (1.f + __expf(-v)); }
    __syncthreads();
    const int col = lane & 31, kh = lane >> 5;
    const float* W = a.w_mod + (size_t)l * 1024 * 3072 + (size_t)(wave * 128 + kh) * 3072 + col0 + col;
    float w[64];
#pragma unroll
    for (int i = 0; i < 64; ++i) w[i] = W[(size_t)(2 * i) * 3072];
    float acc[5] = {0.f, 0.f, 0.f, 0.f, 0.f};
#pragma unroll
    for (int i = 0; i < 64; ++i)
#pragma unroll
        for (int bb = 0; bb < 5; ++bb) acc[bb] += w[i] * s[bb * 1024 + wave * 128 + 2 * i + kh];
#pragma unroll
    for (int bb = 0; bb < 5; ++bb) red[((wave * 2 + kh) * 5 + bb) * 32 + col] = acc[bb];
    __syncthreads();
    if (tid < 160) { const int bb = tid >> 5, cc = tid & 31; float v = a.b_mod[l * 3072 + col0 + cc];
#pragma unroll
        for (int ww = 0; ww < 16; ++ww) v += red[(ww * 5 + bb) * 32 + cc];
        ((float*)(a.ws + WS_MOD))[(l * 5 + bb) * 3072 + col0 + cc] = v; }
    __syncthreads();
}

__device__ __forceinline__ void p0_prologue(const KArgs& a, unsigned char* lds) {
    const int tid = opaque_tid(), lane = tid & 63, wave = tid >> 6;
    const int G = gridDim.x, bx = blockIdx.x;
    unsigned char* ws = a.ws;
    if (bx < 192) p0_mod_gemv(a, bx, (float*)lds);
    {
        float* scr = (float*)(lds + wave * 16384);
        const int gw = bx * 8 + wave, NGW = G * 8;
        constexpr int I_IN = (DM / 64) * (PW / 32), I_OUT = (DM / 64) * (DM / 32);
        constexpr int NIT = 2 * (I_IN + I_OUT);
        for (int it = gw; it < NIT; it += NGW) {
            int r = it; const int l = r / (I_IN + I_OUT); r -= l * (I_IN + I_OUT);
            if (r < I_IN) p0_transpose_item(a.w_in + (size_t)l * DM * PW, DM, PW, (bf16_t*)(ws + WS_WIN) + (size_t)l * PW * DM, 640, scr, r, lane);
            else p0_transpose_item(a.w_out + (size_t)l * DM * DM, DM, DM, (bf16_t*)(ws + WS_WOUT) + (size_t)l * DM * DM, 0, scr, r - I_IN, lane);
        }
    }
    const int gt = bx * NTHREADS + tid, NGT = G * NTHREADS;
    for (int i = gt; i < 128 * 16; i += NGT) {
        const int pos = i >> 4, f = i & 15; const float inv = powf(10000.0f, -(float)f / 16.0f); const float ang = (float)pos * inv;
        float* rp = (float*)(ws + WS_ROPE) + pos * 32; rp[f] = cosf(ang); rp[16 + f] = sinf(ang);
    }
    for (int i = gt; i < 8192; i += NGT) { float sn, cs; sincospif((float)i * (2.0f / 8192.0f), &sn, &cs); float* t = (float*)(ws + WS_TW) + 2 * i; t[0] = cs; t[1] = sn; }
    for (int i = gt; i < 128 * 128; i += NGT) { const int k = i >> 7, n = i & 127; float sn, cs; sincospif((float)((k * n) & 127) * (2.0f / 128.0f), &sn, &cs);
        ((bf16_t*)(ws + WS_T1R))[i] = (bf16_t)(pkbf(cs, 0.f) & 0xffffu); ((bf16_t*)(ws + WS_T1I))[i] = (bf16_t)(pkbf(-sn, 0.f) & 0xffffu); }
    for (int i = gt; i < 64 * 128; i += NGT) { const int k = i >> 7, kk = i & 127, n = kk & 63; float sn, cs; sincospif((float)((k * n) & 63) * (2.0f / 64.0f), &sn, &cs);
        const float tr = kk < 64 ? cs : sn, ti = kk < 64 ? -sn : cs;
        ((bf16_t*)(ws + WS_T3R))[i] = (bf16_t)(pkbf(tr, 0.f) & 0xffffu); ((bf16_t*)(ws + WS_T3I))[i] = (bf16_t)(pkbf(ti, 0.f) & 0xffffu); }
    for (int i = gt; i < 256 * 256; i += NGT) { const int k = i >> 8, n = i & 255; float sn, cs; sincospif((float)((k * n) & 255) * (2.0f / 256.0f), &sn, &cs);
        ((bf16_t*)(ws + WS_T256R))[i] = (bf16_t)(pkbf(cs, 0.f) & 0xffffu); ((bf16_t*)(ws + WS_T256I))[i] = (bf16_t)(pkbf(-sn, 0.f) & 0xffffu); }
    {
        __syncthreads();
        float* trig = (float*)lds;
        if (tid < 64) { float sn, cs; sincospif((float)tid * (2.0f / 64.0f), &sn, &cs); trig[tid] = cs; trig[64 + tid] = sn; }
        __syncthreads();
        for (int i = gt; i < 2 * 4 * 64 * 128; i += NGT) {
            const int kk = i & 127, d = (i >> 7) & 63, g = (i >> 13) & 3, l = i >> 15; const int part = kk >> 6, c = swap23(kk & 63);
            const float* wf = a.w_f + ((size_t)(l * 4 + g) * 64) * 64 + d; float sacc = 0.f;
#pragma unroll 8
            for (int j = 0; j < 64; ++j) sacc += trig[part * 64 + ((c * j) & 63)] * wf[j * 64];
            ((bf16_t*)(ws + WS_GT))[i] = (bf16_t)(pkbf(sacc * (1.0f / 724.0773439350246f), 0.f) & 0xffffu);
        }
        __syncthreads();
    }
}

__device__ __forceinline__ void norm_rows4(int mode, int lane, const float* src, float* dst, const bf16_t* y, const float* ssq, bf16_t* hx,
                                           const f32x4 (&GA)[4], const f32x4 (&GB)[4], const f32x4 (&GC)[4]) {
    f32x4 v[4][4];
#pragma unroll
    for (int rr = 0; rr < 4; ++rr)
#pragma unroll
        for (int j = 0; j < 4; ++j) v[rr][j] = *(const f32x4*)(src + (size_t)rr * DM + 4 * lane + 256 * j);
    if (mode != 0) {
        u32x2 yw[4][4]; float p[4];
#pragma unroll
        for (int rr = 0; rr < 4; ++rr) { p[rr] = ssq[rr * 16 + (lane & 15)];
#pragma unroll
            for (int j = 0; j < 4; ++j) yw[rr][j] = *(const u32x2*)(y + (size_t)rr * DM + 4 * lane + 256 * j); }
#pragma unroll
        for (int rr = 0; rr < 4; ++rr) {
            float q = p[rr]; q += __shfl_xor(q, 1); q += __shfl_xor(q, 2); q += __shfl_xor(q, 4); q += __shfl_xor(q, 8);
            const float rstd = 1.0f / sqrtf(q * (1.0f / DM) + NORM_EPS);
#pragma unroll
            for (int j = 0; j < 4; ++j) {
                f32x4 yy; yy[0] = bf2f(yw[rr][j].x & 0xffffu); yy[1] = bf2f(yw[rr][j].x >> 16); yy[2] = bf2f(yw[rr][j].y & 0xffffu); yy[3] = bf2f(yw[rr][j].y >> 16);
                v[rr][j] = v[rr][j] + GA[j] * (yy * rstd);
                *(f32x4*)(dst + (size_t)rr * DM + 4 * lane + 256 * j) = v[rr][j];
            }
        }
    }
    if (mode != 2) {
        float s[4];
#pragma unroll
        for (int rr = 0; rr < 4; ++rr) { float t = 0.f;
#pragma unroll
            for (int j = 0; j < 4; ++j) t += (v[rr][j][0] * v[rr][j][0] + v[rr][j][1] * v[rr][j][1]) + (v[rr][j][2] * v[rr][j][2] + v[rr][j][3] * v[rr][j][3]);
            s[rr] = t; }
#pragma unroll
        for (int o = 1; o < 64; o <<= 1) {
#pragma unroll
            for (int rr = 0; rr < 4; ++rr) s[rr] += __shfl_xor(s[rr], o); }
#pragma unroll
        for (int rr = 0; rr < 4; ++rr) {
            const float rstd = 1.0f / sqrtf(s[rr] * (1.0f / DM) + NORM_EPS);
#pragma unroll
            for (int j = 0; j < 4; ++j) {
                const f32x4 o = (v[rr][j] * rstd) * GB[j] + GC[j];
                u32x2 w; w.x = pkbf(o[0], o[1]); w.y = pkbf(o[2], o[3]);
                *(u32x2*)(hx + (size_t)rr * DM + 4 * lane + 256 * j) = w;
            }
        }
    }
}
__device__ __forceinline__ void norm_phase(const KArgs& a, int mode) {
    const int tid = opaque_tid(), lane = tid & 63, wave = tid >> 6;
    const int NGW = gridDim.x * 8;
    unsigned char* ws = a.ws;
    const float* mod = (const float*)(ws + WS_MOD);
    const int lp = (mode == 0) ? 0 : 1;
    const int lq = (mode == 1) ? 0 : 1;
    bf16_t* HX = (bf16_t*)(ws + WS_HX); const bf16_t* Y = (const bf16_t*)(ws + WS_Y); const float* SSQ = (const float*)(ws + WS_SSQ);
    const int gw2 = wave * (int)gridDim.x + (int)blockIdx.x;
    const int nlat = NTOK / 4;
    int curb = -1; f32x4 GA[4], GB[4], GC[4];
    int base = gw2 * 4, sub = 0, itc = nlat + gw2; bool inctx = false;
    for (;;) {
        int it;
        if (!inctx) { if (base >= nlat) { inctx = true; continue; } it = base + sub; if (++sub == 4) { sub = 0; base += NGW * 4; } }
        else { if (mode == 2 || itc >= nlat + NCTX / 4) break; it = itc; itc += NGW; }
        const int r = it * 4;
        const int b = r < NTOK ? (r >> 13) : 4;
        if (b != curb) { curb = b;
            const float* mp = mod + (lp * 5 + b) * 3072; const float* mq = mod + (lq * 5 + b) * 3072;
#pragma unroll
            for (int j = 0; j < 4; ++j) { const int c = 4 * lane + 256 * j;
                GA[j] = *(const f32x4*)(mq + 2048 + c) * *(const f32x4*)(a.g_post + lq * DM + c);
                GB[j] = *(const f32x4*)(a.g_pre + lp * DM + c) * (*(const f32x4*)(mp + 1024 + c) + 1.0f);
                GC[j] = *(const f32x4*)(mp + c); } }
        const float* src; float* dst;
        if (r < NTOK) { src = (mode == 2 ? (const float*)a.out : a.x) + (size_t)r * DM; dst = a.out + (size_t)r * DM; }
        else { src = a.ctx + (size_t)(r - NTOK) * DM; dst = (float*)(ws + WS_CTX1) + (size_t)(r - NTOK) * DM; }
        norm_rows4(mode, lane, src, dst, Y + (size_t)r * DM, SSQ + (size_t)r * 16, HX + (size_t)r * DM, GA, GB, GC);
    }
}

__device__ __forceinline__ void attn_unit(int u, const bf16_t* P, const bf16_t* Vt, bf16_t* H, const float* sink, unsigned char* lds) {
    const int tid = opaque_tid(), lane = tid & 63, wave = __builtin_amdgcn_readfirstlane(tid >> 6), r32 = lane & 31, hi = lane >> 5;
    const bool isctx = u >= 1024;
    int b, kvh, qb;
    if (isctx) { const int v = u - 1024; b = v >> 3; kvh = (v >> 2) & 1; qb = v & 3; } else { b = u >> 8; kvh = (u >> 7) & 1; qb = u & 127; }
    const int head = kvh * 4 + (wave >> 1);
    const int qtok = qb * 64 + (wave & 1) * 32 + r32;
    const size_t qrow = isctx ? (size_t)(NTOK + b * CTXL + qtok) : (size_t)(b * SEQ + qtok);
    bf16x8 qf[4];
#pragma unroll
    for (int d0 = 0; d0 < 4; ++d0) qf[d0] = *(const bf16x8*)(P + qrow * PW + C_Q + head * 64 + d0 * 16 + hi * 8);
    int jlo = 0, jhi = -1;
    if (!isctx) { jlo = qb < 2 ? 2 - qb : 0; jhi = (129 - qb) < 4 ? (129 - qb) : 4; }
    const int ntiles = 4 + (jhi - jlo + 1);
    const int srow = tid >> 3, sch = tid & 7;
    const bf16_t* Kc = P + (size_t)(NTOK + b * CTXL + srow) * PW + C_K + kvh * 64 + sch * 8;
    const bf16_t* Kl = P + (size_t)(b * SEQ + srow) * PW + C_K + kvh * 64 + sch * 8;
    const bf16_t* Vb = Vt + (size_t)((b * 2 + kvh) * 64 + srow) * VT_PITCH + sch * 8;
    unsigned char* Ks = lds; unsigned char* Vs = lds + 2 * 9216;
    const int soff = srow * 144 + sch * 16;
    u32x4 kreg, vreg, kreg2, vreg2;
#define ATT_GLOAD(KR, VR, ti_) do { const int t_ = (ti_); \
        if (t_ < 4) { KR = *(const u32x4*)(Kc + (size_t)(64 * t_) * PW); VR = *(const u32x4*)(Vb + SEQ + 64 * t_); } \
        else { const int kbase_ = qb * 64 - 128 + 64 * (jlo + t_ - 4); KR = *(const u32x4*)(Kl + (size_t)kbase_ * PW); VR = *(const u32x4*)(Vb + kbase_); } } while (0)
    const bf16_t* garow = P + qrow * PW + C_GA + head * 64;
    u32x2 gaw[8];
#pragma unroll
    for (int i = 0; i < 8; ++i) gaw[i] = *(const u32x2*)(garow + 32 * (i >> 2) + 8 * (i & 3) + 4 * hi);
    ATT_GLOAD(kreg2, vreg2, 0);
    ATT_GLOAD(kreg, vreg, 1);
    *(u32x4*)(Ks + soff) = kreg2; *(u32x4*)(Vs + soff) = vreg2;
    __syncthreads();
    const float sink2 = sink[head] * LOG2E;
    float mref = sink2, lsum = 0.f;
    f32x16 oT[2]; oT[0] = f32x16{}; oT[1] = f32x16{};
    const int qpos = qtok;
    for (int ti = 0; ti < ntiles; ++ti) {
        const int buf = ti & 1;
        if (ti + 2 < ntiles) ATT_GLOAD(kreg2, vreg2, ti + 2);
        const unsigned char* kb = Ks + buf * 9216 + r32 * 144 + hi * 16;
        const unsigned char* vb = Vs + buf * 9216 + r32 * 144 + hi * 16;
        bf16x8 kf[8];
#pragma unroll
        for (int d0 = 0; d0 < 4; ++d0) { kf[2 * d0] = *(const bf16x8*)(kb + d0 * 32); kf[2 * d0 + 1] = *(const bf16x8*)(kb + 32 * 144 + d0 * 32); }
        f32x16 p0, p1;
#pragma unroll
        for (int r = 0; r < 16; ++r) { p0[r] = -mref; p1[r] = -mref; }
        __builtin_amdgcn_sched_barrier(0);
#pragma unroll
        for (int d0 = 0; d0 < 4; ++d0) { p0 = MFMA32(kf[2 * d0], qf[d0], p0); p1 = MFMA32(kf[2 * d0 + 1], qf[d0], p1); }
        bf16x8 vf[8];
#pragma unroll
        for (int blk = 0; blk < 2; ++blk)
#pragma unroll
            for (int ks = 0; ks < 4; ++ks) vf[blk * 4 + ks] = *(const bf16x8*)(vb + blk * 32 * 144 + ks * 32);
        __builtin_amdgcn_sched_barrier(0);
        if (ti >= 4) {
            const int j = jlo + ti - 4; const int kbase = qb * 64 - 128 + 64 * j;
            if (j == 0) {
#pragma unroll
                for (int r = 0; r < 16; ++r) { const int kp = kbase + crow(r, hi); if (kp < qpos - 128) p0[r] = -INFINITY; if (kp + 32 < qpos - 128) p1[r] = -INFINITY; }
            } else if (j == 4) {
#pragma unroll
                for (int r = 0; r < 16; ++r) { const int kp = kbase + crow(r, hi); if (kp > qpos + 128) p0[r] = -INFINITY; if (kp + 32 > qpos + 128) p1[r] = -INFINITY; }
            }
        }
        float rm = fmaxf(p0[0], p1[0]);
#pragma unroll
        for (int r = 1; r < 16; ++r) rm = fmaxf(rm, fmaxf(p0[r], p1[r]));
        rm = fmaxf(rm, __shfl_xor(rm, 32));
        if (__any(rm > 8.0f)) {
            const float dl = fmaxf(rm, 0.f);
            mref += dl;
            const float f = __builtin_amdgcn_exp2f(-dl);
            lsum *= f;
#pragma unroll
            for (int r = 0; r < 16; ++r) { p0[r] -= dl; p1[r] -= dl; oT[0][r] *= f; oT[1][r] *= f; }
        }
        float ls = 0.f;
#pragma unroll
        for (int r = 0; r < 16; ++r) { p0[r] = __builtin_amdgcn_exp2f(p0[r]); p1[r] = __builtin_amdgcn_exp2f(p1[r]); ls += p0[r] + p1[r]; }
        lsum += ls;
        bf16x8 pf[4]; pf[0] = pack8(p0, 0); pf[1] = pack8(p0, 8); pf[2] = pack8(p1, 0); pf[3] = pack8(p1, 8);
#pragma unroll
        for (int blk = 0; blk < 2; ++blk)
#pragma unroll
            for (int ks = 0; ks < 4; ++ks) oT[blk] = MFMA32(vf[blk * 4 + ks], pf[ks], oT[blk]);
        if (ti + 1 < ntiles) { *(u32x4*)(Ks + (buf ^ 1) * 9216 + soff) = kreg; *(u32x4*)(Vs + (buf ^ 1) * 9216 + soff) = vreg; }
        kreg = kreg2; vreg = vreg2;
        __syncthreads();
    }
    lsum += __shfl_xor(lsum, 32);
    lsum += __builtin_amdgcn_exp2f(sink2 - mref);
    const float inv = 1.0f / lsum;
    bf16_t* hrow = H + qrow * DM + head * 64;
#pragma unroll
    for (int blk = 0; blk < 2; ++blk)
#pragma unroll
        for (int g4 = 0; g4 < 4; ++g4) {
            const int d0 = 32 * blk + 8 * g4 + 4 * hi;
            const u32x2 gw = gaw[blk * 4 + g4];
            const float o0 = oT[blk][4 * g4 + 0] * inv * silu_f(bf2f(gw.x & 0xffffu)), o1 = oT[blk][4 * g4 + 1] * inv * silu_f(bf2f(gw.x >> 16));
            const float o2 = oT[blk][4 * g4 + 2] * inv * silu_f(bf2f(gw.y & 0xffffu)), o3 = oT[blk][4 * g4 + 3] * inv * silu_f(bf2f(gw.y >> 16));
            u32x2 w; w.x = pkbf(o0, o1); w.y = pkbf(o2, o3);
            *(u32x2*)(hrow + d0) = w;
        }
}

typedef short v4i16_t __attribute__((ext_vector_type(4)));
__device__ __forceinline__ v4i16_t trrd(const unsigned char* p) { return __builtin_amdgcn_ds_read_tr16_b64_v4i16((LAS v4i16_t*)p); }
__device__ __forceinline__ bf16x8 cat8(v4i16_t lo, v4i16_t hi) { return (bf16x8){lo[0], lo[1], lo[2], lo[3], hi[0], hi[1], hi[2], hi[3]}; }
__device__ __forceinline__ void fft1_unit(int u, const bf16_t* P, bf16_t* YF, const unsigned char* ws, unsigned char* lds) {
    const int tid = opaque_tid(), lane = tid & 63, wave = __builtin_amdgcn_readfirstlane(tid >> 6), r32 = lane & 31, hi = lane >> 5;
    const int b = u >> 6, n2 = u & 63;
    constexpr int UPB = 576;
    const bf16_t* src = P + (size_t)(b * SEQ + n2) * PW + C_UF;
#pragma unroll
    for (int i = 0; i < 8; ++i) {
        const int id = tid + NTHREADS * i, n1 = id >> 5, cc = id & 31;
        *(u32x4*)(lds + n1 * UPB + cc * 16) = *(const u32x4*)(src + (size_t)n1 * 64 * PW + cc * 8);
    }
    __syncthreads();
    const bf16_t* T1R = (const bf16_t*)(ws + WS_T1R); const bf16_t* T1I = (const bf16_t*)(ws + WS_T1I);
    f32x16 aR[4], aI[4];
#pragma unroll
    for (int kb = 0; kb < 4; ++kb) { aR[kb] = f32x16{}; aI[kb] = f32x16{}; }
    const unsigned char* ap = lds + (8 * hi + ((lane & 15) >> 2)) * UPB + (32 * wave + 16 * ((lane >> 4) & 1) + 4 * (lane & 3)) * 2;
#pragma unroll 2
    for (int ks = 0; ks < 8; ++ks) {
        const bf16x8 av = cat8(trrd(ap + (16 * ks) * UPB), trrd(ap + (16 * ks + 4) * UPB));
#pragma unroll
        for (int kb = 0; kb < 4; ++kb) {
            const bf16x8 bR = *(const bf16x8*)(T1R + (32 * kb + r32) * 128 + 16 * ks + 8 * hi), bI = *(const bf16x8*)(T1I + (32 * kb + r32) * 128 + 16 * ks + 8 * hi);
            aR[kb] = MFMA32(av, bR, aR[kb]); aI[kb] = MFMA32(av, bI, aI[kb]);
        }
    }
    const float* TW = (const float*)(ws + WS_TW);
#pragma unroll
    for (int kb = 0; kb < 4; ++kb) {
        const int k1 = 32 * kb + r32;
        const float ct = TW[2 * (n2 * k1)], st = TW[2 * (n2 * k1) + 1];
        bf16_t* yp = YF + ((size_t)((b * 128 + k1) * 64 + n2)) * 512 + 32 * wave + 4 * hi;
#pragma unroll
        for (int g4 = 0; g4 < 4; ++g4) {
            float yr[4], yi[4];
#pragma unroll
            for (int e = 0; e < 4; ++e) { const float r_ = aR[kb][4 * g4 + e], i_ = aI[kb][4 * g4 + e]; yr[e] = r_ * ct + i_ * st; yi[e] = i_ * ct - r_ * st; }
            u32x2 wr_, wi_; wr_.x = pkbf(yr[0], yr[1]); wr_.y = pkbf(yr[2], yr[3]); wi_.x = pkbf(yi[0], yi[1]); wi_.y = pkbf(yi[2], yi[3]);
            *(u32x2*)(yp + 8 * g4) = wr_; *(u32x2*)(yp + 256 + 8 * g4) = wi_;
        }
    }
    __syncthreads();
}

template <int KK>
__device__ __forceinline__ void dftf_unit(const bf16_t* srcbase, int R, int pitchA, int pitchB, const bf16_t* Tr, const bf16_t* Ti, const bf16_t* Gt,
                                          const bf16_t* P, bf16_t* H, size_t row0, int rowstride, float oscale, unsigned char* lds) {
    const int tid = opaque_tid(), lane = tid & 63, wave = __builtin_amdgcn_readfirstlane(tid >> 6), r32 = lane & 31, hi = lane >> 5;
    constexpr int ZPB = (KK == 128) ? 576 : 544;
#pragma unroll 4
    for (int i = 0; i < KK / 16; ++i) {
        const int id = tid + NTHREADS * i, kk = id >> 5, cc = id & 31;
        *(u32x4*)(lds + kk * ZPB + cc * 16) = *(const u32x4*)(srcbase + (size_t)(kk % R) * pitchA + (size_t)(kk / R) * pitchB + cc * 8);
    }
    __syncthreads();
    const int g = wave >> 1, kblk = wave & 1;
    f32x16 XR[2], XI[2];
#pragma unroll
    for (int cb = 0; cb < 2; ++cb) { XR[cb] = f32x16{}; XI[cb] = f32x16{}; }
    const bf16_t* trp = Tr + (size_t)(32 * kblk + r32) * KK + 8 * hi; const bf16_t* tip = Ti + (size_t)(32 * kblk + r32) * KK + 8 * hi;
    const unsigned char* zp = lds + (8 * hi + ((lane & 15) >> 2)) * ZPB + (64 * g + 16 * ((lane >> 4) & 1) + 4 * (lane & 3)) * 2;
#pragma unroll 2
    for (int ks = 0; ks < KK / 16; ++ks) {
        const bf16x8 bR = *(const bf16x8*)(trp + 16 * ks), bI = *(const bf16x8*)(tip + 16 * ks);
#pragma unroll
        for (int cb = 0; cb < 2; ++cb) { const bf16x8 av = cat8(trrd(zp + (16 * ks) * ZPB + cb * 64), trrd(zp + (16 * ks + 4) * ZPB + cb * 64)); XR[cb] = MFMA32(av, bR, XR[cb]); XI[cb] = MFMA32(av, bI, XI[cb]); }
    }
    f32x16 oa[2]; oa[0] = f32x16{}; oa[1] = f32x16{};
    const bf16_t* gp = Gt + (size_t)(g * 64 + r32) * 128 + 8 * hi;
#pragma unroll
    for (int part = 0; part < 2; ++part)
#pragma unroll
        for (int cb = 0; cb < 2; ++cb)
#pragma unroll
            for (int s = 0; s < 2; ++s) {
                const bf16x8 bx = pack8(part ? XI[cb] : XR[cb], 8 * s);
                const int kko = part * 64 + 32 * cb + 16 * s;
#pragma unroll
                for (int lb = 0; lb < 2; ++lb) { const bf16x8 ag = *(const bf16x8*)(gp + (size_t)(32 * lb) * 128 + kko); oa[lb] = MFMA32(ag, bx, oa[lb]); }
            }
    const int k2 = 32 * kblk + r32;
    const size_t row = row0 + (size_t)k2 * rowstride;
    const bf16_t* gfrow = P + row * PW + C_GF + 64 * g;
    bf16_t* hrow = H + row * DM + 512 + 64 * g;
#pragma unroll
    for (int lb = 0; lb < 2; ++lb)
#pragma unroll
        for (int g4 = 0; g4 < 4; ++g4) {
            const int l0 = 32 * lb + 8 * g4 + 4 * hi;
            const u32x2 gw = *(const u32x2*)(gfrow + l0);
            const float o0 = oa[lb][4 * g4 + 0] * oscale * silu_f(bf2f(gw.x & 0xffffu)), o1 = oa[lb][4 * g4 + 1] * oscale * silu_f(bf2f(gw.x >> 16));
            const float o2 = oa[lb][4 * g4 + 2] * oscale * silu_f(bf2f(gw.y & 0xffffu)), o3 = oa[lb][4 * g4 + 3] * oscale * silu_f(bf2f(gw.y >> 16));
            u32x2 w; w.x = pkbf(o0, o1); w.y = pkbf(o2, o3);
            *(u32x2*)(hrow + l0) = w;
        }
    __syncthreads();
}

__device__ __forceinline__ void conv_unit(int u, const bf16_t* P, bf16_t* H, const float* cw, const float* cb) {
    const int tid = opaque_tid(), cgp = tid & 31, rg = tid >> 5;
    const int ch0 = cgp * 8;
    const int r0 = u * 64 + rg * 4;
    int pos, len; if (r0 < NTOK) { pos = r0 & (SEQ - 1); len = SEQ; } else { pos = (r0 - NTOK) & (CTXL - 1); len = CTXL; }
    float w0[8], w1[8], w2[8], bs[8];
#pragma unroll
    for (int e = 0; e < 8; ++e) { w0[e] = cw[ch0 + e]; w1[e] = cw[256 + ch0 + e]; w2[e] = cw[512 + ch0 + e]; bs[e] = cb[ch0 + e]; }
    float T[6][8];
#pragma unroll
    for (int i = 0; i < 6; ++i) {
        const int p = pos - 1 + i;
        if (p >= 0 && p < len) {
            const size_t row = (size_t)(r0 - 1 + i);
            const u32x4 z = *(const u32x4*)(P + row * PW + C_ZC + ch0), c = *(const u32x4*)(P + row * PW + C_CC + ch0);
            T[i][0] = bf2f(z.x & 0xffffu) * bf2f(c.x & 0xffffu); T[i][1] = bf2f(z.x >> 16) * bf2f(c.x >> 16);
            T[i][2] = bf2f(z.y & 0xffffu) * bf2f(c.y & 0xffffu); T[i][3] = bf2f(z.y >> 16) * bf2f(c.y >> 16);
            T[i][4] = bf2f(z.z & 0xffffu) * bf2f(c.z & 0xffffu); T[i][5] = bf2f(z.z >> 16) * bf2f(c.z >> 16);
            T[i][6] = bf2f(z.w & 0xffffu) * bf2f(c.w & 0xffffu); T[i][7] = bf2f(z.w >> 16) * bf2f(c.w >> 16);
        } else {
#pragma unroll
            for (int e = 0; e < 8; ++e) T[i][e] = 0.f;
        }
    }
#pragma unroll
    for (int i = 0; i < 4; ++i) {
        const size_t row = (size_t)(r0 + i);
        const u32x4 bw = *(const u32x4*)(P + row * PW + C_BC + ch0), gw = *(const u32x4*)(P + row * PW + C_GC + ch0);
        const unsigned bwv[4] = {bw.x, bw.y, bw.z, bw.w}, gwv[4] = {gw.x, gw.y, gw.z, gw.w};
        float o[8];
#pragma unroll
        for (int e = 0; e < 8; ++e) {
            const float bv = (e & 1) ? bf2f(bwv[e >> 1] >> 16) : bf2f(bwv[e >> 1] & 0xffffu);
            const float gv = (e & 1) ? bf2f(gwv[e >> 1] >> 16) : bf2f(gwv[e >> 1] & 0xffffu);
            const float y = T[i][e] * w0[e] + T[i + 1][e] * w1[e] + T[i + 2][e] * w2[e] + bs[e];
            o[e] = bv * y * silu_f(gv);
        }
        u32x4 w; w.x = pkbf(o[0], o[1]); w.y = pkbf(o[2], o[3]); w.z = pkbf(o[4], o[5]); w.w = pkbf(o[6], o[7]);
        *(u32x4*)(H + row * DM + 768 + ch0) = w;
    }
}

__device__ __forceinline__ void fft1_wave(int task, const bf16_t* P, bf16_t* YF, const unsigned char* ws, unsigned char* lds_w, int lane) {
    const int r32 = lane & 31, hi = lane >> 5;
    const int cblk = task & 7, n2 = (task >> 3) & 63, b = task >> 9;
    const bf16_t* src = P + (size_t)(b * SEQ + n2) * PW + C_UF + 32 * cblk + 8 * (lane & 3);
#pragma unroll
    for (int i = 0; i < 8; ++i) { const int n1 = 16 * i + (lane >> 2);
        *(u32x4*)(lds_w + n1 * 64 + (lane & 3) * 16) = *(const u32x4*)(src + (size_t)n1 * 64 * PW); }
    asm volatile("s_waitcnt vmcnt(0) lgkmcnt(0)" ::: "memory");
    const bf16_t* T1R = (const bf16_t*)(ws + WS_T1R); const bf16_t* T1I = (const bf16_t*)(ws + WS_T1I);
    f32x16 aR[4], aI[4];
#pragma unroll
    for (int kb = 0; kb < 4; ++kb) { aR[kb] = f32x16{}; aI[kb] = f32x16{}; }
    const unsigned char* ap = lds_w + (8 * hi + ((lane & 15) >> 2)) * 64 + (16 * ((lane >> 4) & 1) + 4 * (lane & 3)) * 2;
    const bf16_t* t1r = T1R + (size_t)r32 * 128 + 8 * hi; const bf16_t* t1i = T1I + (size_t)r32 * 128 + 8 * hi;
    bf16x8 bA[8], bB[8];
#define F1_LOADB(B, ks_) do { _Pragma("unroll") for (int kb = 0; kb < 4; ++kb) { B[2 * kb] = *(const bf16x8*)(t1r + (size_t)(32 * kb) * 128 + 16 * (ks_)); B[2 * kb + 1] = *(const bf16x8*)(t1i + (size_t)(32 * kb) * 128 + 16 * (ks_)); } } while (0)
#define F1_STEP(B, ks_) do { const bf16x8 av = cat8(trrd(ap + (16 * (ks_)) * 64), trrd(ap + (16 * (ks_) + 4) * 64)); \
        _Pragma("unroll") for (int kb = 0; kb < 4; ++kb) { aR[kb] = MFMA32(av, B[2 * kb], aR[kb]); aI[kb] = MFMA32(av, B[2 * kb + 1], aI[kb]); } } while (0)
    F1_LOADB(bA, 0);
#pragma unroll
    for (int k2 = 0; k2 < 4; ++k2) {
        F1_LOADB(bB, 2 * k2 + 1);
        __builtin_amdgcn_sched_barrier(0);
        F1_STEP(bA, 2 * k2);
        __builtin_amdgcn_sched_barrier(0);
        if (k2 < 3) F1_LOADB(bA, 2 * k2 + 2);
        __builtin_amdgcn_sched_barrier(0);
        F1_STEP(bB, 2 * k2 + 1);
        __builtin_amdgcn_sched_barrier(0);
    }
#undef F1_LOADB
#undef F1_STEP
    const float* TW = (const float*)(ws + WS_TW);
#pragma unroll
    for (int kb = 0; kb < 4; ++kb) {
        const int k1 = 32 * kb + r32;
        const float ct = TW[2 * (n2 * k1)], st = TW[2 * (n2 * k1) + 1];
        bf16_t* yp = YF + ((size_t)((b * 128 + k1) * 64 + n2)) * 512 + 32 * cblk + 4 * hi;
#pragma unroll
        for (int g4 = 0; g4 < 4; ++g4) {
            float yr[4], yi[4];
#pragma unroll
            for (int e = 0; e < 4; ++e) { const float r_ = aR[kb][4 * g4 + e], i_ = aI[kb][4 * g4 + e]; yr[e] = r_ * ct + i_ * st; yi[e] = i_ * ct - r_ * st; }
            u32x2 wr_, wi_; wr_.x = pkbf(yr[0], yr[1]); wr_.y = pkbf(yr[2], yr[3]); wi_.x = pkbf(yi[0], yi[1]); wi_.y = pkbf(yi[2], yi[3]);
            *(u32x2*)(yp + 8 * g4) = wr_; *(u32x2*)(yp + 256 + 8 * g4) = wi_;
        }
    }
    asm volatile("s_waitcnt lgkmcnt(0)" ::: "memory");
}
__device__ __forceinline__ void fft3_wave(int task, const bf16_t* YF, const bf16_t* Gt, const bf16_t* P, bf16_t* H, const unsigned char* ws, unsigned char* lds_w, int lane) {
    const int r32 = lane & 31, hi = lane >> 5;
    const int g = task & 3, k1 = (task >> 2) & 127, b = task >> 9;
    const bf16_t* src = YF + ((size_t)(b * 128 + k1) * 64) * 512 + 64 * g + 8 * (lane & 7);
#pragma unroll
    for (int i = 0; i < 16; ++i) { const int kk = 8 * i + (lane >> 3), ch = lane & 7;
        *(u32x4*)(lds_w + kk * 128 + ((ch ^ (((kk >> 1) & 1) << 2)) * 16)) = *(const u32x4*)(src + (size_t)(kk & 63) * 512 + (size_t)(kk >> 6) * 256); }
    asm volatile("s_waitcnt vmcnt(0) lgkmcnt(0)" ::: "memory");
    const bf16_t* T3R = (const bf16_t*)(ws + WS_T3R); const bf16_t* T3I = (const bf16_t*)(ws + WS_T3I);
    const int q = (lane & 15) >> 2, sw = (q >> 1) & 1;
    const int chl = 2 * ((lane >> 4) & 1) + ((lane & 3) >> 1);
    const unsigned char* zb = lds_w + (8 * hi + q) * 128 + 8 * (lane & 1);
    const unsigned char* zp0 = zb + ((chl ^ (sw << 2)) * 16);
    const unsigned char* zp1 = zb + (((4 + chl) ^ (sw << 2)) * 16);
    const bf16_t* gp = Gt + (size_t)(g * 64 + r32) * 128 + 8 * hi;
    const size_t rowb = (size_t)(b * SEQ + k1);
#pragma unroll 1
    for (int kblk = 0; kblk < 2; ++kblk) {
        f32x16 XR[2], XI[2];
#pragma unroll
        for (int cb = 0; cb < 2; ++cb) { XR[cb] = f32x16{}; XI[cb] = f32x16{}; }
        const bf16_t* trp = T3R + (size_t)(32 * kblk + r32) * 128 + 8 * hi; const bf16_t* tip = T3I + (size_t)(32 * kblk + r32) * 128 + 8 * hi;
        bf16x8 bR[8], bI[8];
#pragma unroll
        for (int ks = 0; ks < 8; ++ks) { bR[ks] = *(const bf16x8*)(trp + 16 * ks); bI[ks] = *(const bf16x8*)(tip + 16 * ks); }
        __builtin_amdgcn_sched_barrier(0);
#pragma unroll
        for (int ks = 0; ks < 8; ++ks) {
            const bf16x8 a0 = cat8(trrd(zp0 + (16 * ks) * 128), trrd(zp0 + (16 * ks + 4) * 128));
            const bf16x8 a1 = cat8(trrd(zp1 + (16 * ks) * 128), trrd(zp1 + (16 * ks + 4) * 128));
            XR[0] = MFMA32(a0, bR[ks], XR[0]); XI[0] = MFMA32(a0, bI[ks], XI[0]); XR[1] = MFMA32(a1, bR[ks], XR[1]); XI[1] = MFMA32(a1, bI[ks], XI[1]);
        }
        __builtin_amdgcn_sched_barrier(0);
        bf16x8 gfr[2][8];
#pragma unroll
        for (int lb = 0; lb < 2; ++lb)
#pragma unroll
            for (int q8 = 0; q8 < 8; ++q8) gfr[lb][q8] = *(const bf16x8*)(gp + (size_t)(32 * lb) * 128 + 16 * q8);
        __builtin_amdgcn_sched_barrier(0);
        f32x16 oa[2]; oa[0] = f32x16{}; oa[1] = f32x16{};
#pragma unroll
        for (int part = 0; part < 2; ++part)
#pragma unroll
            for (int cb = 0; cb < 2; ++cb)
#pragma unroll
                for (int s = 0; s < 2; ++s) {
                    const bf16x8 bx = pack8(part ? XI[cb] : XR[cb], 8 * s);
                    const int kko = part * 64 + 32 * cb + 16 * s;
#pragma unroll
                    for (int lb = 0; lb < 2; ++lb) oa[lb] = MFMA32(gfr[lb][kko >> 4], bx, oa[lb]);
                }
        const int k2 = 32 * kblk + r32;
        const size_t row = rowb + (size_t)k2 * 128;
        const bf16_t* gfrow = P + row * PW + C_GF + 64 * g;
        bf16_t* hrow = H + row * DM + 512 + 64 * g;
#pragma unroll
        for (int lb = 0; lb < 2; ++lb)
#pragma unroll
            for (int g4 = 0; g4 < 4; ++g4) {
                const int l0 = 32 * lb + 8 * g4 + 4 * hi;
                const u32x2 gw = *(const u32x2*)(gfrow + l0);
                const float o0 = oa[lb][4 * g4 + 0] * silu_f(bf2f(gw.x & 0xffffu)), o1 = oa[lb][4 * g4 + 1] * silu_f(bf2f(gw.x >> 16));
                const float o2 = oa[lb][4 * g4 + 2] * silu_f(bf2f(gw.y & 0xffffu)), o3 = oa[lb][4 * g4 + 3] * silu_f(bf2f(gw.y >> 16));
                u32x2 w; w.x = pkbf(o0, o1); w.y = pkbf(o2, o3);
                *(u32x2*)(hrow + l0) = w;
            }
    }
    asm volatile("s_waitcnt lgkmcnt(0)" ::: "memory");
}
__device__ __forceinline__ void conv_wave(int task, const bf16_t* P, bf16_t* H, const float* cw, const float* cb, int lane) {
    const int cgp = lane & 31, ch0 = cgp * 8;
    const int r0 = task * 8 + (lane >> 5) * 4;
    int pos, len; if (r0 < NTOK) { pos = r0 & (SEQ - 1); len = SEQ; } else { pos = (r0 - NTOK) & (CTXL - 1); len = CTXL; }
    u32x4 zz[6], cc[6], bb[4], gg[4];
#pragma unroll
    for (int i = 0; i < 6; ++i) { const int p = pos - 1 + i; const bool ok = p >= 0 && p < len; const size_t row = (size_t)(ok ? r0 - 1 + i : r0);
        zz[i] = *(const u32x4*)(P + row * PW + C_ZC + ch0); cc[i] = *(const u32x4*)(P + row * PW + C_CC + ch0);
        if (!ok) { zz[i] = (u32x4){0u, 0u, 0u, 0u}; } }
#pragma unroll
    for (int i = 0; i < 4; ++i) { const size_t row = (size_t)(r0 + i); bb[i] = *(const u32x4*)(P + row * PW + C_BC + ch0); gg[i] = *(const u32x4*)(P + row * PW + C_GC + ch0); }
    float w0[8], w1[8], w2[8], bs[8];
    { const f32x4 a0 = *(const f32x4*)(cw + ch0), a1 = *(const f32x4*)(cw + ch0 + 4), b0 = *(const f32x4*)(cw + 256 + ch0), b1 = *(const f32x4*)(cw + 256 + ch0 + 4);
      const f32x4 c0 = *(const f32x4*)(cw + 512 + ch0), c1 = *(const f32x4*)(cw + 512 + ch0 + 4), d0 = *(const f32x4*)(cb + ch0), d1 = *(const f32x4*)(cb + ch0 + 4);
#pragma unroll
      for (int e = 0; e < 4; ++e) { w0[e] = a0[e]; w0[4 + e] = a1[e]; w1[e] = b0[e]; w1[4 + e] = b1[e]; w2[e] = c0[e]; w2[4 + e] = c1[e]; bs[e] = d0[e]; bs[4 + e] = d1[e]; } }
    float T[6][8];
#pragma unroll
    for (int i = 0; i < 6; ++i) {
        const unsigned zv[4] = {zz[i].x, zz[i].y, zz[i].z, zz[i].w}, cv[4] = {cc[i].x, cc[i].y, cc[i].z, cc[i].w};
#pragma unroll
        for (int e = 0; e < 8; ++e) T[i][e] = ((e & 1) ? bf2f(zv[e >> 1] >> 16) : bf2f(zv[e >> 1] & 0xffffu)) * ((e & 1) ? bf2f(cv[e >> 1] >> 16) : bf2f(cv[e >> 1] & 0xffffu));
    }
#pragma unroll
    for (int i = 0; i < 4; ++i) {
        const size_t row = (size_t)(r0 + i);
        const unsigned bwv[4] = {bb[i].x, bb[i].y, bb[i].z, bb[i].w}, gwv[4] = {gg[i].x, gg[i].y, gg[i].z, gg[i].w};
        float o[8];
#pragma unroll
        for (int e = 0; e < 8; ++e) {
            const float bv = (e & 1) ? bf2f(bwv[e >> 1] >> 16) : bf2f(bwv[e >> 1] & 0xffffu);
            const float gv = (e & 1) ? bf2f(gwv[e >> 1] >> 16) : bf2f(gwv[e >> 1] & 0xffffu);
            const float y = T[i][e] * w0[e] + T[i + 1][e] * w1[e] + T[i + 2][e] * w2[e] + bs[e];
            o[e] = bv * y * silu_f(gv);
        }
        u32x4 w; w.x = pkbf(o[0], o[1]); w.y = pkbf(o[2], o[3]); w.z = pkbf(o[4], o[5]); w.w = pkbf(o[6], o[7]);
        *(u32x4*)(H + row * DM + 768 + ch0) = w;
    }
}

#define XB_TMO      128
#define XB_XCNT(j)  (256  + 64 * (j))
#define XB_XSUB(j)  (1280 + 64 * (j))
#define XB_XGEN(j)  (2304 + 64 * (j))
#define XB_TOP      3328
#define XB_TOPGEN   3392
#define XCD_BAR_WORDS 3456
#define XB_SPIN_CAP (1u << 18)

__device__ __forceinline__ unsigned xb_ld(unsigned* p)              { return __hip_atomic_load(p, __ATOMIC_RELAXED, __HIP_MEMORY_SCOPE_AGENT); }
__device__ __forceinline__ unsigned xb_add(unsigned* p, unsigned v) { return __hip_atomic_fetch_add(p, v, __ATOMIC_RELAXED, __HIP_MEMORY_SCOPE_AGENT); }
__device__ __forceinline__ unsigned xb_xcc_id() { return (unsigned)__builtin_amdgcn_s_getreg((3 << 11) | 20) & 0xFu; }
#define XB_SPIN(cond, bar) do { unsigned _sp = 0; while (cond) { __builtin_amdgcn_s_sleep(1); \
    if ((++_sp & 255u) == 0u) { if (xb_ld(&(bar)[XB_TMO])) break; if (_sp > XB_SPIN_CAP) { atomicAdd(&(bar)[XB_TMO], 1u); break; } } } } while (0)

struct XcdBarrier {
    unsigned* bar; unsigned x;
    volatile LAS unsigned* st;
};

__device__ __forceinline__ XcdBarrier xcd_barrier_post(unsigned* bar, volatile LAS unsigned* st) {
    XcdBarrier b; b.bar = bar; b.x = xb_xcc_id(); b.st = st;
    if (threadIdx.x == 0) (void)xb_add(&bar[XB_XCNT(b.x)], 1u);
    return b;
}
__device__ __forceinline__ void xcd_barrier_complete(unsigned* bar, unsigned x, unsigned& nloc, unsigned& nx) {
    const unsigned G = gridDim.x * gridDim.y * gridDim.z;
    unsigned sum, cnt, mine, sp = 0u;
    for (;;) {
        sum = 0u; cnt = 0u; mine = 0u;
#pragma unroll
        for (unsigned j = 0; j < 16; ++j) { const unsigned c = xb_ld(&bar[XB_XCNT(j)]); sum += c; cnt += (c > 0u) ? 1u : 0u; mine = (j == x) ? c : mine; }
        if (sum == G) break;
        __builtin_amdgcn_s_sleep(1);
        if ((++sp & 255u) == 0u) { if (xb_ld(&bar[XB_TMO])) break; if (sp > XB_SPIN_CAP) { atomicAdd(&bar[XB_TMO], 1u); break; } }
    }
    nloc = mine > 0u ? mine : 1u; nx = cnt > 0u ? cnt : 1u;
}

__device__ __forceinline__ void xcd_barrier(const XcdBarrier& b) {
    asm volatile("s_waitcnt vmcnt(0)" ::: "memory");
    __syncthreads();
    if (threadIdx.x == 0) {
        unsigned* bar = b.bar;
        __builtin_amdgcn_s_waitcnt(0);
        unsigned nloc = b.st[0], nx = b.st[1];
        if (nloc == 0u) { xcd_barrier_complete(bar, b.x, nloc, nx); b.st[0] = nloc; b.st[1] = nx; }
        const unsigned old = xb_add(&bar[XB_XSUB(b.x)], 1u);
        const unsigned gen = old / nloc;
        if (old + 1u == (gen + 1u) * nloc) {
            __builtin_amdgcn_fence(__ATOMIC_RELEASE, "agent");
            asm volatile("s_waitcnt vmcnt(0)" ::: "memory");
            const unsigned og = xb_add(&bar[XB_TOP], 1u);
            const unsigned tg = og / nx;
            if (og + 1u == (tg + 1u) * nx) xb_add(&bar[XB_TOPGEN], 1u);
            else XB_SPIN(xb_ld(&bar[XB_TOPGEN]) == tg, bar);
            __builtin_amdgcn_fence(__ATOMIC_ACQUIRE, "agent");
            xb_add(&bar[XB_XGEN(b.x)], 1u);
            asm volatile("s_waitcnt vmcnt(0)" ::: "memory");
        } else {
            XB_SPIN(xb_ld(&bar[XB_XGEN(b.x)]) == gen, bar);
            __builtin_amdgcn_fence(__ATOMIC_ACQUIRE, "agent");
            asm volatile("s_waitcnt vmcnt(0)" ::: "memory");
        }
    }
    __syncthreads();
}

__device__ __forceinline__ int next_unit(unsigned* ctr, unsigned char* lds) {
    volatile int* sw = (volatile int*)(lds + LDS_SCHED);
    if (threadIdx.x == 0) *sw = (int)atomicAdd(ctr, 1u);
    __syncthreads();
    const int u = *sw;
    __syncthreads();
    return u;
}

__global__ void __launch_bounds__(NTHREADS, 2) hybrid_fwd(KArgs a) {
    extern __shared__ __attribute__((aligned(16))) unsigned char lds[];
    cg::grid_group grid = cg::this_grid();
    unsigned char* ws = a.ws;
    const int lo = a.ph_lo, hi = a.ph_hi;
#ifndef PHMASK
#define PHMASK 0xfff
#endif
#define IN(k) (((PHMASK >> ((k) > 5 && (k) < 11 ? (k) - 5 : (k))) & 1) && lo <= (k) && (k) < hi)
#define SEAM(k) do { if (IN(k) && IN((k) + 1)) xcd_barrier(xbar); } while (0)
#ifndef REP_PHASE
#define REP_PHASE -1
#endif
#define REPS(j) for (int rep = 0, nrep = (REP_PHASE == (j)) ? 2 : 1; rep < nrep; ++rep, (rep < nrep ? xcd_barrier(xbar) : (void)0))
    bf16_t* HX = (bf16_t*)(ws + WS_HX); bf16_t* Pb = (bf16_t*)(ws + WS_P); bf16_t* Vt = (bf16_t*)(ws + WS_VT); bf16_t* Hb = (bf16_t*)(ws + WS_H);
    bf16_t* Yb = (bf16_t*)(ws + WS_Y); bf16_t* YF = (bf16_t*)(ws + WS_YF); float* SSQ = (float*)(ws + WS_SSQ);
    unsigned* ctl = (unsigned*)(ws + WS_CTL);

    if (threadIdx.x < 2) ((volatile LAS unsigned*)(lds + LDS_BARST))[threadIdx.x] = 0u;
    __syncthreads();
    const XcdBarrier xbar = xcd_barrier_post((unsigned*)(ws + WS_BAR), (volatile LAS unsigned*)(lds + LDS_BARST));
    if (a.ph_lo < 0) grid.sync();
    REPS(30) if (IN(0)) p0_prologue(a, lds);
    SEAM(0);
    for (int l = 0; l < 2; ++l) {
        const int pb = 1 + 5 * l;
        REPS(0) if (IN(pb)) norm_phase(a, l);
        SEAM(pb);
        REPS(1) if (IN(pb + 1)) {
            pg8::Gemm g{HX, (const bf16_t*)(ws + WS_WIN) + (size_t)l * PW * DM, MROWS, PW, DM};
            pg8::StaticOrder S; S.init(MROWS, PW, (int)gridDim.x, (int)blockIdx.x);
            pg8::EpiProj E{Pb, Vt, (const float*)(ws + WS_ROPE), 0.125f * LOG2E};
            pg8::gemm_phase<pg8::EpiProj, pg8::StaticOrder, true, true>((PG8_LAS unsigned char*)lds, g, S, E);
        }
        SEAM(pb + 1);
        for (int rep = 0, nrep = (REP_PHASE >= 20 && REP_PHASE < 30) ? 2 : 1; rep < nrep; ++rep, (rep < nrep ? xcd_barrier(xbar) : (void)0)) if (IN(pb + 2)) {
            const int nAttn = (l == 0) ? 1056 : 1024, nCtxF = (l == 0) ? 16 : 0, nF1 = 256, nConv = ((l == 0) ? MROWS : NTOK) / 64;
            const int e0 = nF1, e1 = e0 + nCtxF, e2 = e1 + nAttn, e3 = e2 + nConv;
            for (;;) {
                const int u = next_unit(ctl + 2 * l + 8 * rep, lds);
                if (u >= e3) break;
                if (rep == 1) { const int ty = u < e0 ? 1 : u < e1 ? 3 : u < e2 ? 0 : 2; if (REP_PHASE == 25 ? (ty == 0) : (ty != REP_PHASE - 20)) continue; }
                if (u >= e1 && u < e2) attn_unit(u - e1, Pb, Vt, Hb, a.sink + 8 * l, lds);
                else if (u >= e0 && u < e1) { const int v = u - e0, b = v >> 2, kb = v & 3;
                    dftf_unit<256>(Pb + (size_t)(NTOK + b * CTXL) * PW + C_UF, 256, PW, 0, (const bf16_t*)(ws + WS_T256R) + (size_t)(64 * kb) * 256, (const bf16_t*)(ws + WS_T256I) + (size_t)(64 * kb) * 256,
                                   (const bf16_t*)(ws + WS_GT) + (size_t)l * 4 * 64 * 128, Pb, Hb, (size_t)(NTOK + b * CTXL + 64 * kb), 1, 5.656854249492381f, lds); }
                else {
                    const int tid = opaque_tid(), lane = tid & 63, wave = __builtin_amdgcn_readfirstlane(tid >> 6);
                    if (u < e0) fft1_wave(u * 8 + wave, Pb, YF, ws, lds + wave * 16384, lane);
                    else conv_wave((u - e2) * 8 + wave, Pb, Hb, a.conv_w + l * 768, a.conv_b + l * 256, lane);
                }
            }
        }
        SEAM(pb + 2);
        REPS(3) if (IN(pb + 3)) {
            const bool gemmwg = (l == 0 && blockIdx.x < 16);
            if (gemmwg) {
                pg8::Gemm g{Hb + (size_t)NTOK * DM, (const bf16_t*)(ws + WS_WOUT) + (size_t)l * DM * DM, NCTX, DM, DM};
                pg8::StaticOrder S; S.init(NCTX, DM, 16, (int)blockIdx.x);
                pg8::EpiY E{Yb + (size_t)NTOK * DM, SSQ + (size_t)NTOK * 16};
                pg8::gemm_phase<pg8::EpiY, pg8::StaticOrder, true, true>((PG8_LAS unsigned char*)lds, g, S, E);
            } else {
                const int tid = opaque_tid(), lane = tid & 63, wave = __builtin_amdgcn_readfirstlane(tid >> 6);
                const int nb0 = (l == 0) ? 16 : 0;
                const int gw = ((int)blockIdx.x - nb0) + wave * ((int)gridDim.x - nb0), NGW = ((int)gridDim.x - nb0) * 8;
                unsigned char* lds_w = lds + wave * 16384;
                for (int t = gw; t < 2048; t += NGW) fft3_wave(t, YF, (const bf16_t*)(ws + WS_GT) + (size_t)l * 4 * 64 * 128, Pb, Hb, ws, lds_w, lane);
            }
            __syncthreads();
        }
        SEAM(pb + 3);
        REPS(4) if (IN(pb + 4)) {
            pg8::Gemm g{Hb, (const bf16_t*)(ws + WS_WOUT) + (size_t)l * DM * DM, NTOK, DM, DM};
            pg8::StaticOrder S; S.init(NTOK, DM, (int)gridDim.x, (int)blockIdx.x);
            pg8::EpiY E{Yb, SSQ};
            pg8::gemm_phase<pg8::EpiY, pg8::StaticOrder, true, true>((PG8_LAS unsigned char*)lds, g, S, E);
        }
        SEAM(pb + 4);
    }
#if REP_PHASE == 9
    for (int i = 0; i < 10; ++i) xcd_barrier(xbar);
#endif
    if (IN(11)) norm_phase(a, 2);
#undef IN
#undef SEAM
}

#ifndef MK_MULTI
#define MK_MULTI 0
#endif
extern "C" void kernel_launch(void* const* d_in, const int* in_sizes, int n_in, void* d_out, int out_size, void* d_ws, size_t ws_size, hipStream_t stream) {
    static int grid = 0;
    if (grid == 0) {
        if (n_in != 14 || ws_size < WS_END) { fprintf(stderr, "kernel_launch: unexpected n_in %d or ws_size %zu (need %zu)\n", n_in, ws_size, (size_t)WS_END); grid = -1; return; }
        int dev = 0, cus = 0, per_cu = 0;
        hipGetDevice(&dev); hipDeviceGetAttribute(&cus, hipDeviceAttributeMultiprocessorCount, dev);
        if (hipFuncSetAttribute((const void*)hybrid_fwd, hipFuncAttributeMaxDynamicSharedMemorySize, LDS_BYTES) != hipSuccess) { fprintf(stderr, "kernel_launch: hipFuncSetAttribute failed\n"); grid = -1; return; }
        if (hipOccupancyMaxActiveBlocksPerMultiprocessor(&per_cu, (const void*)hybrid_fwd, NTHREADS, LDS_BYTES) != hipSuccess || per_cu < 1) { fprintf(stderr, "kernel_launch: occupancy query gave %d\n", per_cu); per_cu = 1; }
        (void)hipGetLastError();
        grid = cus * 1;
        fprintf(stderr, "kernel_launch: grid %d (cus %d, per_cu %d)\n", grid, cus, per_cu);
    }
    if (grid < 0) return;
    if (hipMemsetAsync((char*)d_ws + WS_CTL, 0, WS_ZERO_BYTES, stream) != hipSuccess) { fprintf(stderr, "kernel_launch: hipMemsetAsync failed\n"); return; }
    KArgs a{};
    a.x = (const float*)d_in[0]; a.c = (const float*)d_in[1]; a.ctx = (const float*)d_in[2]; a.c_ctx = (const float*)d_in[3]; a.w_mod = (const float*)d_in[4]; a.b_mod = (const float*)d_in[5];
    a.g_pre = (const float*)d_in[6]; a.g_post = (const float*)d_in[7]; a.w_in = (const float*)d_in[8]; a.w_out = (const float*)d_in[9]; a.sink = (const float*)d_in[10]; a.w_f = (const float*)d_in[11];
    a.conv_w = (const float*)d_in[12]; a.conv_b = (const float*)d_in[13];
    a.out = (float*)d_out; a.ws = (unsigned char*)d_ws;
#if MK_MULTI
    for (int ph = 0; ph < 12; ++ph) { a.ph_lo = ph; a.ph_hi = ph + 1; hipLaunchKernelGGL(hybrid_fwd, dim3(grid), dim3(NTHREADS), LDS_BYTES, stream, a); }
#else
    a.ph_lo = 0; a.ph_hi = 12;
    void* args[] = {&a};
    hipError_t e = hipLaunchCooperativeKernel((const void*)hybrid_fwd, dim3(grid), dim3(NTHREADS), args, LDS_BYTES, stream);
    if (e != hipSuccess) fprintf(stderr, "kernel_launch: cooperative launch failed: %s (grid %d)\n", hipGetErrorString(e), grid);
#endif
}
```

```cpp
#include <hip/hip_runtime.h>
#include <hip/hip_cooperative_groups.h>
#include <cstdio>
#include <cstdint>
namespace cg = cooperative_groups;
namespace pg8 {
#define PG8_LAS __attribute__((address_space(3)))
typedef unsigned short bf16_t;
typedef short bf16x8 __attribute__((ext_vector_type(8)));
typedef float f32x4 __attribute__((ext_vector_type(4)));
typedef unsigned u32x4 __attribute__((ext_vector_type(4)));
constexpr int BM = 256, BK = 64, HALF = 128, HTB = HALF * BK * 2  , STAGE_BYTES = 8 * HTB, NXCD = 8, WGM = 8;

__host__ __device__ __forceinline__ int lds_byte(int r, int c) { const int st = (r >> 4) * 2 + (c >> 5), rr = r & 15, cc = c & 31, ob = rr * 64 + cc * 2; return st * 1024 + (ob ^ (((ob >> 9) & 1) << 5)); }
__host__ __device__ __forceinline__ void stage_rc(int b, int& R, int& C) { const int st = b / 1024, sb = b % 1024, swz = sb ^ (((sb >> 9) & 1) << 5); R = (st >> 1) * 16 + swz / 64; C = (st & 1) * 32 + (swz % 64) / 2; }
__host__ __device__ __forceinline__ int perm32(int rho) { const int n = rho >> 4, i = rho & 15; return 8 * (i >> 2) + 4 * n + (i & 3); }

struct Unit { int pm, pn; };
struct Gemm { const bf16_t* A; const bf16_t* Bt; int M, N, K; };

struct StaticOrder {
    int nM, nN, nwg, G, c;
    __host__ __device__ void init(int M, int N, int G_, int c_) { nM = M / BM; nN = N / BM; nwg = nM * nN; G = G_; c = c_; }
    __host__ __device__ bool next(int i, Unit& u) const {
        const long L = (long)i * G + c; if (L >= nwg) return false;
        int wgid = (int)L; { const int q = nwg / NXCD, r = nwg % NXCD, xcd = wgid % NXCD, off = wgid / NXCD; wgid = (xcd < r ? xcd * (q + 1) : r * (q + 1) + (xcd - r) * q) + off; }
        const int nig = WGM * nN, gid = wgid / nig, fm = gid * WGM, gsz = (nM - fm) < WGM ? (nM - fm) : WGM;
        u.pm = fm + ((wgid % nig) % gsz); u.pn = (wgid % nig) / gsz; return true;
    }
    __device__ __forceinline__ void a_ready(const Unit&) const {}
    __device__ __forceinline__ void done(const Unit&) const {}
};

__device__ __forceinline__ unsigned cvt_pk_bf16(float lo, float hi) { unsigned r; asm volatile("v_cvt_pk_bf16_f32 %0, %1, %2" : "=v"(r) : "v"(lo), "v"(hi)); return r; }
typedef unsigned u32x2 __attribute__((ext_vector_type(2)));
__device__ __forceinline__ int swap23(int t) { return (t & ~12) | ((t & 4) << 1) | ((t & 8) >> 1); }
struct EpiProj {
    static constexpr bool PERM = true, AFTER_DRAIN = false;
    bf16_t* P; bf16_t* Vt; const float* rope; bf16_t* UFP; float qscale;
    __device__ __forceinline__ void operator()(const f32x4 (&acc)[2][2][4][2], const Unit& u, int wr, int wc, int fr, int fq) const {
        const int row0 = u.pm * BM + wr * 64 + fr;
        const int pn = u.pn;
        const bool ctxrow = u.pm >= 128;
#pragma unroll
        for (int ai = 0; ai < 2; ++ai)
#pragma unroll
            for (int m = 0; m < 4; ++m) {
                const int row = row0 + ai * HALF + m * 16;
                bf16_t* rowp = P + (size_t)row * 2816 + pn * BM + wc * 32 + 8 * fq;
                if (pn == 5 && !ctxrow) { const int t = row & 8191; rowp = UFP + ((size_t)(((row >> 13) * 64 + (t & 63)) * 128 + (t >> 6))) * 256 + wc * 32 + 8 * fq; }
                if (pn > 2) {
#pragma unroll
                    for (int bj = 0; bj < 2; ++bj) { const f32x4 v0 = acc[ai][bj][m][0], v1 = acc[ai][bj][m][1];
                        u32x4 w; w.x = cvt_pk_bf16(v0[0], v0[1]); w.y = cvt_pk_bf16(v0[2], v0[3]); w.z = cvt_pk_bf16(v1[0], v1[1]); w.w = cvt_pk_bf16(v1[2], v1[3]);
                        *(u32x4*)(rowp + bj * HALF) = w; }
                } else {
                    f32x4 cs = (f32x4){1.f, 1.f, 1.f, 1.f}, sn = (f32x4){0.f, 0.f, 0.f, 0.f};
                    if (!ctxrow) { const int t = row & 8191; const int pos = (wc & 1) ? (t & 63) : (t >> 6);
                        cs = *(const f32x4*)(rope + pos * 32 + 4 * fq); sn = *(const f32x4*)(rope + pos * 32 + 16 + 4 * fq); }
#pragma unroll
                    for (int bj = 0; bj < 2; ++bj) {
                        f32x4 v0 = acc[ai][bj][m][0], v1 = acc[ai][bj][m][1];
                        if (pn == 2 && bj == 1) {
                            int b, tok; if (ctxrow) { const int rr = row - 32768; b = rr >> 8; tok = 8192 + (rr & 255); } else { b = row >> 13; tok = row & 8191; }
                            const int ptok = swap23(tok);
                            bf16_t* vp = Vt + ((size_t)((b * 2 + (wc >> 1)) * 64 + 32 * (wc & 1) + 8 * fq)) * 8448 + ptok;
                            const unsigned w0 = cvt_pk_bf16(v0[0], v0[1]), w1 = cvt_pk_bf16(v0[2], v0[3]), w2 = cvt_pk_bf16(v1[0], v1[1]), w3 = cvt_pk_bf16(v1[2], v1[3]);
                            vp[0 * 8448] = (bf16_t)(w0 & 0xffffu); vp[1 * 8448] = (bf16_t)(w0 >> 16); vp[2 * 8448] = (bf16_t)(w1 & 0xffffu); vp[3 * 8448] = (bf16_t)(w1 >> 16);
                            vp[4 * 8448] = (bf16_t)(w2 & 0xffffu); vp[5 * 8448] = (bf16_t)(w2 >> 16); vp[6 * 8448] = (bf16_t)(w3 & 0xffffu); vp[7 * 8448] = (bf16_t)(w3 >> 16);
                        } else {
                            const f32x4 r0 = v0 * cs - v1 * sn, r1 = v0 * sn + v1 * cs;
                            v0 = r0; v1 = r1;
                            if (pn < 2) { v0 = v0 * qscale; v1 = v1 * qscale; }
                            u32x4 w; w.x = cvt_pk_bf16(v0[0], v0[1]); w.y = cvt_pk_bf16(v0[2], v0[3]); w.z = cvt_pk_bf16(v1[0], v1[1]); w.w = cvt_pk_bf16(v1[2], v1[3]);
                            *(u32x4*)(rowp + bj * HALF) = w;
                        }
                    }
                }
            }
    }
};
struct EpiY {
    static constexpr bool PERM = true, AFTER_DRAIN = false;
    bf16_t* Y; float* ssq;
    __device__ __forceinline__ void operator()(const f32x4 (&acc)[2][2][4][2], const Unit& u, int wr, int wc, int fr, int fq) const {
        const int row0 = u.pm * BM + wr * 64 + fr;
#pragma unroll
        for (int ai = 0; ai < 2; ++ai)
#pragma unroll
            for (int m = 0; m < 4; ++m) {
                const int row = row0 + ai * HALF + m * 16;
                bf16_t* rowp = Y + (size_t)row * 1024 + u.pn * BM + wc * 32 + 8 * fq;
                float s = 0.f;
#pragma unroll
                for (int bj = 0; bj < 2; ++bj) { const f32x4 v0 = acc[ai][bj][m][0], v1 = acc[ai][bj][m][1];
                    s += (v0[0] * v0[0] + v0[1] * v0[1]) + (v0[2] * v0[2] + v0[3] * v0[3]) + (v1[0] * v1[0] + v1[1] * v1[1]) + (v1[2] * v1[2] + v1[3] * v1[3]);
                    u32x4 w; w.x = cvt_pk_bf16(v0[0], v0[1]); w.y = cvt_pk_bf16(v0[2], v0[3]); w.z = cvt_pk_bf16(v1[0], v1[1]); w.w = cvt_pk_bf16(v1[2], v1[3]);
                    *(u32x4*)(rowp + bj * HALF) = w; }
                s += __shfl_xor(s, 16); s += __shfl_xor(s, 32);
                if (fq == 0) ssq[(size_t)row * 16 + u.pn * 4 + wc] = s;
            }
    }
};
template <class Epi, class Sched, bool ALIGN_EPI = false, bool SP2 = false>
__device__ __forceinline__ void gemm_phase(PG8_LAS unsigned char* lds, const Gemm g, const Sched& S, const Epi& E) {
    int tid_ = threadIdx.x; asm volatile("" : "+v"(tid_));
    const int tid = tid_, wid = __builtin_amdgcn_readfirstlane(tid >> 6), lane = tid & 63, wr = wid >> 2, wc = wid & 3, fr = lane & 15, fq = lane >> 4;
    const int K = g.K, nt = K / BK;
    unsigned voffA[2], voffB[2];
#pragma unroll
    for (int i = 0; i < 2; ++i) { int R, C; stage_rc(tid * 16 + i * 8192, R, C); const int Rb = Epi::PERM ? ((R & ~31) + perm32(R & 31)) : R;
        voffA[i] = (unsigned)(R * K + C) * 2u; voffB[i] = (unsigned)(Rb * K + C) * 2u; }
    const size_t kstep = (size_t)(BK * 2);
    const size_t hstep = (size_t)HALF * K * 2;
    const size_t tstep = 2 * hstep;
    const unsigned ldsw = (unsigned)wid * 1024u;
    const int aoff = lds_byte(wr * 64 + fr, fq * 8), boff = lds_byte(wc * 32 + fr, fq * 8);
#define PG8_SA(b, h) (((b) * 2 + (h)) * HTB)
#define PG8_SB(b, h) ((4 + (b) * 2 + (h)) * HTB)
#define PG8_STAGE(bufoff, gbase, voff) do { _Pragma("unroll") for (int _i = 0; _i < 2; ++_i) \
        __builtin_amdgcn_global_load_lds((const unsigned*)((const char*)(gbase) + (voff)[_i]), (PG8_LAS unsigned*)(lds + (bufoff) + ldsw + _i * 8192), 16, 0, 0); } while (0)
#define PG8_LDA(dst, b, h) do { _Pragma("unroll") for (int m = 0; m < 4; ++m) _Pragma("unroll") for (int k = 0; k < 2; ++k) dst[m][k] = *(const PG8_LAS bf16x8*)(lds + PG8_SA(b, h) + aoff + m * 2048 + k * 1024); } while (0)
#define PG8_LDB(dst, b, h) do { _Pragma("unroll") for (int n = 0; n < 2; ++n) _Pragma("unroll") for (int k = 0; k < 2; ++k) dst[n][k] = *(const PG8_LAS bf16x8*)(lds + PG8_SB(b, h) + boff + n * 2048 + k * 1024); } while (0)
#define PG8_MMA(ai, bj, At, Bt) do { __builtin_amdgcn_s_setprio(1); _Pragma("unroll") for (int m = 0; m < 4; ++m) _Pragma("unroll") for (int n = 0; n < 2; ++n) _Pragma("unroll") for (int k = 0; k < 2; ++k) \
        acc[ai][bj][m][n] = __builtin_amdgcn_mfma_f32_16x16x32_bf16(Bt[n][k], At[m][k], acc[ai][bj][m][n], 0, 0, 0); __builtin_amdgcn_s_setprio(0); } while (0)
#define PG8_WAIT_V(n) asm volatile("s_waitcnt vmcnt(" #n ")" ::: "memory")
#define PG8_WAIT_L(n) asm volatile("s_waitcnt lgkmcnt(" #n ")" ::: "memory")
#define PG8_BAR __builtin_amdgcn_s_barrier()
#define PG8_SCHED __builtin_amdgcn_sched_barrier(0)
    Unit cur, nxt; int ui = 0;
    if (!S.next(0, cur)) return;
    f32x4 acc[2][2][4][2];
#pragma unroll
    for (int a = 0; a < 2; ++a)
#pragma unroll
        for (int b = 0; b < 2; ++b)
#pragma unroll
            for (int m = 0; m < 4; ++m)
#pragma unroll
                for (int n = 0; n < 2; ++n) acc[a][b][m][n] = (f32x4){0.f, 0.f, 0.f, 0.f};
    bf16x8 At[4][2], B0[2][2], B1[2][2];
    const char* cA = (const char*)g.A + (size_t)cur.pm * tstep; const char* cB = (const char*)g.Bt + (size_t)cur.pn * tstep;
    S.a_ready(cur);
    if constexpr (SP2) {
        PG8_STAGE(PG8_SB(0, 0), cB, voffB); PG8_STAGE(PG8_SB(0, 1), cB + hstep, voffB); PG8_STAGE(PG8_SA(0, 0), cA, voffA); PG8_STAGE(PG8_SA(0, 1), cA + hstep, voffA);
        if (wr == 1) PG8_BAR;
        PG8_WAIT_V(2); PG8_BAR;
        PG8_STAGE(PG8_SB(1, 0), cB + kstep, voffB); PG8_STAGE(PG8_SA(1, 0), cA + kstep, voffA); PG8_STAGE(PG8_SB(1, 1), cB + hstep + kstep, voffB);
        PG8_WAIT_V(6); PG8_BAR;
    } else {
        PG8_STAGE(PG8_SB(0, 0), cB, voffB); PG8_STAGE(PG8_SA(0, 0), cA, voffA); PG8_STAGE(PG8_SB(0, 1), cB + hstep, voffB); PG8_STAGE(PG8_SA(0, 1), cA + hstep, voffA);
        if (wr == 1) PG8_BAR;
        PG8_WAIT_V(4); PG8_BAR;
        PG8_STAGE(PG8_SB(1, 0), cB + kstep, voffB); PG8_STAGE(PG8_SA(1, 0), cA + kstep, voffA); PG8_STAGE(PG8_SB(1, 1), cB + hstep + kstep, voffB);
        PG8_WAIT_V(6); PG8_BAR;
    }
    for (;;) {
        const bool has_next = S.next(ui + 1, nxt);
        const char* nA = has_next ? (const char*)g.A + (size_t)nxt.pm * tstep : cA; const char* nB = has_next ? (const char*)g.Bt + (size_t)nxt.pn * tstep : cB;
        for (int t = 0; t < nt; t += 2) {
            const bool last = (t == nt - 2);
            const char* a1 = cA + (size_t)(t + 1) * kstep;
            const char* a2 = last ? nA : cA + (size_t)(t + 2) * kstep; const char* b2 = last ? nB : cB + (size_t)(t + 2) * kstep;
            const char* a3 = a2 + kstep; const char* b3 = b2 + kstep;
            if (last && has_next) S.a_ready(nxt);
            if constexpr (SP2) {
            PG8_LDB(B0, 0, 0); PG8_LDB(B1, 0, 1); PG8_SCHED; PG8_LDA(At, 0, 0); PG8_STAGE(PG8_SA(1, 1), a1 + hstep, voffA);
            PG8_WAIT_V(8); PG8_WAIT_L(0); PG8_BAR; PG8_MMA(0, 0, At, B0); PG8_MMA(0, 1, At, B1); PG8_BAR; PG8_SCHED;
            PG8_LDA(At, 0, 1); PG8_STAGE(PG8_SB(0, 0), b2, voffB); PG8_STAGE(PG8_SB(0, 1), b2 + hstep, voffB); PG8_STAGE(PG8_SA(0, 0), a2, voffA);
            PG8_WAIT_V(8); PG8_WAIT_L(0); PG8_BAR; PG8_MMA(1, 0, At, B0); PG8_MMA(1, 1, At, B1); PG8_BAR; PG8_SCHED;
            PG8_LDB(B0, 1, 0); PG8_LDB(B1, 1, 1); PG8_SCHED; PG8_LDA(At, 1, 0); PG8_STAGE(PG8_SA(0, 1), a2 + hstep, voffA);
            PG8_WAIT_V(8); PG8_WAIT_L(0); PG8_BAR; PG8_MMA(0, 0, At, B0); PG8_MMA(0, 1, At, B1); PG8_BAR; PG8_SCHED;
            PG8_LDA(At, 1, 1); PG8_STAGE(PG8_SB(1, 0), b3, voffB); PG8_STAGE(PG8_SB(1, 1), b3 + hstep, voffB); PG8_STAGE(PG8_SA(1, 0), a3, voffA);
            PG8_WAIT_V(8); PG8_WAIT_L(0); PG8_BAR; PG8_MMA(1, 0, At, B0); PG8_MMA(1, 1, At, B1); PG8_BAR; PG8_SCHED;
            } else {
            PG8_LDB(B0, 0, 0); PG8_SCHED; PG8_LDA(At, 0, 0); PG8_STAGE(PG8_SA(1, 1), a1 + hstep, voffA);
            PG8_WAIT_L(8); PG8_BAR; PG8_WAIT_L(0); PG8_MMA(0, 0, At, B0); PG8_BAR; PG8_SCHED;
            PG8_LDB(B1, 0, 1); PG8_STAGE(PG8_SB(0, 0), b2, voffB);
            PG8_BAR; PG8_WAIT_L(0); PG8_MMA(0, 1, At, B1); PG8_BAR;
            PG8_LDA(At, 0, 1); PG8_STAGE(PG8_SA(0, 0), a2, voffA);
            PG8_BAR; PG8_WAIT_L(0); PG8_MMA(1, 0, At, B0); PG8_BAR; PG8_SCHED;
            PG8_STAGE(PG8_SB(0, 1), b2 + hstep, voffB);
            PG8_WAIT_V(6); PG8_BAR; PG8_MMA(1, 1, At, B1); PG8_BAR;
            PG8_LDB(B0, 1, 0); PG8_SCHED; PG8_LDA(At, 1, 0); PG8_STAGE(PG8_SA(0, 1), a2 + hstep, voffA);
            PG8_WAIT_L(8); PG8_BAR; PG8_WAIT_L(0); PG8_MMA(0, 0, At, B0); PG8_BAR; PG8_SCHED;
            PG8_LDB(B1, 1, 1); PG8_STAGE(PG8_SB(1, 0), b3, voffB);
            PG8_BAR; PG8_WAIT_L(0); PG8_MMA(0, 1, At, B1); PG8_BAR;
            PG8_LDA(At, 1, 1); PG8_STAGE(PG8_SA(1, 0), a3, voffA);
            PG8_BAR; PG8_WAIT_L(0); PG8_MMA(1, 0, At, B0); PG8_BAR; PG8_SCHED;
            PG8_STAGE(PG8_SB(1, 1), b3 + hstep, voffB);
            PG8_WAIT_V(6); PG8_BAR; PG8_MMA(1, 1, At, B1); PG8_BAR;
            }
        }
        if constexpr (ALIGN_EPI) { if (wr == 0) PG8_BAR; }
        if constexpr (!Epi::AFTER_DRAIN) { E(acc, cur, wr, wc, fr, fq); S.done(cur); }
        if (!has_next) break;
#pragma unroll
        for (int a = 0; a < 2; ++a)
#pragma unroll
            for (int b = 0; b < 2; ++b)
#pragma unroll
                for (int m = 0; m < 4; ++m)
#pragma unroll
                    for (int n = 0; n < 2; ++n) acc[a][b][m][n] = (f32x4){0.f, 0.f, 0.f, 0.f};
        cur = nxt; cA = nA; cB = nB; ++ui;
        if constexpr (ALIGN_EPI) { if (wr == 1) PG8_BAR; }
    }
    PG8_WAIT_V(0);
    if constexpr (!ALIGN_EPI) { if (wr == 0) PG8_BAR; }
    PG8_BAR;
    if constexpr (Epi::AFTER_DRAIN) { E.fused(acc, cur, wr, wc, fr, fq, lds, wid, lane); S.done(cur); }
#undef PG8_SA
#undef PG8_SB
#undef PG8_STAGE
#undef PG8_LDA
#undef PG8_LDB
#undef PG8_MMA
#undef PG8_WAIT_V
#undef PG8_WAIT_L
#undef PG8_BAR
#undef PG8_SCHED
}
}

typedef unsigned short bf16_t;
typedef short bf16x8 __attribute__((ext_vector_type(8)));
typedef float f32x4 __attribute__((ext_vector_type(4)));
typedef float f32x16 __attribute__((ext_vector_type(16)));
typedef unsigned u32x4 __attribute__((ext_vector_type(4)));
typedef unsigned u32x2 __attribute__((ext_vector_type(2)));
#define LAS __attribute__((address_space(3)))
__device__ __forceinline__ int opaque_tid() { int t = threadIdx.x; asm volatile("" : "+v"(t)); return t; }

constexpr int DM = 1024, NBATCH = 4, SEQ = 8192, NTOK = NBATCH * SEQ, CTXL = 256, NCTX = NBATCH * CTXL, MROWS = NTOK + NCTX;
constexpr int PW = 2816;
constexpr int C_Q = 0, C_K = 512, C_V = 640, C_GA = 768, C_UF = 1280, C_GF = 1536, C_ZC = 1792, C_BC = 2048, C_CC = 2304, C_GC = 2560;
constexpr int VT_PITCH = SEQ + CTXL;
constexpr float NORM_EPS = 1e-6f;
constexpr float LOG2E = 1.4426950408889634f;

constexpr size_t KiB = 1024, MiB = 1u << 20;
constexpr size_t WS_CTL = 0;
constexpr size_t WS_BAR = 16 * KiB;
constexpr size_t WS_ZERO_BYTES = 32 * KiB;
constexpr size_t WS_MOD = 64 * KiB;
constexpr size_t WS_ROPE = 256 * KiB;
constexpr size_t WS_TW = 320 * KiB;
constexpr size_t WS_T1R = 384 * KiB, WS_T1I = 416 * KiB;
constexpr size_t WS_T3R = 448 * KiB, WS_T3I = 464 * KiB;
constexpr size_t WS_T256R = 512 * KiB, WS_T256I = 640 * KiB;
constexpr size_t WS_GT = 768 * KiB;
constexpr size_t WS_SSQ = 1 * MiB;
constexpr size_t WS_WIN = 4 * MiB;
constexpr size_t WS_WOUT = 16 * MiB;
constexpr size_t WS_MODP = 24 * MiB;
constexpr size_t WS_HX = 32 * MiB;
constexpr size_t WS_P = 112 * MiB;
constexpr size_t WS_VT = 304 * MiB;
constexpr size_t WS_H = 320 * MiB;
constexpr size_t WS_Y = 392 * MiB;
constexpr size_t WS_YF = 464 * MiB;
constexpr size_t WS_CTX1 = 100 * MiB;
constexpr size_t WS_UFP = 496 * MiB;
constexpr size_t WS_END = 512 * MiB;
static_assert(WS_BAR + 3456 * 4 <= WS_ZERO_BYTES && WS_MODP + (size_t)2 * 8 * 5 * 3072 * 4 <= WS_HX && WS_SSQ + (size_t)MROWS * 16 * 4 <= WS_WIN && WS_WIN + (size_t)2 * PW * DM * 2 <= WS_WOUT && WS_HX + (size_t)MROWS * DM * 2 <= WS_P && WS_P + (size_t)MROWS * PW * 2 <= WS_VT &&
              WS_VT + (size_t)8 * 64 * VT_PITCH * 2 <= WS_H && WS_H + (size_t)MROWS * DM * 2 <= WS_Y && WS_Y + (size_t)MROWS * DM * 2 <= WS_YF && WS_YF + (size_t)4 * 128 * 64 * 512 * 2 <= WS_UFP && WS_UFP + (size_t)NTOK * 256 * 2 <= WS_END && WS_HX + (size_t)MROWS * DM * 2 <= WS_CTX1 && WS_CTX1 + (size_t)NCTX * DM * 4 <= WS_P, "ws map");

constexpr int LDS_BYTES = 147456;
constexpr int LDS_SCHED = LDS_BYTES - 64;
constexpr int LDS_BARST = LDS_BYTES - 32;
constexpr int NTHREADS = 512;

__device__ __forceinline__ float bf2f(unsigned h) { return __uint_as_float(h << 16); }
__device__ __forceinline__ unsigned pkbf(float lo, float hi) { unsigned r; asm volatile("v_cvt_pk_bf16_f32 %0, %1, %2" : "=v"(r) : "v"(lo), "v"(hi)); return r; }
__device__ __forceinline__ float silu_f(float x) { return x * __builtin_amdgcn_rcpf(1.f + __builtin_amdgcn_exp2f(-x * LOG2E)); }
__device__ __forceinline__ float wave_sum(float v) {
#pragma unroll
    for (int o = 1; o < 64; o <<= 1) v += __shfl_xor(v, o);
    return v;
}
__device__ __forceinline__ int swap23(int t) { return (t & ~12) | ((t & 4) << 1) | ((t & 8) >> 1); }
__device__ __forceinline__ int crow(int r, int hi) { return (r & 3) + 8 * (r >> 2) + 4 * hi; }
__device__ __forceinline__ bf16x8 pack8(const f32x16& p, int base) {
    u32x4 w; w.x = pkbf(p[base + 0], p[base + 1]); w.y = pkbf(p[base + 2], p[base + 3]); w.z = pkbf(p[base + 4], p[base + 5]); w.w = pkbf(p[base + 6], p[base + 7]);
    return __builtin_bit_cast(bf16x8, w);
}
#define MFMA32(a, b, c) __builtin_amdgcn_mfma_f32_32x32x16_bf16((a), (b), (c), 0, 0, 0)

struct KArgs {
    const float *x, *c, *ctx, *c_ctx, *w_mod, *b_mod, *g_pre, *g_post, *w_in, *w_out, *sink, *w_f, *conv_w, *conv_b;
    float* out; unsigned char* ws; int ph_lo, ph_hi;
};

__device__ __forceinline__ int prow_qk(int n) { return (n & ~31) | (8 * ((n >> 2) & 3) + 4 * ((n >> 4) & 1) + (n & 3)); }
__device__ __forceinline__ void p0_transpose_item(const float* W, int K, int N, bf16_t* WT, int nperm, float* scr, int item, int lane) {
    const int nblk = N / 32, kb = item / nblk, nb = item % nblk, k0 = 64 * kb, n0 = 32 * nb;
#pragma unroll 8
    for (int i = 0; i < 32; ++i) { const int kk = 2 * i + (lane >> 5); scr[kk * 33 + (lane & 31)] = W[(size_t)(k0 + kk) * N + n0 + (lane & 31)]; }
    asm volatile("s_waitcnt lgkmcnt(0)" ::: "memory");
    const int c = lane & 7;
#pragma unroll
    for (int j = 0; j < 4; ++j) { const int n = (lane >> 3) + 8 * j; const float* s = scr + (8 * c) * 33 + n;
        u32x4 o; o.x = pkbf(s[0 * 33], s[1 * 33]); o.y = pkbf(s[2 * 33], s[3 * 33]); o.z = pkbf(s[4 * 33], s[5 * 33]); o.w = pkbf(s[6 * 33], s[7 * 33]);
        const int nl = n0 + n; const int np = nl < nperm ? prow_qk(nl) : nl;
        *(u32x4*)(WT + (size_t)np * K + k0 + 8 * c) = o; }
    asm volatile("s_waitcnt lgkmcnt(0)" ::: "memory");
}

__device__ __forceinline__ void p0_mod_gemv(const KArgs& a, int item, float* ldsf) {
    const int tid = opaque_tid(), lane = tid & 63, wave = tid >> 6;
    const int l = item / 96, col0 = (item % 96) * 32;
    float* s = ldsf;
    float* red = ldsf + 5 * 1024;
    for (int i = tid; i < 5 * 1024; i += NTHREADS) { const int bb = i >> 10, k = i & 1023; const float v = bb < 4 ? a.c[bb * 1024 + k] : a.c_ctx[k]; s[i] = v / (1.f + __expf(-v)); }
    __syncthreads();
    const int col = lane & 31, kh = lane >> 5;
    const float* W = a.w_mod + (size_t)l * 1024 * 3072 + (size_t)(wave * 128 + kh) * 3072 + col0 + col;
    float w[64];
#pragma unroll
    for (int i = 0; i < 64; ++i) w[i] = W[(size_t)(2 * i) * 3072];
    float acc[5] = {0.f, 0.f, 0.f, 0.f, 0.f};
#pragma unroll
    for (int i = 0; i < 64; ++i)
#pragma unroll
        for (int bb = 0; bb < 5; ++bb) acc[bb] += w[i] * s[bb * 1024 + wave * 128 + 2 * i + kh];
#pragma unroll
    for (int bb = 0; bb < 5; ++bb) red[((wave * 2 + kh) * 5 + bb) * 32 + col] = acc[bb];
    __syncthreads();
    if (tid < 160) { const int bb = tid >> 5, cc = tid & 31; float v = a.b_mod[l * 3072 + col0 + cc];
#pragma unroll
        for (int ww = 0; ww < 16; ++ww) v += red[(ww * 5 + bb) * 32 + cc];
        ((float*)(a.ws + WS_MOD))[(l * 5 + bb) * 3072 + col0 + cc] = v; }
    __syncthreads();
}

__device__ __forceinline__ void p0_prologue(const KArgs& a, unsigned char* lds) {
    const int tid = opaque_tid(), lane = tid & 63, wave = tid >> 6;
    const int G = gridDim.x, bx = blockIdx.x;
    unsigned char* ws = a.ws;
    if (bx < 192) p0_mod_gemv(a, bx, (float*)lds);
    {
        float* scr = (float*)(lds + wave * 16384);
        const int gw = bx * 8 + wave, NGW = G * 8;
        constexpr int I_IN = (DM / 64) * (PW / 32), I_OUT = (DM / 64) * (DM / 32);
        constexpr int NIT = 2 * (I_IN + I_OUT);
        for (int it = gw; it < NIT; it += NGW) {
            int r = it; const int l = r / (I_IN + I_OUT); r -= l * (I_IN + I_OUT);
            if (r < I_IN) p0_transpose_item(a.w_in + (size_t)l * DM * PW, DM, PW, (bf16_t*)(ws + WS_WIN) + (size_t)l * PW * DM, 640, scr, r, lane);
            else p0_transpose_item(a.w_out + (size_t)l * DM * DM, DM, DM, (bf16_t*)(ws + WS_WOUT) + (size_t)l * DM * DM, 0, scr, r - I_IN, lane);
        }
    }
    const int gt = bx * NTHREADS + tid, NGT = G * NTHREADS;
    for (int i = gt; i < 128 * 16; i += NGT) {
        const int pos = i >> 4, f = i & 15; const float inv = powf(10000.0f, -(float)f / 16.0f); const float ang = (float)pos * inv;
        float* rp = (float*)(ws + WS_ROPE) + pos * 32; rp[f] = cosf(ang); rp[16 + f] = sinf(ang);
    }
    for (int i = gt; i < 8192; i += NGT) { float sn, cs; sincospif((float)i * (2.0f / 8192.0f), &sn, &cs); float* t = (float*)(ws + WS_TW) + 2 * i; t[0] = cs; t[1] = sn; }
    for (int i = gt; i < 128 * 128; i += NGT) { const int k = i >> 7, n = i & 127; float sn, cs; sincospif((float)((k * n) & 127) * (2.0f / 128.0f), &sn, &cs);
        ((bf16_t*)(ws + WS_T1R))[i] = (bf16_t)(pkbf(cs, 0.f) & 0xffffu); ((bf16_t*)(ws + WS_T1I))[i] = (bf16_t)(pkbf(-sn, 0.f) & 0xffffu); }
    for (int i = gt; i < 64 * 128; i += NGT) { const int k = i >> 7, kk = i & 127, n = kk & 63; float sn, cs; sincospif((float)((k * n) & 63) * (2.0f / 64.0f), &sn, &cs);
        const float tr = kk < 64 ? cs : sn, ti = kk < 64 ? -sn : cs;
        ((bf16_t*)(ws + WS_T3R))[i] = (bf16_t)(pkbf(tr, 0.f) & 0xffffu); ((bf16_t*)(ws + WS_T3I))[i] = (bf16_t)(pkbf(ti, 0.f) & 0xffffu); }
    for (int i = gt; i < 256 * 256; i += NGT) { const int k = i >> 8, n = i & 255; float sn, cs; sincospif((float)((k * n) & 255) * (2.0f / 256.0f), &sn, &cs);
        ((bf16_t*)(ws + WS_T256R))[i] = (bf16_t)(pkbf(cs, 0.f) & 0xffffu); ((bf16_t*)(ws + WS_T256I))[i] = (bf16_t)(pkbf(-sn, 0.f) & 0xffffu); }
    {
        __syncthreads();
        float* trig = (float*)lds;
        if (tid < 64) { float sn, cs; sincospif((float)tid * (2.0f / 64.0f), &sn, &cs); trig[tid] = cs; trig[64 + tid] = sn; }
        __syncthreads();
        for (int i = gt; i < 2 * 4 * 64 * 128; i += NGT) {
            const int kk = i & 127, d = (i >> 7) & 63, g = (i >> 13) & 3, l = i >> 15; const int part = kk >> 6, c = swap23(kk & 63);
            const float* wf = a.w_f + ((size_t)(l * 4 + g) * 64) * 64 + d; float sacc = 0.f;
#pragma unroll 8
            for (int j = 0; j < 64; ++j) sacc += trig[part * 64 + ((c * j) & 63)] * wf[j * 64];
            ((bf16_t*)(ws + WS_GT))[i] = (bf16_t)(pkbf(sacc * (1.0f / 724.0773439350246f), 0.f) & 0xffffu);
        }
        __syncthreads();
    }
}

__device__ __forceinline__ void norm_rows4(int mode, int lane, const float* src, float* dst, const bf16_t* y, const float* ssq, bf16_t* hx,
                                           const f32x4 (&GA)[4], const f32x4 (&GB)[4], const f32x4 (&GC)[4]) {
    f32x4 v[4][4];
#pragma unroll
    for (int rr = 0; rr < 4; ++rr)
#pragma unroll
        for (int j = 0; j < 4; ++j) v[rr][j] = *(const f32x4*)(src + (size_t)rr * DM + 4 * lane + 256 * j);
    if (mode != 0) {
        u32x2 yw[4][4]; float p[4];
#pragma unroll
        for (int rr = 0; rr < 4; ++rr) { p[rr] = ssq[rr * 16 + (lane & 15)];
#pragma unroll
            for (int j = 0; j < 4; ++j) yw[rr][j] = *(const u32x2*)(y + (size_t)rr * DM + 4 * lane + 256 * j); }
#pragma unroll
        for (int rr = 0; rr < 4; ++rr) {
            float q = p[rr]; q += __shfl_xor(q, 1); q += __shfl_xor(q, 2); q += __shfl_xor(q, 4); q += __shfl_xor(q, 8);
            const float rstd = 1.0f / sqrtf(q * (1.0f / DM) + NORM_EPS);
#pragma unroll
            for (int j = 0; j < 4; ++j) {
                f32x4 yy; yy[0] = bf2f(yw[rr][j].x & 0xffffu); yy[1] = bf2f(yw[rr][j].x >> 16); yy[2] = bf2f(yw[rr][j].y & 0xffffu); yy[3] = bf2f(yw[rr][j].y >> 16);
                v[rr][j] = v[rr][j] + GA[j] * (yy * rstd);
                *(f32x4*)(dst + (size_t)rr * DM + 4 * lane + 256 * j) = v[rr][j];
            }
        }
    }
    if (mode != 2) {
        float s[4];
#pragma unroll
        for (int rr = 0; rr < 4; ++rr) { float t = 0.f;
#pragma unroll
            for (int j = 0; j < 4; ++j) t += (v[rr][j][0] * v[rr][j][0] + v[rr][j][1] * v[rr][j][1]) + (v[rr][j][2] * v[rr][j][2] + v[rr][j][3] * v[rr][j][3]);
            s[rr] = t; }
#pragma unroll
        for (int o = 1; o < 64; o <<= 1) {
#pragma unroll
            for (int rr = 0; rr < 4; ++rr) s[rr] += __shfl_xor(s[rr], o); }
#pragma unroll
        for (int rr = 0; rr < 4; ++rr) {
            const float rstd = 1.0f / sqrtf(s[rr] * (1.0f / DM) + NORM_EPS);
#pragma unroll
            for (int j = 0; j < 4; ++j) {
                const f32x4 o = (v[rr][j] * rstd) * GB[j] + GC[j];
                u32x2 w; w.x = pkbf(o[0], o[1]); w.y = pkbf(o[2], o[3]);
                *(u32x2*)(hx + (size_t)rr * DM + 4 * lane + 256 * j) = w;
            }
        }
    }
}
__device__ __forceinline__ void norm_phase(const KArgs& a, int mode) {
    const int tid = opaque_tid(), lane = tid & 63, wave = tid >> 6;
    const int NGW = gridDim.x * 8;
    unsigned char* ws = a.ws;
    const float* mod = (const float*)(ws + WS_MOD);
    const int lp = (mode == 0) ? 0 : 1;
    const int lq = (mode == 1) ? 0 : 1;
    bf16_t* HX = (bf16_t*)(ws + WS_HX); const bf16_t* Y = (const bf16_t*)(ws + WS_Y); const float* SSQ = (const float*)(ws + WS_SSQ);
    const int gw2 = wave * (int)gridDim.x + (int)blockIdx.x;
    const int nlat = NTOK / 4;
    int curb = -1; f32x4 GA[4], GB[4], GC[4];
    int base = gw2 * 4, sub = 0, itc = nlat + gw2; bool inctx = false;
    for (;;) {
        int it;
        if (!inctx) { if (base >= nlat) { inctx = true; continue; } it = base + sub; if (++sub == 4) { sub = 0; base += NGW * 4; } }
        else { if (mode == 2 || itc >= nlat + NCTX / 4) break; it = itc; itc += NGW; }
        const int r = it * 4;
        const int b = r < NTOK ? (r >> 13) : 4;
        if (b != curb) { curb = b;
            const float* mp = mod + (lp * 5 + b) * 3072; const float* mq = mod + (lq * 5 + b) * 3072;
#pragma unroll
            for (int j = 0; j < 4; ++j) { const int c = 4 * lane + 256 * j;
                GA[j] = *(const f32x4*)(mq + 2048 + c) * *(const f32x4*)(a.g_post + lq * DM + c);
                GB[j] = *(const f32x4*)(a.g_pre + lp * DM + c) * (*(const f32x4*)(mp + 1024 + c) + 1.0f);
                GC[j] = *(const f32x4*)(mp + c); } }
        const float* src; float* dst;
        if (r < NTOK) { src = (mode == 2 ? (const float*)a.out : a.x) + (size_t)r * DM; dst = a.out + (size_t)r * DM; }
        else { src = a.ctx + (size_t)(r - NTOK) * DM; dst = (float*)(ws + WS_CTX1) + (size_t)(r - NTOK) * DM; }
        norm_rows4(mode, lane, src, dst, Y + (size_t)r * DM, SSQ + (size_t)r * 16, HX + (size_t)r * DM, GA, GB, GC);
    }
}

__device__ __forceinline__ void attn_unit(int u, const bf16_t* P, const bf16_t* Vt, bf16_t* H, const float* sink, unsigned char* lds) {
    const int tid = opaque_tid(), lane = tid & 63, wave = __builtin_amdgcn_readfirstlane(tid >> 6), r32 = lane & 31, hi = lane >> 5;
    const bool isctx = u >= 1024;
    int b, kvh, qb;
    if (isctx) { const int v = u - 1024; b = v >> 3; kvh = (v >> 2) & 1; qb = v & 3; } else { b = u >> 8; kvh = (u >> 7) & 1; qb = u & 127; }
    const int head = kvh * 4 + (wave >> 1);
    const int qtok = qb * 64 + (wave & 1) * 32 + r32;
    const size_t qrow = isctx ? (size_t)(NTOK + b * CTXL + qtok) : (size_t)(b * SEQ + qtok);
    const float sinkv = sink[head];
    bf16x8 qf[4];
#pragma unroll
    for (int d0 = 0; d0 < 4; ++d0) qf[d0] = *(const bf16x8*)(P + qrow * PW + C_Q + head * 64 + d0 * 16 + hi * 8);
    int jlo = 0, jhi = -1;
    if (!isctx) { jlo = qb < 2 ? 2 - qb : 0; jhi = (129 - qb) < 4 ? (129 - qb) : 4; }
    const int ntiles = 4 + (jhi - jlo + 1);
    const int srow = tid >> 3, sch = tid & 7;
    const bf16_t* Kc = P + (size_t)(NTOK + b * CTXL + srow) * PW + C_K + kvh * 64 + sch * 8;
    const bf16_t* Kl = P + (size_t)(b * SEQ + srow) * PW + C_K + kvh * 64 + sch * 8;
    const bf16_t* Vb = Vt + (size_t)((b * 2 + kvh) * 64 + srow) * VT_PITCH + sch * 8;
    unsigned char* Ks = lds; unsigned char* Vs = lds + 2 * 9216;
    const int soff = srow * 144 + sch * 16;
    u32x4 kreg, vreg, kreg2, vreg2;
#define ATT_GLOAD(KR, VR, ti_) do { const int t_ = (ti_); \
        if (t_ < 4) { KR = *(const u32x4*)(Kc + (size_t)(64 * t_) * PW); VR = *(const u32x4*)(Vb + SEQ + 64 * t_); } \
        else { const int kbase_ = qb * 64 - 128 + 64 * (jlo + t_ - 4); KR = *(const u32x4*)(Kl + (size_t)kbase_ * PW); VR = *(const u32x4*)(Vb + kbase_); } } while (0)
    const bf16_t* garow = P + qrow * PW + C_GA + head * 64;
    u32x2 gaw[8];
#pragma unroll
    for (int i = 0; i < 8; ++i) gaw[i] = *(const u32x2*)(garow + 32 * (i >> 2) + 8 * (i & 3) + 4 * hi);
    ATT_GLOAD(kreg2, vreg2, 0);
    ATT_GLOAD(kreg, vreg, 1);
    *(u32x4*)(Ks + soff) = kreg2; *(u32x4*)(Vs + soff) = vreg2;
    __syncthreads();
    const float sink2 = sinkv * LOG2E;
    float mref = sink2, lsum = 0.f;
    f32x16 oT[2]; oT[0] = f32x16{}; oT[1] = f32x16{};
    const int qpos = qtok;
    for (int ti = 0; ti < ntiles; ++ti) {
        const int buf = ti & 1;
        if (ti + 2 < ntiles) ATT_GLOAD(kreg2, vreg2, ti + 2);
        const unsigned char* kb = Ks + buf * 9216 + r32 * 144 + hi * 16;
        const unsigned char* vb = Vs + buf * 9216 + r32 * 144 + hi * 16;
        bf16x8 kf[8];
#pragma unroll
        for (int d0 = 0; d0 < 4; ++d0) { kf[2 * d0] = *(const bf16x8*)(kb + d0 * 32); kf[2 * d0 + 1] = *(const bf16x8*)(kb + 32 * 144 + d0 * 32); }
        f32x16 p0, p1;
#pragma unroll
        for (int r = 0; r < 16; ++r) { p0[r] = -mref; p1[r] = -mref; }
        __builtin_amdgcn_sched_barrier(0);
#pragma unroll
        for (int d0 = 0; d0 < 4; ++d0) { p0 = MFMA32(kf[2 * d0], qf[d0], p0); p1 = MFMA32(kf[2 * d0 + 1], qf[d0], p1); }
        bf16x8 vf[8];
#pragma unroll
        for (int blk = 0; blk < 2; ++blk)
#pragma unroll
            for (int ks = 0; ks < 4; ++ks) vf[blk * 4 + ks] = *(const bf16x8*)(vb + blk * 32 * 144 + ks * 32);
        __builtin_amdgcn_sched_barrier(0);
        if (ti >= 4) {
            const int j = jlo + ti - 4; const int kbase = qb * 64 - 128 + 64 * j;
            if (j == 0) {
#pragma unroll
                for (int r = 0; r < 16; ++r) { const int kp = kbase + crow(r, hi); if (kp < qpos - 128) p0[r] = -INFINITY; if (kp + 32 < qpos - 128) p1[r] = -INFINITY; }
            } else if (j == 4) {
#pragma unroll
                for (int r = 0; r < 16; ++r) { const int kp = kbase + crow(r, hi); if (kp > qpos + 128) p0[r] = -INFINITY; if (kp + 32 > qpos + 128) p1[r] = -INFINITY; }
            }
        }
        float rm = fmaxf(p0[0], p1[0]);
#pragma unroll
        for (int r = 1; r < 16; ++r) rm = fmaxf(rm, fmaxf(p0[r], p1[r]));
        rm = fmaxf(rm, __shfl_xor(rm, 32));
        if (__any(rm > 8.0f)) {
            const float dl = fmaxf(rm, 0.f);
            mref += dl;
            const float f = __builtin_amdgcn_exp2f(-dl);
            lsum *= f;
#pragma unroll
            for (int r = 0; r < 16; ++r) { p0[r] -= dl; p1[r] -= dl; oT[0][r] *= f; oT[1][r] *= f; }
        }
        float ls = 0.f;
#pragma unroll
        for (int r = 0; r < 16; ++r) { p0[r] = __builtin_amdgcn_exp2f(p0[r]); p1[r] = __builtin_amdgcn_exp2f(p1[r]); ls += p0[r] + p1[r]; }
        lsum += ls;
        bf16x8 pf[4]; pf[0] = pack8(p0, 0); pf[1] = pack8(p0, 8); pf[2] = pack8(p1, 0); pf[3] = pack8(p1, 8);
#pragma unroll
        for (int blk = 0; blk < 2; ++blk)
#pragma unroll
            for (int ks = 0; ks < 4; ++ks) oT[blk] = MFMA32(vf[blk * 4 + ks], pf[ks], oT[blk]);
        if (ti + 1 < ntiles) { *(u32x4*)(Ks + (buf ^ 1) * 9216 + soff) = kreg; *(u32x4*)(Vs + (buf ^ 1) * 9216 + soff) = vreg; }
        kreg = kreg2; vreg = vreg2;
        __syncthreads();
    }
    lsum += __shfl_xor(lsum, 32);
    lsum += __builtin_amdgcn_exp2f(sink2 - mref);
    const float inv = 1.0f / lsum;
    bf16_t* hrow = H + qrow * DM + head * 64;
#pragma unroll
    for (int blk = 0; blk < 2; ++blk)
#pragma unroll
        for (int g4 = 0; g4 < 4; ++g4) {
            const int d0 = 32 * blk + 8 * g4 + 4 * hi;
            const u32x2 gw = gaw[blk * 4 + g4];
            const float o0 = oT[blk][4 * g4 + 0] * inv * silu_f(bf2f(gw.x & 0xffffu)), o1 = oT[blk][4 * g4 + 1] * inv * silu_f(bf2f(gw.x >> 16));
            const float o2 = oT[blk][4 * g4 + 2] * inv * silu_f(bf2f(gw.y & 0xffffu)), o3 = oT[blk][4 * g4 + 3] * inv * silu_f(bf2f(gw.y >> 16));
            u32x2 w; w.x = pkbf(o0, o1); w.y = pkbf(o2, o3);
            *(u32x2*)(hrow + d0) = w;
        }
}

typedef short v4i16_t __attribute__((ext_vector_type(4)));
__device__ __forceinline__ v4i16_t trrd(const unsigned char* p) { return __builtin_amdgcn_ds_read_tr16_b64_v4i16((LAS v4i16_t*)p); }
__device__ __forceinline__ bf16x8 cat8(v4i16_t lo, v4i16_t hi) { return (bf16x8){lo[0], lo[1], lo[2], lo[3], hi[0], hi[1], hi[2], hi[3]}; }
__device__ __forceinline__ void fft1_unit(int u, const bf16_t* P, bf16_t* YF, const unsigned char* ws, unsigned char* lds) {
    const int tid = opaque_tid(), lane = tid & 63, wave = __builtin_amdgcn_readfirstlane(tid >> 6), r32 = lane & 31, hi = lane >> 5;
    const int b = u >> 6, n2 = u & 63;
    constexpr int UPB = 576;
    const bf16_t* src = P + (size_t)(b * SEQ + n2) * PW + C_UF;
#pragma unroll
    for (int i = 0; i < 8; ++i) {
        const int id = tid + NTHREADS * i, n1 = id >> 5, cc = id & 31;
        *(u32x4*)(lds + n1 * UPB + cc * 16) = *(const u32x4*)(src + (size_t)n1 * 64 * PW + cc * 8);
    }
    __syncthreads();
    const bf16_t* T1R = (const bf16_t*)(ws + WS_T1R); const bf16_t* T1I = (const bf16_t*)(ws + WS_T1I);
    f32x16 aR[4], aI[4];
#pragma unroll
    for (int kb = 0; kb < 4; ++kb) { aR[kb] = f32x16{}; aI[kb] = f32x16{}; }
    const unsigned char* ap = lds + (8 * hi + ((lane & 15) >> 2)) * UPB + (32 * wave + 16 * ((lane >> 4) & 1) + 4 * (lane & 3)) * 2;
#pragma unroll 2
    for (int ks = 0; ks < 8; ++ks) {
        const bf16x8 av = cat8(trrd(ap + (16 * ks) * UPB), trrd(ap + (16 * ks + 4) * UPB));
#pragma unroll
        for (int kb = 0; kb < 4; ++kb) {
            const bf16x8 bR = *(const bf16x8*)(T1R + (32 * kb + r32) * 128 + 16 * ks + 8 * hi), bI = *(const bf16x8*)(T1I + (32 * kb + r32) * 128 + 16 * ks + 8 * hi);
            aR[kb] = MFMA32(av, bR, aR[kb]); aI[kb] = MFMA32(av, bI, aI[kb]);
        }
    }
    const float* TW = (const float*)(ws + WS_TW);
#pragma unroll
    for (int kb = 0; kb < 4; ++kb) {
        const int k1 = 32 * kb + r32;
        const float ct = TW[2 * (n2 * k1)], st = TW[2 * (n2 * k1) + 1];
        bf16_t* yp = YF + ((size_t)((b * 128 + k1) * 64 + n2)) * 512 + 32 * wave + 4 * hi;
#pragma unroll
        for (int g4 = 0; g4 < 4; ++g4) {
            float yr[4], yi[4];
#pragma unroll
            for (int e = 0; e < 4; ++e) { const float r_ = aR[kb][4 * g4 + e], i_ = aI[kb][4 * g4 + e]; yr[e] = r_ * ct + i_ * st; yi[e] = i_ * ct - r_ * st; }
            u32x2 wr_, wi_; wr_.x = pkbf(yr[0], yr[1]); wr_.y = pkbf(yr[2], yr[3]); wi_.x = pkbf(yi[0], yi[1]); wi_.y = pkbf(yi[2], yi[3]);
            *(u32x2*)(yp + 8 * g4) = wr_; *(u32x2*)(yp + 256 + 8 * g4) = wi_;
        }
    }
    __syncthreads();
}

template <int KK>
__device__ __forceinline__ void dftf_unit(const bf16_t* srcbase, int R, int pitchA, int pitchB, const bf16_t* Tr, const bf16_t* Ti, const bf16_t* Gt,
                                          const bf16_t* P, bf16_t* H, size_t row0, int rowstride, float oscale, unsigned char* lds) {
    const int tid = opaque_tid(), lane = tid & 63, wave = __builtin_amdgcn_readfirstlane(tid >> 6), r32 = lane & 31, hi = lane >> 5;
    constexpr int ZPB = (KK == 128) ? 576 : 544;
#pragma unroll 1
    for (int i0 = 0; i0 < KK / 16; i0 += 8) {
        u32x4 img[8];
#pragma unroll
        for (int i = 0; i < 8; ++i) { const int id = tid + NTHREADS * (i0 + i), kk = id >> 5, cc = id & 31; img[i] = *(const u32x4*)(srcbase + (size_t)(kk % R) * pitchA + (size_t)(kk / R) * pitchB + cc * 8); }
        __builtin_amdgcn_sched_barrier(0);
#pragma unroll
        for (int i = 0; i < 8; ++i) { const int id = tid + NTHREADS * (i0 + i), kk = id >> 5, cc = id & 31; *(u32x4*)(lds + kk * ZPB + cc * 16) = img[i]; }
        __builtin_amdgcn_sched_barrier(0);
    }
    __syncthreads();
    const int g = wave >> 1, kblk = wave & 1;
    f32x16 XR[2], XI[2];
#pragma unroll
    for (int cb = 0; cb < 2; ++cb) { XR[cb] = f32x16{}; XI[cb] = f32x16{}; }
    const bf16_t* trp = Tr + (size_t)(32 * kblk + r32) * KK + 8 * hi; const bf16_t* tip = Ti + (size_t)(32 * kblk + r32) * KK + 8 * hi;
    const unsigned char* zp = lds + (8 * hi + ((lane & 15) >> 2)) * ZPB + (64 * g + 16 * ((lane >> 4) & 1) + 4 * (lane & 3)) * 2;
#pragma unroll 2
    for (int ks = 0; ks < KK / 16; ++ks) {
        const bf16x8 bR = *(const bf16x8*)(trp + 16 * ks), bI = *(const bf16x8*)(tip + 16 * ks);
#pragma unroll
        for (int cb = 0; cb < 2; ++cb) { const bf16x8 av = cat8(trrd(zp + (16 * ks) * ZPB + cb * 64), trrd(zp + (16 * ks + 4) * ZPB + cb * 64)); XR[cb] = MFMA32(av, bR, XR[cb]); XI[cb] = MFMA32(av, bI, XI[cb]); }
    }
    f32x16 oa[2]; oa[0] = f32x16{}; oa[1] = f32x16{};
    const bf16_t* gp = Gt + (size_t)(g * 64 + r32) * 128 + 8 * hi;
    u32x2 gfw[8];
    { const size_t rowg = row0 + (size_t)(32 * kblk + r32) * rowstride;
#pragma unroll
      for (int i8 = 0; i8 < 8; ++i8) gfw[i8] = *(const u32x2*)(P + rowg * PW + C_GF + 64 * g + 32 * (i8 >> 2) + 8 * (i8 & 3) + 4 * hi); }
#pragma unroll
    for (int part = 0; part < 2; ++part)
#pragma unroll
        for (int cb = 0; cb < 2; ++cb)
#pragma unroll
            for (int s = 0; s < 2; ++s) {
                const bf16x8 bx = pack8(part ? XI[cb] : XR[cb], 8 * s);
                const int kko = part * 64 + 32 * cb + 16 * s;
#pragma unroll
                for (int lb = 0; lb < 2; ++lb) { const bf16x8 ag = *(const bf16x8*)(gp + (size_t)(32 * lb) * 128 + kko); oa[lb] = MFMA32(ag, bx, oa[lb]); }
            }
    const int k2 = 32 * kblk + r32;
    const size_t row = row0 + (size_t)k2 * rowstride;
    const bf16_t* gfrow = P + row * PW + C_GF + 64 * g;
    bf16_t* hrow = H + row * DM + 512 + 64 * g;
#pragma unroll
    for (int lb = 0; lb < 2; ++lb)
#pragma unroll
        for (int g4 = 0; g4 < 4; ++g4) {
            const int l0 = 32 * lb + 8 * g4 + 4 * hi;
            const u32x2 gw = gfw[lb * 4 + g4];
            const float o0 = oa[lb][4 * g4 + 0] * oscale * silu_f(bf2f(gw.x & 0xffffu)), o1 = oa[lb][4 * g4 + 1] * oscale * silu_f(bf2f(gw.x >> 16));
            const float o2 = oa[lb][4 * g4 + 2] * oscale * silu_f(bf2f(gw.y & 0xffffu)), o3 = oa[lb][4 * g4 + 3] * oscale * silu_f(bf2f(gw.y >> 16));
            u32x2 w; w.x = pkbf(o0, o1); w.y = pkbf(o2, o3);
            *(u32x2*)(hrow + l0) = w;
        }
    __syncthreads();
}

__device__ __forceinline__ void conv_unit(int u, const bf16_t* P, bf16_t* H, const float* cw, const float* cb) {
    const int tid = opaque_tid(), cgp = tid & 31, rg = tid >> 5;
    const int ch0 = cgp * 8;
    const int r0 = u * 64 + rg * 4;
    int pos, len; if (r0 < NTOK) { pos = r0 & (SEQ - 1); len = SEQ; } else { pos = (r0 - NTOK) & (CTXL - 1); len = CTXL; }
    float w0[8], w1[8], w2[8], bs[8];
#pragma unroll
    for (int e = 0; e < 8; ++e) { w0[e] = cw[ch0 + e]; w1[e] = cw[256 + ch0 + e]; w2[e] = cw[512 + ch0 + e]; bs[e] = cb[ch0 + e]; }
    float T[6][8];
#pragma unroll
    for (int i = 0; i < 6; ++i) {
        const int p = pos - 1 + i;
        if (p >= 0 && p < len) {
            const size_t row = (size_t)(r0 - 1 + i);
            const u32x4 z = *(const u32x4*)(P + row * PW + C_ZC + ch0), c = *(const u32x4*)(P + row * PW + C_CC + ch0);
            T[i][0] = bf2f(z.x & 0xffffu) * bf2f(c.x & 0xffffu); T[i][1] = bf2f(z.x >> 16) * bf2f(c.x >> 16);
            T[i][2] = bf2f(z.y & 0xffffu) * bf2f(c.y & 0xffffu); T[i][3] = bf2f(z.y >> 16) * bf2f(c.y >> 16);
            T[i][4] = bf2f(z.z & 0xffffu) * bf2f(c.z & 0xffffu); T[i][5] = bf2f(z.z >> 16) * bf2f(c.z >> 16);
            T[i][6] = bf2f(z.w & 0xffffu) * bf2f(c.w & 0xffffu); T[i][7] = bf2f(z.w >> 16) * bf2f(c.w >> 16);
        } else {
#pragma unroll
            for (int e = 0; e < 8; ++e) T[i][e] = 0.f;
        }
    }
#pragma unroll
    for (int i = 0; i < 4; ++i) {
        const size_t row = (size_t)(r0 + i);
        const u32x4 bw = *(const u32x4*)(P + row * PW + C_BC + ch0), gw = *(const u32x4*)(P + row * PW + C_GC + ch0);
        const unsigned bwv[4] = {bw.x, bw.y, bw.z, bw.w}, gwv[4] = {gw.x, gw.y, gw.z, gw.w};
        float o[8];
#pragma unroll
        for (int e = 0; e < 8; ++e) {
            const float bv = (e & 1) ? bf2f(bwv[e >> 1] >> 16) : bf2f(bwv[e >> 1] & 0xffffu);
            const float gv = (e & 1) ? bf2f(gwv[e >> 1] >> 16) : bf2f(gwv[e >> 1] & 0xffffu);
            const float y = T[i][e] * w0[e] + T[i + 1][e] * w1[e] + T[i + 2][e] * w2[e] + bs[e];
            o[e] = bv * y * silu_f(gv);
        }
        u32x4 w; w.x = pkbf(o[0], o[1]); w.y = pkbf(o[2], o[3]); w.z = pkbf(o[4], o[5]); w.w = pkbf(o[6], o[7]);
        *(u32x4*)(H + row * DM + 768 + ch0) = w;
    }
}

__device__ __forceinline__ void fft1_wave(int task, const bf16_t* P, bf16_t* YF, const unsigned char* ws, unsigned char* lds_w, int lane, int pmode = 0) {
    const int r32 = lane & 31, hi = lane >> 5;
    const int cblk = task & 7, n2 = (task >> 3) & 63, b = task >> 9;
    const bf16_t* src = P + (size_t)((b * 64 + n2) * 128) * 256 + 32 * cblk + 8 * (lane & 3);
    { u32x4 img[8];
#pragma unroll
      for (int i = 0; i < 8; ++i) img[i] = *(const u32x4*)(src + (size_t)(16 * i + (lane >> 2)) * 256);
      __builtin_amdgcn_sched_barrier(0);
#pragma unroll
      for (int i = 0; i < 8; ++i) *(u32x4*)(lds_w + (16 * i + (lane >> 2)) * 64 + (lane & 3) * 16) = img[i];
      __builtin_amdgcn_sched_barrier(0); }
    asm volatile("s_waitcnt vmcnt(0) lgkmcnt(0)" ::: "memory");
    if (pmode == 2) return;
    const bf16_t* T1R = (const bf16_t*)(ws + WS_T1R); const bf16_t* T1I = (const bf16_t*)(ws + WS_T1I);
    f32x16 aR[4], aI[4];
#pragma unroll
    for (int kb = 0; kb < 4; ++kb) { aR[kb] = f32x16{}; aI[kb] = f32x16{}; }
    const unsigned char* ap = lds_w + (8 * hi + ((lane & 15) >> 2)) * 64 + (16 * ((lane >> 4) & 1) + 4 * (lane & 3)) * 2;
    const bf16_t* t1r = T1R + (size_t)r32 * 128 + 8 * hi; const bf16_t* t1i = T1I + (size_t)r32 * 128 + 8 * hi;
    bf16x8 bA[8], bB[8];
#define F1_LOADB(B, ks_) do { _Pragma("unroll") for (int kb = 0; kb < 4; ++kb) { B[2 * kb] = *(const bf16x8*)(t1r + (size_t)(32 * kb) * 128 + 16 * (ks_)); B[2 * kb + 1] = *(const bf16x8*)(t1i + (size_t)(32 * kb) * 128 + 16 * (ks_)); } } while (0)
#define F1_STEP(B, ks_) do { const bf16x8 av = cat8(trrd(ap + (16 * (ks_)) * 64), trrd(ap + (16 * (ks_) + 4) * 64)); \
        _Pragma("unroll") for (int kb = 0; kb < 4; ++kb) { aR[kb] = MFMA32(av, B[2 * kb], aR[kb]); aI[kb] = MFMA32(av, B[2 * kb + 1], aI[kb]); } } while (0)
    F1_LOADB(bA, 0);
#pragma unroll
    for (int k2 = 0; k2 < 4; ++k2) {
        F1_LOADB(bB, 2 * k2 + 1);
        __builtin_amdgcn_sched_barrier(0);
        F1_STEP(bA, 2 * k2);
        __builtin_amdgcn_sched_barrier(0);
        if (k2 < 3) F1_LOADB(bA, 2 * k2 + 2);
        __builtin_amdgcn_sched_barrier(0);
        F1_STEP(bB, 2 * k2 + 1);
        __builtin_amdgcn_sched_barrier(0);
    }
#undef F1_LOADB
#undef F1_STEP
    const float* TW = (const float*)(ws + WS_TW);
#pragma unroll
    for (int kb = 0; kb < 4; ++kb) {
        const int k1 = 32 * kb + r32;
        const float ct = TW[2 * (n2 * k1)], st = TW[2 * (n2 * k1) + 1];
        bf16_t* yp = YF + ((size_t)((b * 128 + k1) * 64 + n2)) * 512 + 32 * cblk + 4 * hi;
#pragma unroll
        for (int g4 = 0; g4 < 4; ++g4) {
            float yr[4], yi[4];
#pragma unroll
            for (int e = 0; e < 4; ++e) { const float r_ = aR[kb][4 * g4 + e], i_ = aI[kb][4 * g4 + e]; yr[e] = r_ * ct + i_ * st; yi[e] = i_ * ct - r_ * st; }
            u32x2 wr_, wi_; wr_.x = pkbf(yr[0], yr[1]); wr_.y = pkbf(yr[2], yr[3]); wi_.x = pkbf(yi[0], yi[1]); wi_.y = pkbf(yi[2], yi[3]);
            if (pmode != 1 || wr_.x == 0x12345678u) { *(u32x2*)(yp + 8 * g4) = wr_; *(u32x2*)(yp + 256 + 8 * g4) = wi_; }
        }
    }
    asm volatile("s_waitcnt lgkmcnt(0)" ::: "memory");
}
__device__ __forceinline__ void fft3_wave(int task, const bf16_t* YF, const bf16_t* Gt, const bf16_t* P, bf16_t* H, const unsigned char* ws, unsigned char* lds_w, int lane) {
    const int r32 = lane & 31, hi = lane >> 5;
    const int g = task & 3, k1 = (task >> 2) & 127, b = task >> 9;
    const bf16_t* src = YF + ((size_t)(b * 128 + k1) * 64) * 512 + 64 * g + 8 * (lane & 7);
    { u32x4 img[16];
#pragma unroll
      for (int i = 0; i < 16; ++i) { const int kk = 8 * i + (lane >> 3); img[i] = *(const u32x4*)(src + (size_t)(kk & 63) * 512 + (size_t)(kk >> 6) * 256); }
      __builtin_amdgcn_sched_barrier(0);
#pragma unroll
      for (int i = 0; i < 16; ++i) { const int kk = 8 * i + (lane >> 3), ch = lane & 7; *(u32x4*)(lds_w + kk * 128 + ((ch ^ (((kk >> 1) & 1) << 2)) * 16)) = img[i]; }
      __builtin_amdgcn_sched_barrier(0); }
    asm volatile("s_waitcnt vmcnt(0) lgkmcnt(0)" ::: "memory");
    const bf16_t* T3R = (const bf16_t*)(ws + WS_T3R); const bf16_t* T3I = (const bf16_t*)(ws + WS_T3I);
    const int q = (lane & 15) >> 2, sw = (q >> 1) & 1;
    const int chl = 2 * ((lane >> 4) & 1) + ((lane & 3) >> 1);
    const unsigned char* zb = lds_w + (8 * hi + q) * 128 + 8 * (lane & 1);
    const unsigned char* zp0 = zb + ((chl ^ (sw << 2)) * 16);
    const unsigned char* zp1 = zb + (((4 + chl) ^ (sw << 2)) * 16);
    const bf16_t* gp = Gt + (size_t)(g * 64 + r32) * 128 + 8 * hi;
    const size_t rowb = (size_t)(b * SEQ + k1);
#pragma unroll 1
    for (int kblk = 0; kblk < 2; ++kblk) {
        f32x16 XR[2], XI[2];
#pragma unroll
        for (int cb = 0; cb < 2; ++cb) { XR[cb] = f32x16{}; XI[cb] = f32x16{}; }
        const bf16_t* trp = T3R + (size_t)(32 * kblk + r32) * 128 + 8 * hi; const bf16_t* tip = T3I + (size_t)(32 * kblk + r32) * 128 + 8 * hi;
        const size_t rowg = rowb + (size_t)(32 * kblk + r32) * 128;
        u32x2 gfw[8];
#pragma unroll
        for (int i8 = 0; i8 < 8; ++i8) gfw[i8] = *(const u32x2*)(P + rowg * PW + C_GF + 64 * g + 32 * (i8 >> 2) + 8 * (i8 & 3) + 4 * hi);
        bf16x8 bR[8], bI[8];
#pragma unroll
        for (int ks = 0; ks < 8; ++ks) { bR[ks] = *(const bf16x8*)(trp + 16 * ks); bI[ks] = *(const bf16x8*)(tip + 16 * ks); }
        __builtin_amdgcn_sched_barrier(0);
#pragma unroll
        for (int ks = 0; ks < 8; ++ks) {
            const bf16x8 a0 = cat8(trrd(zp0 + (16 * ks) * 128), trrd(zp0 + (16 * ks + 4) * 128));
            const bf16x8 a1 = cat8(trrd(zp1 + (16 * ks) * 128), trrd(zp1 + (16 * ks + 4) * 128));
            XR[0] = MFMA32(a0, bR[ks], XR[0]); XI[0] = MFMA32(a0, bI[ks], XI[0]); XR[1] = MFMA32(a1, bR[ks], XR[1]); XI[1] = MFMA32(a1, bI[ks], XI[1]);
        }
        __builtin_amdgcn_sched_barrier(0);
        bf16x8 gfr[2][8];
#pragma unroll
        for (int lb = 0; lb < 2; ++lb)
#pragma unroll
            for (int q8 = 0; q8 < 8; ++q8) gfr[lb][q8] = *(const bf16x8*)(gp + (size_t)(32 * lb) * 128 + 16 * q8);
        __builtin_amdgcn_sched_barrier(0);
        f32x16 oa[2]; oa[0] = f32x16{}; oa[1] = f32x16{};
#pragma unroll
        for (int part = 0; part < 2; ++part)
#pragma unroll
            for (int cb = 0; cb < 2; ++cb)
#pragma unroll
                for (int s = 0; s < 2; ++s) {
                    const bf16x8 bx = pack8(part ? XI[cb] : XR[cb], 8 * s);
                    const int kko = part * 64 + 32 * cb + 16 * s;
#pragma unroll
                    for (int lb = 0; lb < 2; ++lb) oa[lb] = MFMA32(gfr[lb][kko >> 4], bx, oa[lb]);
                }
        const int k2 = 32 * kblk + r32;
        const size_t row = rowb + (size_t)k2 * 128;
        const bf16_t* gfrow = P + row * PW + C_GF + 64 * g;
        bf16_t* hrow = H + row * DM + 512 + 64 * g;
#pragma unroll
        for (int lb = 0; lb < 2; ++lb)
#pragma unroll
            for (int g4 = 0; g4 < 4; ++g4) {
                const int l0 = 32 * lb + 8 * g4 + 4 * hi;
                const u32x2 gw = gfw[lb * 4 + g4];
                const float o0 = oa[lb][4 * g4 + 0] * silu_f(bf2f(gw.x & 0xffffu)), o1 = oa[lb][4 * g4 + 1] * silu_f(bf2f(gw.x >> 16));
                const float o2 = oa[lb][4 * g4 + 2] * silu_f(bf2f(gw.y & 0xffffu)), o3 = oa[lb][4 * g4 + 3] * silu_f(bf2f(gw.y >> 16));
                u32x2 w; w.x = pkbf(o0, o1); w.y = pkbf(o2, o3);
                *(u32x2*)(hrow + l0) = w;
            }
    }
    asm volatile("s_waitcnt lgkmcnt(0)" ::: "memory");
}
__device__ __forceinline__ void conv_wave(int task, const bf16_t* P, bf16_t* H, const float* cw, const float* cb, int lane) {
    const int cgp = lane & 31, ch0 = cgp * 8;
    const int r0 = task * 8 + (lane >> 5) * 4;
    int pos, len; if (r0 < NTOK) { pos = r0 & (SEQ - 1); len = SEQ; } else { pos = (r0 - NTOK) & (CTXL - 1); len = CTXL; }
    u32x4 zz[6], cc[6], bb[4], gg[4];
#pragma unroll
    for (int i = 0; i < 6; ++i) { const int p = pos - 1 + i; const bool ok = p >= 0 && p < len; const size_t row = (size_t)(ok ? r0 - 1 + i : r0);
        zz[i] = *(const u32x4*)(P + row * PW + C_ZC + ch0); cc[i] = *(const u32x4*)(P + row * PW + C_CC + ch0);
        if (!ok) { zz[i] = (u32x4){0u, 0u, 0u, 0u}; } }
#pragma unroll
    for (int i = 0; i < 4; ++i) { const size_t row = (size_t)(r0 + i); bb[i] = *(const u32x4*)(P + row * PW + C_BC + ch0); gg[i] = *(const u32x4*)(P + row * PW + C_GC + ch0); }
    float w0[8], w1[8], w2[8], bs[8];
    { const f32x4 a0 = *(const f32x4*)(cw + ch0), a1 = *(const f32x4*)(cw + ch0 + 4), b0 = *(const f32x4*)(cw + 256 + ch0), b1 = *(const f32x4*)(cw + 256 + ch0 + 4);
      const f32x4 c0 = *(const f32x4*)(cw + 512 + ch0), c1 = *(const f32x4*)(cw + 512 + ch0 + 4), d0 = *(const f32x4*)(cb + ch0), d1 = *(const f32x4*)(cb + ch0 + 4);
#pragma unroll
      for (int e = 0; e < 4; ++e) { w0[e] = a0[e]; w0[4 + e] = a1[e]; w1[e] = b0[e]; w1[4 + e] = b1[e]; w2[e] = c0[e]; w2[4 + e] = c1[e]; bs[e] = d0[e]; bs[4 + e] = d1[e]; } }
    float T[6][8];
#pragma unroll
    for (int i = 0; i < 6; ++i) {
        const unsigned zv[4] = {zz[i].x, zz[i].y, zz[i].z, zz[i].w}, cv[4] = {cc[i].x, cc[i].y, cc[i].z, cc[i].w};
#pragma unroll
        for (int e = 0; e < 8; ++e) T[i][e] = ((e & 1) ? bf2f(zv[e >> 1] >> 16) : bf2f(zv[e >> 1] & 0xffffu)) * ((e & 1) ? bf2f(cv[e >> 1] >> 16) : bf2f(cv[e >> 1] & 0xffffu));
    }
#pragma unroll
    for (int i = 0; i < 4; ++i) {
        const size_t row = (size_t)(r0 + i);
        const unsigned bwv[4] = {bb[i].x, bb[i].y, bb[i].z, bb[i].w}, gwv[4] = {gg[i].x, gg[i].y, gg[i].z, gg[i].w};
        float o[8];
#pragma unroll
        for (int e = 0; e < 8; ++e) {
            const float bv = (e & 1) ? bf2f(bwv[e >> 1] >> 16) : bf2f(bwv[e >> 1] & 0xffffu);
            const float gv = (e & 1) ? bf2f(gwv[e >> 1] >> 16) : bf2f(gwv[e >> 1] & 0xffffu);
            const float y = T[i][e] * w0[e] + T[i + 1][e] * w1[e] + T[i + 2][e] * w2[e] + bs[e];
            o[e] = bv * y * silu_f(gv);
        }
        u32x4 w; w.x = pkbf(o[0], o[1]); w.y = pkbf(o[2], o[3]); w.z = pkbf(o[4], o[5]); w.w = pkbf(o[6], o[7]);
        *(u32x4*)(H + row * DM + 768 + ch0) = w;
    }
}

#define XB_TMO      128
#define XB_XCNT(j)  (256  + 64 * (j))
#define XB_XSUB(j)  (1280 + 64 * (j))
#define XB_XGEN(j)  (2304 + 64 * (j))
#define XB_TOP      3328
#define XB_TOPGEN   3392
#define XCD_BAR_WORDS 3456
#define XB_SPIN_CAP (1u << 18)

__device__ __forceinline__ unsigned xb_ld(unsigned* p)              { return __hip_atomic_load(p, __ATOMIC_RELAXED, __HIP_MEMORY_SCOPE_AGENT); }
__device__ __forceinline__ unsigned xb_add(unsigned* p, unsigned v) { return __hip_atomic_fetch_add(p, v, __ATOMIC_RELAXED, __HIP_MEMORY_SCOPE_AGENT); }
__device__ __forceinline__ unsigned xb_xcc_id() { return (unsigned)__builtin_amdgcn_s_getreg((3 << 11) | 20) & 0xFu; }
#define XB_SPIN(cond, bar) do { unsigned _sp = 0; while (cond) { __builtin_amdgcn_s_sleep(1); \
    if ((++_sp & 255u) == 0u) { if (xb_ld(&(bar)[XB_TMO])) break; if (_sp > XB_SPIN_CAP) { atomicAdd(&(bar)[XB_TMO], 1u); break; } } } } while (0)

struct XcdBarrier {
    unsigned* bar; unsigned x;
    volatile LAS unsigned* st;
};

__device__ __forceinline__ XcdBarrier xcd_barrier_post(unsigned* bar, volatile LAS unsigned* st) {
    XcdBarrier b; b.bar = bar; b.x = xb_xcc_id(); b.st = st;
    if (threadIdx.x == 0) (void)xb_add(&bar[XB_XCNT(b.x)], 1u);
    return b;
}
__device__ __forceinline__ void xcd_barrier_complete(unsigned* bar, unsigned x, unsigned& nloc, unsigned& nx) {
    const unsigned G = gridDim.x * gridDim.y * gridDim.z;
    unsigned sum, cnt, mine, sp = 0u;
    for (;;) {
        sum = 0u; cnt = 0u; mine = 0u;
#pragma unroll
        for (unsigned j = 0; j < 16; ++j) { const unsigned c = xb_ld(&bar[XB_XCNT(j)]); sum += c; cnt += (c > 0u) ? 1u : 0u; mine = (j == x) ? c : mine; }
        if (sum == G) break;
        __builtin_amdgcn_s_sleep(1);
        if ((++sp & 255u) == 0u) { if (xb_ld(&bar[XB_TMO])) break; if (sp > XB_SPIN_CAP) { atomicAdd(&bar[XB_TMO], 1u); break; } }
    }
    nloc = mine > 0u ? mine : 1u; nx = cnt > 0u ? cnt : 1u;
}

__device__ __forceinline__ void xcd_barrier(const XcdBarrier& b) {
    asm volatile("s_waitcnt vmcnt(0)" ::: "memory");
    __syncthreads();
    if (threadIdx.x == 0) {
        unsigned* bar = b.bar;
        __builtin_amdgcn_s_waitcnt(0);
        unsigned nloc = b.st[0], nx = b.st[1];
        if (nloc == 0u) { xcd_barrier_complete(bar, b.x, nloc, nx); b.st[0] = nloc; b.st[1] = nx; }
        const unsigned old = xb_add(&bar[XB_XSUB(b.x)], 1u);
        const unsigned gen = old / nloc;
        if (old + 1u == (gen + 1u) * nloc) {
            __builtin_amdgcn_fence(__ATOMIC_RELEASE, "agent");
            asm volatile("s_waitcnt vmcnt(0)" ::: "memory");
            const unsigned og = xb_add(&bar[XB_TOP], 1u);
            const unsigned tg = og / nx;
            if (og + 1u == (tg + 1u) * nx) xb_add(&bar[XB_TOPGEN], 1u);
            else XB_SPIN(xb_ld(&bar[XB_TOPGEN]) == tg, bar);
            __builtin_amdgcn_fence(__ATOMIC_ACQUIRE, "agent");
            xb_add(&bar[XB_XGEN(b.x)], 1u);
            asm volatile("s_waitcnt vmcnt(0)" ::: "memory");
        } else {
            XB_SPIN(xb_ld(&bar[XB_XGEN(b.x)]) == gen, bar);
            __builtin_amdgcn_fence(__ATOMIC_ACQUIRE, "agent");
            asm volatile("s_waitcnt vmcnt(0)" ::: "memory");
        }
    }
    __syncthreads();
}

__device__ __forceinline__ int next_unit(unsigned* ctr, unsigned char* lds) {
    volatile int* sw = (volatile int*)(lds + LDS_SCHED);
    if (threadIdx.x == 0) *sw = (int)atomicAdd(ctr, 1u);
    __syncthreads();
    const int u = *sw;
    __syncthreads();
    return u;
}

__global__ void __launch_bounds__(NTHREADS, 2) hybrid_fwd(KArgs a) {
    extern __shared__ __attribute__((aligned(16))) unsigned char lds[];
    cg::grid_group grid = cg::this_grid();
    unsigned char* ws = a.ws;
    const int lo = a.ph_lo, hi = a.ph_hi;
#ifndef PHMASK
#define PHMASK 0xfff
#endif
#define IN(k) (((PHMASK >> ((k) > 5 && (k) < 11 ? (k) - 5 : (k))) & 1) && lo <= (k) && (k) < hi)
#define SEAM(k) do { if (IN(k) && IN((k) + 1)) xcd_barrier(xbar); } while (0)
#ifndef REP_PHASE
#define REP_PHASE -1
#endif
#define REPS(j) for (int rep = 0, nrep = (REP_PHASE == (j)) ? 2 : 1; rep < nrep; ++rep, (rep < nrep ? xcd_barrier(xbar) : (void)0))
    bf16_t* HX = (bf16_t*)(ws + WS_HX); bf16_t* Pb = (bf16_t*)(ws + WS_P); bf16_t* Vt = (bf16_t*)(ws + WS_VT); bf16_t* Hb = (bf16_t*)(ws + WS_H);
    bf16_t* Yb = (bf16_t*)(ws + WS_Y); bf16_t* YF = (bf16_t*)(ws + WS_YF); float* SSQ = (float*)(ws + WS_SSQ);
    unsigned* ctl = (unsigned*)(ws + WS_CTL);

    if (threadIdx.x < 2) ((volatile LAS unsigned*)(lds + LDS_BARST))[threadIdx.x] = 0u;
    __syncthreads();
    const XcdBarrier xbar = xcd_barrier_post((unsigned*)(ws + WS_BAR), (volatile LAS unsigned*)(lds + LDS_BARST));
    if (a.ph_lo < 0) grid.sync();
    REPS(30) if (IN(0)) p0_prologue(a, lds);
    SEAM(0);
    for (int l = 0; l < 2; ++l) {
        const int pb = 1 + 5 * l;
        REPS(0) if (IN(pb)) norm_phase(a, l);
        SEAM(pb);
        REPS(1) if (IN(pb + 1)) {
            pg8::Gemm g{HX, (const bf16_t*)(ws + WS_WIN) + (size_t)l * PW * DM, MROWS, PW, DM};
            pg8::StaticOrder S; S.init(MROWS, PW, (int)gridDim.x, (int)blockIdx.x);
            pg8::EpiProj E{Pb, Vt, (const float*)(ws + WS_ROPE), (bf16_t*)(ws + WS_UFP), 0.125f * LOG2E};
            pg8::gemm_phase<pg8::EpiProj, pg8::StaticOrder, true, true>((PG8_LAS unsigned char*)lds, g, S, E);
        }
        SEAM(pb + 1);
        for (int rep = 0, nrep = (REP_PHASE >= 20 && REP_PHASE < 30) ? 2 : 1; rep < nrep; ++rep, (rep < nrep ? xcd_barrier(xbar) : (void)0)) if (IN(pb + 2)) {
            const int nAttn = (l == 0) ? 1056 : 1024, nCtxF = (l == 0) ? 16 : 0, nF1 = 256, nConv = ((l == 0) ? MROWS : NTOK) / 64;
            const int e0 = nF1, e1 = e0 + nCtxF, e2 = e1 + nAttn, e3 = e2 + nConv;
            for (;;) {
                const int u = next_unit(ctl + 2 * l + 8 * rep, lds);
                if (u >= e3) break;
                if (rep == 1) { const int ty = u < e0 ? 1 : u < e1 ? 3 : u < e2 ? 0 : 2; if (REP_PHASE == 25 ? (ty == 0) : (ty != REP_PHASE - 20)) continue; }
                if (u >= e1 && u < e2) attn_unit(u - e1, Pb, Vt, Hb, a.sink + 8 * l, lds);
                else if (u >= e0 && u < e1) { const int v = u - e0, b = v >> 2, kb = v & 3;
                    dftf_unit<256>(Pb + (size_t)(NTOK + b * CTXL) * PW + C_UF, 256, PW, 0, (const bf16_t*)(ws + WS_T256R) + (size_t)(64 * kb) * 256, (const bf16_t*)(ws + WS_T256I) + (size_t)(64 * kb) * 256,
                                   (const bf16_t*)(ws + WS_GT) + (size_t)l * 4 * 64 * 128, Pb, Hb, (size_t)(NTOK + b * CTXL + 64 * kb), 1, 5.656854249492381f, lds); }
                else {
                    const int tid = opaque_tid(), lane = tid & 63, wave = __builtin_amdgcn_readfirstlane(tid >> 6);
                    if (u < e0) fft1_wave(u * 8 + wave, (const bf16_t*)(ws + WS_UFP), YF, ws, lds + wave * 16384, lane);
                    else conv_wave((u - e2) * 8 + wave, Pb, Hb, a.conv_w + l * 768, a.conv_b + l * 256, lane);
                }
            }
        }
        SEAM(pb + 2);
        REPS(3) if (IN(pb + 3)) {
            const bool gemmwg = (l == 0 && blockIdx.x < 16);
            if (gemmwg) {
                pg8::Gemm g{Hb + (size_t)NTOK * DM, (const bf16_t*)(ws + WS_WOUT) + (size_t)l * DM * DM, NCTX, DM, DM};
                pg8::StaticOrder S; S.init(NCTX, DM, 16, (int)blockIdx.x);
                pg8::EpiY E{Yb + (size_t)NTOK * DM, SSQ + (size_t)NTOK * 16};
                pg8::gemm_phase<pg8::EpiY, pg8::StaticOrder, true, true>((PG8_LAS unsigned char*)lds, g, S, E);
            } else {
                const int tid = opaque_tid(), lane = tid & 63, wave = __builtin_amdgcn_readfirstlane(tid >> 6);
                const int nb0 = (l == 0) ? 16 : 0;
                const int gw = ((int)blockIdx.x - nb0) + wave * ((int)gridDim.x - nb0), NGW = ((int)gridDim.x - nb0) * 8;
                unsigned char* lds_w = lds + wave * 16384;
                for (int t = gw; t < 2048; t += NGW) fft3_wave(t, YF, (const bf16_t*)(ws + WS_GT) + (size_t)l * 4 * 64 * 128, Pb, Hb, ws, lds_w, lane);
            }
            __syncthreads();
        }
        SEAM(pb + 3);
        REPS(4) if (IN(pb + 4)) {
            pg8::Gemm g{Hb, (const bf16_t*)(ws + WS_WOUT) + (size_t)l * DM * DM, NTOK, DM, DM};
            pg8::StaticOrder S; S.init(NTOK, DM, (int)gridDim.x, (int)blockIdx.x);
            pg8::EpiY E{Yb, SSQ};
            pg8::gemm_phase<pg8::EpiY, pg8::StaticOrder, true, true>((PG8_LAS unsigned char*)lds, g, S, E);
        }
        SEAM(pb + 4);
    }
#if REP_PHASE == 9
    for (int i = 0; i < 10; ++i) xcd_barrier(xbar);
#endif
    if (IN(11)) norm_phase(a, 2);
#undef IN
#undef SEAM
}

#ifndef MK_MULTI
#define MK_MULTI 0
#endif
extern "C" void kernel_launch(void* const* d_in, const int* in_sizes, int n_in, void* d_out, int out_size, void* d_ws, size_t ws_size, hipStream_t stream) {
    static int grid = 0;
    if (grid == 0) {
        if (n_in != 14 || ws_size < WS_END) { fprintf(stderr, "kernel_launch: unexpected n_in %d or ws_size %zu (need %zu)\n", n_in, ws_size, (size_t)WS_END); grid = -1; return; }
        int dev = 0, cus = 0, per_cu = 0;
        hipGetDevice(&dev); hipDeviceGetAttribute(&cus, hipDeviceAttributeMultiprocessorCount, dev);
        if (hipFuncSetAttribute((const void*)hybrid_fwd, hipFuncAttributeMaxDynamicSharedMemorySize, LDS_BYTES) != hipSuccess) { fprintf(stderr, "kernel_launch: hipFuncSetAttribute failed\n"); grid = -1; return; }
        if (hipOccupancyMaxActiveBlocksPerMultiprocessor(&per_cu, (const void*)hybrid_fwd, NTHREADS, LDS_BYTES) != hipSuccess || per_cu < 1) { fprintf(stderr, "kernel_launch: occupancy query gave %d\n", per_cu); per_cu = 1; }
        (void)hipGetLastError();
        grid = cus * 1;
        fprintf(stderr, "kernel_launch: grid %d (cus %d, per_cu %d)\n", grid, cus, per_cu);
    }
    if (grid < 0) return;
    if (hipMemsetAsync((char*)d_ws + WS_CTL, 0, WS_ZERO_BYTES, stream) != hipSuccess) { fprintf(stderr, "kernel_launch: hipMemsetAsync failed\n"); return; }
    KArgs a{};
    a.x = (const float*)d_in[0]; a.c = (const float*)d_in[1]; a.ctx = (const float*)d_in[2]; a.c_ctx = (const float*)d_in[3]; a.w_mod = (const float*)d_in[4]; a.b_mod = (const float*)d_in[5];
    a.g_pre = (const float*)d_in[6]; a.g_post = (const float*)d_in[7]; a.w_in = (const float*)d_in[8]; a.w_out = (const float*)d_in[9]; a.sink = (const float*)d_in[10]; a.w_f = (const float*)d_in[11];
    a.conv_w = (const float*)d_in[12]; a.conv_b = (const float*)d_in[13];
    a.out = (float*)d_out; a.ws = (unsigned char*)d_ws;
#if MK_MULTI
    for (int ph = 0; ph < 12; ++ph) { a.ph_lo = ph; a.ph_hi = ph + 1; hipLaunchKernelGGL(hybrid_fwd, dim3(grid), dim3(NTHREADS), LDS_BYTES, stream, a); }
#else
    a.ph_lo = 0; a.ph_hi = 12;
    void* args[] = {&a};
    hipError_t e = hipLaunchCooperativeKernel((const void*)hybrid_fwd, dim3(grid), dim3(NTHREADS), args, LDS_BYTES, stream);
    if (e != hipSuccess) fprintf(stderr, "kernel_launch: cooperative launch failed: %s (grid %d)\n", hipGetErrorString(e), grid);
#endif
}
```

```cpp
#include <hip/hip_runtime.h>
#include <hip/hip_cooperative_groups.h>
#include <cstdio>
#include <cstdint>
namespace cg = cooperative_groups;
namespace pg8 {
#define PG8_LAS __attribute__((address_space(3)))
typedef unsigned short bf16_t;
typedef short bf16x8 __attribute__((ext_vector_type(8)));
typedef float f32x4 __attribute__((ext_vector_type(4)));
typedef unsigned u32x4 __attribute__((ext_vector_type(4)));
constexpr int BM = 256, BK = 64, HALF = 128, HTB = HALF * BK * 2  , STAGE_BYTES = 8 * HTB, NXCD = 8, WGM = 8;

__host__ __device__ __forceinline__ int lds_byte(int r, int c) { const int st = (r >> 4) * 2 + (c >> 5), rr = r & 15, cc = c & 31, ob = rr * 64 + cc * 2; return st * 1024 + (ob ^ (((ob >> 9) & 1) << 5)); }
__host__ __device__ __forceinline__ void stage_rc(int b, int& R, int& C) { const int st = b / 1024, sb = b % 1024, swz = sb ^ (((sb >> 9) & 1) << 5); R = (st >> 1) * 16 + swz / 64; C = (st & 1) * 32 + (swz % 64) / 2; }
__host__ __device__ __forceinline__ int perm32(int rho) { const int n = rho >> 4, i = rho & 15; return 8 * (i >> 2) + 4 * n + (i & 3); }

struct Unit { int pm, pn; };
struct Gemm { const bf16_t* A; const bf16_t* Bt; int M, N, K; };

struct StaticOrder {
    int nM, nN, nwg, G, c;
    __host__ __device__ void init(int M, int N, int G_, int c_) { nM = M / BM; nN = N / BM; nwg = nM * nN; G = G_; c = c_; }
    __host__ __device__ bool next(int i, Unit& u) const {
        const long L = (long)i * G + c; if (L >= nwg) return false;
        int wgid = (int)L; { const int q = nwg / NXCD, r = nwg % NXCD, xcd = wgid % NXCD, off = wgid / NXCD; wgid = (xcd < r ? xcd * (q + 1) : r * (q + 1) + (xcd - r) * q) + off; }
        const int nig = WGM * nN, gid = wgid / nig, fm = gid * WGM, gsz = (nM - fm) < WGM ? (nM - fm) : WGM;
        u.pm = fm + ((wgid % nig) % gsz); u.pn = (wgid % nig) / gsz; return true;
    }
    __device__ __forceinline__ void a_ready(const Unit&) const {}
    __device__ __forceinline__ void done(const Unit&) const {}
};

__device__ __forceinline__ unsigned cvt_pk_bf16(float lo, float hi) { unsigned r; asm volatile("v_cvt_pk_bf16_f32 %0, %1, %2" : "=v"(r) : "v"(lo), "v"(hi)); return r; }
typedef unsigned u32x2 __attribute__((ext_vector_type(2)));
__device__ __forceinline__ int swap23(int t) { return (t & ~12) | ((t & 4) << 1) | ((t & 8) >> 1); }
struct EpiProj {
    static constexpr bool PERM = true, AFTER_DRAIN = false;
    bf16_t* P; bf16_t* Vt; const float* rope; bf16_t* UFP; float qscale;
    __device__ __forceinline__ void operator()(const f32x4 (&acc)[2][2][4][2], const Unit& u, int wr, int wc, int fr, int fq) const {
        const int row0 = u.pm * BM + wr * 64 + fr;
        const int pn = u.pn;
        const bool ctxrow = u.pm >= 128;
        f32x4 CS[2][4], SN[2][4];
        if (pn <= 2) {
#pragma unroll
            for (int ai = 0; ai < 2; ++ai)
#pragma unroll
                for (int m = 0; m < 4; ++m) {
                    CS[ai][m] = (f32x4){1.f, 1.f, 1.f, 1.f}; SN[ai][m] = (f32x4){0.f, 0.f, 0.f, 0.f};
                    if (!ctxrow) { const int t = (row0 + ai * HALF + m * 16) & 8191; const int pos = (wc & 1) ? (t & 63) : (t >> 6);
                        CS[ai][m] = *(const f32x4*)(rope + pos * 32 + 4 * fq); SN[ai][m] = *(const f32x4*)(rope + pos * 32 + 16 + 4 * fq); }
                }
            __builtin_amdgcn_sched_barrier(0);
        }
#pragma unroll
        for (int ai = 0; ai < 2; ++ai)
#pragma unroll
            for (int m = 0; m < 4; ++m) {
                const int row = row0 + ai * HALF + m * 16;
                bf16_t* rowp = P + (size_t)row * 2816 + pn * BM + wc * 32 + 8 * fq;
                if (pn == 5 && !ctxrow) { const int t = row & 8191; rowp = UFP + ((size_t)(((row >> 13) * 64 + (t & 63)) * 128 + (t >> 6))) * 256 + wc * 32 + 8 * fq; }
                if (pn > 2) {
#pragma unroll
                    for (int bj = 0; bj < 2; ++bj) { const f32x4 v0 = acc[ai][bj][m][0], v1 = acc[ai][bj][m][1];
                        u32x4 w; w.x = cvt_pk_bf16(v0[0], v0[1]); w.y = cvt_pk_bf16(v0[2], v0[3]); w.z = cvt_pk_bf16(v1[0], v1[1]); w.w = cvt_pk_bf16(v1[2], v1[3]);
                        *(u32x4*)(rowp + bj * HALF) = w; }
                } else {
                    const f32x4 cs = CS[ai][m], sn = SN[ai][m];
#pragma unroll
                    for (int bj = 0; bj < 2; ++bj) {
                        f32x4 v0 = acc[ai][bj][m][0], v1 = acc[ai][bj][m][1];
                        if (pn == 2 && bj == 1) {
                            int b, tok; if (ctxrow) { const int rr = row - 32768; b = rr >> 8; tok = 8192 + (rr & 255); } else { b = row >> 13; tok = row & 8191; }
                            const int ptok = swap23(tok);
                            bf16_t* vp = Vt + ((size_t)((b * 2 + (wc >> 1)) * 64 + 32 * (wc & 1) + 8 * fq)) * 8448 + ptok;
                            const unsigned w0 = cvt_pk_bf16(v0[0], v0[1]), w1 = cvt_pk_bf16(v0[2], v0[3]), w2 = cvt_pk_bf16(v1[0], v1[1]), w3 = cvt_pk_bf16(v1[2], v1[3]);
                            vp[0 * 8448] = (bf16_t)(w0 & 0xffffu); vp[1 * 8448] = (bf16_t)(w0 >> 16); vp[2 * 8448] = (bf16_t)(w1 & 0xffffu); vp[3 * 8448] = (bf16_t)(w1 >> 16);
                            vp[4 * 8448] = (bf16_t)(w2 & 0xffffu); vp[5 * 8448] = (bf16_t)(w2 >> 16); vp[6 * 8448] = (bf16_t)(w3 & 0xffffu); vp[7 * 8448] = (bf16_t)(w3 >> 16);
                        } else {
                            const f32x4 r0 = v0 * cs - v1 * sn, r1 = v0 * sn + v1 * cs;
                            v0 = r0; v1 = r1;
                            if (pn < 2) { v0 = v0 * qscale; v1 = v1 * qscale; }
                            u32x4 w; w.x = cvt_pk_bf16(v0[0], v0[1]); w.y = cvt_pk_bf16(v0[2], v0[3]); w.z = cvt_pk_bf16(v1[0], v1[1]); w.w = cvt_pk_bf16(v1[2], v1[3]);
                            *(u32x4*)(rowp + bj * HALF) = w;
                        }
                    }
                }
            }
    }
};
struct EpiY {
    static constexpr bool PERM = true, AFTER_DRAIN = false;
    bf16_t* Y; float* ssq;
    __device__ __forceinline__ void operator()(const f32x4 (&acc)[2][2][4][2], const Unit& u, int wr, int wc, int fr, int fq) const {
        const int row0 = u.pm * BM + wr * 64 + fr;
#pragma unroll
        for (int ai = 0; ai < 2; ++ai)
#pragma unroll
            for (int m = 0; m < 4; ++m) {
                const int row = row0 + ai * HALF + m * 16;
                bf16_t* rowp = Y + (size_t)row * 1024 + u.pn * BM + wc * 32 + 8 * fq;
                float s = 0.f;
#pragma unroll
                for (int bj = 0; bj < 2; ++bj) { const f32x4 v0 = acc[ai][bj][m][0], v1 = acc[ai][bj][m][1];
                    s += (v0[0] * v0[0] + v0[1] * v0[1]) + (v0[2] * v0[2] + v0[3] * v0[3]) + (v1[0] * v1[0] + v1[1] * v1[1]) + (v1[2] * v1[2] + v1[3] * v1[3]);
                    u32x4 w; w.x = cvt_pk_bf16(v0[0], v0[1]); w.y = cvt_pk_bf16(v0[2], v0[3]); w.z = cvt_pk_bf16(v1[0], v1[1]); w.w = cvt_pk_bf16(v1[2], v1[3]);
                    *(u32x4*)(rowp + bj * HALF) = w; }
                s += __shfl_xor(s, 16); s += __shfl_xor(s, 32);
                if (fq == 0) ssq[(size_t)row * 16 + u.pn * 4 + wc] = s;
            }
    }
};
template <class Epi, class Sched, bool ALIGN_EPI = false, bool SP2 = false>
__device__ __forceinline__ void gemm_phase(PG8_LAS unsigned char* lds, const Gemm g, const Sched& S, const Epi& E) {
    int tid_ = threadIdx.x; asm volatile("" : "+v"(tid_));
    const int tid = tid_, wid = __builtin_amdgcn_readfirstlane(tid >> 6), lane = tid & 63, wr = wid >> 2, wc = wid & 3, fr = lane & 15, fq = lane >> 4;
    const int K = g.K, nt = K / BK;
    unsigned voffA[2], voffB[2];
#pragma unroll
    for (int i = 0; i < 2; ++i) { int R, C; stage_rc(tid * 16 + i * 8192, R, C); const int Rb = Epi::PERM ? ((R & ~31) + perm32(R & 31)) : R;
        voffA[i] = (unsigned)(R * K + C) * 2u; voffB[i] = (unsigned)(Rb * K + C) * 2u; }
    const size_t kstep = (size_t)(BK * 2);
    const size_t hstep = (size_t)HALF * K * 2;
    const size_t tstep = 2 * hstep;
    const unsigned ldsw = (unsigned)wid * 1024u;
    const int aoff = lds_byte(wr * 64 + fr, fq * 8), boff = lds_byte(wc * 32 + fr, fq * 8);
#define PG8_SA(b, h) (((b) * 2 + (h)) * HTB)
#define PG8_SB(b, h) ((4 + (b) * 2 + (h)) * HTB)
#define PG8_STAGE(bufoff, gbase, voff) do { _Pragma("unroll") for (int _i = 0; _i < 2; ++_i) \
        __builtin_amdgcn_global_load_lds((const unsigned*)((const char*)(gbase) + (voff)[_i]), (PG8_LAS unsigned*)(lds + (bufoff) + ldsw + _i * 8192), 16, 0, 0); } while (0)
#define PG8_LDA(dst, b, h) do { _Pragma("unroll") for (int m = 0; m < 4; ++m) _Pragma("unroll") for (int k = 0; k < 2; ++k) dst[m][k] = *(const PG8_LAS bf16x8*)(lds + PG8_SA(b, h) + aoff + m * 2048 + k * 1024); } while (0)
#define PG8_LDB(dst, b, h) do { _Pragma("unroll") for (int n = 0; n < 2; ++n) _Pragma("unroll") for (int k = 0; k < 2; ++k) dst[n][k] = *(const PG8_LAS bf16x8*)(lds + PG8_SB(b, h) + boff + n * 2048 + k * 1024); } while (0)
#define PG8_MMA(ai, bj, At, Bt) do { __builtin_amdgcn_s_setprio(1); _Pragma("unroll") for (int m = 0; m < 4; ++m) _Pragma("unroll") for (int n = 0; n < 2; ++n) _Pragma("unroll") for (int k = 0; k < 2; ++k) \
        acc[ai][bj][m][n] = __builtin_amdgcn_mfma_f32_16x16x32_bf16(Bt[n][k], At[m][k], acc[ai][bj][m][n], 0, 0, 0); __builtin_amdgcn_s_setprio(0); } while (0)
#define PG8_WAIT_V(n) asm volatile("s_waitcnt vmcnt(" #n ")" ::: "memory")
#define PG8_WAIT_L(n) asm volatile("s_waitcnt lgkmcnt(" #n ")" ::: "memory")
#define PG8_BAR __builtin_amdgcn_s_barrier()
#define PG8_SCHED __builtin_amdgcn_sched_barrier(0)
    Unit cur, nxt; int ui = 0;
    if (!S.next(0, cur)) return;
    f32x4 acc[2][2][4][2];
#pragma unroll
    for (int a = 0; a < 2; ++a)
#pragma unroll
        for (int b = 0; b < 2; ++b)
#pragma unroll
            for (int m = 0; m < 4; ++m)
#pragma unroll
                for (int n = 0; n < 2; ++n) acc[a][b][m][n] = (f32x4){0.f, 0.f, 0.f, 0.f};
    bf16x8 At[4][2], B0[2][2], B1[2][2];
    const char* cA = (const char*)g.A + (size_t)cur.pm * tstep; const char* cB = (const char*)g.Bt + (size_t)cur.pn * tstep;
    S.a_ready(cur);
    if constexpr (SP2) {
        PG8_STAGE(PG8_SB(0, 0), cB, voffB); PG8_STAGE(PG8_SB(0, 1), cB + hstep, voffB); PG8_STAGE(PG8_SA(0, 0), cA, voffA); PG8_STAGE(PG8_SA(0, 1), cA + hstep, voffA);
        if (wr == 1) PG8_BAR;
        PG8_WAIT_V(2); PG8_BAR;
        PG8_STAGE(PG8_SB(1, 0), cB + kstep, voffB); PG8_STAGE(PG8_SA(1, 0), cA + kstep, voffA); PG8_STAGE(PG8_SB(1, 1), cB + hstep + kstep, voffB);
        PG8_WAIT_V(6); PG8_BAR;
    } else {
        PG8_STAGE(PG8_SB(0, 0), cB, voffB); PG8_STAGE(PG8_SA(0, 0), cA, voffA); PG8_STAGE(PG8_SB(0, 1), cB + hstep, voffB); PG8_STAGE(PG8_SA(0, 1), cA + hstep, voffA);
        if (wr == 1) PG8_BAR;
        PG8_WAIT_V(4); PG8_BAR;
        PG8_STAGE(PG8_SB(1, 0), cB + kstep, voffB); PG8_STAGE(PG8_SA(1, 0), cA + kstep, voffA); PG8_STAGE(PG8_SB(1, 1), cB + hstep + kstep, voffB);
        PG8_WAIT_V(6); PG8_BAR;
    }
    for (;;) {
        const bool has_next = S.next(ui + 1, nxt);
        const char* nA = has_next ? (const char*)g.A + (size_t)nxt.pm * tstep : cA; const char* nB = has_next ? (const char*)g.Bt + (size_t)nxt.pn * tstep : cB;
        for (int t = 0; t < nt; t += 2) {
            const bool last = (t == nt - 2);
            const char* a1 = cA + (size_t)(t + 1) * kstep;
            const char* a2 = last ? nA : cA + (size_t)(t + 2) * kstep; const char* b2 = last ? nB : cB + (size_t)(t + 2) * kstep;
            const char* a3 = a2 + kstep; const char* b3 = b2 + kstep;
            if (last && has_next) S.a_ready(nxt);
            if constexpr (SP2) {
            PG8_LDB(B0, 0, 0); PG8_LDB(B1, 0, 1); PG8_SCHED; PG8_LDA(At, 0, 0); PG8_STAGE(PG8_SA(1, 1), a1 + hstep, voffA);
            PG8_WAIT_V(8); PG8_WAIT_L(0); PG8_BAR; PG8_MMA(0, 0, At, B0); PG8_MMA(0, 1, At, B1); PG8_BAR; PG8_SCHED;
            PG8_LDA(At, 0, 1); PG8_STAGE(PG8_SB(0, 0), b2, voffB); PG8_STAGE(PG8_SB(0, 1), b2 + hstep, voffB); PG8_STAGE(PG8_SA(0, 0), a2, voffA);
            PG8_WAIT_V(8); PG8_WAIT_L(0); PG8_BAR; PG8_MMA(1, 0, At, B0); PG8_MMA(1, 1, At, B1); PG8_BAR; PG8_SCHED;
            PG8_LDB(B0, 1, 0); PG8_LDB(B1, 1, 1); PG8_SCHED; PG8_LDA(At, 1, 0); PG8_STAGE(PG8_SA(0, 1), a2 + hstep, voffA);
            PG8_WAIT_V(8); PG8_WAIT_L(0); PG8_BAR; PG8_MMA(0, 0, At, B0); PG8_MMA(0, 1, At, B1); PG8_BAR; PG8_SCHED;
            PG8_LDA(At, 1, 1); PG8_STAGE(PG8_SB(1, 0), b3, voffB); PG8_STAGE(PG8_SB(1, 1), b3 + hstep, voffB); PG8_STAGE(PG8_SA(1, 0), a3, voffA);
            PG8_WAIT_V(8); PG8_WAIT_L(0); PG8_BAR; PG8_MMA(1, 0, At, B0); PG8_MMA(1, 1, At, B1); PG8_BAR; PG8_SCHED;
            } else {
            PG8_LDB(B0, 0, 0); PG8_SCHED; PG8_LDA(At, 0, 0); PG8_STAGE(PG8_SA(1, 1), a1 + hstep, voffA);
            PG8_WAIT_L(8); PG8_BAR; PG8_WAIT_L(0); PG8_MMA(0, 0, At, B0); PG8_BAR; PG8_SCHED;
            PG8_LDB(B1, 0, 1); PG8_STAGE(PG8_SB(0, 0), b2, voffB);
            PG8_BAR; PG8_WAIT_L(0); PG8_MMA(0, 1, At, B1); PG8_BAR;
            PG8_LDA(At, 0, 1); PG8_STAGE(PG8_SA(0, 0), a2, voffA);
            PG8_BAR; PG8_WAIT_L(0); PG8_MMA(1, 0, At, B0); PG8_BAR; PG8_SCHED;
            PG8_STAGE(PG8_SB(0, 1), b2 + hstep, voffB);
            PG8_WAIT_V(6); PG8_BAR; PG8_MMA(1, 1, At, B1); PG8_BAR;
            PG8_LDB(B0, 1, 0); PG8_SCHED; PG8_LDA(At, 1, 0); PG8_STAGE(PG8_SA(0, 1), a2 + hstep, voffA);
            PG8_WAIT_L(8); PG8_BAR; PG8_WAIT_L(0); PG8_MMA(0, 0, At, B0); PG8_BAR; PG8_SCHED;
            PG8_LDB(B1, 1, 1); PG8_STAGE(PG8_SB(1, 0), b3, voffB);
            PG8_BAR; PG8_WAIT_L(0); PG8_MMA(0, 1, At, B1); PG8_BAR;
            PG8_LDA(At, 1, 1); PG8_STAGE(PG8_SA(1, 0), a3, voffA);
            PG8_BAR; PG8_WAIT_L(0); PG8_MMA(1, 0, At, B0); PG8_BAR; PG8_SCHED;
            PG8_STAGE(PG8_SB(1, 1), b3 + hstep, voffB);
            PG8_WAIT_V(6); PG8_BAR; PG8_MMA(1, 1, At, B1); PG8_BAR;
            }
        }
        if constexpr (ALIGN_EPI) { if (wr == 0) PG8_BAR; }
        if constexpr (!Epi::AFTER_DRAIN) { E(acc, cur, wr, wc, fr, fq); S.done(cur); }
        if (!has_next) break;
#pragma unroll
        for (int a = 0; a < 2; ++a)
#pragma unroll
            for (int b = 0; b < 2; ++b)
#pragma unroll
                for (int m = 0; m < 4; ++m)
#pragma unroll
                    for (int n = 0; n < 2; ++n) acc[a][b][m][n] = (f32x4){0.f, 0.f, 0.f, 0.f};
        cur = nxt; cA = nA; cB = nB; ++ui;
        if constexpr (ALIGN_EPI) { if (wr == 1) PG8_BAR; }
    }
    PG8_WAIT_V(0);
    if constexpr (!ALIGN_EPI) { if (wr == 0) PG8_BAR; }
    PG8_BAR;
    if constexpr (Epi::AFTER_DRAIN) { E.fused(acc, cur, wr, wc, fr, fq, lds, wid, lane); S.done(cur); }
#undef PG8_SA
#undef PG8_SB
#undef PG8_STAGE
#undef PG8_LDA
#undef PG8_LDB
#undef PG8_MMA
#undef PG8_WAIT_V
#undef PG8_WAIT_L
#undef PG8_BAR
#undef PG8_SCHED
}
}

typedef unsigned short bf16_t;
typedef short bf16x8 __attribute__((ext_vector_type(8)));
typedef float f32x4 __attribute__((ext_vector_type(4)));
typedef float f32x16 __attribute__((ext_vector_type(16)));
typedef unsigned u32x4 __attribute__((ext_vector_type(4)));
typedef unsigned u32x2 __attribute__((ext_vector_type(2)));
#define LAS __attribute__((address_space(3)))
__device__ __forceinline__ int opaque_tid() { int t = threadIdx.x; asm volatile("" : "+v"(t)); return t; }

constexpr int DM = 1024, NBATCH = 4, SEQ = 8192, NTOK = NBATCH * SEQ, CTXL = 256, NCTX = NBATCH * CTXL, MROWS = NTOK + NCTX;
constexpr int PW = 2816;
constexpr int C_Q = 0, C_K = 512, C_V = 640, C_GA = 768, C_UF = 1280, C_GF = 1536, C_ZC = 1792, C_BC = 2048, C_CC = 2304, C_GC = 2560;
constexpr int VT_PITCH = SEQ + CTXL;
constexpr float NORM_EPS = 1e-6f;
constexpr float LOG2E = 1.4426950408889634f;

constexpr size_t KiB = 1024, MiB = 1u << 20;
constexpr size_t WS_CTL = 0;
constexpr size_t WS_BAR = 16 * KiB;
constexpr size_t WS_ZERO_BYTES = 32 * KiB;
constexpr size_t WS_MOD = 64 * KiB;
constexpr size_t WS_ROPE = 256 * KiB;
constexpr size_t WS_TW = 320 * KiB;
constexpr size_t WS_T1R = 384 * KiB, WS_T1I = 416 * KiB;
constexpr size_t WS_T3R = 448 * KiB, WS_T3I = 464 * KiB;
constexpr size_t WS_T256R = 512 * KiB, WS_T256I = 640 * KiB;
constexpr size_t WS_GT = 768 * KiB;
constexpr size_t WS_SSQ = 1 * MiB;
constexpr size_t WS_WIN = 4 * MiB;
constexpr size_t WS_WOUT = 16 * MiB;
constexpr size_t WS_MODP = 24 * MiB;
constexpr size_t WS_HX = 32 * MiB;
constexpr size_t WS_P = 112 * MiB;
constexpr size_t WS_VT = 304 * MiB;
constexpr size_t WS_H = 320 * MiB;
constexpr size_t WS_Y = 392 * MiB;
constexpr size_t WS_YF = 464 * MiB;
constexpr size_t WS_CTX1 = 100 * MiB;
constexpr size_t WS_UFP = 496 * MiB;
constexpr size_t WS_END = 512 * MiB;
static_assert(WS_BAR + 3456 * 4 <= WS_ZERO_BYTES && WS_MODP + (size_t)2 * 8 * 5 * 3072 * 4 <= WS_HX && WS_SSQ + (size_t)MROWS * 16 * 4 <= WS_WIN && WS_WIN + (size_t)2 * PW * DM * 2 <= WS_WOUT && WS_HX + (size_t)MROWS * DM * 2 <= WS_P && WS_P + (size_t)MROWS * PW * 2 <= WS_VT &&
              WS_VT + (size_t)8 * 64 * VT_PITCH * 2 <= WS_H && WS_H + (size_t)MROWS * DM * 2 <= WS_Y && WS_Y + (size_t)MROWS * DM * 2 <= WS_YF && WS_YF + (size_t)4 * 128 * 64 * 512 * 2 <= WS_UFP && WS_UFP + (size_t)NTOK * 256 * 2 <= WS_END && WS_HX + (size_t)MROWS * DM * 2 <= WS_CTX1 && WS_CTX1 + (size_t)NCTX * DM * 4 <= WS_P, "ws map");

constexpr int LDS_BYTES = 147456;
constexpr int LDS_SCHED = LDS_BYTES - 64;
constexpr int LDS_BARST = LDS_BYTES - 32;
constexpr int NTHREADS = 512;

__device__ __forceinline__ float bf2f(unsigned h) { return __uint_as_float(h << 16); }
__device__ __forceinline__ unsigned pkbf(float lo, float hi) { unsigned r; asm volatile("v_cvt_pk_bf16_f32 %0, %1, %2" : "=v"(r) : "v"(lo), "v"(hi)); return r; }
__device__ __forceinline__ float silu_f(float x) { return x * __builtin_amdgcn_rcpf(1.f + __builtin_amdgcn_exp2f(-x * LOG2E)); }
__device__ __forceinline__ float wave_sum(float v) {
#pragma unroll
    for (int o = 1; o < 64; o <<= 1) v += __shfl_xor(v, o);
    return v;
}
__device__ __forceinline__ int swap23(int t) { return (t & ~12) | ((t & 4) << 1) | ((t & 8) >> 1); }
__device__ __forceinline__ int crow(int r, int hi) { return (r & 3) + 8 * (r >> 2) + 4 * hi; }
__device__ __forceinline__ bf16x8 pack8(const f32x16& p, int base) {
    u32x4 w; w.x = pkbf(p[base + 0], p[base + 1]); w.y = pkbf(p[base + 2], p[base + 3]); w.z = pkbf(p[base + 4], p[base + 5]); w.w = pkbf(p[base + 6], p[base + 7]);
    return __builtin_bit_cast(bf16x8, w);
}
#define MFMA32(a, b, c) __builtin_amdgcn_mfma_f32_32x32x16_bf16((a), (b), (c), 0, 0, 0)

struct KArgs {
    const float *x, *c, *ctx, *c_ctx, *w_mod, *b_mod, *g_pre, *g_post, *w_in, *w_out, *sink, *w_f, *conv_w, *conv_b;
    float* out; unsigned char* ws; int ph_lo, ph_hi;
};

__device__ __forceinline__ int prow_qk(int n) { return (n & ~31) | (8 * ((n >> 2) & 3) + 4 * ((n >> 4) & 1) + (n & 3)); }
__device__ __forceinline__ void p0_transpose_item(const float* W, int K, int N, bf16_t* WT, int nperm, float* scr, int item, int lane) {
    const int nblk = N / 32, kb = item / nblk, nb = item % nblk, k0 = 64 * kb, n0 = 32 * nb;
#pragma unroll 8
    for (int i = 0; i < 32; ++i) { const int kk = 2 * i + (lane >> 5); scr[kk * 33 + (lane & 31)] = W[(size_t)(k0 + kk) * N + n0 + (lane & 31)]; }
    asm volatile("s_waitcnt lgkmcnt(0)" ::: "memory");
    const int c = lane & 7;
#pragma unroll
    for (int j = 0; j < 4; ++j) { const int n = (lane >> 3) + 8 * j; const float* s = scr + (8 * c) * 33 + n;
        u32x4 o; o.x = pkbf(s[0 * 33], s[1 * 33]); o.y = pkbf(s[2 * 33], s[3 * 33]); o.z = pkbf(s[4 * 33], s[5 * 33]); o.w = pkbf(s[6 * 33], s[7 * 33]);
        const int nl = n0 + n; const int np = nl < nperm ? prow_qk(nl) : nl;
        *(u32x4*)(WT + (size_t)np * K + k0 + 8 * c) = o; }
    asm volatile("s_waitcnt lgkmcnt(0)" ::: "memory");
}

__device__ __forceinline__ void p0_mod_gemv(const KArgs& a, int item, float* ldsf) {
    const int tid = opaque_tid(), lane = tid & 63, wave = tid >> 6;
    const int l = item / 96, col0 = (item % 96) * 32;
    float* s = ldsf;
    float* red = ldsf + 5 * 1024;
    for (int i = tid; i < 5 * 1024; i += NTHREADS) { const int bb = i >> 10, k = i & 1023; const float v = bb < 4 ? a.c[bb * 1024 + k] : a.c_ctx[k]; s[i] = v / (1.f + __expf(-v)); }
    __syncthreads();
    const int col = lane & 31, kh = lane >> 5;
    const float* W = a.w_mod + (size_t)l * 1024 * 3072 + (size_t)(wave * 128 + kh) * 3072 + col0 + col;
    float w[64];
#pragma unroll
    for (int i = 0; i < 64; ++i) w[i] = W[(size_t)(2 * i) * 3072];
    float acc[5] = {0.f, 0.f, 0.f, 0.f, 0.f};
#pragma unroll
    for (int i = 0; i < 64; ++i)
#pragma unroll
        for (int bb = 0; bb < 5; ++bb) acc[bb] += w[i] * s[bb * 1024 + wave * 128 + 2 * i + kh];
#pragma unroll
    for (int bb = 0; bb < 5; ++bb) red[((wave * 2 + kh) * 5 + bb) * 32 + col] = acc[bb];
    __syncthreads();
    if (tid < 160) { const int bb = tid >> 5, cc = tid & 31; float v = a.b_mod[l * 3072 + col0 + cc];
#pragma unroll
        for (int ww = 0; ww < 16; ++ww) v += red[(ww * 5 + bb) * 32 + cc];
        ((float*)(a.ws + WS_MOD))[(l * 5 + bb) * 3072 + col0 + cc] = v; }
    __syncthreads();
}

__device__ __forceinline__ void p0_prologue(const KArgs& a, unsigned char* lds) {
    const int tid = opaque_tid(), lane = tid & 63, wave = tid >> 6;
    const int G = gridDim.x, bx = blockIdx.x;
    unsigned char* ws = a.ws;
    if (bx < 192) p0_mod_gemv(a, bx, (float*)lds);
    {
        float* scr = (float*)(lds + wave * 16384);
        const int gw = bx * 8 + wave, NGW = G * 8;
        constexpr int I_IN = (DM / 64) * (PW / 32), I_OUT = (DM / 64) * (DM / 32);
        constexpr int NIT = 2 * (I_IN + I_OUT);
        for (int it = gw; it < NIT; it += NGW) {
            int r = it; const int l = r / (I_IN + I_OUT); r -= l * (I_IN + I_OUT);
            if (r < I_IN) p0_transpose_item(a.w_in + (size_t)l * DM * PW, DM, PW, (bf16_t*)(ws + WS_WIN) + (size_t)l * PW * DM, 640, scr, r, lane);
            else p0_transpose_item(a.w_out + (size_t)l * DM * DM, DM, DM, (bf16_t*)(ws + WS_WOUT) + (size_t)l * DM * DM, 0, scr, r - I_IN, lane);
        }
    }
    const int gt = bx * NTHREADS + tid, NGT = G * NTHREADS;
    for (int i = gt; i < 128 * 16; i += NGT) {
        const int pos = i >> 4, f = i & 15; const float inv = powf(10000.0f, -(float)f / 16.0f); const float ang = (float)pos * inv;
        float* rp = (float*)(ws + WS_ROPE) + pos * 32; rp[f] = cosf(ang); rp[16 + f] = sinf(ang);
    }
    for (int i = gt; i < 8192; i += NGT) { float sn, cs; sincospif((float)i * (2.0f / 8192.0f), &sn, &cs); float* t = (float*)(ws + WS_TW) + 2 * i; t[0] = cs; t[1] = sn; }
    for (int i = gt; i < 128 * 128; i += NGT) { const int k = i >> 7, n = i & 127; float sn, cs; sincospif((float)((k * n) & 127) * (2.0f / 128.0f), &sn, &cs);
        ((bf16_t*)(ws + WS_T1R))[i] = (bf16_t)(pkbf(cs, 0.f) & 0xffffu); ((bf16_t*)(ws + WS_T1I))[i] = (bf16_t)(pkbf(-sn, 0.f) & 0xffffu); }
    for (int i = gt; i < 64 * 128; i += NGT) { const int k = i >> 7, kk = i & 127, n = kk & 63; float sn, cs; sincospif((float)((k * n) & 63) * (2.0f / 64.0f), &sn, &cs);
        const float tr = kk < 64 ? cs : sn, ti = kk < 64 ? -sn : cs;
        ((bf16_t*)(ws + WS_T3R))[i] = (bf16_t)(pkbf(tr, 0.f) & 0xffffu); ((bf16_t*)(ws + WS_T3I))[i] = (bf16_t)(pkbf(ti, 0.f) & 0xffffu); }
    for (int i = gt; i < 256 * 256; i += NGT) { const int k = i >> 8, n = i & 255; float sn, cs; sincospif((float)((k * n) & 255) * (2.0f / 256.0f), &sn, &cs);
        ((bf16_t*)(ws + WS_T256R))[i] = (bf16_t)(pkbf(cs, 0.f) & 0xffffu); ((bf16_t*)(ws + WS_T256I))[i] = (bf16_t)(pkbf(-sn, 0.f) & 0xffffu); }
    {
        __syncthreads();
        float* trig = (float*)lds;
        if (tid < 64) { float sn, cs; sincospif((float)tid * (2.0f / 64.0f), &sn, &cs); trig[tid] = cs; trig[64 + tid] = sn; }
        __syncthreads();
        for (int i = gt; i < 2 * 4 * 64 * 128; i += NGT) {
            const int kk = i & 127, d = (i >> 7) & 63, g = (i >> 13) & 3, l = i >> 15; const int part = kk >> 6, c = swap23(kk & 63);
            const float* wf = a.w_f + ((size_t)(l * 4 + g) * 64) * 64 + d; float sacc = 0.f;
#pragma unroll 8
            for (int j = 0; j < 64; ++j) sacc += trig[part * 64 + ((c * j) & 63)] * wf[j * 64];
            ((bf16_t*)(ws + WS_GT))[i] = (bf16_t)(pkbf(sacc * (1.0f / 724.0773439350246f), 0.f) & 0xffffu);
        }
        __syncthreads();
    }
}

__device__ __forceinline__ void norm_rows4(int mode, int lane, const float* src, float* dst, const bf16_t* y, const float* ssq, bf16_t* hx,
                                           const f32x4 (&GA)[4], const f32x4 (&GB)[4], const f32x4 (&GC)[4]) {
    f32x4 v[4][4];
#pragma unroll
    for (int rr = 0; rr < 4; ++rr)
#pragma unroll
        for (int j = 0; j < 4; ++j) v[rr][j] = *(const f32x4*)(src + (size_t)rr * DM + 4 * lane + 256 * j);
    if (mode != 0) {
        u32x2 yw[4][4]; float p[4];
#pragma unroll
        for (int rr = 0; rr < 4; ++rr) { p[rr] = ssq[rr * 16 + (lane & 15)];
#pragma unroll
            for (int j = 0; j < 4; ++j) yw[rr][j] = *(const u32x2*)(y + (size_t)rr * DM + 4 * lane + 256 * j); }
#pragma unroll
        for (int rr = 0; rr < 4; ++rr) {
            float q = p[rr]; q += __shfl_xor(q, 1); q += __shfl_xor(q, 2); q += __shfl_xor(q, 4); q += __shfl_xor(q, 8);
            const float rstd = 1.0f / sqrtf(q * (1.0f / DM) + NORM_EPS);
#pragma unroll
            for (int j = 0; j < 4; ++j) {
                f32x4 yy; yy[0] = bf2f(yw[rr][j].x & 0xffffu); yy[1] = bf2f(yw[rr][j].x >> 16); yy[2] = bf2f(yw[rr][j].y & 0xffffu); yy[3] = bf2f(yw[rr][j].y >> 16);
                v[rr][j] = v[rr][j] + GA[j] * (yy * rstd);
                *(f32x4*)(dst + (size_t)rr * DM + 4 * lane + 256 * j) = v[rr][j];
            }
        }
    }
    if (mode != 2) {
        float s[4];
#pragma unroll
        for (int rr = 0; rr < 4; ++rr) { float t = 0.f;
#pragma unroll
            for (int j = 0; j < 4; ++j) t += (v[rr][j][0] * v[rr][j][0] + v[rr][j][1] * v[rr][j][1]) + (v[rr][j][2] * v[rr][j][2] + v[rr][j][3] * v[rr][j][3]);
            s[rr] = t; }
#pragma unroll
        for (int o = 1; o < 64; o <<= 1) {
#pragma unroll
            for (int rr = 0; rr < 4; ++rr) s[rr] += __shfl_xor(s[rr], o); }
#pragma unroll
        for (int rr = 0; rr < 4; ++rr) {
            const float rstd = 1.0f / sqrtf(s[rr] * (1.0f / DM) + NORM_EPS);
#pragma unroll
            for (int j = 0; j < 4; ++j) {
                const f32x4 o = (v[rr][j] * rstd) * GB[j] + GC[j];
                u32x2 w; w.x = pkbf(o[0], o[1]); w.y = pkbf(o[2], o[3]);
                *(u32x2*)(hx + (size_t)rr * DM + 4 * lane + 256 * j) = w;
            }
        }
    }
}
__device__ __forceinline__ void norm_phase(const KArgs& a, int mode) {
    const int tid = opaque_tid(), lane = tid & 63, wave = tid >> 6;
    const int NGW = gridDim.x * 8;
    unsigned char* ws = a.ws;
    const float* mod = (const float*)(ws + WS_MOD);
    const int lp = (mode == 0) ? 0 : 1;
    const int lq = (mode == 1) ? 0 : 1;
    bf16_t* HX = (bf16_t*)(ws + WS_HX); const bf16_t* Y = (const bf16_t*)(ws + WS_Y); const float* SSQ = (const float*)(ws + WS_SSQ);
    const int gw2 = wave * (int)gridDim.x + (int)blockIdx.x;
    const int nlat = NTOK / 4;
    int curb = -1; f32x4 GA[4], GB[4], GC[4];
    int base = gw2 * 4, sub = 0, itc = nlat + gw2; bool inctx = false;
    for (;;) {
        int it;
        if (!inctx) { if (base >= nlat) { inctx = true; continue; } it = base + sub; if (++sub == 4) { sub = 0; base += NGW * 4; } }
        else { if (mode == 2 || itc >= nlat + NCTX / 4) break; it = itc; itc += NGW; }
        const int r = it * 4;
        const int b = r < NTOK ? (r >> 13) : 4;
        if (b != curb) { curb = b;
            const float* mp = mod + (lp * 5 + b) * 3072; const float* mq = mod + (lq * 5 + b) * 3072;
#pragma unroll
            for (int j = 0; j < 4; ++j) { const int c = 4 * lane + 256 * j;
                GA[j] = *(const f32x4*)(mq + 2048 + c) * *(const f32x4*)(a.g_post + lq * DM + c);
                GB[j] = *(const f32x4*)(a.g_pre + lp * DM + c) * (*(const f32x4*)(mp + 1024 + c) + 1.0f);
                GC[j] = *(const f32x4*)(mp + c); } }
        const float* src; float* dst;
        if (r < NTOK) { src = (mode == 2 ? (const float*)a.out : a.x) + (size_t)r * DM; dst = a.out + (size_t)r * DM; }
        else { src = a.ctx + (size_t)(r - NTOK) * DM; dst = (float*)(ws + WS_CTX1) + (size_t)(r - NTOK) * DM; }
        norm_rows4(mode, lane, src, dst, Y + (size_t)r * DM, SSQ + (size_t)r * 16, HX + (size_t)r * DM, GA, GB, GC);
    }
}

__device__ __forceinline__ void attn_unit(int u, const bf16_t* P, const bf16_t* Vt, bf16_t* H, const float* sink, unsigned char* lds) {
    const int tid = opaque_tid(), lane = tid & 63, wave = __builtin_amdgcn_readfirstlane(tid >> 6), r32 = lane & 31, hi = lane >> 5;
    const bool isctx = u >= 1024;
    int b, kvh, qb;
    if (isctx) { const int v = u - 1024; b = v >> 3; kvh = (v >> 2) & 1; qb = v & 3; } else { b = u >> 8; kvh = (u >> 7) & 1; qb = u & 127; }
    const int head = kvh * 4 + (wave >> 1);
    const int qtok = qb * 64 + (wave & 1) * 32 + r32;
    const size_t qrow = isctx ? (size_t)(NTOK + b * CTXL + qtok) : (size_t)(b * SEQ + qtok);
    const float sinkv = sink[head];
    bf16x8 qf[4];
#pragma unroll
    for (int d0 = 0; d0 < 4; ++d0) qf[d0] = *(const bf16x8*)(P + qrow * PW + C_Q + head * 64 + d0 * 16 + hi * 8);
    int jlo = 0, jhi = -1;
    if (!isctx) { jlo = qb < 2 ? 2 - qb : 0; jhi = (129 - qb) < 4 ? (129 - qb) : 4; }
    const int ntiles = 4 + (jhi - jlo + 1);
    const int srow = tid >> 3, sch = tid & 7;
    const bf16_t* Kc = P + (size_t)(NTOK + b * CTXL + srow) * PW + C_K + kvh * 64 + sch * 8;
    const bf16_t* Kl = P + (size_t)(b * SEQ + srow) * PW + C_K + kvh * 64 + sch * 8;
    const bf16_t* Vb = Vt + (size_t)((b * 2 + kvh) * 64 + srow) * VT_PITCH + sch * 8;
    unsigned char* Ks = lds; unsigned char* Vs = lds + 2 * 9216;
    const int soff = srow * 144 + sch * 16;
    u32x4 kreg, vreg, kreg2, vreg2;
#define ATT_GLOAD(KR, VR, ti_) do { const int t_ = (ti_); \
        if (t_ < 4) { KR = *(const u32x4*)(Kc + (size_t)(64 * t_) * PW); VR = *(const u32x4*)(Vb + SEQ + 64 * t_); } \
        else { const int kbase_ = qb * 64 - 128 + 64 * (jlo + t_ - 4); KR = *(const u32x4*)(Kl + (size_t)kbase_ * PW); VR = *(const u32x4*)(Vb + kbase_); } } while (0)
    const bf16_t* garow = P + qrow * PW + C_GA + head * 64;
    u32x2 gaw[8];
#pragma unroll
    for (int i = 0; i < 8; ++i) gaw[i] = *(const u32x2*)(garow + 32 * (i >> 2) + 8 * (i & 3) + 4 * hi);
    ATT_GLOAD(kreg2, vreg2, 0);
    ATT_GLOAD(kreg, vreg, 1);
    *(u32x4*)(Ks + soff) = kreg2; *(u32x4*)(Vs + soff) = vreg2;
    __syncthreads();
    const float sink2 = sinkv * LOG2E;
    float mref = sink2, lsum = 0.f;
    f32x16 oT[2]; oT[0] = f32x16{}; oT[1] = f32x16{};
    const int qpos = qtok;
    for (int ti = 0; ti < ntiles; ++ti) {
        const int buf = ti & 1;
        if (ti + 2 < ntiles) ATT_GLOAD(kreg2, vreg2, ti + 2);
        const unsigned char* kb = Ks + buf * 9216 + r32 * 144 + hi * 16;
        const unsigned char* vb = Vs + buf * 9216 + r32 * 144 + hi * 16;
        bf16x8 kf[8];
#pragma unroll
        for (int d0 = 0; d0 < 4; ++d0) { kf[2 * d0] = *(const bf16x8*)(kb + d0 * 32); kf[2 * d0 + 1] = *(const bf16x8*)(kb + 32 * 144 + d0 * 32); }
        f32x16 p0, p1;
#pragma unroll
        for (int r = 0; r < 16; ++r) { p0[r] = -mref; p1[r] = -mref; }
        __builtin_amdgcn_sched_barrier(0);
#pragma unroll
        for (int d0 = 0; d0 < 4; ++d0) { p0 = MFMA32(kf[2 * d0], qf[d0], p0); p1 = MFMA32(kf[2 * d0 + 1], qf[d0], p1); }
        bf16x8 vf[8];
#pragma unroll
        for (int blk = 0; blk < 2; ++blk)
#pragma unroll
            for (int ks = 0; ks < 4; ++ks) vf[blk * 4 + ks] = *(const bf16x8*)(vb + blk * 32 * 144 + ks * 32);
        __builtin_amdgcn_sched_barrier(0);
        if (ti >= 4) {
            const int j = jlo + ti - 4; const int kbase = qb * 64 - 128 + 64 * j;
            if (j == 0) {
#pragma unroll
                for (int r = 0; r < 16; ++r) { const int kp = kbase + crow(r, hi); if (kp < qpos - 128) p0[r] = -INFINITY; if (kp + 32 < qpos - 128) p1[r] = -INFINITY; }
            } else if (j == 4) {
#pragma unroll
                for (int r = 0; r < 16; ++r) { const int kp = kbase + crow(r, hi); if (kp > qpos + 128) p0[r] = -INFINITY; if (kp + 32 > qpos + 128) p1[r] = -INFINITY; }
            }
        }
        float rm = fmaxf(p0[0], p1[0]);
#pragma unroll
        for (int r = 1; r < 16; ++r) rm = fmaxf(rm, fmaxf(p0[r], p1[r]));
        rm = fmaxf(rm, __shfl_xor(rm, 32));
        if (__any(rm > 8.0f)) {
            const float dl = fmaxf(rm, 0.f);
            mref += dl;
            const float f = __builtin_amdgcn_exp2f(-dl);
            lsum *= f;
#pragma unroll
            for (int r = 0; r < 16; ++r) { p0[r] -= dl; p1[r] -= dl; oT[0][r] *= f; oT[1][r] *= f; }
        }
        float ls = 0.f;
#pragma unroll
        for (int r = 0; r < 16; ++r) { p0[r] = __builtin_amdgcn_exp2f(p0[r]); p1[r] = __builtin_amdgcn_exp2f(p1[r]); ls += p0[r] + p1[r]; }
        lsum += ls;
        bf16x8 pf[4]; pf[0] = pack8(p0, 0); pf[1] = pack8(p0, 8); pf[2] = pack8(p1, 0); pf[3] = pack8(p1, 8);
#pragma unroll
        for (int blk = 0; blk < 2; ++blk)
#pragma unroll
            for (int ks = 0; ks < 4; ++ks) oT[blk] = MFMA32(vf[blk * 4 + ks], pf[ks], oT[blk]);
        if (ti + 1 < ntiles) { *(u32x4*)(Ks + (buf ^ 1) * 9216 + soff) = kreg; *(u32x4*)(Vs + (buf ^ 1) * 9216 + soff) = vreg; }
        kreg = kreg2; vreg = vreg2;
        __syncthreads();
    }
    lsum += __shfl_xor(lsum, 32);
    lsum += __builtin_amdgcn_exp2f(sink2 - mref);
    const float inv = 1.0f / lsum;
    bf16_t* hrow = H + qrow * DM + head * 64;
#pragma unroll
    for (int blk = 0; blk < 2; ++blk)
#pragma unroll
        for (int g4 = 0; g4 < 4; ++g4) {
            const int d0 = 32 * blk + 8 * g4 + 4 * hi;
            const u32x2 gw = gaw[blk * 4 + g4];
            const float o0 = oT[blk][4 * g4 + 0] * inv * silu_f(bf2f(gw.x & 0xffffu)), o1 = oT[blk][4 * g4 + 1] * inv * silu_f(bf2f(gw.x >> 16));
            const float o2 = oT[blk][4 * g4 + 2] * inv * silu_f(bf2f(gw.y & 0xffffu)), o3 = oT[blk][4 * g4 + 3] * inv * silu_f(bf2f(gw.y >> 16));
            u32x2 w; w.x = pkbf(o0, o1); w.y = pkbf(o2, o3);
            *(u32x2*)(hrow + d0) = w;
        }
}

typedef short v4i16_t __attribute__((ext_vector_type(4)));
__device__ __forceinline__ v4i16_t trrd(const unsigned char* p) { return __builtin_amdgcn_ds_read_tr16_b64_v4i16((LAS v4i16_t*)p); }
__device__ __forceinline__ bf16x8 cat8(v4i16_t lo, v4i16_t hi) { return (bf16x8){lo[0], lo[1], lo[2], lo[3], hi[0], hi[1], hi[2], hi[3]}; }
__device__ __forceinline__ void fft1_unit(int u, const bf16_t* P, bf16_t* YF, const unsigned char* ws, unsigned char* lds) {
    const int tid = opaque_tid(), lane = tid & 63, wave = __builtin_amdgcn_readfirstlane(tid >> 6), r32 = lane & 31, hi = lane >> 5;
    const int b = u >> 6, n2 = u & 63;
    constexpr int UPB = 576;
    const bf16_t* src = P + (size_t)(b * SEQ + n2) * PW + C_UF;
#pragma unroll
    for (int i = 0; i < 8; ++i) {
        const int id = tid + NTHREADS * i, n1 = id >> 5, cc = id & 31;
        *(u32x4*)(lds + n1 * UPB + cc * 16) = *(const u32x4*)(src + (size_t)n1 * 64 * PW + cc * 8);
    }
    __syncthreads();
    const bf16_t* T1R = (const bf16_t*)(ws + WS_T1R); const bf16_t* T1I = (const bf16_t*)(ws + WS_T1I);
    f32x16 aR[4], aI[4];
#pragma unroll
    for (int kb = 0; kb < 4; ++kb) { aR[kb] = f32x16{}; aI[kb] = f32x16{}; }
    const unsigned char* ap = lds + (8 * hi + ((lane & 15) >> 2)) * UPB + (32 * wave + 16 * ((lane >> 4) & 1) + 4 * (lane & 3)) * 2;
#pragma unroll 2
    for (int ks = 0; ks < 8; ++ks) {
        const bf16x8 av = cat8(trrd(ap + (16 * ks) * UPB), trrd(ap + (16 * ks + 4) * UPB));
#pragma unroll
        for (int kb = 0; kb < 4; ++kb) {
            const bf16x8 bR = *(const bf16x8*)(T1R + (32 * kb + r32) * 128 + 16 * ks + 8 * hi), bI = *(const bf16x8*)(T1I + (32 * kb + r32) * 128 + 16 * ks + 8 * hi);
            aR[kb] = MFMA32(av, bR, aR[kb]); aI[kb] = MFMA32(av, bI, aI[kb]);
        }
    }
    const float* TW = (const float*)(ws + WS_TW);
#pragma unroll
    for (int kb = 0; kb < 4; ++kb) {
        const int k1 = 32 * kb + r32;
        const float ct = TW[2 * (n2 * k1)], st = TW[2 * (n2 * k1) + 1];
        bf16_t* yp = YF + ((size_t)((b * 128 + k1) * 64 + n2)) * 512 + 32 * wave + 4 * hi;
#pragma unroll
        for (int g4 = 0; g4 < 4; ++g4) {
            float yr[4], yi[4];
#pragma unroll
            for (int e = 0; e < 4; ++e) { const float r_ = aR[kb][4 * g4 + e], i_ = aI[kb][4 * g4 + e]; yr[e] = r_ * ct + i_ * st; yi[e] = i_ * ct - r_ * st; }
            u32x2 wr_, wi_; wr_.x = pkbf(yr[0], yr[1]); wr_.y = pkbf(yr[2], yr[3]); wi_.x = pkbf(yi[0], yi[1]); wi_.y = pkbf(yi[2], yi[3]);
            *(u32x2*)(yp + 8 * g4) = wr_; *(u32x2*)(yp + 256 + 8 * g4) = wi_;
        }
    }
    __syncthreads();
}

template <int KK>
__device__ __forceinline__ void dftf_unit(const bf16_t* srcbase, int R, int pitchA, int pitchB, const bf16_t* Tr, const bf16_t* Ti, const bf16_t* Gt,
                                          const bf16_t* P, bf16_t* H, size_t row0, int rowstride, float oscale, unsigned char* lds) {
    const int tid = opaque_tid(), lane = tid & 63, wave = __builtin_amdgcn_readfirstlane(tid >> 6), r32 = lane & 31, hi = lane >> 5;
    constexpr int ZPB = (KK == 128) ? 576 : 544;
#pragma unroll 1
    for (int i0 = 0; i0 < KK / 16; i0 += 8) {
        u32x4 img[8];
#pragma unroll
        for (int i = 0; i < 8; ++i) { const int id = tid + NTHREADS * (i0 + i), kk = id >> 5, cc = id & 31; img[i] = *(const u32x4*)(srcbase + (size_t)(kk % R) * pitchA + (size_t)(kk / R) * pitchB + cc * 8); }
        __builtin_amdgcn_sched_barrier(0);
#pragma unroll
        for (int i = 0; i < 8; ++i) { const int id = tid + NTHREADS * (i0 + i), kk = id >> 5, cc = id & 31; *(u32x4*)(lds + kk * ZPB + cc * 16) = img[i]; }
        __builtin_amdgcn_sched_barrier(0);
    }
    __syncthreads();
    const int g = wave >> 1, kblk = wave & 1;
    f32x16 XR[2], XI[2];
#pragma unroll
    for (int cb = 0; cb < 2; ++cb) { XR[cb] = f32x16{}; XI[cb] = f32x16{}; }
    const bf16_t* trp = Tr + (size_t)(32 * kblk + r32) * KK + 8 * hi; const bf16_t* tip = Ti + (size_t)(32 * kblk + r32) * KK + 8 * hi;
    const unsigned char* zp = lds + (8 * hi + ((lane & 15) >> 2)) * ZPB + (64 * g + 16 * ((lane >> 4) & 1) + 4 * (lane & 3)) * 2;
#pragma unroll 2
    for (int ks = 0; ks < KK / 16; ++ks) {
        const bf16x8 bR = *(const bf16x8*)(trp + 16 * ks), bI = *(const bf16x8*)(tip + 16 * ks);
#pragma unroll
        for (int cb = 0; cb < 2; ++cb) { const bf16x8 av = cat8(trrd(zp + (16 * ks) * ZPB + cb * 64), trrd(zp + (16 * ks + 4) * ZPB + cb * 64)); XR[cb] = MFMA32(av, bR, XR[cb]); XI[cb] = MFMA32(av, bI, XI[cb]); }
    }
    f32x16 oa[2]; oa[0] = f32x16{}; oa[1] = f32x16{};
    const bf16_t* gp = Gt + (size_t)(g * 64 + r32) * 128 + 8 * hi;
    u32x2 gfw[8];
    { const size_t rowg = row0 + (size_t)(32 * kblk + r32) * rowstride;
#pragma unroll
      for (int i8 = 0; i8 < 8; ++i8) gfw[i8] = *(const u32x2*)(P + rowg * PW + C_GF + 64 * g + 32 * (i8 >> 2) + 8 * (i8 & 3) + 4 * hi); }
#pragma unroll
    for (int part = 0; part < 2; ++part)
#pragma unroll
        for (int cb = 0; cb < 2; ++cb)
#pragma unroll
            for (int s = 0; s < 2; ++s) {
                const bf16x8 bx = pack8(part ? XI[cb] : XR[cb], 8 * s);
                const int kko = part * 64 + 32 * cb + 16 * s;
#pragma unroll
                for (int lb = 0; lb < 2; ++lb) { const bf16x8 ag = *(const bf16x8*)(gp + (size_t)(32 * lb) * 128 + kko); oa[lb] = MFMA32(ag, bx, oa[lb]); }
            }
    const int k2 = 32 * kblk + r32;
    const size_t row = row0 + (size_t)k2 * rowstride;
    const bf16_t* gfrow = P + row * PW + C_GF + 64 * g;
    bf16_t* hrow = H + row * DM + 512 + 64 * g;
#pragma unroll
    for (int lb = 0; lb < 2; ++lb)
#pragma unroll
        for (int g4 = 0; g4 < 4; ++g4) {
            const int l0 = 32 * lb + 8 * g4 + 4 * hi;
            const u32x2 gw = gfw[lb * 4 + g4];
            const float o0 = oa[lb][4 * g4 + 0] * oscale * silu_f(bf2f(gw.x & 0xffffu)), o1 = oa[lb][4 * g4 + 1] * oscale * silu_f(bf2f(gw.x >> 16));
            const float o2 = oa[lb][4 * g4 + 2] * oscale * silu_f(bf2f(gw.y & 0xffffu)), o3 = oa[lb][4 * g4 + 3] * oscale * silu_f(bf2f(gw.y >> 16));
            u32x2 w; w.x = pkbf(o0, o1); w.y = pkbf(o2, o3);
            *(u32x2*)(hrow + l0) = w;
        }
    __syncthreads();
}

__device__ __forceinline__ void conv_unit(int u, const bf16_t* P, bf16_t* H, const float* cw, const float* cb) {
    const int tid = opaque_tid(), cgp = tid & 31, rg = tid >> 5;
    const int ch0 = cgp * 8;
    const int r0 = u * 64 + rg * 4;
    int pos, len; if (r0 < NTOK) { pos = r0 & (SEQ - 1); len = SEQ; } else { pos = (r0 - NTOK) & (CTXL - 1); len = CTXL; }
    float w0[8], w1[8], w2[8], bs[8];
#pragma unroll
    for (int e = 0; e < 8; ++e) { w0[e] = cw[ch0 + e]; w1[e] = cw[256 + ch0 + e]; w2[e] = cw[512 + ch0 + e]; bs[e] = cb[ch0 + e]; }
    float T[6][8];
#pragma unroll
    for (int i = 0; i < 6; ++i) {
        const int p = pos - 1 + i;
        if (p >= 0 && p < len) {
            const size_t row = (size_t)(r0 - 1 + i);
            const u32x4 z = *(const u32x4*)(P + row * PW + C_ZC + ch0), c = *(const u32x4*)(P + row * PW + C_CC + ch0);
            T[i][0] = bf2f(z.x & 0xffffu) * bf2f(c.x & 0xffffu); T[i][1] = bf2f(z.x >> 16) * bf2f(c.x >> 16);
            T[i][2] = bf2f(z.y & 0xffffu) * bf2f(c.y & 0xffffu); T[i][3] = bf2f(z.y >> 16) * bf2f(c.y >> 16);
            T[i][4] = bf2f(z.z & 0xffffu) * bf2f(c.z & 0xffffu); T[i][5] = bf2f(z.z >> 16) * bf2f(c.z >> 16);
            T[i][6] = bf2f(z.w & 0xffffu) * bf2f(c.w & 0xffffu); T[i][7] = bf2f(z.w >> 16) * bf2f(c.w >> 16);
        } else {
#pragma unroll
            for (int e = 0; e < 8; ++e) T[i][e] = 0.f;
        }
    }
#pragma unroll
    for (int i = 0; i < 4; ++i) {
        const size_t row = (size_t)(r0 + i);
        const u32x4 bw = *(const u32x4*)(P + row * PW + C_BC + ch0), gw = *(const u32x4*)(P + row * PW + C_GC + ch0);
        const unsigned bwv[4] = {bw.x, bw.y, bw.z, bw.w}, gwv[4] = {gw.x, gw.y, gw.z, gw.w};
        float o[8];
#pragma unroll
        for (int e = 0; e < 8; ++e) {
            const float bv = (e & 1) ? bf2f(bwv[e >> 1] >> 16) : bf2f(bwv[e >> 1] & 0xffffu);
            const float gv = (e & 1) ? bf2f(gwv[e >> 1] >> 16) : bf2f(gwv[e >> 1] & 0xffffu);
            const float y = T[i][e] * w0[e] + T[i + 1][e] * w1[e] + T[i + 2][e] * w2[e] + bs[e];
            o[e] = bv * y * silu_f(gv);
        }
        u32x4 w; w.x = pkbf(o[0], o[1]); w.y = pkbf(o[2], o[3]); w.z = pkbf(o[4], o[5]); w.w = pkbf(o[6], o[7]);
        *(u32x4*)(H + row * DM + 768 + ch0) = w;
    }
}

__device__ __forceinline__ void fft1_wave(int task, const bf16_t* P, bf16_t* YF, const unsigned char* ws, unsigned char* lds_w, int lane, int pmode = 0) {
    const int r32 = lane & 31, hi = lane >> 5;
    const int cblk = task & 7, n2 = (task >> 3) & 63, b = task >> 9;
    const bf16_t* src = P + (size_t)((b * 64 + n2) * 128) * 256 + 32 * cblk + 8 * (lane & 3);
    { u32x4 img[8];
#pragma unroll
      for (int i = 0; i < 8; ++i) img[i] = *(const u32x4*)(src + (size_t)(16 * i + (lane >> 2)) * 256);
      __builtin_amdgcn_sched_barrier(0);
#pragma unroll
      for (int i = 0; i < 8; ++i) *(u32x4*)(lds_w + (16 * i + (lane >> 2)) * 64 + (lane & 3) * 16) = img[i];
      __builtin_amdgcn_sched_barrier(0); }
    asm volatile("s_waitcnt vmcnt(0) lgkmcnt(0)" ::: "memory");
    if (pmode == 2) return;
    const bf16_t* T1R = (const bf16_t*)(ws + WS_T1R); const bf16_t* T1I = (const bf16_t*)(ws + WS_T1I);
    f32x16 aR[4], aI[4];
#pragma unroll
    for (int kb = 0; kb < 4; ++kb) { aR[kb] = f32x16{}; aI[kb] = f32x16{}; }
    const unsigned char* ap = lds_w + (8 * hi + ((lane & 15) >> 2)) * 64 + (16 * ((lane >> 4) & 1) + 4 * (lane & 3)) * 2;
    const bf16_t* t1r = T1R + (size_t)r32 * 128 + 8 * hi; const bf16_t* t1i = T1I + (size_t)r32 * 128 + 8 * hi;
    bf16x8 bA[8], bB[8];
#define F1_LOADB(B, ks_) do { _Pragma("unroll") for (int kb = 0; kb < 4; ++kb) { B[2 * kb] = *(const bf16x8*)(t1r + (size_t)(32 * kb) * 128 + 16 * (ks_)); B[2 * kb + 1] = *(const bf16x8*)(t1i + (size_t)(32 * kb) * 128 + 16 * (ks_)); } } while (0)
#define F1_STEP(B, ks_) do { const bf16x8 av = cat8(trrd(ap + (16 * (ks_)) * 64), trrd(ap + (16 * (ks_) + 4) * 64)); \
        _Pragma("unroll") for (int kb = 0; kb < 4; ++kb) { aR[kb] = MFMA32(av, B[2 * kb], aR[kb]); aI[kb] = MFMA32(av, B[2 * kb + 1], aI[kb]); } } while (0)
    F1_LOADB(bA, 0);
#pragma unroll
    for (int k2 = 0; k2 < 4; ++k2) {
        F1_LOADB(bB, 2 * k2 + 1);
        __builtin_amdgcn_sched_barrier(0);
        F1_STEP(bA, 2 * k2);
        __builtin_amdgcn_sched_barrier(0);
        if (k2 < 3) F1_LOADB(bA, 2 * k2 + 2);
        __builtin_amdgcn_sched_barrier(0);
        F1_STEP(bB, 2 * k2 + 1);
        __builtin_amdgcn_sched_barrier(0);
    }
#undef F1_LOADB
#undef F1_STEP
    const float* TW = (const float*)(ws + WS_TW);
#pragma unroll
    for (int kb = 0; kb < 4; ++kb) {
        const int k1 = 32 * kb + r32;
        const float ct = TW[2 * (n2 * k1)], st = TW[2 * (n2 * k1) + 1];
        bf16_t* yp = YF + ((size_t)((b * 128 + k1) * 64 + n2)) * 512 + 32 * cblk + 4 * hi;
#pragma unroll
        for (int g4 = 0; g4 < 4; ++g4) {
            float yr[4], yi[4];
#pragma unroll
            for (int e = 0; e < 4; ++e) { const float r_ = aR[kb][4 * g4 + e], i_ = aI[kb][4 * g4 + e]; yr[e] = r_ * ct + i_ * st; yi[e] = i_ * ct - r_ * st; }
            u32x2 wr_, wi_; wr_.x = pkbf(yr[0], yr[1]); wr_.y = pkbf(yr[2], yr[3]); wi_.x = pkbf(yi[0], yi[1]); wi_.y = pkbf(yi[2], yi[3]);
            if (pmode != 1 || wr_.x == 0x12345678u) { *(u32x2*)(yp + 8 * g4) = wr_; *(u32x2*)(yp + 256 + 8 * g4) = wi_; }
        }
    }
    asm volatile("s_waitcnt lgkmcnt(0)" ::: "memory");
}
__device__ __forceinline__ void fft3_wave(int task, const bf16_t* YF, const bf16_t* Gt, const bf16_t* P, bf16_t* H, const unsigned char* ws, unsigned char* lds_w, int lane) {
    const int r32 = lane & 31, hi = lane >> 5;
    const int g = task & 3, k1 = (task >> 2) & 127, b = task >> 9;
    const bf16_t* src = YF + ((size_t)(b * 128 + k1) * 64) * 512 + 64 * g + 8 * (lane & 7);
    { u32x4 img[16];
#pragma unroll
      for (int i = 0; i < 16; ++i) { const int kk = 8 * i + (lane >> 3); img[i] = *(const u32x4*)(src + (size_t)(kk & 63) * 512 + (size_t)(kk >> 6) * 256); }
      __builtin_amdgcn_sched_barrier(0);
#pragma unroll
      for (int i = 0; i < 16; ++i) { const int kk = 8 * i + (lane >> 3), ch = lane & 7; *(u32x4*)(lds_w + kk * 128 + ((ch ^ (((kk >> 1) & 1) << 2)) * 16)) = img[i]; }
      __builtin_amdgcn_sched_barrier(0); }
    asm volatile("s_waitcnt vmcnt(0) lgkmcnt(0)" ::: "memory");
    const bf16_t* T3R = (const bf16_t*)(ws + WS_T3R); const bf16_t* T3I = (const bf16_t*)(ws + WS_T3I);
    const int q = (lane & 15) >> 2, sw = (q >> 1) & 1;
    const int chl = 2 * ((lane >> 4) & 1) + ((lane & 3) >> 1);
    const unsigned char* zb = lds_w + (8 * hi + q) * 128 + 8 * (lane & 1);
    const unsigned char* zp0 = zb + ((chl ^ (sw << 2)) * 16);
    const unsigned char* zp1 = zb + (((4 + chl) ^ (sw << 2)) * 16);
    const bf16_t* gp = Gt + (size_t)(g * 64 + r32) * 128 + 8 * hi;
    const size_t rowb = (size_t)(b * SEQ + k1);
#pragma unroll 1
    for (int kblk = 0; kblk < 2; ++kblk) {
        f32x16 XR[2], XI[2];
#pragma unroll
        for (int cb = 0; cb < 2; ++cb) { XR[cb] = f32x16{}; XI[cb] = f32x16{}; }
        const bf16_t* trp = T3R + (size_t)(32 * kblk + r32) * 128 + 8 * hi; const bf16_t* tip = T3I + (size_t)(32 * kblk + r32) * 128 + 8 * hi;
        const size_t rowg = rowb + (size_t)(32 * kblk + r32) * 128;
        u32x2 gfw[8];
#pragma unroll
        for (int i8 = 0; i8 < 8; ++i8) gfw[i8] = *(const u32x2*)(P + rowg * PW + C_GF + 64 * g + 32 * (i8 >> 2) + 8 * (i8 & 3) + 4 * hi);
        bf16x8 bR[8], bI[8];
#pragma unroll
        for (int ks = 0; ks < 8; ++ks) { bR[ks] = *(const bf16x8*)(trp + 16 * ks); bI[ks] = *(const bf16x8*)(tip + 16 * ks); }
        __builtin_amdgcn_sched_barrier(0);
#pragma unroll
        for (int ks = 0; ks < 8; ++ks) {
            const bf16x8 a0 = cat8(trrd(zp0 + (16 * ks) * 128), trrd(zp0 + (16 * ks + 4) * 128));
            const bf16x8 a1 = cat8(trrd(zp1 + (16 * ks) * 128), trrd(zp1 + (16 * ks + 4) * 128));
            XR[0] = MFMA32(a0, bR[ks], XR[0]); XI[0] = MFMA32(a0, bI[ks], XI[0]); XR[1] = MFMA32(a1, bR[ks], XR[1]); XI[1] = MFMA32(a1, bI[ks], XI[1]);
        }
        __builtin_amdgcn_sched_barrier(0);
        bf16x8 gfr[2][8];
#pragma unroll
        for (int lb = 0; lb < 2; ++lb)
#pragma unroll
            for (int q8 = 0; q8 < 8; ++q8) gfr[lb][q8] = *(const bf16x8*)(gp + (size_t)(32 * lb) * 128 + 16 * q8);
        __builtin_amdgcn_sched_barrier(0);
        f32x16 oa[2]; oa[0] = f32x16{}; oa[1] = f32x16{};
#pragma unroll
        for (int part = 0; part < 2; ++part)
#pragma unroll
            for (int cb = 0; cb < 2; ++cb)
#pragma unroll
                for (int s = 0; s < 2; ++s) {
                    const bf16x8 bx = pack8(part ? XI[cb] : XR[cb], 8 * s);
                    const int kko = part * 64 + 32 * cb + 16 * s;
#pragma unroll
                    for (int lb = 0; lb < 2; ++lb) oa[lb] = MFMA32(gfr[lb][kko >> 4], bx, oa[lb]);
                }
        const int k2 = 32 * kblk + r32;
        const size_t row = rowb + (size_t)k2 * 128;
        const bf16_t* gfrow = P + row * PW + C_GF + 64 * g;
        bf16_t* hrow = H + row * DM + 512 + 64 * g;
#pragma unroll
        for (int lb = 0; lb < 2; ++lb)
#pragma unroll
            for (int g4 = 0; g4 < 4; ++g4) {
                const int l0 = 32 * lb + 8 * g4 + 4 * hi;
                const u32x2 gw = gfw[lb * 4 + g4];
                const float o0 = oa[lb][4 * g4 + 0] * silu_f(bf2f(gw.x & 0xffffu)), o1 = oa[lb][4 * g4 + 1] * silu_f(bf2f(gw.x >> 16));
                const float o2 = oa[lb][4 * g4 + 2] * silu_f(bf2f(gw.y & 0xffffu)), o3 = oa[lb][4 * g4 + 3] * silu_f(bf2f(gw.y >> 16));
                u32x2 w; w.x = pkbf(o0, o1); w.y = pkbf(o2, o3);
                *(u32x2*)(hrow + l0) = w;
            }
    }
    asm volatile("s_waitcnt lgkmcnt(0)" ::: "memory");
}
__device__ __forceinline__ void conv_wave(int task, const bf16_t* P, bf16_t* H, const float* cw, const float* cb, int lane) {
    const int cgp = lane & 31, ch0 = cgp * 8;
    const int r0 = task * 8 + (lane >> 5) * 4;
    int pos, len; if (r0 < NTOK) { pos = r0 & (SEQ - 1); len = SEQ; } else { pos = (r0 - NTOK) & (CTXL - 1); len = CTXL; }
    u32x4 zz[6], cc[6], bb[4], gg[4]; float okf[6];
#pragma unroll
    for (int i = 0; i < 6; ++i) { const int p = pos - 1 + i; const bool ok = p >= 0 && p < len; okf[i] = ok ? 1.f : 0.f; const size_t row = (size_t)(ok ? r0 - 1 + i : r0);
        zz[i] = *(const u32x4*)(P + row * PW + C_ZC + ch0); cc[i] = *(const u32x4*)(P + row * PW + C_CC + ch0); }
#pragma unroll
    for (int i = 0; i < 4; ++i) { const size_t row = (size_t)(r0 + i); bb[i] = *(const u32x4*)(P + row * PW + C_BC + ch0); gg[i] = *(const u32x4*)(P + row * PW + C_GC + ch0); }
    __builtin_amdgcn_sched_barrier(0);
    float w0[8], w1[8], w2[8], bs[8];
    { const f32x4 a0 = *(const f32x4*)(cw + ch0), a1 = *(const f32x4*)(cw + ch0 + 4), b0 = *(const f32x4*)(cw + 256 + ch0), b1 = *(const f32x4*)(cw + 256 + ch0 + 4);
      const f32x4 c0 = *(const f32x4*)(cw + 512 + ch0), c1 = *(const f32x4*)(cw + 512 + ch0 + 4), d0 = *(const f32x4*)(cb + ch0), d1 = *(const f32x4*)(cb + ch0 + 4);
#pragma unroll
      for (int e = 0; e < 4; ++e) { w0[e] = a0[e]; w0[4 + e] = a1[e]; w1[e] = b0[e]; w1[4 + e] = b1[e]; w2[e] = c0[e]; w2[4 + e] = c1[e]; bs[e] = d0[e]; bs[4 + e] = d1[e]; } }
    float T[6][8];
#pragma unroll
    for (int i = 0; i < 6; ++i) {
        const unsigned zv[4] = {zz[i].x, zz[i].y, zz[i].z, zz[i].w}, cv[4] = {cc[i].x, cc[i].y, cc[i].z, cc[i].w};
#pragma unroll
        for (int e = 0; e < 8; ++e) T[i][e] = okf[i] * ((e & 1) ? bf2f(zv[e >> 1] >> 16) : bf2f(zv[e >> 1] & 0xffffu)) * ((e & 1) ? bf2f(cv[e >> 1] >> 16) : bf2f(cv[e >> 1] & 0xffffu));
    }
#pragma unroll
    for (int i = 0; i < 4; ++i) {
        const size_t row = (size_t)(r0 + i);
        const unsigned bwv[4] = {bb[i].x, bb[i].y, bb[i].z, bb[i].w}, gwv[4] = {gg[i].x, gg[i].y, gg[i].z, gg[i].w};
        float o[8];
#pragma unroll
        for (int e = 0; e < 8; ++e) {
            const float bv = (e & 1) ? bf2f(bwv[e >> 1] >> 16) : bf2f(bwv[e >> 1] & 0xffffu);
            const float gv = (e & 1) ? bf2f(gwv[e >> 1] >> 16) : bf2f(gwv[e >> 1] & 0xffffu);
            const float y = T[i][e] * w0[e] + T[i + 1][e] * w1[e] + T[i + 2][e] * w2[e] + bs[e];
            o[e] = bv * y * silu_f(gv);
        }
        u32x4 w; w.x = pkbf(o[0], o[1]); w.y = pkbf(o[2], o[3]); w.z = pkbf(o[4], o[5]); w.w = pkbf(o[6], o[7]);
        *(u32x4*)(H + row * DM + 768 + ch0) = w;
    }
}

#define XB_TMO      128
#define XB_XCNT(j)  (256  + 64 * (j))
#define XB_XSUB(j)  (1280 + 64 * (j))
#define XB_XGEN(j)  (2304 + 64 * (j))
#define XB_TOP      3328
#define XB_TOPGEN   3392
#define XCD_BAR_WORDS 3456
#define XB_SPIN_CAP (1u << 18)

__device__ __forceinline__ unsigned xb_ld(unsigned* p)              { return __hip_atomic_load(p, __ATOMIC_RELAXED, __HIP_MEMORY_SCOPE_AGENT); }
__device__ __forceinline__ unsigned xb_add(unsigned* p, unsigned v) { return __hip_atomic_fetch_add(p, v, __ATOMIC_RELAXED, __HIP_MEMORY_SCOPE_AGENT); }
__device__ __forceinline__ unsigned xb_xcc_id() { return (unsigned)__builtin_amdgcn_s_getreg((3 << 11) | 20) & 0xFu; }
#define XB_SPIN(cond, bar) do { unsigned _sp = 0; while (cond) { __builtin_amdgcn_s_sleep(1); \
    if ((++_sp & 255u) == 0u) { if (xb_ld(&(bar)[XB_TMO])) break; if (_sp > XB_SPIN_CAP) { atomicAdd(&(bar)[XB_TMO], 1u); break; } } } } while (0)

struct XcdBarrier {
    unsigned* bar; unsigned x;
    volatile LAS unsigned* st;
};

__device__ __forceinline__ XcdBarrier xcd_barrier_post(unsigned* bar, volatile LAS unsigned* st) {
    XcdBarrier b; b.bar = bar; b.x = xb_xcc_id(); b.st = st;
    if (threadIdx.x == 0) (void)xb_add(&bar[XB_XCNT(b.x)], 1u);
    return b;
}
__device__ __forceinline__ void xcd_barrier_complete(unsigned* bar, unsigned x, unsigned& nloc, unsigned& nx) {
    const unsigned G = gridDim.x * gridDim.y * gridDim.z;
    unsigned sum, cnt, mine, sp = 0u;
    for (;;) {
        sum = 0u; cnt = 0u; mine = 0u;
#pragma unroll
        for (unsigned j = 0; j < 16; ++j) { const unsigned c = xb_ld(&bar[XB_XCNT(j)]); sum += c; cnt += (c > 0u) ? 1u : 0u; mine = (j == x) ? c : mine; }
        if (sum == G) break;
        __builtin_amdgcn_s_sleep(1);
        if ((++sp & 255u) == 0u) { if (xb_ld(&bar[XB_TMO])) break; if (sp > XB_SPIN_CAP) { atomicAdd(&bar[XB_TMO], 1u); break; } }
    }
    nloc = mine > 0u ? mine : 1u; nx = cnt > 0u ? cnt : 1u;
}

__device__ __forceinline__ void xcd_barrier(const XcdBarrier& b) {
    asm volatile("s_waitcnt vmcnt(0)" ::: "memory");
    __syncthreads();
    if (threadIdx.x == 0) {
        unsigned* bar = b.bar;
        __builtin_amdgcn_s_waitcnt(0);
        unsigned nloc = b.st[0], nx = b.st[1];
        if (nloc == 0u) { xcd_barrier_complete(bar, b.x, nloc, nx); b.st[0] = nloc; b.st[1] = nx; }
        const unsigned old = xb_add(&bar[XB_XSUB(b.x)], 1u);
        const unsigned gen = old / nloc;
        if (old + 1u == (gen + 1u) * nloc) {
            __builtin_amdgcn_fence(__ATOMIC_RELEASE, "agent");
            asm volatile("s_waitcnt vmcnt(0)" ::: "memory");
            const unsigned og = xb_add(&bar[XB_TOP], 1u);
            const unsigned tg = og / nx;
            if (og + 1u == (tg + 1u) * nx) xb_add(&bar[XB_TOPGEN], 1u);
            else XB_SPIN(xb_ld(&bar[XB_TOPGEN]) == tg, bar);
            __builtin_amdgcn_fence(__ATOMIC_ACQUIRE, "agent");
            xb_add(&bar[XB_XGEN(b.x)], 1u);
            asm volatile("s_waitcnt vmcnt(0)" ::: "memory");
        } else {
            XB_SPIN(xb_ld(&bar[XB_XGEN(b.x)]) == gen, bar);
            __builtin_amdgcn_fence(__ATOMIC_ACQUIRE, "agent");
            asm volatile("s_waitcnt vmcnt(0)" ::: "memory");
        }
    }
    __syncthreads();
}

__device__ __forceinline__ int next_unit(unsigned* ctr, unsigned char* lds) {
    volatile int* sw = (volatile int*)(lds + LDS_SCHED);
    if (threadIdx.x == 0) *sw = (int)atomicAdd(ctr, 1u);
    __syncthreads();
    const int u = *sw;
    __syncthreads();
    return u;
}

__global__ void __launch_bounds__(NTHREADS, 2) hybrid_fwd(KArgs a) {
    extern __shared__ __attribute__((aligned(16))) unsigned char lds[];
    cg::grid_group grid = cg::this_grid();
    unsigned char* ws = a.ws;
    const int lo = a.ph_lo, hi = a.ph_hi;
#ifndef PHMASK
#define PHMASK 0xfff
#endif
#define IN(k) (((PHMASK >> ((k) > 5 && (k) < 11 ? (k) - 5 : (k))) & 1) && lo <= (k) && (k) < hi)
#define SEAM(k) do { if (IN(k) && IN((k) + 1)) xcd_barrier(xbar); } while (0)
#ifndef REP_PHASE
#define REP_PHASE -1
#endif
#define REPS(j) for (int rep = 0, nrep = (REP_PHASE == (j)) ? 2 : 1; rep < nrep; ++rep, (rep < nrep ? xcd_barrier(xbar) : (void)0))
    bf16_t* HX = (bf16_t*)(ws + WS_HX); bf16_t* Pb = (bf16_t*)(ws + WS_P); bf16_t* Vt = (bf16_t*)(ws + WS_VT); bf16_t* Hb = (bf16_t*)(ws + WS_H);
    bf16_t* Yb = (bf16_t*)(ws + WS_Y); bf16_t* YF = (bf16_t*)(ws + WS_YF); float* SSQ = (float*)(ws + WS_SSQ);
    unsigned* ctl = (unsigned*)(ws + WS_CTL);

    if (threadIdx.x < 2) ((volatile LAS unsigned*)(lds + LDS_BARST))[threadIdx.x] = 0u;
    __syncthreads();
    const XcdBarrier xbar = xcd_barrier_post((unsigned*)(ws + WS_BAR), (volatile LAS unsigned*)(lds + LDS_BARST));
    if (a.ph_lo < 0) grid.sync();
    REPS(30) if (IN(0)) p0_prologue(a, lds);
    SEAM(0);
    for (int l = 0; l < 2; ++l) {
        const int pb = 1 + 5 * l;
        REPS(0) if (IN(pb)) norm_phase(a, l);
        SEAM(pb);
        REPS(1) if (IN(pb + 1)) {
            pg8::Gemm g{HX, (const bf16_t*)(ws + WS_WIN) + (size_t)l * PW * DM, MROWS, PW, DM};
            pg8::StaticOrder S; S.init(MROWS, PW, (int)gridDim.x, (int)blockIdx.x);
            pg8::EpiProj E{Pb, Vt, (const float*)(ws + WS_ROPE), (bf16_t*)(ws + WS_UFP), 0.125f * LOG2E};
            pg8::gemm_phase<pg8::EpiProj, pg8::StaticOrder, true, true>((PG8_LAS unsigned char*)lds, g, S, E);
        }
        SEAM(pb + 1);
        for (int rep = 0, nrep = (REP_PHASE >= 20 && REP_PHASE < 30) ? 2 : 1; rep < nrep; ++rep, (rep < nrep ? xcd_barrier(xbar) : (void)0)) if (IN(pb + 2)) {
            const int nAttn = (l == 0) ? 1056 : 1024, nCtxF = (l == 0) ? 16 : 0, nF1 = 256, nConv = ((l == 0) ? MROWS : NTOK) / 64;
            const int e0 = nF1, e1 = e0 + nCtxF, e2 = e1 + nAttn, e3 = e2 + nConv;
            for (;;) {
                const int u = next_unit(ctl + 2 * l + 8 * rep, lds);
                if (u >= e3) break;
                if (rep == 1) { const int ty = u < e0 ? 1 : u < e1 ? 3 : u < e2 ? 0 : 2; if (REP_PHASE == 25 ? (ty == 0) : (ty != REP_PHASE - 20)) continue; }
                if (u >= e1 && u < e2) attn_unit(u - e1, Pb, Vt, Hb, a.sink + 8 * l, lds);
                else if (u >= e0 && u < e1) { const int v = u - e0, b = v >> 2, kb = v & 3;
                    dftf_unit<256>(Pb + (size_t)(NTOK + b * CTXL) * PW + C_UF, 256, PW, 0, (const bf16_t*)(ws + WS_T256R) + (size_t)(64 * kb) * 256, (const bf16_t*)(ws + WS_T256I) + (size_t)(64 * kb) * 256,
                                   (const bf16_t*)(ws + WS_GT) + (size_t)l * 4 * 64 * 128, Pb, Hb, (size_t)(NTOK + b * CTXL + 64 * kb), 1, 5.656854249492381f, lds); }
                else {
                    const int tid = opaque_tid(), lane = tid & 63, wave = __builtin_amdgcn_readfirstlane(tid >> 6);
                    if (u < e0) fft1_wave(u * 8 + wave, (const bf16_t*)(ws + WS_UFP), YF, ws, lds + wave * 16384, lane);
                    else conv_wave((u - e2) * 8 + wave, Pb, Hb, a.conv_w + l * 768, a.conv_b + l * 256, lane);
                }
            }
        }
        SEAM(pb + 2);
        REPS(3) if (IN(pb + 3)) {
            const bool gemmwg = (l == 0 && blockIdx.x < 16);
            if (gemmwg) {
                pg8::Gemm g{Hb + (size_t)NTOK * DM, (const bf16_t*)(ws + WS_WOUT) + (size_t)l * DM * DM, NCTX, DM, DM};
                pg8::StaticOrder S; S.init(NCTX, DM, 16, (int)blockIdx.x);
                pg8::EpiY E{Yb + (size_t)NTOK * DM, SSQ + (size_t)NTOK * 16};
                pg8::gemm_phase<pg8::EpiY, pg8::StaticOrder, true, true>((PG8_LAS unsigned char*)lds, g, S, E);
            } else {
                const int tid = opaque_tid(), lane = tid & 63, wave = __builtin_amdgcn_readfirstlane(tid >> 6);
                const int nb0 = (l == 0) ? 16 : 0;
                const int gw = ((int)blockIdx.x - nb0) + wave * ((int)gridDim.x - nb0), NGW = ((int)gridDim.x - nb0) * 8;
                unsigned char* lds_w = lds + wave * 16384;
                for (int t = gw; t < 2048; t += NGW) fft3_wave(t, YF, (const bf16_t*)(ws + WS_GT) + (size_t)l * 4 * 64 * 128, Pb, Hb, ws, lds_w, lane);
            }
            __syncthreads();
        }
        SEAM(pb + 3);
        REPS(4) if (IN(pb + 4)) {
            pg8::Gemm g{Hb, (const bf16_t*)(ws + WS_WOUT) + (size_t)l * DM * DM, NTOK, DM, DM};
            pg8::StaticOrder S; S.init(NTOK, DM, (int)gridDim.x, (int)blockIdx.x);
            pg8::EpiY E{Yb, SSQ};
            pg8::gemm_phase<pg8::EpiY, pg8::StaticOrder, true, true>((PG8_LAS unsigned char*)lds, g, S, E);
        }
        SEAM(pb + 4);
    }
#if REP_PHASE == 9
    for (int i = 0; i < 10; ++i) xcd_barrier(xbar);
#endif
    if (IN(11)) norm_phase(a, 2);
#undef IN
#undef SEAM
}

#ifndef MK_MULTI
#define MK_MULTI 0
#endif
extern "C" void kernel_launch(void* const* d_in, const int* in_sizes, int n_in, void* d_out, int out_size, void* d_ws, size_t ws_size, hipStream_t stream) {
    static int grid = 0;
    if (grid == 0) {
        if (n_in != 14 || ws_size < WS_END) { fprintf(stderr, "kernel_launch: unexpected n_in %d or ws_size %zu (need %zu)\n", n_in, ws_size, (size_t)WS_END); grid = -1; return; }
        int dev = 0, cus = 0, per_cu = 0;
        hipGetDevice(&dev); hipDeviceGetAttribute(&cus, hipDeviceAttributeMultiprocessorCount, dev);
        if (hipFuncSetAttribute((const void*)hybrid_fwd, hipFuncAttributeMaxDynamicSharedMemorySize, LDS_BYTES) != hipSuccess) { fprintf(stderr, "kernel_launch: hipFuncSetAttribute failed\n"); grid = -1; return; }
        if (hipOccupancyMaxActiveBlocksPerMultiprocessor(&per_cu, (const void*)hybrid_fwd, NTHREADS, LDS_BYTES) != hipSuccess || per_cu < 1) { fprintf(stderr, "kernel_launch: occupancy query gave %d\n", per_cu); per_cu = 1; }
        (void)hipGetLastError();
        grid = cus * 1;
        fprintf(stderr, "kernel_launch: grid %d (cus %d, per_cu %d)\n", grid, cus, per_cu);
    }
    if (grid < 0) return;
    if (hipMemsetAsync((char*)d_ws + WS_CTL, 0, WS_ZERO_BYTES, stream) != hipSuccess) { fprintf(stderr, "kernel_launch: hipMemsetAsync failed\n"); return; }
    KArgs a{};
    a.x = (const float*)d_in[0]; a.c = (const float*)d_in[1]; a.ctx = (const float*)d_in[2]; a.c_ctx = (const float*)d_in[3]; a.w_mod = (const float*)d_in[4]; a.b_mod = (const float*)d_in[5];
    a.g_pre = (const float*)d_in[6]; a.g_post = (const float*)d_in[7]; a.w_in = (const float*)d_in[8]; a.w_out = (const float*)d_in[9]; a.sink = (const float*)d_in[10]; a.w_f = (const float*)d_in[11];
    a.conv_w = (const float*)d_in[12]; a.conv_b = (const float*)d_in[13];
    a.out = (float*)d_out; a.ws = (unsigned char*)d_ws;
#if MK_MULTI
    for (int ph = 0; ph < 12; ++ph) { a.ph_lo = ph; a.ph_hi = ph + 1; hipLaunchKernelGGL(hybrid_fwd, dim3(grid), dim3(NTHREADS), LDS_BYTES, stream, a); }
#else
    a.ph_lo = 0; a.ph_hi = 12;
    void* args[] = {&a};
    hipError_t e = hipLaunchCooperativeKernel((const void*)hybrid_fwd, dim3(grid), dim3(NTHREADS), args, LDS_BYTES, stream);
    if (e != hipSuccess) fprintf(stderr, "kernel_launch: cooperative launch failed: %s (grid %d)\n", hipGetErrorString(e), grid);
#endif
}
```

```cpp
#include <hip/hip_runtime.h>
#include <hip/hip_cooperative_groups.h>
#include <cstdio>
#include <cstdint>
namespace cg = cooperative_groups;
namespace pg8 {
#define PG8_LAS __attribute__((address_space(3)))
typedef unsigned short bf16_t;
typedef short bf16x8 __attribute__((ext_vector_type(8)));
typedef float f32x4 __attribute__((ext_vector_type(4)));
typedef unsigned u32x4 __attribute__((ext_vector_type(4)));
constexpr int BM = 256, BK = 64, HALF = 128, HTB = HALF * BK * 2  , STAGE_BYTES = 8 * HTB, NXCD = 8, WGM = 8;

__host__ __device__ __forceinline__ int lds_byte(int r, int c) { const int st = (r >> 4) * 2 + (c >> 5), rr = r & 15, cc = c & 31, ob = rr * 64 + cc * 2; return st * 1024 + (ob ^ (((ob >> 9) & 1) << 5)); }
__host__ __device__ __forceinline__ void stage_rc(int b, int& R, int& C) { const int st = b / 1024, sb = b % 1024, swz = sb ^ (((sb >> 9) & 1) << 5); R = (st >> 1) * 16 + swz / 64; C = (st & 1) * 32 + (swz % 64) / 2; }
__host__ __device__ __forceinline__ int perm32(int rho) { const int n = rho >> 4, i = rho & 15; return 8 * (i >> 2) + 4 * n + (i & 3); }

struct Unit { int pm, pn; };
struct Gemm { const bf16_t* A; const bf16_t* Bt; int M, N, K; };

struct StaticOrder {
    int nM, nN, nwg, G, c;
    __host__ __device__ void init(int M, int N, int G_, int c_) { nM = M / BM; nN = N / BM; nwg = nM * nN; G = G_; c = c_; }
    __host__ __device__ bool next(int i, Unit& u) const {
        const long L = (long)i * G + c; if (L >= nwg) return false;
        int wgid = (int)L; { const int q = nwg / NXCD, r = nwg % NXCD, xcd = wgid % NXCD, off = wgid / NXCD; wgid = (xcd < r ? xcd * (q + 1) : r * (q + 1) + (xcd - r) * q) + off; }
        const int nig = WGM * nN, gid = wgid / nig, fm = gid * WGM, gsz = (nM - fm) < WGM ? (nM - fm) : WGM;
        u.pm = fm + ((wgid % nig) % gsz); u.pn = (wgid % nig) / gsz; return true;
    }
    __device__ __forceinline__ void a_ready(const Unit&) const {}
    __device__ __forceinline__ void done(const Unit&) const {}
};

__device__ __forceinline__ unsigned cvt_pk_bf16(float lo, float hi) { unsigned r; asm volatile("v_cvt_pk_bf16_f32 %0, %1, %2" : "=v"(r) : "v"(lo), "v"(hi)); return r; }
typedef unsigned u32x2 __attribute__((ext_vector_type(2)));
__device__ __forceinline__ int swap23(int t) { return (t & ~12) | ((t & 4) << 1) | ((t & 8) >> 1); }
struct EpiProj {
    static constexpr bool PERM = true, AFTER_DRAIN = false;
    bf16_t* P; bf16_t* Vt; const float* rope; bf16_t* UFP; float qscale;
    __device__ __forceinline__ void operator()(const f32x4 (&acc)[2][2][4][2], const Unit& u, int wr, int wc, int fr, int fq) const {
        const int row0 = u.pm * BM + wr * 64 + fr;
        const int pn = u.pn;
        const bool ctxrow = u.pm >= 128;
        f32x4 CS[2][4], SN[2][4];
        if (pn <= 2) {
#pragma unroll
            for (int ai = 0; ai < 2; ++ai)
#pragma unroll
                for (int m = 0; m < 4; ++m) {
                    CS[ai][m] = (f32x4){1.f, 1.f, 1.f, 1.f}; SN[ai][m] = (f32x4){0.f, 0.f, 0.f, 0.f};
                    if (!ctxrow) { const int t = (row0 + ai * HALF + m * 16) & 8191; const int pos = (wc & 1) ? (t & 63) : (t >> 6);
                        CS[ai][m] = *(const f32x4*)(rope + pos * 32 + 4 * fq); SN[ai][m] = *(const f32x4*)(rope + pos * 32 + 16 + 4 * fq); }
                }
            __builtin_amdgcn_sched_barrier(0);
        }
#pragma unroll
        for (int ai = 0; ai < 2; ++ai)
#pragma unroll
            for (int m = 0; m < 4; ++m) {
                const int row = row0 + ai * HALF + m * 16;
                bf16_t* rowp = P + (size_t)row * 2816 + pn * BM + wc * 32 + 8 * fq;
                if (pn == 5 && !ctxrow) { const int t = row & 8191; rowp = UFP + ((size_t)(((row >> 13) * 64 + (t & 63)) * 128 + (t >> 6))) * 256 + wc * 32 + 8 * fq; }
                if (pn > 2) {
#pragma unroll
                    for (int bj = 0; bj < 2; ++bj) { const f32x4 v0 = acc[ai][bj][m][0], v1 = acc[ai][bj][m][1];
                        u32x4 w; w.x = cvt_pk_bf16(v0[0], v0[1]); w.y = cvt_pk_bf16(v0[2], v0[3]); w.z = cvt_pk_bf16(v1[0], v1[1]); w.w = cvt_pk_bf16(v1[2], v1[3]);
                        *(u32x4*)(rowp + bj * HALF) = w; }
                } else {
                    const f32x4 cs = CS[ai][m], sn = SN[ai][m];
#pragma unroll
                    for (int bj = 0; bj < 2; ++bj) {
                        f32x4 v0 = acc[ai][bj][m][0], v1 = acc[ai][bj][m][1];
                        if (pn == 2 && bj == 1) {
                            int b, tok; if (ctxrow) { const int rr = row - 32768; b = rr >> 8; tok = 8192 + (rr & 255); } else { b = row >> 13; tok = row & 8191; }
                            const int ptok = swap23(tok);
                            bf16_t* vp = Vt + ((size_t)((b * 2 + (wc >> 1)) * 64 + 32 * (wc & 1) + 8 * fq)) * 8448 + ptok;
                            const unsigned w0 = cvt_pk_bf16(v0[0], v0[1]), w1 = cvt_pk_bf16(v0[2], v0[3]), w2 = cvt_pk_bf16(v1[0], v1[1]), w3 = cvt_pk_bf16(v1[2], v1[3]);
                            vp[0 * 8448] = (bf16_t)(w0 & 0xffffu); vp[1 * 8448] = (bf16_t)(w0 >> 16); vp[2 * 8448] = (bf16_t)(w1 & 0xffffu); vp[3 * 8448] = (bf16_t)(w1 >> 16);
                            vp[4 * 8448] = (bf16_t)(w2 & 0xffffu); vp[5 * 8448] = (bf16_t)(w2 >> 16); vp[6 * 8448] = (bf16_t)(w3 & 0xffffu); vp[7 * 8448] = (bf16_t)(w3 >> 16);
                        } else {
                            const f32x4 r0 = v0 * cs - v1 * sn, r1 = v0 * sn + v1 * cs;
                            v0 = r0; v1 = r1;
                            if (pn < 2) { v0 = v0 * qscale; v1 = v1 * qscale; }
                            u32x4 w; w.x = cvt_pk_bf16(v0[0], v0[1]); w.y = cvt_pk_bf16(v0[2], v0[3]); w.z = cvt_pk_bf16(v1[0], v1[1]); w.w = cvt_pk_bf16(v1[2], v1[3]);
                            *(u32x4*)(rowp + bj * HALF) = w;
                        }
                    }
                }
            }
    }
};
struct EpiY {
    static constexpr bool PERM = true, AFTER_DRAIN = false;
    bf16_t* Y; float* ssq;
    __device__ __forceinline__ void operator()(const f32x4 (&acc)[2][2][4][2], const Unit& u, int wr, int wc, int fr, int fq) const {
        const int row0 = u.pm * BM + wr * 64 + fr;
#pragma unroll
        for (int ai = 0; ai < 2; ++ai)
#pragma unroll
            for (int m = 0; m < 4; ++m) {
                const int row = row0 + ai * HALF + m * 16;
                bf16_t* rowp = Y + (size_t)row * 1024 + u.pn * BM + wc * 32 + 8 * fq;
                float s = 0.f;
#pragma unroll
                for (int bj = 0; bj < 2; ++bj) { const f32x4 v0 = acc[ai][bj][m][0], v1 = acc[ai][bj][m][1];
                    s += (v0[0] * v0[0] + v0[1] * v0[1]) + (v0[2] * v0[2] + v0[3] * v0[3]) + (v1[0] * v1[0] + v1[1] * v1[1]) + (v1[2] * v1[2] + v1[3] * v1[3]);
                    u32x4 w; w.x = cvt_pk_bf16(v0[0], v0[1]); w.y = cvt_pk_bf16(v0[2], v0[3]); w.z = cvt_pk_bf16(v1[0], v1[1]); w.w = cvt_pk_bf16(v1[2], v1[3]);
                    *(u32x4*)(rowp + bj * HALF) = w; }
                s += __shfl_xor(s, 16); s += __shfl_xor(s, 32);
                if (fq == 0) ssq[(size_t)row * 16 + u.pn * 4 + wc] = s;
            }
    }
};
template <class Epi, class Sched, bool ALIGN_EPI = false, bool SP2 = false>
__device__ __forceinline__ void gemm_phase(PG8_LAS unsigned char* lds, const Gemm g, const Sched& S, const Epi& E) {
    int tid_ = threadIdx.x; asm volatile("" : "+v"(tid_));
    const int tid = tid_, wid = __builtin_amdgcn_readfirstlane(tid >> 6), lane = tid & 63, wr = wid >> 2, wc = wid & 3, fr = lane & 15, fq = lane >> 4;
    const int K = g.K, nt = K / BK;
    unsigned voffA[2], voffB[2];
#pragma unroll
    for (int i = 0; i < 2; ++i) { int R, C; stage_rc(tid * 16 + i * 8192, R, C); const int Rb = Epi::PERM ? ((R & ~31) + perm32(R & 31)) : R;
        voffA[i] = (unsigned)(R * K + C) * 2u; voffB[i] = (unsigned)(Rb * K + C) * 2u; }
    const size_t kstep = (size_t)(BK * 2);
    const size_t hstep = (size_t)HALF * K * 2;
    const size_t tstep = 2 * hstep;
    const unsigned ldsw = (unsigned)wid * 1024u;
    const int aoff = lds_byte(wr * 64 + fr, fq * 8), boff = lds_byte(wc * 32 + fr, fq * 8);
#define PG8_SA(b, h) (((b) * 2 + (h)) * HTB)
#define PG8_SB(b, h) ((4 + (b) * 2 + (h)) * HTB)
#define PG8_STAGE(bufoff, gbase, voff) do { _Pragma("unroll") for (int _i = 0; _i < 2; ++_i) \
        __builtin_amdgcn_global_load_lds((const unsigned*)((const char*)(gbase) + (voff)[_i]), (PG8_LAS unsigned*)(lds + (bufoff) + ldsw + _i * 8192), 16, 0, 0); } while (0)
#define PG8_LDA(dst, b, h) do { _Pragma("unroll") for (int m = 0; m < 4; ++m) _Pragma("unroll") for (int k = 0; k < 2; ++k) dst[m][k] = *(const PG8_LAS bf16x8*)(lds + PG8_SA(b, h) + aoff + m * 2048 + k * 1024); } while (0)
#define PG8_LDB(dst, b, h) do { _Pragma("unroll") for (int n = 0; n < 2; ++n) _Pragma("unroll") for (int k = 0; k < 2; ++k) dst[n][k] = *(const PG8_LAS bf16x8*)(lds + PG8_SB(b, h) + boff + n * 2048 + k * 1024); } while (0)
#define PG8_MMA(ai, bj, At, Bt) do { __builtin_amdgcn_s_setprio(1); _Pragma("unroll") for (int m = 0; m < 4; ++m) _Pragma("unroll") for (int n = 0; n < 2; ++n) _Pragma("unroll") for (int k = 0; k < 2; ++k) \
        acc[ai][bj][m][n] = __builtin_amdgcn_mfma_f32_16x16x32_bf16(Bt[n][k], At[m][k], acc[ai][bj][m][n], 0, 0, 0); __builtin_amdgcn_s_setprio(0); } while (0)
#define PG8_WAIT_V(n) asm volatile("s_waitcnt vmcnt(" #n ")" ::: "memory")
#define PG8_WAIT_L(n) asm volatile("s_waitcnt lgkmcnt(" #n ")" ::: "memory")
#define PG8_BAR __builtin_amdgcn_s_barrier()
#define PG8_SCHED __builtin_amdgcn_sched_barrier(0)
    Unit cur, nxt; int ui = 0;
    if (!S.next(0, cur)) return;
    f32x4 acc[2][2][4][2];
#pragma unroll
    for (int a = 0; a < 2; ++a)
#pragma unroll
        for (int b = 0; b < 2; ++b)
#pragma unroll
            for (int m = 0; m < 4; ++m)
#pragma unroll
                for (int n = 0; n < 2; ++n) acc[a][b][m][n] = (f32x4){0.f, 0.f, 0.f, 0.f};
    bf16x8 At[4][2], B0[2][2], B1[2][2];
    const char* cA = (const char*)g.A + (size_t)cur.pm * tstep; const char* cB = (const char*)g.Bt + (size_t)cur.pn * tstep;
    S.a_ready(cur);
    if constexpr (SP2) {
        PG8_STAGE(PG8_SB(0, 0), cB, voffB); PG8_STAGE(PG8_SB(0, 1), cB + hstep, voffB); PG8_STAGE(PG8_SA(0, 0), cA, voffA); PG8_STAGE(PG8_SA(0, 1), cA + hstep, voffA);
        if (wr == 1) PG8_BAR;
        PG8_WAIT_V(2); PG8_BAR;
        PG8_STAGE(PG8_SB(1, 0), cB + kstep, voffB); PG8_STAGE(PG8_SA(1, 0), cA + kstep, voffA); PG8_STAGE(PG8_SB(1, 1), cB + hstep + kstep, voffB);
        PG8_WAIT_V(6); PG8_BAR;
    } else {
        PG8_STAGE(PG8_SB(0, 0), cB, voffB); PG8_STAGE(PG8_SA(0, 0), cA, voffA); PG8_STAGE(PG8_SB(0, 1), cB + hstep, voffB); PG8_STAGE(PG8_SA(0, 1), cA + hstep, voffA);
        if (wr == 1) PG8_BAR;
        PG8_WAIT_V(4); PG8_BAR;
        PG8_STAGE(PG8_SB(1, 0), cB + kstep, voffB); PG8_STAGE(PG8_SA(1, 0), cA + kstep, voffA); PG8_STAGE(PG8_SB(1, 1), cB + hstep + kstep, voffB);
        PG8_WAIT_V(6); PG8_BAR;
    }
    for (;;) {
        const bool has_next = S.next(ui + 1, nxt);
        const char* nA = has_next ? (const char*)g.A + (size_t)nxt.pm * tstep : cA; const char* nB = has_next ? (const char*)g.Bt + (size_t)nxt.pn * tstep : cB;
        for (int t = 0; t < nt; t += 2) {
            const bool last = (t == nt - 2);
            const char* a1 = cA + (size_t)(t + 1) * kstep;
            const char* a2 = last ? nA : cA + (size_t)(t + 2) * kstep; const char* b2 = last ? nB : cB + (size_t)(t + 2) * kstep;
            const char* a3 = a2 + kstep; const char* b3 = b2 + kstep;
            if (last && has_next) S.a_ready(nxt);
            if constexpr (SP2) {
            PG8_LDB(B0, 0, 0); PG8_LDB(B1, 0, 1); PG8_SCHED; PG8_LDA(At, 0, 0); PG8_STAGE(PG8_SA(1, 1), a1 + hstep, voffA);
            PG8_WAIT_V(8); PG8_WAIT_L(0); PG8_BAR; PG8_MMA(0, 0, At, B0); PG8_MMA(0, 1, At, B1); PG8_BAR; PG8_SCHED;
            PG8_LDA(At, 0, 1); PG8_STAGE(PG8_SB(0, 0), b2, voffB); PG8_STAGE(PG8_SB(0, 1), b2 + hstep, voffB); PG8_STAGE(PG8_SA(0, 0), a2, voffA);
            PG8_WAIT_V(8); PG8_WAIT_L(0); PG8_BAR; PG8_MMA(1, 0, At, B0); PG8_MMA(1, 1, At, B1); PG8_BAR; PG8_SCHED;
            PG8_LDB(B0, 1, 0); PG8_LDB(B1, 1, 1); PG8_SCHED; PG8_LDA(At, 1, 0); PG8_STAGE(PG8_SA(0, 1), a2 + hstep, voffA);
            PG8_WAIT_V(8); PG8_WAIT_L(0); PG8_BAR; PG8_MMA(0, 0, At, B0); PG8_MMA(0, 1, At, B1); PG8_BAR; PG8_SCHED;
            PG8_LDA(At, 1, 1); PG8_STAGE(PG8_SB(1, 0), b3, voffB); PG8_STAGE(PG8_SB(1, 1), b3 + hstep, voffB); PG8_STAGE(PG8_SA(1, 0), a3, voffA);
            PG8_WAIT_V(8); PG8_WAIT_L(0); PG8_BAR; PG8_MMA(1, 0, At, B0); PG8_MMA(1, 1, At, B1); PG8_BAR; PG8_SCHED;
            } else {
            PG8_LDB(B0, 0, 0); PG8_SCHED; PG8_LDA(At, 0, 0); PG8_STAGE(PG8_SA(1, 1), a1 + hstep, voffA);
            PG8_WAIT_L(8); PG8_BAR; PG8_WAIT_L(0); PG8_MMA(0, 0, At, B0); PG8_BAR; PG8_SCHED;
            PG8_LDB(B1, 0, 1); PG8_STAGE(PG8_SB(0, 0), b2, voffB);
            PG8_BAR; PG8_WAIT_L(0); PG8_MMA(0, 1, At, B1); PG8_BAR;
            PG8_LDA(At, 0, 1); PG8_STAGE(PG8_SA(0, 0), a2, voffA);
            PG8_BAR; PG8_WAIT_L(0); PG8_MMA(1, 0, At, B0); PG8_BAR; PG8_SCHED;
            PG8_STAGE(PG8_SB(0, 1), b2 + hstep, voffB);
            PG8_WAIT_V(6); PG8_BAR; PG8_MMA(1, 1, At, B1); PG8_BAR;
            PG8_LDB(B0, 1, 0); PG8_SCHED; PG8_LDA(At, 1, 0); PG8_STAGE(PG8_SA(0, 1), a2 + hstep, voffA);
            PG8_WAIT_L(8); PG8_BAR; PG8_WAIT_L(0); PG8_MMA(0, 0, At, B0); PG8_BAR; PG8_SCHED;
            PG8_LDB(B1, 1, 1); PG8_STAGE(PG8_SB(1, 0), b3, voffB);
            PG8_BAR; PG8_WAIT_L(0); PG8_MMA(0, 1, At, B1); PG8_BAR;
            PG8_LDA(At, 1, 1); PG8_STAGE(PG8_SA(1, 0), a3, voffA);
            PG8_BAR; PG8_WAIT_L(0); PG8_MMA(1, 0, At, B0); PG8_BAR; PG8_SCHED;
            PG8_STAGE(PG8_SB(1, 1), b3 + hstep, voffB);
            PG8_WAIT_V(6); PG8_BAR; PG8_MMA(1, 1, At, B1); PG8_BAR;
            }
        }
        if constexpr (ALIGN_EPI) { if (wr == 0) PG8_BAR; }
        if constexpr (!Epi::AFTER_DRAIN) { E(acc, cur, wr, wc, fr, fq); S.done(cur); }
        if (!has_next) break;
#pragma unroll
        for (int a = 0; a < 2; ++a)
#pragma unroll
            for (int b = 0; b < 2; ++b)
#pragma unroll
                for (int m = 0; m < 4; ++m)
#pragma unroll
                    for (int n = 0; n < 2; ++n) acc[a][b][m][n] = (f32x4){0.f, 0.f, 0.f, 0.f};
        cur = nxt; cA = nA; cB = nB; ++ui;
        if constexpr (ALIGN_EPI) { if (wr == 1) PG8_BAR; }
    }
    PG8_WAIT_V(0);
    if constexpr (!ALIGN_EPI) { if (wr == 0) PG8_BAR; }
    PG8_BAR;
    if constexpr (Epi::AFTER_DRAIN) { E.fused(acc, cur, wr, wc, fr, fq, lds, wid, lane); S.done(cur); }
#undef PG8_SA
#undef PG8_SB
#undef PG8_STAGE
#undef PG8_LDA
#undef PG8_LDB
#undef PG8_MMA
#undef PG8_WAIT_V
#undef PG8_WAIT_L
#undef PG8_BAR
#undef PG8_SCHED
}
}

typedef unsigned short bf16_t;
typedef short bf16x8 __attribute__((ext_vector_type(8)));
typedef float f32x4 __attribute__((ext_vector_type(4)));
typedef float f32x16 __attribute__((ext_vector_type(16)));
typedef unsigned u32x4 __attribute__((ext_vector_type(4)));
typedef unsigned u32x2 __attribute__((ext_vector_type(2)));
#define LAS __attribute__((address_space(3)))
__device__ __forceinline__ int opaque_tid() { int t = threadIdx.x; asm volatile("" : "+v"(t)); return t; }

constexpr int DM = 1024, NBATCH = 4, SEQ = 8192, NTOK = NBATCH * SEQ, CTXL = 256, NCTX = NBATCH * CTXL, MROWS = NTOK + NCTX;
constexpr int PW = 2816;
constexpr int C_Q = 0, C_K = 512, C_V = 640, C_GA = 768, C_UF = 1280, C_GF = 1536, C_ZC = 1792, C_BC = 2048, C_CC = 2304, C_GC = 2560;
constexpr int VT_PITCH = SEQ + CTXL;
constexpr float NORM_EPS = 1e-6f;
constexpr float LOG2E = 1.4426950408889634f;

constexpr size_t KiB = 1024, MiB = 1u << 20;
constexpr size_t WS_CTL = 0;
constexpr size_t WS_BAR = 16 * KiB;
constexpr size_t WS_ZERO_BYTES = 32 * KiB;
constexpr size_t WS_MOD = 64 * KiB;
constexpr size_t WS_ROPE = 256 * KiB;
constexpr size_t WS_TW = 320 * KiB;
constexpr size_t WS_T1R = 384 * KiB, WS_T1I = 416 * KiB;
constexpr size_t WS_T3R = 448 * KiB, WS_T3I = 464 * KiB;
constexpr size_t WS_T256R = 512 * KiB, WS_T256I = 640 * KiB;
constexpr size_t WS_GT = 768 * KiB;
constexpr size_t WS_SSQ = 1 * MiB;
constexpr size_t WS_WIN = 4 * MiB;
constexpr size_t WS_WOUT = 16 * MiB;
constexpr size_t WS_MODP = 24 * MiB;
constexpr size_t WS_HX = 32 * MiB;
constexpr size_t WS_P = 112 * MiB;
constexpr size_t WS_VT = 304 * MiB;
constexpr size_t WS_H = 320 * MiB;
constexpr size_t WS_Y = 392 * MiB;
constexpr size_t WS_YF = 464 * MiB;
constexpr size_t WS_CTX1 = 100 * MiB;
constexpr size_t WS_UFP = 496 * MiB;
constexpr size_t WS_END = 512 * MiB;
static_assert(WS_BAR + 3456 * 4 <= WS_ZERO_BYTES && WS_MODP + (size_t)2 * 8 * 5 * 3072 * 4 <= WS_HX && WS_SSQ + (size_t)MROWS * 16 * 4 <= WS_WIN && WS_WIN + (size_t)2 * PW * DM * 2 <= WS_WOUT && WS_HX + (size_t)MROWS * DM * 2 <= WS_P && WS_P + (size_t)MROWS * PW * 2 <= WS_VT &&
              WS_VT + (size_t)8 * 64 * VT_PITCH * 2 <= WS_H && WS_H + (size_t)MROWS * DM * 2 <= WS_Y && WS_Y + (size_t)MROWS * DM * 2 <= WS_YF && WS_YF + (size_t)4 * 128 * 64 * 512 * 2 <= WS_UFP && WS_UFP + (size_t)NTOK * 256 * 2 <= WS_END && WS_HX + (size_t)MROWS * DM * 2 <= WS_CTX1 && WS_CTX1 + (size_t)NCTX * DM * 4 <= WS_P, "ws map");

constexpr int LDS_BYTES = 147456;
constexpr int LDS_SCHED = LDS_BYTES - 64;
constexpr int LDS_BARST = LDS_BYTES - 32;
constexpr int NTHREADS = 512;

__device__ __forceinline__ float bf2f(unsigned h) { return __uint_as_float(h << 16); }
__device__ __forceinline__ unsigned pkbf(float lo, float hi) { unsigned r; asm volatile("v_cvt_pk_bf16_f32 %0, %1, %2" : "=v"(r) : "v"(lo), "v"(hi)); return r; }
__device__ __forceinline__ float silu_f(float x) { return x * __builtin_amdgcn_rcpf(1.f + __builtin_amdgcn_exp2f(-x * LOG2E)); }
__device__ __forceinline__ float wave_sum(float v) {
#pragma unroll
    for (int o = 1; o < 64; o <<= 1) v += __shfl_xor(v, o);
    return v;
}
__device__ __forceinline__ int swap23(int t) { return (t & ~12) | ((t & 4) << 1) | ((t & 8) >> 1); }
__device__ __forceinline__ int crow(int r, int hi) { return (r & 3) + 8 * (r >> 2) + 4 * hi; }
__device__ __forceinline__ bf16x8 pack8(const f32x16& p, int base) {
    u32x4 w; w.x = pkbf(p[base + 0], p[base + 1]); w.y = pkbf(p[base + 2], p[base + 3]); w.z = pkbf(p[base + 4], p[base + 5]); w.w = pkbf(p[base + 6], p[base + 7]);
    return __builtin_bit_cast(bf16x8, w);
}
#define MFMA32(a, b, c) __builtin_amdgcn_mfma_f32_32x32x16_bf16((a), (b), (c), 0, 0, 0)

struct KArgs {
    const float *x, *c, *ctx, *c_ctx, *w_mod, *b_mod, *g_pre, *g_post, *w_in, *w_out, *sink, *w_f, *conv_w, *conv_b;
    float* out; unsigned char* ws; int ph_lo, ph_hi;
};

__device__ __forceinline__ int prow_qk(int n) { return (n & ~31) | (8 * ((n >> 2) & 3) + 4 * ((n >> 4) & 1) + (n & 3)); }
__device__ __forceinline__ void p0_transpose_item(const float* W, int K, int N, bf16_t* WT, int nperm, float* scr, int item, int lane) {
    const int nblk = N / 32, kb = item / nblk, nb = item % nblk, k0 = 64 * kb, n0 = 32 * nb;
#pragma unroll 8
    for (int i = 0; i < 32; ++i) { const int kk = 2 * i + (lane >> 5); scr[kk * 33 + (lane & 31)] = W[(size_t)(k0 + kk) * N + n0 + (lane & 31)]; }
    asm volatile("s_waitcnt lgkmcnt(0)" ::: "memory");
    const int c = lane & 7;
#pragma unroll
    for (int j = 0; j < 4; ++j) { const int n = (lane >> 3) + 8 * j; const float* s = scr + (8 * c) * 33 + n;
        u32x4 o; o.x = pkbf(s[0 * 33], s[1 * 33]); o.y = pkbf(s[2 * 33], s[3 * 33]); o.z = pkbf(s[4 * 33], s[5 * 33]); o.w = pkbf(s[6 * 33], s[7 * 33]);
        const int nl = n0 + n; const int np = nl < nperm ? prow_qk(nl) : nl;
        *(u32x4*)(WT + (size_t)np * K + k0 + 8 * c) = o; }
    asm volatile("s_waitcnt lgkmcnt(0)" ::: "memory");
}

__device__ __forceinline__ void p0_mod_gemv(const KArgs& a, int item, float* ldsf) {
    const int tid = opaque_tid(), lane = tid & 63, wave = tid >> 6;
    const int l = item / 96, col0 = (item % 96) * 32;
    float* s = ldsf;
    float* red = ldsf + 5 * 1024;
    for (int i = tid; i < 5 * 1024; i += NTHREADS) { const int bb = i >> 10, k = i & 1023; const float v = bb < 4 ? a.c[bb * 1024 + k] : a.c_ctx[k]; s[i] = v / (1.f + __expf(-v)); }
    __syncthreads();
    const int col = lane & 31, kh = lane >> 5;
    const float* W = a.w_mod + (size_t)l * 1024 * 3072 + (size_t)(wave * 128 + kh) * 3072 + col0 + col;
    float w[64];
#pragma unroll
    for (int i = 0; i < 64; ++i) w[i] = W[(size_t)(2 * i) * 3072];
    float acc[5] = {0.f, 0.f, 0.f, 0.f, 0.f};
#pragma unroll
    for (int i = 0; i < 64; ++i)
#pragma unroll
        for (int bb = 0; bb < 5; ++bb) acc[bb] += w[i] * s[bb * 1024 + wave * 128 + 2 * i + kh];
#pragma unroll
    for (int bb = 0; bb < 5; ++bb) red[((wave * 2 + kh) * 5 + bb) * 32 + col] = acc[bb];
    __syncthreads();
    if (tid < 160) { const int bb = tid >> 5, cc = tid & 31; float v = a.b_mod[l * 3072 + col0 + cc];
#pragma unroll
        for (int ww = 0; ww < 16; ++ww) v += red[(ww * 5 + bb) * 32 + cc];
        ((float*)(a.ws + WS_MOD))[(l * 5 + bb) * 3072 + col0 + cc] = v; }
    __syncthreads();
}

__device__ __forceinline__ void p0_prologue(const KArgs& a, unsigned char* lds) {
    const int tid = opaque_tid(), lane = tid & 63, wave = tid >> 6;
    const int G = gridDim.x, bx = blockIdx.x;
    unsigned char* ws = a.ws;
    if (bx < 192) p0_mod_gemv(a, bx, (float*)lds);
    {
        float* scr = (float*)(lds + wave * 16384);
        const int gw = bx * 8 + wave, NGW = G * 8;
        constexpr int I_IN = (DM / 64) * (PW / 32), I_OUT = (DM / 64) * (DM / 32);
        constexpr int NIT = 2 * (I_IN + I_OUT);
        for (int it = gw; it < NIT; it += NGW) {
            int r = it; const int l = r / (I_IN + I_OUT); r -= l * (I_IN + I_OUT);
            if (r < I_IN) p0_transpose_item(a.w_in + (size_t)l * DM * PW, DM, PW, (bf16_t*)(ws + WS_WIN) + (size_t)l * PW * DM, 640, scr, r, lane);
            else p0_transpose_item(a.w_out + (size_t)l * DM * DM, DM, DM, (bf16_t*)(ws + WS_WOUT) + (size_t)l * DM * DM, 0, scr, r - I_IN, lane);
        }
    }
    const int gt = bx * NTHREADS + tid, NGT = G * NTHREADS;
    for (int i = gt; i < 128 * 16; i += NGT) {
        const int pos = i >> 4, f = i & 15; const float inv = powf(10000.0f, -(float)f / 16.0f); const float ang = (float)pos * inv;
        float* rp = (float*)(ws + WS_ROPE) + pos * 32; rp[f] = cosf(ang); rp[16 + f] = sinf(ang);
    }
    for (int i = gt; i < 8192; i += NGT) { float sn, cs; sincospif((float)i * (2.0f / 8192.0f), &sn, &cs); float* t = (float*)(ws + WS_TW) + 2 * i; t[0] = cs; t[1] = sn; }
    for (int i = gt; i < 128 * 128; i += NGT) { const int k = i >> 7, n = i & 127; float sn, cs; sincospif((float)((k * n) & 127) * (2.0f / 128.0f), &sn, &cs);
        ((bf16_t*)(ws + WS_T1R))[i] = (bf16_t)(pkbf(cs, 0.f) & 0xffffu); ((bf16_t*)(ws + WS_T1I))[i] = (bf16_t)(pkbf(-sn, 0.f) & 0xffffu); }
    for (int i = gt; i < 64 * 128; i += NGT) { const int k = i >> 7, kk = i & 127, n = kk & 63; float sn, cs; sincospif((float)((k * n) & 63) * (2.0f / 64.0f), &sn, &cs);
        const float tr = kk < 64 ? cs : sn, ti = kk < 64 ? -sn : cs;
        ((bf16_t*)(ws + WS_T3R))[i] = (bf16_t)(pkbf(tr, 0.f) & 0xffffu); ((bf16_t*)(ws + WS_T3I))[i] = (bf16_t)(pkbf(ti, 0.f) & 0xffffu); }
    for (int i = gt; i < 256 * 256; i += NGT) { const int k = i >> 8, n = i & 255; float sn, cs; sincospif((float)((k * n) & 255) * (2.0f / 256.0f), &sn, &cs);
        ((bf16_t*)(ws + WS_T256R))[i] = (bf16_t)(pkbf(cs, 0.f) & 0xffffu); ((bf16_t*)(ws + WS_T256I))[i] = (bf16_t)(pkbf(-sn, 0.f) & 0xffffu); }
    {
        __syncthreads();
        float* trig = (float*)lds;
        if (tid < 64) { float sn, cs; sincospif((float)tid * (2.0f / 64.0f), &sn, &cs); trig[tid] = cs; trig[64 + tid] = sn; }
        __syncthreads();
        for (int i = gt; i < 2 * 4 * 64 * 128; i += NGT) {
            const int kk = i & 127, d = (i >> 7) & 63, g = (i >> 13) & 3, l = i >> 15; const int part = kk >> 6, c = swap23(kk & 63);
            const float* wf = a.w_f + ((size_t)(l * 4 + g) * 64) * 64 + d; float sacc = 0.f;
#pragma unroll 8
            for (int j = 0; j < 64; ++j) sacc += trig[part * 64 + ((c * j) & 63)] * wf[j * 64];
            ((bf16_t*)(ws + WS_GT))[i] = (bf16_t)(pkbf(sacc * (1.0f / 724.0773439350246f), 0.f) & 0xffffu);
        }
        __syncthreads();
    }
}

__device__ __forceinline__ void norm_rows4(int mode, int lane, const float* src, float* dst, const bf16_t* y, const float* ssq, bf16_t* hx,
                                           const f32x4 (&GA)[4], const f32x4 (&GB)[4], const f32x4 (&GC)[4]) {
    f32x4 v[4][4];
#pragma unroll
    for (int rr = 0; rr < 4; ++rr)
#pragma unroll
        for (int j = 0; j < 4; ++j) v[rr][j] = *(const f32x4*)(src + (size_t)rr * DM + 4 * lane + 256 * j);
    if (mode != 0) {
        u32x2 yw[4][4]; float p[4];
#pragma unroll
        for (int rr = 0; rr < 4; ++rr) { p[rr] = ssq[rr * 16 + (lane & 15)];
#pragma unroll
            for (int j = 0; j < 4; ++j) yw[rr][j] = *(const u32x2*)(y + (size_t)rr * DM + 4 * lane + 256 * j); }
#pragma unroll
        for (int rr = 0; rr < 4; ++rr) {
            float q = p[rr]; q += __shfl_xor(q, 1); q += __shfl_xor(q, 2); q += __shfl_xor(q, 4); q += __shfl_xor(q, 8);
            const float rstd = 1.0f / sqrtf(q * (1.0f / DM) + NORM_EPS);
#pragma unroll
            for (int j = 0; j < 4; ++j) {
                f32x4 yy; yy[0] = bf2f(yw[rr][j].x & 0xffffu); yy[1] = bf2f(yw[rr][j].x >> 16); yy[2] = bf2f(yw[rr][j].y & 0xffffu); yy[3] = bf2f(yw[rr][j].y >> 16);
                v[rr][j] = v[rr][j] + GA[j] * (yy * rstd);
                *(f32x4*)(dst + (size_t)rr * DM + 4 * lane + 256 * j) = v[rr][j];
            }
        }
    }
    if (mode != 2) {
        float s[4];
#pragma unroll
        for (int rr = 0; rr < 4; ++rr) { float t = 0.f;
#pragma unroll
            for (int j = 0; j < 4; ++j) t += (v[rr][j][0] * v[rr][j][0] + v[rr][j][1] * v[rr][j][1]) + (v[rr][j][2] * v[rr][j][2] + v[rr][j][3] * v[rr][j][3]);
            s[rr] = t; }
#pragma unroll
        for (int o = 1; o < 64; o <<= 1) {
#pragma unroll
            for (int rr = 0; rr < 4; ++rr) s[rr] += __shfl_xor(s[rr], o); }
#pragma unroll
        for (int rr = 0; rr < 4; ++rr) {
            const float rstd = 1.0f / sqrtf(s[rr] * (1.0f / DM) + NORM_EPS);
#pragma unroll
            for (int j = 0; j < 4; ++j) {
                const f32x4 o = (v[rr][j] * rstd) * GB[j] + GC[j];
                u32x2 w; w.x = pkbf(o[0], o[1]); w.y = pkbf(o[2], o[3]);
                *(u32x2*)(hx + (size_t)rr * DM + 4 * lane + 256 * j) = w;
            }
        }
    }
}
__device__ __forceinline__ void norm_phase(const KArgs& a, int mode) {
    const int tid = opaque_tid(), lane = tid & 63, wave = tid >> 6;
    const int NGW = gridDim.x * 8;
    unsigned char* ws = a.ws;
    const float* mod = (const float*)(ws + WS_MOD);
    const int lp = (mode == 0) ? 0 : 1;
    const int lq = (mode == 1) ? 0 : 1;
    bf16_t* HX = (bf16_t*)(ws + WS_HX); const bf16_t* Y = (const bf16_t*)(ws + WS_Y); const float* SSQ = (const float*)(ws + WS_SSQ);
    const int gw2 = wave * (int)gridDim.x + (int)blockIdx.x;
    const int nlat = NTOK / 4;
    int curb = -1; f32x4 GA[4], GB[4], GC[4];
    int base = gw2 * 4, sub = 0, itc = nlat + gw2; bool inctx = false;
    for (;;) {
        int it;
        if (!inctx) { if (base >= nlat) { inctx = true; continue; } it = base + sub; if (++sub == 4) { sub = 0; base += NGW * 4; } }
        else { if (mode == 2 || itc >= nlat + NCTX / 4) break; it = itc; itc += NGW; }
        const int r = it * 4;
        const int b = r < NTOK ? (r >> 13) : 4;
        if (b != curb) { curb = b;
            const float* mp = mod + (lp * 5 + b) * 3072; const float* mq = mod + (lq * 5 + b) * 3072;
#pragma unroll
            for (int j = 0; j < 4; ++j) { const int c = 4 * lane + 256 * j;
                GA[j] = *(const f32x4*)(mq + 2048 + c) * *(const f32x4*)(a.g_post + lq * DM + c);
                GB[j] = *(const f32x4*)(a.g_pre + lp * DM + c) * (*(const f32x4*)(mp + 1024 + c) + 1.0f);
                GC[j] = *(const f32x4*)(mp + c); } }
        const float* src; float* dst;
        if (r < NTOK) { src = (mode == 2 ? (const float*)a.out : a.x) + (size_t)r * DM; dst = a.out + (size_t)r * DM; }
        else { src = a.ctx + (size_t)(r - NTOK) * DM; dst = (float*)(ws + WS_CTX1) + (size_t)(r - NTOK) * DM; }
        norm_rows4(mode, lane, src, dst, Y + (size_t)r * DM, SSQ + (size_t)r * 16, HX + (size_t)r * DM, GA, GB, GC);
    }
}

__device__ __forceinline__ void attn_unit(int u, const bf16_t* P, const bf16_t* Vt, bf16_t* H, const float* sink, unsigned char* lds) {
    const int tid = opaque_tid(), lane = tid & 63, wave = __builtin_amdgcn_readfirstlane(tid >> 6), r32 = lane & 31, hi = lane >> 5;
    const bool isctx = u >= 1024;
    int b, kvh, qb;
    if (isctx) { const int v = u - 1024; b = v >> 3; kvh = (v >> 2) & 1; qb = v & 3; } else { b = u >> 8; kvh = (u >> 7) & 1; qb = u & 127; }
    const int head = kvh * 4 + (wave >> 1);
    const int qtok = qb * 64 + (wave & 1) * 32 + r32;
    const size_t qrow = isctx ? (size_t)(NTOK + b * CTXL + qtok) : (size_t)(b * SEQ + qtok);
    const float sinkv = sink[head];
    bf16x8 qf[4];
#pragma unroll
    for (int d0 = 0; d0 < 4; ++d0) qf[d0] = *(const bf16x8*)(P + qrow * PW + C_Q + head * 64 + d0 * 16 + hi * 8);
    int jlo = 0, jhi = -1;
    if (!isctx) { jlo = qb < 2 ? 2 - qb : 0; jhi = (129 - qb) < 4 ? (129 - qb) : 4; }
    const int ntiles = 4 + (jhi - jlo + 1);
    const int srow = tid >> 3, sch = tid & 7;
    const bf16_t* Kc = P + (size_t)(NTOK + b * CTXL + srow) * PW + C_K + kvh * 64 + sch * 8;
    const bf16_t* Kl = P + (size_t)(b * SEQ + srow) * PW + C_K + kvh * 64 + sch * 8;
    const bf16_t* Vb = Vt + (size_t)((b * 2 + kvh) * 64 + srow) * VT_PITCH + sch * 8;
    unsigned char* Ks = lds; unsigned char* Vs = lds + 2 * 9216;
    const int soff = srow * 144 + sch * 16;
    u32x4 kreg, vreg, kreg2, vreg2;
#define ATT_GLOAD(KR, VR, ti_) do { const int t_ = (ti_); \
        if (t_ < 4) { KR = *(const u32x4*)(Kc + (size_t)(64 * t_) * PW); VR = *(const u32x4*)(Vb + SEQ + 64 * t_); } \
        else { const int kbase_ = qb * 64 - 128 + 64 * (jlo + t_ - 4); KR = *(const u32x4*)(Kl + (size_t)kbase_ * PW); VR = *(const u32x4*)(Vb + kbase_); } } while (0)
    const bf16_t* garow = P + qrow * PW + C_GA + head * 64;
    u32x2 gaw[8];
#pragma unroll
    for (int i = 0; i < 8; ++i) gaw[i] = *(const u32x2*)(garow + 32 * (i >> 2) + 8 * (i & 3) + 4 * hi);
    ATT_GLOAD(kreg2, vreg2, 0);
    ATT_GLOAD(kreg, vreg, 1);
    *(u32x4*)(Ks + soff) = kreg2; *(u32x4*)(Vs + soff) = vreg2;
    __syncthreads();
    const float sink2 = sinkv * LOG2E;
    float mref = sink2, lsum = 0.f;
    f32x16 oT[2]; oT[0] = f32x16{}; oT[1] = f32x16{};
    const int qpos = qtok;
    for (int ti = 0; ti < ntiles; ++ti) {
        const int buf = ti & 1;
        if (ti + 2 < ntiles) ATT_GLOAD(kreg2, vreg2, ti + 2);
        const unsigned char* kb = Ks + buf * 9216 + r32 * 144 + hi * 16;
        const unsigned char* vb = Vs + buf * 9216 + r32 * 144 + hi * 16;
        bf16x8 kf[8];
#pragma unroll
        for (int d0 = 0; d0 < 4; ++d0) { kf[2 * d0] = *(const bf16x8*)(kb + d0 * 32); kf[2 * d0 + 1] = *(const bf16x8*)(kb + 32 * 144 + d0 * 32); }
        f32x16 p0, p1;
#pragma unroll
        for (int r = 0; r < 16; ++r) { p0[r] = -mref; p1[r] = -mref; }
        __builtin_amdgcn_sched_barrier(0);
#pragma unroll
        for (int d0 = 0; d0 < 4; ++d0) { p0 = MFMA32(kf[2 * d0], qf[d0], p0); p1 = MFMA32(kf[2 * d0 + 1], qf[d0], p1); }
        bf16x8 vf[8];
#pragma unroll
        for (int blk = 0; blk < 2; ++blk)
#pragma unroll
            for (int ks = 0; ks < 4; ++ks) vf[blk * 4 + ks] = *(const bf16x8*)(vb + blk * 32 * 144 + ks * 32);
        __builtin_amdgcn_sched_barrier(0);
        asm volatile("s_nop 15\n\ts_nop 7" : "+v"(p0), "+v"(p1));
        if (ti >= 4) {
            const int j = jlo + ti - 4; const int kbase = qb * 64 - 128 + 64 * j;
            if (j == 0) {
#pragma unroll
                for (int r = 0; r < 16; ++r) { const int kp = kbase + crow(r, hi); if (kp < qpos - 128) p0[r] = -INFINITY; if (kp + 32 < qpos - 128) p1[r] = -INFINITY; }
            } else if (j == 4) {
#pragma unroll
                for (int r = 0; r < 16; ++r) { const int kp = kbase + crow(r, hi); if (kp > qpos + 128) p0[r] = -INFINITY; if (kp + 32 > qpos + 128) p1[r] = -INFINITY; }
            }
        }
        float rma, rmb;
        asm("v_max3_f32 %0, %1, %2, %3" : "=v"(rma) : "v"(p0[0]), "v"(p0[1]), "v"(p1[0]));
        asm("v_max3_f32 %0, %1, %2, %3" : "=v"(rmb) : "v"(p0[2]), "v"(p0[3]), "v"(p1[1]));
        asm("v_max3_f32 %0, %1, %2, %3" : "=v"(rma) : "v"(rma), "v"(p1[2]), "v"(p1[3]));
#pragma unroll
        for (int r = 4; r < 16; r += 4) {
            asm("v_max3_f32 %0, %1, %2, %3" : "=v"(rma) : "v"(rma), "v"(p0[r]), "v"(p0[r + 1]));
            asm("v_max3_f32 %0, %1, %2, %3" : "=v"(rmb) : "v"(rmb), "v"(p0[r + 2]), "v"(p0[r + 3]));
            asm("v_max3_f32 %0, %1, %2, %3" : "=v"(rma) : "v"(rma), "v"(p1[r]), "v"(p1[r + 1]));
            asm("v_max3_f32 %0, %1, %2, %3" : "=v"(rmb) : "v"(rmb), "v"(p1[r + 2]), "v"(p1[r + 3]));
        }
        float rm; asm("v_max3_f32 %0, %1, %2, %3" : "=v"(rm) : "v"(rma), "v"(rmb), "v"(rmb));
        { const float rmo = __shfl_xor(rm, 32); asm("v_max3_f32 %0, %1, %2, %3" : "=v"(rm) : "v"(rm), "v"(rmo), "v"(rmo)); }
        if (__any(rm > 8.0f)) {
            const float dl = fmaxf(rm, 0.f);
            mref += dl;
            const float f = __builtin_amdgcn_exp2f(-dl);
            lsum *= f;
#pragma unroll
            for (int r = 0; r < 16; ++r) { p0[r] -= dl; p1[r] -= dl; oT[0][r] *= f; oT[1][r] *= f; }
        }
        float ls = 0.f;
#pragma unroll
        for (int r = 0; r < 16; ++r) { p0[r] = __builtin_amdgcn_exp2f(p0[r]); p1[r] = __builtin_amdgcn_exp2f(p1[r]); ls += p0[r] + p1[r]; }
        lsum += ls;
        bf16x8 pf[4]; pf[0] = pack8(p0, 0); pf[1] = pack8(p0, 8); pf[2] = pack8(p1, 0); pf[3] = pack8(p1, 8);
#pragma unroll
        for (int blk = 0; blk < 2; ++blk)
#pragma unroll
            for (int ks = 0; ks < 4; ++ks) oT[blk] = MFMA32(vf[blk * 4 + ks], pf[ks], oT[blk]);
        if (ti + 1 < ntiles) { *(u32x4*)(Ks + (buf ^ 1) * 9216 + soff) = kreg; *(u32x4*)(Vs + (buf ^ 1) * 9216 + soff) = vreg; }
        kreg = kreg2; vreg = vreg2;
        __syncthreads();
    }
    lsum += __shfl_xor(lsum, 32);
    lsum += __builtin_amdgcn_exp2f(sink2 - mref);
    const float inv = 1.0f / lsum;
    bf16_t* hrow = H + qrow * DM + head * 64;
#pragma unroll
    for (int blk = 0; blk < 2; ++blk)
#pragma unroll
        for (int g4 = 0; g4 < 4; ++g4) {
            const int d0 = 32 * blk + 8 * g4 + 4 * hi;
            const u32x2 gw = gaw[blk * 4 + g4];
            const float o0 = oT[blk][4 * g4 + 0] * inv * silu_f(bf2f(gw.x & 0xffffu)), o1 = oT[blk][4 * g4 + 1] * inv * silu_f(bf2f(gw.x >> 16));
            const float o2 = oT[blk][4 * g4 + 2] * inv * silu_f(bf2f(gw.y & 0xffffu)), o3 = oT[blk][4 * g4 + 3] * inv * silu_f(bf2f(gw.y >> 16));
            u32x2 w; w.x = pkbf(o0, o1); w.y = pkbf(o2, o3);
            *(u32x2*)(hrow + d0) = w;
        }
}

typedef short v4i16_t __attribute__((ext_vector_type(4)));
__device__ __forceinline__ v4i16_t trrd(const unsigned char* p) { return __builtin_amdgcn_ds_read_tr16_b64_v4i16((LAS v4i16_t*)p); }
__device__ __forceinline__ bf16x8 cat8(v4i16_t lo, v4i16_t hi) { return (bf16x8){lo[0], lo[1], lo[2], lo[3], hi[0], hi[1], hi[2], hi[3]}; }
__device__ __forceinline__ void fft1_unit(int u, const bf16_t* P, bf16_t* YF, const unsigned char* ws, unsigned char* lds) {
    const int tid = opaque_tid(), lane = tid & 63, wave = __builtin_amdgcn_readfirstlane(tid >> 6), r32 = lane & 31, hi = lane >> 5;
    const int b = u >> 6, n2 = u & 63;
    constexpr int UPB = 576;
    const bf16_t* src = P + (size_t)(b * SEQ + n2) * PW + C_UF;
#pragma unroll
    for (int i = 0; i < 8; ++i) {
        const int id = tid + NTHREADS * i, n1 = id >> 5, cc = id & 31;
        *(u32x4*)(lds + n1 * UPB + cc * 16) = *(const u32x4*)(src + (size_t)n1 * 64 * PW + cc * 8);
    }
    __syncthreads();
    const bf16_t* T1R = (const bf16_t*)(ws + WS_T1R); const bf16_t* T1I = (const bf16_t*)(ws + WS_T1I);
    f32x16 aR[4], aI[4];
#pragma unroll
    for (int kb = 0; kb < 4; ++kb) { aR[kb] = f32x16{}; aI[kb] = f32x16{}; }
    const unsigned char* ap = lds + (8 * hi + ((lane & 15) >> 2)) * UPB + (32 * wave + 16 * ((lane >> 4) & 1) + 4 * (lane & 3)) * 2;
#pragma unroll 2
    for (int ks = 0; ks < 8; ++ks) {
        const bf16x8 av = cat8(trrd(ap + (16 * ks) * UPB), trrd(ap + (16 * ks + 4) * UPB));
#pragma unroll
        for (int kb = 0; kb < 4; ++kb) {
            const bf16x8 bR = *(const bf16x8*)(T1R + (32 * kb + r32) * 128 + 16 * ks + 8 * hi), bI = *(const bf16x8*)(T1I + (32 * kb + r32) * 128 + 16 * ks + 8 * hi);
            aR[kb] = MFMA32(av, bR, aR[kb]); aI[kb] = MFMA32(av, bI, aI[kb]);
        }
    }
    const float* TW = (const float*)(ws + WS_TW);
#pragma unroll
    for (int kb = 0; kb < 4; ++kb) {
        const int k1 = 32 * kb + r32;
        const float ct = TW[2 * (n2 * k1)], st = TW[2 * (n2 * k1) + 1];
        bf16_t* yp = YF + ((size_t)((b * 128 + k1) * 64 + n2)) * 512 + 32 * wave + 4 * hi;
#pragma unroll
        for (int g4 = 0; g4 < 4; ++g4) {
            float yr[4], yi[4];
#pragma unroll
            for (int e = 0; e < 4; ++e) { const float r_ = aR[kb][4 * g4 + e], i_ = aI[kb][4 * g4 + e]; yr[e] = r_ * ct + i_ * st; yi[e] = i_ * ct - r_ * st; }
            u32x2 wr_, wi_; wr_.x = pkbf(yr[0], yr[1]); wr_.y = pkbf(yr[2], yr[3]); wi_.x = pkbf(yi[0], yi[1]); wi_.y = pkbf(yi[2], yi[3]);
            *(u32x2*)(yp + 8 * g4) = wr_; *(u32x2*)(yp + 256 + 8 * g4) = wi_;
        }
    }
    __syncthreads();
}

template <int KK>
__device__ __forceinline__ void dftf_unit(const bf16_t* srcbase, int R, int pitchA, int pitchB, const bf16_t* Tr, const bf16_t* Ti, const bf16_t* Gt,
                                          const bf16_t* P, bf16_t* H, size_t row0, int rowstride, float oscale, unsigned char* lds) {
    const int tid = opaque_tid(), lane = tid & 63, wave = __builtin_amdgcn_readfirstlane(tid >> 6), r32 = lane & 31, hi = lane >> 5;
    constexpr int ZPB = (KK == 128) ? 576 : 544;
#pragma unroll 1
    for (int i0 = 0; i0 < KK / 16; i0 += 8) {
        u32x4 img[8];
#pragma unroll
        for (int i = 0; i < 8; ++i) { const int id = tid + NTHREADS * (i0 + i), kk = id >> 5, cc = id & 31; img[i] = *(const u32x4*)(srcbase + (size_t)(kk % R) * pitchA + (size_t)(kk / R) * pitchB + cc * 8); }
        __builtin_amdgcn_sched_barrier(0);
#pragma unroll
        for (int i = 0; i < 8; ++i) { const int id = tid + NTHREADS * (i0 + i), kk = id >> 5, cc = id & 31; *(u32x4*)(lds + kk * ZPB + cc * 16) = img[i]; }
        __builtin_amdgcn_sched_barrier(0);
    }
    __syncthreads();
    const int g = wave >> 1, kblk = wave & 1;
    f32x16 XR[2], XI[2];
#pragma unroll
    for (int cb = 0; cb < 2; ++cb) { XR[cb] = f32x16{}; XI[cb] = f32x16{}; }
    const bf16_t* trp = Tr + (size_t)(32 * kblk + r32) * KK + 8 * hi; const bf16_t* tip = Ti + (size_t)(32 * kblk + r32) * KK + 8 * hi;
    const unsigned char* zp = lds + (8 * hi + ((lane & 15) >> 2)) * ZPB + (64 * g + 16 * ((lane >> 4) & 1) + 4 * (lane & 3)) * 2;
#pragma unroll 2
    for (int ks = 0; ks < KK / 16; ++ks) {
        const bf16x8 bR = *(const bf16x8*)(trp + 16 * ks), bI = *(const bf16x8*)(tip + 16 * ks);
#pragma unroll
        for (int cb = 0; cb < 2; ++cb) { const bf16x8 av = cat8(trrd(zp + (16 * ks) * ZPB + cb * 64), trrd(zp + (16 * ks + 4) * ZPB + cb * 64)); XR[cb] = MFMA32(av, bR, XR[cb]); XI[cb] = MFMA32(av, bI, XI[cb]); }
    }
    f32x16 oa[2]; oa[0] = f32x16{}; oa[1] = f32x16{};
    const bf16_t* gp = Gt + (size_t)(g * 64 + r32) * 128 + 8 * hi;
    u32x2 gfw[8];
    { const size_t rowg = row0 + (size_t)(32 * kblk + r32) * rowstride;
#pragma unroll
      for (int i8 = 0; i8 < 8; ++i8) gfw[i8] = *(const u32x2*)(P + rowg * PW + C_GF + 64 * g + 32 * (i8 >> 2) + 8 * (i8 & 3) + 4 * hi); }
#pragma unroll
    for (int part = 0; part < 2; ++part)
#pragma unroll
        for (int cb = 0; cb < 2; ++cb)
#pragma unroll
            for (int s = 0; s < 2; ++s) {
                const bf16x8 bx = pack8(part ? XI[cb] : XR[cb], 8 * s);
                const int kko = part * 64 + 32 * cb + 16 * s;
#pragma unroll
                for (int lb = 0; lb < 2; ++lb) { const bf16x8 ag = *(const bf16x8*)(gp + (size_t)(32 * lb) * 128 + kko); oa[lb] = MFMA32(ag, bx, oa[lb]); }
            }
    const int k2 = 32 * kblk + r32;
    const size_t row = row0 + (size_t)k2 * rowstride;
    const bf16_t* gfrow = P + row * PW + C_GF + 64 * g;
    bf16_t* hrow = H + row * DM + 512 + 64 * g;
#pragma unroll
    for (int lb = 0; lb < 2; ++lb)
#pragma unroll
        for (int g4 = 0; g4 < 4; ++g4) {
            const int l0 = 32 * lb + 8 * g4 + 4 * hi;
            const u32x2 gw = gfw[lb * 4 + g4];
            const float o0 = oa[lb][4 * g4 + 0] * oscale * silu_f(bf2f(gw.x & 0xffffu)), o1 = oa[lb][4 * g4 + 1] * oscale * silu_f(bf2f(gw.x >> 16));
            const float o2 = oa[lb][4 * g4 + 2] * oscale * silu_f(bf2f(gw.y & 0xffffu)), o3 = oa[lb][4 * g4 + 3] * oscale * silu_f(bf2f(gw.y >> 16));
            u32x2 w; w.x = pkbf(o0, o1); w.y = pkbf(o2, o3);
            *(u32x2*)(hrow + l0) = w;
        }
    __syncthreads();
}

__device__ __forceinline__ void conv_unit(int u, const bf16_t* P, bf16_t* H, const float* cw, const float* cb) {
    const int tid = opaque_tid(), cgp = tid & 31, rg = tid >> 5;
    const int ch0 = cgp * 8;
    const int r0 = u * 64 + rg * 4;
    int pos, len; if (r0 < NTOK) { pos = r0 & (SEQ - 1); len = SEQ; } else { pos = (r0 - NTOK) & (CTXL - 1); len = CTXL; }
    float w0[8], w1[8], w2[8], bs[8];
#pragma unroll
    for (int e = 0; e < 8; ++e) { w0[e] = cw[ch0 + e]; w1[e] = cw[256 + ch0 + e]; w2[e] = cw[512 + ch0 + e]; bs[e] = cb[ch0 + e]; }
    float T[6][8];
#pragma unroll
    for (int i = 0; i < 6; ++i) {
        const int p = pos - 1 + i;
        if (p >= 0 && p < len) {
            const size_t row = (size_t)(r0 - 1 + i);
            const u32x4 z = *(const u32x4*)(P + row * PW + C_ZC + ch0), c = *(const u32x4*)(P + row * PW + C_CC + ch0);
            T[i][0] = bf2f(z.x & 0xffffu) * bf2f(c.x & 0xffffu); T[i][1] = bf2f(z.x >> 16) * bf2f(c.x >> 16);
            T[i][2] = bf2f(z.y & 0xffffu) * bf2f(c.y & 0xffffu); T[i][3] = bf2f(z.y >> 16) * bf2f(c.y >> 16);
            T[i][4] = bf2f(z.z & 0xffffu) * bf2f(c.z & 0xffffu); T[i][5] = bf2f(z.z >> 16) * bf2f(c.z >> 16);
            T[i][6] = bf2f(z.w & 0xffffu) * bf2f(c.w & 0xffffu); T[i][7] = bf2f(z.w >> 16) * bf2f(c.w >> 16);
        } else {
#pragma unroll
            for (int e = 0; e < 8; ++e) T[i][e] = 0.f;
        }
    }
#pragma unroll
    for (int i = 0; i < 4; ++i) {
        const size_t row = (size_t)(r0 + i);
        const u32x4 bw = *(const u32x4*)(P + row * PW + C_BC + ch0), gw = *(const u32x4*)(P + row * PW + C_GC + ch0);
        const unsigned bwv[4] = {bw.x, bw.y, bw.z, bw.w}, gwv[4] = {gw.x, gw.y, gw.z, gw.w};
        float o[8];
#pragma unroll
        for (int e = 0; e < 8; ++e) {
            const float bv = (e & 1) ? bf2f(bwv[e >> 1] >> 16) : bf2f(bwv[e >> 1] & 0xffffu);
            const float gv = (e & 1) ? bf2f(gwv[e >> 1] >> 16) : bf2f(gwv[e >> 1] & 0xffffu);
            const float y = T[i][e] * w0[e] + T[i + 1][e] * w1[e] + T[i + 2][e] * w2[e] + bs[e];
            o[e] = bv * y * silu_f(gv);
        }
        u32x4 w; w.x = pkbf(o[0], o[1]); w.y = pkbf(o[2], o[3]); w.z = pkbf(o[4], o[5]); w.w = pkbf(o[6], o[7]);
        *(u32x4*)(H + row * DM + 768 + ch0) = w;
    }
}

__device__ __forceinline__ void fft1_wave(int task, const bf16_t* P, bf16_t* YF, const unsigned char* ws, unsigned char* lds_w, int lane, int pmode = 0) {
    const int r32 = lane & 31, hi = lane >> 5;
    const int cblk = task & 7, n2 = (task >> 3) & 63, b = task >> 9;
    const bf16_t* src = P + (size_t)((b * 64 + n2) * 128) * 256 + 32 * cblk + 8 * (lane & 3);
    { u32x4 img[8];
#pragma unroll
      for (int i = 0; i < 8; ++i) img[i] = *(const u32x4*)(src + (size_t)(16 * i + (lane >> 2)) * 256);
      __builtin_amdgcn_sched_barrier(0);
#pragma unroll
      for (int i = 0; i < 8; ++i) *(u32x4*)(lds_w + (16 * i + (lane >> 2)) * 64 + (lane & 3) * 16) = img[i];
      __builtin_amdgcn_sched_barrier(0); }
    asm volatile("s_waitcnt vmcnt(0) lgkmcnt(0)" ::: "memory");
    if (pmode == 2) return;
    const bf16_t* T1R = (const bf16_t*)(ws + WS_T1R); const bf16_t* T1I = (const bf16_t*)(ws + WS_T1I);
    f32x16 aR[4], aI[4];
#pragma unroll
    for (int kb = 0; kb < 4; ++kb) { aR[kb] = f32x16{}; aI[kb] = f32x16{}; }
    const unsigned char* ap = lds_w + (8 * hi + ((lane & 15) >> 2)) * 64 + (16 * ((lane >> 4) & 1) + 4 * (lane & 3)) * 2;
    const bf16_t* t1r = T1R + (size_t)r32 * 128 + 8 * hi; const bf16_t* t1i = T1I + (size_t)r32 * 128 + 8 * hi;
    bf16x8 bA[8], bB[8];
#define F1_LOADB(B, ks_) do { _Pragma("unroll") for (int kb = 0; kb < 4; ++kb) { B[2 * kb] = *(const bf16x8*)(t1r + (size_t)(32 * kb) * 128 + 16 * (ks_)); B[2 * kb + 1] = *(const bf16x8*)(t1i + (size_t)(32 * kb) * 128 + 16 * (ks_)); } } while (0)
#define F1_STEP(B, ks_) do { const bf16x8 av = cat8(trrd(ap + (16 * (ks_)) * 64), trrd(ap + (16 * (ks_) + 4) * 64)); \
        _Pragma("unroll") for (int kb = 0; kb < 4; ++kb) { aR[kb] = MFMA32(av, B[2 * kb], aR[kb]); aI[kb] = MFMA32(av, B[2 * kb + 1], aI[kb]); } } while (0)
    F1_LOADB(bA, 0);
#pragma unroll
    for (int k2 = 0; k2 < 4; ++k2) {
        F1_LOADB(bB, 2 * k2 + 1);
        __builtin_amdgcn_sched_barrier(0);
        F1_STEP(bA, 2 * k2);
        __builtin_amdgcn_sched_barrier(0);
        if (k2 < 3) F1_LOADB(bA, 2 * k2 + 2);
        __builtin_amdgcn_sched_barrier(0);
        F1_STEP(bB, 2 * k2 + 1);
        __builtin_amdgcn_sched_barrier(0);
    }
#undef F1_LOADB
#undef F1_STEP
    const float* TW = (const float*)(ws + WS_TW);
#pragma unroll
    for (int kb = 0; kb < 4; ++kb) {
        const int k1 = 32 * kb + r32;
        const float ct = TW[2 * (n2 * k1)], st = TW[2 * (n2 * k1) + 1];
        bf16_t* yp = YF + ((size_t)((b * 128 + k1) * 64 + n2)) * 512 + 32 * cblk + 4 * hi;
#pragma unroll
        for (int g4 = 0; g4 < 4; ++g4) {
            float yr[4], yi[4];
#pragma unroll
            for (int e = 0; e < 4; ++e) { const float r_ = aR[kb][4 * g4 + e], i_ = aI[kb][4 * g4 + e]; yr[e] = r_ * ct + i_ * st; yi[e] = i_ * ct - r_ * st; }
            u32x2 wr_, wi_; wr_.x = pkbf(yr[0], yr[1]); wr_.y = pkbf(yr[2], yr[3]); wi_.x = pkbf(yi[0], yi[1]); wi_.y = pkbf(yi[2], yi[3]);
            if (pmode != 1 || wr_.x == 0x12345678u) { *(u32x2*)(yp + 8 * g4) = wr_; *(u32x2*)(yp + 256 + 8 * g4) = wi_; }
        }
    }
    asm volatile("s_waitcnt lgkmcnt(0)" ::: "memory");
}
__device__ __forceinline__ void fft3_wave(int task, const bf16_t* YF, const bf16_t* Gt, const bf16_t* P, bf16_t* H, const unsigned char* ws, unsigned char* lds_w, int lane) {
    const int r32 = lane & 31, hi = lane >> 5;
    const int g = task & 3, k1 = (task >> 2) & 127, b = task >> 9;
    const bf16_t* src = YF + ((size_t)(b * 128 + k1) * 64) * 512 + 64 * g + 8 * (lane & 7);
    { u32x4 img[16];
#pragma unroll
      for (int i = 0; i < 16; ++i) { const int kk = 8 * i + (lane >> 3); img[i] = *(const u32x4*)(src + (size_t)(kk & 63) * 512 + (size_t)(kk >> 6) * 256); }
      __builtin_amdgcn_sched_barrier(0);
#pragma unroll
      for (int i = 0; i < 16; ++i) { const int kk = 8 * i + (lane >> 3), ch = lane & 7; *(u32x4*)(lds_w + kk * 128 + ((ch ^ (((kk >> 1) & 1) << 2)) * 16)) = img[i]; }
      __builtin_amdgcn_sched_barrier(0); }
    asm volatile("s_waitcnt vmcnt(0) lgkmcnt(0)" ::: "memory");
    const bf16_t* T3R = (const bf16_t*)(ws + WS_T3R); const bf16_t* T3I = (const bf16_t*)(ws + WS_T3I);
    const int q = (lane & 15) >> 2, sw = (q >> 1) & 1;
    const int chl = 2 * ((lane >> 4) & 1) + ((lane & 3) >> 1);
    const unsigned char* zb = lds_w + (8 * hi + q) * 128 + 8 * (lane & 1);
    const unsigned char* zp0 = zb + ((chl ^ (sw << 2)) * 16);
    const unsigned char* zp1 = zb + (((4 + chl) ^ (sw << 2)) * 16);
    const bf16_t* gp = Gt + (size_t)(g * 64 + r32) * 128 + 8 * hi;
    const size_t rowb = (size_t)(b * SEQ + k1);
#pragma unroll 1
    for (int kblk = 0; kblk < 2; ++kblk) {
        f32x16 XR[2], XI[2];
#pragma unroll
        for (int cb = 0; cb < 2; ++cb) { XR[cb] = f32x16{}; XI[cb] = f32x16{}; }
        const bf16_t* trp = T3R + (size_t)(32 * kblk + r32) * 128 + 8 * hi; const bf16_t* tip = T3I + (size_t)(32 * kblk + r32) * 128 + 8 * hi;
        const size_t rowg = rowb + (size_t)(32 * kblk + r32) * 128;
        u32x2 gfw[8];
#pragma unroll
        for (int i8 = 0; i8 < 8; ++i8) gfw[i8] = *(const u32x2*)(P + rowg * PW + C_GF + 64 * g + 32 * (i8 >> 2) + 8 * (i8 & 3) + 4 * hi);
        bf16x8 bR[8], bI[8];
#pragma unroll
        for (int ks = 0; ks < 8; ++ks) { bR[ks] = *(const bf16x8*)(trp + 16 * ks); bI[ks] = *(const bf16x8*)(tip + 16 * ks); }
        __builtin_amdgcn_sched_barrier(0);
#pragma unroll
        for (int ks = 0; ks < 8; ++ks) {
            const bf16x8 a0 = cat8(trrd(zp0 + (16 * ks) * 128), trrd(zp0 + (16 * ks + 4) * 128));
            const bf16x8 a1 = cat8(trrd(zp1 + (16 * ks) * 128), trrd(zp1 + (16 * ks + 4) * 128));
            XR[0] = MFMA32(a0, bR[ks], XR[0]); XI[0] = MFMA32(a0, bI[ks], XI[0]); XR[1] = MFMA32(a1, bR[ks], XR[1]); XI[1] = MFMA32(a1, bI[ks], XI[1]);
        }
        __builtin_amdgcn_sched_barrier(0);
        bf16x8 gfr[2][8];
#pragma unroll
        for (int lb = 0; lb < 2; ++lb)
#pragma unroll
            for (int q8 = 0; q8 < 8; ++q8) gfr[lb][q8] = *(const bf16x8*)(gp + (size_t)(32 * lb) * 128 + 16 * q8);
        __builtin_amdgcn_sched_barrier(0);
        f32x16 oa[2]; oa[0] = f32x16{}; oa[1] = f32x16{};
#pragma unroll
        for (int part = 0; part < 2; ++part)
#pragma unroll
            for (int cb = 0; cb < 2; ++cb)
#pragma unroll
                for (int s = 0; s < 2; ++s) {
                    const bf16x8 bx = pack8(part ? XI[cb] : XR[cb], 8 * s);
                    const int kko = part * 64 + 32 * cb + 16 * s;
#pragma unroll
                    for (int lb = 0; lb < 2; ++lb) oa[lb] = MFMA32(gfr[lb][kko >> 4], bx, oa[lb]);
                }
        const int k2 = 32 * kblk + r32;
        const size_t row = rowb + (size_t)k2 * 128;
        const bf16_t* gfrow = P + row * PW + C_GF + 64 * g;
        bf16_t* hrow = H + row * DM + 512 + 64 * g;
#pragma unroll
        for (int lb = 0; lb < 2; ++lb)
#pragma unroll
            for (int g4 = 0; g4 < 4; ++g4) {
                const int l0 = 32 * lb + 8 * g4 + 4 * hi;
                const u32x2 gw = gfw[lb * 4 + g4];
                const float o0 = oa[lb][4 * g4 + 0] * silu_f(bf2f(gw.x & 0xffffu)), o1 = oa[lb][4 * g4 + 1] * silu_f(bf2f(gw.x >> 16));
                const float o2 = oa[lb][4 * g4 + 2] * silu_f(bf2f(gw.y & 0xffffu)), o3 = oa[lb][4 * g4 + 3] * silu_f(bf2f(gw.y >> 16));
                u32x2 w; w.x = pkbf(o0, o1); w.y = pkbf(o2, o3);
                *(u32x2*)(hrow + l0) = w;
            }
    }
    asm volatile("s_waitcnt lgkmcnt(0)" ::: "memory");
}
__device__ __forceinline__ void conv_wave(int task, const bf16_t* P, bf16_t* H, const float* cw, const float* cb, int lane) {
    const int cgp = lane & 31, ch0 = cgp * 8;
    const int r0 = task * 8 + (lane >> 5) * 4;
    int pos, len; if (r0 < NTOK) { pos = r0 & (SEQ - 1); len = SEQ; } else { pos = (r0 - NTOK) & (CTXL - 1); len = CTXL; }
    u32x4 zz[6], cc[6], bb[4], gg[4]; float okf[6];
#pragma unroll
    for (int i = 0; i < 6; ++i) { const int p = pos - 1 + i; const bool ok = p >= 0 && p < len; okf[i] = ok ? 1.f : 0.f; const size_t row = (size_t)(ok ? r0 - 1 + i : r0);
        zz[i] = *(const u32x4*)(P + row * PW + C_ZC + ch0); cc[i] = *(const u32x4*)(P + row * PW + C_CC + ch0); }
#pragma unroll
    for (int i = 0; i < 4; ++i) { const size_t row = (size_t)(r0 + i); bb[i] = *(const u32x4*)(P + row * PW + C_BC + ch0); gg[i] = *(const u32x4*)(P + row * PW + C_GC + ch0); }
    __builtin_amdgcn_sched_barrier(0);
    float w0[8], w1[8], w2[8], bs[8];
    { const f32x4 a0 = *(const f32x4*)(cw + ch0), a1 = *(const f32x4*)(cw + ch0 + 4), b0 = *(const f32x4*)(cw + 256 + ch0), b1 = *(const f32x4*)(cw + 256 + ch0 + 4);
      const f32x4 c0 = *(const f32x4*)(cw + 512 + ch0), c1 = *(const f32x4*)(cw + 512 + ch0 + 4), d0 = *(const f32x4*)(cb + ch0), d1 = *(const f32x4*)(cb + ch0 + 4);
#pragma unroll
      for (int e = 0; e < 4; ++e) { w0[e] = a0[e]; w0[4 + e] = a1[e]; w1[e] = b0[e]; w1[4 + e] = b1[e]; w2[e] = c0[e]; w2[4 + e] = c1[e]; bs[e] = d0[e]; bs[4 + e] = d1[e]; } }
    float T[6][8];
#pragma unroll
    for (int i = 0; i < 6; ++i) {
        const unsigned zv[4] = {zz[i].x, zz[i].y, zz[i].z, zz[i].w}, cv[4] = {cc[i].x, cc[i].y, cc[i].z, cc[i].w};
#pragma unroll
        for (int e = 0; e < 8; ++e) T[i][e] = okf[i] * ((e & 1) ? bf2f(zv[e >> 1] >> 16) : bf2f(zv[e >> 1] & 0xffffu)) * ((e & 1) ? bf2f(cv[e >> 1] >> 16) : bf2f(cv[e >> 1] & 0xffffu));
    }
#pragma unroll
    for (int i = 0; i < 4; ++i) {
        const size_t row = (size_t)(r0 + i);
        const unsigned bwv[4] = {bb[i].x, bb[i].y, bb[i].z, bb[i].w}, gwv[4] = {gg[i].x, gg[i].y, gg[i].z, gg[i].w};
        float o[8];
#pragma unroll
        for (int e = 0; e < 8; ++e) {
            const float bv = (e & 1) ? bf2f(bwv[e >> 1] >> 16) : bf2f(bwv[e >> 1] & 0xffffu);
            const float gv = (e & 1) ? bf2f(gwv[e >> 1] >> 16) : bf2f(gwv[e >> 1] & 0xffffu);
            const float y = T[i][e] * w0[e] + T[i + 1][e] * w1[e] + T[i + 2][e] * w2[e] + bs[e];
            o[e] = bv * y * silu_f(gv);
        }
        u32x4 w; w.x = pkbf(o[0], o[1]); w.y = pkbf(o[2], o[3]); w.z = pkbf(o[4], o[5]); w.w = pkbf(o[6], o[7]);
        *(u32x4*)(H + row * DM + 768 + ch0) = w;
    }
}

#define XB_TMO      128
#define XB_XCNT(j)  (256  + 64 * (j))
#define XB_XSUB(j)  (1280 + 64 * (j))
#define XB_XGEN(j)  (2304 + 64 * (j))
#define XB_TOP      3328
#define XB_TOPGEN   3392
#define XCD_BAR_WORDS 3456
#define XB_SPIN_CAP (1u << 18)

__device__ __forceinline__ unsigned xb_ld(unsigned* p)              { return __hip_atomic_load(p, __ATOMIC_RELAXED, __HIP_MEMORY_SCOPE_AGENT); }
__device__ __forceinline__ unsigned xb_add(unsigned* p, unsigned v) { return __hip_atomic_fetch_add(p, v, __ATOMIC_RELAXED, __HIP_MEMORY_SCOPE_AGENT); }
__device__ __forceinline__ unsigned xb_xcc_id() { return (unsigned)__builtin_amdgcn_s_getreg((3 << 11) | 20) & 0xFu; }
#define XB_SPIN(cond, bar) do { unsigned _sp = 0; while (cond) { __builtin_amdgcn_s_sleep(1); \
    if ((++_sp & 255u) == 0u) { if (xb_ld(&(bar)[XB_TMO])) break; if (_sp > XB_SPIN_CAP) { atomicAdd(&(bar)[XB_TMO], 1u); break; } } } } while (0)

struct XcdBarrier {
    unsigned* bar; unsigned x;
    volatile LAS unsigned* st;
};

__device__ __forceinline__ XcdBarrier xcd_barrier_post(unsigned* bar, volatile LAS unsigned* st) {
    XcdBarrier b; b.bar = bar; b.x = xb_xcc_id(); b.st = st;
    if (threadIdx.x == 0) (void)xb_add(&bar[XB_XCNT(b.x)], 1u);
    return b;
}
__device__ __forceinline__ void xcd_barrier_complete(unsigned* bar, unsigned x, unsigned& nloc, unsigned& nx) {
    const unsigned G = gridDim.x * gridDim.y * gridDim.z;
    unsigned sum, cnt, mine, sp = 0u;
    for (;;) {
        sum = 0u; cnt = 0u; mine = 0u;
#pragma unroll
        for (unsigned j = 0; j < 16; ++j) { const unsigned c = xb_ld(&bar[XB_XCNT(j)]); sum += c; cnt += (c > 0u) ? 1u : 0u; mine = (j == x) ? c : mine; }
        if (sum == G) break;
        __builtin_amdgcn_s_sleep(1);
        if ((++sp & 255u) == 0u) { if (xb_ld(&bar[XB_TMO])) break; if (sp > XB_SPIN_CAP) { atomicAdd(&bar[XB_TMO], 1u); break; } }
    }
    nloc = mine > 0u ? mine : 1u; nx = cnt > 0u ? cnt : 1u;
}

__device__ __forceinline__ void xcd_barrier(const XcdBarrier& b) {
    asm volatile("s_waitcnt vmcnt(0)" ::: "memory");
    __syncthreads();
    if (threadIdx.x == 0) {
        unsigned* bar = b.bar;
        __builtin_amdgcn_s_waitcnt(0);
        unsigned nloc = b.st[0], nx = b.st[1];
        if (nloc == 0u) { xcd_barrier_complete(bar, b.x, nloc, nx); b.st[0] = nloc; b.st[1] = nx; }
        const unsigned old = xb_add(&bar[XB_XSUB(b.x)], 1u);
        const unsigned gen = old / nloc;
        if (old + 1u == (gen + 1u) * nloc) {
            __builtin_amdgcn_fence(__ATOMIC_RELEASE, "agent");
            asm volatile("s_waitcnt vmcnt(0)" ::: "memory");
            const unsigned og = xb_add(&bar[XB_TOP], 1u);
            const unsigned tg = og / nx;
            if (og + 1u == (tg + 1u) * nx) xb_add(&bar[XB_TOPGEN], 1u);
            else XB_SPIN(xb_ld(&bar[XB_TOPGEN]) == tg, bar);
            __builtin_amdgcn_fence(__ATOMIC_ACQUIRE, "agent");
            xb_add(&bar[XB_XGEN(b.x)], 1u);
            asm volatile("s_waitcnt vmcnt(0)" ::: "memory");
        } else {
            XB_SPIN(xb_ld(&bar[XB_XGEN(b.x)]) == gen, bar);
            __builtin_amdgcn_fence(__ATOMIC_ACQUIRE, "agent");
            asm volatile("s_waitcnt vmcnt(0)" ::: "memory");
        }
    }
    __syncthreads();
}

__device__ __forceinline__ int next_unit(unsigned* ctr, unsigned char* lds) {
    volatile int* sw = (volatile int*)(lds + LDS_SCHED);
    if (threadIdx.x == 0) *sw = (int)atomicAdd(ctr, 1u);
    __syncthreads();
    const int u = *sw;
    __syncthreads();
    return u;
}

__global__ void __launch_bounds__(NTHREADS, 2) hybrid_fwd(KArgs a) {
    extern __shared__ __attribute__((aligned(16))) unsigned char lds[];
    cg::grid_group grid = cg::this_grid();
    unsigned char* ws = a.ws;
    const int lo = a.ph_lo, hi = a.ph_hi;
#ifndef PHMASK
#define PHMASK 0xfff
#endif
#define IN(k) (((PHMASK >> ((k) > 5 && (k) < 11 ? (k) - 5 : (k))) & 1) && lo <= (k) && (k) < hi)
#define SEAM(k) do { if (IN(k) && IN((k) + 1)) xcd_barrier(xbar); } while (0)
#ifndef REP_PHASE
#define REP_PHASE -1
#endif
#define REPS(j) for (int rep = 0, nrep = (REP_PHASE == (j)) ? 2 : 1; rep < nrep; ++rep, (rep < nrep ? xcd_barrier(xbar) : (void)0))
    bf16_t* HX = (bf16_t*)(ws + WS_HX); bf16_t* Pb = (bf16_t*)(ws + WS_P); bf16_t* Vt = (bf16_t*)(ws + WS_VT); bf16_t* Hb = (bf16_t*)(ws + WS_H);
    bf16_t* Yb = (bf16_t*)(ws + WS_Y); bf16_t* YF = (bf16_t*)(ws + WS_YF); float* SSQ = (float*)(ws + WS_SSQ);
    unsigned* ctl = (unsigned*)(ws + WS_CTL);

    if (threadIdx.x < 2) ((volatile LAS unsigned*)(lds + LDS_BARST))[threadIdx.x] = 0u;
    __syncthreads();
    const XcdBarrier xbar = xcd_barrier_post((unsigned*)(ws + WS_BAR), (volatile LAS unsigned*)(lds + LDS_BARST));
    if (a.ph_lo < 0) grid.sync();
    REPS(30) if (IN(0)) p0_prologue(a, lds);
    SEAM(0);
    for (int l = 0; l < 2; ++l) {
        const int pb = 1 + 5 * l;
        REPS(0) if (IN(pb)) norm_phase(a, l);
        SEAM(pb);
        REPS(1) if (IN(pb + 1)) {
            pg8::Gemm g{HX, (const bf16_t*)(ws + WS_WIN) + (size_t)l * PW * DM, MROWS, PW, DM};
            pg8::StaticOrder S; S.init(MROWS, PW, (int)gridDim.x, (int)blockIdx.x);
            pg8::EpiProj E{Pb, Vt, (const float*)(ws + WS_ROPE), (bf16_t*)(ws + WS_UFP), 0.125f * LOG2E};
            pg8::gemm_phase<pg8::EpiProj, pg8::StaticOrder, true, true>((PG8_LAS unsigned char*)lds, g, S, E);
        }
        SEAM(pb + 1);
        for (int rep = 0, nrep = (REP_PHASE >= 20 && REP_PHASE < 30) ? 2 : 1; rep < nrep; ++rep, (rep < nrep ? xcd_barrier(xbar) : (void)0)) if (IN(pb + 2)) {
            const int nAttn = (l == 0) ? 1056 : 1024, nCtxF = (l == 0) ? 16 : 0, nF1 = 256, nConv = ((l == 0) ? MROWS : NTOK) / 64;
            const int e0 = nF1, e1 = e0 + nCtxF, e2 = e1 + nAttn, e3 = e2 + nConv;
            for (;;) {
                const int u = next_unit(ctl + 2 * l + 8 * rep, lds);
                if (u >= e3) break;
                if (rep == 1) { const int ty = u < e0 ? 1 : u < e1 ? 3 : u < e2 ? 0 : 2; if (REP_PHASE == 25 ? (ty == 0) : (ty != REP_PHASE - 20)) continue; }
                if (u >= e1 && u < e2) attn_unit(u - e1, Pb, Vt, Hb, a.sink + 8 * l, lds);
                else if (u >= e0 && u < e1) { const int v = u - e0, b = v >> 2, kb = v & 3;
                    dftf_unit<256>(Pb + (size_t)(NTOK + b * CTXL) * PW + C_UF, 256, PW, 0, (const bf16_t*)(ws + WS_T256R) + (size_t)(64 * kb) * 256, (const bf16_t*)(ws + WS_T256I) + (size_t)(64 * kb) * 256,
                                   (const bf16_t*)(ws + WS_GT) + (size_t)l * 4 * 64 * 128, Pb, Hb, (size_t)(NTOK + b * CTXL + 64 * kb), 1, 5.656854249492381f, lds); }
                else {
                    const int tid = opaque_tid(), lane = tid & 63, wave = __builtin_amdgcn_readfirstlane(tid >> 6);
                    if (u < e0) fft1_wave(u * 8 + wave, (const bf16_t*)(ws + WS_UFP), YF, ws, lds + wave * 16384, lane);
                    else conv_wave((u - e2) * 8 + wave, Pb, Hb, a.conv_w + l * 768, a.conv_b + l * 256, lane);
                }
            }
        }
        SEAM(pb + 2);
        REPS(3) if (IN(pb + 3)) {
            const bool gemmwg = (l == 0 && blockIdx.x < 16);
            if (gemmwg) {
                pg8::Gemm g{Hb + (size_t)NTOK * DM, (const bf16_t*)(ws + WS_WOUT) + (size_t)l * DM * DM, NCTX, DM, DM};
                pg8::StaticOrder S; S.init(NCTX, DM, 16, (int)blockIdx.x);
                pg8::EpiY E{Yb + (size_t)NTOK * DM, SSQ + (size_t)NTOK * 16};
                pg8::gemm_phase<pg8::EpiY, pg8::StaticOrder, true, true>((PG8_LAS unsigned char*)lds, g, S, E);
            } else {
                const int tid = opaque_tid(), lane = tid & 63, wave = __builtin_amdgcn_readfirstlane(tid >> 6);
                const int nb0 = (l == 0) ? 16 : 0;
                const int gw = ((int)blockIdx.x - nb0) + wave * ((int)gridDim.x - nb0), NGW = ((int)gridDim.x - nb0) * 8;
                unsigned char* lds_w = lds + wave * 16384;
                for (int t = gw; t < 2048; t += NGW) fft3_wave(t, YF, (const bf16_t*)(ws + WS_GT) + (size_t)l * 4 * 64 * 128, Pb, Hb, ws, lds_w, lane);
            }
            __syncthreads();
        }
        SEAM(pb + 3);
        REPS(4) if (IN(pb + 4)) {
            pg8::Gemm g{Hb, (const bf16_t*)(ws + WS_WOUT) + (size_t)l * DM * DM, NTOK, DM, DM};
            pg8::StaticOrder S; S.init(NTOK, DM, (int)gridDim.x, (int)blockIdx.x);
            pg8::EpiY E{Yb, SSQ};
            pg8::gemm_phase<pg8::EpiY, pg8::StaticOrder, true, true>((PG8_LAS unsigned char*)lds, g, S, E);
        }
        SEAM(pb + 4);
    }
#if REP_PHASE == 9
    for (int i = 0; i < 10; ++i) xcd_barrier(xbar);
#endif
    if (IN(11)) norm_phase(a, 2);
#undef IN
#undef SEAM
}

#ifndef MK_MULTI
#define MK_MULTI 0
#endif
extern "C" void kernel_launch(void* const* d_in, const int* in_sizes, int n_in, void* d_out, int out_size, void* d_ws, size_t ws_size, hipStream_t stream) {
    static int grid = 0;
    if (grid == 0) {
        if (n_in != 14 || ws_size < WS_END) { fprintf(stderr, "kernel_launch: unexpected n_in %d or ws_size %zu (need %zu)\n", n_in, ws_size, (size_t)WS_END); grid = -1; return; }
        int dev = 0, cus = 0, per_cu = 0;
        hipGetDevice(&dev); hipDeviceGetAttribute(&cus, hipDeviceAttributeMultiprocessorCount, dev);
        if (hipFuncSetAttribute((const void*)hybrid_fwd, hipFuncAttributeMaxDynamicSharedMemorySize, LDS_BYTES) != hipSuccess) { fprintf(stderr, "kernel_launch: hipFuncSetAttribute failed\n"); grid = -1; return; }
        if (hipOccupancyMaxActiveBlocksPerMultiprocessor(&per_cu, (const void*)hybrid_fwd, NTHREADS, LDS_BYTES) != hipSuccess || per_cu < 1) { fprintf(stderr, "kernel_launch: occupancy query gave %d\n", per_cu); per_cu = 1; }
        (void)hipGetLastError();
        grid = cus * 1;
        fprintf(stderr, "kernel_launch: grid %d (cus %d, per_cu %d)\n", grid, cus, per_cu);
    }
    if (grid < 0) return;
    if (hipMemsetAsync((char*)d_ws + WS_CTL, 0, WS_ZERO_BYTES, stream) != hipSuccess) { fprintf(stderr, "kernel_launch: hipMemsetAsync failed\n"); return; }
    KArgs a{};
    a.x = (const float*)d_in[0]; a.c = (const float*)d_in[1]; a.ctx = (const float*)d_in[2]; a.c_ctx = (const float*)d_in[3]; a.w_mod = (const float*)d_in[4]; a.b_mod = (const float*)d_in[5];
    a.g_pre = (const float*)d_in[6]; a.g_post = (const float*)d_in[7]; a.w_in = (const float*)d_in[8]; a.w_out = (const float*)d_in[9]; a.sink = (const float*)d_in[10]; a.w_f = (const float*)d_in[11];
    a.conv_w = (const float*)d_in[12]; a.conv_b = (const float*)d_in[13];
    a.out = (float*)d_out; a.ws = (unsigned char*)d_ws;
#if MK_MULTI
    for (int ph = 0; ph < 12; ++ph) { a.ph_lo = ph; a.ph_hi = ph + 1; hipLaunchKernelGGL(hybrid_fwd, dim3(grid), dim3(NTHREADS), LDS_BYTES, stream, a); }
#else
    a.ph_lo = 0; a.ph_hi = 12;
    void* args[] = {&a};
    hipError_t e = hipLaunchCooperativeKernel((const void*)hybrid_fwd, dim3(grid), dim3(NTHREADS), args, LDS_BYTES, stream);
    if (e != hipSuccess) fprintf(stderr, "kernel_launch: cooperative launch failed: %s (grid %d)\n", hipGetErrorString(e), grid);
#endif
}
```

```cpp
#include <hip/hip_runtime.h>
#include <hip/hip_cooperative_groups.h>
#include <cstdio>
#include <cstdint>
namespace cg = cooperative_groups;
namespace pg8 {
#define PG8_LAS __attribute__((address_space(3)))
typedef unsigned short bf16_t;
typedef short bf16x8 __attribute__((ext_vector_type(8)));
typedef float f32x4 __attribute__((ext_vector_type(4)));
typedef unsigned u32x4 __attribute__((ext_vector_type(4)));
constexpr int BM = 256, BK = 64, HALF = 128, HTB = HALF * BK * 2  , STAGE_BYTES = 8 * HTB, NXCD = 8, WGM = 8;

__host__ __device__ __forceinline__ int lds_byte(int r, int c) { const int st = (r >> 4) * 2 + (c >> 5), rr = r & 15, cc = c & 31, ob = rr * 64 + cc * 2; return st * 1024 + (ob ^ (((ob >> 9) & 1) << 5)); }
__host__ __device__ __forceinline__ void stage_rc(int b, int& R, int& C) { const int st = b / 1024, sb = b % 1024, swz = sb ^ (((sb >> 9) & 1) << 5); R = (st >> 1) * 16 + swz / 64; C = (st & 1) * 32 + (swz % 64) / 2; }
__host__ __device__ __forceinline__ int perm32(int rho) { const int n = rho >> 4, i = rho & 15; return 8 * (i >> 2) + 4 * n + (i & 3); }

struct Unit { int pm, pn; };
struct Gemm { const bf16_t* A; const bf16_t* Bt; int M, N, K; };

struct StaticOrder {
    int nM, nN, nwg, G, c;
    __host__ __device__ void init(int M, int N, int G_, int c_) { nM = M / BM; nN = N / BM; nwg = nM * nN; G = G_; c = c_; }
    __host__ __device__ bool next(int i, Unit& u) const {
        const long L = (long)i * G + c; if (L >= nwg) return false;
        int wgid = (int)L; { const int q = nwg / NXCD, r = nwg % NXCD, xcd = wgid % NXCD, off = wgid / NXCD; wgid = (xcd < r ? xcd * (q + 1) : r * (q + 1) + (xcd - r) * q) + off; }
        const int nig = WGM * nN, gid = wgid / nig, fm = gid * WGM, gsz = (nM - fm) < WGM ? (nM - fm) : WGM;
        u.pm = fm + ((wgid % nig) % gsz); u.pn = (wgid % nig) / gsz; return true;
    }
    __device__ __forceinline__ void a_ready(const Unit&) const {}
    __device__ __forceinline__ void done(const Unit&) const {}
};

__device__ __forceinline__ unsigned cvt_pk_bf16(float lo, float hi) { unsigned r; asm volatile("v_cvt_pk_bf16_f32 %0, %1, %2" : "=v"(r) : "v"(lo), "v"(hi)); return r; }
typedef unsigned u32x2 __attribute__((ext_vector_type(2)));
__device__ __forceinline__ int swap23(int t) { return (t & ~12) | ((t & 4) << 1) | ((t & 8) >> 1); }
struct EpiProj {
    static constexpr bool PERM = true, AFTER_DRAIN = false;
    bf16_t* P; bf16_t* Vt; const float* rope; bf16_t* UFP; float qscale;
    __device__ __forceinline__ void operator()(const f32x4 (&acc)[2][2][4][2], const Unit& u, int wr, int wc, int fr, int fq) const {
        const int row0 = u.pm * BM + wr * 64 + fr;
        const int pn = u.pn;
        const bool ctxrow = u.pm >= 128;
        f32x4 CS[2][4], SN[2][4];
        if (pn <= 2) {
#pragma unroll
            for (int ai = 0; ai < 2; ++ai)
#pragma unroll
                for (int m = 0; m < 4; ++m) {
                    CS[ai][m] = (f32x4){1.f, 1.f, 1.f, 1.f}; SN[ai][m] = (f32x4){0.f, 0.f, 0.f, 0.f};
                    if (!ctxrow) { const int t = (row0 + ai * HALF + m * 16) & 8191; const int pos = (wc & 1) ? (t & 63) : (t >> 6);
                        CS[ai][m] = *(const f32x4*)(rope + pos * 32 + 4 * fq); SN[ai][m] = *(const f32x4*)(rope + pos * 32 + 16 + 4 * fq); }
                }
            __builtin_amdgcn_sched_barrier(0);
        }
#pragma unroll
        for (int ai = 0; ai < 2; ++ai)
#pragma unroll
            for (int m = 0; m < 4; ++m) {
                const int row = row0 + ai * HALF + m * 16;
                bf16_t* rowp = P + (size_t)row * 2816 + pn * BM + wc * 32 + 8 * fq;
                if (pn == 5 && !ctxrow) { const int t = row & 8191; rowp = UFP + ((size_t)(((row >> 13) * 64 + (t & 63)) * 128 + (t >> 6))) * 256 + wc * 32 + 8 * fq; }
                if (pn > 2) {
#pragma unroll
                    for (int bj = 0; bj < 2; ++bj) { const f32x4 v0 = acc[ai][bj][m][0], v1 = acc[ai][bj][m][1];
                        u32x4 w; w.x = cvt_pk_bf16(v0[0], v0[1]); w.y = cvt_pk_bf16(v0[2], v0[3]); w.z = cvt_pk_bf16(v1[0], v1[1]); w.w = cvt_pk_bf16(v1[2], v1[3]);
                        *(u32x4*)(rowp + bj * HALF) = w; }
                } else {
                    const f32x4 cs = CS[ai][m], sn = SN[ai][m];
#pragma unroll
                    for (int bj = 0; bj < 2; ++bj) {
                        f32x4 v0 = acc[ai][bj][m][0], v1 = acc[ai][bj][m][1];
                        if (pn == 2 && bj == 1) {
                            int b, tok; if (ctxrow) { const int rr = row - 32768; b = rr >> 8; tok = 8192 + (rr & 255); } else { b = row >> 13; tok = row & 8191; }
                            const int ptok = swap23(tok);
                            bf16_t* vp = Vt + ((size_t)((b * 2 + (wc >> 1)) * 64 + 32 * (wc & 1) + 8 * fq)) * 8448 + ptok;
                            const unsigned w0 = cvt_pk_bf16(v0[0], v0[1]), w1 = cvt_pk_bf16(v0[2], v0[3]), w2 = cvt_pk_bf16(v1[0], v1[1]), w3 = cvt_pk_bf16(v1[2], v1[3]);
                            vp[0 * 8448] = (bf16_t)(w0 & 0xffffu); vp[1 * 8448] = (bf16_t)(w0 >> 16); vp[2 * 8448] = (bf16_t)(w1 & 0xffffu); vp[3 * 8448] = (bf16_t)(w1 >> 16);
                            vp[4 * 8448] = (bf16_t)(w2 & 0xffffu); vp[5 * 8448] = (bf16_t)(w2 >> 16); vp[6 * 8448] = (bf16_t)(w3 & 0xffffu); vp[7 * 8448] = (bf16_t)(w3 >> 16);
                        } else {
                            const f32x4 r0 = v0 * cs - v1 * sn, r1 = v0 * sn + v1 * cs;
                            v0 = r0; v1 = r1;
                            if (pn < 2) { v0 = v0 * qscale; v1 = v1 * qscale; }
                            u32x4 w; w.x = cvt_pk_bf16(v0[0], v0[1]); w.y = cvt_pk_bf16(v0[2], v0[3]); w.z = cvt_pk_bf16(v1[0], v1[1]); w.w = cvt_pk_bf16(v1[2], v1[3]);
                            *(u32x4*)(rowp + bj * HALF) = w;
                        }
                    }
                }
            }
    }
};
struct EpiY {
    static constexpr bool PERM = true, AFTER_DRAIN = false;
    bf16_t* Y; float* ssq;
    __device__ __forceinline__ void operator()(const f32x4 (&acc)[2][2][4][2], const Unit& u, int wr, int wc, int fr, int fq) const {
        const int row0 = u.pm * BM + wr * 64 + fr;
#pragma unroll
        for (int ai = 0; ai < 2; ++ai)
#pragma unroll
            for (int m = 0; m < 4; ++m) {
                const int row = row0 + ai * HALF + m * 16;
                bf16_t* rowp = Y + (size_t)row * 1024 + u.pn * BM + wc * 32 + 8 * fq;
                float s = 0.f;
#pragma unroll
                for (int bj = 0; bj < 2; ++bj) { const f32x4 v0 = acc[ai][bj][m][0], v1 = acc[ai][bj][m][1];
                    s += (v0[0] * v0[0] + v0[1] * v0[1]) + (v0[2] * v0[2] + v0[3] * v0[3]) + (v1[0] * v1[0] + v1[1] * v1[1]) + (v1[2] * v1[2] + v1[3] * v1[3]);
                    u32x4 w; w.x = cvt_pk_bf16(v0[0], v0[1]); w.y = cvt_pk_bf16(v0[2], v0[3]); w.z = cvt_pk_bf16(v1[0], v1[1]); w.w = cvt_pk_bf16(v1[2], v1[3]);
                    *(u32x4*)(rowp + bj * HALF) = w; }
                s += __shfl_xor(s, 16); s += __shfl_xor(s, 32);
                if (fq == 0) ssq[(size_t)row * 16 + u.pn * 4 + wc] = s;
            }
    }
};
template <class Epi, class Sched, bool ALIGN_EPI = false, bool SP2 = false>
__device__ __forceinline__ void gemm_phase(PG8_LAS unsigned char* lds, const Gemm g, const Sched& S, const Epi& E) {
    int tid_ = threadIdx.x; asm volatile("" : "+v"(tid_));
    const int tid = tid_, wid = __builtin_amdgcn_readfirstlane(tid >> 6), lane = tid & 63, wr = wid >> 2, wc = wid & 3, fr = lane & 15, fq = lane >> 4;
    const int K = g.K, nt = K / BK;
    unsigned voffA[2], voffB[2];
#pragma unroll
    for (int i = 0; i < 2; ++i) { int R, C; stage_rc(tid * 16 + i * 8192, R, C); const int Rb = Epi::PERM ? ((R & ~31) + perm32(R & 31)) : R;
        voffA[i] = (unsigned)(R * K + C) * 2u; voffB[i] = (unsigned)(Rb * K + C) * 2u; }
    const size_t kstep = (size_t)(BK * 2);
    const size_t hstep = (size_t)HALF * K * 2;
    const size_t tstep = 2 * hstep;
    const unsigned ldsw = (unsigned)wid * 1024u;
    const int aoff = lds_byte(wr * 64 + fr, fq * 8), boff = lds_byte(wc * 32 + fr, fq * 8);
#define PG8_SA(b, h) (((b) * 2 + (h)) * HTB)
#define PG8_SB(b, h) ((4 + (b) * 2 + (h)) * HTB)
#define PG8_STAGE(bufoff, gbase, voff) do { _Pragma("unroll") for (int _i = 0; _i < 2; ++_i) \
        __builtin_amdgcn_global_load_lds((const unsigned*)((const char*)(gbase) + (voff)[_i]), (PG8_LAS unsigned*)(lds + (bufoff) + ldsw + _i * 8192), 16, 0, 0); } while (0)
#define PG8_LDA(dst, b, h) do { _Pragma("unroll") for (int m = 0; m < 4; ++m) _Pragma("unroll") for (int k = 0; k < 2; ++k) dst[m][k] = *(const PG8_LAS bf16x8*)(lds + PG8_SA(b, h) + aoff + m * 2048 + k * 1024); } while (0)
#define PG8_LDB(dst, b, h) do { _Pragma("unroll") for (int n = 0; n < 2; ++n) _Pragma("unroll") for (int k = 0; k < 2; ++k) dst[n][k] = *(const PG8_LAS bf16x8*)(lds + PG8_SB(b, h) + boff + n * 2048 + k * 1024); } while (0)
#define PG8_MMA(ai, bj, At, Bt) do { __builtin_amdgcn_s_setprio(1); _Pragma("unroll") for (int m = 0; m < 4; ++m) _Pragma("unroll") for (int n = 0; n < 2; ++n) _Pragma("unroll") for (int k = 0; k < 2; ++k) \
        acc[ai][bj][m][n] = __builtin_amdgcn_mfma_f32_16x16x32_bf16(Bt[n][k], At[m][k], acc[ai][bj][m][n], 0, 0, 0); __builtin_amdgcn_s_setprio(0); } while (0)
#define PG8_WAIT_V(n) asm volatile("s_waitcnt vmcnt(" #n ")" ::: "memory")
#define PG8_WAIT_L(n) asm volatile("s_waitcnt lgkmcnt(" #n ")" ::: "memory")
#define PG8_BAR __builtin_amdgcn_s_barrier()
#define PG8_SCHED __builtin_amdgcn_sched_barrier(0)
    Unit cur, nxt; int ui = 0;
    if (!S.next(0, cur)) return;
    f32x4 acc[2][2][4][2];
#pragma unroll
    for (int a = 0; a < 2; ++a)
#pragma unroll
        for (int b = 0; b < 2; ++b)
#pragma unroll
            for (int m = 0; m < 4; ++m)
#pragma unroll
                for (int n = 0; n < 2; ++n) acc[a][b][m][n] = (f32x4){0.f, 0.f, 0.f, 0.f};
    bf16x8 At[4][2], B0[2][2], B1[2][2];
    const char* cA = (const char*)g.A + (size_t)cur.pm * tstep; const char* cB = (const char*)g.Bt + (size_t)cur.pn * tstep;
    S.a_ready(cur);
    if constexpr (SP2) {
        PG8_STAGE(PG8_SB(0, 0), cB, voffB); PG8_STAGE(PG8_SB(0, 1), cB + hstep, voffB); PG8_STAGE(PG8_SA(0, 0), cA, voffA); PG8_STAGE(PG8_SA(0, 1), cA + hstep, voffA);
        if (wr == 1) PG8_BAR;
        PG8_WAIT_V(2); PG8_BAR;
        PG8_STAGE(PG8_SB(1, 0), cB + kstep, voffB); PG8_STAGE(PG8_SA(1, 0), cA + kstep, voffA); PG8_STAGE(PG8_SB(1, 1), cB + hstep + kstep, voffB);
        PG8_WAIT_V(6); PG8_BAR;
    } else {
        PG8_STAGE(PG8_SB(0, 0), cB, voffB); PG8_STAGE(PG8_SA(0, 0), cA, voffA); PG8_STAGE(PG8_SB(0, 1), cB + hstep, voffB); PG8_STAGE(PG8_SA(0, 1), cA + hstep, voffA);
        if (wr == 1) PG8_BAR;
        PG8_WAIT_V(4); PG8_BAR;
        PG8_STAGE(PG8_SB(1, 0), cB + kstep, voffB); PG8_STAGE(PG8_SA(1, 0), cA + kstep, voffA); PG8_STAGE(PG8_SB(1, 1), cB + hstep + kstep, voffB);
        PG8_WAIT_V(6); PG8_BAR;
    }
    for (;;) {
        const bool has_next = S.next(ui + 1, nxt);
        const char* nA = has_next ? (const char*)g.A + (size_t)nxt.pm * tstep : cA; const char* nB = has_next ? (const char*)g.Bt + (size_t)nxt.pn * tstep : cB;
        for (int t = 0; t < nt; t += 2) {
            const bool last = (t == nt - 2);
            const char* a1 = cA + (size_t)(t + 1) * kstep;
            const char* a2 = last ? nA : cA + (size_t)(t + 2) * kstep; const char* b2 = last ? nB : cB + (size_t)(t + 2) * kstep;
            const char* a3 = a2 + kstep; const char* b3 = b2 + kstep;
            if (last && has_next) S.a_ready(nxt);
            if constexpr (SP2) {
            PG8_LDB(B0, 0, 0); PG8_LDB(B1, 0, 1); PG8_SCHED; PG8_LDA(At, 0, 0); PG8_STAGE(PG8_SA(1, 1), a1 + hstep, voffA);
            PG8_WAIT_V(8); PG8_WAIT_L(0); PG8_BAR; PG8_MMA(0, 0, At, B0); PG8_MMA(0, 1, At, B1); PG8_BAR; PG8_SCHED;
            PG8_LDA(At, 0, 1); PG8_STAGE(PG8_SB(0, 0), b2, voffB); PG8_STAGE(PG8_SB(0, 1), b2 + hstep, voffB); PG8_STAGE(PG8_SA(0, 0), a2, voffA);
            PG8_WAIT_V(8); PG8_WAIT_L(0); PG8_BAR; PG8_MMA(1, 0, At, B0); PG8_MMA(1, 1, At, B1); PG8_BAR; PG8_SCHED;
            PG8_LDB(B0, 1, 0); PG8_LDB(B1, 1, 1); PG8_SCHED; PG8_LDA(At, 1, 0); PG8_STAGE(PG8_SA(0, 1), a2 + hstep, voffA);
            PG8_WAIT_V(8); PG8_WAIT_L(0); PG8_BAR; PG8_MMA(0, 0, At, B0); PG8_MMA(0, 1, At, B1); PG8_BAR; PG8_SCHED;
            PG8_LDA(At, 1, 1); PG8_STAGE(PG8_SB(1, 0), b3, voffB); PG8_STAGE(PG8_SB(1, 1), b3 + hstep, voffB); PG8_STAGE(PG8_SA(1, 0), a3, voffA);
            PG8_WAIT_V(8); PG8_WAIT_L(0); PG8_BAR; PG8_MMA(1, 0, At, B0); PG8_MMA(1, 1, At, B1); PG8_BAR; PG8_SCHED;
            } else {
            PG8_LDB(B0, 0, 0); PG8_SCHED; PG8_LDA(At, 0, 0); PG8_STAGE(PG8_SA(1, 1), a1 + hstep, voffA);
            PG8_WAIT_L(8); PG8_BAR; PG8_WAIT_L(0); PG8_MMA(0, 0, At, B0); PG8_BAR; PG8_SCHED;
            PG8_LDB(B1, 0, 1); PG8_STAGE(PG8_SB(0, 0), b2, voffB);
            PG8_BAR; PG8_WAIT_L(0); PG8_MMA(0, 1, At, B1); PG8_BAR;
            PG8_LDA(At, 0, 1); PG8_STAGE(PG8_SA(0, 0), a2, voffA);
            PG8_BAR; PG8_WAIT_L(0); PG8_MMA(1, 0, At, B0); PG8_BAR; PG8_SCHED;
            PG8_STAGE(PG8_SB(0, 1), b2 + hstep, voffB);
            PG8_WAIT_V(6); PG8_BAR; PG8_MMA(1, 1, At, B1); PG8_BAR;
            PG8_LDB(B0, 1, 0); PG8_SCHED; PG8_LDA(At, 1, 0); PG8_STAGE(PG8_SA(0, 1), a2 + hstep, voffA);
            PG8_WAIT_L(8); PG8_BAR; PG8_WAIT_L(0); PG8_MMA(0, 0, At, B0); PG8_BAR; PG8_SCHED;
            PG8_LDB(B1, 1, 1); PG8_STAGE(PG8_SB(1, 0), b3, voffB);
            PG8_BAR; PG8_WAIT_L(0); PG8_MMA(0, 1, At, B1); PG8_BAR;
            PG8_LDA(At, 1, 1); PG8_STAGE(PG8_SA(1, 0), a3, voffA);
            PG8_BAR; PG8_WAIT_L(0); PG8_MMA(1, 0, At, B0); PG8_BAR; PG8_SCHED;
            PG8_STAGE(PG8_SB(1, 1), b3 + hstep, voffB);
            PG8_WAIT_V(6); PG8_BAR; PG8_MMA(1, 1, At, B1); PG8_BAR;
            }
        }
        if constexpr (ALIGN_EPI) { if (wr == 0) PG8_BAR; }
        if constexpr (!Epi::AFTER_DRAIN) { E(acc, cur, wr, wc, fr, fq); S.done(cur); }
        if (!has_next) break;
#pragma unroll
        for (int a = 0; a < 2; ++a)
#pragma unroll
            for (int b = 0; b < 2; ++b)
#pragma unroll
                for (int m = 0; m < 4; ++m)
#pragma unroll
                    for (int n = 0; n < 2; ++n) acc[a][b][m][n] = (f32x4){0.f, 0.f, 0.f, 0.f};
        cur = nxt; cA = nA; cB = nB; ++ui;
        if constexpr (ALIGN_EPI) { if (wr == 1) PG8_BAR; }
    }
    PG8_WAIT_V(0);
    if constexpr (!ALIGN_EPI) { if (wr == 0) PG8_BAR; }
    PG8_BAR;
    if constexpr (Epi::AFTER_DRAIN) { E.fused(acc, cur, wr, wc, fr, fq, lds, wid, lane); S.done(cur); }
#undef PG8_SA
#undef PG8_SB
#undef PG8_STAGE
#undef PG8_LDA
#undef PG8_LDB
#undef PG8_MMA
#undef PG8_WAIT_V
#undef PG8_WAIT_L
#undef PG8_BAR
#undef PG8_SCHED
}
}

typedef unsigned short bf16_t;
typedef short bf16x8 __attribute__((ext_vector_type(8)));
typedef float f32x4 __attribute__((ext_vector_type(4)));
typedef float f32x16 __attribute__((ext_vector_type(16)));
typedef unsigned u32x4 __attribute__((ext_vector_type(4)));
typedef unsigned u32x2 __attribute__((ext_vector_type(2)));
#define LAS __attribute__((address_space(3)))
__device__ __forceinline__ int opaque_tid() { int t = threadIdx.x; asm volatile("" : "+v"(t)); return t; }

constexpr int DM = 1024, NBATCH = 4, SEQ = 8192, NTOK = NBATCH * SEQ, CTXL = 256, NCTX = NBATCH * CTXL, MROWS = NTOK + NCTX;
constexpr int PW = 2816;
constexpr int C_Q = 0, C_K = 512, C_V = 640, C_GA = 768, C_UF = 1280, C_GF = 1536, C_ZC = 1792, C_BC = 2048, C_CC = 2304, C_GC = 2560;
constexpr int VT_PITCH = SEQ + CTXL;
constexpr float NORM_EPS = 1e-6f;
constexpr float LOG2E = 1.4426950408889634f;

constexpr size_t KiB = 1024, MiB = 1u << 20;
constexpr size_t WS_CTL = 0;
constexpr size_t WS_BAR = 16 * KiB;
constexpr size_t WS_ZERO_BYTES = 32 * KiB;
constexpr size_t WS_MOD = 64 * KiB;
constexpr size_t WS_ROPE = 256 * KiB;
constexpr size_t WS_TW = 320 * KiB;
constexpr size_t WS_T1R = 384 * KiB, WS_T1I = 416 * KiB;
constexpr size_t WS_T3R = 448 * KiB, WS_T3I = 464 * KiB;
constexpr size_t WS_T256R = 512 * KiB, WS_T256I = 640 * KiB;
constexpr size_t WS_GT = 768 * KiB;
constexpr size_t WS_SSQ = 1 * MiB;
constexpr size_t WS_WIN = 4 * MiB;
constexpr size_t WS_WOUT = 16 * MiB;
constexpr size_t WS_SSQ1 = 24 * MiB;
constexpr size_t WS_MODP = 28 * MiB;
constexpr size_t WS_HX = 32 * MiB;
constexpr size_t WS_P = 112 * MiB;
constexpr size_t WS_VT = 304 * MiB;
constexpr size_t WS_H = 320 * MiB;
constexpr size_t WS_Y = 392 * MiB;
constexpr size_t WS_YF = 464 * MiB;
constexpr size_t WS_CTX1 = 100 * MiB;
constexpr size_t WS_UFP = 496 * MiB;
constexpr size_t WS_END = 512 * MiB;
static_assert(WS_BAR + 3456 * 4 <= WS_ZERO_BYTES && WS_MODP + (size_t)2 * 8 * 5 * 3072 * 4 <= WS_HX && WS_SSQ + (size_t)MROWS * 16 * 4 <= WS_WIN && WS_WIN + (size_t)2 * PW * DM * 2 <= WS_WOUT && WS_HX + (size_t)MROWS * DM * 2 <= WS_P && WS_P + (size_t)MROWS * PW * 2 <= WS_VT &&
              WS_VT + (size_t)8 * 64 * VT_PITCH * 2 <= WS_H && WS_H + (size_t)MROWS * DM * 2 <= WS_Y && WS_Y + (size_t)MROWS * DM * 2 <= WS_YF && WS_YF + (size_t)4 * 128 * 64 * 512 * 2 <= WS_UFP && WS_UFP + (size_t)NTOK * 256 * 2 <= WS_END && WS_HX + (size_t)MROWS * DM * 2 <= WS_CTX1 && WS_CTX1 + (size_t)NCTX * DM * 4 <= WS_P, "ws map");

constexpr int LDS_BYTES = 147456;
constexpr int LDS_SCHED = LDS_BYTES - 64;
constexpr int LDS_BARST = LDS_BYTES - 32;
constexpr int NTHREADS = 512;

__device__ __forceinline__ float bf2f(unsigned h) { return __uint_as_float(h << 16); }
__device__ __forceinline__ unsigned pkbf(float lo, float hi) { unsigned r; asm volatile("v_cvt_pk_bf16_f32 %0, %1, %2" : "=v"(r) : "v"(lo), "v"(hi)); return r; }
__device__ __forceinline__ float silu_f(float x) { return x * __builtin_amdgcn_rcpf(1.f + __builtin_amdgcn_exp2f(-x * LOG2E)); }
__device__ __forceinline__ float wave_sum(float v) {
#pragma unroll
    for (int o = 1; o < 64; o <<= 1) v += __shfl_xor(v, o);
    return v;
}
__device__ __forceinline__ int swap23(int t) { return (t & ~12) | ((t & 4) << 1) | ((t & 8) >> 1); }
__device__ __forceinline__ int crow(int r, int hi) { return (r & 3) + 8 * (r >> 2) + 4 * hi; }
__device__ __forceinline__ bf16x8 pack8(const f32x16& p, int base) {
    u32x4 w; w.x = pkbf(p[base + 0], p[base + 1]); w.y = pkbf(p[base + 2], p[base + 3]); w.z = pkbf(p[base + 4], p[base + 5]); w.w = pkbf(p[base + 6], p[base + 7]);
    return __builtin_bit_cast(bf16x8, w);
}
#define MFMA32(a, b, c) __builtin_amdgcn_mfma_f32_32x32x16_bf16((a), (b), (c), 0, 0, 0)

struct KArgs {
    const float *x, *c, *ctx, *c_ctx, *w_mod, *b_mod, *g_pre, *g_post, *w_in, *w_out, *sink, *w_f, *conv_w, *conv_b;
    float* out; unsigned char* ws; int ph_lo, ph_hi;
};

__device__ __forceinline__ int prow_qk(int n) { return (n & ~31) | (8 * ((n >> 2) & 3) + 4 * ((n >> 4) & 1) + (n & 3)); }
__device__ __forceinline__ void p0_transpose_item(const float* W, int K, int N, bf16_t* WT, int nperm, float* scr, int item, int lane) {
    const int nblk = N / 32, kb = item / nblk, nb = item % nblk, k0 = 64 * kb, n0 = 32 * nb;
#pragma unroll 8
    for (int i = 0; i < 32; ++i) { const int kk = 2 * i + (lane >> 5); scr[kk * 33 + (lane & 31)] = W[(size_t)(k0 + kk) * N + n0 + (lane & 31)]; }
    asm volatile("s_waitcnt lgkmcnt(0)" ::: "memory");
    const int c = lane & 7;
#pragma unroll
    for (int j = 0; j < 4; ++j) { const int n = (lane >> 3) + 8 * j; const float* s = scr + (8 * c) * 33 + n;
        u32x4 o; o.x = pkbf(s[0 * 33], s[1 * 33]); o.y = pkbf(s[2 * 33], s[3 * 33]); o.z = pkbf(s[4 * 33], s[5 * 33]); o.w = pkbf(s[6 * 33], s[7 * 33]);
        const int nl = n0 + n; const int np = nl < nperm ? prow_qk(nl) : nl;
        *(u32x4*)(WT + (size_t)np * K + k0 + 8 * c) = o; }
    asm volatile("s_waitcnt lgkmcnt(0)" ::: "memory");
}

__device__ __forceinline__ void p0_mod_gemv(const KArgs& a, int item, float* ldsf) {
    const int tid = opaque_tid(), lane = tid & 63, wave = tid >> 6;
    const int l = item / 96, col0 = (item % 96) * 32;
    float* s = ldsf;
    float* red = ldsf + 5 * 1024;
    for (int i = tid; i < 5 * 1024; i += NTHREADS) { const int bb = i >> 10, k = i & 1023; const float v = bb < 4 ? a.c[bb * 1024 + k] : a.c_ctx[k]; s[i] = v / (1.f + __expf(-v)); }
    __syncthreads();
    const int col = lane & 31, kh = lane >> 5;
    const float* W = a.w_mod + (size_t)l * 1024 * 3072 + (size_t)(wave * 128 + kh) * 3072 + col0 + col;
    float w[64];
#pragma unroll
    for (int i = 0; i < 64; ++i) w[i] = W[(size_t)(2 * i) * 3072];
    float acc[5] = {0.f, 0.f, 0.f, 0.f, 0.f};
#pragma unroll
    for (int i = 0; i < 64; ++i)
#pragma unroll
        for (int bb = 0; bb < 5; ++bb) acc[bb] += w[i] * s[bb * 1024 + wave * 128 + 2 * i + kh];
#pragma unroll
    for (int bb = 0; bb < 5; ++bb) red[((wave * 2 + kh) * 5 + bb) * 32 + col] = acc[bb];
    __syncthreads();
    if (tid < 160) { const int bb = tid >> 5, cc = tid & 31; float v = a.b_mod[l * 3072 + col0 + cc];
#pragma unroll
        for (int ww = 0; ww < 16; ++ww) v += red[(ww * 5 + bb) * 32 + cc];
        ((float*)(a.ws + WS_MOD))[(l * 5 + bb) * 3072 + col0 + cc] = v; }
    __syncthreads();
}

__device__ __forceinline__ void p0_prologue(const KArgs& a, unsigned char* lds) {
    const int tid = opaque_tid(), lane = tid & 63, wave = tid >> 6;
    const int G = gridDim.x, bx = blockIdx.x;
    unsigned char* ws = a.ws;
    if (bx < 192) p0_mod_gemv(a, bx, (float*)lds);
    {
        float* scr = (float*)(lds + wave * 16384);
        const int gw = bx * 8 + wave, NGW = G * 8;
        constexpr int I_IN = (DM / 64) * (PW / 32), I_OUT = (DM / 64) * (DM / 32);
        constexpr int NIT = 2 * (I_IN + I_OUT);
        for (int it = gw; it < NIT; it += NGW) {
            int r = it; const int l = r / (I_IN + I_OUT); r -= l * (I_IN + I_OUT);
            if (r < I_IN) p0_transpose_item(a.w_in + (size_t)l * DM * PW, DM, PW, (bf16_t*)(ws + WS_WIN) + (size_t)l * PW * DM, 640, scr, r, lane);
            else p0_transpose_item(a.w_out + (size_t)l * DM * DM, DM, DM, (bf16_t*)(ws + WS_WOUT) + (size_t)l * DM * DM, 0, scr, r - I_IN, lane);
        }
    }
    const int gt = bx * NTHREADS + tid, NGT = G * NTHREADS;
    for (int i = gt; i < 128 * 16; i += NGT) {
        const int pos = i >> 4, f = i & 15; const float inv = powf(10000.0f, -(float)f / 16.0f); const float ang = (float)pos * inv;
        float* rp = (float*)(ws + WS_ROPE) + pos * 32; rp[f] = cosf(ang); rp[16 + f] = sinf(ang);
    }
    for (int i = gt; i < 8192; i += NGT) { float sn, cs; sincospif((float)i * (2.0f / 8192.0f), &sn, &cs); float* t = (float*)(ws + WS_TW) + 2 * i; t[0] = cs; t[1] = sn; }
    for (int i = gt; i < 128 * 128; i += NGT) { const int k = i >> 7, n = i & 127; float sn, cs; sincospif((float)((k * n) & 127) * (2.0f / 128.0f), &sn, &cs);
        ((bf16_t*)(ws + WS_T1R))[i] = (bf16_t)(pkbf(cs, 0.f) & 0xffffu); ((bf16_t*)(ws + WS_T1I))[i] = (bf16_t)(pkbf(-sn, 0.f) & 0xffffu); }
    for (int i = gt; i < 64 * 128; i += NGT) { const int k = i >> 7, kk = i & 127, n = kk & 63; float sn, cs; sincospif((float)((k * n) & 63) * (2.0f / 64.0f), &sn, &cs);
        const float tr = kk < 64 ? cs : sn, ti = kk < 64 ? -sn : cs;
        ((bf16_t*)(ws + WS_T3R))[i] = (bf16_t)(pkbf(tr, 0.f) & 0xffffu); ((bf16_t*)(ws + WS_T3I))[i] = (bf16_t)(pkbf(ti, 0.f) & 0xffffu); }
    for (int i = gt; i < 256 * 256; i += NGT) { const int k = i >> 8, n = i & 255; float sn, cs; sincospif((float)((k * n) & 255) * (2.0f / 256.0f), &sn, &cs);
        ((bf16_t*)(ws + WS_T256R))[i] = (bf16_t)(pkbf(cs, 0.f) & 0xffffu); ((bf16_t*)(ws + WS_T256I))[i] = (bf16_t)(pkbf(-sn, 0.f) & 0xffffu); }
    {
        __syncthreads();
        float* trig = (float*)lds;
        if (tid < 64) { float sn, cs; sincospif((float)tid * (2.0f / 64.0f), &sn, &cs); trig[tid] = cs; trig[64 + tid] = sn; }
        __syncthreads();
        for (int i = gt; i < 2 * 4 * 64 * 128; i += NGT) {
            const int kk = i & 127, d = (i >> 7) & 63, g = (i >> 13) & 3, l = i >> 15; const int part = kk >> 6, c = swap23(kk & 63);
            const float* wf = a.w_f + ((size_t)(l * 4 + g) * 64) * 64 + d; float sacc = 0.f;
#pragma unroll 8
            for (int j = 0; j < 64; ++j) sacc += trig[part * 64 + ((c * j) & 63)] * wf[j * 64];
            ((bf16_t*)(ws + WS_GT))[i] = (bf16_t)(pkbf(sacc * (1.0f / 724.0773439350246f), 0.f) & 0xffffu);
        }
        __syncthreads();
    }
}

__device__ __forceinline__ void norm_rows4(int mode, int lane, const float* src, float* dst, const bf16_t* y0, const float* ssq0, const bf16_t* y1, const float* ssq1, bf16_t* hx,
                                           const f32x4 (&GA0)[4], const f32x4 (&GA1)[4], const f32x4 (&GB)[4], const f32x4 (&GC)[4]) {
    f32x4 v[4][4];
#pragma unroll
    for (int rr = 0; rr < 4; ++rr)
#pragma unroll
        for (int j = 0; j < 4; ++j) v[rr][j] = *(const f32x4*)(src + (size_t)rr * DM + 4 * lane + 256 * j);
    if (mode != 0) {
        u32x2 yw[4][4], yx[4][4]; float p[4], p1[4];
#pragma unroll
        for (int rr = 0; rr < 4; ++rr) { p[rr] = ssq0[rr * 16 + (lane & 15)];
#pragma unroll
            for (int j = 0; j < 4; ++j) yw[rr][j] = *(const u32x2*)(y0 + (size_t)rr * DM + 4 * lane + 256 * j); }
        if (mode == 2) {
#pragma unroll
            for (int rr = 0; rr < 4; ++rr) { p1[rr] = ssq1[rr * 16 + (lane & 15)];
#pragma unroll
                for (int j = 0; j < 4; ++j) yx[rr][j] = *(const u32x2*)(y1 + (size_t)rr * DM + 4 * lane + 256 * j); }
        }
#pragma unroll
        for (int rr = 0; rr < 4; ++rr) {
            float q = p[rr]; q += __shfl_xor(q, 1); q += __shfl_xor(q, 2); q += __shfl_xor(q, 4); q += __shfl_xor(q, 8);
            const float rstd = 1.0f / sqrtf(q * (1.0f / DM) + NORM_EPS);
#pragma unroll
            for (int j = 0; j < 4; ++j) {
                f32x4 yy; yy[0] = bf2f(yw[rr][j].x & 0xffffu); yy[1] = bf2f(yw[rr][j].x >> 16); yy[2] = bf2f(yw[rr][j].y & 0xffffu); yy[3] = bf2f(yw[rr][j].y >> 16);
                v[rr][j] = v[rr][j] + GA0[j] * (yy * rstd);
            }
        }
        if (mode == 2) {
#pragma unroll
            for (int rr = 0; rr < 4; ++rr) {
                float q = p1[rr]; q += __shfl_xor(q, 1); q += __shfl_xor(q, 2); q += __shfl_xor(q, 4); q += __shfl_xor(q, 8);
                const float rstd = 1.0f / sqrtf(q * (1.0f / DM) + NORM_EPS);
#pragma unroll
                for (int j = 0; j < 4; ++j) {
                    f32x4 yy; yy[0] = bf2f(yx[rr][j].x & 0xffffu); yy[1] = bf2f(yx[rr][j].x >> 16); yy[2] = bf2f(yx[rr][j].y & 0xffffu); yy[3] = bf2f(yx[rr][j].y >> 16);
                    v[rr][j] = v[rr][j] + GA1[j] * (yy * rstd);
                    *(f32x4*)(dst + (size_t)rr * DM + 4 * lane + 256 * j) = v[rr][j];
                }
            }
        }
    }
    if (mode != 2) {
        float s[4];
#pragma unroll
        for (int rr = 0; rr < 4; ++rr) { float t = 0.f;
#pragma unroll
            for (int j = 0; j < 4; ++j) t += (v[rr][j][0] * v[rr][j][0] + v[rr][j][1] * v[rr][j][1]) + (v[rr][j][2] * v[rr][j][2] + v[rr][j][3] * v[rr][j][3]);
            s[rr] = t; }
#pragma unroll
        for (int o = 1; o < 64; o <<= 1) {
#pragma unroll
            for (int rr = 0; rr < 4; ++rr) s[rr] += __shfl_xor(s[rr], o); }
#pragma unroll
        for (int rr = 0; rr < 4; ++rr) {
            const float rstd = 1.0f / sqrtf(s[rr] * (1.0f / DM) + NORM_EPS);
#pragma unroll
            for (int j = 0; j < 4; ++j) {
                const f32x4 o = (v[rr][j] * rstd) * GB[j] + GC[j];
                u32x2 w; w.x = pkbf(o[0], o[1]); w.y = pkbf(o[2], o[3]);
                *(u32x2*)(hx + (size_t)rr * DM + 4 * lane + 256 * j) = w;
            }
        }
    }
}
__device__ __forceinline__ void norm_phase(const KArgs& a, int mode) {
    const int tid = opaque_tid(), lane = tid & 63, wave = tid >> 6;
    const int NGW = gridDim.x * 8;
    unsigned char* ws = a.ws;
    const float* mod = (const float*)(ws + WS_MOD);
    const int lp = (mode == 0) ? 0 : 1;
    bf16_t* HX = (bf16_t*)(ws + WS_HX); const bf16_t* Y0 = (const bf16_t*)(ws + WS_Y); const float* SSQ0 = (const float*)(ws + WS_SSQ);
    const bf16_t* Y1 = (const bf16_t*)(ws + WS_HX); const float* SSQ1 = (const float*)(ws + WS_SSQ1);
    const int gw2 = wave * (int)gridDim.x + (int)blockIdx.x;
    const int nlat = NTOK / 4;
    int curb = -1; f32x4 GA0[4], GA1[4], GB[4], GC[4];
    int base = gw2 * 4, sub = 0, itc = nlat + gw2; bool inctx = false;
    for (;;) {
        int it;
        if (!inctx) { if (base >= nlat) { inctx = true; continue; } it = base + sub; if (++sub == 4) { sub = 0; base += NGW * 4; } }
        else { if (mode == 2 || itc >= nlat + NCTX / 4) break; it = itc; itc += NGW; }
        const int r = it * 4;
        const int b = r < NTOK ? (r >> 13) : 4;
        if (b != curb) { curb = b;
            const float* mp = mod + (lp * 5 + b) * 3072; const float* m0 = mod + (0 * 5 + b) * 3072; const float* m1 = mod + (1 * 5 + b) * 3072;
#pragma unroll
            for (int j = 0; j < 4; ++j) { const int c = 4 * lane + 256 * j;
                GA0[j] = *(const f32x4*)(m0 + 2048 + c) * *(const f32x4*)(a.g_post + c);
                GA1[j] = *(const f32x4*)(m1 + 2048 + c) * *(const f32x4*)(a.g_post + DM + c);
                GB[j] = *(const f32x4*)(a.g_pre + lp * DM + c) * (*(const f32x4*)(mp + 1024 + c) + 1.0f);
                GC[j] = *(const f32x4*)(mp + c); } }
        const float* src = (r < NTOK) ? a.x + (size_t)r * DM : a.ctx + (size_t)(r - NTOK) * DM;
        norm_rows4(mode, lane, src, a.out + (size_t)r * DM, Y0 + (size_t)r * DM, SSQ0 + (size_t)r * 16, Y1 + (size_t)r * DM, SSQ1 + (size_t)r * 16, HX + (size_t)r * DM, GA0, GA1, GB, GC);
    }
}

__device__ __forceinline__ void attn_unit(int u, const bf16_t* P, const bf16_t* Vt, bf16_t* H, const float* sink, unsigned char* lds) {
    const int tid = opaque_tid(), lane = tid & 63, wave = __builtin_amdgcn_readfirstlane(tid >> 6), r32 = lane & 31, hi = lane >> 5;
    const bool isctx = u >= 1024;
    int b, kvh, qb;
    if (isctx) { const int v = u - 1024; b = v >> 3; kvh = (v >> 2) & 1; qb = v & 3; } else { b = u >> 8; kvh = (u >> 7) & 1; qb = u & 127; }
    const int head = kvh * 4 + (wave >> 1);
    const int qtok = qb * 64 + (wave & 1) * 32 + r32;
    const size_t qrow = isctx ? (size_t)(NTOK + b * CTXL + qtok) : (size_t)(b * SEQ + qtok);
    const float sinkv = sink[head];
    bf16x8 qf[4];
#pragma unroll
    for (int d0 = 0; d0 < 4; ++d0) qf[d0] = *(const bf16x8*)(P + qrow * PW + C_Q + head * 64 + d0 * 16 + hi * 8);
    int jlo = 0, jhi = -1;
    if (!isctx) { jlo = qb < 2 ? 2 - qb : 0; jhi = (129 - qb) < 4 ? (129 - qb) : 4; }
    const int ntiles = 4 + (jhi - jlo + 1);
    const int srow = tid >> 3, sch = tid & 7;
    const bf16_t* Kc = P + (size_t)(NTOK + b * CTXL + srow) * PW + C_K + kvh * 64 + sch * 8;
    const bf16_t* Kl = P + (size_t)(b * SEQ + srow) * PW + C_K + kvh * 64 + sch * 8;
    const bf16_t* Vb = Vt + (size_t)((b * 2 + kvh) * 64 + srow) * VT_PITCH + sch * 8;
    unsigned char* Ks = lds; unsigned char* Vs = lds + 2 * 9216;
    const int soff = srow * 144 + sch * 16;
    u32x4 kreg, vreg, kreg2, vreg2;
#define ATT_GLOAD(KR, VR, ti_) do { const int t_ = (ti_); \
        if (t_ < 4) { KR = *(const u32x4*)(Kc + (size_t)(64 * t_) * PW); VR = *(const u32x4*)(Vb + SEQ + 64 * t_); } \
        else { const int kbase_ = qb * 64 - 128 + 64 * (jlo + t_ - 4); KR = *(const u32x4*)(Kl + (size_t)kbase_ * PW); VR = *(const u32x4*)(Vb + kbase_); } } while (0)
    const bf16_t* garow = P + qrow * PW + C_GA + head * 64;
    u32x2 gaw[8];
#pragma unroll
    for (int i = 0; i < 8; ++i) gaw[i] = *(const u32x2*)(garow + 32 * (i >> 2) + 8 * (i & 3) + 4 * hi);
    ATT_GLOAD(kreg2, vreg2, 0);
    ATT_GLOAD(kreg, vreg, 1);
    *(u32x4*)(Ks + soff) = kreg2; *(u32x4*)(Vs + soff) = vreg2;
    __syncthreads();
    const float sink2 = sinkv * LOG2E;
    float mref = sink2, lsum = 0.f;
    f32x16 oT[2]; oT[0] = f32x16{}; oT[1] = f32x16{};
    const int qpos = qtok;
    for (int ti = 0; ti < ntiles; ++ti) {
        const int buf = ti & 1;
        if (ti + 2 < ntiles) ATT_GLOAD(kreg2, vreg2, ti + 2);
        const unsigned char* kb = Ks + buf * 9216 + r32 * 144 + hi * 16;
        const unsigned char* vb = Vs + buf * 9216 + r32 * 144 + hi * 16;
        bf16x8 kf[8];
#pragma unroll
        for (int d0 = 0; d0 < 4; ++d0) { kf[2 * d0] = *(const bf16x8*)(kb + d0 * 32); kf[2 * d0 + 1] = *(const bf16x8*)(kb + 32 * 144 + d0 * 32); }
        f32x16 p0, p1;
#pragma unroll
        for (int r = 0; r < 16; ++r) { p0[r] = -mref; p1[r] = -mref; }
        __builtin_amdgcn_sched_barrier(0);
#pragma unroll
        for (int d0 = 0; d0 < 4; ++d0) { p0 = MFMA32(kf[2 * d0], qf[d0], p0); p1 = MFMA32(kf[2 * d0 + 1], qf[d0], p1); }
        bf16x8 vf[8];
#pragma unroll
        for (int blk = 0; blk < 2; ++blk)
#pragma unroll
            for (int ks = 0; ks < 4; ++ks) vf[blk * 4 + ks] = *(const bf16x8*)(vb + blk * 32 * 144 + ks * 32);
        __builtin_amdgcn_sched_barrier(0);
        asm volatile("s_nop 15\n\ts_nop 7" : "+v"(p0), "+v"(p1));
        if (ti >= 4) {
            const int j = jlo + ti - 4; const int kbase = qb * 64 - 128 + 64 * j;
            if (j == 0) {
#pragma unroll
                for (int r = 0; r < 16; ++r) { const int kp = kbase + crow(r, hi); if (kp < qpos - 128) p0[r] = -INFINITY; if (kp + 32 < qpos - 128) p1[r] = -INFINITY; }
            } else if (j == 4) {
#pragma unroll
                for (int r = 0; r < 16; ++r) { const int kp = kbase + crow(r, hi); if (kp > qpos + 128) p0[r] = -INFINITY; if (kp + 32 > qpos + 128) p1[r] = -INFINITY; }
            }
        }
        float rma, rmb;
        asm("v_max3_f32 %0, %1, %2, %3" : "=v"(rma) : "v"(p0[0]), "v"(p0[1]), "v"(p1[0]));
        asm("v_max3_f32 %0, %1, %2, %3" : "=v"(rmb) : "v"(p0[2]), "v"(p0[3]), "v"(p1[1]));
        asm("v_max3_f32 %0, %1, %2, %3" : "=v"(rma) : "v"(rma), "v"(p1[2]), "v"(p1[3]));
#pragma unroll
        for (int r = 4; r < 16; r += 4) {
            asm("v_max3_f32 %0, %1, %2, %3" : "=v"(rma) : "v"(rma), "v"(p0[r]), "v"(p0[r + 1]));
            asm("v_max3_f32 %0, %1, %2, %3" : "=v"(rmb) : "v"(rmb), "v"(p0[r + 2]), "v"(p0[r + 3]));
            asm("v_max3_f32 %0, %1, %2, %3" : "=v"(rma) : "v"(rma), "v"(p1[r]), "v"(p1[r + 1]));
            asm("v_max3_f32 %0, %1, %2, %3" : "=v"(rmb) : "v"(rmb), "v"(p1[r + 2]), "v"(p1[r + 3]));
        }
        float rm; asm("v_max3_f32 %0, %1, %2, %3" : "=v"(rm) : "v"(rma), "v"(rmb), "v"(rmb));
        { const float rmo = __shfl_xor(rm, 32); asm("v_max3_f32 %0, %1, %2, %3" : "=v"(rm) : "v"(rm), "v"(rmo), "v"(rmo)); }
        if (__any(rm > 8.0f)) {
            const float dl = fmaxf(rm, 0.f);
            mref += dl;
            const float f = __builtin_amdgcn_exp2f(-dl);
            lsum *= f;
#pragma unroll
            for (int r = 0; r < 16; ++r) { p0[r] -= dl; p1[r] -= dl; oT[0][r] *= f; oT[1][r] *= f; }
        }
        float ls = 0.f;
#pragma unroll
        for (int r = 0; r < 16; ++r) { p0[r] = __builtin_amdgcn_exp2f(p0[r]); p1[r] = __builtin_amdgcn_exp2f(p1[r]); ls += p0[r] + p1[r]; }
        lsum += ls;
        bf16x8 pf[4]; pf[0] = pack8(p0, 0); pf[1] = pack8(p0, 8); pf[2] = pack8(p1, 0); pf[3] = pack8(p1, 8);
#pragma unroll
        for (int blk = 0; blk < 2; ++blk)
#pragma unroll
            for (int ks = 0; ks < 4; ++ks) oT[blk] = MFMA32(vf[blk * 4 + ks], pf[ks], oT[blk]);
        if (ti + 1 < ntiles) { *(u32x4*)(Ks + (buf ^ 1) * 9216 + soff) = kreg; *(u32x4*)(Vs + (buf ^ 1) * 9216 + soff) = vreg; }
        kreg = kreg2; vreg = vreg2;
        __syncthreads();
    }
    lsum += __shfl_xor(lsum, 32);
    lsum += __builtin_amdgcn_exp2f(sink2 - mref);
    const float inv = 1.0f / lsum;
    bf16_t* hrow = H + qrow * DM + head * 64;
#pragma unroll
    for (int blk = 0; blk < 2; ++blk)
#pragma unroll
        for (int g4 = 0; g4 < 4; ++g4) {
            const int d0 = 32 * blk + 8 * g4 + 4 * hi;
            const u32x2 gw = gaw[blk * 4 + g4];
            const float o0 = oT[blk][4 * g4 + 0] * inv * silu_f(bf2f(gw.x & 0xffffu)), o1 = oT[blk][4 * g4 + 1] * inv * silu_f(bf2f(gw.x >> 16));
            const float o2 = oT[blk][4 * g4 + 2] * inv * silu_f(bf2f(gw.y & 0xffffu)), o3 = oT[blk][4 * g4 + 3] * inv * silu_f(bf2f(gw.y >> 16));
            u32x2 w; w.x = pkbf(o0, o1); w.y = pkbf(o2, o3);
            *(u32x2*)(hrow + d0) = w;
        }
}

typedef short v4i16_t __attribute__((ext_vector_type(4)));
__device__ __forceinline__ v4i16_t trrd(const unsigned char* p) { return __builtin_amdgcn_ds_read_tr16_b64_v4i16((LAS v4i16_t*)p); }
__device__ __forceinline__ bf16x8 cat8(v4i16_t lo, v4i16_t hi) { return (bf16x8){lo[0], lo[1], lo[2], lo[3], hi[0], hi[1], hi[2], hi[3]}; }
__device__ __forceinline__ void fft1_unit(int u, const bf16_t* P, bf16_t* YF, const unsigned char* ws, unsigned char* lds) {
    const int tid = opaque_tid(), lane = tid & 63, wave = __builtin_amdgcn_readfirstlane(tid >> 6), r32 = lane & 31, hi = lane >> 5;
    const int b = u >> 6, n2 = u & 63;
    constexpr int UPB = 576;
    const bf16_t* src = P + (size_t)(b * SEQ + n2) * PW + C_UF;
#pragma unroll
    for (int i = 0; i < 8; ++i) {
        const int id = tid + NTHREADS * i, n1 = id >> 5, cc = id & 31;
        *(u32x4*)(lds + n1 * UPB + cc * 16) = *(const u32x4*)(src + (size_t)n1 * 64 * PW + cc * 8);
    }
    __syncthreads();
    const bf16_t* T1R = (const bf16_t*)(ws + WS_T1R); const bf16_t* T1I = (const bf16_t*)(ws + WS_T1I);
    f32x16 aR[4], aI[4];
#pragma unroll
    for (int kb = 0; kb < 4; ++kb) { aR[kb] = f32x16{}; aI[kb] = f32x16{}; }
    const unsigned char* ap = lds + (8 * hi + ((lane & 15) >> 2)) * UPB + (32 * wave + 16 * ((lane >> 4) & 1) + 4 * (lane & 3)) * 2;
#pragma unroll 2
    for (int ks = 0; ks < 8; ++ks) {
        const bf16x8 av = cat8(trrd(ap + (16 * ks) * UPB), trrd(ap + (16 * ks + 4) * UPB));
#pragma unroll
        for (int kb = 0; kb < 4; ++kb) {
            const bf16x8 bR = *(const bf16x8*)(T1R + (32 * kb + r32) * 128 + 16 * ks + 8 * hi), bI = *(const bf16x8*)(T1I + (32 * kb + r32) * 128 + 16 * ks + 8 * hi);
            aR[kb] = MFMA32(av, bR, aR[kb]); aI[kb] = MFMA32(av, bI, aI[kb]);
        }
    }
    const float* TW = (const float*)(ws + WS_TW);
#pragma unroll
    for (int kb = 0; kb < 4; ++kb) {
        const int k1 = 32 * kb + r32;
        const float ct = TW[2 * (n2 * k1)], st = TW[2 * (n2 * k1) + 1];
        bf16_t* yp = YF + ((size_t)((b * 128 + k1) * 64 + n2)) * 512 + 32 * wave + 4 * hi;
#pragma unroll
        for (int g4 = 0; g4 < 4; ++g4) {
            float yr[4], yi[4];
#pragma unroll
            for (int e = 0; e < 4; ++e) { const float r_ = aR[kb][4 * g4 + e], i_ = aI[kb][4 * g4 + e]; yr[e] = r_ * ct + i_ * st; yi[e] = i_ * ct - r_ * st; }
            u32x2 wr_, wi_; wr_.x = pkbf(yr[0], yr[1]); wr_.y = pkbf(yr[2], yr[3]); wi_.x = pkbf(yi[0], yi[1]); wi_.y = pkbf(yi[2], yi[3]);
            *(u32x2*)(yp + 8 * g4) = wr_; *(u32x2*)(yp + 256 + 8 * g4) = wi_;
        }
    }
    __syncthreads();
}

template <int KK>
__device__ __forceinline__ void dftf_unit(const bf16_t* srcbase, int R, int pitchA, int pitchB, const bf16_t* Tr, const bf16_t* Ti, const bf16_t* Gt,
                                          const bf16_t* P, bf16_t* H, size_t row0, int rowstride, float oscale, unsigned char* lds) {
    const int tid = opaque_tid(), lane = tid & 63, wave = __builtin_amdgcn_readfirstlane(tid >> 6), r32 = lane & 31, hi = lane >> 5;
    constexpr int ZPB = (KK == 128) ? 576 : 544;
#pragma unroll 1
    for (int i0 = 0; i0 < KK / 16; i0 += 8) {
        u32x4 img[8];
#pragma unroll
        for (int i = 0; i < 8; ++i) { const int id = tid + NTHREADS * (i0 + i), kk = id >> 5, cc = id & 31; img[i] = *(const u32x4*)(srcbase + (size_t)(kk % R) * pitchA + (size_t)(kk / R) * pitchB + cc * 8); }
        __builtin_amdgcn_sched_barrier(0);
#pragma unroll
        for (int i = 0; i < 8; ++i) { const int id = tid + NTHREADS * (i0 + i), kk = id >> 5, cc = id & 31; *(u32x4*)(lds + kk * ZPB + cc * 16) = img[i]; }
        __builtin_amdgcn_sched_barrier(0);
    }
    __syncthreads();
    const int g = wave >> 1, kblk = wave & 1;
    f32x16 XR[2], XI[2];
#pragma unroll
    for (int cb = 0; cb < 2; ++cb) { XR[cb] = f32x16{}; XI[cb] = f32x16{}; }
    const bf16_t* trp = Tr + (size_t)(32 * kblk + r32) * KK + 8 * hi; const bf16_t* tip = Ti + (size_t)(32 * kblk + r32) * KK + 8 * hi;
    const unsigned char* zp = lds + (8 * hi + ((lane & 15) >> 2)) * ZPB + (64 * g + 16 * ((lane >> 4) & 1) + 4 * (lane & 3)) * 2;
#pragma unroll 2
    for (int ks = 0; ks < KK / 16; ++ks) {
        const bf16x8 bR = *(const bf16x8*)(trp + 16 * ks), bI = *(const bf16x8*)(tip + 16 * ks);
#pragma unroll
        for (int cb = 0; cb < 2; ++cb) { const bf16x8 av = cat8(trrd(zp + (16 * ks) * ZPB + cb * 64), trrd(zp + (16 * ks + 4) * ZPB + cb * 64)); XR[cb] = MFMA32(av, bR, XR[cb]); XI[cb] = MFMA32(av, bI, XI[cb]); }
    }
    f32x16 oa[2]; oa[0] = f32x16{}; oa[1] = f32x16{};
    const bf16_t* gp = Gt + (size_t)(g * 64 + r32) * 128 + 8 * hi;
    u32x2 gfw[8];
    { const size_t rowg = row0 + (size_t)(32 * kblk + r32) * rowstride;
#pragma unroll
      for (int i8 = 0; i8 < 8; ++i8) gfw[i8] = *(const u32x2*)(P + rowg * PW + C_GF + 64 * g + 32 * (i8 >> 2) + 8 * (i8 & 3) + 4 * hi); }
#pragma unroll
    for (int part = 0; part < 2; ++part)
#pragma unroll
        for (int cb = 0; cb < 2; ++cb)
#pragma unroll
            for (int s = 0; s < 2; ++s) {
                const bf16x8 bx = pack8(part ? XI[cb] : XR[cb], 8 * s);
                const int kko = part * 64 + 32 * cb + 16 * s;
#pragma unroll
                for (int lb = 0; lb < 2; ++lb) { const bf16x8 ag = *(const bf16x8*)(gp + (size_t)(32 * lb) * 128 + kko); oa[lb] = MFMA32(ag, bx, oa[lb]); }
            }
    const int k2 = 32 * kblk + r32;
    const size_t row = row0 + (size_t)k2 * rowstride;
    const bf16_t* gfrow = P + row * PW + C_GF + 64 * g;
    bf16_t* hrow = H + row * DM + 512 + 64 * g;
#pragma unroll
    for (int lb = 0; lb < 2; ++lb)
#pragma unroll
        for (int g4 = 0; g4 < 4; ++g4) {
            const int l0 = 32 * lb + 8 * g4 + 4 * hi;
            const u32x2 gw = gfw[lb * 4 + g4];
            const float o0 = oa[lb][4 * g4 + 0] * oscale * silu_f(bf2f(gw.x & 0xffffu)), o1 = oa[lb][4 * g4 + 1] * oscale * silu_f(bf2f(gw.x >> 16));
            const float o2 = oa[lb][4 * g4 + 2] * oscale * silu_f(bf2f(gw.y & 0xffffu)), o3 = oa[lb][4 * g4 + 3] * oscale * silu_f(bf2f(gw.y >> 16));
            u32x2 w; w.x = pkbf(o0, o1); w.y = pkbf(o2, o3);
            *(u32x2*)(hrow + l0) = w;
        }
    __syncthreads();
}

__device__ __forceinline__ void conv_unit(int u, const bf16_t* P, bf16_t* H, const float* cw, const float* cb) {
    const int tid = opaque_tid(), cgp = tid & 31, rg = tid >> 5;
    const int ch0 = cgp * 8;
    const int r0 = u * 64 + rg * 4;
    int pos, len; if (r0 < NTOK) { pos = r0 & (SEQ - 1); len = SEQ; } else { pos = (r0 - NTOK) & (CTXL - 1); len = CTXL; }
    float w0[8], w1[8], w2[8], bs[8];
#pragma unroll
    for (int e = 0; e < 8; ++e) { w0[e] = cw[ch0 + e]; w1[e] = cw[256 + ch0 + e]; w2[e] = cw[512 + ch0 + e]; bs[e] = cb[ch0 + e]; }
    float T[6][8];
#pragma unroll
    for (int i = 0; i < 6; ++i) {
        const int p = pos - 1 + i;
        if (p >= 0 && p < len) {
            const size_t row = (size_t)(r0 - 1 + i);
            const u32x4 z = *(const u32x4*)(P + row * PW + C_ZC + ch0), c = *(const u32x4*)(P + row * PW + C_CC + ch0);
            T[i][0] = bf2f(z.x & 0xffffu) * bf2f(c.x & 0xffffu); T[i][1] = bf2f(z.x >> 16) * bf2f(c.x >> 16);
            T[i][2] = bf2f(z.y & 0xffffu) * bf2f(c.y & 0xffffu); T[i][3] = bf2f(z.y >> 16) * bf2f(c.y >> 16);
            T[i][4] = bf2f(z.z & 0xffffu) * bf2f(c.z & 0xffffu); T[i][5] = bf2f(z.z >> 16) * bf2f(c.z >> 16);
            T[i][6] = bf2f(z.w & 0xffffu) * bf2f(c.w & 0xffffu); T[i][7] = bf2f(z.w >> 16) * bf2f(c.w >> 16);
        } else {
#pragma unroll
            for (int e = 0; e < 8; ++e) T[i][e] = 0.f;
        }
    }
#pragma unroll
    for (int i = 0; i < 4; ++i) {
        const size_t row = (size_t)(r0 + i);
        const u32x4 bw = *(const u32x4*)(P + row * PW + C_BC + ch0), gw = *(const u32x4*)(P + row * PW + C_GC + ch0);
        const unsigned bwv[4] = {bw.x, bw.y, bw.z, bw.w}, gwv[4] = {gw.x, gw.y, gw.z, gw.w};
        float o[8];
#pragma unroll
        for (int e = 0; e < 8; ++e) {
            const float bv = (e & 1) ? bf2f(bwv[e >> 1] >> 16) : bf2f(bwv[e >> 1] & 0xffffu);
            const float gv = (e & 1) ? bf2f(gwv[e >> 1] >> 16) : bf2f(gwv[e >> 1] & 0xffffu);
            const float y = T[i][e] * w0[e] + T[i + 1][e] * w1[e] + T[i + 2][e] * w2[e] + bs[e];
            o[e] = bv * y * silu_f(gv);
        }
        u32x4 w; w.x = pkbf(o[0], o[1]); w.y = pkbf(o[2], o[3]); w.z = pkbf(o[4], o[5]); w.w = pkbf(o[6], o[7]);
        *(u32x4*)(H + row * DM + 768 + ch0) = w;
    }
}

__device__ __forceinline__ void fft1_wave(int task, const bf16_t* P, bf16_t* YF, const unsigned char* ws, unsigned char* lds_w, int lane, int pmode = 0) {
    const int r32 = lane & 31, hi = lane >> 5;
    const int cblk = task & 7, n2 = (task >> 3) & 63, b = task >> 9;
    const bf16_t* src = P + (size_t)((b * 64 + n2) * 128) * 256 + 32 * cblk + 8 * (lane & 3);
    { u32x4 img[8];
#pragma unroll
      for (int i = 0; i < 8; ++i) img[i] = *(const u32x4*)(src + (size_t)(16 * i + (lane >> 2)) * 256);
      __builtin_amdgcn_sched_barrier(0);
#pragma unroll
      for (int i = 0; i < 8; ++i) *(u32x4*)(lds_w + (16 * i + (lane >> 2)) * 64 + (lane & 3) * 16) = img[i];
      __builtin_amdgcn_sched_barrier(0); }
    asm volatile("s_waitcnt vmcnt(0) lgkmcnt(0)" ::: "memory");
    if (pmode == 2) return;
    const bf16_t* T1R = (const bf16_t*)(ws + WS_T1R); const bf16_t* T1I = (const bf16_t*)(ws + WS_T1I);
    f32x16 aR[4], aI[4];
#pragma unroll
    for (int kb = 0; kb < 4; ++kb) { aR[kb] = f32x16{}; aI[kb] = f32x16{}; }
    const unsigned char* ap = lds_w + (8 * hi + ((lane & 15) >> 2)) * 64 + (16 * ((lane >> 4) & 1) + 4 * (lane & 3)) * 2;
    const bf16_t* t1r = T1R + (size_t)r32 * 128 + 8 * hi; const bf16_t* t1i = T1I + (size_t)r32 * 128 + 8 * hi;
    bf16x8 bA[8], bB[8];
#define F1_LOADB(B, ks_) do { _Pragma("unroll") for (int kb = 0; kb < 4; ++kb) { B[2 * kb] = *(const bf16x8*)(t1r + (size_t)(32 * kb) * 128 + 16 * (ks_)); B[2 * kb + 1] = *(const bf16x8*)(t1i + (size_t)(32 * kb) * 128 + 16 * (ks_)); } } while (0)
#define F1_STEP(B, ks_) do { const bf16x8 av = cat8(trrd(ap + (16 * (ks_)) * 64), trrd(ap + (16 * (ks_) + 4) * 64)); \
        _Pragma("unroll") for (int kb = 0; kb < 4; ++kb) { aR[kb] = MFMA32(av, B[2 * kb], aR[kb]); aI[kb] = MFMA32(av, B[2 * kb + 1], aI[kb]); } } while (0)
    F1_LOADB(bA, 0);
#pragma unroll
    for (int k2 = 0; k2 < 4; ++k2) {
        F1_LOADB(bB, 2 * k2 + 1);
        __builtin_amdgcn_sched_barrier(0);
        F1_STEP(bA, 2 * k2);
        __builtin_amdgcn_sched_barrier(0);
        if (k2 < 3) F1_LOADB(bA, 2 * k2 + 2);
        __builtin_amdgcn_sched_barrier(0);
        F1_STEP(bB, 2 * k2 + 1);
        __builtin_amdgcn_sched_barrier(0);
    }
#undef F1_LOADB
#undef F1_STEP
    const float* TW = (const float*)(ws + WS_TW);
#pragma unroll
    for (int kb = 0; kb < 4; ++kb) {
        const int k1 = 32 * kb + r32;
        const float ct = TW[2 * (n2 * k1)], st = TW[2 * (n2 * k1) + 1];
        bf16_t* yp = YF + ((size_t)((b * 128 + k1) * 64 + n2)) * 512 + 32 * cblk + 4 * hi;
#pragma unroll
        for (int g4 = 0; g4 < 4; ++g4) {
            float yr[4], yi[4];
#pragma unroll
            for (int e = 0; e < 4; ++e) { const float r_ = aR[kb][4 * g4 + e], i_ = aI[kb][4 * g4 + e]; yr[e] = r_ * ct + i_ * st; yi[e] = i_ * ct - r_ * st; }
            u32x2 wr_, wi_; wr_.x = pkbf(yr[0], yr[1]); wr_.y = pkbf(yr[2], yr[3]); wi_.x = pkbf(yi[0], yi[1]); wi_.y = pkbf(yi[2], yi[3]);
            if (pmode != 1 || wr_.x == 0x12345678u) { *(u32x2*)(yp + 8 * g4) = wr_; *(u32x2*)(yp + 256 + 8 * g4) = wi_; }
        }
    }
    asm volatile("s_waitcnt lgkmcnt(0)" ::: "memory");
}
__device__ __forceinline__ void fft3_wave(int task, const bf16_t* YF, const bf16_t* Gt, const bf16_t* P, bf16_t* H, const unsigned char* ws, unsigned char* lds_w, int lane) {
    const int r32 = lane & 31, hi = lane >> 5;
    const int g = task & 3, k1 = (task >> 2) & 127, b = task >> 9;
    const bf16_t* src = YF + ((size_t)(b * 128 + k1) * 64) * 512 + 64 * g + 8 * (lane & 7);
    { u32x4 img[16];
#pragma unroll
      for (int i = 0; i < 16; ++i) { const int kk = 8 * i + (lane >> 3); img[i] = *(const u32x4*)(src + (size_t)(kk & 63) * 512 + (size_t)(kk >> 6) * 256); }
      __builtin_amdgcn_sched_barrier(0);
#pragma unroll
      for (int i = 0; i < 16; ++i) { const int kk = 8 * i + (lane >> 3), ch = lane & 7; *(u32x4*)(lds_w + kk * 128 + ((ch ^ (((kk >> 1) & 1) << 2)) * 16)) = img[i]; }
      __builtin_amdgcn_sched_barrier(0); }
    asm volatile("s_waitcnt vmcnt(0) lgkmcnt(0)" ::: "memory");
    const bf16_t* T3R = (const bf16_t*)(ws + WS_T3R); const bf16_t* T3I = (const bf16_t*)(ws + WS_T3I);
    const int q = (lane & 15) >> 2, sw = (q >> 1) & 1;
    const int chl = 2 * ((lane >> 4) & 1) + ((lane & 3) >> 1);
    const unsigned char* zb = lds_w + (8 * hi + q) * 128 + 8 * (lane & 1);
    const unsigned char* zp0 = zb + ((chl ^ (sw << 2)) * 16);
    const unsigned char* zp1 = zb + (((4 + chl) ^ (sw << 2)) * 16);
    const bf16_t* gp = Gt + (size_t)(g * 64 + r32) * 128 + 8 * hi;
    const size_t rowb = (size_t)(b * SEQ + k1);
#pragma unroll 1
    for (int kblk = 0; kblk < 2; ++kblk) {
        f32x16 XR[2], XI[2];
#pragma unroll
        for (int cb = 0; cb < 2; ++cb) { XR[cb] = f32x16{}; XI[cb] = f32x16{}; }
        const bf16_t* trp = T3R + (size_t)(32 * kblk + r32) * 128 + 8 * hi; const bf16_t* tip = T3I + (size_t)(32 * kblk + r32) * 128 + 8 * hi;
        const size_t rowg = rowb + (size_t)(32 * kblk + r32) * 128;
        u32x2 gfw[8];
#pragma unroll
        for (int i8 = 0; i8 < 8; ++i8) gfw[i8] = *(const u32x2*)(P + rowg * PW + C_GF + 64 * g + 32 * (i8 >> 2) + 8 * (i8 & 3) + 4 * hi);
        bf16x8 bR[8], bI[8];
#pragma unroll
        for (int ks = 0; ks < 8; ++ks) { bR[ks] = *(const bf16x8*)(trp + 16 * ks); bI[ks] = *(const bf16x8*)(tip + 16 * ks); }
        __builtin_amdgcn_sched_barrier(0);
#pragma unroll
        for (int ks = 0; ks < 8; ++ks) {
            const bf16x8 a0 = cat8(trrd(zp0 + (16 * ks) * 128), trrd(zp0 + (16 * ks + 4) * 128));
            const bf16x8 a1 = cat8(trrd(zp1 + (16 * ks) * 128), trrd(zp1 + (16 * ks + 4) * 128));
            XR[0] = MFMA32(a0, bR[ks], XR[0]); XI[0] = MFMA32(a0, bI[ks], XI[0]); XR[1] = MFMA32(a1, bR[ks], XR[1]); XI[1] = MFMA32(a1, bI[ks], XI[1]);
        }
        __builtin_amdgcn_sched_barrier(0);
        bf16x8 gfr[2][8];
#pragma unroll
        for (int lb = 0; lb < 2; ++lb)
#pragma unroll
            for (int q8 = 0; q8 < 8; ++q8) gfr[lb][q8] = *(const bf16x8*)(gp + (size_t)(32 * lb) * 128 + 16 * q8);
        __builtin_amdgcn_sched_barrier(0);
        f32x16 oa[2]; oa[0] = f32x16{}; oa[1] = f32x16{};
#pragma unroll
        for (int part = 0; part < 2; ++part)
#pragma unroll
            for (int cb = 0; cb < 2; ++cb)
#pragma unroll
                for (int s = 0; s < 2; ++s) {
                    const bf16x8 bx = pack8(part ? XI[cb] : XR[cb], 8 * s);
                    const int kko = part * 64 + 32 * cb + 16 * s;
#pragma unroll
                    for (int lb = 0; lb < 2; ++lb) oa[lb] = MFMA32(gfr[lb][kko >> 4], bx, oa[lb]);
                }
        const int k2 = 32 * kblk + r32;
        const size_t row = rowb + (size_t)k2 * 128;
        const bf16_t* gfrow = P + row * PW + C_GF + 64 * g;
        bf16_t* hrow = H + row * DM + 512 + 64 * g;
#pragma unroll
        for (int lb = 0; lb < 2; ++lb)
#pragma unroll
            for (int g4 = 0; g4 < 4; ++g4) {
                const int l0 = 32 * lb + 8 * g4 + 4 * hi;
                const u32x2 gw = gfw[lb * 4 + g4];
                const float o0 = oa[lb][4 * g4 + 0] * silu_f(bf2f(gw.x & 0xffffu)), o1 = oa[lb][4 * g4 + 1] * silu_f(bf2f(gw.x >> 16));
                const float o2 = oa[lb][4 * g4 + 2] * silu_f(bf2f(gw.y & 0xffffu)), o3 = oa[lb][4 * g4 + 3] * silu_f(bf2f(gw.y >> 16));
                u32x2 w; w.x = pkbf(o0, o1); w.y = pkbf(o2, o3);
                *(u32x2*)(hrow + l0) = w;
            }
    }
    asm volatile("s_waitcnt lgkmcnt(0)" ::: "memory");
}
__device__ __forceinline__ void conv_wave(int task, const bf16_t* P, bf16_t* H, const float* cw, const float* cb, int lane) {
    const int cgp = lane & 31, ch0 = cgp * 8;
    const int r0 = task * 8 + (lane >> 5) * 4;
    int pos, len; if (r0 < NTOK) { pos = r0 & (SEQ - 1); len = SEQ; } else { pos = (r0 - NTOK) & (CTXL - 1); len = CTXL; }
    u32x4 zz[6], cc[6], bb[4], gg[4]; float okf[6];
#pragma unroll
    for (int i = 0; i < 6; ++i) { const int p = pos - 1 + i; const bool ok = p >= 0 && p < len; okf[i] = ok ? 1.f : 0.f; const size_t row = (size_t)(ok ? r0 - 1 + i : r0);
        zz[i] = *(const u32x4*)(P + row * PW + C_ZC + ch0); cc[i] = *(const u32x4*)(P + row * PW + C_CC + ch0); }
#pragma unroll
    for (int i = 0; i < 4; ++i) { const size_t row = (size_t)(r0 + i); bb[i] = *(const u32x4*)(P + row * PW + C_BC + ch0); gg[i] = *(const u32x4*)(P + row * PW + C_GC + ch0); }
    __builtin_amdgcn_sched_barrier(0);
    float w0[8], w1[8], w2[8], bs[8];
    { const f32x4 a0 = *(const f32x4*)(cw + ch0), a1 = *(const f32x4*)(cw + ch0 + 4), b0 = *(const f32x4*)(cw + 256 + ch0), b1 = *(const f32x4*)(cw + 256 + ch0 + 4);
      const f32x4 c0 = *(const f32x4*)(cw + 512 + ch0), c1 = *(const f32x4*)(cw + 512 + ch0 + 4), d0 = *(const f32x4*)(cb + ch0), d1 = *(const f32x4*)(cb + ch0 + 4);
#pragma unroll
      for (int e = 0; e < 4; ++e) { w0[e] = a0[e]; w0[4 + e] = a1[e]; w1[e] = b0[e]; w1[4 + e] = b1[e]; w2[e] = c0[e]; w2[4 + e] = c1[e]; bs[e] = d0[e]; bs[4 + e] = d1[e]; } }
    float T[6][8];
#pragma unroll
    for (int i = 0; i < 6; ++i) {
        const unsigned zv[4] = {zz[i].x, zz[i].y, zz[i].z, zz[i].w}, cv[4] = {cc[i].x, cc[i].y, cc[i].z, cc[i].w};
#pragma unroll
        for (int e = 0; e < 8; ++e) T[i][e] = okf[i] * ((e & 1) ? bf2f(zv[e >> 1] >> 16) : bf2f(zv[e >> 1] & 0xffffu)) * ((e & 1) ? bf2f(cv[e >> 1] >> 16) : bf2f(cv[e >> 1] & 0xffffu));
    }
#pragma unroll
    for (int i = 0; i < 4; ++i) {
        const size_t row = (size_t)(r0 + i);
        const unsigned bwv[4] = {bb[i].x, bb[i].y, bb[i].z, bb[i].w}, gwv[4] = {gg[i].x, gg[i].y, gg[i].z, gg[i].w};
        float o[8];
#pragma unroll
        for (int e = 0; e < 8; ++e) {
            const float bv = (e & 1) ? bf2f(bwv[e >> 1] >> 16) : bf2f(bwv[e >> 1] & 0xffffu);
            const float gv = (e & 1) ? bf2f(gwv[e >> 1] >> 16) : bf2f(gwv[e >> 1] & 0xffffu);
            const float y = T[i][e] * w0[e] + T[i + 1][e] * w1[e] + T[i + 2][e] * w2[e] + bs[e];
            o[e] = bv * y * silu_f(gv);
        }
        u32x4 w; w.x = pkbf(o[0], o[1]); w.y = pkbf(o[2], o[3]); w.z = pkbf(o[4], o[5]); w.w = pkbf(o[6], o[7]);
        *(u32x4*)(H + row * DM + 768 + ch0) = w;
    }
}

#define XB_TMO      128
#define XB_XCNT(j)  (256  + 64 * (j))
#define XB_XSUB(j)  (1280 + 64 * (j))
#define XB_XGEN(j)  (2304 + 64 * (j))
#define XB_TOP      3328
#define XB_TOPGEN   3392
#define XCD_BAR_WORDS 3456
#define XB_SPIN_CAP (1u << 18)

__device__ __forceinline__ unsigned xb_ld(unsigned* p)              { return __hip_atomic_load(p, __ATOMIC_RELAXED, __HIP_MEMORY_SCOPE_AGENT); }
__device__ __forceinline__ unsigned xb_add(unsigned* p, unsigned v) { return __hip_atomic_fetch_add(p, v, __ATOMIC_RELAXED, __HIP_MEMORY_SCOPE_AGENT); }
__device__ __forceinline__ unsigned xb_xcc_id() { return (unsigned)__builtin_amdgcn_s_getreg((3 << 11) | 20) & 0xFu; }
#define XB_SPIN(cond, bar) do { unsigned _sp = 0; while (cond) { __builtin_amdgcn_s_sleep(1); \
    if ((++_sp & 255u) == 0u) { if (xb_ld(&(bar)[XB_TMO])) break; if (_sp > XB_SPIN_CAP) { atomicAdd(&(bar)[XB_TMO], 1u); break; } } } } while (0)

struct XcdBarrier {
    unsigned* bar; unsigned x;
    volatile LAS unsigned* st;
};

__device__ __forceinline__ XcdBarrier xcd_barrier_post(unsigned* bar, volatile LAS unsigned* st) {
    XcdBarrier b; b.bar = bar; b.x = xb_xcc_id(); b.st = st;
    if (threadIdx.x == 0) (void)xb_add(&bar[XB_XCNT(b.x)], 1u);
    return b;
}
__device__ __forceinline__ void xcd_barrier_complete(unsigned* bar, unsigned x, unsigned& nloc, unsigned& nx) {
    const unsigned G = gridDim.x * gridDim.y * gridDim.z;
    unsigned sum, cnt, mine, sp = 0u;
    for (;;) {
        sum = 0u; cnt = 0u; mine = 0u;
#pragma unroll
        for (unsigned j = 0; j < 16; ++j) { const unsigned c = xb_ld(&bar[XB_XCNT(j)]); sum += c; cnt += (c > 0u) ? 1u : 0u; mine = (j == x) ? c : mine; }
        if (sum == G) break;
        __builtin_amdgcn_s_sleep(1);
        if ((++sp & 255u) == 0u) { if (xb_ld(&bar[XB_TMO])) break; if (sp > XB_SPIN_CAP) { atomicAdd(&bar[XB_TMO], 1u); break; } }
    }
    nloc = mine > 0u ? mine : 1u; nx = cnt > 0u ? cnt : 1u;
}

__device__ __forceinline__ void xcd_barrier(const XcdBarrier& b) {
    asm volatile("s_waitcnt vmcnt(0)" ::: "memory");
    __syncthreads();
    if (threadIdx.x == 0) {
        unsigned* bar = b.bar;
        __builtin_amdgcn_s_waitcnt(0);
        unsigned nloc = b.st[0], nx = b.st[1];
        if (nloc == 0u) { xcd_barrier_complete(bar, b.x, nloc, nx); b.st[0] = nloc; b.st[1] = nx; }
        const unsigned old = xb_add(&bar[XB_XSUB(b.x)], 1u);
        const unsigned gen = old / nloc;
        if (old + 1u == (gen + 1u) * nloc) {
            __builtin_amdgcn_fence(__ATOMIC_RELEASE, "agent");
            asm volatile("s_waitcnt vmcnt(0)" ::: "memory");
            const unsigned og = xb_add(&bar[XB_TOP], 1u);
            const unsigned tg = og / nx;
            if (og + 1u == (tg + 1u) * nx) xb_add(&bar[XB_TOPGEN], 1u);
            else XB_SPIN(xb_ld(&bar[XB_TOPGEN]) == tg, bar);
            __builtin_amdgcn_fence(__ATOMIC_ACQUIRE, "agent");
            xb_add(&bar[XB_XGEN(b.x)], 1u);
            asm volatile("s_waitcnt vmcnt(0)" ::: "memory");
        } else {
            XB_SPIN(xb_ld(&bar[XB_XGEN(b.x)]) == gen, bar);
            __builtin_amdgcn_fence(__ATOMIC_ACQUIRE, "agent");
            asm volatile("s_waitcnt vmcnt(0)" ::: "memory");
        }
    }
    __syncthreads();
}

__device__ __forceinline__ int next_unit(unsigned* ctr, unsigned char* lds) {
    volatile int* sw = (volatile int*)(lds + LDS_SCHED);
    if (threadIdx.x == 0) *sw = (int)atomicAdd(ctr, 1u);
    __syncthreads();
    const int u = *sw;
    __syncthreads();
    return u;
}

__global__ void __launch_bounds__(NTHREADS, 2) hybrid_fwd(KArgs a) {
    extern __shared__ __attribute__((aligned(16))) unsigned char lds[];
    cg::grid_group grid = cg::this_grid();
    unsigned char* ws = a.ws;
    const int lo = a.ph_lo, hi = a.ph_hi;
#ifndef PHMASK
#define PHMASK 0xfff
#endif
#define IN(k) (((PHMASK >> ((k) > 5 && (k) < 11 ? (k) - 5 : (k))) & 1) && lo <= (k) && (k) < hi)
#define SEAM(k) do { if (IN(k) && IN((k) + 1)) xcd_barrier(xbar); } while (0)
#ifndef REP_PHASE
#define REP_PHASE -1
#endif
#define REPS(j) for (int rep = 0, nrep = (REP_PHASE == (j)) ? 2 : 1; rep < nrep; ++rep, (rep < nrep ? xcd_barrier(xbar) : (void)0))
    bf16_t* HX = (bf16_t*)(ws + WS_HX); bf16_t* Pb = (bf16_t*)(ws + WS_P); bf16_t* Vt = (bf16_t*)(ws + WS_VT); bf16_t* Hb = (bf16_t*)(ws + WS_H);
    bf16_t* Yb = (bf16_t*)(ws + WS_Y); bf16_t* YF = (bf16_t*)(ws + WS_YF); float* SSQ = (float*)(ws + WS_SSQ);
    unsigned* ctl = (unsigned*)(ws + WS_CTL);

    if (threadIdx.x < 2) ((volatile LAS unsigned*)(lds + LDS_BARST))[threadIdx.x] = 0u;
    __syncthreads();
    const XcdBarrier xbar = xcd_barrier_post((unsigned*)(ws + WS_BAR), (volatile LAS unsigned*)(lds + LDS_BARST));
    if (a.ph_lo < 0) grid.sync();
    REPS(30) if (IN(0)) p0_prologue(a, lds);
    SEAM(0);
    for (int l = 0; l < 2; ++l) {
        const int pb = 1 + 5 * l;
        REPS(0) if (IN(pb)) norm_phase(a, l);
        SEAM(pb);
        REPS(1) if (IN(pb + 1)) {
            pg8::Gemm g{HX, (const bf16_t*)(ws + WS_WIN) + (size_t)l * PW * DM, MROWS, PW, DM};
            pg8::StaticOrder S; S.init(MROWS, PW, (int)gridDim.x, (int)blockIdx.x);
            pg8::EpiProj E{Pb, Vt, (const float*)(ws + WS_ROPE), (bf16_t*)(ws + WS_UFP), 0.125f * LOG2E};
            pg8::gemm_phase<pg8::EpiProj, pg8::StaticOrder, true, true>((PG8_LAS unsigned char*)lds, g, S, E);
        }
        SEAM(pb + 1);
        for (int rep = 0, nrep = (REP_PHASE >= 20 && REP_PHASE < 30) ? 2 : 1; rep < nrep; ++rep, (rep < nrep ? xcd_barrier(xbar) : (void)0)) if (IN(pb + 2)) {
            const int nAttn = (l == 0) ? 1056 : 1024, nCtxF = (l == 0) ? 16 : 0, nF1 = 256, nConv = ((l == 0) ? MROWS : NTOK) / 64;
            const int e0 = nF1, e1 = e0 + nCtxF, e2 = e1 + nAttn, e3 = e2 + nConv;
            for (;;) {
                const int u = next_unit(ctl + 2 * l + 8 * rep, lds);
                if (u >= e3) break;
                if (rep == 1) { const int ty = u < e0 ? 1 : u < e1 ? 3 : u < e2 ? 0 : 2; if (REP_PHASE == 25 ? (ty == 0) : (ty != REP_PHASE - 20)) continue; }
                if (u >= e1 && u < e2) attn_unit(u - e1, Pb, Vt, Hb, a.sink + 8 * l, lds);
                else if (u >= e0 && u < e1) { const int v = u - e0, b = v >> 2, kb = v & 3;
                    dftf_unit<256>(Pb + (size_t)(NTOK + b * CTXL) * PW + C_UF, 256, PW, 0, (const bf16_t*)(ws + WS_T256R) + (size_t)(64 * kb) * 256, (const bf16_t*)(ws + WS_T256I) + (size_t)(64 * kb) * 256,
                                   (const bf16_t*)(ws + WS_GT) + (size_t)l * 4 * 64 * 128, Pb, Hb, (size_t)(NTOK + b * CTXL + 64 * kb), 1, 5.656854249492381f, lds); }
                else {
                    const int tid = opaque_tid(), lane = tid & 63, wave = __builtin_amdgcn_readfirstlane(tid >> 6);
                    if (u < e0) fft1_wave(u * 8 + wave, (const bf16_t*)(ws + WS_UFP), YF, ws, lds + wave * 16384, lane);
                    else conv_wave((u - e2) * 8 + wave, Pb, Hb, a.conv_w + l * 768, a.conv_b + l * 256, lane);
                }
            }
        }
        SEAM(pb + 2);
        REPS(3) if (IN(pb + 3)) {
            const bool gemmwg = (l == 0 && blockIdx.x < 16);
            if (gemmwg) {
                pg8::Gemm g{Hb + (size_t)NTOK * DM, (const bf16_t*)(ws + WS_WOUT) + (size_t)l * DM * DM, NCTX, DM, DM};
                pg8::StaticOrder S; S.init(NCTX, DM, 16, (int)blockIdx.x);
                pg8::EpiY E{Yb + (size_t)NTOK * DM, SSQ + (size_t)NTOK * 16};
                pg8::gemm_phase<pg8::EpiY, pg8::StaticOrder, true, true>((PG8_LAS unsigned char*)lds, g, S, E);
            } else {
                const int tid = opaque_tid(), lane = tid & 63, wave = __builtin_amdgcn_readfirstlane(tid >> 6);
                const int nb0 = (l == 0) ? 16 : 0;
                const int gw = ((int)blockIdx.x - nb0) + wave * ((int)gridDim.x - nb0), NGW = ((int)gridDim.x - nb0) * 8;
                unsigned char* lds_w = lds + wave * 16384;
                for (int t = gw; t < 2048; t += NGW) fft3_wave(t, YF, (const bf16_t*)(ws + WS_GT) + (size_t)l * 4 * 64 * 128, Pb, Hb, ws, lds_w, lane);
            }
            __syncthreads();
        }
        SEAM(pb + 3);
        REPS(4) if (IN(pb + 4)) {
            pg8::Gemm g{Hb, (const bf16_t*)(ws + WS_WOUT) + (size_t)l * DM * DM, NTOK, DM, DM};
            pg8::StaticOrder S; S.init(NTOK, DM, (int)gridDim.x, (int)blockIdx.x);
            pg8::EpiY E{l == 0 ? Yb : HX, l == 0 ? SSQ : (float*)(ws + WS_SSQ1)};
            pg8::gemm_phase<pg8::EpiY, pg8::StaticOrder, true, true>((PG8_LAS unsigned char*)lds, g, S, E);
        }
        SEAM(pb + 4);
    }
#if REP_PHASE == 9
    for (int i = 0; i < 10; ++i) xcd_barrier(xbar);
#endif
    if (IN(11)) norm_phase(a, 2);
#undef IN
#undef SEAM
}

#ifndef MK_MULTI
#define MK_MULTI 0
#endif
extern "C" void kernel_launch(void* const* d_in, const int* in_sizes, int n_in, void* d_out, int out_size, void* d_ws, size_t ws_size, hipStream_t stream) {
    static int grid = 0;
    if (grid == 0) {
        if (n_in != 14 || ws_size < WS_END) { fprintf(stderr, "kernel_launch: unexpected n_in %d or ws_size %zu (need %zu)\n", n_in, ws_size, (size_t)WS_END); grid = -1; return; }
        int dev = 0, cus = 0, per_cu = 0;
        hipGetDevice(&dev); hipDeviceGetAttribute(&cus, hipDeviceAttributeMultiprocessorCount, dev);
        if (hipFuncSetAttribute((const void*)hybrid_fwd, hipFuncAttributeMaxDynamicSharedMemorySize, LDS_BYTES) != hipSuccess) { fprintf(stderr, "kernel_launch: hipFuncSetAttribute failed\n"); grid = -1; return; }
        if (hipOccupancyMaxActiveBlocksPerMultiprocessor(&per_cu, (const void*)hybrid_fwd, NTHREADS, LDS_BYTES) != hipSuccess || per_cu < 1) { fprintf(stderr, "kernel_launch: occupancy query gave %d\n", per_cu); per_cu = 1; }
        (void)hipGetLastError();
        grid = cus * 1;
        fprintf(stderr, "kernel_launch: grid %d (cus %d, per_cu %d)\n", grid, cus, per_cu);
    }
    if (grid < 0) return;
    if (hipMemsetAsync((char*)d_ws + WS_CTL, 0, WS_ZERO_BYTES, stream) != hipSuccess) { fprintf(stderr, "kernel_launch: hipMemsetAsync failed\n"); return; }
    KArgs a{};
    a.x = (const float*)d_in[0]; a.c = (const float*)d_in[1]; a.ctx = (const float*)d_in[2]; a.c_ctx = (const float*)d_in[3]; a.w_mod = (const float*)d_in[4]; a.b_mod = (const float*)d_in[5];
    a.g_pre = (const float*)d_in[6]; a.g_post = (const float*)d_in[7]; a.w_in = (const float*)d_in[8]; a.w_out = (const float*)d_in[9]; a.sink = (const float*)d_in[10]; a.w_f = (const float*)d_in[11];
    a.conv_w = (const float*)d_in[12]; a.conv_b = (const float*)d_in[13];
    a.out = (float*)d_out; a.ws = (unsigned char*)d_ws;
#if MK_MULTI
    for (int ph = 0; ph < 12; ++ph) { a.ph_lo = ph; a.ph_hi = ph + 1; hipLaunchKernelGGL(hybrid_fwd, dim3(grid), dim3(NTHREADS), LDS_BYTES, stream, a); }
#else
    a.ph_lo = 0; a.ph_hi = 12;
    void* args[] = {&a};
    hipError_t e = hipLaunchCooperativeKernel((const void*)hybrid_fwd, dim3(grid), dim3(NTHREADS), args, LDS_BYTES, stream);
    if (e != hipSuccess) fprintf(stderr, "kernel_launch: cooperative launch failed: %s (grid %d)\n", hipGetErrorString(e), grid);
#endif
}
```

```cpp
#include <hip/hip_runtime.h>
#include <hip/hip_cooperative_groups.h>
#include <cstdio>
#include <cstdint>
namespace cg = cooperative_groups;
namespace pg8 {
#define PG8_LAS __attribute__((address_space(3)))
typedef unsigned short bf16_t;
typedef short bf16x8 __attribute__((ext_vector_type(8)));
typedef float f32x4 __attribute__((ext_vector_type(4)));
typedef unsigned u32x4 __attribute__((ext_vector_type(4)));
constexpr int BM = 256, BK = 64, HALF = 128, HTB = HALF * BK * 2  , STAGE_BYTES = 8 * HTB, NXCD = 8, WGM = 8;

__host__ __device__ __forceinline__ int lds_byte(int r, int c) { const int st = (r >> 4) * 2 + (c >> 5), rr = r & 15, cc = c & 31, ob = rr * 64 + cc * 2; return st * 1024 + (ob ^ (((ob >> 9) & 1) << 5)); }
__host__ __device__ __forceinline__ void stage_rc(int b, int& R, int& C) { const int st = b / 1024, sb = b % 1024, swz = sb ^ (((sb >> 9) & 1) << 5); R = (st >> 1) * 16 + swz / 64; C = (st & 1) * 32 + (swz % 64) / 2; }
__host__ __device__ __forceinline__ int perm32(int rho) { const int n = rho >> 4, i = rho & 15; return 8 * (i >> 2) + 4 * n + (i & 3); }

struct Unit { int pm, pn; };
struct Gemm { const bf16_t* A; const bf16_t* Bt; int M, N, K; };

struct StaticOrder {
    int nM, nN, nwg, G, c;
    __host__ __device__ void init(int M, int N, int G_, int c_) { nM = M / BM; nN = N / BM; nwg = nM * nN; G = G_; c = c_; }
    __host__ __device__ bool next(int i, Unit& u) const {
        const long L = (long)i * G + c; if (L >= nwg) return false;
        int wgid = (int)L; { const int q = nwg / NXCD, r = nwg % NXCD, xcd = wgid % NXCD, off = wgid / NXCD; wgid = (xcd < r ? xcd * (q + 1) : r * (q + 1) + (xcd - r) * q) + off; }
        const int nig = WGM * nN, gid = wgid / nig, fm = gid * WGM, gsz = (nM - fm) < WGM ? (nM - fm) : WGM;
        u.pm = fm + ((wgid % nig) % gsz); u.pn = (wgid % nig) / gsz; return true;
    }
    __device__ __forceinline__ void a_ready(const Unit&) const {}
    __device__ __forceinline__ void done(const Unit&) const {}
};

__device__ __forceinline__ unsigned cvt_pk_bf16(float lo, float hi) { unsigned r; asm volatile("v_cvt_pk_bf16_f32 %0, %1, %2" : "=v"(r) : "v"(lo), "v"(hi)); return r; }
typedef unsigned u32x2 __attribute__((ext_vector_type(2)));
__device__ __forceinline__ int swap23(int t) { return (t & ~12) | ((t & 4) << 1) | ((t & 8) >> 1); }
struct EpiProj {
    static constexpr bool PERM = true, AFTER_DRAIN = false;
    bf16_t* P; bf16_t* Vt; const float* rope; bf16_t* UFP; float qscale;
    __device__ __forceinline__ void operator()(const f32x4 (&acc)[2][2][4][2], const Unit& u, int wr, int wc, int fr, int fq) const {
        const int row0 = u.pm * BM + wr * 64 + fr;
        const int pn = u.pn;
        const bool ctxrow = u.pm >= 128;
        f32x4 CS[2][4], SN[2][4];
        if (pn <= 2) {
#pragma unroll
            for (int ai = 0; ai < 2; ++ai)
#pragma unroll
                for (int m = 0; m < 4; ++m) {
                    CS[ai][m] = (f32x4){1.f, 1.f, 1.f, 1.f}; SN[ai][m] = (f32x4){0.f, 0.f, 0.f, 0.f};
                    if (!ctxrow) { const int t = (row0 + ai * HALF + m * 16) & 8191; const int pos = (wc & 1) ? (t & 63) : (t >> 6);
                        CS[ai][m] = *(const f32x4*)(rope + pos * 32 + 4 * fq); SN[ai][m] = *(const f32x4*)(rope + pos * 32 + 16 + 4 * fq); }
                }
            __builtin_amdgcn_sched_barrier(0);
        }
#pragma unroll
        for (int ai = 0; ai < 2; ++ai)
#pragma unroll
            for (int m = 0; m < 4; ++m) {
                const int row = row0 + ai * HALF + m * 16;
                bf16_t* rowp = P + (size_t)row * 2816 + pn * BM + wc * 32 + 8 * fq;
                if (pn == 5 && !ctxrow) { const int t = row & 8191; rowp = UFP + ((size_t)(((row >> 13) * 64 + (t & 63)) * 128 + (t >> 6))) * 256 + wc * 32 + 8 * fq; }
                if (pn > 2) {
#pragma unroll
                    for (int bj = 0; bj < 2; ++bj) { const f32x4 v0 = acc[ai][bj][m][0], v1 = acc[ai][bj][m][1];
                        u32x4 w; w.x = cvt_pk_bf16(v0[0], v0[1]); w.y = cvt_pk_bf16(v0[2], v0[3]); w.z = cvt_pk_bf16(v1[0], v1[1]); w.w = cvt_pk_bf16(v1[2], v1[3]);
                        *(u32x4*)(rowp + bj * HALF) = w; }
                } else {
                    const f32x4 cs = CS[ai][m], sn = SN[ai][m];
#pragma unroll
                    for (int bj = 0; bj < 2; ++bj) {
                        f32x4 v0 = acc[ai][bj][m][0], v1 = acc[ai][bj][m][1];
                        if (pn == 2 && bj == 1) {
                            int b, tok; if (ctxrow) { const int rr = row - 32768; b = rr >> 8; tok = 8192 + (rr & 255); } else { b = row >> 13; tok = row & 8191; }
                            const int ptok = swap23(tok);
                            bf16_t* vp = Vt + ((size_t)((b * 2 + (wc >> 1)) * 64 + 32 * (wc & 1) + 8 * fq)) * 8448 + ptok;
                            const unsigned w0 = cvt_pk_bf16(v0[0], v0[1]), w1 = cvt_pk_bf16(v0[2], v0[3]), w2 = cvt_pk_bf16(v1[0], v1[1]), w3 = cvt_pk_bf16(v1[2], v1[3]);
                            vp[0 * 8448] = (bf16_t)(w0 & 0xffffu); vp[1 * 8448] = (bf16_t)(w0 >> 16); vp[2 * 8448] = (bf16_t)(w1 & 0xffffu); vp[3 * 8448] = (bf16_t)(w1 >> 16);
                            vp[4 * 8448] = (bf16_t)(w2 & 0xffffu); vp[5 * 8448] = (bf16_t)(w2 >> 16); vp[6 * 8448] = (bf16_t)(w3 & 0xffffu); vp[7 * 8448] = (bf16_t)(w3 >> 16);
                        } else {
                            const f32x4 r0 = v0 * cs - v1 * sn, r1 = v0 * sn + v1 * cs;
                            v0 = r0; v1 = r1;
                            if (pn < 2) { v0 = v0 * qscale; v1 = v1 * qscale; }
                            u32x4 w; w.x = cvt_pk_bf16(v0[0], v0[1]); w.y = cvt_pk_bf16(v0[2], v0[3]); w.z = cvt_pk_bf16(v1[0], v1[1]); w.w = cvt_pk_bf16(v1[2], v1[3]);
                            *(u32x4*)(rowp + bj * HALF) = w;
                        }
                    }
                }
            }
    }
};
struct EpiY {
    static constexpr bool PERM = true, AFTER_DRAIN = false;
    bf16_t* Y; float* ssq;
    __device__ __forceinline__ void operator()(const f32x4 (&acc)[2][2][4][2], const Unit& u, int wr, int wc, int fr, int fq) const {
        const int row0 = u.pm * BM + wr * 64 + fr;
#pragma unroll
        for (int ai = 0; ai < 2; ++ai)
#pragma unroll
            for (int m = 0; m < 4; ++m) {
                const int row = row0 + ai * HALF + m * 16;
                bf16_t* rowp = Y + (size_t)row * 1024 + u.pn * BM + wc * 32 + 8 * fq;
                float s = 0.f;
#pragma unroll
                for (int bj = 0; bj < 2; ++bj) { const f32x4 v0 = acc[ai][bj][m][0], v1 = acc[ai][bj][m][1];
                    s += (v0[0] * v0[0] + v0[1] * v0[1]) + (v0[2] * v0[2] + v0[3] * v0[3]) + (v1[0] * v1[0] + v1[1] * v1[1]) + (v1[2] * v1[2] + v1[3] * v1[3]);
                    u32x4 w; w.x = cvt_pk_bf16(v0[0], v0[1]); w.y = cvt_pk_bf16(v0[2], v0[3]); w.z = cvt_pk_bf16(v1[0], v1[1]); w.w = cvt_pk_bf16(v1[2], v1[3]);
                    *(u32x4*)(rowp + bj * HALF) = w; }
                s += __shfl_xor(s, 16); s += __shfl_xor(s, 32);
                if (fq == 0) ssq[(size_t)row * 16 + u.pn * 4 + wc] = s;
            }
    }
};
template <class Epi, class Sched, bool ALIGN_EPI = false, bool SP2 = false>
__device__ __forceinline__ void gemm_phase(PG8_LAS unsigned char* lds, const Gemm g, const Sched& S, const Epi& E) {
    int tid_ = threadIdx.x; asm volatile("" : "+v"(tid_));
    const int tid = tid_, wid = __builtin_amdgcn_readfirstlane(tid >> 6), lane = tid & 63, wr = wid >> 2, wc = wid & 3, fr = lane & 15, fq = lane >> 4;
    const int K = g.K, nt = K / BK;
    unsigned voffA[2], voffB[2];
#pragma unroll
    for (int i = 0; i < 2; ++i) { int R, C; stage_rc(tid * 16 + i * 8192, R, C); const int Rb = Epi::PERM ? ((R & ~31) + perm32(R & 31)) : R;
        voffA[i] = (unsigned)(R * K + C) * 2u; voffB[i] = (unsigned)(Rb * K + C) * 2u; }
    const size_t kstep = (size_t)(BK * 2);
    const size_t hstep = (size_t)HALF * K * 2;
    const size_t tstep = 2 * hstep;
    const unsigned ldsw = (unsigned)wid * 1024u;
    const int aoff = lds_byte(wr * 64 + fr, fq * 8), boff = lds_byte(wc * 32 + fr, fq * 8);
#define PG8_SA(b, h) (((b) * 2 + (h)) * HTB)
#define PG8_SB(b, h) ((4 + (b) * 2 + (h)) * HTB)
#define PG8_STAGE(bufoff, gbase, voff) do { _Pragma("unroll") for (int _i = 0; _i < 2; ++_i) \
        __builtin_amdgcn_global_load_lds((const unsigned*)((const char*)(gbase) + (voff)[_i]), (PG8_LAS unsigned*)(lds + (bufoff) + ldsw + _i * 8192), 16, 0, 0); } while (0)
#define PG8_LDA(dst, b, h) do { _Pragma("unroll") for (int m = 0; m < 4; ++m) _Pragma("unroll") for (int k = 0; k < 2; ++k) dst[m][k] = *(const PG8_LAS bf16x8*)(lds + PG8_SA(b, h) + aoff + m * 2048 + k * 1024); } while (0)
#define PG8_LDB(dst, b, h) do { _Pragma("unroll") for (int n = 0; n < 2; ++n) _Pragma("unroll") for (int k = 0; k < 2; ++k) dst[n][k] = *(const PG8_LAS bf16x8*)(lds + PG8_SB(b, h) + boff + n * 2048 + k * 1024); } while (0)
#define PG8_MMA(ai, bj, At, Bt) do { __builtin_amdgcn_s_setprio(1); _Pragma("unroll") for (int m = 0; m < 4; ++m) _Pragma("unroll") for (int n = 0; n < 2; ++n) _Pragma("unroll") for (int k = 0; k < 2; ++k) \
        acc[ai][bj][m][n] = __builtin_amdgcn_mfma_f32_16x16x32_bf16(Bt[n][k], At[m][k], acc[ai][bj][m][n], 0, 0, 0); __builtin_amdgcn_s_setprio(0); } while (0)
#define PG8_WAIT_V(n) asm volatile("s_waitcnt vmcnt(" #n ")" ::: "memory")
#define PG8_WAIT_L(n) asm volatile("s_waitcnt lgkmcnt(" #n ")" ::: "memory")
#define PG8_BAR __builtin_amdgcn_s_barrier()
#define PG8_SCHED __builtin_amdgcn_sched_barrier(0)
    Unit cur, nxt; int ui = 0;
    if (!S.next(0, cur)) return;
    f32x4 acc[2][2][4][2];
#pragma unroll
    for (int a = 0; a < 2; ++a)
#pragma unroll
        for (int b = 0; b < 2; ++b)
#pragma unroll
            for (int m = 0; m < 4; ++m)
#pragma unroll
                for (int n = 0; n < 2; ++n) acc[a][b][m][n] = (f32x4){0.f, 0.f, 0.f, 0.f};
    bf16x8 At[4][2], B0[2][2], B1[2][2];
    const char* cA = (const char*)g.A + (size_t)cur.pm * tstep; const char* cB = (const char*)g.Bt + (size_t)cur.pn * tstep;
    S.a_ready(cur);
    if constexpr (SP2) {
        PG8_STAGE(PG8_SB(0, 0), cB, voffB); PG8_STAGE(PG8_SB(0, 1), cB + hstep, voffB); PG8_STAGE(PG8_SA(0, 0), cA, voffA); PG8_STAGE(PG8_SA(0, 1), cA + hstep, voffA);
        if (wr == 1) PG8_BAR;
        PG8_WAIT_V(2); PG8_BAR;
        PG8_STAGE(PG8_SB(1, 0), cB + kstep, voffB); PG8_STAGE(PG8_SA(1, 0), cA + kstep, voffA); PG8_STAGE(PG8_SB(1, 1), cB + hstep + kstep, voffB);
        PG8_WAIT_V(6); PG8_BAR;
    } else {
        PG8_STAGE(PG8_SB(0, 0), cB, voffB); PG8_STAGE(PG8_SA(0, 0), cA, voffA); PG8_STAGE(PG8_SB(0, 1), cB + hstep, voffB); PG8_STAGE(PG8_SA(0, 1), cA + hstep, voffA);
        if (wr == 1) PG8_BAR;
        PG8_WAIT_V(4); PG8_BAR;
        PG8_STAGE(PG8_SB(1, 0), cB + kstep, voffB); PG8_STAGE(PG8_SA(1, 0), cA + kstep, voffA); PG8_STAGE(PG8_SB(1, 1), cB + hstep + kstep, voffB);
        PG8_WAIT_V(6); PG8_BAR;
    }
    for (;;) {
        const bool has_next = S.next(ui + 1, nxt);
        const char* nA = has_next ? (const char*)g.A + (size_t)nxt.pm * tstep : cA; const char* nB = has_next ? (const char*)g.Bt + (size_t)nxt.pn * tstep : cB;
        for (int t = 0; t < nt; t += 2) {
            const bool last = (t == nt - 2);
            const char* a1 = cA + (size_t)(t + 1) * kstep;
            const char* a2 = last ? nA : cA + (size_t)(t + 2) * kstep; const char* b2 = last ? nB : cB + (size_t)(t + 2) * kstep;
            const char* a3 = a2 + kstep; const char* b3 = b2 + kstep;
            if (last && has_next) S.a_ready(nxt);
            if constexpr (SP2) {
            PG8_LDB(B0, 0, 0); PG8_LDB(B1, 0, 1); PG8_SCHED; PG8_LDA(At, 0, 0); PG8_STAGE(PG8_SA(1, 1), a1 + hstep, voffA);
            PG8_WAIT_V(8); PG8_WAIT_L(0); PG8_BAR; PG8_MMA(0, 0, At, B0); PG8_MMA(0, 1, At, B1); PG8_BAR; PG8_SCHED;
            PG8_LDA(At, 0, 1); PG8_STAGE(PG8_SB(0, 0), b2, voffB); PG8_STAGE(PG8_SB(0, 1), b2 + hstep, voffB); PG8_STAGE(PG8_SA(0, 0), a2, voffA);
            PG8_WAIT_V(8); PG8_WAIT_L(0); PG8_BAR; PG8_MMA(1, 0, At, B0); PG8_MMA(1, 1, At, B1); PG8_BAR; PG8_SCHED;
            PG8_LDB(B0, 1, 0); PG8_LDB(B1, 1, 1); PG8_SCHED; PG8_LDA(At, 1, 0); PG8_STAGE(PG8_SA(0, 1), a2 + hstep, voffA);
            PG8_WAIT_V(8); PG8_WAIT_L(0); PG8_BAR; PG8_MMA(0, 0, At, B0); PG8_MMA(0, 1, At, B1); PG8_BAR; PG8_SCHED;
            PG8_LDA(At, 1, 1); PG8_STAGE(PG8_SB(1, 0), b3, voffB); PG8_STAGE(PG8_SB(1, 1), b3 + hstep, voffB); PG8_STAGE(PG8_SA(1, 0), a3, voffA);
            PG8_WAIT_V(8); PG8_WAIT_L(0); PG8_BAR; PG8_MMA(1, 0, At, B0); PG8_MMA(1, 1, At, B1); PG8_BAR; PG8_SCHED;
            } else {
            PG8_LDB(B0, 0, 0); PG8_SCHED; PG8_LDA(At, 0, 0); PG8_STAGE(PG8_SA(1, 1), a1 + hstep, voffA);
            PG8_WAIT_L(8); PG8_BAR; PG8_WAIT_L(0); PG8_MMA(0, 0, At, B0); PG8_BAR; PG8_SCHED;
            PG8_LDB(B1, 0, 1); PG8_STAGE(PG8_SB(0, 0), b2, voffB);
            PG8_BAR; PG8_WAIT_L(0); PG8_MMA(0, 1, At, B1); PG8_BAR;
            PG8_LDA(At, 0, 1); PG8_STAGE(PG8_SA(0, 0), a2, voffA);
            PG8_BAR; PG8_WAIT_L(0); PG8_MMA(1, 0, At, B0); PG8_BAR; PG8_SCHED;
            PG8_STAGE(PG8_SB(0, 1), b2 + hstep, voffB);
            PG8_WAIT_V(6); PG8_BAR; PG8_MMA(1, 1, At, B1); PG8_BAR;
            PG8_LDB(B0, 1, 0); PG8_SCHED; PG8_LDA(At, 1, 0); PG8_STAGE(PG8_SA(0, 1), a2 + hstep, voffA);
            PG8_WAIT_L(8); PG8_BAR; PG8_WAIT_L(0); PG8_MMA(0, 0, At, B0); PG8_BAR; PG8_SCHED;
            PG8_LDB(B1, 1, 1); PG8_STAGE(PG8_SB(1, 0), b3, voffB);
            PG8_BAR; PG8_WAIT_L(0); PG8_MMA(0, 1, At, B1); PG8_BAR;
            PG8_LDA(At, 1, 1); PG8_STAGE(PG8_SA(1, 0), a3, voffA);
            PG8_BAR; PG8_WAIT_L(0); PG8_MMA(1, 0, At, B0); PG8_BAR; PG8_SCHED;
            PG8_STAGE(PG8_SB(1, 1), b3 + hstep, voffB);
            PG8_WAIT_V(6); PG8_BAR; PG8_MMA(1, 1, At, B1); PG8_BAR;
            }
        }
        if constexpr (ALIGN_EPI) { if (wr == 0) PG8_BAR; }
        if constexpr (!Epi::AFTER_DRAIN) { E(acc, cur, wr, wc, fr, fq); S.done(cur); }
        if (!has_next) break;
#pragma unroll
        for (int a = 0; a < 2; ++a)
#pragma unroll
            for (int b = 0; b < 2; ++b)
#pragma unroll
                for (int m = 0; m < 4; ++m)
#pragma unroll
                    for (int n = 0; n < 2; ++n) acc[a][b][m][n] = (f32x4){0.f, 0.f, 0.f, 0.f};
        cur = nxt; cA = nA; cB = nB; ++ui;
        if constexpr (ALIGN_EPI) { if (wr == 1) PG8_BAR; }
    }
    PG8_WAIT_V(0);
    if constexpr (!ALIGN_EPI) { if (wr == 0) PG8_BAR; }
    PG8_BAR;
    if constexpr (Epi::AFTER_DRAIN) { E.fused(acc, cur, wr, wc, fr, fq, lds, wid, lane); S.done(cur); }
#undef PG8_SA
#undef PG8_SB
#undef PG8_STAGE
#undef PG8_LDA
#undef PG8_LDB
#undef PG8_MMA
#undef PG8_WAIT_V
#undef PG8_WAIT_L
#undef PG8_BAR
#undef PG8_SCHED
}
}

typedef unsigned short bf16_t;
typedef short bf16x8 __attribute__((ext_vector_type(8)));
typedef float f32x4 __attribute__((ext_vector_type(4)));
typedef float f32x16 __attribute__((ext_vector_type(16)));
typedef unsigned u32x4 __attribute__((ext_vector_type(4)));
typedef unsigned u32x2 __attribute__((ext_vector_type(2)));
#define LAS __attribute__((address_space(3)))
__device__ __forceinline__ int opaque_tid() { int t = threadIdx.x; asm volatile("" : "+v"(t)); return t; }

constexpr int DM = 1024, NBATCH = 4, SEQ = 8192, NTOK = NBATCH * SEQ, CTXL = 256, NCTX = NBATCH * CTXL, MROWS = NTOK + NCTX;
constexpr int PW = 2816;
constexpr int C_Q = 0, C_K = 512, C_V = 640, C_GA = 768, C_UF = 1280, C_GF = 1536, C_ZC = 1792, C_BC = 2048, C_CC = 2304, C_GC = 2560;
constexpr int VT_PITCH = SEQ + CTXL;
constexpr float NORM_EPS = 1e-6f;
constexpr float LOG2E = 1.4426950408889634f;

constexpr size_t KiB = 1024, MiB = 1u << 20;
constexpr size_t WS_CTL = 0;
constexpr size_t WS_BAR = 16 * KiB;
constexpr size_t WS_ZERO_BYTES = 32 * KiB;
constexpr size_t WS_MOD = 64 * KiB;
constexpr size_t WS_ROPE = 256 * KiB;
constexpr size_t WS_TW = 320 * KiB;
constexpr size_t WS_T1R = 384 * KiB, WS_T1I = 416 * KiB;
constexpr size_t WS_T3R = 448 * KiB, WS_T3I = 464 * KiB;
constexpr size_t WS_T256R = 512 * KiB, WS_T256I = 640 * KiB;
constexpr size_t WS_GT = 768 * KiB;
constexpr size_t WS_SSQ = 1 * MiB;
constexpr size_t WS_WIN = 4 * MiB;
constexpr size_t WS_WOUT = 16 * MiB;
constexpr size_t WS_SSQ1 = 24 * MiB;
constexpr size_t WS_MODP = 28 * MiB;
constexpr size_t WS_HX = 32 * MiB;
constexpr size_t WS_P = 112 * MiB;
constexpr size_t WS_VT = 304 * MiB;
constexpr size_t WS_H = 320 * MiB;
constexpr size_t WS_Y = 392 * MiB;
constexpr size_t WS_YF = 464 * MiB;
constexpr size_t WS_CTX1 = 100 * MiB;
constexpr size_t WS_UFP = 496 * MiB;
constexpr size_t WS_END = 512 * MiB;
static_assert(WS_BAR + 3456 * 4 <= WS_ZERO_BYTES && WS_MODP + (size_t)2 * 8 * 5 * 3072 * 4 <= WS_HX && WS_SSQ + (size_t)MROWS * 16 * 4 <= WS_WIN && WS_WIN + (size_t)2 * PW * DM * 2 <= WS_WOUT && WS_HX + (size_t)MROWS * DM * 2 <= WS_P && WS_P + (size_t)MROWS * PW * 2 <= WS_VT &&
              WS_VT + (size_t)8 * 64 * VT_PITCH * 2 <= WS_H && WS_H + (size_t)MROWS * DM * 2 <= WS_Y && WS_Y + (size_t)MROWS * DM * 2 <= WS_YF && WS_YF + (size_t)4 * 128 * 64 * 512 * 2 <= WS_UFP && WS_UFP + (size_t)NTOK * 256 * 2 <= WS_END && WS_HX + (size_t)MROWS * DM * 2 <= WS_CTX1 && WS_CTX1 + (size_t)NCTX * DM * 4 <= WS_P, "ws map");

constexpr int LDS_BYTES = 147456;
constexpr int LDS_SCHED = LDS_BYTES - 64;
constexpr int LDS_BARST = LDS_BYTES - 32;
constexpr int NTHREADS = 512;

__device__ __forceinline__ float bf2f(unsigned h) { return __uint_as_float(h << 16); }
__device__ __forceinline__ unsigned pkbf(float lo, float hi) { unsigned r; asm volatile("v_cvt_pk_bf16_f32 %0, %1, %2" : "=v"(r) : "v"(lo), "v"(hi)); return r; }
__device__ __forceinline__ float silu_f(float x) { return x * __builtin_amdgcn_rcpf(1.f + __builtin_amdgcn_exp2f(-x * LOG2E)); }
__device__ __forceinline__ float wave_sum(float v) {
#pragma unroll
    for (int o = 1; o < 64; o <<= 1) v += __shfl_xor(v, o);
    return v;
}
__device__ __forceinline__ int swap23(int t) { return (t & ~12) | ((t & 4) << 1) | ((t & 8) >> 1); }
__device__ __forceinline__ int crow(int r, int hi) { return (r & 3) + 8 * (r >> 2) + 4 * hi; }
__device__ __forceinline__ bf16x8 pack8(const f32x16& p, int base) {
    u32x4 w; w.x = pkbf(p[base + 0], p[base + 1]); w.y = pkbf(p[base + 2], p[base + 3]); w.z = pkbf(p[base + 4], p[base + 5]); w.w = pkbf(p[base + 6], p[base + 7]);
    return __builtin_bit_cast(bf16x8, w);
}
#define MFMA32(a, b, c) __builtin_amdgcn_mfma_f32_32x32x16_bf16((a), (b), (c), 0, 0, 0)

struct KArgs {
    const float *x, *c, *ctx, *c_ctx, *w_mod, *b_mod, *g_pre, *g_post, *w_in, *w_out, *sink, *w_f, *conv_w, *conv_b;
    float* out; unsigned char* ws; int ph_lo, ph_hi;
};

__device__ __forceinline__ int prow_qk(int n) { return (n & ~31) | (8 * ((n >> 2) & 3) + 4 * ((n >> 4) & 1) + (n & 3)); }
__device__ __forceinline__ void p0_transpose_item(const float* W, int K, int N, bf16_t* WT, int nperm, float* scr, int item, int lane) {
    const int nblk = N / 32, kb = item / nblk, nb = item % nblk, k0 = 64 * kb, n0 = 32 * nb;
    { float wv[32];
#pragma unroll
      for (int i = 0; i < 32; ++i) wv[i] = W[(size_t)(k0 + 2 * i + (lane >> 5)) * N + n0 + (lane & 31)];
      __builtin_amdgcn_sched_barrier(0);
#pragma unroll
      for (int i = 0; i < 32; ++i) scr[(2 * i + (lane >> 5)) * 33 + (lane & 31)] = wv[i];
      __builtin_amdgcn_sched_barrier(0); }
    asm volatile("s_waitcnt lgkmcnt(0)" ::: "memory");
    const int c = lane & 7;
#pragma unroll
    for (int j = 0; j < 4; ++j) { const int n = (lane >> 3) + 8 * j; const float* s = scr + (8 * c) * 33 + n;
        u32x4 o; o.x = pkbf(s[0 * 33], s[1 * 33]); o.y = pkbf(s[2 * 33], s[3 * 33]); o.z = pkbf(s[4 * 33], s[5 * 33]); o.w = pkbf(s[6 * 33], s[7 * 33]);
        const int nl = n0 + n; const int np = nl < nperm ? prow_qk(nl) : nl;
        *(u32x4*)(WT + (size_t)np * K + k0 + 8 * c) = o; }
    asm volatile("s_waitcnt lgkmcnt(0)" ::: "memory");
}

__device__ __forceinline__ void p0_mod_gemv(const KArgs& a, int item, float* ldsf) {
    const int tid = opaque_tid(), lane = tid & 63, wave = tid >> 6;
    const int l = item / 96, col0 = (item % 96) * 32;
    float* s = ldsf;
    float* red = ldsf + 5 * 1024;
    for (int i = tid; i < 5 * 1024; i += NTHREADS) { const int bb = i >> 10, k = i & 1023; const float v = bb < 4 ? a.c[bb * 1024 + k] : a.c_ctx[k]; s[i] = v / (1.f + __expf(-v)); }
    __syncthreads();
    const int col = lane & 31, kh = lane >> 5;
    const float* W = a.w_mod + (size_t)l * 1024 * 3072 + (size_t)(wave * 128 + kh) * 3072 + col0 + col;
    float w[64];
#pragma unroll
    for (int i = 0; i < 64; ++i) w[i] = W[(size_t)(2 * i) * 3072];
    float acc[5] = {0.f, 0.f, 0.f, 0.f, 0.f};
#pragma unroll
    for (int i = 0; i < 64; ++i)
#pragma unroll
        for (int bb = 0; bb < 5; ++bb) acc[bb] += w[i] * s[bb * 1024 + wave * 128 + 2 * i + kh];
#pragma unroll
    for (int bb = 0; bb < 5; ++bb) red[((wave * 2 + kh) * 5 + bb) * 32 + col] = acc[bb];
    __syncthreads();
    if (tid < 160) { const int bb = tid >> 5, cc = tid & 31; float v = a.b_mod[l * 3072 + col0 + cc];
#pragma unroll
        for (int ww = 0; ww < 16; ++ww) v += red[(ww * 5 + bb) * 32 + cc];
        ((float*)(a.ws + WS_MOD))[(l * 5 + bb) * 3072 + col0 + cc] = v; }
    __syncthreads();
}

__device__ __forceinline__ void p0_prologue(const KArgs& a, unsigned char* lds) {
    const int tid = opaque_tid(), lane = tid & 63, wave = tid >> 6;
    const int G = gridDim.x, bx = blockIdx.x;
    unsigned char* ws = a.ws;
    if (bx < 192) p0_mod_gemv(a, bx, (float*)lds);
    {
        float* scr = (float*)(lds + wave * 16384);
        const int gw = bx * 8 + wave, NGW = G * 8;
        constexpr int I_IN = (DM / 64) * (PW / 32), I_OUT = (DM / 64) * (DM / 32);
        constexpr int NIT = 2 * (I_IN + I_OUT);
        for (int it = gw; it < NIT; it += NGW) {
            int r = it; const int l = r / (I_IN + I_OUT); r -= l * (I_IN + I_OUT);
            if (r < I_IN) p0_transpose_item(a.w_in + (size_t)l * DM * PW, DM, PW, (bf16_t*)(ws + WS_WIN) + (size_t)l * PW * DM, 640, scr, r, lane);
            else p0_transpose_item(a.w_out + (size_t)l * DM * DM, DM, DM, (bf16_t*)(ws + WS_WOUT) + (size_t)l * DM * DM, 0, scr, r - I_IN, lane);
        }
    }
    const int gt = bx * NTHREADS + tid, NGT = G * NTHREADS;
    for (int i = gt; i < 128 * 16; i += NGT) {
        const int pos = i >> 4, f = i & 15; const float inv = powf(10000.0f, -(float)f / 16.0f); const float ang = (float)pos * inv;
        float* rp = (float*)(ws + WS_ROPE) + pos * 32; rp[f] = cosf(ang); rp[16 + f] = sinf(ang);
    }
    for (int i = gt; i < 8192; i += NGT) { float sn, cs; sincospif((float)i * (2.0f / 8192.0f), &sn, &cs); float* t = (float*)(ws + WS_TW) + 2 * i; t[0] = cs; t[1] = sn; }
    for (int i = gt; i < 128 * 128; i += NGT) { const int k = i >> 7, n = i & 127; float sn, cs; sincospif((float)((k * n) & 127) * (2.0f / 128.0f), &sn, &cs);
        ((bf16_t*)(ws + WS_T1R))[i] = (bf16_t)(pkbf(cs, 0.f) & 0xffffu); ((bf16_t*)(ws + WS_T1I))[i] = (bf16_t)(pkbf(-sn, 0.f) & 0xffffu); }
    for (int i = gt; i < 64 * 128; i += NGT) { const int k = i >> 7, kk = i & 127, n = kk & 63; float sn, cs; sincospif((float)((k * n) & 63) * (2.0f / 64.0f), &sn, &cs);
        const float tr = kk < 64 ? cs : sn, ti = kk < 64 ? -sn : cs;
        ((bf16_t*)(ws + WS_T3R))[i] = (bf16_t)(pkbf(tr, 0.f) & 0xffffu); ((bf16_t*)(ws + WS_T3I))[i] = (bf16_t)(pkbf(ti, 0.f) & 0xffffu); }
    for (int i = gt; i < 256 * 256; i += NGT) { const int k = i >> 8, n = i & 255; float sn, cs; sincospif((float)((k * n) & 255) * (2.0f / 256.0f), &sn, &cs);
        ((bf16_t*)(ws + WS_T256R))[i] = (bf16_t)(pkbf(cs, 0.f) & 0xffffu); ((bf16_t*)(ws + WS_T256I))[i] = (bf16_t)(pkbf(-sn, 0.f) & 0xffffu); }
    {
        __syncthreads();
        float* trig = (float*)lds;
        if (tid < 64) { float sn, cs; sincospif((float)tid * (2.0f / 64.0f), &sn, &cs); trig[tid] = cs; trig[64 + tid] = sn; }
        __syncthreads();
        for (int i = gt; i < 2 * 4 * 64 * 128; i += NGT) {
            const int kk = i & 127, d = (i >> 7) & 63, g = (i >> 13) & 3, l = i >> 15; const int part = kk >> 6, c = swap23(kk & 63);
            const float* wf = a.w_f + ((size_t)(l * 4 + g) * 64) * 64 + d; float sacc = 0.f;
            float wfv[64];
#pragma unroll
            for (int j = 0; j < 64; ++j) wfv[j] = wf[j * 64];
            __builtin_amdgcn_sched_barrier(0);
#pragma unroll
            for (int j = 0; j < 64; ++j) sacc += trig[part * 64 + ((c * j) & 63)] * wfv[j];
            ((bf16_t*)(ws + WS_GT))[i] = (bf16_t)(pkbf(sacc * (1.0f / 724.0773439350246f), 0.f) & 0xffffu);
        }
        __syncthreads();
    }
}

__device__ __forceinline__ void norm_rows4(int mode, int lane, const float* src, float* dst, const bf16_t* y0, const float* ssq0, const bf16_t* y1, const float* ssq1, bf16_t* hx,
                                           const f32x4 (&GA0)[4], const f32x4 (&GA1)[4], const f32x4 (&GB)[4], const f32x4 (&GC)[4]) {
    f32x4 v[4][4];
#pragma unroll
    for (int rr = 0; rr < 4; ++rr)
#pragma unroll
        for (int j = 0; j < 4; ++j) v[rr][j] = *(const f32x4*)(src + (size_t)rr * DM + 4 * lane + 256 * j);
    if (mode != 0) {
        u32x2 yw[4][4], yx[4][4]; float p[4], p1[4];
#pragma unroll
        for (int rr = 0; rr < 4; ++rr) { p[rr] = ssq0[rr * 16 + (lane & 15)];
#pragma unroll
            for (int j = 0; j < 4; ++j) yw[rr][j] = *(const u32x2*)(y0 + (size_t)rr * DM + 4 * lane + 256 * j); }
        if (mode == 2) {
#pragma unroll
            for (int rr = 0; rr < 4; ++rr) { p1[rr] = ssq1[rr * 16 + (lane & 15)];
#pragma unroll
                for (int j = 0; j < 4; ++j) yx[rr][j] = *(const u32x2*)(y1 + (size_t)rr * DM + 4 * lane + 256 * j); }
        }
#pragma unroll
        for (int rr = 0; rr < 4; ++rr) {
            float q = p[rr]; q += __shfl_xor(q, 1); q += __shfl_xor(q, 2); q += __shfl_xor(q, 4); q += __shfl_xor(q, 8);
            const float rstd = 1.0f / sqrtf(q * (1.0f / DM) + NORM_EPS);
#pragma unroll
            for (int j = 0; j < 4; ++j) {
                f32x4 yy; yy[0] = bf2f(yw[rr][j].x & 0xffffu); yy[1] = bf2f(yw[rr][j].x >> 16); yy[2] = bf2f(yw[rr][j].y & 0xffffu); yy[3] = bf2f(yw[rr][j].y >> 16);
                v[rr][j] = v[rr][j] + GA0[j] * (yy * rstd);
            }
        }
        if (mode == 2) {
#pragma unroll
            for (int rr = 0; rr < 4; ++rr) {
                float q = p1[rr]; q += __shfl_xor(q, 1); q += __shfl_xor(q, 2); q += __shfl_xor(q, 4); q += __shfl_xor(q, 8);
                const float rstd = 1.0f / sqrtf(q * (1.0f / DM) + NORM_EPS);
#pragma unroll
                for (int j = 0; j < 4; ++j) {
                    f32x4 yy; yy[0] = bf2f(yx[rr][j].x & 0xffffu); yy[1] = bf2f(yx[rr][j].x >> 16); yy[2] = bf2f(yx[rr][j].y & 0xffffu); yy[3] = bf2f(yx[rr][j].y >> 16);
                    v[rr][j] = v[rr][j] + GA1[j] * (yy * rstd);
                    *(f32x4*)(dst + (size_t)rr * DM + 4 * lane + 256 * j) = v[rr][j];
                }
            }
        }
    }
    if (mode != 2) {
        float s[4];
#pragma unroll
        for (int rr = 0; rr < 4; ++rr) { float t = 0.f;
#pragma unroll
            for (int j = 0; j < 4; ++j) t += (v[rr][j][0] * v[rr][j][0] + v[rr][j][1] * v[rr][j][1]) + (v[rr][j][2] * v[rr][j][2] + v[rr][j][3] * v[rr][j][3]);
            s[rr] = t; }
#pragma unroll
        for (int o = 1; o < 64; o <<= 1) {
#pragma unroll
            for (int rr = 0; rr < 4; ++rr) s[rr] += __shfl_xor(s[rr], o); }
#pragma unroll
        for (int rr = 0; rr < 4; ++rr) {
            const float rstd = 1.0f / sqrtf(s[rr] * (1.0f / DM) + NORM_EPS);
#pragma unroll
            for (int j = 0; j < 4; ++j) {
                const f32x4 o = (v[rr][j] * rstd) * GB[j] + GC[j];
                u32x2 w; w.x = pkbf(o[0], o[1]); w.y = pkbf(o[2], o[3]);
                *(u32x2*)(hx + (size_t)rr * DM + 4 * lane + 256 * j) = w;
            }
        }
    }
}
__device__ __forceinline__ void norm_phase(const KArgs& a, int mode) {
    const int tid = opaque_tid(), lane = tid & 63, wave = tid >> 6;
    const int NGW = gridDim.x * 8;
    unsigned char* ws = a.ws;
    const float* mod = (const float*)(ws + WS_MOD);
    const int lp = (mode == 0) ? 0 : 1;
    bf16_t* HX = (bf16_t*)(ws + WS_HX); const bf16_t* Y0 = (const bf16_t*)(ws + WS_Y); const float* SSQ0 = (const float*)(ws + WS_SSQ);
    const bf16_t* Y1 = (const bf16_t*)(ws + WS_HX); const float* SSQ1 = (const float*)(ws + WS_SSQ1);
    const int gw2 = wave * (int)gridDim.x + (int)blockIdx.x;
    const int nlat = NTOK / 4;
    int curb = -1; f32x4 GA0[4], GA1[4], GB[4], GC[4];
    int base = gw2 * 4, sub = 0, itc = nlat + gw2; bool inctx = false;
    for (;;) {
        int it;
        if (!inctx) { if (base >= nlat) { inctx = true; continue; } it = base + sub; if (++sub == 4) { sub = 0; base += NGW * 4; } }
        else { if (mode == 2 || itc >= nlat + NCTX / 4) break; it = itc; itc += NGW; }
        const int r = it * 4;
        const int b = r < NTOK ? (r >> 13) : 4;
        if (b != curb) { curb = b;
            const float* mp = mod + (lp * 5 + b) * 3072; const float* m0 = mod + (0 * 5 + b) * 3072; const float* m1 = mod + (1 * 5 + b) * 3072;
#pragma unroll
            for (int j = 0; j < 4; ++j) { const int c = 4 * lane + 256 * j;
                GA0[j] = *(const f32x4*)(m0 + 2048 + c) * *(const f32x4*)(a.g_post + c);
                GA1[j] = *(const f32x4*)(m1 + 2048 + c) * *(const f32x4*)(a.g_post + DM + c);
                GB[j] = *(const f32x4*)(a.g_pre + lp * DM + c) * (*(const f32x4*)(mp + 1024 + c) + 1.0f);
                GC[j] = *(const f32x4*)(mp + c); } }
        const float* src = (r < NTOK) ? a.x + (size_t)r * DM : a.ctx + (size_t)(r - NTOK) * DM;
        norm_rows4(mode, lane, src, a.out + (size_t)r * DM, Y0 + (size_t)r * DM, SSQ0 + (size_t)r * 16, Y1 + (size_t)r * DM, SSQ1 + (size_t)r * 16, HX + (size_t)r * DM, GA0, GA1, GB, GC);
    }
}

__device__ __forceinline__ void attn_unit(int u, const bf16_t* P, const bf16_t* Vt, bf16_t* H, const float* sink, unsigned char* lds) {
    const int tid = opaque_tid(), lane = tid & 63, wave = __builtin_amdgcn_readfirstlane(tid >> 6), r32 = lane & 31, hi = lane >> 5;
    const bool isctx = u >= 1024;
    int b, kvh, qb;
    if (isctx) { const int v = u - 1024; b = v >> 3; kvh = (v >> 2) & 1; qb = v & 3; } else { b = u >> 8; kvh = (u >> 7) & 1; qb = u & 127; }
    const int head = kvh * 4 + (wave >> 1);
    const int qtok = qb * 64 + (wave & 1) * 32 + r32;
    const size_t qrow = isctx ? (size_t)(NTOK + b * CTXL + qtok) : (size_t)(b * SEQ + qtok);
    const float sinkv = sink[head];
    bf16x8 qf[4];
#pragma unroll
    for (int d0 = 0; d0 < 4; ++d0) qf[d0] = *(const bf16x8*)(P + qrow * PW + C_Q + head * 64 + d0 * 16 + hi * 8);
    int jlo = 0, jhi = -1;
    if (!isctx) { jlo = qb < 2 ? 2 - qb : 0; jhi = (129 - qb) < 4 ? (129 - qb) : 4; }
    const int ntiles = 4 + (jhi - jlo + 1);
    const int srow = tid >> 3, sch = tid & 7;
    const bf16_t* Kc = P + (size_t)(NTOK + b * CTXL + srow) * PW + C_K + kvh * 64 + sch * 8;
    const bf16_t* Kl = P + (size_t)(b * SEQ + srow) * PW + C_K + kvh * 64 + sch * 8;
    const bf16_t* Vb = Vt + (size_t)((b * 2 + kvh) * 64 + srow) * VT_PITCH + sch * 8;
    unsigned char* Ks = lds; unsigned char* Vs = lds + 2 * 9216;
    const int soff = srow * 144 + sch * 16;
    u32x4 kreg, vreg, kreg2, vreg2;
#define ATT_GLOAD(KR, VR, ti_) do { const int t_ = (ti_); \
        if (t_ < 4) { KR = *(const u32x4*)(Kc + (size_t)(64 * t_) * PW); VR = *(const u32x4*)(Vb + SEQ + 64 * t_); } \
        else { const int kbase_ = qb * 64 - 128 + 64 * (jlo + t_ - 4); KR = *(const u32x4*)(Kl + (size_t)kbase_ * PW); VR = *(const u32x4*)(Vb + kbase_); } } while (0)
    const bf16_t* garow = P + qrow * PW + C_GA + head * 64;
    u32x2 gaw[8];
#pragma unroll
    for (int i = 0; i < 8; ++i) gaw[i] = *(const u32x2*)(garow + 32 * (i >> 2) + 8 * (i & 3) + 4 * hi);
    ATT_GLOAD(kreg2, vreg2, 0);
    ATT_GLOAD(kreg, vreg, 1);
    *(u32x4*)(Ks + soff) = kreg2; *(u32x4*)(Vs + soff) = vreg2;
    __syncthreads();
    const float sink2 = sinkv * LOG2E;
    float mref = sink2, lsum = 0.f;
    f32x16 oT[2]; oT[0] = f32x16{}; oT[1] = f32x16{};
    const int qpos = qtok;
    for (int ti = 0; ti < ntiles; ++ti) {
        const int buf = ti & 1;
        if (ti + 2 < ntiles) ATT_GLOAD(kreg2, vreg2, ti + 2);
        const unsigned char* kb = Ks + buf * 9216 + r32 * 144 + hi * 16;
        const unsigned char* vb = Vs + buf * 9216 + r32 * 144 + hi * 16;
        bf16x8 kf[8];
#pragma unroll
        for (int d0 = 0; d0 < 4; ++d0) { kf[2 * d0] = *(const bf16x8*)(kb + d0 * 32); kf[2 * d0 + 1] = *(const bf16x8*)(kb + 32 * 144 + d0 * 32); }
        f32x16 p0, p1;
#pragma unroll
        for (int r = 0; r < 16; ++r) { p0[r] = -mref; p1[r] = -mref; }
        __builtin_amdgcn_sched_barrier(0);
#pragma unroll
        for (int d0 = 0; d0 < 4; ++d0) { p0 = MFMA32(kf[2 * d0], qf[d0], p0); p1 = MFMA32(kf[2 * d0 + 1], qf[d0], p1); }
        bf16x8 vf[8];
#pragma unroll
        for (int blk = 0; blk < 2; ++blk)
#pragma unroll
            for (int ks = 0; ks < 4; ++ks) vf[blk * 4 + ks] = *(const bf16x8*)(vb + blk * 32 * 144 + ks * 32);
        __builtin_amdgcn_sched_barrier(0);
        asm volatile("s_nop 15\n\ts_nop 7" : "+v"(p0), "+v"(p1));
        if (ti >= 4) {
            const int j = jlo + ti - 4; const int kbase = qb * 64 - 128 + 64 * j;
            if (j == 0) {
#pragma unroll
                for (int r = 0; r < 16; ++r) { const int kp = kbase + crow(r, hi); if (kp < qpos - 128) p0[r] = -INFINITY; if (kp + 32 < qpos - 128) p1[r] = -INFINITY; }
            } else if (j == 4) {
#pragma unroll
                for (int r = 0; r < 16; ++r) { const int kp = kbase + crow(r, hi); if (kp > qpos + 128) p0[r] = -INFINITY; if (kp + 32 > qpos + 128) p1[r] = -INFINITY; }
            }
        }
        float rma, rmb;
        asm("v_max3_f32 %0, %1, %2, %3" : "=v"(rma) : "v"(p0[0]), "v"(p0[1]), "v"(p1[0]));
        asm("v_max3_f32 %0, %1, %2, %3" : "=v"(rmb) : "v"(p0[2]), "v"(p0[3]), "v"(p1[1]));
        asm("v_max3_f32 %0, %1, %2, %3" : "=v"(rma) : "v"(rma), "v"(p1[2]), "v"(p1[3]));
#pragma unroll
        for (int r = 4; r < 16; r += 4) {
            asm("v_max3_f32 %0, %1, %2, %3" : "=v"(rma) : "v"(rma), "v"(p0[r]), "v"(p0[r + 1]));
            asm("v_max3_f32 %0, %1, %2, %3" : "=v"(rmb) : "v"(rmb), "v"(p0[r + 2]), "v"(p0[r + 3]));
            asm("v_max3_f32 %0, %1, %2, %3" : "=v"(rma) : "v"(rma), "v"(p1[r]), "v"(p1[r + 1]));
            asm("v_max3_f32 %0, %1, %2, %3" : "=v"(rmb) : "v"(rmb), "v"(p1[r + 2]), "v"(p1[r + 3]));
        }
        float rm; asm("v_max3_f32 %0, %1, %2, %3" : "=v"(rm) : "v"(rma), "v"(rmb), "v"(rmb));
        { const float rmo = __shfl_xor(rm, 32); asm("v_max3_f32 %0, %1, %2, %3" : "=v"(rm) : "v"(rm), "v"(rmo), "v"(rmo)); }
        if (__any(rm > 8.0f)) {
            const float dl = fmaxf(rm, 0.f);
            mref += dl;
            const float f = __builtin_amdgcn_exp2f(-dl);
            lsum *= f;
#pragma unroll
            for (int r = 0; r < 16; ++r) { p0[r] -= dl; p1[r] -= dl; oT[0][r] *= f; oT[1][r] *= f; }
        }
        float ls = 0.f;
#pragma unroll
        for (int r = 0; r < 16; ++r) { p0[r] = __builtin_amdgcn_exp2f(p0[r]); p1[r] = __builtin_amdgcn_exp2f(p1[r]); ls += p0[r] + p1[r]; }
        lsum += ls;
        bf16x8 pf[4]; pf[0] = pack8(p0, 0); pf[1] = pack8(p0, 8); pf[2] = pack8(p1, 0); pf[3] = pack8(p1, 8);
#pragma unroll
        for (int blk = 0; blk < 2; ++blk)
#pragma unroll
            for (int ks = 0; ks < 4; ++ks) oT[blk] = MFMA32(vf[blk * 4 + ks], pf[ks], oT[blk]);
        if (ti + 1 < ntiles) { *(u32x4*)(Ks + (buf ^ 1) * 9216 + soff) = kreg; *(u32x4*)(Vs + (buf ^ 1) * 9216 + soff) = vreg; }
        kreg = kreg2; vreg = vreg2;
        __syncthreads();
    }
    lsum += __shfl_xor(lsum, 32);
    lsum += __builtin_amdgcn_exp2f(sink2 - mref);
    const float inv = 1.0f / lsum;
    bf16_t* hrow = H + qrow * DM + head * 64;
#pragma unroll
    for (int blk = 0; blk < 2; ++blk)
#pragma unroll
        for (int g4 = 0; g4 < 4; ++g4) {
            const int d0 = 32 * blk + 8 * g4 + 4 * hi;
            const u32x2 gw = gaw[blk * 4 + g4];
            const float o0 = oT[blk][4 * g4 + 0] * inv * silu_f(bf2f(gw.x & 0xffffu)), o1 = oT[blk][4 * g4 + 1] * inv * silu_f(bf2f(gw.x >> 16));
            const float o2 = oT[blk][4 * g4 + 2] * inv * silu_f(bf2f(gw.y & 0xffffu)), o3 = oT[blk][4 * g4 + 3] * inv * silu_f(bf2f(gw.y >> 16));
            u32x2 w; w.x = pkbf(o0, o1); w.y = pkbf(o2, o3);
            *(u32x2*)(hrow + d0) = w;
        }
}

typedef short v4i16_t __attribute__((ext_vector_type(4)));
__device__ __forceinline__ v4i16_t trrd(const unsigned char* p) { return __builtin_amdgcn_ds_read_tr16_b64_v4i16((LAS v4i16_t*)p); }
__device__ __forceinline__ bf16x8 cat8(v4i16_t lo, v4i16_t hi) { return (bf16x8){lo[0], lo[1], lo[2], lo[3], hi[0], hi[1], hi[2], hi[3]}; }
__device__ __forceinline__ void fft1_unit(int u, const bf16_t* P, bf16_t* YF, const unsigned char* ws, unsigned char* lds) {
    const int tid = opaque_tid(), lane = tid & 63, wave = __builtin_amdgcn_readfirstlane(tid >> 6), r32 = lane & 31, hi = lane >> 5;
    const int b = u >> 6, n2 = u & 63;
    constexpr int UPB = 576;
    const bf16_t* src = P + (size_t)(b * SEQ + n2) * PW + C_UF;
#pragma unroll
    for (int i = 0; i < 8; ++i) {
        const int id = tid + NTHREADS * i, n1 = id >> 5, cc = id & 31;
        *(u32x4*)(lds + n1 * UPB + cc * 16) = *(const u32x4*)(src + (size_t)n1 * 64 * PW + cc * 8);
    }
    __syncthreads();
    const bf16_t* T1R = (const bf16_t*)(ws + WS_T1R); const bf16_t* T1I = (const bf16_t*)(ws + WS_T1I);
    f32x16 aR[4], aI[4];
#pragma unroll
    for (int kb = 0; kb < 4; ++kb) { aR[kb] = f32x16{}; aI[kb] = f32x16{}; }
    const unsigned char* ap = lds + (8 * hi + ((lane & 15) >> 2)) * UPB + (32 * wave + 16 * ((lane >> 4) & 1) + 4 * (lane & 3)) * 2;
#pragma unroll 2
    for (int ks = 0; ks < 8; ++ks) {
        const bf16x8 av = cat8(trrd(ap + (16 * ks) * UPB), trrd(ap + (16 * ks + 4) * UPB));
#pragma unroll
        for (int kb = 0; kb < 4; ++kb) {
            const bf16x8 bR = *(const bf16x8*)(T1R + (32 * kb + r32) * 128 + 16 * ks + 8 * hi), bI = *(const bf16x8*)(T1I + (32 * kb + r32) * 128 + 16 * ks + 8 * hi);
            aR[kb] = MFMA32(av, bR, aR[kb]); aI[kb] = MFMA32(av, bI, aI[kb]);
        }
    }
    const float* TW = (const float*)(ws + WS_TW);
#pragma unroll
    for (int kb = 0; kb < 4; ++kb) {
        const int k1 = 32 * kb + r32;
        const float ct = TW[2 * (n2 * k1)], st = TW[2 * (n2 * k1) + 1];
        bf16_t* yp = YF + ((size_t)((b * 128 + k1) * 64 + n2)) * 512 + 32 * wave + 4 * hi;
#pragma unroll
        for (int g4 = 0; g4 < 4; ++g4) {
            float yr[4], yi[4];
#pragma unroll
            for (int e = 0; e < 4; ++e) { const float r_ = aR[kb][4 * g4 + e], i_ = aI[kb][4 * g4 + e]; yr[e] = r_ * ct + i_ * st; yi[e] = i_ * ct - r_ * st; }
            u32x2 wr_, wi_; wr_.x = pkbf(yr[0], yr[1]); wr_.y = pkbf(yr[2], yr[3]); wi_.x = pkbf(yi[0], yi[1]); wi_.y = pkbf(yi[2], yi[3]);
            *(u32x2*)(yp + 8 * g4) = wr_; *(u32x2*)(yp + 256 + 8 * g4) = wi_;
        }
    }
    __syncthreads();
}

template <int KK>
__device__ __forceinline__ void dftf_unit(const bf16_t* srcbase, int R, int pitchA, int pitchB, const bf16_t* Tr, const bf16_t* Ti, const bf16_t* Gt,
                                          const bf16_t* P, bf16_t* H, size_t row0, int rowstride, float oscale, unsigned char* lds) {
    const int tid = opaque_tid(), lane = tid & 63, wave = __builtin_amdgcn_readfirstlane(tid >> 6), r32 = lane & 31, hi = lane >> 5;
    constexpr int ZPB = (KK == 128) ? 576 : 544;
#pragma unroll 1
    for (int i0 = 0; i0 < KK / 16; i0 += 8) {
        u32x4 img[8];
#pragma unroll
        for (int i = 0; i < 8; ++i) { const int id = tid + NTHREADS * (i0 + i), kk = id >> 5, cc = id & 31; img[i] = *(const u32x4*)(srcbase + (size_t)(kk % R) * pitchA + (size_t)(kk / R) * pitchB + cc * 8); }
        __builtin_amdgcn_sched_barrier(0);
#pragma unroll
        for (int i = 0; i < 8; ++i) { const int id = tid + NTHREADS * (i0 + i), kk = id >> 5, cc = id & 31; *(u32x4*)(lds + kk * ZPB + cc * 16) = img[i]; }
        __builtin_amdgcn_sched_barrier(0);
    }
    __syncthreads();
    const int g = wave >> 1, kblk = wave & 1;
    f32x16 XR[2], XI[2];
#pragma unroll
    for (int cb = 0; cb < 2; ++cb) { XR[cb] = f32x16{}; XI[cb] = f32x16{}; }
    const bf16_t* trp = Tr + (size_t)(32 * kblk + r32) * KK + 8 * hi; const bf16_t* tip = Ti + (size_t)(32 * kblk + r32) * KK + 8 * hi;
    const unsigned char* zp = lds + (8 * hi + ((lane & 15) >> 2)) * ZPB + (64 * g + 16 * ((lane >> 4) & 1) + 4 * (lane & 3)) * 2;
#pragma unroll 2
    for (int ks = 0; ks < KK / 16; ++ks) {
        const bf16x8 bR = *(const bf16x8*)(trp + 16 * ks), bI = *(const bf16x8*)(tip + 16 * ks);
#pragma unroll
        for (int cb = 0; cb < 2; ++cb) { const bf16x8 av = cat8(trrd(zp + (16 * ks) * ZPB + cb * 64), trrd(zp + (16 * ks + 4) * ZPB + cb * 64)); XR[cb] = MFMA32(av, bR, XR[cb]); XI[cb] = MFMA32(av, bI, XI[cb]); }
    }
    f32x16 oa[2]; oa[0] = f32x16{}; oa[1] = f32x16{};
    const bf16_t* gp = Gt + (size_t)(g * 64 + r32) * 128 + 8 * hi;
    u32x2 gfw[8];
    { const size_t rowg = row0 + (size_t)(32 * kblk + r32) * rowstride;
#pragma unroll
      for (int i8 = 0; i8 < 8; ++i8) gfw[i8] = *(const u32x2*)(P + rowg * PW + C_GF + 64 * g + 32 * (i8 >> 2) + 8 * (i8 & 3) + 4 * hi); }
#pragma unroll
    for (int part = 0; part < 2; ++part)
#pragma unroll
        for (int cb = 0; cb < 2; ++cb)
#pragma unroll
            for (int s = 0; s < 2; ++s) {
                const bf16x8 bx = pack8(part ? XI[cb] : XR[cb], 8 * s);
                const int kko = part * 64 + 32 * cb + 16 * s;
#pragma unroll
                for (int lb = 0; lb < 2; ++lb) { const bf16x8 ag = *(const bf16x8*)(gp + (size_t)(32 * lb) * 128 + kko); oa[lb] = MFMA32(ag, bx, oa[lb]); }
            }
    const int k2 = 32 * kblk + r32;
    const size_t row = row0 + (size_t)k2 * rowstride;
    const bf16_t* gfrow = P + row * PW + C_GF + 64 * g;
    bf16_t* hrow = H + row * DM + 512 + 64 * g;
#pragma unroll
    for (int lb = 0; lb < 2; ++lb)
#pragma unroll
        for (int g4 = 0; g4 < 4; ++g4) {
            const int l0 = 32 * lb + 8 * g4 + 4 * hi;
            const u32x2 gw = gfw[lb * 4 + g4];
            const float o0 = oa[lb][4 * g4 + 0] * oscale * silu_f(bf2f(gw.x & 0xffffu)), o1 = oa[lb][4 * g4 + 1] * oscale * silu_f(bf2f(gw.x >> 16));
            const float o2 = oa[lb][4 * g4 + 2] * oscale * silu_f(bf2f(gw.y & 0xffffu)), o3 = oa[lb][4 * g4 + 3] * oscale * silu_f(bf2f(gw.y >> 16));
            u32x2 w; w.x = pkbf(o0, o1); w.y = pkbf(o2, o3);
            *(u32x2*)(hrow + l0) = w;
        }
    __syncthreads();
}

__device__ __forceinline__ void conv_unit(int u, const bf16_t* P, bf16_t* H, const float* cw, const float* cb) {
    const int tid = opaque_tid(), cgp = tid & 31, rg = tid >> 5;
    const int ch0 = cgp * 8;
    const int r0 = u * 64 + rg * 4;
    int pos, len; if (r0 < NTOK) { pos = r0 & (SEQ - 1); len = SEQ; } else { pos = (r0 - NTOK) & (CTXL - 1); len = CTXL; }
    float w0[8], w1[8], w2[8], bs[8];
#pragma unroll
    for (int e = 0; e < 8; ++e) { w0[e] = cw[ch0 + e]; w1[e] = cw[256 + ch0 + e]; w2[e] = cw[512 + ch0 + e]; bs[e] = cb[ch0 + e]; }
    float T[6][8];
#pragma unroll
    for (int i = 0; i < 6; ++i) {
        const int p = pos - 1 + i;
        if (p >= 0 && p < len) {
            const size_t row = (size_t)(r0 - 1 + i);
            const u32x4 z = *(const u32x4*)(P + row * PW + C_ZC + ch0), c = *(const u32x4*)(P + row * PW + C_CC + ch0);
            T[i][0] = bf2f(z.x & 0xffffu) * bf2f(c.x & 0xffffu); T[i][1] = bf2f(z.x >> 16) * bf2f(c.x >> 16);
            T[i][2] = bf2f(z.y & 0xffffu) * bf2f(c.y & 0xffffu); T[i][3] = bf2f(z.y >> 16) * bf2f(c.y >> 16);
            T[i][4] = bf2f(z.z & 0xffffu) * bf2f(c.z & 0xffffu); T[i][5] = bf2f(z.z >> 16) * bf2f(c.z >> 16);
            T[i][6] = bf2f(z.w & 0xffffu) * bf2f(c.w & 0xffffu); T[i][7] = bf2f(z.w >> 16) * bf2f(c.w >> 16);
        } else {
#pragma unroll
            for (int e = 0; e < 8; ++e) T[i][e] = 0.f;
        }
    }
#pragma unroll
    for (int i = 0; i < 4; ++i) {
        const size_t row = (size_t)(r0 + i);
        const u32x4 bw = *(const u32x4*)(P + row * PW + C_BC + ch0), gw = *(const u32x4*)(P + row * PW + C_GC + ch0);
        const unsigned bwv[4] = {bw.x, bw.y, bw.z, bw.w}, gwv[4] = {gw.x, gw.y, gw.z, gw.w};
        float o[8];
#pragma unroll
        for (int e = 0; e < 8; ++e) {
            const float bv = (e & 1) ? bf2f(bwv[e >> 1] >> 16) : bf2f(bwv[e >> 1] & 0xffffu);
            const float gv = (e & 1) ? bf2f(gwv[e >> 1] >> 16) : bf2f(gwv[e >> 1] & 0xffffu);
            const float y = T[i][e] * w0[e] + T[i + 1][e] * w1[e] + T[i + 2][e] * w2[e] + bs[e];
            o[e] = bv * y * silu_f(gv);
        }
        u32x4 w; w.x = pkbf(o[0], o[1]); w.y = pkbf(o[2], o[3]); w.z = pkbf(o[4], o[5]); w.w = pkbf(o[6], o[7]);
        *(u32x4*)(H + row * DM + 768 + ch0) = w;
    }
}

__device__ __forceinline__ void fft1_wave(int task, const bf16_t* P, bf16_t* YF, const unsigned char* ws, unsigned char* lds_w, int lane, int pmode = 0) {
    const int r32 = lane & 31, hi = lane >> 5;
    const int cblk = task & 7, n2 = (task >> 3) & 63, b = task >> 9;
    const bf16_t* src = P + (size_t)((b * 64 + n2) * 128) * 256 + 32 * cblk + 8 * (lane & 3);
    { u32x4 img[8];
#pragma unroll
      for (int i = 0; i < 8; ++i) img[i] = *(const u32x4*)(src + (size_t)(16 * i + (lane >> 2)) * 256);
      __builtin_amdgcn_sched_barrier(0);
#pragma unroll
      for (int i = 0; i < 8; ++i) *(u32x4*)(lds_w + (16 * i + (lane >> 2)) * 64 + (lane & 3) * 16) = img[i];
      __builtin_amdgcn_sched_barrier(0); }
    asm volatile("s_waitcnt vmcnt(0) lgkmcnt(0)" ::: "memory");
    if (pmode == 2) return;
    const bf16_t* T1R = (const bf16_t*)(ws + WS_T1R); const bf16_t* T1I = (const bf16_t*)(ws + WS_T1I);
    f32x16 aR[4], aI[4];
#pragma unroll
    for (int kb = 0; kb < 4; ++kb) { aR[kb] = f32x16{}; aI[kb] = f32x16{}; }
    const unsigned char* ap = lds_w + (8 * hi + ((lane & 15) >> 2)) * 64 + (16 * ((lane >> 4) & 1) + 4 * (lane & 3)) * 2;
    const bf16_t* t1r = T1R + (size_t)r32 * 128 + 8 * hi; const bf16_t* t1i = T1I + (size_t)r32 * 128 + 8 * hi;
    bf16x8 bA[8], bB[8];
#define F1_LOADB(B, ks_) do { _Pragma("unroll") for (int kb = 0; kb < 4; ++kb) { B[2 * kb] = *(const bf16x8*)(t1r + (size_t)(32 * kb) * 128 + 16 * (ks_)); B[2 * kb + 1] = *(const bf16x8*)(t1i + (size_t)(32 * kb) * 128 + 16 * (ks_)); } } while (0)
#define F1_STEP(B, ks_) do { const bf16x8 av = cat8(trrd(ap + (16 * (ks_)) * 64), trrd(ap + (16 * (ks_) + 4) * 64)); \
        _Pragma("unroll") for (int kb = 0; kb < 4; ++kb) { aR[kb] = MFMA32(av, B[2 * kb], aR[kb]); aI[kb] = MFMA32(av, B[2 * kb + 1], aI[kb]); } } while (0)
    F1_LOADB(bA, 0);
#pragma unroll
    for (int k2 = 0; k2 < 4; ++k2) {
        F1_LOADB(bB, 2 * k2 + 1);
        __builtin_amdgcn_sched_barrier(0);
        F1_STEP(bA, 2 * k2);
        __builtin_amdgcn_sched_barrier(0);
        if (k2 < 3) F1_LOADB(bA, 2 * k2 + 2);
        __builtin_amdgcn_sched_barrier(0);
        F1_STEP(bB, 2 * k2 + 1);
        __builtin_amdgcn_sched_barrier(0);
    }
#undef F1_LOADB
#undef F1_STEP
    const float* TW = (const float*)(ws + WS_TW);
#pragma unroll
    for (int kb = 0; kb < 4; ++kb) {
        const int k1 = 32 * kb + r32;
        const float ct = TW[2 * (n2 * k1)], st = TW[2 * (n2 * k1) + 1];
        bf16_t* yp = YF + ((size_t)((b * 128 + k1) * 64 + n2)) * 512 + 32 * cblk + 4 * hi;
#pragma unroll
        for (int g4 = 0; g4 < 4; ++g4) {
            float yr[4], yi[4];
#pragma unroll
            for (int e = 0; e < 4; ++e) { const float r_ = aR[kb][4 * g4 + e], i_ = aI[kb][4 * g4 + e]; yr[e] = r_ * ct + i_ * st; yi[e] = i_ * ct - r_ * st; }
            u32x2 wr_, wi_; wr_.x = pkbf(yr[0], yr[1]); wr_.y = pkbf(yr[2], yr[3]); wi_.x = pkbf(yi[0], yi[1]); wi_.y = pkbf(yi[2], yi[3]);
            if (pmode != 1 || wr_.x == 0x12345678u) { *(u32x2*)(yp + 8 * g4) = wr_; *(u32x2*)(yp + 256 + 8 * g4) = wi_; }
        }
    }
    asm volatile("s_waitcnt lgkmcnt(0)" ::: "memory");
}
__device__ __forceinline__ void fft3_wave(int task, const bf16_t* YF, const bf16_t* Gt, const bf16_t* P, bf16_t* H, const unsigned char* ws, unsigned char* lds_w, int lane) {
    const int r32 = lane & 31, hi = lane >> 5;
    const int g = task & 3, k1 = (task >> 2) & 127, b = task >> 9;
    const bf16_t* src = YF + ((size_t)(b * 128 + k1) * 64) * 512 + 64 * g + 8 * (lane & 7);
    { u32x4 img[16];
#pragma unroll
      for (int i = 0; i < 16; ++i) { const int kk = 8 * i + (lane >> 3); img[i] = *(const u32x4*)(src + (size_t)(kk & 63) * 512 + (size_t)(kk >> 6) * 256); }
      __builtin_amdgcn_sched_barrier(0);
#pragma unroll
      for (int i = 0; i < 16; ++i) { const int kk = 8 * i + (lane >> 3), ch = lane & 7; *(u32x4*)(lds_w + kk * 128 + ((ch ^ (((kk >> 1) & 1) << 2)) * 16)) = img[i]; }
      __builtin_amdgcn_sched_barrier(0); }
    asm volatile("s_waitcnt vmcnt(0) lgkmcnt(0)" ::: "memory");
    const bf16_t* T3R = (const bf16_t*)(ws + WS_T3R); const bf16_t* T3I = (const bf16_t*)(ws + WS_T3I);
    const int q = (lane & 15) >> 2, sw = (q >> 1) & 1;
    const int chl = 2 * ((lane >> 4) & 1) + ((lane & 3) >> 1);
    const unsigned char* zb = lds_w + (8 * hi + q) * 128 + 8 * (lane & 1);
    const unsigned char* zp0 = zb + ((chl ^ (sw << 2)) * 16);
    const unsigned char* zp1 = zb + (((4 + chl) ^ (sw << 2)) * 16);
    const bf16_t* gp = Gt + (size_t)(g * 64 + r32) * 128 + 8 * hi;
    const size_t rowb = (size_t)(b * SEQ + k1);
#pragma unroll 1
    for (int kblk = 0; kblk < 2; ++kblk) {
        f32x16 XR[2], XI[2];
#pragma unroll
        for (int cb = 0; cb < 2; ++cb) { XR[cb] = f32x16{}; XI[cb] = f32x16{}; }
        const bf16_t* trp = T3R + (size_t)(32 * kblk + r32) * 128 + 8 * hi; const bf16_t* tip = T3I + (size_t)(32 * kblk + r32) * 128 + 8 * hi;
        const size_t rowg = rowb + (size_t)(32 * kblk + r32) * 128;
        u32x2 gfw[8];
#pragma unroll
        for (int i8 = 0; i8 < 8; ++i8) gfw[i8] = *(const u32x2*)(P + rowg * PW + C_GF + 64 * g + 32 * (i8 >> 2) + 8 * (i8 & 3) + 4 * hi);
        bf16x8 bR[8], bI[8];
#pragma unroll
        for (int ks = 0; ks < 8; ++ks) { bR[ks] = *(const bf16x8*)(trp + 16 * ks); bI[ks] = *(const bf16x8*)(tip + 16 * ks); }
        __builtin_amdgcn_sched_barrier(0);
#pragma unroll
        for (int ks = 0; ks < 8; ++ks) {
            const bf16x8 a0 = cat8(trrd(zp0 + (16 * ks) * 128), trrd(zp0 + (16 * ks + 4) * 128));
            const bf16x8 a1 = cat8(trrd(zp1 + (16 * ks) * 128), trrd(zp1 + (16 * ks + 4) * 128));
            XR[0] = MFMA32(a0, bR[ks], XR[0]); XI[0] = MFMA32(a0, bI[ks], XI[0]); XR[1] = MFMA32(a1, bR[ks], XR[1]); XI[1] = MFMA32(a1, bI[ks], XI[1]);
        }
        __builtin_amdgcn_sched_barrier(0);
        bf16x8 gfr[2][8];
#pragma unroll
        for (int lb = 0; lb < 2; ++lb)
#pragma unroll
            for (int q8 = 0; q8 < 8; ++q8) gfr[lb][q8] = *(const bf16x8*)(gp + (size_t)(32 * lb) * 128 + 16 * q8);
        __builtin_amdgcn_sched_barrier(0);
        f32x16 oa[2]; oa[0] = f32x16{}; oa[1] = f32x16{};
#pragma unroll
        for (int part = 0; part < 2; ++part)
#pragma unroll
            for (int cb = 0; cb < 2; ++cb)
#pragma unroll
                for (int s = 0; s < 2; ++s) {
                    const bf16x8 bx = pack8(part ? XI[cb] : XR[cb], 8 * s);
                    const int kko = part * 64 + 32 * cb + 16 * s;
#pragma unroll
                    for (int lb = 0; lb < 2; ++lb) oa[lb] = MFMA32(gfr[lb][kko >> 4], bx, oa[lb]);
                }
        const int k2 = 32 * kblk + r32;
        const size_t row = rowb + (size_t)k2 * 128;
        const bf16_t* gfrow = P + row * PW + C_GF + 64 * g;
        bf16_t* hrow = H + row * DM + 512 + 64 * g;
#pragma unroll
        for (int lb = 0; lb < 2; ++lb)
#pragma unroll
            for (int g4 = 0; g4 < 4; ++g4) {
                const int l0 = 32 * lb + 8 * g4 + 4 * hi;
                const u32x2 gw = gfw[lb * 4 + g4];
                const float o0 = oa[lb][4 * g4 + 0] * silu_f(bf2f(gw.x & 0xffffu)), o1 = oa[lb][4 * g4 + 1] * silu_f(bf2f(gw.x >> 16));
                const float o2 = oa[lb][4 * g4 + 2] * silu_f(bf2f(gw.y & 0xffffu)), o3 = oa[lb][4 * g4 + 3] * silu_f(bf2f(gw.y >> 16));
                u32x2 w; w.x = pkbf(o0, o1); w.y = pkbf(o2, o3);
                *(u32x2*)(hrow + l0) = w;
            }
    }
    asm volatile("s_waitcnt lgkmcnt(0)" ::: "memory");
}
__device__ __forceinline__ void conv_wave(int task, const bf16_t* P, bf16_t* H, const float* cw, const float* cb, int lane) {
    const int cgp = lane & 31, ch0 = cgp * 8;
    const int r0 = task * 8 + (lane >> 5) * 4;
    int pos, len; if (r0 < NTOK) { pos = r0 & (SEQ - 1); len = SEQ; } else { pos = (r0 - NTOK) & (CTXL - 1); len = CTXL; }
    u32x4 zz[6], cc[6], bb[4], gg[4]; float okf[6];
#pragma unroll
    for (int i = 0; i < 6; ++i) { const int p = pos - 1 + i; const bool ok = p >= 0 && p < len; okf[i] = ok ? 1.f : 0.f; const size_t row = (size_t)(ok ? r0 - 1 + i : r0);
        zz[i] = *(const u32x4*)(P + row * PW + C_ZC + ch0); cc[i] = *(const u32x4*)(P + row * PW + C_CC + ch0); }
#pragma unroll
    for (int i = 0; i < 4; ++i) { const size_t row = (size_t)(r0 + i); bb[i] = *(const u32x4*)(P + row * PW + C_BC + ch0); gg[i] = *(const u32x4*)(P + row * PW + C_GC + ch0); }
    __builtin_amdgcn_sched_barrier(0);
    float w0[8], w1[8], w2[8], bs[8];
    { const f32x4 a0 = *(const f32x4*)(cw + ch0), a1 = *(const f32x4*)(cw + ch0 + 4), b0 = *(const f32x4*)(cw + 256 + ch0), b1 = *(const f32x4*)(cw + 256 + ch0 + 4);
      const f32x4 c0 = *(const f32x4*)(cw + 512 + ch0), c1 = *(const f32x4*)(cw + 512 + ch0 + 4), d0 = *(const f32x4*)(cb + ch0), d1 = *(const f32x4*)(cb + ch0 + 4);
#pragma unroll
      for (int e = 0; e < 4; ++e) { w0[e] = a0[e]; w0[4 + e] = a1[e]; w1[e] = b0[e]; w1[4 + e] = b1[e]; w2[e] = c0[e]; w2[4 + e] = c1[e]; bs[e] = d0[e]; bs[4 + e] = d1[e]; } }
    float T[6][8];
#pragma unroll
    for (int i = 0; i < 6; ++i) {
        const unsigned zv[4] = {zz[i].x, zz[i].y, zz[i].z, zz[i].w}, cv[4] = {cc[i].x, cc[i].y, cc[i].z, cc[i].w};
#pragma unroll
        for (int e = 0; e < 8; ++e) T[i][e] = okf[i] * ((e & 1) ? bf2f(zv[e >> 1] >> 16) : bf2f(zv[e >> 1] & 0xffffu)) * ((e & 1) ? bf2f(cv[e >> 1] >> 16) : bf2f(cv[e >> 1] & 0xffffu));
    }
#pragma unroll
    for (int i = 0; i < 4; ++i) {
        const size_t row = (size_t)(r0 + i);
        const unsigned bwv[4] = {bb[i].x, bb[i].y, bb[i].z, bb[i].w}, gwv[4] = {gg[i].x, gg[i].y, gg[i].z, gg[i].w};
        float o[8];
#pragma unroll
        for (int e = 0; e < 8; ++e) {
            const float bv = (e & 1) ? bf2f(bwv[e >> 1] >> 16) : bf2f(bwv[e >> 1] & 0xffffu);
            const float gv = (e & 1) ? bf2f(gwv[e >> 1] >> 16) : bf2f(gwv[e >> 1] & 0xffffu);
            const float y = T[i][e] * w0[e] + T[i + 1][e] * w1[e] + T[i + 2][e] * w2[e] + bs[e];
            o[e] = bv * y * silu_f(gv);
        }
        u32x4 w; w.x = pkbf(o[0], o[1]); w.y = pkbf(o[2], o[3]); w.z = pkbf(o[4], o[5]); w.w = pkbf(o[6], o[7]);
        *(u32x4*)(H + row * DM + 768 + ch0) = w;
    }
}

#define XB_TMO      128
#define XB_XCNT(j)  (256  + 64 * (j))
#define XB_XSUB(j)  (1280 + 64 * (j))
#define XB_XGEN(j)  (2304 + 64 * (j))
#define XB_TOP      3328
#define XB_TOPGEN   3392
#define XCD_BAR_WORDS 3456
#define XB_SPIN_CAP (1u << 18)

__device__ __forceinline__ unsigned xb_ld(unsigned* p)              { return __hip_atomic_load(p, __ATOMIC_RELAXED, __HIP_MEMORY_SCOPE_AGENT); }
__device__ __forceinline__ unsigned xb_add(unsigned* p, unsigned v) { return __hip_atomic_fetch_add(p, v, __ATOMIC_RELAXED, __HIP_MEMORY_SCOPE_AGENT); }
__device__ __forceinline__ unsigned xb_xcc_id() { return (unsigned)__builtin_amdgcn_s_getreg((3 << 11) | 20) & 0xFu; }
#define XB_SPIN(cond, bar) do { unsigned _sp = 0; while (cond) { __builtin_amdgcn_s_sleep(1); \
    if ((++_sp & 255u) == 0u) { if (xb_ld(&(bar)[XB_TMO])) break; if (_sp > XB_SPIN_CAP) { atomicAdd(&(bar)[XB_TMO], 1u); break; } } } } while (0)

struct XcdBarrier {
    unsigned* bar; unsigned x;
    volatile LAS unsigned* st;
};

__device__ __forceinline__ XcdBarrier xcd_barrier_post(unsigned* bar, volatile LAS unsigned* st) {
    XcdBarrier b; b.bar = bar; b.x = xb_xcc_id(); b.st = st;
    if (threadIdx.x == 0) (void)xb_add(&bar[XB_XCNT(b.x)], 1u);
    return b;
}
__device__ __forceinline__ void xcd_barrier_complete(unsigned* bar, unsigned x, unsigned& nloc, unsigned& nx) {
    const unsigned G = gridDim.x * gridDim.y * gridDim.z;
    unsigned sum, cnt, mine, sp = 0u;
    for (;;) {
        sum = 0u; cnt = 0u; mine = 0u;
#pragma unroll
        for (unsigned j = 0; j < 16; ++j) { const unsigned c = xb_ld(&bar[XB_XCNT(j)]); sum += c; cnt += (c > 0u) ? 1u : 0u; mine = (j == x) ? c : mine; }
        if (sum == G) break;
        __builtin_amdgcn_s_sleep(1);
        if ((++sp & 255u) == 0u) { if (xb_ld(&bar[XB_TMO])) break; if (sp > XB_SPIN_CAP) { atomicAdd(&bar[XB_TMO], 1u); break; } }
    }
    nloc = mine > 0u ? mine : 1u; nx = cnt > 0u ? cnt : 1u;
}

__device__ __forceinline__ void xcd_barrier(const XcdBarrier& b) {
    asm volatile("s_waitcnt vmcnt(0)" ::: "memory");
    __syncthreads();
    if (threadIdx.x == 0) {
        unsigned* bar = b.bar;
        __builtin_amdgcn_s_waitcnt(0);
        unsigned nloc = b.st[0], nx = b.st[1];
        if (nloc == 0u) { xcd_barrier_complete(bar, b.x, nloc, nx); b.st[0] = nloc; b.st[1] = nx; }
        const unsigned old = xb_add(&bar[XB_XSUB(b.x)], 1u);
        const unsigned gen = old / nloc;
        if (old + 1u == (gen + 1u) * nloc) {
            __builtin_amdgcn_fence(__ATOMIC_RELEASE, "agent");
            asm volatile("s_waitcnt vmcnt(0)" ::: "memory");
            const unsigned og = xb_add(&bar[XB_TOP], 1u);
            const unsigned tg = og / nx;
            if (og + 1u == (tg + 1u) * nx) xb_add(&bar[XB_TOPGEN], 1u);
            else XB_SPIN(xb_ld(&bar[XB_TOPGEN]) == tg, bar);
            __builtin_amdgcn_fence(__ATOMIC_ACQUIRE, "agent");
            xb_add(&bar[XB_XGEN(b.x)], 1u);
            asm volatile("s_waitcnt vmcnt(0)" ::: "memory");
        } else {
            XB_SPIN(xb_ld(&bar[XB_XGEN(b.x)]) == gen, bar);
            __builtin_amdgcn_fence(__ATOMIC_ACQUIRE, "agent");
            asm volatile("s_waitcnt vmcnt(0)" ::: "memory");
        }
    }
    __syncthreads();
}

__device__ __forceinline__ int next_unit(unsigned* ctr, unsigned char* lds) {
    volatile int* sw = (volatile int*)(lds + LDS_SCHED);
    if (threadIdx.x == 0) *sw = (int)atomicAdd(ctr, 1u);
    __syncthreads();
    const int u = *sw;
    __syncthreads();
    return u;
}

__global__ void __launch_bounds__(NTHREADS, 2) hybrid_fwd(KArgs a) {
    extern __shared__ __attribute__((aligned(16))) unsigned char lds[];
    cg::grid_group grid = cg::this_grid();
    unsigned char* ws = a.ws;
    const int lo = a.ph_lo, hi = a.ph_hi;
#ifndef PHMASK
#define PHMASK 0xfff
#endif
#define IN(k) (((PHMASK >> ((k) > 5 && (k) < 11 ? (k) - 5 : (k))) & 1) && lo <= (k) && (k) < hi)
#define SEAM(k) do { if (IN(k) && IN((k) + 1)) xcd_barrier(xbar); } while (0)
#ifndef REP_PHASE
#define REP_PHASE -1
#endif
#define REPS(j) for (int rep = 0, nrep = (REP_PHASE == (j)) ? 2 : 1; rep < nrep; ++rep, (rep < nrep ? xcd_barrier(xbar) : (void)0))
    bf16_t* HX = (bf16_t*)(ws + WS_HX); bf16_t* Pb = (bf16_t*)(ws + WS_P); bf16_t* Vt = (bf16_t*)(ws + WS_VT); bf16_t* Hb = (bf16_t*)(ws + WS_H);
    bf16_t* Yb = (bf16_t*)(ws + WS_Y); bf16_t* YF = (bf16_t*)(ws + WS_YF); float* SSQ = (float*)(ws + WS_SSQ);
    unsigned* ctl = (unsigned*)(ws + WS_CTL);

    if (threadIdx.x < 2) ((volatile LAS unsigned*)(lds + LDS_BARST))[threadIdx.x] = 0u;
    __syncthreads();
    const XcdBarrier xbar = xcd_barrier_post((unsigned*)(ws + WS_BAR), (volatile LAS unsigned*)(lds + LDS_BARST));
    if (a.ph_lo < 0) grid.sync();
    REPS(30) if (IN(0)) p0_prologue(a, lds);
    SEAM(0);
    for (int l = 0; l < 2; ++l) {
        const int pb = 1 + 5 * l;
        REPS(0) if (IN(pb)) norm_phase(a, l);
        SEAM(pb);
        REPS(1) if (IN(pb + 1)) {
            pg8::Gemm g{HX, (const bf16_t*)(ws + WS_WIN) + (size_t)l * PW * DM, MROWS, PW, DM};
            pg8::StaticOrder S; S.init(MROWS, PW, (int)gridDim.x, (int)blockIdx.x);
            pg8::EpiProj E{Pb, Vt, (const float*)(ws + WS_ROPE), (bf16_t*)(ws + WS_UFP), 0.125f * LOG2E};
            pg8::gemm_phase<pg8::EpiProj, pg8::StaticOrder, true, true>((PG8_LAS unsigned char*)lds, g, S, E);
        }
        SEAM(pb + 1);
        for (int rep = 0, nrep = (REP_PHASE >= 20 && REP_PHASE < 30) ? 2 : 1; rep < nrep; ++rep, (rep < nrep ? xcd_barrier(xbar) : (void)0)) if (IN(pb + 2)) {
            const int nAttn = (l == 0) ? 1056 : 1024, nCtxF = (l == 0) ? 16 : 0, nF1 = 256, nConv = ((l == 0) ? MROWS : NTOK) / 64;
            const int e0 = nF1, e1 = e0 + nCtxF, e2 = e1 + nAttn, e3 = e2 + nConv;
            for (;;) {
                const int u = next_unit(ctl + 2 * l + 8 * rep, lds);
                if (u >= e3) break;
                if (rep == 1) { const int ty = u < e0 ? 1 : u < e1 ? 3 : u < e2 ? 0 : 2; if (REP_PHASE == 25 ? (ty == 0) : (ty != REP_PHASE - 20)) continue; }
                if (u >= e1 && u < e2) attn_unit(u - e1, Pb, Vt, Hb, a.sink + 8 * l, lds);
                else if (u >= e0 && u < e1) { const int v = u - e0, b = v >> 2, kb = v & 3;
                    dftf_unit<256>(Pb + (size_t)(NTOK + b * CTXL) * PW + C_UF, 256, PW, 0, (const bf16_t*)(ws + WS_T256R) + (size_t)(64 * kb) * 256, (const bf16_t*)(ws + WS_T256I) + (size_t)(64 * kb) * 256,
                                   (const bf16_t*)(ws + WS_GT) + (size_t)l * 4 * 64 * 128, Pb, Hb, (size_t)(NTOK + b * CTXL + 64 * kb), 1, 5.656854249492381f, lds); }
                else {
                    const int tid = opaque_tid(), lane = tid & 63, wave = __builtin_amdgcn_readfirstlane(tid >> 6);
                    if (u < e0) fft1_wave(u * 8 + wave, (const bf16_t*)(ws + WS_UFP), YF, ws, lds + wave * 16384, lane);
                    else conv_wave((u - e2) * 8 + wave, Pb, Hb, a.conv_w + l * 768, a.conv_b + l * 256, lane);
                }
            }
        }
        SEAM(pb + 2);
        REPS(3) if (IN(pb + 3)) {
            const bool gemmwg = (l == 0 && blockIdx.x < 16);
            if (gemmwg) {
                pg8::Gemm g{Hb + (size_t)NTOK * DM, (const bf16_t*)(ws + WS_WOUT) + (size_t)l * DM * DM, NCTX, DM, DM};
                pg8::StaticOrder S; S.init(NCTX, DM, 16, (int)blockIdx.x);
                pg8::EpiY E{Yb + (size_t)NTOK * DM, SSQ + (size_t)NTOK * 16};
                pg8::gemm_phase<pg8::EpiY, pg8::StaticOrder, true, true>((PG8_LAS unsigned char*)lds, g, S, E);
            } else {
                const int tid = opaque_tid(), lane = tid & 63, wave = __builtin_amdgcn_readfirstlane(tid >> 6);
                const int nb0 = (l == 0) ? 16 : 0;
                const int gw = ((int)blockIdx.x - nb0) + wave * ((int)gridDim.x - nb0), NGW = ((int)gridDim.x - nb0) * 8;
                unsigned char* lds_w = lds + wave * 16384;
                for (int t = gw; t < 2048; t += NGW) fft3_wave(t, YF, (const bf16_t*)(ws + WS_GT) + (size_t)l * 4 * 64 * 128, Pb, Hb, ws, lds_w, lane);
            }
            __syncthreads();
        }
        SEAM(pb + 3);
        REPS(4) if (IN(pb + 4)) {
            pg8::Gemm g{Hb, (const bf16_t*)(ws + WS_WOUT) + (size_t)l * DM * DM, NTOK, DM, DM};
            pg8::StaticOrder S; S.init(NTOK, DM, (int)gridDim.x, (int)blockIdx.x);
            pg8::EpiY E{l == 0 ? Yb : HX, l == 0 ? SSQ : (float*)(ws + WS_SSQ1)};
            pg8::gemm_phase<pg8::EpiY, pg8::StaticOrder, true, true>((PG8_LAS unsigned char*)lds, g, S, E);
        }
        SEAM(pb + 4);
    }
#if REP_PHASE == 9
    for (int i = 0; i < 10; ++i) xcd_barrier(xbar);
#endif
    if (IN(11)) norm_phase(a, 2);
#undef IN
#undef SEAM
}

#ifndef MK_MULTI
#define MK_MULTI 0
#endif
extern "C" void kernel_launch(void* const* d_in, const int* in_sizes, int n_in, void* d_out, int out_size, void* d_ws, size_t ws_size, hipStream_t stream) {
    static int grid = 0;
    if (grid == 0) {
        if (n_in != 14 || ws_size < WS_END) { fprintf(stderr, "kernel_launch: unexpected n_in %d or ws_size %zu (need %zu)\n", n_in, ws_size, (size_t)WS_END); grid = -1; return; }
        int dev = 0, cus = 0, per_cu = 0;
        hipGetDevice(&dev); hipDeviceGetAttribute(&cus, hipDeviceAttributeMultiprocessorCount, dev);
        if (hipFuncSetAttribute((const void*)hybrid_fwd, hipFuncAttributeMaxDynamicSharedMemorySize, LDS_BYTES) != hipSuccess) { fprintf(stderr, "kernel_launch: hipFuncSetAttribute failed\n"); grid = -1; return; }
        if (hipOccupancyMaxActiveBlocksPerMultiprocessor(&per_cu, (const void*)hybrid_fwd, NTHREADS, LDS_BYTES) != hipSuccess || per_cu < 1) { fprintf(stderr, "kernel_launch: occupancy query gave %d\n", per_cu); per_cu = 1; }
        (void)hipGetLastError();
        grid = cus * 1;
        fprintf(stderr, "kernel_launch: grid %d (cus %d, per_cu %d)\n", grid, cus, per_cu);
    }
    if (grid < 0) return;
    if (hipMemsetAsync((char*)d_ws + WS_CTL, 0, WS_ZERO_BYTES, stream) != hipSuccess) { fprintf(stderr, "kernel_launch: hipMemsetAsync failed\n"); return; }
    KArgs a{};
    a.x = (const float*)d_in[0]; a.c = (const float*)d_in[1]; a.ctx = (const float*)d_in[2]; a.c_ctx = (const float*)d_in[3]; a.w_mod = (const float*)d_in[4]; a.b_mod = (const float*)d_in[5];
    a.g_pre = (const float*)d_in[6]; a.g_post = (const float*)d_in[7]; a.w_in = (const float*)d_in[8]; a.w_out = (const float*)d_in[9]; a.sink = (const float*)d_in[10]; a.w_f = (const float*)d_in[11];
    a.conv_w = (const float*)d_in[12]; a.conv_b = (const float*)d_in[13];
    a.out = (float*)d_out; a.ws = (unsigned char*)d_ws;
#if MK_MULTI
    for (int ph = 0; ph < 12; ++ph) { a.ph_lo = ph; a.ph_hi = ph + 1; hipLaunchKernelGGL(hybrid_fwd, dim3(grid), dim3(NTHREADS), LDS_BYTES, stream, a); }
#else
    a.ph_lo = 0; a.ph_hi = 12;
    void* args[] = {&a};
    hipError_t e = hipLaunchCooperativeKernel((const void*)hybrid_fwd, dim3(grid), dim3(NTHREADS), args, LDS_BYTES, stream);
    if (e != hipSuccess) fprintf(stderr, "kernel_launch: cooperative launch failed: %s (grid %d)\n", hipGetErrorString(e), grid);
#endif
}
```

```cpp
#include <hip/hip_runtime.h>
#include <hip/hip_cooperative_groups.h>
#include <cstdio>
#include <cstdint>
namespace cg = cooperative_groups;
namespace pg8 {
#define PG8_LAS __attribute__((address_space(3)))
typedef unsigned short bf16_t;
typedef short bf16x8 __attribute__((ext_vector_type(8)));
typedef float f32x4 __attribute__((ext_vector_type(4)));
typedef unsigned u32x4 __attribute__((ext_vector_type(4)));
constexpr int BM = 256, BK = 64, HALF = 128, HTB = HALF * BK * 2  , STAGE_BYTES = 8 * HTB, NXCD = 8, WGM = 8;

__host__ __device__ __forceinline__ int lds_byte(int r, int c) { const int st = (r >> 4) * 2 + (c >> 5), rr = r & 15, cc = c & 31, ob = rr * 64 + cc * 2; return st * 1024 + (ob ^ (((ob >> 9) & 1) << 5)); }
__host__ __device__ __forceinline__ void stage_rc(int b, int& R, int& C) { const int st = b / 1024, sb = b % 1024, swz = sb ^ (((sb >> 9) & 1) << 5); R = (st >> 1) * 16 + swz / 64; C = (st & 1) * 32 + (swz % 64) / 2; }
__host__ __device__ __forceinline__ int perm32(int rho) { const int n = rho >> 4, i = rho & 15; return 8 * (i >> 2) + 4 * n + (i & 3); }

struct Unit { int pm, pn; };
struct Gemm { const bf16_t* A; const bf16_t* Bt; int M, N, K; };

struct StaticOrder {
    int nM, nN, nwg, G, c;
    __host__ __device__ void init(int M, int N, int G_, int c_) { nM = M / BM; nN = N / BM; nwg = nM * nN; G = G_; c = c_; }
    __host__ __device__ bool next(int i, Unit& u) const {
        const long L = (long)i * G + c; if (L >= nwg) return false;
        int wgid = (int)L; { const int q = nwg / NXCD, r = nwg % NXCD, xcd = wgid % NXCD, off = wgid / NXCD; wgid = (xcd < r ? xcd * (q + 1) : r * (q + 1) + (xcd - r) * q) + off; }
        const int nig = WGM * nN, gid = wgid / nig, fm = gid * WGM, gsz = (nM - fm) < WGM ? (nM - fm) : WGM;
        u.pm = fm + ((wgid % nig) % gsz); u.pn = (wgid % nig) / gsz; return true;
    }
    __device__ __forceinline__ void a_ready(const Unit&) const {}
    __device__ __forceinline__ void done(const Unit&) const {}
};

__device__ __forceinline__ unsigned cvt_pk_bf16(float lo, float hi) { unsigned r; asm volatile("v_cvt_pk_bf16_f32 %0, %1, %2" : "=v"(r) : "v"(lo), "v"(hi)); return r; }
typedef unsigned u32x2 __attribute__((ext_vector_type(2)));
__device__ __forceinline__ int swap23(int t) { return (t & ~12) | ((t & 4) << 1) | ((t & 8) >> 1); }
struct EpiProj {
    static constexpr bool PERM = true, AFTER_DRAIN = false;
    bf16_t* P; bf16_t* Vt; const float* rope; bf16_t* UFP; float qscale;
    __device__ __forceinline__ void operator()(const f32x4 (&acc)[2][2][4][2], const Unit& u, int wr, int wc, int fr, int fq) const {
        const int row0 = u.pm * BM + wr * 64 + fr;
        const int pn = u.pn;
        const bool ctxrow = u.pm >= 128;
        f32x4 CS[2][4], SN[2][4];
        if (pn <= 2) {
#pragma unroll
            for (int ai = 0; ai < 2; ++ai)
#pragma unroll
                for (int m = 0; m < 4; ++m) {
                    CS[ai][m] = (f32x4){1.f, 1.f, 1.f, 1.f}; SN[ai][m] = (f32x4){0.f, 0.f, 0.f, 0.f};
                    if (!ctxrow) { const int t = (row0 + ai * HALF + m * 16) & 8191; const int pos = (wc & 1) ? (t & 63) : (t >> 6);
                        CS[ai][m] = *(const f32x4*)(rope + pos * 32 + 4 * fq); SN[ai][m] = *(const f32x4*)(rope + pos * 32 + 16 + 4 * fq); }
                }
            __builtin_amdgcn_sched_barrier(0);
        }
#pragma unroll
        for (int ai = 0; ai < 2; ++ai)
#pragma unroll
            for (int m = 0; m < 4; ++m) {
                const int row = row0 + ai * HALF + m * 16;
                bf16_t* rowp = P + (size_t)row * 2816 + pn * BM + wc * 32 + 8 * fq;
                if (pn == 5 && !ctxrow) { const int t = row & 8191; rowp = UFP + ((size_t)(((row >> 13) * 64 + (t & 63)) * 128 + (t >> 6))) * 256 + wc * 32 + 8 * fq; }
                if (pn > 2) {
#pragma unroll
                    for (int bj = 0; bj < 2; ++bj) { const f32x4 v0 = acc[ai][bj][m][0], v1 = acc[ai][bj][m][1];
                        u32x4 w; w.x = cvt_pk_bf16(v0[0], v0[1]); w.y = cvt_pk_bf16(v0[2], v0[3]); w.z = cvt_pk_bf16(v1[0], v1[1]); w.w = cvt_pk_bf16(v1[2], v1[3]);
                        *(u32x4*)(rowp + bj * HALF) = w; }
                } else {
                    const f32x4 cs = CS[ai][m], sn = SN[ai][m];
#pragma unroll
                    for (int bj = 0; bj < 2; ++bj) {
                        f32x4 v0 = acc[ai][bj][m][0], v1 = acc[ai][bj][m][1];
                        if (pn == 2 && bj == 1) {
                            int b, tok; if (ctxrow) { const int rr = row - 32768; b = rr >> 8; tok = 8192 + (rr & 255); } else { b = row >> 13; tok = row & 8191; }
                            const int ptok = swap23(tok);
                            bf16_t* vp = Vt + ((size_t)((b * 2 + (wc >> 1)) * 64 + 32 * (wc & 1) + 8 * fq)) * 8448 + ptok;
                            const unsigned w0 = cvt_pk_bf16(v0[0], v0[1]), w1 = cvt_pk_bf16(v0[2], v0[3]), w2 = cvt_pk_bf16(v1[0], v1[1]), w3 = cvt_pk_bf16(v1[2], v1[3]);
                            vp[0 * 8448] = (bf16_t)(w0 & 0xffffu); vp[1 * 8448] = (bf16_t)(w0 >> 16); vp[2 * 8448] = (bf16_t)(w1 & 0xffffu); vp[3 * 8448] = (bf16_t)(w1 >> 16);
                            vp[4 * 8448] = (bf16_t)(w2 & 0xffffu); vp[5 * 8448] = (bf16_t)(w2 >> 16); vp[6 * 8448] = (bf16_t)(w3 & 0xffffu); vp[7 * 8448] = (bf16_t)(w3 >> 16);
                        } else {
                            const f32x4 r0 = v0 * cs - v1 * sn, r1 = v0 * sn + v1 * cs;
                            v0 = r0; v1 = r1;
                            if (pn < 2) { v0 = v0 * qscale; v1 = v1 * qscale; }
                            u32x4 w; w.x = cvt_pk_bf16(v0[0], v0[1]); w.y = cvt_pk_bf16(v0[2], v0[3]); w.z = cvt_pk_bf16(v1[0], v1[1]); w.w = cvt_pk_bf16(v1[2], v1[3]);
                            *(u32x4*)(rowp + bj * HALF) = w;
                        }
                    }
                }
            }
    }
};
struct EpiY {
    static constexpr bool PERM = true, AFTER_DRAIN = false;
    bf16_t* Y; float* ssq;
    __device__ __forceinline__ void operator()(const f32x4 (&acc)[2][2][4][2], const Unit& u, int wr, int wc, int fr, int fq) const {
        const int row0 = u.pm * BM + wr * 64 + fr;
#pragma unroll
        for (int ai = 0; ai < 2; ++ai)
#pragma unroll
            for (int m = 0; m < 4; ++m) {
                const int row = row0 + ai * HALF + m * 16;
                bf16_t* rowp = Y + (size_t)row * 1024 + u.pn * BM + wc * 32 + 8 * fq;
                float s = 0.f;
#pragma unroll
                for (int bj = 0; bj < 2; ++bj) { const f32x4 v0 = acc[ai][bj][m][0], v1 = acc[ai][bj][m][1];
                    s += (v0[0] * v0[0] + v0[1] * v0[1]) + (v0[2] * v0[2] + v0[3] * v0[3]) + (v1[0] * v1[0] + v1[1] * v1[1]) + (v1[2] * v1[2] + v1[3] * v1[3]);
                    u32x4 w; w.x = cvt_pk_bf16(v0[0], v0[1]); w.y = cvt_pk_bf16(v0[2], v0[3]); w.z = cvt_pk_bf16(v1[0], v1[1]); w.w = cvt_pk_bf16(v1[2], v1[3]);
                    *(u32x4*)(rowp + bj * HALF) = w; }
                s += __shfl_xor(s, 16); s += __shfl_xor(s, 32);
                if (fq == 0) ssq[(size_t)row * 16 + u.pn * 4 + wc] = s;
            }
    }
};
template <class Epi, class Sched, bool ALIGN_EPI = false, bool SP2 = false>
__device__ __forceinline__ void gemm_phase(PG8_LAS unsigned char* lds, const Gemm g, const Sched& S, const Epi& E) {
    int tid_ = threadIdx.x; asm volatile("" : "+v"(tid_));
    const int tid = tid_, wid = __builtin_amdgcn_readfirstlane(tid >> 6), lane = tid & 63, wr = wid >> 2, wc = wid & 3, fr = lane & 15, fq = lane >> 4;
    const int K = g.K, nt = K / BK;
    unsigned voffA[2], voffB[2];
#pragma unroll
    for (int i = 0; i < 2; ++i) { int R, C; stage_rc(tid * 16 + i * 8192, R, C); const int Rb = Epi::PERM ? ((R & ~31) + perm32(R & 31)) : R;
        voffA[i] = (unsigned)(R * K + C) * 2u; voffB[i] = (unsigned)(Rb * K + C) * 2u; }
    const size_t kstep = (size_t)(BK * 2);
    const size_t hstep = (size_t)HALF * K * 2;
    const size_t tstep = 2 * hstep;
    const unsigned ldsw = (unsigned)wid * 1024u;
    const int aoff = lds_byte(wr * 64 + fr, fq * 8), boff = lds_byte(wc * 32 + fr, fq * 8);
#define PG8_SA(b, h) (((b) * 2 + (h)) * HTB)
#define PG8_SB(b, h) ((4 + (b) * 2 + (h)) * HTB)
#define PG8_STAGE(bufoff, gbase, voff) do { _Pragma("unroll") for (int _i = 0; _i < 2; ++_i) \
        __builtin_amdgcn_global_load_lds((const unsigned*)((const char*)(gbase) + (voff)[_i]), (PG8_LAS unsigned*)(lds + (bufoff) + ldsw + _i * 8192), 16, 0, 0); } while (0)
#define PG8_LDA(dst, b, h) do { _Pragma("unroll") for (int m = 0; m < 4; ++m) _Pragma("unroll") for (int k = 0; k < 2; ++k) dst[m][k] = *(const PG8_LAS bf16x8*)(lds + PG8_SA(b, h) + aoff + m * 2048 + k * 1024); } while (0)
#define PG8_LDB(dst, b, h) do { _Pragma("unroll") for (int n = 0; n < 2; ++n) _Pragma("unroll") for (int k = 0; k < 2; ++k) dst[n][k] = *(const PG8_LAS bf16x8*)(lds + PG8_SB(b, h) + boff + n * 2048 + k * 1024); } while (0)
#define PG8_MMA(ai, bj, At, Bt) do { __builtin_amdgcn_s_setprio(1); _Pragma("unroll") for (int m = 0; m < 4; ++m) _Pragma("unroll") for (int n = 0; n < 2; ++n) _Pragma("unroll") for (int k = 0; k < 2; ++k) \
        acc[ai][bj][m][n] = __builtin_amdgcn_mfma_f32_16x16x32_bf16(Bt[n][k], At[m][k], acc[ai][bj][m][n], 0, 0, 0); __builtin_amdgcn_s_setprio(0); } while (0)
#define PG8_WAIT_V(n) asm volatile("s_waitcnt vmcnt(" #n ")" ::: "memory")
#define PG8_WAIT_L(n) asm volatile("s_waitcnt lgkmcnt(" #n ")" ::: "memory")
#define PG8_BAR __builtin_amdgcn_s_barrier()
#define PG8_SCHED __builtin_amdgcn_sched_barrier(0)
    Unit cur, nxt; int ui = 0;
    if (!S.next(0, cur)) return;
    f32x4 acc[2][2][4][2];
#pragma unroll
    for (int a = 0; a < 2; ++a)
#pragma unroll
        for (int b = 0; b < 2; ++b)
#pragma unroll
            for (int m = 0; m < 4; ++m)
#pragma unroll
                for (int n = 0; n < 2; ++n) acc[a][b][m][n] = (f32x4){0.f, 0.f, 0.f, 0.f};
    bf16x8 At[4][2], B0[2][2], B1[2][2];
    const char* cA = (const char*)g.A + (size_t)cur.pm * tstep; const char* cB = (const char*)g.Bt + (size_t)cur.pn * tstep;
    S.a_ready(cur);
    if constexpr (SP2) {
        PG8_STAGE(PG8_SB(0, 0), cB, voffB); PG8_STAGE(PG8_SB(0, 1), cB + hstep, voffB); PG8_STAGE(PG8_SA(0, 0), cA, voffA); PG8_STAGE(PG8_SA(0, 1), cA + hstep, voffA);
        if (wr == 1) PG8_BAR;
        PG8_WAIT_V(2); PG8_BAR;
        PG8_STAGE(PG8_SB(1, 0), cB + kstep, voffB); PG8_STAGE(PG8_SA(1, 0), cA + kstep, voffA); PG8_STAGE(PG8_SB(1, 1), cB + hstep + kstep, voffB);
        PG8_WAIT_V(6); PG8_BAR;
    } else {
        PG8_STAGE(PG8_SB(0, 0), cB, voffB); PG8_STAGE(PG8_SA(0, 0), cA, voffA); PG8_STAGE(PG8_SB(0, 1), cB + hstep, voffB); PG8_STAGE(PG8_SA(0, 1), cA + hstep, voffA);
        if (wr == 1) PG8_BAR;
        PG8_WAIT_V(4); PG8_BAR;
        PG8_STAGE(PG8_SB(1, 0), cB + kstep, voffB); PG8_STAGE(PG8_SA(1, 0), cA + kstep, voffA); PG8_STAGE(PG8_SB(1, 1), cB + hstep + kstep, voffB);
        PG8_WAIT_V(6); PG8_BAR;
    }
    for (;;) {
        const bool has_next = S.next(ui + 1, nxt);
        const char* nA = has_next ? (const char*)g.A + (size_t)nxt.pm * tstep : cA; const char* nB = has_next ? (const char*)g.Bt + (size_t)nxt.pn * tstep : cB;
        for (int t = 0; t < nt; t += 2) {
            const bool last = (t == nt - 2);
            const char* a1 = cA + (size_t)(t + 1) * kstep;
            const char* a2 = last ? nA : cA + (size_t)(t + 2) * kstep; const char* b2 = last ? nB : cB + (size_t)(t + 2) * kstep;
            const char* a3 = a2 + kstep; const char* b3 = b2 + kstep;
            if (last && has_next) S.a_ready(nxt);
            if constexpr (SP2) {
            PG8_LDB(B0, 0, 0); PG8_LDB(B1, 0, 1); PG8_SCHED; PG8_LDA(At, 0, 0); PG8_STAGE(PG8_SA(1, 1), a1 + hstep, voffA);
            PG8_WAIT_V(8); PG8_WAIT_L(0); PG8_BAR; PG8_MMA(0, 0, At, B0); PG8_MMA(0, 1, At, B1); PG8_BAR; PG8_SCHED;
            PG8_LDA(At, 0, 1); PG8_STAGE(PG8_SB(0, 0), b2, voffB); PG8_STAGE(PG8_SB(0, 1), b2 + hstep, voffB); PG8_STAGE(PG8_SA(0, 0), a2, voffA);
            PG8_WAIT_V(8); PG8_WAIT_L(0); PG8_BAR; PG8_MMA(1, 0, At, B0); PG8_MMA(1, 1, At, B1); PG8_BAR; PG8_SCHED;
            PG8_LDB(B0, 1, 0); PG8_LDB(B1, 1, 1); PG8_SCHED; PG8_LDA(At, 1, 0); PG8_STAGE(PG8_SA(0, 1), a2 + hstep, voffA);
            PG8_WAIT_V(8); PG8_WAIT_L(0); PG8_BAR; PG8_MMA(0, 0, At, B0); PG8_MMA(0, 1, At, B1); PG8_BAR; PG8_SCHED;
            PG8_LDA(At, 1, 1); PG8_STAGE(PG8_SB(1, 0), b3, voffB); PG8_STAGE(PG8_SB(1, 1), b3 + hstep, voffB); PG8_STAGE(PG8_SA(1, 0), a3, voffA);
            PG8_WAIT_V(8); PG8_WAIT_L(0); PG8_BAR; PG8_MMA(1, 0, At, B0); PG8_MMA(1, 1, At, B1); PG8_BAR; PG8_SCHED;
            } else {
            PG8_LDB(B0, 0, 0); PG8_SCHED; PG8_LDA(At, 0, 0); PG8_STAGE(PG8_SA(1, 1), a1 + hstep, voffA);
            PG8_WAIT_L(8); PG8_BAR; PG8_WAIT_L(0); PG8_MMA(0, 0, At, B0); PG8_BAR; PG8_SCHED;
            PG8_LDB(B1, 0, 1); PG8_STAGE(PG8_SB(0, 0), b2, voffB);
            PG8_BAR; PG8_WAIT_L(0); PG8_MMA(0, 1, At, B1); PG8_BAR;
            PG8_LDA(At, 0, 1); PG8_STAGE(PG8_SA(0, 0), a2, voffA);
            PG8_BAR; PG8_WAIT_L(0); PG8_MMA(1, 0, At, B0); PG8_BAR; PG8_SCHED;
            PG8_STAGE(PG8_SB(0, 1), b2 + hstep, voffB);
            PG8_WAIT_V(6); PG8_BAR; PG8_MMA(1, 1, At, B1); PG8_BAR;
            PG8_LDB(B0, 1, 0); PG8_SCHED; PG8_LDA(At, 1, 0); PG8_STAGE(PG8_SA(0, 1), a2 + hstep, voffA);
            PG8_WAIT_L(8); PG8_BAR; PG8_WAIT_L(0); PG8_MMA(0, 0, At, B0); PG8_BAR; PG8_SCHED;
            PG8_LDB(B1, 1, 1); PG8_STAGE(PG8_SB(1, 0), b3, voffB);
            PG8_BAR; PG8_WAIT_L(0); PG8_MMA(0, 1, At, B1); PG8_BAR;
            PG8_LDA(At, 1, 1); PG8_STAGE(PG8_SA(1, 0), a3, voffA);
            PG8_BAR; PG8_WAIT_L(0); PG8_MMA(1, 0, At, B0); PG8_BAR; PG8_SCHED;
            PG8_STAGE(PG8_SB(1, 1), b3 + hstep, voffB);
            PG8_WAIT_V(6); PG8_BAR; PG8_MMA(1, 1, At, B1); PG8_BAR;
            }
        }
        if constexpr (ALIGN_EPI) { if (wr == 0) PG8_BAR; }
        if constexpr (!Epi::AFTER_DRAIN) { E(acc, cur, wr, wc, fr, fq); S.done(cur); }
        if (!has_next) break;
#pragma unroll
        for (int a = 0; a < 2; ++a)
#pragma unroll
            for (int b = 0; b < 2; ++b)
#pragma unroll
                for (int m = 0; m < 4; ++m)
#pragma unroll
                    for (int n = 0; n < 2; ++n) acc[a][b][m][n] = (f32x4){0.f, 0.f, 0.f, 0.f};
        cur = nxt; cA = nA; cB = nB; ++ui;
        if constexpr (ALIGN_EPI) { if (wr == 1) PG8_BAR; }
    }
    PG8_WAIT_V(0);
    if constexpr (!ALIGN_EPI) { if (wr == 0) PG8_BAR; }
    PG8_BAR;
    if constexpr (Epi::AFTER_DRAIN) { E.fused(acc, cur, wr, wc, fr, fq, lds, wid, lane); S.done(cur); }
#undef PG8_SA
#undef PG8_SB
#undef PG8_STAGE
#undef PG8_LDA
#undef PG8_LDB
#undef PG8_MMA
#undef PG8_WAIT_V
#undef PG8_WAIT_L
#undef PG8_BAR
#undef PG8_SCHED
}
}

typedef unsigned short bf16_t;
typedef short bf16x8 __attribute__((ext_vector_type(8)));
typedef float f32x4 __attribute__((ext_vector_type(4)));
typedef float f32x16 __attribute__((ext_vector_type(16)));
typedef unsigned u32x4 __attribute__((ext_vector_type(4)));
typedef unsigned u32x2 __attribute__((ext_vector_type(2)));
#define LAS __attribute__((address_space(3)))
__device__ __forceinline__ int opaque_tid() { int t = threadIdx.x; asm volatile("" : "+v"(t)); return t; }

constexpr int DM = 1024, NBATCH = 4, SEQ = 8192, NTOK = NBATCH * SEQ, CTXL = 256, NCTX = NBATCH * CTXL, MROWS = NTOK + NCTX;
constexpr int PW = 2816;
constexpr int C_Q = 0, C_K = 512, C_V = 640, C_GA = 768, C_UF = 1280, C_GF = 1536, C_ZC = 1792, C_BC = 2048, C_CC = 2304, C_GC = 2560;
constexpr int VT_PITCH = SEQ + CTXL;
constexpr float NORM_EPS = 1e-6f;
constexpr float LOG2E = 1.4426950408889634f;

constexpr size_t KiB = 1024, MiB = 1u << 20;
constexpr size_t WS_CTL = 0;
constexpr size_t WS_BAR = 16 * KiB;
constexpr size_t WS_ZERO_BYTES = 32 * KiB;
constexpr size_t WS_MOD = 64 * KiB;
constexpr size_t WS_ROPE = 256 * KiB;
constexpr size_t WS_TW = 320 * KiB;
constexpr size_t WS_T1R = 384 * KiB, WS_T1I = 416 * KiB;
constexpr size_t WS_T3R = 448 * KiB, WS_T3I = 464 * KiB;
constexpr size_t WS_T256R = 512 * KiB, WS_T256I = 640 * KiB;
constexpr size_t WS_GT = 768 * KiB;
constexpr size_t WS_SSQ = 1 * MiB;
constexpr size_t WS_WIN = 4 * MiB;
constexpr size_t WS_WOUT = 16 * MiB;
constexpr size_t WS_SSQ1 = 24 * MiB;
constexpr size_t WS_MODP = 28 * MiB;
constexpr size_t WS_HX = 32 * MiB;
constexpr size_t WS_P = 112 * MiB;
constexpr size_t WS_VT = 304 * MiB;
constexpr size_t WS_H = 320 * MiB;
constexpr size_t WS_Y = 392 * MiB;
constexpr size_t WS_YF = 464 * MiB;
constexpr size_t WS_CTX1 = 100 * MiB;
constexpr size_t WS_UFP = 496 * MiB;
constexpr size_t WS_END = 512 * MiB;
static_assert(WS_BAR + 3456 * 4 <= WS_ZERO_BYTES && WS_MODP + (size_t)2 * 8 * 5 * 3072 * 4 <= WS_HX && WS_SSQ + (size_t)MROWS * 16 * 4 <= WS_WIN && WS_WIN + (size_t)2 * PW * DM * 2 <= WS_WOUT && WS_HX + (size_t)MROWS * DM * 2 <= WS_P && WS_P + (size_t)MROWS * PW * 2 <= WS_VT &&
              WS_VT + (size_t)8 * 64 * VT_PITCH * 2 <= WS_H && WS_H + (size_t)MROWS * DM * 2 <= WS_Y && WS_Y + (size_t)MROWS * DM * 2 <= WS_YF && WS_YF + (size_t)4 * 128 * 64 * 512 * 2 <= WS_UFP && WS_UFP + (size_t)NTOK * 256 * 2 <= WS_END && WS_HX + (size_t)MROWS * DM * 2 <= WS_CTX1 && WS_CTX1 + (size_t)NCTX * DM * 4 <= WS_P, "ws map");

constexpr int LDS_BYTES = 147456;
constexpr int LDS_SCHED = LDS_BYTES - 64;
constexpr int LDS_BARST = LDS_BYTES - 32;
constexpr int NTHREADS = 512;

__device__ __forceinline__ float bf2f(unsigned h) { return __uint_as_float(h << 16); }
__device__ __forceinline__ unsigned pkbf(float lo, float hi) { unsigned r; asm volatile("v_cvt_pk_bf16_f32 %0, %1, %2" : "=v"(r) : "v"(lo), "v"(hi)); return r; }
__device__ __forceinline__ float silu_f(float x) { return x * __builtin_amdgcn_rcpf(1.f + __builtin_amdgcn_exp2f(-x * LOG2E)); }
__device__ __forceinline__ float wave_sum(float v) {
#pragma unroll
    for (int o = 1; o < 64; o <<= 1) v += __shfl_xor(v, o);
    return v;
}
__device__ __forceinline__ int swap23(int t) { return (t & ~12) | ((t & 4) << 1) | ((t & 8) >> 1); }
__device__ __forceinline__ int crow(int r, int hi) { return (r & 3) + 8 * (r >> 2) + 4 * hi; }
__device__ __forceinline__ bf16x8 pack8(const f32x16& p, int base) {
    u32x4 w; w.x = pkbf(p[base + 0], p[base + 1]); w.y = pkbf(p[base + 2], p[base + 3]); w.z = pkbf(p[base + 4], p[base + 5]); w.w = pkbf(p[base + 6], p[base + 7]);
    return __builtin_bit_cast(bf16x8, w);
}
#define MFMA32(a, b, c) __builtin_amdgcn_mfma_f32_32x32x16_bf16((a), (b), (c), 0, 0, 0)

struct KArgs {
    const float *x, *c, *ctx, *c_ctx, *w_mod, *b_mod, *g_pre, *g_post, *w_in, *w_out, *sink, *w_f, *conv_w, *conv_b;
    float* out; unsigned char* ws; int ph_lo, ph_hi;
};

__device__ __forceinline__ int prow_qk(int n) { return (n & ~31) | (8 * ((n >> 2) & 3) + 4 * ((n >> 4) & 1) + (n & 3)); }
__device__ __forceinline__ void p0_transpose_item(const float* W, int K, int N, bf16_t* WT, int nperm, float* scr, int item, int lane) {
    const int nblk = N / 32, kb = item / nblk, nb = item % nblk, k0 = 64 * kb, n0 = 32 * nb;
    { float wv[32];
#pragma unroll
      for (int i = 0; i < 32; ++i) wv[i] = W[(size_t)(k0 + 2 * i + (lane >> 5)) * N + n0 + (lane & 31)];
      __builtin_amdgcn_sched_barrier(0);
#pragma unroll
      for (int i = 0; i < 32; ++i) scr[(2 * i + (lane >> 5)) * 33 + (lane & 31)] = wv[i];
      __builtin_amdgcn_sched_barrier(0); }
    asm volatile("s_waitcnt lgkmcnt(0)" ::: "memory");
    const int c = lane & 7;
#pragma unroll
    for (int j = 0; j < 4; ++j) { const int n = (lane >> 3) + 8 * j; const float* s = scr + (8 * c) * 33 + n;
        u32x4 o; o.x = pkbf(s[0 * 33], s[1 * 33]); o.y = pkbf(s[2 * 33], s[3 * 33]); o.z = pkbf(s[4 * 33], s[5 * 33]); o.w = pkbf(s[6 * 33], s[7 * 33]);
        const int nl = n0 + n; const int np = nl < nperm ? prow_qk(nl) : nl;
        *(u32x4*)(WT + (size_t)np * K + k0 + 8 * c) = o; }
    asm volatile("s_waitcnt lgkmcnt(0)" ::: "memory");
}

__device__ __forceinline__ void p0_mod_gemv(const KArgs& a, int item, float* ldsf) {
    const int tid = opaque_tid(), lane = tid & 63, wave = tid >> 6;
    const int l = item / 96, col0 = (item % 96) * 32;
    float* s = ldsf;
    float* red = ldsf + 5 * 1024;
    for (int i = tid; i < 5 * 1024; i += NTHREADS) { const int bb = i >> 10, k = i & 1023; const float v = bb < 4 ? a.c[bb * 1024 + k] : a.c_ctx[k]; s[i] = v / (1.f + __expf(-v)); }
    __syncthreads();
    const int col = lane & 31, kh = lane >> 5;
    const float* W = a.w_mod + (size_t)l * 1024 * 3072 + (size_t)(wave * 128 + kh) * 3072 + col0 + col;
    float w[64];
#pragma unroll
    for (int i = 0; i < 64; ++i) w[i] = W[(size_t)(2 * i) * 3072];
    float acc[5] = {0.f, 0.f, 0.f, 0.f, 0.f};
#pragma unroll
    for (int i = 0; i < 64; ++i)
#pragma unroll
        for (int bb = 0; bb < 5; ++bb) acc[bb] += w[i] * s[bb * 1024 + wave * 128 + 2 * i + kh];
#pragma unroll
    for (int bb = 0; bb < 5; ++bb) red[((wave * 2 + kh) * 5 + bb) * 32 + col] = acc[bb];
    __syncthreads();
    if (tid < 160) { const int bb = tid >> 5, cc = tid & 31; float v = a.b_mod[l * 3072 + col0 + cc];
#pragma unroll
        for (int ww = 0; ww < 16; ++ww) v += red[(ww * 5 + bb) * 32 + cc];
        ((float*)(a.ws + WS_MOD))[(l * 5 + bb) * 3072 + col0 + cc] = v; }
    __syncthreads();
}

__device__ __forceinline__ void p0_prologue(const KArgs& a, unsigned char* lds) {
    const int tid = opaque_tid(), lane = tid & 63, wave = tid >> 6;
    const int G = gridDim.x, bx = blockIdx.x;
    unsigned char* ws = a.ws;
    if (bx < 192) p0_mod_gemv(a, bx, (float*)lds);
    {
        float* scr = (float*)(lds + wave * 16384);
        const int gw = bx * 8 + wave, NGW = G * 8;
        constexpr int I_IN = (DM / 64) * (PW / 32), I_OUT = (DM / 64) * (DM / 32);
        constexpr int NIT = 2 * (I_IN + I_OUT);
        for (int it = gw; it < NIT; it += NGW) {
            int r = it; const int l = r / (I_IN + I_OUT); r -= l * (I_IN + I_OUT);
            if (r < I_IN) p0_transpose_item(a.w_in + (size_t)l * DM * PW, DM, PW, (bf16_t*)(ws + WS_WIN) + (size_t)l * PW * DM, 640, scr, r, lane);
            else p0_transpose_item(a.w_out + (size_t)l * DM * DM, DM, DM, (bf16_t*)(ws + WS_WOUT) + (size_t)l * DM * DM, 0, scr, r - I_IN, lane);
        }
    }
    const int gt = bx * NTHREADS + tid, NGT = G * NTHREADS;
    for (int i = gt; i < 128 * 16; i += NGT) {
        const int pos = i >> 4, f = i & 15; const float inv = powf(10000.0f, -(float)f / 16.0f); const float ang = (float)pos * inv;
        float* rp = (float*)(ws + WS_ROPE) + pos * 32; rp[f] = cosf(ang); rp[16 + f] = sinf(ang);
    }
    for (int i = gt; i < 8192; i += NGT) { float sn, cs; sincospif((float)i * (2.0f / 8192.0f), &sn, &cs); float* t = (float*)(ws + WS_TW) + 2 * i; t[0] = cs; t[1] = sn; }
    for (int i = gt; i < 128 * 128; i += NGT) { const int k = i >> 7, n = i & 127; float sn, cs; sincospif((float)((k * n) & 127) * (2.0f / 128.0f), &sn, &cs);
        ((bf16_t*)(ws + WS_T1R))[i] = (bf16_t)(pkbf(cs, 0.f) & 0xffffu); ((bf16_t*)(ws + WS_T1I))[i] = (bf16_t)(pkbf(-sn, 0.f) & 0xffffu); }
    for (int i = gt; i < 64 * 128; i += NGT) { const int k = i >> 7, kk = i & 127, n = kk & 63; float sn, cs; sincospif((float)((k * n) & 63) * (2.0f / 64.0f), &sn, &cs);
        const float tr = kk < 64 ? cs : sn, ti = kk < 64 ? -sn : cs;
        ((bf16_t*)(ws + WS_T3R))[i] = (bf16_t)(pkbf(tr, 0.f) & 0xffffu); ((bf16_t*)(ws + WS_T3I))[i] = (bf16_t)(pkbf(ti, 0.f) & 0xffffu); }
    for (int i = gt; i < 256 * 256; i += NGT) { const int k = i >> 8, n = i & 255; float sn, cs; sincospif((float)((k * n) & 255) * (2.0f / 256.0f), &sn, &cs);
        ((bf16_t*)(ws + WS_T256R))[i] = (bf16_t)(pkbf(cs, 0.f) & 0xffffu); ((bf16_t*)(ws + WS_T256I))[i] = (bf16_t)(pkbf(-sn, 0.f) & 0xffffu); }
    {
        __syncthreads();
        float* trig = (float*)lds;
        if (tid < 64) { float sn, cs; sincospif((float)tid * (2.0f / 64.0f), &sn, &cs); trig[tid] = cs; trig[64 + tid] = sn; }
        __syncthreads();
        for (int i = gt; i < 2 * 4 * 64 * 128; i += NGT) {
            const int kk = i & 127, d = (i >> 7) & 63, g = (i >> 13) & 3, l = i >> 15; const int part = kk >> 6, c = swap23(kk & 63);
            const float* wf = a.w_f + ((size_t)(l * 4 + g) * 64) * 64 + d; float sacc = 0.f;
            float wfv[64];
#pragma unroll
            for (int j = 0; j < 64; ++j) wfv[j] = wf[j * 64];
            __builtin_amdgcn_sched_barrier(0);
#pragma unroll
            for (int j = 0; j < 64; ++j) sacc += trig[part * 64 + ((c * j) & 63)] * wfv[j];
            ((bf16_t*)(ws + WS_GT))[i] = (bf16_t)(pkbf(sacc * (1.0f / 724.0773439350246f), 0.f) & 0xffffu);
        }
        __syncthreads();
    }
}

__device__ __forceinline__ void norm_rows4(int mode, int lane, const float* src, float* dst, const bf16_t* y0, const float* ssq0, const bf16_t* y1, const float* ssq1, bf16_t* hx,
                                           const f32x4 (&GA0)[4], const f32x4 (&GA1)[4], const f32x4 (&GB)[4], const f32x4 (&GC)[4]) {
    f32x4 v[4][4];
#pragma unroll
    for (int rr = 0; rr < 4; ++rr)
#pragma unroll
        for (int j = 0; j < 4; ++j) v[rr][j] = *(const f32x4*)(src + (size_t)rr * DM + 4 * lane + 256 * j);
    if (mode != 0) {
        u32x2 yw[4][4], yx[4][4]; float p[4], p1[4];
#pragma unroll
        for (int rr = 0; rr < 4; ++rr) { p[rr] = ssq0[rr * 16 + (lane & 15)];
#pragma unroll
            for (int j = 0; j < 4; ++j) yw[rr][j] = *(const u32x2*)(y0 + (size_t)rr * DM + 4 * lane + 256 * j); }
        if (mode == 2) {
#pragma unroll
            for (int rr = 0; rr < 4; ++rr) { p1[rr] = ssq1[rr * 16 + (lane & 15)];
#pragma unroll
                for (int j = 0; j < 4; ++j) yx[rr][j] = *(const u32x2*)(y1 + (size_t)rr * DM + 4 * lane + 256 * j); }
        }
#pragma unroll
        for (int rr = 0; rr < 4; ++rr) {
            float q = p[rr]; q += __shfl_xor(q, 1); q += __shfl_xor(q, 2); q += __shfl_xor(q, 4); q += __shfl_xor(q, 8);
            const float rstd = 1.0f / sqrtf(q * (1.0f / DM) + NORM_EPS);
#pragma unroll
            for (int j = 0; j < 4; ++j) {
                f32x4 yy; yy[0] = bf2f(yw[rr][j].x & 0xffffu); yy[1] = bf2f(yw[rr][j].x >> 16); yy[2] = bf2f(yw[rr][j].y & 0xffffu); yy[3] = bf2f(yw[rr][j].y >> 16);
                v[rr][j] = v[rr][j] + GA0[j] * (yy * rstd);
            }
        }
        if (mode == 2) {
#pragma unroll
            for (int rr = 0; rr < 4; ++rr) {
                float q = p1[rr]; q += __shfl_xor(q, 1); q += __shfl_xor(q, 2); q += __shfl_xor(q, 4); q += __shfl_xor(q, 8);
                const float rstd = 1.0f / sqrtf(q * (1.0f / DM) + NORM_EPS);
#pragma unroll
                for (int j = 0; j < 4; ++j) {
                    f32x4 yy; yy[0] = bf2f(yx[rr][j].x & 0xffffu); yy[1] = bf2f(yx[rr][j].x >> 16); yy[2] = bf2f(yx[rr][j].y & 0xffffu); yy[3] = bf2f(yx[rr][j].y >> 16);
                    v[rr][j] = v[rr][j] + GA1[j] * (yy * rstd);
                    *(f32x4*)(dst + (size_t)rr * DM + 4 * lane + 256 * j) = v[rr][j];
                }
            }
        }
    }
    if (mode != 2) {
        float s[4];
#pragma unroll
        for (int rr = 0; rr < 4; ++rr) { float t = 0.f;
#pragma unroll
            for (int j = 0; j < 4; ++j) t += (v[rr][j][0] * v[rr][j][0] + v[rr][j][1] * v[rr][j][1]) + (v[rr][j][2] * v[rr][j][2] + v[rr][j][3] * v[rr][j][3]);
            s[rr] = t; }
#pragma unroll
        for (int o = 1; o < 64; o <<= 1) {
#pragma unroll
            for (int rr = 0; rr < 4; ++rr) s[rr] += __shfl_xor(s[rr], o); }
#pragma unroll
        for (int rr = 0; rr < 4; ++rr) {
            const float rstd = 1.0f / sqrtf(s[rr] * (1.0f / DM) + NORM_EPS);
#pragma unroll
            for (int j = 0; j < 4; ++j) {
                const f32x4 o = (v[rr][j] * rstd) * GB[j] + GC[j];
                u32x2 w; w.x = pkbf(o[0], o[1]); w.y = pkbf(o[2], o[3]);
                *(u32x2*)(hx + (size_t)rr * DM + 4 * lane + 256 * j) = w;
            }
        }
    }
}
__device__ __forceinline__ void norm_phase(const KArgs& a, int mode) {
    const int tid = opaque_tid(), lane = tid & 63, wave = tid >> 6;
    const int NGW = gridDim.x * 8;
    unsigned char* ws = a.ws;
    const float* mod = (const float*)(ws + WS_MOD);
    const int lp = (mode == 0) ? 0 : 1;
    bf16_t* HX = (bf16_t*)(ws + WS_HX); const bf16_t* Y0 = (const bf16_t*)(ws + WS_Y); const float* SSQ0 = (const float*)(ws + WS_SSQ);
    const bf16_t* Y1 = (const bf16_t*)(ws + WS_HX); const float* SSQ1 = (const float*)(ws + WS_SSQ1);
    const int gw2 = wave * (int)gridDim.x + (int)blockIdx.x;
    const int nlat = NTOK / 4;
    int curb = -1; f32x4 GA0[4], GA1[4], GB[4], GC[4];
    int base = gw2 * 4, sub = 0, itc = nlat + gw2; bool inctx = false;
    for (;;) {
        int it;
        if (!inctx) { if (base >= nlat) { inctx = true; continue; } it = base + sub; if (++sub == 4) { sub = 0; base += NGW * 4; } }
        else { if (mode == 2 || itc >= nlat + NCTX / 4) break; it = itc; itc += NGW; }
        const int r = it * 4;
        const int b = r < NTOK ? (r >> 13) : 4;
        if (b != curb) { curb = b;
            const float* mp = mod + (lp * 5 + b) * 3072; const float* m0 = mod + (0 * 5 + b) * 3072; const float* m1 = mod + (1 * 5 + b) * 3072;
#pragma unroll
            for (int j = 0; j < 4; ++j) { const int c = 4 * lane + 256 * j;
                GA0[j] = *(const f32x4*)(m0 + 2048 + c) * *(const f32x4*)(a.g_post + c);
                GA1[j] = *(const f32x4*)(m1 + 2048 + c) * *(const f32x4*)(a.g_post + DM + c);
                GB[j] = *(const f32x4*)(a.g_pre + lp * DM + c) * (*(const f32x4*)(mp + 1024 + c) + 1.0f);
                GC[j] = *(const f32x4*)(mp + c); } }
        const float* src = (r < NTOK) ? a.x + (size_t)r * DM : a.ctx + (size_t)(r - NTOK) * DM;
        norm_rows4(mode, lane, src, a.out + (size_t)r * DM, Y0 + (size_t)r * DM, SSQ0 + (size_t)r * 16, Y1 + (size_t)r * DM, SSQ1 + (size_t)r * 16, HX + (size_t)r * DM, GA0, GA1, GB, GC);
    }
}

__device__ __forceinline__ void attn_unit(int u, const bf16_t* P, const bf16_t* Vt, bf16_t* H, const float* sink, unsigned char* lds) {
    const int tid = opaque_tid(), lane = tid & 63, wave = __builtin_amdgcn_readfirstlane(tid >> 6), r32 = lane & 31, hi = lane >> 5;
    const bool isctx = u >= 1024;
    int b, kvh, qb;
    if (isctx) { const int v = u - 1024; b = v >> 3; kvh = (v >> 2) & 1; qb = v & 3; } else { b = u >> 8; kvh = (u >> 7) & 1; qb = u & 127; }
    const int head = kvh * 4 + (wave >> 1);
    const int qtok = qb * 64 + (wave & 1) * 32 + r32;
    const size_t qrow = isctx ? (size_t)(NTOK + b * CTXL + qtok) : (size_t)(b * SEQ + qtok);
    const float sinkv = sink[head];
    bf16x8 qf[4];
#pragma unroll
    for (int d0 = 0; d0 < 4; ++d0) qf[d0] = *(const bf16x8*)(P + qrow * PW + C_Q + head * 64 + d0 * 16 + hi * 8);
    int jlo = 0, jhi = -1;
    if (!isctx) { jlo = qb < 2 ? 2 - qb : 0; jhi = (129 - qb) < 4 ? (129 - qb) : 4; }
    const int ntiles = 4 + (jhi - jlo + 1);
    const int srow = tid >> 3, sch = tid & 7;
    const bf16_t* Kc = P + (size_t)(NTOK + b * CTXL + srow) * PW + C_K + kvh * 64 + sch * 8;
    const bf16_t* Kl = P + (size_t)(b * SEQ + srow) * PW + C_K + kvh * 64 + sch * 8;
    const bf16_t* Vb = Vt + (size_t)((b * 2 + kvh) * 64 + srow) * VT_PITCH + sch * 8;
    unsigned char* Ks = lds; unsigned char* Vs = lds + 2 * 9216;
    const int soff = srow * 144 + sch * 16;
    u32x4 kreg, vreg, kreg2, vreg2;
#define ATT_GLOAD(KR, VR, ti_) do { const int t_ = (ti_); \
        if (t_ < 4) { KR = *(const u32x4*)(Kc + (size_t)(64 * t_) * PW); VR = *(const u32x4*)(Vb + SEQ + 64 * t_); } \
        else { const int kbase_ = qb * 64 - 128 + 64 * (jlo + t_ - 4); KR = *(const u32x4*)(Kl + (size_t)kbase_ * PW); VR = *(const u32x4*)(Vb + kbase_); } } while (0)
    const bf16_t* garow = P + qrow * PW + C_GA + head * 64;
    u32x2 gaw[8];
#pragma unroll
    for (int i = 0; i < 8; ++i) gaw[i] = *(const u32x2*)(garow + 32 * (i >> 2) + 8 * (i & 3) + 4 * hi);
    ATT_GLOAD(kreg2, vreg2, 0);
    ATT_GLOAD(kreg, vreg, 1);
    *(u32x4*)(Ks + soff) = kreg2; *(u32x4*)(Vs + soff) = vreg2;
    __syncthreads();
    const float sink2 = sinkv * LOG2E;
    float mref = sink2, lsum = 0.f;
    f32x16 oT[2]; oT[0] = f32x16{}; oT[1] = f32x16{};
    const int qpos = qtok;
    for (int ti = 0; ti < ntiles; ++ti) {
        const int buf = ti & 1;
        if (ti + 2 < ntiles) ATT_GLOAD(kreg2, vreg2, ti + 2);
        const unsigned char* kb = Ks + buf * 9216 + r32 * 144 + hi * 16;
        const unsigned char* vb = Vs + buf * 9216 + r32 * 144 + hi * 16;
        bf16x8 kf[8];
#pragma unroll
        for (int d0 = 0; d0 < 4; ++d0) { kf[2 * d0] = *(const bf16x8*)(kb + d0 * 32); kf[2 * d0 + 1] = *(const bf16x8*)(kb + 32 * 144 + d0 * 32); }
        f32x16 p0, p1;
#pragma unroll
        for (int r = 0; r < 16; ++r) { p0[r] = -mref; p1[r] = -mref; }
        __builtin_amdgcn_sched_barrier(0);
#pragma unroll
        for (int d0 = 0; d0 < 4; ++d0) { p0 = MFMA32(kf[2 * d0], qf[d0], p0); p1 = MFMA32(kf[2 * d0 + 1], qf[d0], p1); }
        bf16x8 vf[8];
#pragma unroll
        for (int blk = 0; blk < 2; ++blk)
#pragma unroll
            for (int ks = 0; ks < 4; ++ks) vf[blk * 4 + ks] = *(const bf16x8*)(vb + blk * 32 * 144 + ks * 32);
        __builtin_amdgcn_sched_barrier(0);
        asm volatile("s_nop 15\n\ts_nop 7" : "+v"(p0), "+v"(p1));
        if (ti >= 4) {
            const int j = jlo + ti - 4; const int kbase = qb * 64 - 128 + 64 * j;
            if (j == 0) {
#pragma unroll
                for (int r = 0; r < 16; ++r) { const int kp = kbase + crow(r, hi); if (kp < qpos - 128) p0[r] = -INFINITY; if (kp + 32 < qpos - 128) p1[r] = -INFINITY; }
            } else if (j == 4) {
#pragma unroll
                for (int r = 0; r < 16; ++r) { const int kp = kbase + crow(r, hi); if (kp > qpos + 128) p0[r] = -INFINITY; if (kp + 32 > qpos + 128) p1[r] = -INFINITY; }
            }
        }
        float rma, rmb;
        asm("v_max3_f32 %0, %1, %2, %3" : "=v"(rma) : "v"(p0[0]), "v"(p0[1]), "v"(p1[0]));
        asm("v_max3_f32 %0, %1, %2, %3" : "=v"(rmb) : "v"(p0[2]), "v"(p0[3]), "v"(p1[1]));
        asm("v_max3_f32 %0, %1, %2, %3" : "=v"(rma) : "v"(rma), "v"(p1[2]), "v"(p1[3]));
#pragma unroll
        for (int r = 4; r < 16; r += 4) {
            asm("v_max3_f32 %0, %1, %2, %3" : "=v"(rma) : "v"(rma), "v"(p0[r]), "v"(p0[r + 1]));
            asm("v_max3_f32 %0, %1, %2, %3" : "=v"(rmb) : "v"(rmb), "v"(p0[r + 2]), "v"(p0[r + 3]));
            asm("v_max3_f32 %0, %1, %2, %3" : "=v"(rma) : "v"(rma), "v"(p1[r]), "v"(p1[r + 1]));
            asm("v_max3_f32 %0, %1, %2, %3" : "=v"(rmb) : "v"(rmb), "v"(p1[r + 2]), "v"(p1[r + 3]));
        }
        float rm; asm("v_max3_f32 %0, %1, %2, %3" : "=v"(rm) : "v"(rma), "v"(rmb), "v"(rmb));
        { const float rmo = __shfl_xor(rm, 32); asm("v_max3_f32 %0, %1, %2, %3" : "=v"(rm) : "v"(rm), "v"(rmo), "v"(rmo)); }
        if (__any(rm > 8.0f)) {
            const float dl = fmaxf(rm, 0.f);
            mref += dl;
            const float f = __builtin_amdgcn_exp2f(-dl);
            lsum *= f;
#pragma unroll
            for (int r = 0; r < 16; ++r) { p0[r] -= dl; p1[r] -= dl; oT[0][r] *= f; oT[1][r] *= f; }
        }
        float ls = 0.f;
#pragma unroll
        for (int r = 0; r < 16; ++r) { p0[r] = __builtin_amdgcn_exp2f(p0[r]); p1[r] = __builtin_amdgcn_exp2f(p1[r]); ls += p0[r] + p1[r]; }
        lsum += ls;
        bf16x8 pf[4]; pf[0] = pack8(p0, 0); pf[1] = pack8(p0, 8); pf[2] = pack8(p1, 0); pf[3] = pack8(p1, 8);
#pragma unroll
        for (int blk = 0; blk < 2; ++blk)
#pragma unroll
            for (int ks = 0; ks < 4; ++ks) oT[blk] = MFMA32(vf[blk * 4 + ks], pf[ks], oT[blk]);
        if (ti + 1 < ntiles) { *(u32x4*)(Ks + (buf ^ 1) * 9216 + soff) = kreg; *(u32x4*)(Vs + (buf ^ 1) * 9216 + soff) = vreg; }
        kreg = kreg2; vreg = vreg2;
        __syncthreads();
    }
    lsum += __shfl_xor(lsum, 32);
    lsum += __builtin_amdgcn_exp2f(sink2 - mref);
    const float inv = 1.0f / lsum;
    bf16_t* hrow = H + qrow * DM + head * 64;
#pragma unroll
    for (int blk = 0; blk < 2; ++blk)
#pragma unroll
        for (int g4 = 0; g4 < 4; ++g4) {
            const int d0 = 32 * blk + 8 * g4 + 4 * hi;
            const u32x2 gw = gaw[blk * 4 + g4];
            const float o0 = oT[blk][4 * g4 + 0] * inv * silu_f(bf2f(gw.x & 0xffffu)), o1 = oT[blk][4 * g4 + 1] * inv * silu_f(bf2f(gw.x >> 16));
            const float o2 = oT[blk][4 * g4 + 2] * inv * silu_f(bf2f(gw.y & 0xffffu)), o3 = oT[blk][4 * g4 + 3] * inv * silu_f(bf2f(gw.y >> 16));
            u32x2 w; w.x = pkbf(o0, o1); w.y = pkbf(o2, o3);
            *(u32x2*)(hrow + d0) = w;
        }
}

typedef short v4i16_t __attribute__((ext_vector_type(4)));
__device__ __forceinline__ v4i16_t trrd(const unsigned char* p) { return __builtin_amdgcn_ds_read_tr16_b64_v4i16((LAS v4i16_t*)p); }
__device__ __forceinline__ bf16x8 cat8(v4i16_t lo, v4i16_t hi) { return (bf16x8){lo[0], lo[1], lo[2], lo[3], hi[0], hi[1], hi[2], hi[3]}; }
__device__ __forceinline__ void fft1_unit(int u, const bf16_t* P, bf16_t* YF, const unsigned char* ws, unsigned char* lds) {
    const int tid = opaque_tid(), lane = tid & 63, wave = __builtin_amdgcn_readfirstlane(tid >> 6), r32 = lane & 31, hi = lane >> 5;
    const int b = u >> 6, n2 = u & 63;
    constexpr int UPB = 576;
    const bf16_t* src = P + (size_t)(b * SEQ + n2) * PW + C_UF;
#pragma unroll
    for (int i = 0; i < 8; ++i) {
        const int id = tid + NTHREADS * i, n1 = id >> 5, cc = id & 31;
        *(u32x4*)(lds + n1 * UPB + cc * 16) = *(const u32x4*)(src + (size_t)n1 * 64 * PW + cc * 8);
    }
    __syncthreads();
    const bf16_t* T1R = (const bf16_t*)(ws + WS_T1R); const bf16_t* T1I = (const bf16_t*)(ws + WS_T1I);
    f32x16 aR[4], aI[4];
#pragma unroll
    for (int kb = 0; kb < 4; ++kb) { aR[kb] = f32x16{}; aI[kb] = f32x16{}; }
    const unsigned char* ap = lds + (8 * hi + ((lane & 15) >> 2)) * UPB + (32 * wave + 16 * ((lane >> 4) & 1) + 4 * (lane & 3)) * 2;
#pragma unroll 2
    for (int ks = 0; ks < 8; ++ks) {
        const bf16x8 av = cat8(trrd(ap + (16 * ks) * UPB), trrd(ap + (16 * ks + 4) * UPB));
#pragma unroll
        for (int kb = 0; kb < 4; ++kb) {
            const bf16x8 bR = *(const bf16x8*)(T1R + (32 * kb + r32) * 128 + 16 * ks + 8 * hi), bI = *(const bf16x8*)(T1I + (32 * kb + r32) * 128 + 16 * ks + 8 * hi);
            aR[kb] = MFMA32(av, bR, aR[kb]); aI[kb] = MFMA32(av, bI, aI[kb]);
        }
    }
    const float* TW = (const float*)(ws + WS_TW);
#pragma unroll
    for (int kb = 0; kb < 4; ++kb) {
        const int k1 = 32 * kb + r32;
        const float ct = TW[2 * (n2 * k1)], st = TW[2 * (n2 * k1) + 1];
        bf16_t* yp = YF + ((size_t)((b * 128 + k1) * 64 + n2)) * 512 + 32 * wave + 4 * hi;
#pragma unroll
        for (int g4 = 0; g4 < 4; ++g4) {
            float yr[4], yi[4];
#pragma unroll
            for (int e = 0; e < 4; ++e) { const float r_ = aR[kb][4 * g4 + e], i_ = aI[kb][4 * g4 + e]; yr[e] = r_ * ct + i_ * st; yi[e] = i_ * ct - r_ * st; }
            u32x2 wr_, wi_; wr_.x = pkbf(yr[0], yr[1]); wr_.y = pkbf(yr[2], yr[3]); wi_.x = pkbf(yi[0], yi[1]); wi_.y = pkbf(yi[2], yi[3]);
            *(u32x2*)(yp + 8 * g4) = wr_; *(u32x2*)(yp + 256 + 8 * g4) = wi_;
        }
    }
    __syncthreads();
}

template <int KK>
__device__ __forceinline__ void dftf_unit(const bf16_t* srcbase, int R, int pitchA, int pitchB, const bf16_t* Tr, const bf16_t* Ti, const bf16_t* Gt,
                                          const bf16_t* P, bf16_t* H, size_t row0, int rowstride, float oscale, unsigned char* lds) {
    const int tid = opaque_tid(), lane = tid & 63, wave = __builtin_amdgcn_readfirstlane(tid >> 6), r32 = lane & 31, hi = lane >> 5;
    constexpr int ZPB = (KK == 128) ? 576 : 544;
#pragma unroll 1
    for (int i0 = 0; i0 < KK / 16; i0 += 8) {
        u32x4 img[8];
#pragma unroll
        for (int i = 0; i < 8; ++i) { const int id = tid + NTHREADS * (i0 + i), kk = id >> 5, cc = id & 31; img[i] = *(const u32x4*)(srcbase + (size_t)(kk % R) * pitchA + (size_t)(kk / R) * pitchB + cc * 8); }
        __builtin_amdgcn_sched_barrier(0);
#pragma unroll
        for (int i = 0; i < 8; ++i) { const int id = tid + NTHREADS * (i0 + i), kk = id >> 5, cc = id & 31; *(u32x4*)(lds + kk * ZPB + cc * 16) = img[i]; }
        __builtin_amdgcn_sched_barrier(0);
    }
    __syncthreads();
    const int g = wave >> 1, kblk = wave & 1;
    f32x16 XR[2], XI[2];
#pragma unroll
    for (int cb = 0; cb < 2; ++cb) { XR[cb] = f32x16{}; XI[cb] = f32x16{}; }
    const bf16_t* trp = Tr + (size_t)(32 * kblk + r32) * KK + 8 * hi; const bf16_t* tip = Ti + (size_t)(32 * kblk + r32) * KK + 8 * hi;
    const unsigned char* zp = lds + (8 * hi + ((lane & 15) >> 2)) * ZPB + (64 * g + 16 * ((lane >> 4) & 1) + 4 * (lane & 3)) * 2;
#pragma unroll 2
    for (int ks = 0; ks < KK / 16; ++ks) {
        const bf16x8 bR = *(const bf16x8*)(trp + 16 * ks), bI = *(const bf16x8*)(tip + 16 * ks);
#pragma unroll
        for (int cb = 0; cb < 2; ++cb) { const bf16x8 av = cat8(trrd(zp + (16 * ks) * ZPB + cb * 64), trrd(zp + (16 * ks + 4) * ZPB + cb * 64)); XR[cb] = MFMA32(av, bR, XR[cb]); XI[cb] = MFMA32(av, bI, XI[cb]); }
    }
    f32x16 oa[2]; oa[0] = f32x16{}; oa[1] = f32x16{};
    const bf16_t* gp = Gt + (size_t)(g * 64 + r32) * 128 + 8 * hi;
    u32x2 gfw[8];
    { const size_t rowg = row0 + (size_t)(32 * kblk + r32) * rowstride;
#pragma unroll
      for (int i8 = 0; i8 < 8; ++i8) gfw[i8] = *(const u32x2*)(P + rowg * PW + C_GF + 64 * g + 32 * (i8 >> 2) + 8 * (i8 & 3) + 4 * hi); }
#pragma unroll
    for (int part = 0; part < 2; ++part)
#pragma unroll
        for (int cb = 0; cb < 2; ++cb)
#pragma unroll
            for (int s = 0; s < 2; ++s) {
                const bf16x8 bx = pack8(part ? XI[cb] : XR[cb], 8 * s);
                const int kko = part * 64 + 32 * cb + 16 * s;
#pragma unroll
                for (int lb = 0; lb < 2; ++lb) { const bf16x8 ag = *(const bf16x8*)(gp + (size_t)(32 * lb) * 128 + kko); oa[lb] = MFMA32(ag, bx, oa[lb]); }
            }
    const int k2 = 32 * kblk + r32;
    const size_t row = row0 + (size_t)k2 * rowstride;
    const bf16_t* gfrow = P + row * PW + C_GF + 64 * g;
    bf16_t* hrow = H + row * DM + 512 + 64 * g;
#pragma unroll
    for (int lb = 0; lb < 2; ++lb)
#pragma unroll
        for (int g4 = 0; g4 < 4; ++g4) {
            const int l0 = 32 * lb + 8 * g4 + 4 * hi;
            const u32x2 gw = gfw[lb * 4 + g4];
            const float o0 = oa[lb][4 * g4 + 0] * oscale * silu_f(bf2f(gw.x & 0xffffu)), o1 = oa[lb][4 * g4 + 1] * oscale * silu_f(bf2f(gw.x >> 16));
            const float o2 = oa[lb][4 * g4 + 2] * oscale * silu_f(bf2f(gw.y & 0xffffu)), o3 = oa[lb][4 * g4 + 3] * oscale * silu_f(bf2f(gw.y >> 16));
            u32x2 w; w.x = pkbf(o0, o1); w.y = pkbf(o2, o3);
            *(u32x2*)(hrow + l0) = w;
        }
    __syncthreads();
}

__device__ __forceinline__ void conv_unit(int u, const bf16_t* P, bf16_t* H, const float* cw, const float* cb) {
    const int tid = opaque_tid(), cgp = tid & 31, rg = tid >> 5;
    const int ch0 = cgp * 8;
    const int r0 = u * 64 + rg * 4;
    int pos, len; if (r0 < NTOK) { pos = r0 & (SEQ - 1); len = SEQ; } else { pos = (r0 - NTOK) & (CTXL - 1); len = CTXL; }
    float w0[8], w1[8], w2[8], bs[8];
#pragma unroll
    for (int e = 0; e < 8; ++e) { w0[e] = cw[ch0 + e]; w1[e] = cw[256 + ch0 + e]; w2[e] = cw[512 + ch0 + e]; bs[e] = cb[ch0 + e]; }
    float T[6][8];
#pragma unroll
    for (int i = 0; i < 6; ++i) {
        const int p = pos - 1 + i;
        if (p >= 0 && p < len) {
            const size_t row = (size_t)(r0 - 1 + i);
            const u32x4 z = *(const u32x4*)(P + row * PW + C_ZC + ch0), c = *(const u32x4*)(P + row * PW + C_CC + ch0);
            T[i][0] = bf2f(z.x & 0xffffu) * bf2f(c.x & 0xffffu); T[i][1] = bf2f(z.x >> 16) * bf2f(c.x >> 16);
            T[i][2] = bf2f(z.y & 0xffffu) * bf2f(c.y & 0xffffu); T[i][3] = bf2f(z.y >> 16) * bf2f(c.y >> 16);
            T[i][4] = bf2f(z.z & 0xffffu) * bf2f(c.z & 0xffffu); T[i][5] = bf2f(z.z >> 16) * bf2f(c.z >> 16);
            T[i][6] = bf2f(z.w & 0xffffu) * bf2f(c.w & 0xffffu); T[i][7] = bf2f(z.w >> 16) * bf2f(c.w >> 16);
        } else {
#pragma unroll
            for (int e = 0; e < 8; ++e) T[i][e] = 0.f;
        }
    }
#pragma unroll
    for (int i = 0; i < 4; ++i) {
        const size_t row = (size_t)(r0 + i);
        const u32x4 bw = *(const u32x4*)(P + row * PW + C_BC + ch0), gw = *(const u32x4*)(P + row * PW + C_GC + ch0);
        const unsigned bwv[4] = {bw.x, bw.y, bw.z, bw.w}, gwv[4] = {gw.x, gw.y, gw.z, gw.w};
        float o[8];
#pragma unroll
        for (int e = 0; e < 8; ++e) {
            const float bv = (e & 1) ? bf2f(bwv[e >> 1] >> 16) : bf2f(bwv[e >> 1] & 0xffffu);
            const float gv = (e & 1) ? bf2f(gwv[e >> 1] >> 16) : bf2f(gwv[e >> 1] & 0xffffu);
            const float y = T[i][e] * w0[e] + T[i + 1][e] * w1[e] + T[i + 2][e] * w2[e] + bs[e];
            o[e] = bv * y * silu_f(gv);
        }
        u32x4 w; w.x = pkbf(o[0], o[1]); w.y = pkbf(o[2], o[3]); w.z = pkbf(o[4], o[5]); w.w = pkbf(o[6], o[7]);
        *(u32x4*)(H + row * DM + 768 + ch0) = w;
    }
}

__device__ __forceinline__ void fft1_tables(const unsigned char* ws, unsigned char* tbl, int tid) {
    u32x4 tv[8];
#pragma unroll
    for (int i = 0; i < 8; ++i) { const int id = tid + NTHREADS * i, t = id >> 11, row = (id >> 4) & 127, ch = id & 15; tv[i] = *(const u32x4*)(ws + (t ? WS_T1I : WS_T1R) + row * 256 + ch * 16); }
    __builtin_amdgcn_sched_barrier(0);
#pragma unroll
    for (int i = 0; i < 8; ++i) { const int id = tid + NTHREADS * i, t = id >> 11, row = (id >> 4) & 127, ch = id & 15; *(u32x4*)(tbl + t * 34816 + row * 272 + ch * 16) = tv[i]; }
}
__device__ __forceinline__ void fft1_wave(int task, const bf16_t* P, bf16_t* YF, const unsigned char* ws, unsigned char* lds_w, const unsigned char* tbl, int lane, int pmode = 0) {
    const int r32 = lane & 31, hi = lane >> 5;
    const int cblk = task & 7, n2 = (task >> 3) & 63, b = task >> 9;
    const bf16_t* src = P + (size_t)((b * 64 + n2) * 128) * 256 + 32 * cblk + 8 * (lane & 3);
    { u32x4 img[8];
#pragma unroll
      for (int i = 0; i < 8; ++i) img[i] = *(const u32x4*)(src + (size_t)(16 * i + (lane >> 2)) * 256);
      __builtin_amdgcn_sched_barrier(0);
#pragma unroll
      for (int i = 0; i < 8; ++i) *(u32x4*)(lds_w + (16 * i + (lane >> 2)) * 64 + (lane & 3) * 16) = img[i];
      __builtin_amdgcn_sched_barrier(0); }
    asm volatile("s_waitcnt vmcnt(0) lgkmcnt(0)" ::: "memory");
    if (pmode == 2) return;
    const bf16_t* T1R = (const bf16_t*)(ws + WS_T1R); const bf16_t* T1I = (const bf16_t*)(ws + WS_T1I);
    f32x16 aR[4], aI[4];
#pragma unroll
    for (int kb = 0; kb < 4; ++kb) { aR[kb] = f32x16{}; aI[kb] = f32x16{}; }
    const unsigned char* ap = lds_w + (8 * hi + ((lane & 15) >> 2)) * 64 + (16 * ((lane >> 4) & 1) + 4 * (lane & 3)) * 2;
    const unsigned char* tb = tbl + r32 * 272 + hi * 16;
#pragma unroll 2
    for (int ks = 0; ks < 8; ++ks) {
        const bf16x8 av = cat8(trrd(ap + (16 * ks) * 64), trrd(ap + (16 * ks + 4) * 64));
        bf16x8 bq[8];
#pragma unroll
        for (int kb = 0; kb < 4; ++kb) { bq[2 * kb] = *(const bf16x8*)(tb + (32 * kb) * 272 + 32 * ks); bq[2 * kb + 1] = *(const bf16x8*)(tb + 34816 + (32 * kb) * 272 + 32 * ks); }
#pragma unroll
        for (int kb = 0; kb < 4; ++kb) { aR[kb] = MFMA32(av, bq[2 * kb], aR[kb]); aI[kb] = MFMA32(av, bq[2 * kb + 1], aI[kb]); }
    }
    const float* TW = (const float*)(ws + WS_TW);
#pragma unroll
    for (int kb = 0; kb < 4; ++kb) {
        const int k1 = 32 * kb + r32;
        const float ct = TW[2 * (n2 * k1)], st = TW[2 * (n2 * k1) + 1];
        bf16_t* yp = YF + ((size_t)((b * 128 + k1) * 64 + n2)) * 512 + 32 * cblk + 4 * hi;
#pragma unroll
        for (int g4 = 0; g4 < 4; ++g4) {
            float yr[4], yi[4];
#pragma unroll
            for (int e = 0; e < 4; ++e) { const float r_ = aR[kb][4 * g4 + e], i_ = aI[kb][4 * g4 + e]; yr[e] = r_ * ct + i_ * st; yi[e] = i_ * ct - r_ * st; }
            u32x2 wr_, wi_; wr_.x = pkbf(yr[0], yr[1]); wr_.y = pkbf(yr[2], yr[3]); wi_.x = pkbf(yi[0], yi[1]); wi_.y = pkbf(yi[2], yi[3]);
            if (pmode != 1 || wr_.x == 0x12345678u) { *(u32x2*)(yp + 8 * g4) = wr_; *(u32x2*)(yp + 256 + 8 * g4) = wi_; }
        }
    }
    asm volatile("s_waitcnt lgkmcnt(0)" ::: "memory");
}
__device__ __forceinline__ void fft3_wave(int task, const bf16_t* YF, const bf16_t* Gt, const bf16_t* P, bf16_t* H, const unsigned char* ws, unsigned char* lds_w, int lane) {
    const int r32 = lane & 31, hi = lane >> 5;
    const int g = task & 3, k1 = (task >> 2) & 127, b = task >> 9;
    const bf16_t* src = YF + ((size_t)(b * 128 + k1) * 64) * 512 + 64 * g + 8 * (lane & 7);
    { u32x4 img[16];
#pragma unroll
      for (int i = 0; i < 16; ++i) { const int kk = 8 * i + (lane >> 3); img[i] = *(const u32x4*)(src + (size_t)(kk & 63) * 512 + (size_t)(kk >> 6) * 256); }
      __builtin_amdgcn_sched_barrier(0);
#pragma unroll
      for (int i = 0; i < 16; ++i) { const int kk = 8 * i + (lane >> 3), ch = lane & 7; *(u32x4*)(lds_w + kk * 128 + ((ch ^ (((kk >> 1) & 1) << 2)) * 16)) = img[i]; }
      __builtin_amdgcn_sched_barrier(0); }
    asm volatile("s_waitcnt vmcnt(0) lgkmcnt(0)" ::: "memory");
    const bf16_t* T3R = (const bf16_t*)(ws + WS_T3R); const bf16_t* T3I = (const bf16_t*)(ws + WS_T3I);
    const int q = (lane & 15) >> 2, sw = (q >> 1) & 1;
    const int chl = 2 * ((lane >> 4) & 1) + ((lane & 3) >> 1);
    const unsigned char* zb = lds_w + (8 * hi + q) * 128 + 8 * (lane & 1);
    const unsigned char* zp0 = zb + ((chl ^ (sw << 2)) * 16);
    const unsigned char* zp1 = zb + (((4 + chl) ^ (sw << 2)) * 16);
    const bf16_t* gp = Gt + (size_t)(g * 64 + r32) * 128 + 8 * hi;
    const size_t rowb = (size_t)(b * SEQ + k1);
#pragma unroll 1
    for (int kblk = 0; kblk < 2; ++kblk) {
        f32x16 XR[2], XI[2];
#pragma unroll
        for (int cb = 0; cb < 2; ++cb) { XR[cb] = f32x16{}; XI[cb] = f32x16{}; }
        const bf16_t* trp = T3R + (size_t)(32 * kblk + r32) * 128 + 8 * hi; const bf16_t* tip = T3I + (size_t)(32 * kblk + r32) * 128 + 8 * hi;
        const size_t rowg = rowb + (size_t)(32 * kblk + r32) * 128;
        u32x2 gfw[8];
#pragma unroll
        for (int i8 = 0; i8 < 8; ++i8) gfw[i8] = *(const u32x2*)(P + rowg * PW + C_GF + 64 * g + 32 * (i8 >> 2) + 8 * (i8 & 3) + 4 * hi);
        bf16x8 bR[8], bI[8];
#pragma unroll
        for (int ks = 0; ks < 8; ++ks) { bR[ks] = *(const bf16x8*)(trp + 16 * ks); bI[ks] = *(const bf16x8*)(tip + 16 * ks); }
        __builtin_amdgcn_sched_barrier(0);
#pragma unroll
        for (int ks = 0; ks < 8; ++ks) {
            const bf16x8 a0 = cat8(trrd(zp0 + (16 * ks) * 128), trrd(zp0 + (16 * ks + 4) * 128));
            const bf16x8 a1 = cat8(trrd(zp1 + (16 * ks) * 128), trrd(zp1 + (16 * ks + 4) * 128));
            XR[0] = MFMA32(a0, bR[ks], XR[0]); XI[0] = MFMA32(a0, bI[ks], XI[0]); XR[1] = MFMA32(a1, bR[ks], XR[1]); XI[1] = MFMA32(a1, bI[ks], XI[1]);
        }
        __builtin_amdgcn_sched_barrier(0);
        bf16x8 gfr[2][8];
#pragma unroll
        for (int lb = 0; lb < 2; ++lb)
#pragma unroll
            for (int q8 = 0; q8 < 8; ++q8) gfr[lb][q8] = *(const bf16x8*)(gp + (size_t)(32 * lb) * 128 + 16 * q8);
        __builtin_amdgcn_sched_barrier(0);
        f32x16 oa[2]; oa[0] = f32x16{}; oa[1] = f32x16{};
#pragma unroll
        for (int part = 0; part < 2; ++part)
#pragma unroll
            for (int cb = 0; cb < 2; ++cb)
#pragma unroll
                for (int s = 0; s < 2; ++s) {
                    const bf16x8 bx = pack8(part ? XI[cb] : XR[cb], 8 * s);
                    const int kko = part * 64 + 32 * cb + 16 * s;
#pragma unroll
                    for (int lb = 0; lb < 2; ++lb) oa[lb] = MFMA32(gfr[lb][kko >> 4], bx, oa[lb]);
                }
        const int k2 = 32 * kblk + r32;
        const size_t row = rowb + (size_t)k2 * 128;
        const bf16_t* gfrow = P + row * PW + C_GF + 64 * g;
        bf16_t* hrow = H + row * DM + 512 + 64 * g;
#pragma unroll
        for (int lb = 0; lb < 2; ++lb)
#pragma unroll
            for (int g4 = 0; g4 < 4; ++g4) {
                const int l0 = 32 * lb + 8 * g4 + 4 * hi;
                const u32x2 gw = gfw[lb * 4 + g4];
                const float o0 = oa[lb][4 * g4 + 0] * silu_f(bf2f(gw.x & 0xffffu)), o1 = oa[lb][4 * g4 + 1] * silu_f(bf2f(gw.x >> 16));
                const float o2 = oa[lb][4 * g4 + 2] * silu_f(bf2f(gw.y & 0xffffu)), o3 = oa[lb][4 * g4 + 3] * silu_f(bf2f(gw.y >> 16));
                u32x2 w; w.x = pkbf(o0, o1); w.y = pkbf(o2, o3);
                *(u32x2*)(hrow + l0) = w;
            }
    }
    asm volatile("s_waitcnt lgkmcnt(0)" ::: "memory");
}
__device__ __forceinline__ void conv_wave(int task, const bf16_t* P, bf16_t* H, const float* cw, const float* cb, int lane) {
    const int cgp = lane & 31, ch0 = cgp * 8;
    const int r0 = task * 8 + (lane >> 5) * 4;
    int pos, len; if (r0 < NTOK) { pos = r0 & (SEQ - 1); len = SEQ; } else { pos = (r0 - NTOK) & (CTXL - 1); len = CTXL; }
    u32x4 zz[6], cc[6], bb[4], gg[4]; float okf[6];
#pragma unroll
    for (int i = 0; i < 6; ++i) { const int p = pos - 1 + i; const bool ok = p >= 0 && p < len; okf[i] = ok ? 1.f : 0.f; const size_t row = (size_t)(ok ? r0 - 1 + i : r0);
        zz[i] = *(const u32x4*)(P + row * PW + C_ZC + ch0); cc[i] = *(const u32x4*)(P + row * PW + C_CC + ch0); }
#pragma unroll
    for (int i = 0; i < 4; ++i) { const size_t row = (size_t)(r0 + i); bb[i] = *(const u32x4*)(P + row * PW + C_BC + ch0); gg[i] = *(const u32x4*)(P + row * PW + C_GC + ch0); }
    __builtin_amdgcn_sched_barrier(0);
    float w0[8], w1[8], w2[8], bs[8];
    { const f32x4 a0 = *(const f32x4*)(cw + ch0), a1 = *(const f32x4*)(cw + ch0 + 4), b0 = *(const f32x4*)(cw + 256 + ch0), b1 = *(const f32x4*)(cw + 256 + ch0 + 4);
      const f32x4 c0 = *(const f32x4*)(cw + 512 + ch0), c1 = *(const f32x4*)(cw + 512 + ch0 + 4), d0 = *(const f32x4*)(cb + ch0), d1 = *(const f32x4*)(cb + ch0 + 4);
#pragma unroll
      for (int e = 0; e < 4; ++e) { w0[e] = a0[e]; w0[4 + e] = a1[e]; w1[e] = b0[e]; w1[4 + e] = b1[e]; w2[e] = c0[e]; w2[4 + e] = c1[e]; bs[e] = d0[e]; bs[4 + e] = d1[e]; } }
    float T[6][8];
#pragma unroll
    for (int i = 0; i < 6; ++i) {
        const unsigned zv[4] = {zz[i].x, zz[i].y, zz[i].z, zz[i].w}, cv[4] = {cc[i].x, cc[i].y, cc[i].z, cc[i].w};
#pragma unroll
        for (int e = 0; e < 8; ++e) T[i][e] = okf[i] * ((e & 1) ? bf2f(zv[e >> 1] >> 16) : bf2f(zv[e >> 1] & 0xffffu)) * ((e & 1) ? bf2f(cv[e >> 1] >> 16) : bf2f(cv[e >> 1] & 0xffffu));
    }
#pragma unroll
    for (int i = 0; i < 4; ++i) {
        const size_t row = (size_t)(r0 + i);
        const unsigned bwv[4] = {bb[i].x, bb[i].y, bb[i].z, bb[i].w}, gwv[4] = {gg[i].x, gg[i].y, gg[i].z, gg[i].w};
        float o[8];
#pragma unroll
        for (int e = 0; e < 8; ++e) {
            const float bv = (e & 1) ? bf2f(bwv[e >> 1] >> 16) : bf2f(bwv[e >> 1] & 0xffffu);
            const float gv = (e & 1) ? bf2f(gwv[e >> 1] >> 16) : bf2f(gwv[e >> 1] & 0xffffu);
            const float y = T[i][e] * w0[e] + T[i + 1][e] * w1[e] + T[i + 2][e] * w2[e] + bs[e];
            o[e] = bv * y * silu_f(gv);
        }
        u32x4 w; w.x = pkbf(o[0], o[1]); w.y = pkbf(o[2], o[3]); w.z = pkbf(o[4], o[5]); w.w = pkbf(o[6], o[7]);
        *(u32x4*)(H + row * DM + 768 + ch0) = w;
    }
}

#define XB_TMO      128
#define XB_XCNT(j)  (256  + 64 * (j))
#define XB_XSUB(j)  (1280 + 64 * (j))
#define XB_XGEN(j)  (2304 + 64 * (j))
#define XB_TOP      3328
#define XB_TOPGEN   3392
#define XCD_BAR_WORDS 3456
#define XB_SPIN_CAP (1u << 18)

__device__ __forceinline__ unsigned xb_ld(unsigned* p)              { return __hip_atomic_load(p, __ATOMIC_RELAXED, __HIP_MEMORY_SCOPE_AGENT); }
__device__ __forceinline__ unsigned xb_add(unsigned* p, unsigned v) { return __hip_atomic_fetch_add(p, v, __ATOMIC_RELAXED, __HIP_MEMORY_SCOPE_AGENT); }
__device__ __forceinline__ unsigned xb_xcc_id() { return (unsigned)__builtin_amdgcn_s_getreg((3 << 11) | 20) & 0xFu; }
#define XB_SPIN(cond, bar) do { unsigned _sp = 0; while (cond) { __builtin_amdgcn_s_sleep(1); \
    if ((++_sp & 255u) == 0u) { if (xb_ld(&(bar)[XB_TMO])) break; if (_sp > XB_SPIN_CAP) { atomicAdd(&(bar)[XB_TMO], 1u); break; } } } } while (0)

struct XcdBarrier {
    unsigned* bar; unsigned x;
    volatile LAS unsigned* st;
};

__device__ __forceinline__ XcdBarrier xcd_barrier_post(unsigned* bar, volatile LAS unsigned* st) {
    XcdBarrier b; b.bar = bar; b.x = xb_xcc_id(); b.st = st;
    if (threadIdx.x == 0) (void)xb_add(&bar[XB_XCNT(b.x)], 1u);
    return b;
}
__device__ __forceinline__ void xcd_barrier_complete(unsigned* bar, unsigned x, unsigned& nloc, unsigned& nx) {
    const unsigned G = gridDim.x * gridDim.y * gridDim.z;
    unsigned sum, cnt, mine, sp = 0u;
    for (;;) {
        sum = 0u; cnt = 0u; mine = 0u;
#pragma unroll
        for (unsigned j = 0; j < 16; ++j) { const unsigned c = xb_ld(&bar[XB_XCNT(j)]); sum += c; cnt += (c > 0u) ? 1u : 0u; mine = (j == x) ? c : mine; }
        if (sum == G) break;
        __builtin_amdgcn_s_sleep(1);
        if ((++sp & 255u) == 0u) { if (xb_ld(&bar[XB_TMO])) break; if (sp > XB_SPIN_CAP) { atomicAdd(&bar[XB_TMO], 1u); break; } }
    }
    nloc = mine > 0u ? mine : 1u; nx = cnt > 0u ? cnt : 1u;
}

__device__ __forceinline__ void xcd_barrier(const XcdBarrier& b) {
    asm volatile("s_waitcnt vmcnt(0)" ::: "memory");
    __syncthreads();
    if (threadIdx.x == 0) {
        unsigned* bar = b.bar;
        __builtin_amdgcn_s_waitcnt(0);
        unsigned nloc = b.st[0], nx = b.st[1];
        if (nloc == 0u) { xcd_barrier_complete(bar, b.x, nloc, nx); b.st[0] = nloc; b.st[1] = nx; }
        const unsigned old = xb_add(&bar[XB_XSUB(b.x)], 1u);
        const unsigned gen = old / nloc;
        if (old + 1u == (gen + 1u) * nloc) {
            __builtin_amdgcn_fence(__ATOMIC_RELEASE, "agent");
            asm volatile("s_waitcnt vmcnt(0)" ::: "memory");
            const unsigned og = xb_add(&bar[XB_TOP], 1u);
            const unsigned tg = og / nx;
            if (og + 1u == (tg + 1u) * nx) xb_add(&bar[XB_TOPGEN], 1u);
            else XB_SPIN(xb_ld(&bar[XB_TOPGEN]) == tg, bar);
            __builtin_amdgcn_fence(__ATOMIC_ACQUIRE, "agent");
            xb_add(&bar[XB_XGEN(b.x)], 1u);
            asm volatile("s_waitcnt vmcnt(0)" ::: "memory");
        } else {
            XB_SPIN(xb_ld(&bar[XB_XGEN(b.x)]) == gen, bar);
            __builtin_amdgcn_fence(__ATOMIC_ACQUIRE, "agent");
            asm volatile("s_waitcnt vmcnt(0)" ::: "memory");
        }
    }
    __syncthreads();
}

__device__ __forceinline__ int next_unit(unsigned* ctr, unsigned char* lds) {
    volatile int* sw = (volatile int*)(lds + LDS_SCHED);
    if (threadIdx.x == 0) *sw = (int)atomicAdd(ctr, 1u);
    __syncthreads();
    const int u = *sw;
    __syncthreads();
    return u;
}

__global__ void __launch_bounds__(NTHREADS, 2) hybrid_fwd(KArgs a) {
    extern __shared__ __attribute__((aligned(16))) unsigned char lds[];
    cg::grid_group grid = cg::this_grid();
    unsigned char* ws = a.ws;
    const int lo = a.ph_lo, hi = a.ph_hi;
#ifndef PHMASK
#define PHMASK 0xfff
#endif
#define IN(k) (((PHMASK >> ((k) > 5 && (k) < 11 ? (k) - 5 : (k))) & 1) && lo <= (k) && (k) < hi)
#define SEAM(k) do { if (IN(k) && IN((k) + 1)) xcd_barrier(xbar); } while (0)
#ifndef REP_PHASE
#define REP_PHASE -1
#endif
#define REPS(j) for (int rep = 0, nrep = (REP_PHASE == (j)) ? 2 : 1; rep < nrep; ++rep, (rep < nrep ? xcd_barrier(xbar) : (void)0))
    bf16_t* HX = (bf16_t*)(ws + WS_HX); bf16_t* Pb = (bf16_t*)(ws + WS_P); bf16_t* Vt = (bf16_t*)(ws + WS_VT); bf16_t* Hb = (bf16_t*)(ws + WS_H);
    bf16_t* Yb = (bf16_t*)(ws + WS_Y); bf16_t* YF = (bf16_t*)(ws + WS_YF); float* SSQ = (float*)(ws + WS_SSQ);
    unsigned* ctl = (unsigned*)(ws + WS_CTL);

    if (threadIdx.x < 2) ((volatile LAS unsigned*)(lds + LDS_BARST))[threadIdx.x] = 0u;
    __syncthreads();
    const XcdBarrier xbar = xcd_barrier_post((unsigned*)(ws + WS_BAR), (volatile LAS unsigned*)(lds + LDS_BARST));
    if (a.ph_lo < 0) grid.sync();
    REPS(30) if (IN(0)) p0_prologue(a, lds);
    SEAM(0);
    for (int l = 0; l < 2; ++l) {
        const int pb = 1 + 5 * l;
        REPS(0) if (IN(pb)) norm_phase(a, l);
        SEAM(pb);
        REPS(1) if (IN(pb + 1)) {
            pg8::Gemm g{HX, (const bf16_t*)(ws + WS_WIN) + (size_t)l * PW * DM, MROWS, PW, DM};
            pg8::StaticOrder S; S.init(MROWS, PW, (int)gridDim.x, (int)blockIdx.x);
            pg8::EpiProj E{Pb, Vt, (const float*)(ws + WS_ROPE), (bf16_t*)(ws + WS_UFP), 0.125f * LOG2E};
            pg8::gemm_phase<pg8::EpiProj, pg8::StaticOrder, true, true>((PG8_LAS unsigned char*)lds, g, S, E);
        }
        SEAM(pb + 1);
        for (int rep = 0, nrep = (REP_PHASE >= 20 && REP_PHASE < 30) ? 2 : 1; rep < nrep; ++rep, (rep < nrep ? xcd_barrier(xbar) : (void)0)) if (IN(pb + 2)) {
            const int nAttn = (l == 0) ? 1056 : 1024, nCtxF = (l == 0) ? 16 : 0, nF1 = 256, nConv = ((l == 0) ? MROWS : NTOK) / 64;
            const int e0 = nF1, e1 = e0 + nCtxF, e2 = e1 + nAttn, e3 = e2 + nConv;
            for (;;) {
                const int u = next_unit(ctl + 2 * l + 8 * rep, lds);
                if (u >= e3) break;
                if (rep == 1) { const int ty = u < e0 ? 1 : u < e1 ? 3 : u < e2 ? 0 : 2; if (REP_PHASE == 25 ? (ty == 0) : (ty != REP_PHASE - 20)) continue; }
                if (u >= e1 && u < e2) attn_unit(u - e1, Pb, Vt, Hb, a.sink + 8 * l, lds);
                else if (u >= e0 && u < e1) { const int v = u - e0, b = v >> 2, kb = v & 3;
                    dftf_unit<256>(Pb + (size_t)(NTOK + b * CTXL) * PW + C_UF, 256, PW, 0, (const bf16_t*)(ws + WS_T256R) + (size_t)(64 * kb) * 256, (const bf16_t*)(ws + WS_T256I) + (size_t)(64 * kb) * 256,
                                   (const bf16_t*)(ws + WS_GT) + (size_t)l * 4 * 64 * 128, Pb, Hb, (size_t)(NTOK + b * CTXL + 64 * kb), 1, 5.656854249492381f, lds); }
                else {
                    const int tid = opaque_tid(), lane = tid & 63, wave = __builtin_amdgcn_readfirstlane(tid >> 6);
                    if (u < e0) { fft1_tables(ws, lds + 65536, tid); __syncthreads(); fft1_wave(u * 8 + wave, (const bf16_t*)(ws + WS_UFP), YF, ws, lds + wave * 8192, lds + 65536, lane); }
                    else conv_wave((u - e2) * 8 + wave, Pb, Hb, a.conv_w + l * 768, a.conv_b + l * 256, lane);
                }
            }
        }
        SEAM(pb + 2);
        REPS(3) if (IN(pb + 3)) {
            const bool gemmwg = (l == 0 && blockIdx.x < 16);
            if (gemmwg) {
                pg8::Gemm g{Hb + (size_t)NTOK * DM, (const bf16_t*)(ws + WS_WOUT) + (size_t)l * DM * DM, NCTX, DM, DM};
                pg8::StaticOrder S; S.init(NCTX, DM, 16, (int)blockIdx.x);
                pg8::EpiY E{Yb + (size_t)NTOK * DM, SSQ + (size_t)NTOK * 16};
                pg8::gemm_phase<pg8::EpiY, pg8::StaticOrder, true, true>((PG8_LAS unsigned char*)lds, g, S, E);
            } else {
                const int tid = opaque_tid(), lane = tid & 63, wave = __builtin_amdgcn_readfirstlane(tid >> 6);
                const int nb0 = (l == 0) ? 16 : 0;
                const int gw = ((int)blockIdx.x - nb0) + wave * ((int)gridDim.x - nb0), NGW = ((int)gridDim.x - nb0) * 8;
                unsigned char* lds_w = lds + wave * 16384;
                for (int t = gw; t < 2048; t += NGW) fft3_wave(t, YF, (const bf16_t*)(ws + WS_GT) + (size_t)l * 4 * 64 * 128, Pb, Hb, ws, lds_w, lane);
            }
            __syncthreads();
        }
        SEAM(pb + 3);
        REPS(4) if (IN(pb + 4)) {
            pg8::Gemm g{Hb, (const bf16_t*)(ws + WS_WOUT) + (size_t)l * DM * DM, NTOK, DM, DM};
            pg8::StaticOrder S; S.init(NTOK, DM, (int)gridDim.x, (int)blockIdx.x);
            pg8::EpiY E{l == 0 ? Yb : HX, l == 0 ? SSQ : (float*)(ws + WS_SSQ1)};
            pg8::gemm_phase<pg8::EpiY, pg8::StaticOrder, true, true>((PG8_LAS unsigned char*)lds, g, S, E);
        }
        SEAM(pb + 4);
    }
#if REP_PHASE == 9
    for (int i = 0; i < 10; ++i) xcd_barrier(xbar);
#endif
    if (IN(11)) norm_phase(a, 2);
#undef IN
#undef SEAM
}

#ifndef MK_MULTI
#define MK_MULTI 0
#endif
extern "C" void kernel_launch(void* const* d_in, const int* in_sizes, int n_in, void* d_out, int out_size, void* d_ws, size_t ws_size, hipStream_t stream) {
    static int grid = 0;
    if (grid == 0) {
        if (n_in != 14 || ws_size < WS_END) { fprintf(stderr, "kernel_launch: unexpected n_in %d or ws_size %zu (need %zu)\n", n_in, ws_size, (size_t)WS_END); grid = -1; return; }
        int dev = 0, cus = 0, per_cu = 0;
        hipGetDevice(&dev); hipDeviceGetAttribute(&cus, hipDeviceAttributeMultiprocessorCount, dev);
        if (hipFuncSetAttribute((const void*)hybrid_fwd, hipFuncAttributeMaxDynamicSharedMemorySize, LDS_BYTES) != hipSuccess) { fprintf(stderr, "kernel_launch: hipFuncSetAttribute failed\n"); grid = -1; return; }
        if (hipOccupancyMaxActiveBlocksPerMultiprocessor(&per_cu, (const void*)hybrid_fwd, NTHREADS, LDS_BYTES) != hipSuccess || per_cu < 1) { fprintf(stderr, "kernel_launch: occupancy query gave %d\n", per_cu); per_cu = 1; }
        (void)hipGetLastError();
        grid = cus * 1;
        fprintf(stderr, "kernel_launch: grid %d (cus %d, per_cu %d)\n", grid, cus, per_cu);
    }
    if (grid < 0) return;
    if (hipMemsetAsync((char*)d_ws + WS_CTL, 0, WS_ZERO_BYTES, stream) != hipSuccess) { fprintf(stderr, "kernel_launch: hipMemsetAsync failed\n"); return; }
    KArgs a{};
    a.x = (const float*)d_in[0]; a.c = (const float*)d_in[1]; a.ctx = (const float*)d_in[2]; a.c_ctx = (const float*)d_in[3]; a.w_mod = (const float*)d_in[4]; a.b_mod = (const float*)d_in[5];
    a.g_pre = (const float*)d_in[6]; a.g_post = (const float*)d_in[7]; a.w_in = (const float*)d_in[8]; a.w_out = (const float*)d_in[9]; a.sink = (const float*)d_in[10]; a.w_f = (const float*)d_in[11];
    a.conv_w = (const float*)d_in[12]; a.conv_b = (const float*)d_in[13];
    a.out = (float*)d_out; a.ws = (unsigned char*)d_ws;
#if MK_MULTI
    for (int ph = 0; ph < 12; ++ph) { a.ph_lo = ph; a.ph_hi = ph + 1; hipLaunchKernelGGL(hybrid_fwd, dim3(grid), dim3(NTHREADS), LDS_BYTES, stream, a); }
#else
    a.ph_lo = 0; a.ph_hi = 12;
    void* args[] = {&a};
    hipError_t e = hipLaunchCooperativeKernel((const void*)hybrid_fwd, dim3(grid), dim3(NTHREADS), args, LDS_BYTES, stream);
    if (e != hipSuccess) fprintf(stderr, "kernel_launch: cooperative launch failed: %s (grid %d)\n", hipGetErrorString(e), grid);
#endif
}
```

```cpp
#include <hip/hip_runtime.h>
#include <hip/hip_cooperative_groups.h>
#include <cstdio>
#include <cstdint>
namespace cg = cooperative_groups;
namespace pg8 {
#define PG8_LAS __attribute__((address_space(3)))
typedef unsigned short bf16_t;
typedef short bf16x8 __attribute__((ext_vector_type(8)));
typedef float f32x4 __attribute__((ext_vector_type(4)));
typedef unsigned u32x4 __attribute__((ext_vector_type(4)));
constexpr int BM = 256, BK = 64, HALF = 128, HTB = HALF * BK * 2  , STAGE_BYTES = 8 * HTB, NXCD = 8, WGM = 8;

__host__ __device__ __forceinline__ int lds_byte(int r, int c) { const int st = (r >> 4) * 2 + (c >> 5), rr = r & 15, cc = c & 31, ob = rr * 64 + cc * 2; return st * 1024 + (ob ^ (((ob >> 9) & 1) << 5)); }
__host__ __device__ __forceinline__ void stage_rc(int b, int& R, int& C) { const int st = b / 1024, sb = b % 1024, swz = sb ^ (((sb >> 9) & 1) << 5); R = (st >> 1) * 16 + swz / 64; C = (st & 1) * 32 + (swz % 64) / 2; }
__host__ __device__ __forceinline__ int perm32(int rho) { const int n = rho >> 4, i = rho & 15; return 8 * (i >> 2) + 4 * n + (i & 3); }

struct Unit { int pm, pn; };
struct Gemm { const bf16_t* A; const bf16_t* Bt; int M, N, K; };

struct StaticOrder {
    int nM, nN, nwg, G, c;
    __host__ __device__ void init(int M, int N, int G_, int c_) { nM = M / BM; nN = N / BM; nwg = nM * nN; G = G_; c = c_; }
    __host__ __device__ bool next(int i, Unit& u) const {
        const long L = (long)i * G + c; if (L >= nwg) return false;
        int wgid = (int)L; { const int q = nwg / NXCD, r = nwg % NXCD, xcd = wgid % NXCD, off = wgid / NXCD; wgid = (xcd < r ? xcd * (q + 1) : r * (q + 1) + (xcd - r) * q) + off; }
        const int nig = WGM * nN, gid = wgid / nig, fm = gid * WGM, gsz = (nM - fm) < WGM ? (nM - fm) : WGM;
        u.pm = fm + ((wgid % nig) % gsz); u.pn = (wgid % nig) / gsz; return true;
    }
    __device__ __forceinline__ void a_ready(const Unit&) const {}
    __device__ __forceinline__ void done(const Unit&) const {}
};

__device__ __forceinline__ unsigned cvt_pk_bf16(float lo, float hi) { unsigned r; asm volatile("v_cvt_pk_bf16_f32 %0, %1, %2" : "=v"(r) : "v"(lo), "v"(hi)); return r; }
typedef unsigned u32x2 __attribute__((ext_vector_type(2)));
__device__ __forceinline__ int swap23(int t) { return (t & ~12) | ((t & 4) << 1) | ((t & 8) >> 1); }
struct EpiProj {
    static constexpr bool PERM = true, AFTER_DRAIN = false;
    bf16_t* P; bf16_t* Vt; const float* rope; bf16_t* UFP; float qscale;
    __device__ __forceinline__ void operator()(const f32x4 (&acc)[2][2][4][2], const Unit& u, int wr, int wc, int fr, int fq) const {
        const int row0 = u.pm * BM + wr * 64 + fr;
        const int pn = u.pn;
        const bool ctxrow = u.pm >= 128;
        f32x4 CS[2][4], SN[2][4];
        if (pn <= 2) {
#pragma unroll
            for (int ai = 0; ai < 2; ++ai)
#pragma unroll
                for (int m = 0; m < 4; ++m) {
                    CS[ai][m] = (f32x4){1.f, 1.f, 1.f, 1.f}; SN[ai][m] = (f32x4){0.f, 0.f, 0.f, 0.f};
                    if (!ctxrow) { const int t = (row0 + ai * HALF + m * 16) & 8191; const int pos = (wc & 1) ? (t & 63) : (t >> 6);
                        CS[ai][m] = *(const f32x4*)(rope + pos * 32 + 4 * fq); SN[ai][m] = *(const f32x4*)(rope + pos * 32 + 16 + 4 * fq); }
                }
            __builtin_amdgcn_sched_barrier(0);
        }
#pragma unroll
        for (int ai = 0; ai < 2; ++ai)
#pragma unroll
            for (int m = 0; m < 4; ++m) {
                const int row = row0 + ai * HALF + m * 16;
                bf16_t* rowp = P + (size_t)row * 2816 + pn * BM + wc * 32 + 8 * fq;
                if (pn == 5 && !ctxrow) { const int t = row & 8191; rowp = UFP + ((size_t)(((row >> 13) * 64 + (t & 63)) * 128 + (t >> 6))) * 256 + wc * 32 + 8 * fq; }
                if (pn > 2) {
#pragma unroll
                    for (int bj = 0; bj < 2; ++bj) { const f32x4 v0 = acc[ai][bj][m][0], v1 = acc[ai][bj][m][1];
                        u32x4 w; w.x = cvt_pk_bf16(v0[0], v0[1]); w.y = cvt_pk_bf16(v0[2], v0[3]); w.z = cvt_pk_bf16(v1[0], v1[1]); w.w = cvt_pk_bf16(v1[2], v1[3]);
                        *(u32x4*)(rowp + bj * HALF) = w; }
                } else {
                    const f32x4 cs = CS[ai][m], sn = SN[ai][m];
#pragma unroll
                    for (int bj = 0; bj < 2; ++bj) {
                        f32x4 v0 = acc[ai][bj][m][0], v1 = acc[ai][bj][m][1];
                        if (pn == 2 && bj == 1) {
                            int b, tok; if (ctxrow) { const int rr = row - 32768; b = rr >> 8; tok = 8192 + (rr & 255); } else { b = row >> 13; tok = row & 8191; }
                            const int ptok = swap23(tok);
                            bf16_t* vp = Vt + ((size_t)((b * 2 + (wc >> 1)) * 64 + 32 * (wc & 1) + 8 * fq)) * 8448 + ptok;
                            const unsigned w0 = cvt_pk_bf16(v0[0], v0[1]), w1 = cvt_pk_bf16(v0[2], v0[3]), w2 = cvt_pk_bf16(v1[0], v1[1]), w3 = cvt_pk_bf16(v1[2], v1[3]);
                            vp[0 * 8448] = (bf16_t)(w0 & 0xffffu); vp[1 * 8448] = (bf16_t)(w0 >> 16); vp[2 * 8448] = (bf16_t)(w1 & 0xffffu); vp[3 * 8448] = (bf16_t)(w1 >> 16);
                            vp[4 * 8448] = (bf16_t)(w2 & 0xffffu); vp[5 * 8448] = (bf16_t)(w2 >> 16); vp[6 * 8448] = (bf16_t)(w3 & 0xffffu); vp[7 * 8448] = (bf16_t)(w3 >> 16);
                        } else {
                            const f32x4 r0 = v0 * cs - v1 * sn, r1 = v0 * sn + v1 * cs;
                            v0 = r0; v1 = r1;
                            if (pn < 2) { v0 = v0 * qscale; v1 = v1 * qscale; }
                            u32x4 w; w.x = cvt_pk_bf16(v0[0], v0[1]); w.y = cvt_pk_bf16(v0[2], v0[3]); w.z = cvt_pk_bf16(v1[0], v1[1]); w.w = cvt_pk_bf16(v1[2], v1[3]);
                            *(u32x4*)(rowp + bj * HALF) = w;
                        }
                    }
                }
            }
    }
};
struct EpiY {
    static constexpr bool PERM = true, AFTER_DRAIN = false;
    bf16_t* Y; float* ssq;
    __device__ __forceinline__ void operator()(const f32x4 (&acc)[2][2][4][2], const Unit& u, int wr, int wc, int fr, int fq) const {
        const int row0 = u.pm * BM + wr * 64 + fr;
#pragma unroll
        for (int ai = 0; ai < 2; ++ai)
#pragma unroll
            for (int m = 0; m < 4; ++m) {
                const int row = row0 + ai * HALF + m * 16;
                bf16_t* rowp = Y + (size_t)row * 1024 + u.pn * BM + wc * 32 + 8 * fq;
                float s = 0.f;
#pragma unroll
                for (int bj = 0; bj < 2; ++bj) { const f32x4 v0 = acc[ai][bj][m][0], v1 = acc[ai][bj][m][1];
                    s += (v0[0] * v0[0] + v0[1] * v0[1]) + (v0[2] * v0[2] + v0[3] * v0[3]) + (v1[0] * v1[0] + v1[1] * v1[1]) + (v1[2] * v1[2] + v1[3] * v1[3]);
                    u32x4 w; w.x = cvt_pk_bf16(v0[0], v0[1]); w.y = cvt_pk_bf16(v0[2], v0[3]); w.z = cvt_pk_bf16(v1[0], v1[1]); w.w = cvt_pk_bf16(v1[2], v1[3]);
                    *(u32x4*)(rowp + bj * HALF) = w; }
                s += __shfl_xor(s, 16); s += __shfl_xor(s, 32);
                if (fq == 0) ssq[(size_t)row * 16 + u.pn * 4 + wc] = s;
            }
    }
};
template <class Epi, class Sched, bool ALIGN_EPI = false, bool SP2 = false>
__device__ __forceinline__ void gemm_phase(PG8_LAS unsigned char* lds, const Gemm g, const Sched& S, const Epi& E) {
    int tid_ = threadIdx.x; asm volatile("" : "+v"(tid_));
    const int tid = tid_, wid = __builtin_amdgcn_readfirstlane(tid >> 6), lane = tid & 63, wr = wid >> 2, wc = wid & 3, fr = lane & 15, fq = lane >> 4;
    const int K = g.K, nt = K / BK;
    unsigned voffA[2], voffB[2];
#pragma unroll
    for (int i = 0; i < 2; ++i) { int R, C; stage_rc(tid * 16 + i * 8192, R, C); const int Rb = Epi::PERM ? ((R & ~31) + perm32(R & 31)) : R;
        voffA[i] = (unsigned)(R * K + C) * 2u; voffB[i] = (unsigned)(Rb * K + C) * 2u; }
    const size_t kstep = (size_t)(BK * 2);
    const size_t hstep = (size_t)HALF * K * 2;
    const size_t tstep = 2 * hstep;
    const unsigned ldsw = (unsigned)wid * 1024u;
    const int aoff = lds_byte(wr * 64 + fr, fq * 8), boff = lds_byte(wc * 32 + fr, fq * 8);
#define PG8_SA(b, h) (((b) * 2 + (h)) * HTB)
#define PG8_SB(b, h) ((4 + (b) * 2 + (h)) * HTB)
#define PG8_STAGE(bufoff, gbase, voff) do { _Pragma("unroll") for (int _i = 0; _i < 2; ++_i) \
        __builtin_amdgcn_global_load_lds((const unsigned*)((const char*)(gbase) + (voff)[_i]), (PG8_LAS unsigned*)(lds + (bufoff) + ldsw + _i * 8192), 16, 0, 0); } while (0)
#define PG8_LDA(dst, b, h) do { _Pragma("unroll") for (int m = 0; m < 4; ++m) _Pragma("unroll") for (int k = 0; k < 2; ++k) dst[m][k] = *(const PG8_LAS bf16x8*)(lds + PG8_SA(b, h) + aoff + m * 2048 + k * 1024); } while (0)
#define PG8_LDB(dst, b, h) do { _Pragma("unroll") for (int n = 0; n < 2; ++n) _Pragma("unroll") for (int k = 0; k < 2; ++k) dst[n][k] = *(const PG8_LAS bf16x8*)(lds + PG8_SB(b, h) + boff + n * 2048 + k * 1024); } while (0)
#define PG8_MMA(ai, bj, At, Bt) do { __builtin_amdgcn_s_setprio(1); _Pragma("unroll") for (int m = 0; m < 4; ++m) _Pragma("unroll") for (int n = 0; n < 2; ++n) _Pragma("unroll") for (int k = 0; k < 2; ++k) \
        acc[ai][bj][m][n] = __builtin_amdgcn_mfma_f32_16x16x32_bf16(Bt[n][k], At[m][k], acc[ai][bj][m][n], 0, 0, 0); __builtin_amdgcn_s_setprio(0); } while (0)
#define PG8_WAIT_V(n) asm volatile("s_waitcnt vmcnt(" #n ")" ::: "memory")
#define PG8_WAIT_L(n) asm volatile("s_waitcnt lgkmcnt(" #n ")" ::: "memory")
#define PG8_BAR __builtin_amdgcn_s_barrier()
#define PG8_SCHED __builtin_amdgcn_sched_barrier(0)
    Unit cur, nxt; int ui = 0;
    if (!S.next(0, cur)) return;
    f32x4 acc[2][2][4][2];
#pragma unroll
    for (int a = 0; a < 2; ++a)
#pragma unroll
        for (int b = 0; b < 2; ++b)
#pragma unroll
            for (int m = 0; m < 4; ++m)
#pragma unroll
                for (int n = 0; n < 2; ++n) acc[a][b][m][n] = (f32x4){0.f, 0.f, 0.f, 0.f};
    bf16x8 At[4][2], B0[2][2], B1[2][2];
    const char* cA = (const char*)g.A + (size_t)cur.pm * tstep; const char* cB = (const char*)g.Bt + (size_t)cur.pn * tstep;
    S.a_ready(cur);
    if constexpr (SP2) {
        PG8_STAGE(PG8_SB(0, 0), cB, voffB); PG8_STAGE(PG8_SB(0, 1), cB + hstep, voffB); PG8_STAGE(PG8_SA(0, 0), cA, voffA); PG8_STAGE(PG8_SA(0, 1), cA + hstep, voffA);
        if (wr == 1) PG8_BAR;
        PG8_WAIT_V(2); PG8_BAR;
        PG8_STAGE(PG8_SB(1, 0), cB + kstep, voffB); PG8_STAGE(PG8_SA(1, 0), cA + kstep, voffA); PG8_STAGE(PG8_SB(1, 1), cB + hstep + kstep, voffB);
        PG8_WAIT_V(6); PG8_BAR;
    } else {
        PG8_STAGE(PG8_SB(0, 0), cB, voffB); PG8_STAGE(PG8_SA(0, 0), cA, voffA); PG8_STAGE(PG8_SB(0, 1), cB + hstep, voffB); PG8_STAGE(PG8_SA(0, 1), cA + hstep, voffA);
        if (wr == 1) PG8_BAR;
        PG8_WAIT_V(4); PG8_BAR;
        PG8_STAGE(PG8_SB(1, 0), cB + kstep, voffB); PG8_STAGE(PG8_SA(1, 0), cA + kstep, voffA); PG8_STAGE(PG8_SB(1, 1), cB + hstep + kstep, voffB);
        PG8_WAIT_V(6); PG8_BAR;
    }
    for (;;) {
        const bool has_next = S.next(ui + 1, nxt);
        const char* nA = has_next ? (const char*)g.A + (size_t)nxt.pm * tstep : cA; const char* nB = has_next ? (const char*)g.Bt + (size_t)nxt.pn * tstep : cB;
        for (int t = 0; t < nt; t += 2) {
            const bool last = (t == nt - 2);
            const char* a1 = cA + (size_t)(t + 1) * kstep;
            const char* a2 = last ? nA : cA + (size_t)(t + 2) * kstep; const char* b2 = last ? nB : cB + (size_t)(t + 2) * kstep;
            const char* a3 = a2 + kstep; const char* b3 = b2 + kstep;
            if (last && has_next) S.a_ready(nxt);
            if constexpr (SP2) {
            PG8_LDB(B0, 0, 0); PG8_LDB(B1, 0, 1); PG8_SCHED; PG8_LDA(At, 0, 0); PG8_STAGE(PG8_SA(1, 1), a1 + hstep, voffA);
            PG8_WAIT_V(8); PG8_WAIT_L(0); PG8_BAR; PG8_MMA(0, 0, At, B0); PG8_MMA(0, 1, At, B1); PG8_BAR; PG8_SCHED;
            PG8_LDA(At, 0, 1); PG8_STAGE(PG8_SB(0, 0), b2, voffB); PG8_STAGE(PG8_SB(0, 1), b2 + hstep, voffB); PG8_STAGE(PG8_SA(0, 0), a2, voffA);
            PG8_WAIT_V(8); PG8_WAIT_L(0); PG8_BAR; PG8_MMA(1, 0, At, B0); PG8_MMA(1, 1, At, B1); PG8_BAR; PG8_SCHED;
            PG8_LDB(B0, 1, 0); PG8_LDB(B1, 1, 1); PG8_SCHED; PG8_LDA(At, 1, 0); PG8_STAGE(PG8_SA(0, 1), a2 + hstep, voffA);
            PG8_WAIT_V(8); PG8_WAIT_L(0); PG8_BAR; PG8_MMA(0, 0, At, B0); PG8_MMA(0, 1, At, B1); PG8_BAR; PG8_SCHED;
            PG8_LDA(At, 1, 1); PG8_STAGE(PG8_SB(1, 0), b3, voffB); PG8_STAGE(PG8_SB(1, 1), b3 + hstep, voffB); PG8_STAGE(PG8_SA(1, 0), a3, voffA);
            PG8_WAIT_V(8); PG8_WAIT_L(0); PG8_BAR; PG8_MMA(1, 0, At, B0); PG8_MMA(1, 1, At, B1); PG8_BAR; PG8_SCHED;
            } else {
            PG8_LDB(B0, 0, 0); PG8_SCHED; PG8_LDA(At, 0, 0); PG8_STAGE(PG8_SA(1, 1), a1 + hstep, voffA);
            PG8_WAIT_L(8); PG8_BAR; PG8_WAIT_L(0); PG8_MMA(0, 0, At, B0); PG8_BAR; PG8_SCHED;
            PG8_LDB(B1, 0, 1); PG8_STAGE(PG8_SB(0, 0), b2, voffB);
            PG8_BAR; PG8_WAIT_L(0); PG8_MMA(0, 1, At, B1); PG8_BAR;
            PG8_LDA(At, 0, 1); PG8_STAGE(PG8_SA(0, 0), a2, voffA);
            PG8_BAR; PG8_WAIT_L(0); PG8_MMA(1, 0, At, B0); PG8_BAR; PG8_SCHED;
            PG8_STAGE(PG8_SB(0, 1), b2 + hstep, voffB);
            PG8_WAIT_V(6); PG8_BAR; PG8_MMA(1, 1, At, B1); PG8_BAR;
            PG8_LDB(B0, 1, 0); PG8_SCHED; PG8_LDA(At, 1, 0); PG8_STAGE(PG8_SA(0, 1), a2 + hstep, voffA);
            PG8_WAIT_L(8); PG8_BAR; PG8_WAIT_L(0); PG8_MMA(0, 0, At, B0); PG8_BAR; PG8_SCHED;
            PG8_LDB(B1, 1, 1); PG8_STAGE(PG8_SB(1, 0), b3, voffB);
            PG8_BAR; PG8_WAIT_L(0); PG8_MMA(0, 1, At, B1); PG8_BAR;
            PG8_LDA(At, 1, 1); PG8_STAGE(PG8_SA(1, 0), a3, voffA);
            PG8_BAR; PG8_WAIT_L(0); PG8_MMA(1, 0, At, B0); PG8_BAR; PG8_SCHED;
            PG8_STAGE(PG8_SB(1, 1), b3 + hstep, voffB);
            PG8_WAIT_V(6); PG8_BAR; PG8_MMA(1, 1, At, B1); PG8_BAR;
            }
        }
        if constexpr (ALIGN_EPI) { if (wr == 0) PG8_BAR; }
        if constexpr (!Epi::AFTER_DRAIN) { E(acc, cur, wr, wc, fr, fq); S.done(cur); }
        if (!has_next) break;
#pragma unroll
        for (int a = 0; a < 2; ++a)
#pragma unroll
            for (int b = 0; b < 2; ++b)
#pragma unroll
                for (int m = 0; m < 4; ++m)
#pragma unroll
                    for (int n = 0; n < 2; ++n) acc[a][b][m][n] = (f32x4){0.f, 0.f, 0.f, 0.f};
        cur = nxt; cA = nA; cB = nB; ++ui;
        if constexpr (ALIGN_EPI) { if (wr == 1) PG8_BAR; }
    }
    PG8_WAIT_V(0);
    if constexpr (!ALIGN_EPI) { if (wr == 0) PG8_BAR; }
    PG8_BAR;
    if constexpr (Epi::AFTER_DRAIN) { E.fused(acc, cur, wr, wc, fr, fq, lds, wid, lane); S.done(cur); }
#undef PG8_SA
#undef PG8_SB
#undef PG8_STAGE
#undef PG8_LDA
#undef PG8_LDB
#undef PG8_MMA
#undef PG8_WAIT_V
#undef PG8_WAIT_L
#undef PG8_BAR
#undef PG8_SCHED
}
}

typedef unsigned short bf16_t;
typedef short bf16x8 __attribute__((ext_vector_type(8)));
typedef float f32x4 __attribute__((ext_vector_type(4)));
typedef float f32x16 __attribute__((ext_vector_type(16)));
typedef unsigned u32x4 __attribute__((ext_vector_type(4)));
typedef unsigned u32x2 __attribute__((ext_vector_type(2)));
#define LAS __attribute__((address_space(3)))
__device__ __forceinline__ int opaque_tid() { int t = threadIdx.x; asm volatile("" : "+v"(t)); return t; }

constexpr int DM = 1024, NBATCH = 4, SEQ = 8192, NTOK = NBATCH * SEQ, CTXL = 256, NCTX = NBATCH * CTXL, MROWS = NTOK + NCTX;
constexpr int PW = 2816;
constexpr int C_Q = 0, C_K = 512, C_V = 640, C_GA = 768, C_UF = 1280, C_GF = 1536, C_ZC = 1792, C_BC = 2048, C_CC = 2304, C_GC = 2560;
constexpr int VT_PITCH = SEQ + CTXL;
constexpr float NORM_EPS = 1e-6f;
constexpr float LOG2E = 1.4426950408889634f;

constexpr size_t KiB = 1024, MiB = 1u << 20;
constexpr size_t WS_CTL = 0;
constexpr size_t WS_BAR = 16 * KiB;
constexpr size_t WS_ZERO_BYTES = 32 * KiB;
constexpr size_t WS_MOD = 64 * KiB;
constexpr size_t WS_ROPE = 256 * KiB;
constexpr size_t WS_TW = 320 * KiB;
constexpr size_t WS_T1R = 384 * KiB, WS_T1I = 416 * KiB;
constexpr size_t WS_T3R = 448 * KiB, WS_T3I = 464 * KiB;
constexpr size_t WS_T256R = 512 * KiB, WS_T256I = 640 * KiB;
constexpr size_t WS_GT = 768 * KiB;
constexpr size_t WS_SSQ = 1 * MiB;
constexpr size_t WS_WIN = 4 * MiB;
constexpr size_t WS_WOUT = 16 * MiB;
constexpr size_t WS_SSQ1 = 24 * MiB;
constexpr size_t WS_MODP = 28 * MiB;
constexpr size_t WS_HX = 32 * MiB;
constexpr size_t WS_P = 112 * MiB;
constexpr size_t WS_VT = 304 * MiB;
constexpr size_t WS_H = 320 * MiB;
constexpr size_t WS_Y = 392 * MiB;
constexpr size_t WS_YF = 464 * MiB;
constexpr size_t WS_CTX1 = 100 * MiB;
constexpr size_t WS_UFP = 496 * MiB;
constexpr size_t WS_END = 512 * MiB;
static_assert(WS_BAR + 3456 * 4 <= WS_ZERO_BYTES && WS_MODP + (size_t)2 * 8 * 5 * 3072 * 4 <= WS_HX && WS_SSQ + (size_t)MROWS * 16 * 4 <= WS_WIN && WS_WIN + (size_t)2 * PW * DM * 2 <= WS_WOUT && WS_HX + (size_t)MROWS * DM * 2 <= WS_P && WS_P + (size_t)MROWS * PW * 2 <= WS_VT &&
              WS_VT + (size_t)8 * 64 * VT_PITCH * 2 <= WS_H && WS_H + (size_t)MROWS * DM * 2 <= WS_Y && WS_Y + (size_t)MROWS * DM * 2 <= WS_YF && WS_YF + (size_t)4 * 128 * 64 * 512 * 2 <= WS_UFP && WS_UFP + (size_t)NTOK * 256 * 2 <= WS_END && WS_HX + (size_t)MROWS * DM * 2 <= WS_CTX1 && WS_CTX1 + (size_t)NCTX * DM * 4 <= WS_P, "ws map");

constexpr int LDS_BYTES = 147456;
constexpr int LDS_SCHED = LDS_BYTES - 64;
constexpr int LDS_BARST = LDS_BYTES - 32;
constexpr int NTHREADS = 512;

__device__ __forceinline__ float bf2f(unsigned h) { return __uint_as_float(h << 16); }
__device__ __forceinline__ unsigned pkbf(float lo, float hi) { unsigned r; asm volatile("v_cvt_pk_bf16_f32 %0, %1, %2" : "=v"(r) : "v"(lo), "v"(hi)); return r; }
__device__ __forceinline__ float silu_f(float x) { return x * __builtin_amdgcn_rcpf(1.f + __builtin_amdgcn_exp2f(-x * LOG2E)); }
__device__ __forceinline__ float wave_sum(float v) {
#pragma unroll
    for (int o = 1; o < 64; o <<= 1) v += __shfl_xor(v, o);
    return v;
}
__device__ __forceinline__ int swap23(int t) { return (t & ~12) | ((t & 4) << 1) | ((t & 8) >> 1); }
__device__ __forceinline__ int crow(int r, int hi) { return (r & 3) + 8 * (r >> 2) + 4 * hi; }
__device__ __forceinline__ bf16x8 pack8(const f32x16& p, int base) {
    u32x4 w; w.x = pkbf(p[base + 0], p[base + 1]); w.y = pkbf(p[base + 2], p[base + 3]); w.z = pkbf(p[base + 4], p[base + 5]); w.w = pkbf(p[base + 6], p[base + 7]);
    return __builtin_bit_cast(bf16x8, w);
}
#define MFMA32(a, b, c) __builtin_amdgcn_mfma_f32_32x32x16_bf16((a), (b), (c), 0, 0, 0)

struct KArgs {
    const float *x, *c, *ctx, *c_ctx, *w_mod, *b_mod, *g_pre, *g_post, *w_in, *w_out, *sink, *w_f, *conv_w, *conv_b;
    float* out; unsigned char* ws; int ph_lo, ph_hi;
};

__device__ __forceinline__ int prow_qk(int n) { return (n & ~31) | (8 * ((n >> 2) & 3) + 4 * ((n >> 4) & 1) + (n & 3)); }
__device__ __forceinline__ void p0_transpose_item(const float* W, int K, int N, bf16_t* WT, int nperm, float* scr, int item, int lane) {
    const int nblk = N / 32, kb = item / nblk, nb = item % nblk, k0 = 64 * kb, n0 = 32 * nb;
    { float wv[32];
#pragma unroll
      for (int i = 0; i < 32; ++i) wv[i] = W[(size_t)(k0 + 2 * i + (lane >> 5)) * N + n0 + (lane & 31)];
      __builtin_amdgcn_sched_barrier(0);
#pragma unroll
      for (int i = 0; i < 32; ++i) scr[(2 * i + (lane >> 5)) * 33 + (lane & 31)] = wv[i];
      __builtin_amdgcn_sched_barrier(0); }
    asm volatile("s_waitcnt lgkmcnt(0)" ::: "memory");
    const int c = lane & 7;
#pragma unroll
    for (int j = 0; j < 4; ++j) { const int n = (lane >> 3) + 8 * j; const float* s = scr + (8 * c) * 33 + n;
        u32x4 o; o.x = pkbf(s[0 * 33], s[1 * 33]); o.y = pkbf(s[2 * 33], s[3 * 33]); o.z = pkbf(s[4 * 33], s[5 * 33]); o.w = pkbf(s[6 * 33], s[7 * 33]);
        const int nl = n0 + n; const int np = nl < nperm ? prow_qk(nl) : nl;
        *(u32x4*)(WT + (size_t)np * K + k0 + 8 * c) = o; }
    asm volatile("s_waitcnt lgkmcnt(0)" ::: "memory");
}

__device__ __forceinline__ void p0_mod_gemv(const KArgs& a, int item, float* ldsf) {
    const int tid = opaque_tid(), lane = tid & 63, wave = tid >> 6;
    const int l = item / 96, col0 = (item % 96) * 32;
    float* s = ldsf;
    float* red = ldsf + 5 * 1024;
    for (int i = tid; i < 5 * 1024; i += NTHREADS) { const int bb = i >> 10, k = i & 1023; const float v = bb < 4 ? a.c[bb * 1024 + k] : a.c_ctx[k]; s[i] = v / (1.f + __expf(-v)); }
    __syncthreads();
    const int col = lane & 31, kh = lane >> 5;
    const float* W = a.w_mod + (size_t)l * 1024 * 3072 + (size_t)(wave * 128 + kh) * 3072 + col0 + col;
    float w[64];
#pragma unroll
    for (int i = 0; i < 64; ++i) w[i] = W[(size_t)(2 * i) * 3072];
    float acc[5] = {0.f, 0.f, 0.f, 0.f, 0.f};
#pragma unroll
    for (int i = 0; i < 64; ++i)
#pragma unroll
        for (int bb = 0; bb < 5; ++bb) acc[bb] += w[i] * s[bb * 1024 + wave * 128 + 2 * i + kh];
#pragma unroll
    for (int bb = 0; bb < 5; ++bb) red[((wave * 2 + kh) * 5 + bb) * 32 + col] = acc[bb];
    __syncthreads();
    if (tid < 160) { const int bb = tid >> 5, cc = tid & 31; float v = a.b_mod[l * 3072 + col0 + cc];
#pragma unroll
        for (int ww = 0; ww < 16; ++ww) v += red[(ww * 5 + bb) * 32 + cc];
        ((float*)(a.ws + WS_MOD))[(l * 5 + bb) * 3072 + col0 + cc] = v; }
    __syncthreads();
}

__device__ __forceinline__ void p0_prologue(const KArgs& a, unsigned char* lds) {
    const int tid = opaque_tid(), lane = tid & 63, wave = tid >> 6;
    const int G = gridDim.x, bx = blockIdx.x;
    unsigned char* ws = a.ws;
    if (bx < 192) p0_mod_gemv(a, bx, (float*)lds);
    {
        float* scr = (float*)(lds + wave * 16384);
        const int gw = bx * 8 + wave, NGW = G * 8;
        constexpr int I_IN = (DM / 64) * (PW / 32), I_OUT = (DM / 64) * (DM / 32);
        constexpr int NIT = 2 * (I_IN + I_OUT);
        for (int it = gw; it < NIT; it += NGW) {
            int r = it; const int l = r / (I_IN + I_OUT); r -= l * (I_IN + I_OUT);
            if (r < I_IN) p0_transpose_item(a.w_in + (size_t)l * DM * PW, DM, PW, (bf16_t*)(ws + WS_WIN) + (size_t)l * PW * DM, 640, scr, r, lane);
            else p0_transpose_item(a.w_out + (size_t)l * DM * DM, DM, DM, (bf16_t*)(ws + WS_WOUT) + (size_t)l * DM * DM, 0, scr, r - I_IN, lane);
        }
    }
    const int gt = bx * NTHREADS + tid, NGT = G * NTHREADS;
    for (int i = gt; i < 128 * 16; i += NGT) {
        const int pos = i >> 4, f = i & 15; const float inv = powf(10000.0f, -(float)f / 16.0f); const float ang = (float)pos * inv;
        float* rp = (float*)(ws + WS_ROPE) + pos * 32; rp[f] = cosf(ang); rp[16 + f] = sinf(ang);
    }
    for (int i = gt; i < 8192; i += NGT) { float sn, cs; sincospif((float)i * (2.0f / 8192.0f), &sn, &cs); float* t = (float*)(ws + WS_TW) + 2 * i; t[0] = cs; t[1] = sn; }
    for (int i = gt; i < 128 * 128; i += NGT) { const int k = i >> 7, n = i & 127; float sn, cs; sincospif((float)((k * n) & 127) * (2.0f / 128.0f), &sn, &cs);
        ((bf16_t*)(ws + WS_T1R))[i] = (bf16_t)(pkbf(cs, 0.f) & 0xffffu); ((bf16_t*)(ws + WS_T1I))[i] = (bf16_t)(pkbf(-sn, 0.f) & 0xffffu); }
    for (int i = gt; i < 64 * 128; i += NGT) { const int k = i >> 7, kk = i & 127, n = kk & 63; float sn, cs; sincospif((float)((k * n) & 63) * (2.0f / 64.0f), &sn, &cs);
        const float tr = kk < 64 ? cs : sn, ti = kk < 64 ? -sn : cs;
        const int fpos = ((((k >> 5) * 8 + (kk >> 4)) * 64 + ((k & 31) + 32 * ((kk >> 3) & 1))) * 8) + (kk & 7);
        ((bf16_t*)(ws + WS_T3R))[fpos] = (bf16_t)(pkbf(tr, 0.f) & 0xffffu); ((bf16_t*)(ws + WS_T3I))[fpos] = (bf16_t)(pkbf(ti, 0.f) & 0xffffu); }
    for (int i = gt; i < 256 * 256; i += NGT) { const int k = i >> 8, n = i & 255; float sn, cs; sincospif((float)((k * n) & 255) * (2.0f / 256.0f), &sn, &cs);
        ((bf16_t*)(ws + WS_T256R))[i] = (bf16_t)(pkbf(cs, 0.f) & 0xffffu); ((bf16_t*)(ws + WS_T256I))[i] = (bf16_t)(pkbf(-sn, 0.f) & 0xffffu); }
    {
        __syncthreads();
        float* trig = (float*)lds;
        if (tid < 64) { float sn, cs; sincospif((float)tid * (2.0f / 64.0f), &sn, &cs); trig[tid] = cs; trig[64 + tid] = sn; }
        __syncthreads();
        for (int i = gt; i < 2 * 4 * 64 * 128; i += NGT) {
            const int kk = i & 127, d = (i >> 7) & 63, g = (i >> 13) & 3, l = i >> 15; const int part = kk >> 6, c = swap23(kk & 63);
            const float* wf = a.w_f + ((size_t)(l * 4 + g) * 64) * 64 + d; float sacc = 0.f;
            float wfv[64];
#pragma unroll
            for (int j = 0; j < 64; ++j) wfv[j] = wf[j * 64];
            __builtin_amdgcn_sched_barrier(0);
#pragma unroll
            for (int j = 0; j < 64; ++j) sacc += trig[part * 64 + ((c * j) & 63)] * wfv[j];
            const int gpos = ((((((l * 4 + g) * 2 + (d >> 5)) * 8 + (kk >> 4)) * 64) + ((d & 31) + 32 * ((kk >> 3) & 1))) * 8) + (kk & 7);
            ((bf16_t*)(ws + WS_GT))[gpos] = (bf16_t)(pkbf(sacc * (1.0f / 724.0773439350246f), 0.f) & 0xffffu);
        }
        __syncthreads();
    }
}

__device__ __forceinline__ void norm_rows4(int mode, int lane, const float* src, float* dst, const bf16_t* y0, const float* ssq0, const bf16_t* y1, const float* ssq1, bf16_t* hx,
                                           const f32x4 (&GA0)[4], const f32x4 (&GA1)[4], const f32x4 (&GB)[4], const f32x4 (&GC)[4]) {
    f32x4 v[4][4];
#pragma unroll
    for (int rr = 0; rr < 4; ++rr)
#pragma unroll
        for (int j = 0; j < 4; ++j) v[rr][j] = *(const f32x4*)(src + (size_t)rr * DM + 4 * lane + 256 * j);
    if (mode != 0) {
        u32x2 yw[4][4], yx[4][4]; float p[4], p1[4];
#pragma unroll
        for (int rr = 0; rr < 4; ++rr) { p[rr] = ssq0[rr * 16 + (lane & 15)];
#pragma unroll
            for (int j = 0; j < 4; ++j) yw[rr][j] = *(const u32x2*)(y0 + (size_t)rr * DM + 4 * lane + 256 * j); }
        if (mode == 2) {
#pragma unroll
            for (int rr = 0; rr < 4; ++rr) { p1[rr] = ssq1[rr * 16 + (lane & 15)];
#pragma unroll
                for (int j = 0; j < 4; ++j) yx[rr][j] = *(const u32x2*)(y1 + (size_t)rr * DM + 4 * lane + 256 * j); }
        }
#pragma unroll
        for (int rr = 0; rr < 4; ++rr) {
            float q = p[rr]; q += __shfl_xor(q, 1); q += __shfl_xor(q, 2); q += __shfl_xor(q, 4); q += __shfl_xor(q, 8);
            const float rstd = 1.0f / sqrtf(q * (1.0f / DM) + NORM_EPS);
#pragma unroll
            for (int j = 0; j < 4; ++j) {
                f32x4 yy; yy[0] = bf2f(yw[rr][j].x & 0xffffu); yy[1] = bf2f(yw[rr][j].x >> 16); yy[2] = bf2f(yw[rr][j].y & 0xffffu); yy[3] = bf2f(yw[rr][j].y >> 16);
                v[rr][j] = v[rr][j] + GA0[j] * (yy * rstd);
            }
        }
        if (mode == 2) {
#pragma unroll
            for (int rr = 0; rr < 4; ++rr) {
                float q = p1[rr]; q += __shfl_xor(q, 1); q += __shfl_xor(q, 2); q += __shfl_xor(q, 4); q += __shfl_xor(q, 8);
                const float rstd = 1.0f / sqrtf(q * (1.0f / DM) + NORM_EPS);
#pragma unroll
                for (int j = 0; j < 4; ++j) {
                    f32x4 yy; yy[0] = bf2f(yx[rr][j].x & 0xffffu); yy[1] = bf2f(yx[rr][j].x >> 16); yy[2] = bf2f(yx[rr][j].y & 0xffffu); yy[3] = bf2f(yx[rr][j].y >> 16);
                    v[rr][j] = v[rr][j] + GA1[j] * (yy * rstd);
                    *(f32x4*)(dst + (size_t)rr * DM + 4 * lane + 256 * j) = v[rr][j];
                }
            }
        }
    }
    if (mode != 2) {
        float s[4];
#pragma unroll
        for (int rr = 0; rr < 4; ++rr) { float t = 0.f;
#pragma unroll
            for (int j = 0; j < 4; ++j) t += (v[rr][j][0] * v[rr][j][0] + v[rr][j][1] * v[rr][j][1]) + (v[rr][j][2] * v[rr][j][2] + v[rr][j][3] * v[rr][j][3]);
            s[rr] = t; }
#pragma unroll
        for (int o = 1; o < 64; o <<= 1) {
#pragma unroll
            for (int rr = 0; rr < 4; ++rr) s[rr] += __shfl_xor(s[rr], o); }
#pragma unroll
        for (int rr = 0; rr < 4; ++rr) {
            const float rstd = 1.0f / sqrtf(s[rr] * (1.0f / DM) + NORM_EPS);
#pragma unroll
            for (int j = 0; j < 4; ++j) {
                const f32x4 o = (v[rr][j] * rstd) * GB[j] + GC[j];
                u32x2 w; w.x = pkbf(o[0], o[1]); w.y = pkbf(o[2], o[3]);
                *(u32x2*)(hx + (size_t)rr * DM + 4 * lane + 256 * j) = w;
            }
        }
    }
}
__device__ __forceinline__ void norm_phase(const KArgs& a, int mode) {
    const int tid = opaque_tid(), lane = tid & 63, wave = tid >> 6;
    const int NGW = gridDim.x * 8;
    unsigned char* ws = a.ws;
    const float* mod = (const float*)(ws + WS_MOD);
    const int lp = (mode == 0) ? 0 : 1;
    bf16_t* HX = (bf16_t*)(ws + WS_HX); const bf16_t* Y0 = (const bf16_t*)(ws + WS_Y); const float* SSQ0 = (const float*)(ws + WS_SSQ);
    const bf16_t* Y1 = (const bf16_t*)(ws + WS_HX); const float* SSQ1 = (const float*)(ws + WS_SSQ1);
    const int gw2 = wave * (int)gridDim.x + (int)blockIdx.x;
    const int nlat = NTOK / 4;
    int curb = -1; f32x4 GA0[4], GA1[4], GB[4], GC[4];
    int base = gw2 * 4, sub = 0, itc = nlat + gw2; bool inctx = false;
    for (;;) {
        int it;
        if (!inctx) { if (base >= nlat) { inctx = true; continue; } it = base + sub; if (++sub == 4) { sub = 0; base += NGW * 4; } }
        else { if (mode == 2 || itc >= nlat + NCTX / 4) break; it = itc; itc += NGW; }
        const int r = it * 4;
        const int b = r < NTOK ? (r >> 13) : 4;
        if (b != curb) { curb = b;
            const float* mp = mod + (lp * 5 + b) * 3072; const float* m0 = mod + (0 * 5 + b) * 3072; const float* m1 = mod + (1 * 5 + b) * 3072;
#pragma unroll
            for (int j = 0; j < 4; ++j) { const int c = 4 * lane + 256 * j;
                GA0[j] = *(const f32x4*)(m0 + 2048 + c) * *(const f32x4*)(a.g_post + c);
                GA1[j] = *(const f32x4*)(m1 + 2048 + c) * *(const f32x4*)(a.g_post + DM + c);
                GB[j] = *(const f32x4*)(a.g_pre + lp * DM + c) * (*(const f32x4*)(mp + 1024 + c) + 1.0f);
                GC[j] = *(const f32x4*)(mp + c); } }
        const float* src = (r < NTOK) ? a.x + (size_t)r * DM : a.ctx + (size_t)(r - NTOK) * DM;
        norm_rows4(mode, lane, src, a.out + (size_t)r * DM, Y0 + (size_t)r * DM, SSQ0 + (size_t)r * 16, Y1 + (size_t)r * DM, SSQ1 + (size_t)r * 16, HX + (size_t)r * DM, GA0, GA1, GB, GC);
    }
}

__device__ __forceinline__ void attn_unit(int u, const bf16_t* P, const bf16_t* Vt, bf16_t* H, const float* sink, unsigned char* lds) {
    const int tid = opaque_tid(), lane = tid & 63, wave = __builtin_amdgcn_readfirstlane(tid >> 6), r32 = lane & 31, hi = lane >> 5;
    const bool isctx = u >= 1024;
    int b, kvh, qb;
    if (isctx) { const int v = u - 1024; b = v >> 3; kvh = (v >> 2) & 1; qb = v & 3; } else { b = u >> 8; kvh = (u >> 7) & 1; qb = u & 127; }
    const int head = kvh * 4 + (wave >> 1);
    const int qtok = qb * 64 + (wave & 1) * 32 + r32;
    const size_t qrow = isctx ? (size_t)(NTOK + b * CTXL + qtok) : (size_t)(b * SEQ + qtok);
    const float sinkv = sink[head];
    bf16x8 qf[4];
#pragma unroll
    for (int d0 = 0; d0 < 4; ++d0) qf[d0] = *(const bf16x8*)(P + qrow * PW + C_Q + head * 64 + d0 * 16 + hi * 8);
    int jlo = 0, jhi = -1;
    if (!isctx) { jlo = qb < 2 ? 2 - qb : 0; jhi = (129 - qb) < 4 ? (129 - qb) : 4; }
    const int ntiles = 4 + (jhi - jlo + 1);
    const int srow = tid >> 3, sch = tid & 7;
    const bf16_t* Kc = P + (size_t)(NTOK + b * CTXL + srow) * PW + C_K + kvh * 64 + sch * 8;
    const bf16_t* Kl = P + (size_t)(b * SEQ + srow) * PW + C_K + kvh * 64 + sch * 8;
    const bf16_t* Vb = Vt + (size_t)((b * 2 + kvh) * 64 + srow) * VT_PITCH + sch * 8;
    unsigned char* Ks = lds; unsigned char* Vs = lds + 2 * 9216;
    const int soff = srow * 144 + sch * 16;
    u32x4 kreg, vreg, kreg2, vreg2;
#define ATT_GLOAD(KR, VR, ti_) do { const int t_ = (ti_); \
        if (t_ < 4) { KR = *(const u32x4*)(Kc + (size_t)(64 * t_) * PW); VR = *(const u32x4*)(Vb + SEQ + 64 * t_); } \
        else { const int kbase_ = qb * 64 - 128 + 64 * (jlo + t_ - 4); KR = *(const u32x4*)(Kl + (size_t)kbase_ * PW); VR = *(const u32x4*)(Vb + kbase_); } } while (0)
    const bf16_t* garow = P + qrow * PW + C_GA + head * 64;
    u32x2 gaw[8];
#pragma unroll
    for (int i = 0; i < 8; ++i) gaw[i] = *(const u32x2*)(garow + 32 * (i >> 2) + 8 * (i & 3) + 4 * hi);
    ATT_GLOAD(kreg2, vreg2, 0);
    ATT_GLOAD(kreg, vreg, 1);
    *(u32x4*)(Ks + soff) = kreg2; *(u32x4*)(Vs + soff) = vreg2;
    __syncthreads();
    const float sink2 = sinkv * LOG2E;
    float mref = sink2, lsum = 0.f;
    f32x16 oT[2]; oT[0] = f32x16{}; oT[1] = f32x16{};
    const int qpos = qtok;
    for (int ti = 0; ti < ntiles; ++ti) {
        const int buf = ti & 1;
        if (ti + 2 < ntiles) ATT_GLOAD(kreg2, vreg2, ti + 2);
        const unsigned char* kb = Ks + buf * 9216 + r32 * 144 + hi * 16;
        const unsigned char* vb = Vs + buf * 9216 + r32 * 144 + hi * 16;
        bf16x8 kf[8];
#pragma unroll
        for (int d0 = 0; d0 < 4; ++d0) { kf[2 * d0] = *(const bf16x8*)(kb + d0 * 32); kf[2 * d0 + 1] = *(const bf16x8*)(kb + 32 * 144 + d0 * 32); }
        f32x16 p0, p1;
#pragma unroll
        for (int r = 0; r < 16; ++r) { p0[r] = -mref; p1[r] = -mref; }
        __builtin_amdgcn_sched_barrier(0);
#pragma unroll
        for (int d0 = 0; d0 < 4; ++d0) { p0 = MFMA32(kf[2 * d0], qf[d0], p0); p1 = MFMA32(kf[2 * d0 + 1], qf[d0], p1); }
        bf16x8 vf[8];
#pragma unroll
        for (int blk = 0; blk < 2; ++blk)
#pragma unroll
            for (int ks = 0; ks < 4; ++ks) vf[blk * 4 + ks] = *(const bf16x8*)(vb + blk * 32 * 144 + ks * 32);
        __builtin_amdgcn_sched_barrier(0);
        asm volatile("s_nop 15\n\ts_nop 7" : "+v"(p0), "+v"(p1));
        if (ti >= 4) {
            const int j = jlo + ti - 4; const int kbase = qb * 64 - 128 + 64 * j;
            if (j == 0) {
#pragma unroll
                for (int r = 0; r < 16; ++r) { const int kp = kbase + crow(r, hi); if (kp < qpos - 128) p0[r] = -INFINITY; if (kp + 32 < qpos - 128) p1[r] = -INFINITY; }
            } else if (j == 4) {
#pragma unroll
                for (int r = 0; r < 16; ++r) { const int kp = kbase + crow(r, hi); if (kp > qpos + 128) p0[r] = -INFINITY; if (kp + 32 > qpos + 128) p1[r] = -INFINITY; }
            }
        }
        float rma, rmb;
        asm("v_max3_f32 %0, %1, %2, %3" : "=v"(rma) : "v"(p0[0]), "v"(p0[1]), "v"(p1[0]));
        asm("v_max3_f32 %0, %1, %2, %3" : "=v"(rmb) : "v"(p0[2]), "v"(p0[3]), "v"(p1[1]));
        asm("v_max3_f32 %0, %1, %2, %3" : "=v"(rma) : "v"(rma), "v"(p1[2]), "v"(p1[3]));
#pragma unroll
        for (int r = 4; r < 16; r += 4) {
            asm("v_max3_f32 %0, %1, %2, %3" : "=v"(rma) : "v"(rma), "v"(p0[r]), "v"(p0[r + 1]));
            asm("v_max3_f32 %0, %1, %2, %3" : "=v"(rmb) : "v"(rmb), "v"(p0[r + 2]), "v"(p0[r + 3]));
            asm("v_max3_f32 %0, %1, %2, %3" : "=v"(rma) : "v"(rma), "v"(p1[r]), "v"(p1[r + 1]));
            asm("v_max3_f32 %0, %1, %2, %3" : "=v"(rmb) : "v"(rmb), "v"(p1[r + 2]), "v"(p1[r + 3]));
        }
        float rm; asm("v_max3_f32 %0, %1, %2, %3" : "=v"(rm) : "v"(rma), "v"(rmb), "v"(rmb));
        { const float rmo = __shfl_xor(rm, 32); asm("v_max3_f32 %0, %1, %2, %3" : "=v"(rm) : "v"(rm), "v"(rmo), "v"(rmo)); }
        if (__any(rm > 8.0f)) {
            const float dl = fmaxf(rm, 0.f);
            mref += dl;
            const float f = __builtin_amdgcn_exp2f(-dl);
            lsum *= f;
#pragma unroll
            for (int r = 0; r < 16; ++r) { p0[r] -= dl; p1[r] -= dl; oT[0][r] *= f; oT[1][r] *= f; }
        }
        float ls = 0.f;
#pragma unroll
        for (int r = 0; r < 16; ++r) { p0[r] = __builtin_amdgcn_exp2f(p0[r]); p1[r] = __builtin_amdgcn_exp2f(p1[r]); ls += p0[r] + p1[r]; }
        lsum += ls;
        bf16x8 pf[4]; pf[0] = pack8(p0, 0); pf[1] = pack8(p0, 8); pf[2] = pack8(p1, 0); pf[3] = pack8(p1, 8);
#pragma unroll
        for (int blk = 0; blk < 2; ++blk)
#pragma unroll
            for (int ks = 0; ks < 4; ++ks) oT[blk] = MFMA32(vf[blk * 4 + ks], pf[ks], oT[blk]);
        if (ti + 1 < ntiles) { *(u32x4*)(Ks + (buf ^ 1) * 9216 + soff) = kreg; *(u32x4*)(Vs + (buf ^ 1) * 9216 + soff) = vreg; }
        kreg = kreg2; vreg = vreg2;
        __syncthreads();
    }
    lsum += __shfl_xor(lsum, 32);
    lsum += __builtin_amdgcn_exp2f(sink2 - mref);
    const float inv = 1.0f / lsum;
    bf16_t* hrow = H + qrow * DM + head * 64;
#pragma unroll
    for (int blk = 0; blk < 2; ++blk)
#pragma unroll
        for (int g4 = 0; g4 < 4; ++g4) {
            const int d0 = 32 * blk + 8 * g4 + 4 * hi;
            const u32x2 gw = gaw[blk * 4 + g4];
            const float o0 = oT[blk][4 * g4 + 0] * inv * silu_f(bf2f(gw.x & 0xffffu)), o1 = oT[blk][4 * g4 + 1] * inv * silu_f(bf2f(gw.x >> 16));
            const float o2 = oT[blk][4 * g4 + 2] * inv * silu_f(bf2f(gw.y & 0xffffu)), o3 = oT[blk][4 * g4 + 3] * inv * silu_f(bf2f(gw.y >> 16));
            u32x2 w; w.x = pkbf(o0, o1); w.y = pkbf(o2, o3);
            *(u32x2*)(hrow + d0) = w;
        }
}

typedef short v4i16_t __attribute__((ext_vector_type(4)));
__device__ __forceinline__ v4i16_t trrd(const unsigned char* p) { return __builtin_amdgcn_ds_read_tr16_b64_v4i16((LAS v4i16_t*)p); }
__device__ __forceinline__ bf16x8 cat8(v4i16_t lo, v4i16_t hi) { return (bf16x8){lo[0], lo[1], lo[2], lo[3], hi[0], hi[1], hi[2], hi[3]}; }
__device__ __forceinline__ void fft1_unit(int u, const bf16_t* P, bf16_t* YF, const unsigned char* ws, unsigned char* lds) {
    const int tid = opaque_tid(), lane = tid & 63, wave = __builtin_amdgcn_readfirstlane(tid >> 6), r32 = lane & 31, hi = lane >> 5;
    const int b = u >> 6, n2 = u & 63;
    constexpr int UPB = 576;
    const bf16_t* src = P + (size_t)(b * SEQ + n2) * PW + C_UF;
#pragma unroll
    for (int i = 0; i < 8; ++i) {
        const int id = tid + NTHREADS * i, n1 = id >> 5, cc = id & 31;
        *(u32x4*)(lds + n1 * UPB + cc * 16) = *(const u32x4*)(src + (size_t)n1 * 64 * PW + cc * 8);
    }
    __syncthreads();
    const bf16_t* T1R = (const bf16_t*)(ws + WS_T1R); const bf16_t* T1I = (const bf16_t*)(ws + WS_T1I);
    f32x16 aR[4], aI[4];
#pragma unroll
    for (int kb = 0; kb < 4; ++kb) { aR[kb] = f32x16{}; aI[kb] = f32x16{}; }
    const unsigned char* ap = lds + (8 * hi + ((lane & 15) >> 2)) * UPB + (32 * wave + 16 * ((lane >> 4) & 1) + 4 * (lane & 3)) * 2;
#pragma unroll 2
    for (int ks = 0; ks < 8; ++ks) {
        const bf16x8 av = cat8(trrd(ap + (16 * ks) * UPB), trrd(ap + (16 * ks + 4) * UPB));
#pragma unroll
        for (int kb = 0; kb < 4; ++kb) {
            const bf16x8 bR = *(const bf16x8*)(T1R + (32 * kb + r32) * 128 + 16 * ks + 8 * hi), bI = *(const bf16x8*)(T1I + (32 * kb + r32) * 128 + 16 * ks + 8 * hi);
            aR[kb] = MFMA32(av, bR, aR[kb]); aI[kb] = MFMA32(av, bI, aI[kb]);
        }
    }
    const float* TW = (const float*)(ws + WS_TW);
#pragma unroll
    for (int kb = 0; kb < 4; ++kb) {
        const int k1 = 32 * kb + r32;
        const float ct = TW[2 * (n2 * k1)], st = TW[2 * (n2 * k1) + 1];
        bf16_t* yp = YF + ((size_t)((b * 128 + k1) * 64 + n2)) * 512 + 32 * wave + 4 * hi;
#pragma unroll
        for (int g4 = 0; g4 < 4; ++g4) {
            float yr[4], yi[4];
#pragma unroll
            for (int e = 0; e < 4; ++e) { const float r_ = aR[kb][4 * g4 + e], i_ = aI[kb][4 * g4 + e]; yr[e] = r_ * ct + i_ * st; yi[e] = i_ * ct - r_ * st; }
            u32x2 wr_, wi_; wr_.x = pkbf(yr[0], yr[1]); wr_.y = pkbf(yr[2], yr[3]); wi_.x = pkbf(yi[0], yi[1]); wi_.y = pkbf(yi[2], yi[3]);
            *(u32x2*)(yp + 8 * g4) = wr_; *(u32x2*)(yp + 256 + 8 * g4) = wi_;
        }
    }
    __syncthreads();
}

template <int KK>
__device__ __forceinline__ void dftf_unit(const bf16_t* srcbase, int R, int pitchA, int pitchB, const bf16_t* Tr, const bf16_t* Ti, const bf16_t* Gt,
                                          const bf16_t* P, bf16_t* H, size_t row0, int rowstride, float oscale, unsigned char* lds) {
    const int tid = opaque_tid(), lane = tid & 63, wave = __builtin_amdgcn_readfirstlane(tid >> 6), r32 = lane & 31, hi = lane >> 5;
    constexpr int ZPB = (KK == 128) ? 576 : 544;
#pragma unroll 1
    for (int i0 = 0; i0 < KK / 16; i0 += 8) {
        u32x4 img[8];
#pragma unroll
        for (int i = 0; i < 8; ++i) { const int id = tid + NTHREADS * (i0 + i), kk = id >> 5, cc = id & 31; img[i] = *(const u32x4*)(srcbase + (size_t)(kk % R) * pitchA + (size_t)(kk / R) * pitchB + cc * 8); }
        __builtin_amdgcn_sched_barrier(0);
#pragma unroll
        for (int i = 0; i < 8; ++i) { const int id = tid + NTHREADS * (i0 + i), kk = id >> 5, cc = id & 31; *(u32x4*)(lds + kk * ZPB + cc * 16) = img[i]; }
        __builtin_amdgcn_sched_barrier(0);
    }
    __syncthreads();
    const int g = wave >> 1, kblk = wave & 1;
    f32x16 XR[2], XI[2];
#pragma unroll
    for (int cb = 0; cb < 2; ++cb) { XR[cb] = f32x16{}; XI[cb] = f32x16{}; }
    const bf16_t* trp = Tr + (size_t)(32 * kblk + r32) * KK + 8 * hi; const bf16_t* tip = Ti + (size_t)(32 * kblk + r32) * KK + 8 * hi;
    const unsigned char* zp = lds + (8 * hi + ((lane & 15) >> 2)) * ZPB + (64 * g + 16 * ((lane >> 4) & 1) + 4 * (lane & 3)) * 2;
#pragma unroll 2
    for (int ks = 0; ks < KK / 16; ++ks) {
        const bf16x8 bR = *(const bf16x8*)(trp + 16 * ks), bI = *(const bf16x8*)(tip + 16 * ks);
#pragma unroll
        for (int cb = 0; cb < 2; ++cb) { const bf16x8 av = cat8(trrd(zp + (16 * ks) * ZPB + cb * 64), trrd(zp + (16 * ks + 4) * ZPB + cb * 64)); XR[cb] = MFMA32(av, bR, XR[cb]); XI[cb] = MFMA32(av, bI, XI[cb]); }
    }
    f32x16 oa[2]; oa[0] = f32x16{}; oa[1] = f32x16{};
    const bf16_t* gp = Gt + (size_t)(g * 2 * 8 * 64 + lane) * 8;
    u32x2 gfw[8];
    { const size_t rowg = row0 + (size_t)(32 * kblk + r32) * rowstride;
#pragma unroll
      for (int i8 = 0; i8 < 8; ++i8) gfw[i8] = *(const u32x2*)(P + rowg * PW + C_GF + 64 * g + 32 * (i8 >> 2) + 8 * (i8 & 3) + 4 * hi); }
#pragma unroll
    for (int part = 0; part < 2; ++part)
#pragma unroll
        for (int cb = 0; cb < 2; ++cb)
#pragma unroll
            for (int s = 0; s < 2; ++s) {
                const bf16x8 bx = pack8(part ? XI[cb] : XR[cb], 8 * s);
                const int kko = part * 64 + 32 * cb + 16 * s;
#pragma unroll
                for (int lb = 0; lb < 2; ++lb) { const bf16x8 ag = *(const bf16x8*)(gp + (size_t)((lb * 8 + (kko >> 4)) * 64) * 8); oa[lb] = MFMA32(ag, bx, oa[lb]); }
            }
    const int k2 = 32 * kblk + r32;
    const size_t row = row0 + (size_t)k2 * rowstride;
    const bf16_t* gfrow = P + row * PW + C_GF + 64 * g;
    bf16_t* hrow = H + row * DM + 512 + 64 * g;
#pragma unroll
    for (int lb = 0; lb < 2; ++lb)
#pragma unroll
        for (int g4 = 0; g4 < 4; ++g4) {
            const int l0 = 32 * lb + 8 * g4 + 4 * hi;
            const u32x2 gw = gfw[lb * 4 + g4];
            const float o0 = oa[lb][4 * g4 + 0] * oscale * silu_f(bf2f(gw.x & 0xffffu)), o1 = oa[lb][4 * g4 + 1] * oscale * silu_f(bf2f(gw.x >> 16));
            const float o2 = oa[lb][4 * g4 + 2] * oscale * silu_f(bf2f(gw.y & 0xffffu)), o3 = oa[lb][4 * g4 + 3] * oscale * silu_f(bf2f(gw.y >> 16));
            u32x2 w; w.x = pkbf(o0, o1); w.y = pkbf(o2, o3);
            *(u32x2*)(hrow + l0) = w;
        }
    __syncthreads();
}

__device__ __forceinline__ void conv_unit(int u, const bf16_t* P, bf16_t* H, const float* cw, const float* cb) {
    const int tid = opaque_tid(), cgp = tid & 31, rg = tid >> 5;
    const int ch0 = cgp * 8;
    const int r0 = u * 64 + rg * 4;
    int pos, len; if (r0 < NTOK) { pos = r0 & (SEQ - 1); len = SEQ; } else { pos = (r0 - NTOK) & (CTXL - 1); len = CTXL; }
    float w0[8], w1[8], w2[8], bs[8];
#pragma unroll
    for (int e = 0; e < 8; ++e) { w0[e] = cw[ch0 + e]; w1[e] = cw[256 + ch0 + e]; w2[e] = cw[512 + ch0 + e]; bs[e] = cb[ch0 + e]; }
    float T[6][8];
#pragma unroll
    for (int i = 0; i < 6; ++i) {
        const int p = pos - 1 + i;
        if (p >= 0 && p < len) {
            const size_t row = (size_t)(r0 - 1 + i);
            const u32x4 z = *(const u32x4*)(P + row * PW + C_ZC + ch0), c = *(const u32x4*)(P + row * PW + C_CC + ch0);
            T[i][0] = bf2f(z.x & 0xffffu) * bf2f(c.x & 0xffffu); T[i][1] = bf2f(z.x >> 16) * bf2f(c.x >> 16);
            T[i][2] = bf2f(z.y & 0xffffu) * bf2f(c.y & 0xffffu); T[i][3] = bf2f(z.y >> 16) * bf2f(c.y >> 16);
            T[i][4] = bf2f(z.z & 0xffffu) * bf2f(c.z & 0xffffu); T[i][5] = bf2f(z.z >> 16) * bf2f(c.z >> 16);
            T[i][6] = bf2f(z.w & 0xffffu) * bf2f(c.w & 0xffffu); T[i][7] = bf2f(z.w >> 16) * bf2f(c.w >> 16);
        } else {
#pragma unroll
            for (int e = 0; e < 8; ++e) T[i][e] = 0.f;
        }
    }
#pragma unroll
    for (int i = 0; i < 4; ++i) {
        const size_t row = (size_t)(r0 + i);
        const u32x4 bw = *(const u32x4*)(P + row * PW + C_BC + ch0), gw = *(const u32x4*)(P + row * PW + C_GC + ch0);
        const unsigned bwv[4] = {bw.x, bw.y, bw.z, bw.w}, gwv[4] = {gw.x, gw.y, gw.z, gw.w};
        float o[8];
#pragma unroll
        for (int e = 0; e < 8; ++e) {
            const float bv = (e & 1) ? bf2f(bwv[e >> 1] >> 16) : bf2f(bwv[e >> 1] & 0xffffu);
            const float gv = (e & 1) ? bf2f(gwv[e >> 1] >> 16) : bf2f(gwv[e >> 1] & 0xffffu);
            const float y = T[i][e] * w0[e] + T[i + 1][e] * w1[e] + T[i + 2][e] * w2[e] + bs[e];
            o[e] = bv * y * silu_f(gv);
        }
        u32x4 w; w.x = pkbf(o[0], o[1]); w.y = pkbf(o[2], o[3]); w.z = pkbf(o[4], o[5]); w.w = pkbf(o[6], o[7]);
        *(u32x4*)(H + row * DM + 768 + ch0) = w;
    }
}

__device__ __forceinline__ void fft1_tables(const unsigned char* ws, unsigned char* tbl, int tid) {
    u32x4 tv[8];
#pragma unroll
    for (int i = 0; i < 8; ++i) { const int id = tid + NTHREADS * i, t = id >> 11, row = (id >> 4) & 127, ch = id & 15; tv[i] = *(const u32x4*)(ws + (t ? WS_T1I : WS_T1R) + row * 256 + ch * 16); }
    __builtin_amdgcn_sched_barrier(0);
#pragma unroll
    for (int i = 0; i < 8; ++i) { const int id = tid + NTHREADS * i, t = id >> 11, row = (id >> 4) & 127, ch = id & 15; *(u32x4*)(tbl + t * 34816 + row * 272 + ch * 16) = tv[i]; }
}
__device__ __forceinline__ void fft1_wave(int task, const bf16_t* P, bf16_t* YF, const unsigned char* ws, unsigned char* lds_w, const unsigned char* tbl, int lane, int pmode = 0) {
    const int r32 = lane & 31, hi = lane >> 5;
    const int cblk = task & 7, n2 = (task >> 3) & 63, b = task >> 9;
    const bf16_t* src = P + (size_t)((b * 64 + n2) * 128) * 256 + 32 * cblk + 8 * (lane & 3);
    { u32x4 img[8];
#pragma unroll
      for (int i = 0; i < 8; ++i) img[i] = *(const u32x4*)(src + (size_t)(16 * i + (lane >> 2)) * 256);
      __builtin_amdgcn_sched_barrier(0);
#pragma unroll
      for (int i = 0; i < 8; ++i) *(u32x4*)(lds_w + (16 * i + (lane >> 2)) * 64 + (lane & 3) * 16) = img[i];
      __builtin_amdgcn_sched_barrier(0); }
    asm volatile("s_waitcnt vmcnt(0) lgkmcnt(0)" ::: "memory");
    if (pmode == 2) return;
    const bf16_t* T1R = (const bf16_t*)(ws + WS_T1R); const bf16_t* T1I = (const bf16_t*)(ws + WS_T1I);
    f32x16 aR[4], aI[4];
#pragma unroll
    for (int kb = 0; kb < 4; ++kb) { aR[kb] = f32x16{}; aI[kb] = f32x16{}; }
    const unsigned char* ap = lds_w + (8 * hi + ((lane & 15) >> 2)) * 64 + (16 * ((lane >> 4) & 1) + 4 * (lane & 3)) * 2;
    const unsigned char* tb = tbl + r32 * 272 + hi * 16;
#pragma unroll 2
    for (int ks = 0; ks < 8; ++ks) {
        const bf16x8 av = cat8(trrd(ap + (16 * ks) * 64), trrd(ap + (16 * ks + 4) * 64));
        bf16x8 bq[8];
#pragma unroll
        for (int kb = 0; kb < 4; ++kb) { bq[2 * kb] = *(const bf16x8*)(tb + (32 * kb) * 272 + 32 * ks); bq[2 * kb + 1] = *(const bf16x8*)(tb + 34816 + (32 * kb) * 272 + 32 * ks); }
#pragma unroll
        for (int kb = 0; kb < 4; ++kb) { aR[kb] = MFMA32(av, bq[2 * kb], aR[kb]); aI[kb] = MFMA32(av, bq[2 * kb + 1], aI[kb]); }
    }
    const float* TW = (const float*)(ws + WS_TW);
#pragma unroll
    for (int kb = 0; kb < 4; ++kb) {
        const int k1 = 32 * kb + r32;
        const float ct = TW[2 * (n2 * k1)], st = TW[2 * (n2 * k1) + 1];
        bf16_t* yp = YF + ((size_t)((b * 128 + k1) * 64 + n2)) * 512 + 32 * cblk + 4 * hi;
#pragma unroll
        for (int g4 = 0; g4 < 4; ++g4) {
            float yr[4], yi[4];
#pragma unroll
            for (int e = 0; e < 4; ++e) { const float r_ = aR[kb][4 * g4 + e], i_ = aI[kb][4 * g4 + e]; yr[e] = r_ * ct + i_ * st; yi[e] = i_ * ct - r_ * st; }
            u32x2 wr_, wi_; wr_.x = pkbf(yr[0], yr[1]); wr_.y = pkbf(yr[2], yr[3]); wi_.x = pkbf(yi[0], yi[1]); wi_.y = pkbf(yi[2], yi[3]);
            if (pmode != 1 || wr_.x == 0x12345678u) { *(u32x2*)(yp + 8 * g4) = wr_; *(u32x2*)(yp + 256 + 8 * g4) = wi_; }
        }
    }
    asm volatile("s_waitcnt lgkmcnt(0)" ::: "memory");
}
__device__ __forceinline__ void fft3_wave(int task, const bf16_t* YF, const bf16_t* Gt, const bf16_t* P, bf16_t* H, const unsigned char* ws, unsigned char* lds_w, int lane) {
    const int r32 = lane & 31, hi = lane >> 5;
    const int g = task & 3, k1 = (task >> 2) & 127, b = task >> 9;
    const bf16_t* src = YF + ((size_t)(b * 128 + k1) * 64) * 512 + 64 * g + 8 * (lane & 7);
    { u32x4 img[16];
#pragma unroll
      for (int i = 0; i < 16; ++i) { const int kk = 8 * i + (lane >> 3); img[i] = *(const u32x4*)(src + (size_t)(kk & 63) * 512 + (size_t)(kk >> 6) * 256); }
      __builtin_amdgcn_sched_barrier(0);
#pragma unroll
      for (int i = 0; i < 16; ++i) { const int kk = 8 * i + (lane >> 3), ch = lane & 7; *(u32x4*)(lds_w + kk * 128 + ((ch ^ (((kk >> 1) & 1) << 2)) * 16)) = img[i]; }
      __builtin_amdgcn_sched_barrier(0); }
    asm volatile("s_waitcnt vmcnt(0) lgkmcnt(0)" ::: "memory");
    const bf16_t* T3R = (const bf16_t*)(ws + WS_T3R); const bf16_t* T3I = (const bf16_t*)(ws + WS_T3I);
    const int q = (lane & 15) >> 2, sw = (q >> 1) & 1;
    const int chl = 2 * ((lane >> 4) & 1) + ((lane & 3) >> 1);
    const unsigned char* zb = lds_w + (8 * hi + q) * 128 + 8 * (lane & 1);
    const unsigned char* zp0 = zb + ((chl ^ (sw << 2)) * 16);
    const unsigned char* zp1 = zb + (((4 + chl) ^ (sw << 2)) * 16);
    const bf16_t* gp = Gt + (size_t)(g * 2 * 8 * 64 + lane) * 8;
    const size_t rowb = (size_t)(b * SEQ + k1);
#pragma unroll 1
    for (int kblk = 0; kblk < 2; ++kblk) {
        f32x16 XR[2], XI[2];
#pragma unroll
        for (int cb = 0; cb < 2; ++cb) { XR[cb] = f32x16{}; XI[cb] = f32x16{}; }
        const bf16_t* trp = T3R + (size_t)(kblk * 8 * 64 + lane) * 8; const bf16_t* tip = T3I + (size_t)(kblk * 8 * 64 + lane) * 8;
        const size_t rowg = rowb + (size_t)(32 * kblk + r32) * 128;
        u32x2 gfw[8];
#pragma unroll
        for (int i8 = 0; i8 < 8; ++i8) gfw[i8] = *(const u32x2*)(P + rowg * PW + C_GF + 64 * g + 32 * (i8 >> 2) + 8 * (i8 & 3) + 4 * hi);
        bf16x8 bR[8], bI[8];
#pragma unroll
        for (int ks = 0; ks < 8; ++ks) { bR[ks] = *(const bf16x8*)(trp + 512 * ks); bI[ks] = *(const bf16x8*)(tip + 512 * ks); }
        __builtin_amdgcn_sched_barrier(0);
#pragma unroll
        for (int ks = 0; ks < 8; ++ks) {
            const bf16x8 a0 = cat8(trrd(zp0 + (16 * ks) * 128), trrd(zp0 + (16 * ks + 4) * 128));
            const bf16x8 a1 = cat8(trrd(zp1 + (16 * ks) * 128), trrd(zp1 + (16 * ks + 4) * 128));
            XR[0] = MFMA32(a0, bR[ks], XR[0]); XI[0] = MFMA32(a0, bI[ks], XI[0]); XR[1] = MFMA32(a1, bR[ks], XR[1]); XI[1] = MFMA32(a1, bI[ks], XI[1]);
        }
        __builtin_amdgcn_sched_barrier(0);
        bf16x8 gfr[2][8];
#pragma unroll
        for (int lb = 0; lb < 2; ++lb)
#pragma unroll
            for (int q8 = 0; q8 < 8; ++q8) gfr[lb][q8] = *(const bf16x8*)(gp + (size_t)((lb * 8 + q8) * 64) * 8);
        __builtin_amdgcn_sched_barrier(0);
        f32x16 oa[2]; oa[0] = f32x16{}; oa[1] = f32x16{};
#pragma unroll
        for (int part = 0; part < 2; ++part)
#pragma unroll
            for (int cb = 0; cb < 2; ++cb)
#pragma unroll
                for (int s = 0; s < 2; ++s) {
                    const bf16x8 bx = pack8(part ? XI[cb] : XR[cb], 8 * s);
                    const int kko = part * 64 + 32 * cb + 16 * s;
#pragma unroll
                    for (int lb = 0; lb < 2; ++lb) oa[lb] = MFMA32(gfr[lb][kko >> 4], bx, oa[lb]);
                }
        const int k2 = 32 * kblk + r32;
        const size_t row = rowb + (size_t)k2 * 128;
        const bf16_t* gfrow = P + row * PW + C_GF + 64 * g;
        bf16_t* hrow = H + row * DM + 512 + 64 * g;
#pragma unroll
        for (int lb = 0; lb < 2; ++lb)
#pragma unroll
            for (int g4 = 0; g4 < 4; ++g4) {
                const int l0 = 32 * lb + 8 * g4 + 4 * hi;
                const u32x2 gw = gfw[lb * 4 + g4];
                const float o0 = oa[lb][4 * g4 + 0] * silu_f(bf2f(gw.x & 0xffffu)), o1 = oa[lb][4 * g4 + 1] * silu_f(bf2f(gw.x >> 16));
                const float o2 = oa[lb][4 * g4 + 2] * silu_f(bf2f(gw.y & 0xffffu)), o3 = oa[lb][4 * g4 + 3] * silu_f(bf2f(gw.y >> 16));
                u32x2 w; w.x = pkbf(o0, o1); w.y = pkbf(o2, o3);
                *(u32x2*)(hrow + l0) = w;
            }
    }
    asm volatile("s_waitcnt lgkmcnt(0)" ::: "memory");
}
__device__ __forceinline__ void conv_wave(int task, const bf16_t* P, bf16_t* H, const float* cw, const float* cb, int lane) {
    const int cgp = lane & 31, ch0 = cgp * 8;
    const int r0 = task * 8 + (lane >> 5) * 4;
    int pos, len; if (r0 < NTOK) { pos = r0 & (SEQ - 1); len = SEQ; } else { pos = (r0 - NTOK) & (CTXL - 1); len = CTXL; }
    u32x4 zz[6], cc[6], bb[4], gg[4]; float okf[6];
#pragma unroll
    for (int i = 0; i < 6; ++i) { const int p = pos - 1 + i; const bool ok = p >= 0 && p < len; okf[i] = ok ? 1.f : 0.f; const size_t row = (size_t)(ok ? r0 - 1 + i : r0);
        zz[i] = *(const u32x4*)(P + row * PW + C_ZC + ch0); cc[i] = *(const u32x4*)(P + row * PW + C_CC + ch0); }
#pragma unroll
    for (int i = 0; i < 4; ++i) { const size_t row = (size_t)(r0 + i); bb[i] = *(const u32x4*)(P + row * PW + C_BC + ch0); gg[i] = *(const u32x4*)(P + row * PW + C_GC + ch0); }
    __builtin_amdgcn_sched_barrier(0);
    float w0[8], w1[8], w2[8], bs[8];
    { const f32x4 a0 = *(const f32x4*)(cw + ch0), a1 = *(const f32x4*)(cw + ch0 + 4), b0 = *(const f32x4*)(cw + 256 + ch0), b1 = *(const f32x4*)(cw + 256 + ch0 + 4);
      const f32x4 c0 = *(const f32x4*)(cw + 512 + ch0), c1 = *(const f32x4*)(cw + 512 + ch0 + 4), d0 = *(const f32x4*)(cb + ch0), d1 = *(const f32x4*)(cb + ch0 + 4);
#pragma unroll
      for (int e = 0; e < 4; ++e) { w0[e] = a0[e]; w0[4 + e] = a1[e]; w1[e] = b0[e]; w1[4 + e] = b1[e]; w2[e] = c0[e]; w2[4 + e] = c1[e]; bs[e] = d0[e]; bs[4 + e] = d1[e]; } }
    float T[6][8];
#pragma unroll
    for (int i = 0; i < 6; ++i) {
        const unsigned zv[4] = {zz[i].x, zz[i].y, zz[i].z, zz[i].w}, cv[4] = {cc[i].x, cc[i].y, cc[i].z, cc[i].w};
#pragma unroll
        for (int e = 0; e < 8; ++e) T[i][e] = okf[i] * ((e & 1) ? bf2f(zv[e >> 1] >> 16) : bf2f(zv[e >> 1] & 0xffffu)) * ((e & 1) ? bf2f(cv[e >> 1] >> 16) : bf2f(cv[e >> 1] & 0xffffu));
    }
#pragma unroll
    for (int i = 0; i < 4; ++i) {
        const size_t row = (size_t)(r0 + i);
        const unsigned bwv[4] = {bb[i].x, bb[i].y, bb[i].z, bb[i].w}, gwv[4] = {gg[i].x, gg[i].y, gg[i].z, gg[i].w};
        float o[8];
#pragma unroll
        for (int e = 0; e < 8; ++e) {
            const float bv = (e & 1) ? bf2f(bwv[e >> 1] >> 16) : bf2f(bwv[e >> 1] & 0xffffu);
            const float gv = (e & 1) ? bf2f(gwv[e >> 1] >> 16) : bf2f(gwv[e >> 1] & 0xffffu);
            const float y = T[i][e] * w0[e] + T[i + 1][e] * w1[e] + T[i + 2][e] * w2[e] + bs[e];
            o[e] = bv * y * silu_f(gv);
        }
        u32x4 w; w.x = pkbf(o[0], o[1]); w.y = pkbf(o[2], o[3]); w.z = pkbf(o[4], o[5]); w.w = pkbf(o[6], o[7]);
        *(u32x4*)(H + row * DM + 768 + ch0) = w;
    }
}

#define XB_TMO      128
#define XB_XCNT(j)  (256  + 64 * (j))
#define XB_XSUB(j)  (1280 + 64 * (j))
#define XB_XGEN(j)  (2304 + 64 * (j))
#define XB_TOP      3328
#define XB_TOPGEN   3392
#define XCD_BAR_WORDS 3456
#define XB_SPIN_CAP (1u << 18)

__device__ __forceinline__ unsigned xb_ld(unsigned* p)              { return __hip_atomic_load(p, __ATOMIC_RELAXED, __HIP_MEMORY_SCOPE_AGENT); }
__device__ __forceinline__ unsigned xb_add(unsigned* p, unsigned v) { return __hip_atomic_fetch_add(p, v, __ATOMIC_RELAXED, __HIP_MEMORY_SCOPE_AGENT); }
__device__ __forceinline__ unsigned xb_xcc_id() { return (unsigned)__builtin_amdgcn_s_getreg((3 << 11) | 20) & 0xFu; }
#define XB_SPIN(cond, bar) do { unsigned _sp = 0; while (cond) { __builtin_amdgcn_s_sleep(1); \
    if ((++_sp & 255u) == 0u) { if (xb_ld(&(bar)[XB_TMO])) break; if (_sp > XB_SPIN_CAP) { atomicAdd(&(bar)[XB_TMO], 1u); break; } } } } while (0)

struct XcdBarrier {
    unsigned* bar; unsigned x;
    volatile LAS unsigned* st;
};

__device__ __forceinline__ XcdBarrier xcd_barrier_post(unsigned* bar, volatile LAS unsigned* st) {
    XcdBarrier b; b.bar = bar; b.x = xb_xcc_id(); b.st = st;
    if (threadIdx.x == 0) (void)xb_add(&bar[XB_XCNT(b.x)], 1u);
    return b;
}
__device__ __forceinline__ void xcd_barrier_complete(unsigned* bar, unsigned x, unsigned& nloc, unsigned& nx) {
    const unsigned G = gridDim.x * gridDim.y * gridDim.z;
    unsigned sum, cnt, mine, sp = 0u;
    for (;;) {
        sum = 0u; cnt = 0u; mine = 0u;
#pragma unroll
        for (unsigned j = 0; j < 16; ++j) { const unsigned c = xb_ld(&bar[XB_XCNT(j)]); sum += c; cnt += (c > 0u) ? 1u : 0u; mine = (j == x) ? c : mine; }
        if (sum == G) break;
        __builtin_amdgcn_s_sleep(1);
        if ((++sp & 255u) == 0u) { if (xb_ld(&bar[XB_TMO])) break; if (sp > XB_SPIN_CAP) { atomicAdd(&bar[XB_TMO], 1u); break; } }
    }
    nloc = mine > 0u ? mine : 1u; nx = cnt > 0u ? cnt : 1u;
}

__device__ __forceinline__ void xcd_barrier(const XcdBarrier& b) {
    asm volatile("s_waitcnt vmcnt(0)" ::: "memory");
    __syncthreads();
    if (threadIdx.x == 0) {
        unsigned* bar = b.bar;
        __builtin_amdgcn_s_waitcnt(0);
        unsigned nloc = b.st[0], nx = b.st[1];
        if (nloc == 0u) { xcd_barrier_complete(bar, b.x, nloc, nx); b.st[0] = nloc; b.st[1] = nx; }
        const unsigned old = xb_add(&bar[XB_XSUB(b.x)], 1u);
        const unsigned gen = old / nloc;
        if (old + 1u == (gen + 1u) * nloc) {
            __builtin_amdgcn_fence(__ATOMIC_RELEASE, "agent");
            asm volatile("s_waitcnt vmcnt(0)" ::: "memory");
            const unsigned og = xb_add(&bar[XB_TOP], 1u);
            const unsigned tg = og / nx;
            if (og + 1u == (tg + 1u) * nx) xb_add(&bar[XB_TOPGEN], 1u);
            else XB_SPIN(xb_ld(&bar[XB_TOPGEN]) == tg, bar);
            __builtin_amdgcn_fence(__ATOMIC_ACQUIRE, "agent");
            xb_add(&bar[XB_XGEN(b.x)], 1u);
            asm volatile("s_waitcnt vmcnt(0)" ::: "memory");
        } else {
            XB_SPIN(xb_ld(&bar[XB_XGEN(b.x)]) == gen, bar);
            __builtin_amdgcn_fence(__ATOMIC_ACQUIRE, "agent");
            asm volatile("s_waitcnt vmcnt(0)" ::: "memory");
        }
    }
    __syncthreads();
}

__device__ __forceinline__ int next_unit(unsigned* ctr, unsigned char* lds) {
    volatile int* sw = (volatile int*)(lds + LDS_SCHED);
    if (threadIdx.x == 0) *sw = (int)atomicAdd(ctr, 1u);
    __syncthreads();
    const int u = *sw;
    __syncthreads();
    return u;
}

__global__ void __launch_bounds__(NTHREADS, 2) hybrid_fwd(KArgs a) {
    extern __shared__ __attribute__((aligned(16))) unsigned char lds[];
    cg::grid_group grid = cg::this_grid();
    unsigned char* ws = a.ws;
    const int lo = a.ph_lo, hi = a.ph_hi;
#ifndef PHMASK
#define PHMASK 0xfff
#endif
#define IN(k) (((PHMASK >> ((k) > 5 && (k) < 11 ? (k) - 5 : (k))) & 1) && lo <= (k) && (k) < hi)
#define SEAM(k) do { if (IN(k) && IN((k) + 1)) xcd_barrier(xbar); } while (0)
#ifndef REP_PHASE
#define REP_PHASE -1
#endif
#define REPS(j) for (int rep = 0, nrep = (REP_PHASE == (j)) ? 2 : 1; rep < nrep; ++rep, (rep < nrep ? xcd_barrier(xbar) : (void)0))
    bf16_t* HX = (bf16_t*)(ws + WS_HX); bf16_t* Pb = (bf16_t*)(ws + WS_P); bf16_t* Vt = (bf16_t*)(ws + WS_VT); bf16_t* Hb = (bf16_t*)(ws + WS_H);
    bf16_t* Yb = (bf16_t*)(ws + WS_Y); bf16_t* YF = (bf16_t*)(ws + WS_YF); float* SSQ = (float*)(ws + WS_SSQ);
    unsigned* ctl = (unsigned*)(ws + WS_CTL);

    if (threadIdx.x < 2) ((volatile LAS unsigned*)(lds + LDS_BARST))[threadIdx.x] = 0u;
    __syncthreads();
    const XcdBarrier xbar = xcd_barrier_post((unsigned*)(ws + WS_BAR), (volatile LAS unsigned*)(lds + LDS_BARST));
    if (a.ph_lo < 0) grid.sync();
    REPS(30) if (IN(0)) p0_prologue(a, lds);
    SEAM(0);
    for (int l = 0; l < 2; ++l) {
        const int pb = 1 + 5 * l;
        REPS(0) if (IN(pb)) norm_phase(a, l);
        SEAM(pb);
        REPS(1) if (IN(pb + 1)) {
            pg8::Gemm g{HX, (const bf16_t*)(ws + WS_WIN) + (size_t)l * PW * DM, MROWS, PW, DM};
            pg8::StaticOrder S; S.init(MROWS, PW, (int)gridDim.x, (int)blockIdx.x);
            pg8::EpiProj E{Pb, Vt, (const float*)(ws + WS_ROPE), (bf16_t*)(ws + WS_UFP), 0.125f * LOG2E};
            pg8::gemm_phase<pg8::EpiProj, pg8::StaticOrder, true, true>((PG8_LAS unsigned char*)lds, g, S, E);
        }
        SEAM(pb + 1);
        for (int rep = 0, nrep = (REP_PHASE >= 20 && REP_PHASE < 30) ? 2 : 1; rep < nrep; ++rep, (rep < nrep ? xcd_barrier(xbar) : (void)0)) if (IN(pb + 2)) {
            const int nAttn = (l == 0) ? 1056 : 1024, nCtxF = (l == 0) ? 16 : 0, nF1 = 256, nConv = ((l == 0) ? MROWS : NTOK) / 64;
            const int e0 = nF1, e1 = e0 + nCtxF, e2 = e1 + nAttn, e3 = e2 + nConv;
            for (;;) {
                const int u = next_unit(ctl + 2 * l + 8 * rep, lds);
                if (u >= e3) break;
                if (rep == 1) { const int ty = u < e0 ? 1 : u < e1 ? 3 : u < e2 ? 0 : 2; if (REP_PHASE == 25 ? (ty == 0) : (ty != REP_PHASE - 20)) continue; }
                if (u >= e1 && u < e2) attn_unit(u - e1, Pb, Vt, Hb, a.sink + 8 * l, lds);
                else if (u >= e0 && u < e1) { const int v = u - e0, b = v >> 2, kb = v & 3;
                    dftf_unit<256>(Pb + (size_t)(NTOK + b * CTXL) * PW + C_UF, 256, PW, 0, (const bf16_t*)(ws + WS_T256R) + (size_t)(64 * kb) * 256, (const bf16_t*)(ws + WS_T256I) + (size_t)(64 * kb) * 256,
                                   (const bf16_t*)(ws + WS_GT) + (size_t)l * 4 * 64 * 128, Pb, Hb, (size_t)(NTOK + b * CTXL + 64 * kb), 1, 5.656854249492381f, lds); }
                else {
                    const int tid = opaque_tid(), lane = tid & 63, wave = __builtin_amdgcn_readfirstlane(tid >> 6);
                    if (u < e0) { fft1_tables(ws, lds + 65536, tid); __syncthreads(); fft1_wave(u * 8 + wave, (const bf16_t*)(ws + WS_UFP), YF, ws, lds + wave * 8192, lds + 65536, lane); }
                    else conv_wave((u - e2) * 8 + wave, Pb, Hb, a.conv_w + l * 768, a.conv_b + l * 256, lane);
                }
            }
        }
        SEAM(pb + 2);
        REPS(3) if (IN(pb + 3)) {
            const bool gemmwg = (l == 0 && blockIdx.x < 16);
            if (gemmwg) {
                pg8::Gemm g{Hb + (size_t)NTOK * DM, (const bf16_t*)(ws + WS_WOUT) + (size_t)l * DM * DM, NCTX, DM, DM};
                pg8::StaticOrder S; S.init(NCTX, DM, 16, (int)blockIdx.x);
                pg8::EpiY E{Yb + (size_t)NTOK * DM, SSQ + (size_t)NTOK * 16};
                pg8::gemm_phase<pg8::EpiY, pg8::StaticOrder, true, true>((PG8_LAS unsigned char*)lds, g, S, E);
            } else {
                const int tid = opaque_tid(), lane = tid & 63, wave = __builtin_amdgcn_readfirstlane(tid >> 6);
                const int nb0 = (l == 0) ? 16 : 0;
                const int gw = ((int)blockIdx.x - nb0) + wave * ((int)gridDim.x - nb0), NGW = ((int)gridDim.x - nb0) * 8;
                unsigned char* lds_w = lds + wave * 16384;
                for (int t = gw; t < 2048; t += NGW) fft3_wave(t, YF, (const bf16_t*)(ws + WS_GT) + (size_t)l * 4 * 64 * 128, Pb, Hb, ws, lds_w, lane);
            }
            __syncthreads();
        }
        SEAM(pb + 3);
        REPS(4) if (IN(pb + 4)) {
            pg8::Gemm g{Hb, (const bf16_t*)(ws + WS_WOUT) + (size_t)l * DM * DM, NTOK, DM, DM};
            pg8::StaticOrder S; S.init(NTOK, DM, (int)gridDim.x, (int)blockIdx.x);
            pg8::EpiY E{l == 0 ? Yb : HX, l == 0 ? SSQ : (float*)(ws + WS_SSQ1)};
            pg8::gemm_phase<pg8::EpiY, pg8::StaticOrder, true, true>((PG8_LAS unsigned char*)lds, g, S, E);
        }
        SEAM(pb + 4);
    }
#if REP_PHASE == 9
    for (int i = 0; i < 10; ++i) xcd_barrier(xbar);
#endif
    if (IN(11)) norm_phase(a, 2);
#undef IN
#undef SEAM
}

#ifndef MK_MULTI
#define MK_MULTI 0
#endif
extern "C" void kernel_launch(void* const* d_in, const int* in_sizes, int n_in, void* d_out, int out_size, void* d_ws, size_t ws_size, hipStream_t stream) {
    static int grid = 0;
    if (grid == 0) {
        if (n_in != 14 || ws_size < WS_END) { fprintf(stderr, "kernel_launch: unexpected n_in %d or ws_size %zu (need %zu)\n", n_in, ws_size, (size_t)WS_END); grid = -1; return; }
        int dev = 0, cus = 0, per_cu = 0;
        hipGetDevice(&dev); hipDeviceGetAttribute(&cus, hipDeviceAttributeMultiprocessorCount, dev);
        if (hipFuncSetAttribute((const void*)hybrid_fwd, hipFuncAttributeMaxDynamicSharedMemorySize, LDS_BYTES) != hipSuccess) { fprintf(stderr, "kernel_launch: hipFuncSetAttribute failed\n"); grid = -1; return; }
        if (hipOccupancyMaxActiveBlocksPerMultiprocessor(&per_cu, (const void*)hybrid_fwd, NTHREADS, LDS_BYTES) != hipSuccess || per_cu < 1) { fprintf(stderr, "kernel_launch: occupancy query gave %d\n", per_cu); per_cu = 1; }
        (void)hipGetLastError();
        grid = cus * 1;
        fprintf(stderr, "kernel_launch: grid %d (cus %d, per_cu %d)\n", grid, cus, per_cu);
    }
    if (grid < 0) return;
    if (hipMemsetAsync((char*)d_ws + WS_CTL, 0, WS_ZERO_BYTES, stream) != hipSuccess) { fprintf(stderr, "kernel_launch: hipMemsetAsync failed\n"); return; }
    KArgs a{};
    a.x = (const float*)d_in[0]; a.c = (const float*)d_in[1]; a.ctx = (const float*)d_in[2]; a.c_ctx = (const float*)d_in[3]; a.w_mod = (const float*)d_in[4]; a.b_mod = (const float*)d_in[5];
    a.g_pre = (const float*)d_in[6]; a.g_post = (const float*)d_in[7]; a.w_in = (const float*)d_in[8]; a.w_out = (const float*)d_in[9]; a.sink = (const float*)d_in[10]; a.w_f = (const float*)d_in[11];
    a.conv_w = (const float*)d_in[12]; a.conv_b = (const float*)d_in[13];
    a.out = (float*)d_out; a.ws = (unsigned char*)d_ws;
#if MK_MULTI
    for (int ph = 0; ph < 12; ++ph) { a.ph_lo = ph; a.ph_hi = ph + 1; hipLaunchKernelGGL(hybrid_fwd, dim3(grid), dim3(NTHREADS), LDS_BYTES, stream, a); }
#else
    a.ph_lo = 0; a.ph_hi = 12;
    void* args[] = {&a};
    hipError_t e = hipLaunchCooperativeKernel((const void*)hybrid_fwd, dim3(grid), dim3(NTHREADS), args, LDS_BYTES, stream);
    if (e != hipSuccess) fprintf(stderr, "kernel_launch: cooperative launch failed: %s (grid %d)\n", hipGetErrorString(e), grid);
#endif
}
```

```cpp
#include <hip/hip_runtime.h>
#include <hip/hip_cooperative_groups.h>
#include <cstdio>
#include <cstdint>
namespace cg = cooperative_groups;
namespace pg8 {
#define PG8_LAS __attribute__((address_space(3)))
typedef unsigned short bf16_t;
typedef short bf16x8 __attribute__((ext_vector_type(8)));
typedef float f32x4 __attribute__((ext_vector_type(4)));
typedef unsigned u32x4 __attribute__((ext_vector_type(4)));
constexpr int BM = 256, BK = 64, HALF = 128, HTB = HALF * BK * 2  , STAGE_BYTES = 8 * HTB, NXCD = 8, WGM = 8;

__host__ __device__ __forceinline__ int lds_byte(int r, int c) { const int st = (r >> 4) * 2 + (c >> 5), rr = r & 15, cc = c & 31, ob = rr * 64 + cc * 2; return st * 1024 + (ob ^ (((ob >> 9) & 1) << 5)); }
__host__ __device__ __forceinline__ void stage_rc(int b, int& R, int& C) { const int st = b / 1024, sb = b % 1024, swz = sb ^ (((sb >> 9) & 1) << 5); R = (st >> 1) * 16 + swz / 64; C = (st & 1) * 32 + (swz % 64) / 2; }
__host__ __device__ __forceinline__ int perm32(int rho) { const int n = rho >> 4, i = rho & 15; return 8 * (i >> 2) + 4 * n + (i & 3); }

struct Unit { int pm, pn; };
struct Gemm { const bf16_t* A; const bf16_t* Bt; int M, N, K; };

struct StaticOrder {
    int nM, nN, nwg, G, c;
    __host__ __device__ void init(int M, int N, int G_, int c_) { nM = M / BM; nN = N / BM; nwg = nM * nN; G = G_; c = c_; }
    __host__ __device__ bool next(int i, Unit& u) const {
        const long L = (long)i * G + c; if (L >= nwg) return false;
        int wgid = (int)L; { const int q = nwg / NXCD, r = nwg % NXCD, xcd = wgid % NXCD, off = wgid / NXCD; wgid = (xcd < r ? xcd * (q + 1) : r * (q + 1) + (xcd - r) * q) + off; }
        const int nig = WGM * nN, gid = wgid / nig, fm = gid * WGM, gsz = (nM - fm) < WGM ? (nM - fm) : WGM;
        u.pm = fm + ((wgid % nig) % gsz); u.pn = (wgid % nig) / gsz; return true;
    }
    __device__ __forceinline__ void a_ready(const Unit&) const {}
    __device__ __forceinline__ void done(const Unit&) const {}
};

__device__ __forceinline__ unsigned cvt_pk_bf16(float lo, float hi) { unsigned r; asm volatile("v_cvt_pk_bf16_f32 %0, %1, %2" : "=v"(r) : "v"(lo), "v"(hi)); return r; }
typedef unsigned u32x2 __attribute__((ext_vector_type(2)));
__device__ __forceinline__ int swap23(int t) { return (t & ~12) | ((t & 4) << 1) | ((t & 8) >> 1); }
struct EpiProj {
    static constexpr bool PERM = true, AFTER_DRAIN = false;
    bf16_t* P; bf16_t* Vt; const float* rope; bf16_t* UFP; float qscale;
    __device__ __forceinline__ void operator()(const f32x4 (&acc)[2][2][4][2], const Unit& u, int wr, int wc, int fr, int fq) const {
        const int row0 = u.pm * BM + wr * 64 + fr;
        const int pn = u.pn;
        const bool ctxrow = u.pm >= 128;
        f32x4 CS[2][4], SN[2][4];
        if (pn <= 2) {
#pragma unroll
            for (int ai = 0; ai < 2; ++ai)
#pragma unroll
                for (int m = 0; m < 4; ++m) {
                    CS[ai][m] = (f32x4){1.f, 1.f, 1.f, 1.f}; SN[ai][m] = (f32x4){0.f, 0.f, 0.f, 0.f};
                    if (!ctxrow) { const int t = (row0 + ai * HALF + m * 16) & 8191; const int pos = (wc & 1) ? (t & 63) : (t >> 6);
                        CS[ai][m] = *(const f32x4*)(rope + pos * 32 + 4 * fq); SN[ai][m] = *(const f32x4*)(rope + pos * 32 + 16 + 4 * fq); }
                }
            __builtin_amdgcn_sched_barrier(0);
        }
#pragma unroll
        for (int ai = 0; ai < 2; ++ai)
#pragma unroll
            for (int m = 0; m < 4; ++m) {
                const int row = row0 + ai * HALF + m * 16;
                bf16_t* rowp = P + (size_t)row * 2816 + pn * BM + wc * 32 + 8 * fq;
                if (pn == 5 && !ctxrow) { const int t = row & 8191; rowp = UFP + ((size_t)(((row >> 13) * 64 + (t & 63)) * 128 + (t >> 6))) * 256 + wc * 32 + 8 * fq; }
                if (pn > 2) {
#pragma unroll
                    for (int bj = 0; bj < 2; ++bj) { const f32x4 v0 = acc[ai][bj][m][0], v1 = acc[ai][bj][m][1];
                        u32x4 w; w.x = cvt_pk_bf16(v0[0], v0[1]); w.y = cvt_pk_bf16(v0[2], v0[3]); w.z = cvt_pk_bf16(v1[0], v1[1]); w.w = cvt_pk_bf16(v1[2], v1[3]);
                        *(u32x4*)(rowp + bj * HALF) = w; }
                } else {
                    const f32x4 cs = CS[ai][m], sn = SN[ai][m];
#pragma unroll
                    for (int bj = 0; bj < 2; ++bj) {
                        f32x4 v0 = acc[ai][bj][m][0], v1 = acc[ai][bj][m][1];
                        if (pn == 2 && bj == 1) {
                            int b, tok; if (ctxrow) { const int rr = row - 32768; b = rr >> 8; tok = 8192 + (rr & 255); } else { b = row >> 13; tok = row & 8191; }
                            const int ptok = swap23(tok);
                            bf16_t* vp = Vt + ((size_t)((b * 2 + (wc >> 1)) * 64 + 32 * (wc & 1) + 8 * fq)) * 8448 + ptok;
                            const unsigned w0 = cvt_pk_bf16(v0[0], v0[1]), w1 = cvt_pk_bf16(v0[2], v0[3]), w2 = cvt_pk_bf16(v1[0], v1[1]), w3 = cvt_pk_bf16(v1[2], v1[3]);
                            vp[0 * 8448] = (bf16_t)(w0 & 0xffffu); vp[1 * 8448] = (bf16_t)(w0 >> 16); vp[2 * 8448] = (bf16_t)(w1 & 0xffffu); vp[3 * 8448] = (bf16_t)(w1 >> 16);
                            vp[4 * 8448] = (bf16_t)(w2 & 0xffffu); vp[5 * 8448] = (bf16_t)(w2 >> 16); vp[6 * 8448] = (bf16_t)(w3 & 0xffffu); vp[7 * 8448] = (bf16_t)(w3 >> 16);
                        } else {
                            const f32x4 r0 = v0 * cs - v1 * sn, r1 = v0 * sn + v1 * cs;
                            v0 = r0; v1 = r1;
                            if (pn < 2) { v0 = v0 * qscale; v1 = v1 * qscale; }
                            u32x4 w; w.x = cvt_pk_bf16(v0[0], v0[1]); w.y = cvt_pk_bf16(v0[2], v0[3]); w.z = cvt_pk_bf16(v1[0], v1[1]); w.w = cvt_pk_bf16(v1[2], v1[3]);
                            *(u32x4*)(rowp + bj * HALF) = w;
                        }
                    }
                }
            }
    }
};
struct EpiY {
    static constexpr bool PERM = true, AFTER_DRAIN = false;
    bf16_t* Y; float* ssq;
    __device__ __forceinline__ void operator()(const f32x4 (&acc)[2][2][4][2], const Unit& u, int wr, int wc, int fr, int fq) const {
        const int row0 = u.pm * BM + wr * 64 + fr;
#pragma unroll
        for (int ai = 0; ai < 2; ++ai)
#pragma unroll
            for (int m = 0; m < 4; ++m) {
                const int row = row0 + ai * HALF + m * 16;
                bf16_t* rowp = Y + (size_t)row * 1024 + u.pn * BM + wc * 32 + 8 * fq;
                float s = 0.f;
#pragma unroll
                for (int bj = 0; bj < 2; ++bj) { const f32x4 v0 = acc[ai][bj][m][0], v1 = acc[ai][bj][m][1];
                    s += (v0[0] * v0[0] + v0[1] * v0[1]) + (v0[2] * v0[2] + v0[3] * v0[3]) + (v1[0] * v1[0] + v1[1] * v1[1]) + (v1[2] * v1[2] + v1[3] * v1[3]);
                    u32x4 w; w.x = cvt_pk_bf16(v0[0], v0[1]); w.y = cvt_pk_bf16(v0[2], v0[3]); w.z = cvt_pk_bf16(v1[0], v1[1]); w.w = cvt_pk_bf16(v1[2], v1[3]);
                    *(u32x4*)(rowp + bj * HALF) = w; }
                s += __shfl_xor(s, 16); s += __shfl_xor(s, 32);
                if (fq == 0) ssq[(size_t)row * 16 + u.pn * 4 + wc] = s;
            }
    }
};
template <class Epi, class Sched, bool ALIGN_EPI = false, bool SP2 = false>
__device__ __forceinline__ void gemm_phase(PG8_LAS unsigned char* lds, const Gemm g, const Sched& S, const Epi& E) {
    int tid_ = threadIdx.x; asm volatile("" : "+v"(tid_));
    const int tid = tid_, wid = __builtin_amdgcn_readfirstlane(tid >> 6), lane = tid & 63, wr = wid >> 2, wc = wid & 3, fr = lane & 15, fq = lane >> 4;
    const int K = g.K, nt = K / BK;
    unsigned voffA[2], voffB[2];
#pragma unroll
    for (int i = 0; i < 2; ++i) { int R, C; stage_rc(tid * 16 + i * 8192, R, C); const int Rb = Epi::PERM ? ((R & ~31) + perm32(R & 31)) : R;
        voffA[i] = (unsigned)(R * K + C) * 2u; voffB[i] = (unsigned)(Rb * K + C) * 2u; }
    const size_t kstep = (size_t)(BK * 2);
    const size_t hstep = (size_t)HALF * K * 2;
    const size_t tstep = 2 * hstep;
    const unsigned ldsw = (unsigned)wid * 1024u;
    const int aoff = lds_byte(wr * 64 + fr, fq * 8), boff = lds_byte(wc * 32 + fr, fq * 8);
#define PG8_SA(b, h) (((b) * 2 + (h)) * HTB)
#define PG8_SB(b, h) ((4 + (b) * 2 + (h)) * HTB)
#define PG8_STAGE(bufoff, gbase, voff) do { _Pragma("unroll") for (int _i = 0; _i < 2; ++_i) \
        __builtin_amdgcn_global_load_lds((const unsigned*)((const char*)(gbase) + (voff)[_i]), (PG8_LAS unsigned*)(lds + (bufoff) + ldsw + _i * 8192), 16, 0, 0); } while (0)
#define PG8_LDA(dst, b, h) do { _Pragma("unroll") for (int m = 0; m < 4; ++m) _Pragma("unroll") for (int k = 0; k < 2; ++k) dst[m][k] = *(const PG8_LAS bf16x8*)(lds + PG8_SA(b, h) + aoff + m * 2048 + k * 1024); } while (0)
#define PG8_LDB(dst, b, h) do { _Pragma("unroll") for (int n = 0; n < 2; ++n) _Pragma("unroll") for (int k = 0; k < 2; ++k) dst[n][k] = *(const PG8_LAS bf16x8*)(lds + PG8_SB(b, h) + boff + n * 2048 + k * 1024); } while (0)
#define PG8_MMA(ai, bj, At, Bt) do { __builtin_amdgcn_s_setprio(1); _Pragma("unroll") for (int m = 0; m < 4; ++m) _Pragma("unroll") for (int n = 0; n < 2; ++n) _Pragma("unroll") for (int k = 0; k < 2; ++k) \
        acc[ai][bj][m][n] = __builtin_amdgcn_mfma_f32_16x16x32_bf16(Bt[n][k], At[m][k], acc[ai][bj][m][n], 0, 0, 0); __builtin_amdgcn_s_setprio(0); } while (0)
#define PG8_WAIT_V(n) asm volatile("s_waitcnt vmcnt(" #n ")" ::: "memory")
#define PG8_WAIT_L(n) asm volatile("s_waitcnt lgkmcnt(" #n ")" ::: "memory")
#define PG8_BAR __builtin_amdgcn_s_barrier()
#define PG8_SCHED __builtin_amdgcn_sched_barrier(0)
    Unit cur, nxt; int ui = 0;
    if (!S.next(0, cur)) return;
    f32x4 acc[2][2][4][2];
#pragma unroll
    for (int a = 0; a < 2; ++a)
#pragma unroll
        for (int b = 0; b < 2; ++b)
#pragma unroll
            for (int m = 0; m < 4; ++m)
#pragma unroll
                for (int n = 0; n < 2; ++n) acc[a][b][m][n] = (f32x4){0.f, 0.f, 0.f, 0.f};
    bf16x8 At[4][2], B0[2][2], B1[2][2];
    const char* cA = (const char*)g.A + (size_t)cur.pm * tstep; const char* cB = (const char*)g.Bt + (size_t)cur.pn * tstep;
    S.a_ready(cur);
    if constexpr (SP2) {
        PG8_STAGE(PG8_SB(0, 0), cB, voffB); PG8_STAGE(PG8_SB(0, 1), cB + hstep, voffB); PG8_STAGE(PG8_SA(0, 0), cA, voffA); PG8_STAGE(PG8_SA(0, 1), cA + hstep, voffA);
        if (wr == 1) PG8_BAR;
        PG8_WAIT_V(2); PG8_BAR;
        PG8_STAGE(PG8_SB(1, 0), cB + kstep, voffB); PG8_STAGE(PG8_SA(1, 0), cA + kstep, voffA); PG8_STAGE(PG8_SB(1, 1), cB + hstep + kstep, voffB);
        PG8_WAIT_V(6); PG8_BAR;
    } else {
        PG8_STAGE(PG8_SB(0, 0), cB, voffB); PG8_STAGE(PG8_SA(0, 0), cA, voffA); PG8_STAGE(PG8_SB(0, 1), cB + hstep, voffB); PG8_STAGE(PG8_SA(0, 1), cA + hstep, voffA);
        if (wr == 1) PG8_BAR;
        PG8_WAIT_V(4); PG8_BAR;
        PG8_STAGE(PG8_SB(1, 0), cB + kstep, voffB); PG8_STAGE(PG8_SA(1, 0), cA + kstep, voffA); PG8_STAGE(PG8_SB(1, 1), cB + hstep + kstep, voffB);
        PG8_WAIT_V(6); PG8_BAR;
    }
    for (;;) {
        const bool has_next = S.next(ui + 1, nxt);
        const char* nA = has_next ? (const char*)g.A + (size_t)nxt.pm * tstep : cA; const char* nB = has_next ? (const char*)g.Bt + (size_t)nxt.pn * tstep : cB;
        for (int t = 0; t < nt; t += 2) {
            const bool last = (t == nt - 2);
            const char* a1 = cA + (size_t)(t + 1) * kstep;
            const char* a2 = last ? nA : cA + (size_t)(t + 2) * kstep; const char* b2 = last ? nB : cB + (size_t)(t + 2) * kstep;
            const char* a3 = a2 + kstep; const char* b3 = b2 + kstep;
            if (last && has_next) S.a_ready(nxt);
            if constexpr (SP2) {
            PG8_LDB(B0, 0, 0); PG8_LDB(B1, 0, 1); PG8_SCHED; PG8_LDA(At, 0, 0); PG8_STAGE(PG8_SA(1, 1), a1 + hstep, voffA);
            PG8_WAIT_V(8); PG8_WAIT_L(0); PG8_BAR; PG8_MMA(0, 0, At, B0); PG8_MMA(0, 1, At, B1); PG8_BAR; PG8_SCHED;
            PG8_LDA(At, 0, 1); PG8_STAGE(PG8_SB(0, 0), b2, voffB); PG8_STAGE(PG8_SB(0, 1), b2 + hstep, voffB); PG8_STAGE(PG8_SA(0, 0), a2, voffA);
            PG8_WAIT_V(8); PG8_WAIT_L(0); PG8_BAR; PG8_MMA(1, 0, At, B0); PG8_MMA(1, 1, At, B1); PG8_BAR; PG8_SCHED;
            PG8_LDB(B0, 1, 0); PG8_LDB(B1, 1, 1); PG8_SCHED; PG8_LDA(At, 1, 0); PG8_STAGE(PG8_SA(0, 1), a2 + hstep, voffA);
            PG8_WAIT_V(8); PG8_WAIT_L(0); PG8_BAR; PG8_MMA(0, 0, At, B0); PG8_MMA(0, 1, At, B1); PG8_BAR; PG8_SCHED;
            PG8_LDA(At, 1, 1); PG8_STAGE(PG8_SB(1, 0), b3, voffB); PG8_STAGE(PG8_SB(1, 1), b3 + hstep, voffB); PG8_STAGE(PG8_SA(1, 0), a3, voffA);
            PG8_WAIT_V(8); PG8_WAIT_L(0); PG8_BAR; PG8_MMA(1, 0, At, B0); PG8_MMA(1, 1, At, B1); PG8_BAR; PG8_SCHED;
            } else {
            PG8_LDB(B0, 0, 0); PG8_SCHED; PG8_LDA(At, 0, 0); PG8_STAGE(PG8_SA(1, 1), a1 + hstep, voffA);
            PG8_WAIT_L(8); PG8_BAR; PG8_WAIT_L(0); PG8_MMA(0, 0, At, B0); PG8_BAR; PG8_SCHED;
            PG8_LDB(B1, 0, 1); PG8_STAGE(PG8_SB(0, 0), b2, voffB);
            PG8_BAR; PG8_WAIT_L(0); PG8_MMA(0, 1, At, B1); PG8_BAR;
            PG8_LDA(At, 0, 1); PG8_STAGE(PG8_SA(0, 0), a2, voffA);
            PG8_BAR; PG8_WAIT_L(0); PG8_MMA(1, 0, At, B0); PG8_BAR; PG8_SCHED;
            PG8_STAGE(PG8_SB(0, 1), b2 + hstep, voffB);
            PG8_WAIT_V(6); PG8_BAR; PG8_MMA(1, 1, At, B1); PG8_BAR;
            PG8_LDB(B0, 1, 0); PG8_SCHED; PG8_LDA(At, 1, 0); PG8_STAGE(PG8_SA(0, 1), a2 + hstep, voffA);
            PG8_WAIT_L(8); PG8_BAR; PG8_WAIT_L(0); PG8_MMA(0, 0, At, B0); PG8_BAR; PG8_SCHED;
            PG8_LDB(B1, 1, 1); PG8_STAGE(PG8_SB(1, 0), b3, voffB);
            PG8_BAR; PG8_WAIT_L(0); PG8_MMA(0, 1, At, B1); PG8_BAR;
            PG8_LDA(At, 1, 1); PG8_STAGE(PG8_SA(1, 0), a3, voffA);
            PG8_BAR; PG8_WAIT_L(0); PG8_MMA(1, 0, At, B0); PG8_BAR; PG8_SCHED;
            PG8_STAGE(PG8_SB(1, 1), b3 + hstep, voffB);
            PG8_WAIT_V(6); PG8_BAR; PG8_MMA(1, 1, At, B1); PG8_BAR;
            }
        }
        if constexpr (ALIGN_EPI) { if (wr == 0) PG8_BAR; }
        if constexpr (!Epi::AFTER_DRAIN) { E(acc, cur, wr, wc, fr, fq); S.done(cur); }
        if (!has_next) break;
#pragma unroll
        for (int a = 0; a < 2; ++a)
#pragma unroll
            for (int b = 0; b < 2; ++b)
#pragma unroll
                for (int m = 0; m < 4; ++m)
#pragma unroll
                    for (int n = 0; n < 2; ++n) acc[a][b][m][n] = (f32x4){0.f, 0.f, 0.f, 0.f};
        cur = nxt; cA = nA; cB = nB; ++ui;
        if constexpr (ALIGN_EPI) { if (wr == 1) PG8_BAR; }
    }
    PG8_WAIT_V(0);
    if constexpr (!ALIGN_EPI) { if (wr == 0) PG8_BAR; }
    PG8_BAR;
    if constexpr (Epi::AFTER_DRAIN) { E.fused(acc, cur, wr, wc, fr, fq, lds, wid, lane); S.done(cur); }
#undef PG8_SA
#undef PG8_SB
#undef PG8_STAGE
#undef PG8_LDA
#undef PG8_LDB
#undef PG8_MMA
#undef PG8_WAIT_V
#undef PG8_WAIT_L
#undef PG8_BAR
#undef PG8_SCHED
}
}

typedef unsigned short bf16_t;
typedef short bf16x8 __attribute__((ext_vector_type(8)));
typedef float f32x4 __attribute__((ext_vector_type(4)));
typedef float f32x16 __attribute__((ext_vector_type(16)));
typedef unsigned u32x4 __attribute__((ext_vector_type(4)));
typedef unsigned u32x2 __attribute__((ext_vector_type(2)));
#define LAS __attribute__((address_space(3)))
__device__ __forceinline__ int opaque_tid() { int t = threadIdx.x; asm volatile("" : "+v"(t)); return t; }

constexpr int DM = 1024, NBATCH = 4, SEQ = 8192, NTOK = NBATCH * SEQ, CTXL = 256, NCTX = NBATCH * CTXL, MROWS = NTOK + NCTX;
constexpr int PW = 2816;
constexpr int C_Q = 0, C_K = 512, C_V = 640, C_GA = 768, C_UF = 1280, C_GF = 1536, C_ZC = 1792, C_BC = 2048, C_CC = 2304, C_GC = 2560;
constexpr int VT_PITCH = SEQ + CTXL;
constexpr float NORM_EPS = 1e-6f;
constexpr float LOG2E = 1.4426950408889634f;

constexpr size_t KiB = 1024, MiB = 1u << 20;
constexpr size_t WS_CTL = 0;
constexpr size_t WS_BAR = 16 * KiB;
constexpr size_t WS_ZERO_BYTES = 32 * KiB;
constexpr size_t WS_MOD = 64 * KiB;
constexpr size_t WS_ROPE = 256 * KiB;
constexpr size_t WS_TW = 320 * KiB;
constexpr size_t WS_T1R = 384 * KiB, WS_T1I = 416 * KiB;
constexpr size_t WS_T3R = 448 * KiB, WS_T3I = 464 * KiB;
constexpr size_t WS_T256R = 512 * KiB, WS_T256I = 640 * KiB;
constexpr size_t WS_GT = 768 * KiB;
constexpr size_t WS_SSQ = 1 * MiB;
constexpr size_t WS_WIN = 4 * MiB;
constexpr size_t WS_WOUT = 16 * MiB;
constexpr size_t WS_SSQ1 = 24 * MiB;
constexpr size_t WS_MODP = 28 * MiB;
constexpr size_t WS_HX = 32 * MiB;
constexpr size_t WS_P = 112 * MiB;
constexpr size_t WS_VT = 304 * MiB;
constexpr size_t WS_H = 320 * MiB;
constexpr size_t WS_Y = 392 * MiB;
constexpr size_t WS_YF = 464 * MiB;
constexpr size_t WS_CTX1 = 100 * MiB;
constexpr size_t WS_UFP = 496 * MiB;
constexpr size_t WS_END = 512 * MiB;
static_assert(WS_BAR + 3456 * 4 <= WS_ZERO_BYTES && WS_MODP + (size_t)2 * 8 * 5 * 3072 * 4 <= WS_HX && WS_SSQ + (size_t)MROWS * 16 * 4 <= WS_WIN && WS_WIN + (size_t)2 * PW * DM * 2 <= WS_WOUT && WS_HX + (size_t)MROWS * DM * 2 <= WS_P && WS_P + (size_t)MROWS * PW * 2 <= WS_VT &&
              WS_VT + (size_t)8 * 64 * VT_PITCH * 2 <= WS_H && WS_H + (size_t)MROWS * DM * 2 <= WS_Y && WS_Y + (size_t)MROWS * DM * 2 <= WS_YF && WS_YF + (size_t)4 * 128 * 64 * 512 * 2 <= WS_UFP && WS_UFP + (size_t)NTOK * 256 * 2 <= WS_END && WS_HX + (size_t)MROWS * DM * 2 <= WS_CTX1 && WS_CTX1 + (size_t)NCTX * DM * 4 <= WS_P, "ws map");

constexpr int LDS_BYTES = 147456;
constexpr int LDS_SCHED = LDS_BYTES - 64;
constexpr int LDS_BARST = LDS_BYTES - 32;
constexpr int NTHREADS = 512;

__device__ __forceinline__ float bf2f(unsigned h) { return __uint_as_float(h << 16); }
__device__ __forceinline__ unsigned pkbf(float lo, float hi) { unsigned r; asm volatile("v_cvt_pk_bf16_f32 %0, %1, %2" : "=v"(r) : "v"(lo), "v"(hi)); return r; }
__device__ __forceinline__ float silu_f(float x) { return x * __builtin_amdgcn_rcpf(1.f + __builtin_amdgcn_exp2f(-x * LOG2E)); }
__device__ __forceinline__ float wave_sum(float v) {
#pragma unroll
    for (int o = 1; o < 64; o <<= 1) v += __shfl_xor(v, o);
    return v;
}
__device__ __forceinline__ int swap23(int t) { return (t & ~12) | ((t & 4) << 1) | ((t & 8) >> 1); }
__device__ __forceinline__ int crow(int r, int hi) { return (r & 3) + 8 * (r >> 2) + 4 * hi; }
__device__ __forceinline__ bf16x8 pack8(const f32x16& p, int base) {
    u32x4 w; w.x = pkbf(p[base + 0], p[base + 1]); w.y = pkbf(p[base + 2], p[base + 3]); w.z = pkbf(p[base + 4], p[base + 5]); w.w = pkbf(p[base + 6], p[base + 7]);
    return __builtin_bit_cast(bf16x8, w);
}
#define MFMA32(a, b, c) __builtin_amdgcn_mfma_f32_32x32x16_bf16((a), (b), (c), 0, 0, 0)

struct KArgs {
    const float *x, *c, *ctx, *c_ctx, *w_mod, *b_mod, *g_pre, *g_post, *w_in, *w_out, *sink, *w_f, *conv_w, *conv_b;
    float* out; unsigned char* ws; int ph_lo, ph_hi;
};

__device__ __forceinline__ int prow_qk(int n) { return (n & ~31) | (8 * ((n >> 2) & 3) + 4 * ((n >> 4) & 1) + (n & 3)); }
__device__ __forceinline__ void p0_transpose_item(const float* W, int K, int N, bf16_t* WT, int nperm, float* scr, int item, int lane) {
    const int nblk = N / 32, kb = item / nblk, nb = item % nblk, k0 = 64 * kb, n0 = 32 * nb;
    { float wv[32];
#pragma unroll
      for (int i = 0; i < 32; ++i) wv[i] = W[(size_t)(k0 + 2 * i + (lane >> 5)) * N + n0 + (lane & 31)];
      __builtin_amdgcn_sched_barrier(0);
#pragma unroll
      for (int i = 0; i < 32; ++i) scr[(2 * i + (lane >> 5)) * 33 + (lane & 31)] = wv[i];
      __builtin_amdgcn_sched_barrier(0); }
    asm volatile("s_waitcnt lgkmcnt(0)" ::: "memory");
    const int c = lane & 7;
#pragma unroll
    for (int j = 0; j < 4; ++j) { const int n = (lane >> 3) + 8 * j; const float* s = scr + (8 * c) * 33 + n;
        u32x4 o; o.x = pkbf(s[0 * 33], s[1 * 33]); o.y = pkbf(s[2 * 33], s[3 * 33]); o.z = pkbf(s[4 * 33], s[5 * 33]); o.w = pkbf(s[6 * 33], s[7 * 33]);
        const int nl = n0 + n; const int np = nl < nperm ? prow_qk(nl) : nl;
        *(u32x4*)(WT + (size_t)np * K + k0 + 8 * c) = o; }
    asm volatile("s_waitcnt lgkmcnt(0)" ::: "memory");
}

__device__ __forceinline__ void p0_mod_gemv(const KArgs& a, int item, float* ldsf) {
    const int tid = opaque_tid(), lane = tid & 63, wave = tid >> 6;
    const int l = item / 96, col0 = (item % 96) * 32;
    float* s = ldsf;
    float* red = ldsf + 5 * 1024;
    for (int i = tid; i < 5 * 1024; i += NTHREADS) { const int bb = i >> 10, k = i & 1023; const float v = bb < 4 ? a.c[bb * 1024 + k] : a.c_ctx[k]; s[i] = v / (1.f + __expf(-v)); }
    __syncthreads();
    const int col = lane & 31, kh = lane >> 5;
    const float* W = a.w_mod + (size_t)l * 1024 * 3072 + (size_t)(wave * 128 + kh) * 3072 + col0 + col;
    float w[64];
#pragma unroll
    for (int i = 0; i < 64; ++i) w[i] = W[(size_t)(2 * i) * 3072];
    float acc[5] = {0.f, 0.f, 0.f, 0.f, 0.f};
#pragma unroll
    for (int i = 0; i < 64; ++i)
#pragma unroll
        for (int bb = 0; bb < 5; ++bb) acc[bb] += w[i] * s[bb * 1024 + wave * 128 + 2 * i + kh];
#pragma unroll
    for (int bb = 0; bb < 5; ++bb) red[((wave * 2 + kh) * 5 + bb) * 32 + col] = acc[bb];
    __syncthreads();
    if (tid < 160) { const int bb = tid >> 5, cc = tid & 31; float v = a.b_mod[l * 3072 + col0 + cc];
#pragma unroll
        for (int ww = 0; ww < 16; ++ww) v += red[(ww * 5 + bb) * 32 + cc];
        ((float*)(a.ws + WS_MOD))[(l * 5 + bb) * 3072 + col0 + cc] = v; }
    __syncthreads();
}

__device__ __forceinline__ void p0_prologue(const KArgs& a, unsigned char* lds) {
    const int tid = opaque_tid(), lane = tid & 63, wave = tid >> 6;
    const int G = gridDim.x, bx = blockIdx.x;
    unsigned char* ws = a.ws;
    if (bx < 192) p0_mod_gemv(a, bx, (float*)lds);
    {
        float* scr = (float*)(lds + wave * 16384);
        const int gw = bx * 8 + wave, NGW = G * 8;
        constexpr int I_IN = (DM / 64) * (PW / 32), I_OUT = (DM / 64) * (DM / 32);
        constexpr int NIT = 2 * (I_IN + I_OUT);
        for (int it = gw; it < NIT; it += NGW) {
            int r = it; const int l = r / (I_IN + I_OUT); r -= l * (I_IN + I_OUT);
            if (r < I_IN) p0_transpose_item(a.w_in + (size_t)l * DM * PW, DM, PW, (bf16_t*)(ws + WS_WIN) + (size_t)l * PW * DM, 640, scr, r, lane);
            else p0_transpose_item(a.w_out + (size_t)l * DM * DM, DM, DM, (bf16_t*)(ws + WS_WOUT) + (size_t)l * DM * DM, 0, scr, r - I_IN, lane);
        }
    }
    const int gt = bx * NTHREADS + tid, NGT = G * NTHREADS;
    for (int i = gt; i < 128 * 16; i += NGT) {
        const int pos = i >> 4, f = i & 15; const float inv = powf(10000.0f, -(float)f / 16.0f); const float ang = (float)pos * inv;
        float* rp = (float*)(ws + WS_ROPE) + pos * 32; rp[f] = cosf(ang); rp[16 + f] = sinf(ang);
    }
    for (int i = gt; i < 8192; i += NGT) { float sn, cs; sincospif((float)i * (2.0f / 8192.0f), &sn, &cs); float* t = (float*)(ws + WS_TW) + 2 * i; t[0] = cs; t[1] = sn; }
    for (int i = gt; i < 128 * 128; i += NGT) { const int k = i >> 7, n = i & 127; float sn, cs; sincospif((float)((k * n) & 127) * (2.0f / 128.0f), &sn, &cs);
        ((bf16_t*)(ws + WS_T1R))[i] = (bf16_t)(pkbf(cs, 0.f) & 0xffffu); ((bf16_t*)(ws + WS_T1I))[i] = (bf16_t)(pkbf(-sn, 0.f) & 0xffffu); }
    for (int i = gt; i < 64 * 128; i += NGT) { const int k = i >> 7, kk = i & 127, n = kk & 63; float sn, cs; sincospif((float)((k * n) & 63) * (2.0f / 64.0f), &sn, &cs);
        const float tr = kk < 64 ? cs : sn, ti = kk < 64 ? -sn : cs;
        const int fpos = ((((k >> 5) * 8 + (kk >> 4)) * 64 + ((k & 31) + 32 * ((kk >> 3) & 1))) * 8) + (kk & 7);
        ((bf16_t*)(ws + WS_T3R))[fpos] = (bf16_t)(pkbf(tr, 0.f) & 0xffffu); ((bf16_t*)(ws + WS_T3I))[fpos] = (bf16_t)(pkbf(ti, 0.f) & 0xffffu); }
    for (int i = gt; i < 256 * 256; i += NGT) { const int k = i >> 8, n = i & 255; float sn, cs; sincospif((float)((k * n) & 255) * (2.0f / 256.0f), &sn, &cs);
        ((bf16_t*)(ws + WS_T256R))[i] = (bf16_t)(pkbf(cs, 0.f) & 0xffffu); ((bf16_t*)(ws + WS_T256I))[i] = (bf16_t)(pkbf(-sn, 0.f) & 0xffffu); }
    {
        __syncthreads();
        float* trig = (float*)lds;
        if (tid < 64) { float sn, cs; sincospif((float)tid * (2.0f / 64.0f), &sn, &cs); trig[tid] = cs; trig[64 + tid] = sn; }
        __syncthreads();
        for (int i = gt; i < 2 * 4 * 64 * 128; i += NGT) {
            const int kk = i & 127, d = (i >> 7) & 63, g = (i >> 13) & 3, l = i >> 15; const int part = kk >> 6, c = swap23(kk & 63);
            const float* wf = a.w_f + ((size_t)(l * 4 + g) * 64) * 64 + d; float sacc = 0.f;
            float wfv[64];
#pragma unroll
            for (int j = 0; j < 64; ++j) wfv[j] = wf[j * 64];
            __builtin_amdgcn_sched_barrier(0);
#pragma unroll
            for (int j = 0; j < 64; ++j) sacc += trig[part * 64 + ((c * j) & 63)] * wfv[j];
            const int gpos = ((((((l * 4 + g) * 2 + (d >> 5)) * 8 + (kk >> 4)) * 64) + ((d & 31) + 32 * ((kk >> 3) & 1))) * 8) + (kk & 7);
            ((bf16_t*)(ws + WS_GT))[gpos] = (bf16_t)(pkbf(sacc * (1.0f / 724.0773439350246f), 0.f) & 0xffffu);
        }
        __syncthreads();
    }
}

__device__ __forceinline__ void norm_rows4(int mode, int lane, const float* src, float* dst, const bf16_t* y0, const float* ssq0, const bf16_t* y1, const float* ssq1, bf16_t* hx,
                                           const f32x4 (&GA0)[4], const f32x4 (&GA1)[4], const f32x4 (&GB)[4], const f32x4 (&GC)[4]) {
    f32x4 v[4][4];
#pragma unroll
    for (int rr = 0; rr < 4; ++rr)
#pragma unroll
        for (int j = 0; j < 4; ++j) v[rr][j] = *(const f32x4*)(src + (size_t)rr * DM + 4 * lane + 256 * j);
    if (mode != 0) {
        u32x2 yw[4][4], yx[4][4]; float p[4], p1[4];
#pragma unroll
        for (int rr = 0; rr < 4; ++rr) { p[rr] = ssq0[rr * 16 + (lane & 15)];
#pragma unroll
            for (int j = 0; j < 4; ++j) yw[rr][j] = *(const u32x2*)(y0 + (size_t)rr * DM + 4 * lane + 256 * j); }
        if (mode == 2) {
#pragma unroll
            for (int rr = 0; rr < 4; ++rr) { p1[rr] = ssq1[rr * 16 + (lane & 15)];
#pragma unroll
                for (int j = 0; j < 4; ++j) yx[rr][j] = *(const u32x2*)(y1 + (size_t)rr * DM + 4 * lane + 256 * j); }
        }
#pragma unroll
        for (int rr = 0; rr < 4; ++rr) {
            float q = p[rr]; q += __shfl_xor(q, 1); q += __shfl_xor(q, 2); q += __shfl_xor(q, 4); q += __shfl_xor(q, 8);
            const float rstd = 1.0f / sqrtf(q * (1.0f / DM) + NORM_EPS);
#pragma unroll
            for (int j = 0; j < 4; ++j) {
                f32x4 yy; yy[0] = bf2f(yw[rr][j].x & 0xffffu); yy[1] = bf2f(yw[rr][j].x >> 16); yy[2] = bf2f(yw[rr][j].y & 0xffffu); yy[3] = bf2f(yw[rr][j].y >> 16);
                v[rr][j] = v[rr][j] + GA0[j] * (yy * rstd);
            }
        }
        if (mode == 2) {
#pragma unroll
            for (int rr = 0; rr < 4; ++rr) {
                float q = p1[rr]; q += __shfl_xor(q, 1); q += __shfl_xor(q, 2); q += __shfl_xor(q, 4); q += __shfl_xor(q, 8);
                const float rstd = 1.0f / sqrtf(q * (1.0f / DM) + NORM_EPS);
#pragma unroll
                for (int j = 0; j < 4; ++j) {
                    f32x4 yy; yy[0] = bf2f(yx[rr][j].x & 0xffffu); yy[1] = bf2f(yx[rr][j].x >> 16); yy[2] = bf2f(yx[rr][j].y & 0xffffu); yy[3] = bf2f(yx[rr][j].y >> 16);
                    v[rr][j] = v[rr][j] + GA1[j] * (yy * rstd);
                    *(f32x4*)(dst + (size_t)rr * DM + 4 * lane + 256 * j) = v[rr][j];
                }
            }
        }
    }
    if (mode != 2) {
        float s[4];
#pragma unroll
        for (int rr = 0; rr < 4; ++rr) { float t = 0.f;
#pragma unroll
            for (int j = 0; j < 4; ++j) t += (v[rr][j][0] * v[rr][j][0] + v[rr][j][1] * v[rr][j][1]) + (v[rr][j][2] * v[rr][j][2] + v[rr][j][3] * v[rr][j][3]);
            s[rr] = t; }
#pragma unroll
        for (int o = 1; o < 64; o <<= 1) {
#pragma unroll
            for (int rr = 0; rr < 4; ++rr) s[rr] += __shfl_xor(s[rr], o); }
#pragma unroll
        for (int rr = 0; rr < 4; ++rr) {
            const float rstd = 1.0f / sqrtf(s[rr] * (1.0f / DM) + NORM_EPS);
#pragma unroll
            for (int j = 0; j < 4; ++j) {
                const f32x4 o = (v[rr][j] * rstd) * GB[j] + GC[j];
                u32x2 w; w.x = pkbf(o[0], o[1]); w.y = pkbf(o[2], o[3]);
                *(u32x2*)(hx + (size_t)rr * DM + 4 * lane + 256 * j) = w;
            }
        }
    }
}
__device__ __forceinline__ void norm_phase(const KArgs& a, int mode) {
    const int tid = opaque_tid(), lane = tid & 63, wave = tid >> 6;
    const int NGW = gridDim.x * 8;
    unsigned char* ws = a.ws;
    const float* mod = (const float*)(ws + WS_MOD);
    const int lp = (mode == 0) ? 0 : 1;
    bf16_t* HX = (bf16_t*)(ws + WS_HX); const bf16_t* Y0 = (const bf16_t*)(ws + WS_Y); const float* SSQ0 = (const float*)(ws + WS_SSQ);
    const bf16_t* Y1 = (const bf16_t*)(ws + WS_HX); const float* SSQ1 = (const float*)(ws + WS_SSQ1);
    const int gw2 = wave * (int)gridDim.x + (int)blockIdx.x;
    const int nlat = NTOK / 4;
    int curb = -1; f32x4 GA0[4], GA1[4], GB[4], GC[4];
    int base = gw2 * 4, sub = 0, itc = nlat + gw2; bool inctx = false;
    for (;;) {
        int it;
        if (!inctx) { if (base >= nlat) { inctx = true; continue; } it = base + sub; if (++sub == 4) { sub = 0; base += NGW * 4; } }
        else { if (mode == 2 || itc >= nlat + NCTX / 4) break; it = itc; itc += NGW; }
        const int r = it * 4;
        const int b = r < NTOK ? (r >> 13) : 4;
        if (b != curb) { curb = b;
            const float* mp = mod + (lp * 5 + b) * 3072; const float* m0 = mod + (0 * 5 + b) * 3072; const float* m1 = mod + (1 * 5 + b) * 3072;
#pragma unroll
            for (int j = 0; j < 4; ++j) { const int c = 4 * lane + 256 * j;
                GA0[j] = *(const f32x4*)(m0 + 2048 + c) * *(const f32x4*)(a.g_post + c);
                GA1[j] = *(const f32x4*)(m1 + 2048 + c) * *(const f32x4*)(a.g_post + DM + c);
                GB[j] = *(const f32x4*)(a.g_pre + lp * DM + c) * (*(const f32x4*)(mp + 1024 + c) + 1.0f);
                GC[j] = *(const f32x4*)(mp + c); } }
        const float* src = (r < NTOK) ? a.x + (size_t)r * DM : a.ctx + (size_t)(r - NTOK) * DM;
        norm_rows4(mode, lane, src, a.out + (size_t)r * DM, Y0 + (size_t)r * DM, SSQ0 + (size_t)r * 16, Y1 + (size_t)r * DM, SSQ1 + (size_t)r * 16, HX + (size_t)r * DM, GA0, GA1, GB, GC);
    }
}

__device__ __forceinline__ void attn_unit(int u, const bf16_t* P, const bf16_t* Vt, bf16_t* H, const float* sink, unsigned char* lds) {
    const int tid = opaque_tid(), lane = tid & 63, wave = __builtin_amdgcn_readfirstlane(tid >> 6), r32 = lane & 31, hi = lane >> 5;
    const bool isctx = u >= 1024;
    int b, kvh, qb;
    if (isctx) { const int v = u - 1024; b = v >> 3; kvh = (v >> 2) & 1; qb = v & 3; } else { b = u >> 8; kvh = (u >> 7) & 1; qb = u & 127; }
    const int head = kvh * 4 + (wave >> 1);
    const int qtok = qb * 64 + (wave & 1) * 32 + r32;
    const size_t qrow = isctx ? (size_t)(NTOK + b * CTXL + qtok) : (size_t)(b * SEQ + qtok);
    const float sinkv = sink[head];
    unsigned char* qscr = lds + 40960 + wave * 4608;
    u32x4 qld[4];
#pragma unroll
    for (int i4 = 0; i4 < 4; ++i4) qld[i4] = *(const u32x4*)(P + (qrow - r32 + i4 * 8 + (lane >> 3)) * PW + C_Q + head * 64 + (lane & 7) * 8);
    int jlo = 0, jhi = -1;
    if (!isctx) { jlo = qb < 2 ? 2 - qb : 0; jhi = (129 - qb) < 4 ? (129 - qb) : 4; }
    const int ntiles = 4 + (jhi - jlo + 1);
    const int srow = tid >> 3, sch = tid & 7;
    const bf16_t* Kc = P + (size_t)(NTOK + b * CTXL + srow) * PW + C_K + kvh * 64 + sch * 8;
    const bf16_t* Kl = P + (size_t)(b * SEQ + srow) * PW + C_K + kvh * 64 + sch * 8;
    const bf16_t* Vb = Vt + (size_t)((b * 2 + kvh) * 64 + srow) * VT_PITCH + sch * 8;
    unsigned char* Ks = lds; unsigned char* Vs = lds + 2 * 9216;
    const int soff = srow * 144 + sch * 16;
    u32x4 kreg, vreg, kreg2, vreg2;
#define ATT_GLOAD(KR, VR, ti_) do { const int t_ = (ti_); \
        if (t_ < 4) { KR = *(const u32x4*)(Kc + (size_t)(64 * t_) * PW); VR = *(const u32x4*)(Vb + SEQ + 64 * t_); } \
        else { const int kbase_ = qb * 64 - 128 + 64 * (jlo + t_ - 4); KR = *(const u32x4*)(Kl + (size_t)kbase_ * PW); VR = *(const u32x4*)(Vb + kbase_); } } while (0)
    const size_t qrow0 = qrow - r32;
    u32x4 gaw[4];
#pragma unroll
    for (int i4 = 0; i4 < 4; ++i4) gaw[i4] = *(const u32x4*)(P + (qrow0 + i4 * 8 + (lane >> 3)) * PW + C_GA + head * 64 + (lane & 7) * 8);
    ATT_GLOAD(kreg2, vreg2, 0);
    ATT_GLOAD(kreg, vreg, 1);
#pragma unroll
    for (int i4 = 0; i4 < 4; ++i4) *(u32x4*)(qscr + (i4 * 8 + (lane >> 3)) * 144 + (lane & 7) * 16) = qld[i4];
    *(u32x4*)(Ks + soff) = kreg2; *(u32x4*)(Vs + soff) = vreg2;
    __syncthreads();
    bf16x8 qf[4];
#pragma unroll
    for (int d0 = 0; d0 < 4; ++d0) qf[d0] = *(const bf16x8*)(qscr + r32 * 144 + (2 * d0 + hi) * 16);
    const float sink2 = sinkv * LOG2E;
    float mref = sink2, lsum = 0.f;
    f32x16 oT[2]; oT[0] = f32x16{}; oT[1] = f32x16{};
    const int qpos = qtok;
    for (int ti = 0; ti < ntiles; ++ti) {
        const int buf = ti & 1;
        if (ti + 2 < ntiles) ATT_GLOAD(kreg2, vreg2, ti + 2);
        const unsigned char* kb = Ks + buf * 9216 + r32 * 144 + hi * 16;
        const unsigned char* vb = Vs + buf * 9216 + r32 * 144 + hi * 16;
        bf16x8 kf[8];
#pragma unroll
        for (int d0 = 0; d0 < 4; ++d0) { kf[2 * d0] = *(const bf16x8*)(kb + d0 * 32); kf[2 * d0 + 1] = *(const bf16x8*)(kb + 32 * 144 + d0 * 32); }
        f32x16 p0, p1;
#pragma unroll
        for (int r = 0; r < 16; ++r) { p0[r] = -mref; p1[r] = -mref; }
        __builtin_amdgcn_sched_barrier(0);
#pragma unroll
        for (int d0 = 0; d0 < 4; ++d0) { p0 = MFMA32(kf[2 * d0], qf[d0], p0); p1 = MFMA32(kf[2 * d0 + 1], qf[d0], p1); }
        bf16x8 vf[8];
#pragma unroll
        for (int blk = 0; blk < 2; ++blk)
#pragma unroll
            for (int ks = 0; ks < 4; ++ks) vf[blk * 4 + ks] = *(const bf16x8*)(vb + blk * 32 * 144 + ks * 32);
        __builtin_amdgcn_sched_barrier(0);
        asm volatile("s_nop 15\n\ts_nop 7" : "+v"(p0), "+v"(p1));
        if (ti >= 4) {
            const int j = jlo + ti - 4; const int kbase = qb * 64 - 128 + 64 * j;
            if (j == 0) {
#pragma unroll
                for (int r = 0; r < 16; ++r) { const int kp = kbase + crow(r, hi); if (kp < qpos - 128) p0[r] = -INFINITY; if (kp + 32 < qpos - 128) p1[r] = -INFINITY; }
            } else if (j == 4) {
#pragma unroll
                for (int r = 0; r < 16; ++r) { const int kp = kbase + crow(r, hi); if (kp > qpos + 128) p0[r] = -INFINITY; if (kp + 32 > qpos + 128) p1[r] = -INFINITY; }
            }
        }
        float rma, rmb;
        asm("v_max3_f32 %0, %1, %2, %3" : "=v"(rma) : "v"(p0[0]), "v"(p0[1]), "v"(p1[0]));
        asm("v_max3_f32 %0, %1, %2, %3" : "=v"(rmb) : "v"(p0[2]), "v"(p0[3]), "v"(p1[1]));
        asm("v_max3_f32 %0, %1, %2, %3" : "=v"(rma) : "v"(rma), "v"(p1[2]), "v"(p1[3]));
#pragma unroll
        for (int r = 4; r < 16; r += 4) {
            asm("v_max3_f32 %0, %1, %2, %3" : "=v"(rma) : "v"(rma), "v"(p0[r]), "v"(p0[r + 1]));
            asm("v_max3_f32 %0, %1, %2, %3" : "=v"(rmb) : "v"(rmb), "v"(p0[r + 2]), "v"(p0[r + 3]));
            asm("v_max3_f32 %0, %1, %2, %3" : "=v"(rma) : "v"(rma), "v"(p1[r]), "v"(p1[r + 1]));
            asm("v_max3_f32 %0, %1, %2, %3" : "=v"(rmb) : "v"(rmb), "v"(p1[r + 2]), "v"(p1[r + 3]));
        }
        float rm; asm("v_max3_f32 %0, %1, %2, %3" : "=v"(rm) : "v"(rma), "v"(rmb), "v"(rmb));
        { const float rmo = __shfl_xor(rm, 32); asm("v_max3_f32 %0, %1, %2, %3" : "=v"(rm) : "v"(rm), "v"(rmo), "v"(rmo)); }
        if (__any(rm > 8.0f)) {
            const float dl = fmaxf(rm, 0.f);
            mref += dl;
            const float f = __builtin_amdgcn_exp2f(-dl);
            lsum *= f;
#pragma unroll
            for (int r = 0; r < 16; ++r) { p0[r] -= dl; p1[r] -= dl; oT[0][r] *= f; oT[1][r] *= f; }
        }
        float ls = 0.f;
#pragma unroll
        for (int r = 0; r < 16; ++r) { p0[r] = __builtin_amdgcn_exp2f(p0[r]); p1[r] = __builtin_amdgcn_exp2f(p1[r]); ls += p0[r] + p1[r]; }
        lsum += ls;
        bf16x8 pf[4]; pf[0] = pack8(p0, 0); pf[1] = pack8(p0, 8); pf[2] = pack8(p1, 0); pf[3] = pack8(p1, 8);
#pragma unroll
        for (int blk = 0; blk < 2; ++blk)
#pragma unroll
            for (int ks = 0; ks < 4; ++ks) oT[blk] = MFMA32(vf[blk * 4 + ks], pf[ks], oT[blk]);
        if (ti + 1 < ntiles) { *(u32x4*)(Ks + (buf ^ 1) * 9216 + soff) = kreg; *(u32x4*)(Vs + (buf ^ 1) * 9216 + soff) = vreg; }
        kreg = kreg2; vreg = vreg2;
        __syncthreads();
    }
    lsum += __shfl_xor(lsum, 32);
    lsum += __builtin_amdgcn_exp2f(sink2 - mref);
    const float inv = 1.0f / lsum;
    unsigned char* ow = qscr;
#pragma unroll
    for (int blk = 0; blk < 2; ++blk)
#pragma unroll
        for (int g4 = 0; g4 < 4; ++g4) {
            u32x2 w; w.x = pkbf(oT[blk][4 * g4 + 0] * inv, oT[blk][4 * g4 + 1] * inv); w.y = pkbf(oT[blk][4 * g4 + 2] * inv, oT[blk][4 * g4 + 3] * inv);
            *(u32x2*)(ow + r32 * 144 + (32 * blk + 8 * g4 + 4 * hi) * 2) = w;
        }
    asm volatile("s_waitcnt lgkmcnt(0)" ::: "memory");
#pragma unroll
    for (int i4 = 0; i4 < 4; ++i4) {
        const int rr = i4 * 8 + (lane >> 3), ch = lane & 7;
        const u32x4 ov = *(const u32x4*)(ow + rr * 144 + ch * 16);
        const unsigned ovv[4] = {ov.x, ov.y, ov.z, ov.w}, gvv[4] = {gaw[i4].x, gaw[i4].y, gaw[i4].z, gaw[i4].w};
        u32x4 w;
        unsigned wv[4];
#pragma unroll
        for (int e = 0; e < 4; ++e) wv[e] = pkbf(bf2f(ovv[e] & 0xffffu) * silu_f(bf2f(gvv[e] & 0xffffu)), bf2f(ovv[e] >> 16) * silu_f(bf2f(gvv[e] >> 16)));
        w.x = wv[0]; w.y = wv[1]; w.z = wv[2]; w.w = wv[3];
        *(u32x4*)(H + (qrow0 + rr) * DM + head * 64 + ch * 8) = w;
    }
    asm volatile("s_waitcnt lgkmcnt(0)" ::: "memory");
}

typedef short v4i16_t __attribute__((ext_vector_type(4)));
__device__ __forceinline__ v4i16_t trrd(const unsigned char* p) { return __builtin_amdgcn_ds_read_tr16_b64_v4i16((LAS v4i16_t*)p); }
__device__ __forceinline__ bf16x8 cat8(v4i16_t lo, v4i16_t hi) { return (bf16x8){lo[0], lo[1], lo[2], lo[3], hi[0], hi[1], hi[2], hi[3]}; }
__device__ __forceinline__ void fft1_unit(int u, const bf16_t* P, bf16_t* YF, const unsigned char* ws, unsigned char* lds) {
    const int tid = opaque_tid(), lane = tid & 63, wave = __builtin_amdgcn_readfirstlane(tid >> 6), r32 = lane & 31, hi = lane >> 5;
    const int b = u >> 6, n2 = u & 63;
    constexpr int UPB = 576;
    const bf16_t* src = P + (size_t)(b * SEQ + n2) * PW + C_UF;
#pragma unroll
    for (int i = 0; i < 8; ++i) {
        const int id = tid + NTHREADS * i, n1 = id >> 5, cc = id & 31;
        *(u32x4*)(lds + n1 * UPB + cc * 16) = *(const u32x4*)(src + (size_t)n1 * 64 * PW + cc * 8);
    }
    __syncthreads();
    const bf16_t* T1R = (const bf16_t*)(ws + WS_T1R); const bf16_t* T1I = (const bf16_t*)(ws + WS_T1I);
    f32x16 aR[4], aI[4];
#pragma unroll
    for (int kb = 0; kb < 4; ++kb) { aR[kb] = f32x16{}; aI[kb] = f32x16{}; }
    const unsigned char* ap = lds + (8 * hi + ((lane & 15) >> 2)) * UPB + (32 * wave + 16 * ((lane >> 4) & 1) + 4 * (lane & 3)) * 2;
#pragma unroll 2
    for (int ks = 0; ks < 8; ++ks) {
        const bf16x8 av = cat8(trrd(ap + (16 * ks) * UPB), trrd(ap + (16 * ks + 4) * UPB));
#pragma unroll
        for (int kb = 0; kb < 4; ++kb) {
            const bf16x8 bR = *(const bf16x8*)(T1R + (32 * kb + r32) * 128 + 16 * ks + 8 * hi), bI = *(const bf16x8*)(T1I + (32 * kb + r32) * 128 + 16 * ks + 8 * hi);
            aR[kb] = MFMA32(av, bR, aR[kb]); aI[kb] = MFMA32(av, bI, aI[kb]);
        }
    }
    const float* TW = (const float*)(ws + WS_TW);
#pragma unroll
    for (int kb = 0; kb < 4; ++kb) {
        const int k1 = 32 * kb + r32;
        const float ct = TW[2 * (n2 * k1)], st = TW[2 * (n2 * k1) + 1];
        bf16_t* yp = YF + ((size_t)((b * 128 + k1) * 64 + n2)) * 512 + 32 * wave + 4 * hi;
#pragma unroll
        for (int g4 = 0; g4 < 4; ++g4) {
            float yr[4], yi[4];
#pragma unroll
            for (int e = 0; e < 4; ++e) { const float r_ = aR[kb][4 * g4 + e], i_ = aI[kb][4 * g4 + e]; yr[e] = r_ * ct + i_ * st; yi[e] = i_ * ct - r_ * st; }
            u32x2 wr_, wi_; wr_.x = pkbf(yr[0], yr[1]); wr_.y = pkbf(yr[2], yr[3]); wi_.x = pkbf(yi[0], yi[1]); wi_.y = pkbf(yi[2], yi[3]);
            *(u32x2*)(yp + 8 * g4) = wr_; *(u32x2*)(yp + 256 + 8 * g4) = wi_;
        }
    }
    __syncthreads();
}

template <int KK>
__device__ __forceinline__ void dftf_unit(const bf16_t* srcbase, int R, int pitchA, int pitchB, const bf16_t* Tr, const bf16_t* Ti, const bf16_t* Gt,
                                          const bf16_t* P, bf16_t* H, size_t row0, int rowstride, float oscale, unsigned char* lds) {
    const int tid = opaque_tid(), lane = tid & 63, wave = __builtin_amdgcn_readfirstlane(tid >> 6), r32 = lane & 31, hi = lane >> 5;
    constexpr int ZPB = (KK == 128) ? 576 : 544;
#pragma unroll 1
    for (int i0 = 0; i0 < KK / 16; i0 += 8) {
        u32x4 img[8];
#pragma unroll
        for (int i = 0; i < 8; ++i) { const int id = tid + NTHREADS * (i0 + i), kk = id >> 5, cc = id & 31; img[i] = *(const u32x4*)(srcbase + (size_t)(kk % R) * pitchA + (size_t)(kk / R) * pitchB + cc * 8); }
        __builtin_amdgcn_sched_barrier(0);
#pragma unroll
        for (int i = 0; i < 8; ++i) { const int id = tid + NTHREADS * (i0 + i), kk = id >> 5, cc = id & 31; *(u32x4*)(lds + kk * ZPB + cc * 16) = img[i]; }
        __builtin_amdgcn_sched_barrier(0);
    }
    __syncthreads();
    const int g = wave >> 1, kblk = wave & 1;
    f32x16 XR[2], XI[2];
#pragma unroll
    for (int cb = 0; cb < 2; ++cb) { XR[cb] = f32x16{}; XI[cb] = f32x16{}; }
    const bf16_t* trp = Tr + (size_t)(32 * kblk + r32) * KK + 8 * hi; const bf16_t* tip = Ti + (size_t)(32 * kblk + r32) * KK + 8 * hi;
    const unsigned char* zp = lds + (8 * hi + ((lane & 15) >> 2)) * ZPB + (64 * g + 16 * ((lane >> 4) & 1) + 4 * (lane & 3)) * 2;
#pragma unroll 2
    for (int ks = 0; ks < KK / 16; ++ks) {
        const bf16x8 bR = *(const bf16x8*)(trp + 16 * ks), bI = *(const bf16x8*)(tip + 16 * ks);
#pragma unroll
        for (int cb = 0; cb < 2; ++cb) { const bf16x8 av = cat8(trrd(zp + (16 * ks) * ZPB + cb * 64), trrd(zp + (16 * ks + 4) * ZPB + cb * 64)); XR[cb] = MFMA32(av, bR, XR[cb]); XI[cb] = MFMA32(av, bI, XI[cb]); }
    }
    f32x16 oa[2]; oa[0] = f32x16{}; oa[1] = f32x16{};
    const bf16_t* gp = Gt + (size_t)(g * 2 * 8 * 64 + lane) * 8;
    u32x2 gfw[8];
    { const size_t rowg = row0 + (size_t)(32 * kblk + r32) * rowstride;
#pragma unroll
      for (int i8 = 0; i8 < 8; ++i8) gfw[i8] = *(const u32x2*)(P + rowg * PW + C_GF + 64 * g + 32 * (i8 >> 2) + 8 * (i8 & 3) + 4 * hi); }
#pragma unroll
    for (int part = 0; part < 2; ++part)
#pragma unroll
        for (int cb = 0; cb < 2; ++cb)
#pragma unroll
            for (int s = 0; s < 2; ++s) {
                const bf16x8 bx = pack8(part ? XI[cb] : XR[cb], 8 * s);
                const int kko = part * 64 + 32 * cb + 16 * s;
#pragma unroll
                for (int lb = 0; lb < 2; ++lb) { const bf16x8 ag = *(const bf16x8*)(gp + (size_t)((lb * 8 + (kko >> 4)) * 64) * 8); oa[lb] = MFMA32(ag, bx, oa[lb]); }
            }
    const int k2 = 32 * kblk + r32;
    const size_t row = row0 + (size_t)k2 * rowstride;
    const bf16_t* gfrow = P + row * PW + C_GF + 64 * g;
    bf16_t* hrow = H + row * DM + 512 + 64 * g;
#pragma unroll
    for (int lb = 0; lb < 2; ++lb)
#pragma unroll
        for (int g4 = 0; g4 < 4; ++g4) {
            const int l0 = 32 * lb + 8 * g4 + 4 * hi;
            const u32x2 gw = gfw[lb * 4 + g4];
            const float o0 = oa[lb][4 * g4 + 0] * oscale * silu_f(bf2f(gw.x & 0xffffu)), o1 = oa[lb][4 * g4 + 1] * oscale * silu_f(bf2f(gw.x >> 16));
            const float o2 = oa[lb][4 * g4 + 2] * oscale * silu_f(bf2f(gw.y & 0xffffu)), o3 = oa[lb][4 * g4 + 3] * oscale * silu_f(bf2f(gw.y >> 16));
            u32x2 w; w.x = pkbf(o0, o1); w.y = pkbf(o2, o3);
            *(u32x2*)(hrow + l0) = w;
        }
    __syncthreads();
}

__device__ __forceinline__ void conv_unit(int u, const bf16_t* P, bf16_t* H, const float* cw, const float* cb) {
    const int tid = opaque_tid(), cgp = tid & 31, rg = tid >> 5;
    const int ch0 = cgp * 8;
    const int r0 = u * 64 + rg * 4;
    int pos, len; if (r0 < NTOK) { pos = r0 & (SEQ - 1); len = SEQ; } else { pos = (r0 - NTOK) & (CTXL - 1); len = CTXL; }
    float w0[8], w1[8], w2[8], bs[8];
#pragma unroll
    for (int e = 0; e < 8; ++e) { w0[e] = cw[ch0 + e]; w1[e] = cw[256 + ch0 + e]; w2[e] = cw[512 + ch0 + e]; bs[e] = cb[ch0 + e]; }
    float T[6][8];
#pragma unroll
    for (int i = 0; i < 6; ++i) {
        const int p = pos - 1 + i;
        if (p >= 0 && p < len) {
            const size_t row = (size_t)(r0 - 1 + i);
            const u32x4 z = *(const u32x4*)(P + row * PW + C_ZC + ch0), c = *(const u32x4*)(P + row * PW + C_CC + ch0);
            T[i][0] = bf2f(z.x & 0xffffu) * bf2f(c.x & 0xffffu); T[i][1] = bf2f(z.x >> 16) * bf2f(c.x >> 16);
            T[i][2] = bf2f(z.y & 0xffffu) * bf2f(c.y & 0xffffu); T[i][3] = bf2f(z.y >> 16) * bf2f(c.y >> 16);
            T[i][4] = bf2f(z.z & 0xffffu) * bf2f(c.z & 0xffffu); T[i][5] = bf2f(z.z >> 16) * bf2f(c.z >> 16);
            T[i][6] = bf2f(z.w & 0xffffu) * bf2f(c.w & 0xffffu); T[i][7] = bf2f(z.w >> 16) * bf2f(c.w >> 16);
        } else {
#pragma unroll
            for (int e = 0; e < 8; ++e) T[i][e] = 0.f;
        }
    }
#pragma unroll
    for (int i = 0; i < 4; ++i) {
        const size_t row = (size_t)(r0 + i);
        const u32x4 bw = *(const u32x4*)(P + row * PW + C_BC + ch0), gw = *(const u32x4*)(P + row * PW + C_GC + ch0);
        const unsigned bwv[4] = {bw.x, bw.y, bw.z, bw.w}, gwv[4] = {gw.x, gw.y, gw.z, gw.w};
        float o[8];
#pragma unroll
        for (int e = 0; e < 8; ++e) {
            const float bv = (e & 1) ? bf2f(bwv[e >> 1] >> 16) : bf2f(bwv[e >> 1] & 0xffffu);
            const float gv = (e & 1) ? bf2f(gwv[e >> 1] >> 16) : bf2f(gwv[e >> 1] & 0xffffu);
            const float y = T[i][e] * w0[e] + T[i + 1][e] * w1[e] + T[i + 2][e] * w2[e] + bs[e];
            o[e] = bv * y * silu_f(gv);
        }
        u32x4 w; w.x = pkbf(o[0], o[1]); w.y = pkbf(o[2], o[3]); w.z = pkbf(o[4], o[5]); w.w = pkbf(o[6], o[7]);
        *(u32x4*)(H + row * DM + 768 + ch0) = w;
    }
}

__device__ __forceinline__ void fft1_tables(const unsigned char* ws, unsigned char* tbl, int tid) {
    u32x4 tv[8];
#pragma unroll
    for (int i = 0; i < 8; ++i) { const int id = tid + NTHREADS * i, t = id >> 11, row = (id >> 4) & 127, ch = id & 15; tv[i] = *(const u32x4*)(ws + (t ? WS_T1I : WS_T1R) + row * 256 + ch * 16); }
    __builtin_amdgcn_sched_barrier(0);
#pragma unroll
    for (int i = 0; i < 8; ++i) { const int id = tid + NTHREADS * i, t = id >> 11, row = (id >> 4) & 127, ch = id & 15; *(u32x4*)(tbl + t * 34816 + row * 272 + ch * 16) = tv[i]; }
}
__device__ __forceinline__ void fft1_wave(int task, const bf16_t* P, bf16_t* YF, const unsigned char* ws, unsigned char* lds_w, const unsigned char* tbl, int lane, int pmode = 0) {
    const int r32 = lane & 31, hi = lane >> 5;
    const int cblk = task & 7, n2 = (task >> 3) & 63, b = task >> 9;
    const bf16_t* src = P + (size_t)((b * 64 + n2) * 128) * 256 + 32 * cblk + 8 * (lane & 3);
    { u32x4 img[8];
#pragma unroll
      for (int i = 0; i < 8; ++i) img[i] = *(const u32x4*)(src + (size_t)(16 * i + (lane >> 2)) * 256);
      __builtin_amdgcn_sched_barrier(0);
#pragma unroll
      for (int i = 0; i < 8; ++i) *(u32x4*)(lds_w + (16 * i + (lane >> 2)) * 64 + (lane & 3) * 16) = img[i];
      __builtin_amdgcn_sched_barrier(0); }
    asm volatile("s_waitcnt vmcnt(0) lgkmcnt(0)" ::: "memory");
    if (pmode == 2) return;
    const bf16_t* T1R = (const bf16_t*)(ws + WS_T1R); const bf16_t* T1I = (const bf16_t*)(ws + WS_T1I);
    f32x16 aR[4], aI[4];
#pragma unroll
    for (int kb = 0; kb < 4; ++kb) { aR[kb] = f32x16{}; aI[kb] = f32x16{}; }
    const unsigned char* ap = lds_w + (8 * hi + ((lane & 15) >> 2)) * 64 + (16 * ((lane >> 4) & 1) + 4 * (lane & 3)) * 2;
    const unsigned char* tb = tbl + r32 * 272 + hi * 16;
#pragma unroll 2
    for (int ks = 0; ks < 8; ++ks) {
        const bf16x8 av = cat8(trrd(ap + (16 * ks) * 64), trrd(ap + (16 * ks + 4) * 64));
        bf16x8 bq[8];
#pragma unroll
        for (int kb = 0; kb < 4; ++kb) { bq[2 * kb] = *(const bf16x8*)(tb + (32 * kb) * 272 + 32 * ks); bq[2 * kb + 1] = *(const bf16x8*)(tb + 34816 + (32 * kb) * 272 + 32 * ks); }
#pragma unroll
        for (int kb = 0; kb < 4; ++kb) { aR[kb] = MFMA32(av, bq[2 * kb], aR[kb]); aI[kb] = MFMA32(av, bq[2 * kb + 1], aI[kb]); }
    }
    const float* TW = (const float*)(ws + WS_TW);
    float ctw[4], stw[4];
#pragma unroll
    for (int kb = 0; kb < 4; ++kb) { const int k1 = 32 * kb + r32; ctw[kb] = TW[2 * (n2 * k1)]; stw[kb] = TW[2 * (n2 * k1) + 1]; }
    asm volatile("s_waitcnt lgkmcnt(0)" ::: "memory");
#pragma unroll
    for (int pr = 0; pr < 2; ++pr) {
#pragma unroll
        for (int kq = 0; kq < 2; ++kq) {
            const int kb = 2 * pr + kq; const int rowl = 32 * kq + r32; const float ct = ctw[kb], st = stw[kb];
#pragma unroll
            for (int g4 = 0; g4 < 4; ++g4) {
                float yr[4], yi[4];
#pragma unroll
                for (int e = 0; e < 4; ++e) { const float r_ = aR[kb][4 * g4 + e], i_ = aI[kb][4 * g4 + e]; yr[e] = r_ * ct + i_ * st; yi[e] = i_ * ct - r_ * st; }
                u32x2 wr_, wi_; wr_.x = pkbf(yr[0], yr[1]); wr_.y = pkbf(yr[2], yr[3]); wi_.x = pkbf(yi[0], yi[1]); wi_.y = pkbf(yi[2], yi[3]);
                *(u32x2*)(lds_w + rowl * 128 + ((g4 ^ (rowl & 7)) * 16) + hi * 8) = wr_;
                *(u32x2*)(lds_w + rowl * 128 + (((4 + g4) ^ (rowl & 7)) * 16) + hi * 8) = wi_;
            }
        }
        asm volatile("s_waitcnt lgkmcnt(0)" ::: "memory");
#pragma unroll
        for (int i8 = 0; i8 < 8; ++i8) {
            const int rowl = i8 * 8 + (lane >> 3), ch = lane & 7;
            const u32x4 v = *(const u32x4*)(lds_w + rowl * 128 + ((ch ^ (rowl & 7)) * 16));
            const int k1 = 64 * pr + rowl;
            bf16_t* dst = YF + ((size_t)((b * 128 + k1) * 64 + n2)) * 512 + (ch >> 2) * 256 + 32 * cblk + 8 * (ch & 3);
            *(u32x4*)dst = v;
        }
        asm volatile("s_waitcnt lgkmcnt(0)" ::: "memory");
    }
}
__device__ __forceinline__ void fft3_wave(int task, const bf16_t* YF, const bf16_t* Gt, const bf16_t* P, bf16_t* H, const unsigned char* ws, unsigned char* lds_w, int lane) {
    const int r32 = lane & 31, hi = lane >> 5;
    const int g = task & 3, k1 = (task >> 2) & 127, b = task >> 9;
    const bf16_t* src = YF + ((size_t)(b * 128 + k1) * 64) * 512 + 64 * g + 8 * (lane & 7);
    { u32x4 img[16];
#pragma unroll
      for (int i = 0; i < 16; ++i) { const int kk = 8 * i + (lane >> 3); img[i] = *(const u32x4*)(src + (size_t)(kk & 63) * 512 + (size_t)(kk >> 6) * 256); }
      __builtin_amdgcn_sched_barrier(0);
#pragma unroll
      for (int i = 0; i < 16; ++i) { const int kk = 8 * i + (lane >> 3), ch = lane & 7; *(u32x4*)(lds_w + kk * 128 + ((ch ^ (((kk >> 1) & 1) << 2)) * 16)) = img[i]; }
      __builtin_amdgcn_sched_barrier(0); }
    asm volatile("s_waitcnt vmcnt(0) lgkmcnt(0)" ::: "memory");
    const bf16_t* T3R = (const bf16_t*)(ws + WS_T3R); const bf16_t* T3I = (const bf16_t*)(ws + WS_T3I);
    const int q = (lane & 15) >> 2, sw = (q >> 1) & 1;
    const int chl = 2 * ((lane >> 4) & 1) + ((lane & 3) >> 1);
    const unsigned char* zb = lds_w + (8 * hi + q) * 128 + 8 * (lane & 1);
    const unsigned char* zp0 = zb + ((chl ^ (sw << 2)) * 16);
    const unsigned char* zp1 = zb + (((4 + chl) ^ (sw << 2)) * 16);
    const bf16_t* gp = Gt + (size_t)(g * 2 * 8 * 64 + lane) * 8;
    const size_t rowb = (size_t)(b * SEQ + k1);
#pragma unroll 1
    for (int kblk = 0; kblk < 2; ++kblk) {
        f32x16 XR[2], XI[2];
#pragma unroll
        for (int cb = 0; cb < 2; ++cb) { XR[cb] = f32x16{}; XI[cb] = f32x16{}; }
        const bf16_t* trp = T3R + (size_t)(kblk * 8 * 64 + lane) * 8; const bf16_t* tip = T3I + (size_t)(kblk * 8 * 64 + lane) * 8;
        const size_t rowg = rowb + (size_t)(32 * kblk + r32) * 128;
        u32x2 gfw[8];
#pragma unroll
        for (int i8 = 0; i8 < 8; ++i8) gfw[i8] = *(const u32x2*)(P + rowg * PW + C_GF + 64 * g + 32 * (i8 >> 2) + 8 * (i8 & 3) + 4 * hi);
        bf16x8 bR[8], bI[8];
#pragma unroll
        for (int ks = 0; ks < 8; ++ks) { bR[ks] = *(const bf16x8*)(trp + 512 * ks); bI[ks] = *(const bf16x8*)(tip + 512 * ks); }
        __builtin_amdgcn_sched_barrier(0);
#pragma unroll
        for (int ks = 0; ks < 8; ++ks) {
            const bf16x8 a0 = cat8(trrd(zp0 + (16 * ks) * 128), trrd(zp0 + (16 * ks + 4) * 128));
            const bf16x8 a1 = cat8(trrd(zp1 + (16 * ks) * 128), trrd(zp1 + (16 * ks + 4) * 128));
            XR[0] = MFMA32(a0, bR[ks], XR[0]); XI[0] = MFMA32(a0, bI[ks], XI[0]); XR[1] = MFMA32(a1, bR[ks], XR[1]); XI[1] = MFMA32(a1, bI[ks], XI[1]);
        }
        __builtin_amdgcn_sched_barrier(0);
        bf16x8 gfr[2][8];
#pragma unroll
        for (int lb = 0; lb < 2; ++lb)
#pragma unroll
            for (int q8 = 0; q8 < 8; ++q8) gfr[lb][q8] = *(const bf16x8*)(gp + (size_t)((lb * 8 + q8) * 64) * 8);
        __builtin_amdgcn_sched_barrier(0);
        f32x16 oa[2]; oa[0] = f32x16{}; oa[1] = f32x16{};
#pragma unroll
        for (int part = 0; part < 2; ++part)
#pragma unroll
            for (int cb = 0; cb < 2; ++cb)
#pragma unroll
                for (int s = 0; s < 2; ++s) {
                    const bf16x8 bx = pack8(part ? XI[cb] : XR[cb], 8 * s);
                    const int kko = part * 64 + 32 * cb + 16 * s;
#pragma unroll
                    for (int lb = 0; lb < 2; ++lb) oa[lb] = MFMA32(gfr[lb][kko >> 4], bx, oa[lb]);
                }
        const int k2 = 32 * kblk + r32;
        const size_t row = rowb + (size_t)k2 * 128;
        const bf16_t* gfrow = P + row * PW + C_GF + 64 * g;
        bf16_t* hrow = H + row * DM + 512 + 64 * g;
#pragma unroll
        for (int lb = 0; lb < 2; ++lb)
#pragma unroll
            for (int g4 = 0; g4 < 4; ++g4) {
                const int l0 = 32 * lb + 8 * g4 + 4 * hi;
                const u32x2 gw = gfw[lb * 4 + g4];
                const float o0 = oa[lb][4 * g4 + 0] * silu_f(bf2f(gw.x & 0xffffu)), o1 = oa[lb][4 * g4 + 1] * silu_f(bf2f(gw.x >> 16));
                const float o2 = oa[lb][4 * g4 + 2] * silu_f(bf2f(gw.y & 0xffffu)), o3 = oa[lb][4 * g4 + 3] * silu_f(bf2f(gw.y >> 16));
                u32x2 w; w.x = pkbf(o0, o1); w.y = pkbf(o2, o3);
                *(u32x2*)(hrow + l0) = w;
            }
    }
    asm volatile("s_waitcnt lgkmcnt(0)" ::: "memory");
}
__device__ __forceinline__ void conv_wave(int task, const bf16_t* P, bf16_t* H, const float* cw, const float* cb, int lane) {
    const int cgp = lane & 31, ch0 = cgp * 8;
    const int r0 = task * 8 + (lane >> 5) * 4;
    int pos, len; if (r0 < NTOK) { pos = r0 & (SEQ - 1); len = SEQ; } else { pos = (r0 - NTOK) & (CTXL - 1); len = CTXL; }
    u32x4 zz[6], cc[6], bb[4], gg[4]; float okf[6];
#pragma unroll
    for (int i = 0; i < 6; ++i) { const int p = pos - 1 + i; const bool ok = p >= 0 && p < len; okf[i] = ok ? 1.f : 0.f; const size_t row = (size_t)(ok ? r0 - 1 + i : r0);
        zz[i] = *(const u32x4*)(P + row * PW + C_ZC + ch0); cc[i] = *(const u32x4*)(P + row * PW + C_CC + ch0); }
#pragma unroll
    for (int i = 0; i < 4; ++i) { const size_t row = (size_t)(r0 + i); bb[i] = *(const u32x4*)(P + row * PW + C_BC + ch0); gg[i] = *(const u32x4*)(P + row * PW + C_GC + ch0); }
    __builtin_amdgcn_sched_barrier(0);
    float w0[8], w1[8], w2[8], bs[8];
    { const f32x4 a0 = *(const f32x4*)(cw + ch0), a1 = *(const f32x4*)(cw + ch0 + 4), b0 = *(const f32x4*)(cw + 256 + ch0), b1 = *(const f32x4*)(cw + 256 + ch0 + 4);
      const f32x4 c0 = *(const f32x4*)(cw + 512 + ch0), c1 = *(const f32x4*)(cw + 512 + ch0 + 4), d0 = *(const f32x4*)(cb + ch0), d1 = *(const f32x4*)(cb + ch0 + 4);
#pragma unroll
      for (int e = 0; e < 4; ++e) { w0[e] = a0[e]; w0[4 + e] = a1[e]; w1[e] = b0[e]; w1[4 + e] = b1[e]; w2[e] = c0[e]; w2[4 + e] = c1[e]; bs[e] = d0[e]; bs[4 + e] = d1[e]; } }
    float T[6][8];
#pragma unroll
    for (int i = 0; i < 6; ++i) {
        const unsigned zv[4] = {zz[i].x, zz[i].y, zz[i].z, zz[i].w}, cv[4] = {cc[i].x, cc[i].y, cc[i].z, cc[i].w};
#pragma unroll
        for (int e = 0; e < 8; ++e) T[i][e] = okf[i] * ((e & 1) ? bf2f(zv[e >> 1] >> 16) : bf2f(zv[e >> 1] & 0xffffu)) * ((e & 1) ? bf2f(cv[e >> 1] >> 16) : bf2f(cv[e >> 1] & 0xffffu));
    }
#pragma unroll
    for (int i = 0; i < 4; ++i) {
        const size_t row = (size_t)(r0 + i);
        const unsigned bwv[4] = {bb[i].x, bb[i].y, bb[i].z, bb[i].w}, gwv[4] = {gg[i].x, gg[i].y, gg[i].z, gg[i].w};
        float o[8];
#pragma unroll
        for (int e = 0; e < 8; ++e) {
            const float bv = (e & 1) ? bf2f(bwv[e >> 1] >> 16) : bf2f(bwv[e >> 1] & 0xffffu);
            const float gv = (e & 1) ? bf2f(gwv[e >> 1] >> 16) : bf2f(gwv[e >> 1] & 0xffffu);
            const float y = T[i][e] * w0[e] + T[i + 1][e] * w1[e] + T[i + 2][e] * w2[e] + bs[e];
            o[e] = bv * y * silu_f(gv);
        }
        u32x4 w; w.x = pkbf(o[0], o[1]); w.y = pkbf(o[2], o[3]); w.z = pkbf(o[4], o[5]); w.w = pkbf(o[6], o[7]);
        *(u32x4*)(H + row * DM + 768 + ch0) = w;
    }
}

#define XB_TMO      128
#define XB_XCNT(j)  (256  + 64 * (j))
#define XB_XSUB(j)  (1280 + 64 * (j))
#define XB_XGEN(j)  (2304 + 64 * (j))
#define XB_TOP      3328
#define XB_TOPGEN   3392
#define XCD_BAR_WORDS 3456
#define XB_SPIN_CAP (1u << 18)

__device__ __forceinline__ unsigned xb_ld(unsigned* p)              { return __hip_atomic_load(p, __ATOMIC_RELAXED, __HIP_MEMORY_SCOPE_AGENT); }
__device__ __forceinline__ unsigned xb_add(unsigned* p, unsigned v) { return __hip_atomic_fetch_add(p, v, __ATOMIC_RELAXED, __HIP_MEMORY_SCOPE_AGENT); }
__device__ __forceinline__ unsigned xb_xcc_id() { return (unsigned)__builtin_amdgcn_s_getreg((3 << 11) | 20) & 0xFu; }
#define XB_SPIN(cond, bar) do { unsigned _sp = 0; while (cond) { __builtin_amdgcn_s_sleep(1); \
    if ((++_sp & 255u) == 0u) { if (xb_ld(&(bar)[XB_TMO])) break; if (_sp > XB_SPIN_CAP) { atomicAdd(&(bar)[XB_TMO], 1u); break; } } } } while (0)

struct XcdBarrier {
    unsigned* bar; unsigned x;
    volatile LAS unsigned* st;
};

__device__ __forceinline__ XcdBarrier xcd_barrier_post(unsigned* bar, volatile LAS unsigned* st) {
    XcdBarrier b; b.bar = bar; b.x = xb_xcc_id(); b.st = st;
    if (threadIdx.x == 0) (void)xb_add(&bar[XB_XCNT(b.x)], 1u);
    return b;
}
__device__ __forceinline__ void xcd_barrier_complete(unsigned* bar, unsigned x, unsigned& nloc, unsigned& nx) {
    const unsigned G = gridDim.x * gridDim.y * gridDim.z;
    unsigned sum, cnt, mine, sp = 0u;
    for (;;) {
        sum = 0u; cnt = 0u; mine = 0u;
#pragma unroll
        for (unsigned j = 0; j < 16; ++j) { const unsigned c = xb_ld(&bar[XB_XCNT(j)]); sum += c; cnt += (c > 0u) ? 1u : 0u; mine = (j == x) ? c : mine; }
        if (sum == G) break;
        __builtin_amdgcn_s_sleep(1);
        if ((++sp & 255u) == 0u) { if (xb_ld(&bar[XB_TMO])) break; if (sp > XB_SPIN_CAP) { atomicAdd(&bar[XB_TMO], 1u); break; } }
    }
    nloc = mine > 0u ? mine : 1u; nx = cnt > 0u ? cnt : 1u;
}

__device__ __forceinline__ void xcd_barrier(const XcdBarrier& b) {
    asm volatile("s_waitcnt vmcnt(0)" ::: "memory");
    __syncthreads();
    if (threadIdx.x == 0) {
        unsigned* bar = b.bar;
        __builtin_amdgcn_s_waitcnt(0);
        unsigned nloc = b.st[0], nx = b.st[1];
        if (nloc == 0u) { xcd_barrier_complete(bar, b.x, nloc, nx); b.st[0] = nloc; b.st[1] = nx; }
        const unsigned old = xb_add(&bar[XB_XSUB(b.x)], 1u);
        const unsigned gen = old / nloc;
        if (old + 1u == (gen + 1u) * nloc) {
            __builtin_amdgcn_fence(__ATOMIC_RELEASE, "agent");
            asm volatile("s_waitcnt vmcnt(0)" ::: "memory");
            const unsigned og = xb_add(&bar[XB_TOP], 1u);
            const unsigned tg = og / nx;
            if (og + 1u == (tg + 1u) * nx) xb_add(&bar[XB_TOPGEN], 1u);
            else XB_SPIN(xb_ld(&bar[XB_TOPGEN]) == tg, bar);
            __builtin_amdgcn_fence(__ATOMIC_ACQUIRE, "agent");
            xb_add(&bar[XB_XGEN(b.x)], 1u);
            asm volatile("s_waitcnt vmcnt(0)" ::: "memory");
        } else {
            XB_SPIN(xb_ld(&bar[XB_XGEN(b.x)]) == gen, bar);
            __builtin_amdgcn_fence(__ATOMIC_ACQUIRE, "agent");
            asm volatile("s_waitcnt vmcnt(0)" ::: "memory");
        }
    }
    __syncthreads();
}

__device__ __forceinline__ int next_unit(unsigned* ctr, unsigned char* lds) {
    volatile int* sw = (volatile int*)(lds + LDS_SCHED);
    if (threadIdx.x == 0) *sw = (int)atomicAdd(ctr, 1u);
    __syncthreads();
    const int u = *sw;
    __syncthreads();
    return u;
}

__global__ void __launch_bounds__(NTHREADS, 2) hybrid_fwd(KArgs a) {
    extern __shared__ __attribute__((aligned(16))) unsigned char lds[];
    cg::grid_group grid = cg::this_grid();
    unsigned char* ws = a.ws;
    const int lo = a.ph_lo, hi = a.ph_hi;
#ifndef PHMASK
#define PHMASK 0xfff
#endif
#define IN(k) (((PHMASK >> ((k) > 5 && (k) < 11 ? (k) - 5 : (k))) & 1) && lo <= (k) && (k) < hi)
#define SEAM(k) do { if (IN(k) && IN((k) + 1)) xcd_barrier(xbar); } while (0)
#ifndef REP_PHASE
#define REP_PHASE -1
#endif
#define REPS(j) for (int rep = 0, nrep = (REP_PHASE == (j)) ? 2 : 1; rep < nrep; ++rep, (rep < nrep ? xcd_barrier(xbar) : (void)0))
    bf16_t* HX = (bf16_t*)(ws + WS_HX); bf16_t* Pb = (bf16_t*)(ws + WS_P); bf16_t* Vt = (bf16_t*)(ws + WS_VT); bf16_t* Hb = (bf16_t*)(ws + WS_H);
    bf16_t* Yb = (bf16_t*)(ws + WS_Y); bf16_t* YF = (bf16_t*)(ws + WS_YF); float* SSQ = (float*)(ws + WS_SSQ);
    unsigned* ctl = (unsigned*)(ws + WS_CTL);

    if (threadIdx.x < 2) ((volatile LAS unsigned*)(lds + LDS_BARST))[threadIdx.x] = 0u;
    __syncthreads();
    const XcdBarrier xbar = xcd_barrier_post((unsigned*)(ws + WS_BAR), (volatile LAS unsigned*)(lds + LDS_BARST));
    if (a.ph_lo < 0) grid.sync();
    REPS(30) if (IN(0)) p0_prologue(a, lds);
    SEAM(0);
    for (int l = 0; l < 2; ++l) {
        const int pb = 1 + 5 * l;
        REPS(0) if (IN(pb)) norm_phase(a, l);
        SEAM(pb);
        REPS(1) if (IN(pb + 1)) {
            pg8::Gemm g{HX, (const bf16_t*)(ws + WS_WIN) + (size_t)l * PW * DM, MROWS, PW, DM};
            pg8::StaticOrder S; S.init(MROWS, PW, (int)gridDim.x, (int)blockIdx.x);
            pg8::EpiProj E{Pb, Vt, (const float*)(ws + WS_ROPE), (bf16_t*)(ws + WS_UFP), 0.125f * LOG2E};
            pg8::gemm_phase<pg8::EpiProj, pg8::StaticOrder, true, true>((PG8_LAS unsigned char*)lds, g, S, E);
        }
        SEAM(pb + 1);
        for (int rep = 0, nrep = (REP_PHASE >= 20 && REP_PHASE < 30) ? 2 : 1; rep < nrep; ++rep, (rep < nrep ? xcd_barrier(xbar) : (void)0)) if (IN(pb + 2)) {
            const int nAttn = (l == 0) ? 1056 : 1024, nCtxF = (l == 0) ? 16 : 0, nF1 = 256, nConv = ((l == 0) ? MROWS : NTOK) / 64;
            const int e0 = nF1, e1 = e0 + nCtxF, e2 = e1 + nAttn, e3 = e2 + nConv;
            for (;;) {
                const int u = next_unit(ctl + 2 * l + 8 * rep, lds);
                if (u >= e3) break;
                if (rep == 1) { const int ty = u < e0 ? 1 : u < e1 ? 3 : u < e2 ? 0 : 2; if (REP_PHASE == 25 ? (ty == 0) : (ty != REP_PHASE - 20)) continue; }
                if (u >= e1 && u < e2) attn_unit(u - e1, Pb, Vt, Hb, a.sink + 8 * l, lds);
                else if (u >= e0 && u < e1) { const int v = u - e0, b = v >> 2, kb = v & 3;
                    dftf_unit<256>(Pb + (size_t)(NTOK + b * CTXL) * PW + C_UF, 256, PW, 0, (const bf16_t*)(ws + WS_T256R) + (size_t)(64 * kb) * 256, (const bf16_t*)(ws + WS_T256I) + (size_t)(64 * kb) * 256,
                                   (const bf16_t*)(ws + WS_GT) + (size_t)l * 4 * 64 * 128, Pb, Hb, (size_t)(NTOK + b * CTXL + 64 * kb), 1, 5.656854249492381f, lds); }
                else {
                    const int tid = opaque_tid(), lane = tid & 63, wave = __builtin_amdgcn_readfirstlane(tid >> 6);
                    if (u < e0) { fft1_tables(ws, lds + 65536, tid); __syncthreads(); fft1_wave(u * 8 + wave, (const bf16_t*)(ws + WS_UFP), YF, ws, lds + wave * 8192, lds + 65536, lane); }
                    else conv_wave((u - e2) * 8 + wave, Pb, Hb, a.conv_w + l * 768, a.conv_b + l * 256, lane);
                }
            }
        }
        SEAM(pb + 2);
        REPS(3) if (IN(pb + 3)) {
            const bool gemmwg = (l == 0 && blockIdx.x < 16);
            if (gemmwg) {
                pg8::Gemm g{Hb + (size_t)NTOK * DM, (const bf16_t*)(ws + WS_WOUT) + (size_t)l * DM * DM, NCTX, DM, DM};
                pg8::StaticOrder S; S.init(NCTX, DM, 16, (int)blockIdx.x);
                pg8::EpiY E{Yb + (size_t)NTOK * DM, SSQ + (size_t)NTOK * 16};
                pg8::gemm_phase<pg8::EpiY, pg8::StaticOrder, true, true>((PG8_LAS unsigned char*)lds, g, S, E);
            } else {
                const int tid = opaque_tid(), lane = tid & 63, wave = __builtin_amdgcn_readfirstlane(tid >> 6);
                const int nb0 = (l == 0) ? 16 : 0;
                const int gw = ((int)blockIdx.x - nb0) + wave * ((int)gridDim.x - nb0), NGW = ((int)gridDim.x - nb0) * 8;
                unsigned char* lds_w = lds + wave * 16384;
                for (int t = gw; t < 2048; t += NGW) fft3_wave(t, YF, (const bf16_t*)(ws + WS_GT) + (size_t)l * 4 * 64 * 128, Pb, Hb, ws, lds_w, lane);
            }
            __syncthreads();
        }
        SEAM(pb + 3);
        REPS(4) if (IN(pb + 4)) {
            pg8::Gemm g{Hb, (const bf16_t*)(ws + WS_WOUT) + (size_t)l * DM * DM, NTOK, DM, DM};
            pg8::StaticOrder S; S.init(NTOK, DM, (int)gridDim.x, (int)blockIdx.x);
            pg8::EpiY E{l == 0 ? Yb : HX, l == 0 ? SSQ : (float*)(ws + WS_SSQ1)};
            pg8::gemm_phase<pg8::EpiY, pg8::StaticOrder, true, true>((PG8_LAS unsigned char*)lds, g, S, E);
        }
        SEAM(pb + 4);
    }
#if REP_PHASE == 9
    for (int i = 0; i < 10; ++i) xcd_barrier(xbar);
#endif
    if (IN(11)) norm_phase(a, 2);
#undef IN
#undef SEAM
}

#ifndef MK_MULTI
#define MK_MULTI 0
#endif
extern "C" void kernel_launch(void* const* d_in, const int* in_sizes, int n_in, void* d_out, int out_size, void* d_ws, size_t ws_size, hipStream_t stream) {
    static int grid = 0;
    if (grid == 0) {
        if (n_in != 14 || ws_size < WS_END) { fprintf(stderr, "kernel_launch: unexpected n_in %d or ws_size %zu (need %zu)\n", n_in, ws_size, (size_t)WS_END); grid = -1; return; }
        int dev = 0, cus = 0, per_cu = 0;
        hipGetDevice(&dev); hipDeviceGetAttribute(&cus, hipDeviceAttributeMultiprocessorCount, dev);
        if (hipFuncSetAttribute((const void*)hybrid_fwd, hipFuncAttributeMaxDynamicSharedMemorySize, LDS_BYTES) != hipSuccess) { fprintf(stderr, "kernel_launch: hipFuncSetAttribute failed\n"); grid = -1; return; }
        if (hipOccupancyMaxActiveBlocksPerMultiprocessor(&per_cu, (const void*)hybrid_fwd, NTHREADS, LDS_BYTES) != hipSuccess || per_cu < 1) { fprintf(stderr, "kernel_launch: occupancy query gave %d\n", per_cu); per_cu = 1; }
        (void)hipGetLastError();
        grid = cus * 1;
        fprintf(stderr, "kernel_launch: grid %d (cus %d, per_cu %d)\n", grid, cus, per_cu);
    }
    if (grid < 0) return;
    if (hipMemsetAsync((char*)d_ws + WS_CTL, 0, WS_ZERO_BYTES, stream) != hipSuccess) { fprintf(stderr, "kernel_launch: hipMemsetAsync failed\n"); return; }
    KArgs a{};
    a.x = (const float*)d_in[0]; a.c = (const float*)d_in[1]; a.ctx = (const float*)d_in[2]; a.c_ctx = (const float*)d_in[3]; a.w_mod = (const float*)d_in[4]; a.b_mod = (const float*)d_in[5];
    a.g_pre = (const float*)d_in[6]; a.g_post = (const float*)d_in[7]; a.w_in = (const float*)d_in[8]; a.w_out = (const float*)d_in[9]; a.sink = (const float*)d_in[10]; a.w_f = (const float*)d_in[11];
    a.conv_w = (const float*)d_in[12]; a.conv_b = (const float*)d_in[13];
    a.out = (float*)d_out; a.ws = (unsigned char*)d_ws;
#if MK_MULTI
    for (int ph = 0; ph < 12; ++ph) { a.ph_lo = ph; a.ph_hi = ph + 1; hipLaunchKernelGGL(hybrid_fwd, dim3(grid), dim3(NTHREADS), LDS_BYTES, stream, a); }
#else
    a.ph_lo = 0; a.ph_hi = 12;
    void* args[] = {&a};
    hipError_t e = hipLaunchCooperativeKernel((const void*)hybrid_fwd, dim3(grid), dim3(NTHREADS), args, LDS_BYTES, stream);
    if (e != hipSuccess) fprintf(stderr, "kernel_launch: cooperative launch failed: %s (grid %d)\n", hipGetErrorString(e), grid);
#endif
}
```

```cpp
#include <hip/hip_runtime.h>
#include <hip/hip_cooperative_groups.h>
#include <cstdio>
#include <cstdint>
namespace cg = cooperative_groups;
namespace pg8 {
#define PG8_LAS __attribute__((address_space(3)))
typedef unsigned short bf16_t;
typedef short bf16x8 __attribute__((ext_vector_type(8)));
typedef float f32x4 __attribute__((ext_vector_type(4)));
typedef unsigned u32x4 __attribute__((ext_vector_type(4)));
constexpr int BM = 256, BK = 64, HALF = 128, HTB = HALF * BK * 2  , STAGE_BYTES = 8 * HTB, NXCD = 8, WGM = 8;

__host__ __device__ __forceinline__ int lds_byte(int r, int c) { const int st = (r >> 4) * 2 + (c >> 5), rr = r & 15, cc = c & 31, ob = rr * 64 + cc * 2; return st * 1024 + (ob ^ (((ob >> 9) & 1) << 5)); }
__host__ __device__ __forceinline__ void stage_rc(int b, int& R, int& C) { const int st = b / 1024, sb = b % 1024, swz = sb ^ (((sb >> 9) & 1) << 5); R = (st >> 1) * 16 + swz / 64; C = (st & 1) * 32 + (swz % 64) / 2; }
__host__ __device__ __forceinline__ int perm32(int rho) { const int n = rho >> 4, i = rho & 15; return 8 * (i >> 2) + 4 * n + (i & 3); }

struct Unit { int pm, pn; };
struct Gemm { const bf16_t* A; const bf16_t* Bt; int M, N, K; };

struct StaticOrder {
    int nM, nN, nwg, G, c;
    __host__ __device__ void init(int M, int N, int G_, int c_) { nM = M / BM; nN = N / BM; nwg = nM * nN; G = G_; c = c_; }
    __host__ __device__ bool next(int i, Unit& u) const {
        const long L = (long)i * G + c; if (L >= nwg) return false;
        int wgid = (int)L; { const int q = nwg / NXCD, r = nwg % NXCD, xcd = wgid % NXCD, off = wgid / NXCD; wgid = (xcd < r ? xcd * (q + 1) : r * (q + 1) + (xcd - r) * q) + off; }
        const int nig = WGM * nN, gid = wgid / nig, fm = gid * WGM, gsz = (nM - fm) < WGM ? (nM - fm) : WGM;
        u.pm = fm + ((wgid % nig) % gsz); u.pn = (wgid % nig) / gsz; return true;
    }
    __device__ __forceinline__ void a_ready(const Unit&) const {}
    __device__ __forceinline__ void done(const Unit&) const {}
};

__device__ __forceinline__ unsigned cvt_pk_bf16(float lo, float hi) { unsigned r; asm volatile("v_cvt_pk_bf16_f32 %0, %1, %2" : "=v"(r) : "v"(lo), "v"(hi)); return r; }
typedef unsigned u32x2 __attribute__((ext_vector_type(2)));
__device__ __forceinline__ int swap23(int t) { return (t & ~12) | ((t & 4) << 1) | ((t & 8) >> 1); }
struct EpiProj {
    static constexpr bool PERM = true, AFTER_DRAIN = false;
    bf16_t* P; bf16_t* Vt; const float* rope; bf16_t* UFP; float qscale;
    __device__ __forceinline__ void operator()(const f32x4 (&acc)[2][2][4][2], const Unit& u, int wr, int wc, int fr, int fq) const {
        const int row0 = u.pm * BM + wr * 64 + fr;
        const int pn = u.pn;
        const bool ctxrow = u.pm >= 128;
        f32x4 CS[2][4], SN[2][4];
        if (pn <= 2) {
#pragma unroll
            for (int ai = 0; ai < 2; ++ai)
#pragma unroll
                for (int m = 0; m < 4; ++m) {
                    CS[ai][m] = (f32x4){1.f, 1.f, 1.f, 1.f}; SN[ai][m] = (f32x4){0.f, 0.f, 0.f, 0.f};
                    if (!ctxrow) { const int t = (row0 + ai * HALF + m * 16) & 8191; const int pos = (wc & 1) ? (t & 63) : (t >> 6);
                        CS[ai][m] = *(const f32x4*)(rope + pos * 32 + 4 * fq); SN[ai][m] = *(const f32x4*)(rope + pos * 32 + 16 + 4 * fq); }
                }
            __builtin_amdgcn_sched_barrier(0);
        }
#pragma unroll
        for (int ai = 0; ai < 2; ++ai)
#pragma unroll
            for (int m = 0; m < 4; ++m) {
                const int row = row0 + ai * HALF + m * 16;
                bf16_t* rowp = P + (size_t)row * 2816 + pn * BM + wc * 32 + 8 * fq;
                if (pn == 5 && !ctxrow) { const int t = row & 8191; rowp = UFP + ((size_t)(((row >> 13) * 64 + (t & 63)) * 128 + (t >> 6))) * 256 + wc * 32 + 8 * fq; }
                if (pn > 2) {
#pragma unroll
                    for (int bj = 0; bj < 2; ++bj) { const f32x4 v0 = acc[ai][bj][m][0], v1 = acc[ai][bj][m][1];
                        u32x4 w; w.x = cvt_pk_bf16(v0[0], v0[1]); w.y = cvt_pk_bf16(v0[2], v0[3]); w.z = cvt_pk_bf16(v1[0], v1[1]); w.w = cvt_pk_bf16(v1[2], v1[3]);
                        *(u32x4*)(rowp + bj * HALF) = w; }
                } else {
                    const f32x4 cs = CS[ai][m], sn = SN[ai][m];
#pragma unroll
                    for (int bj = 0; bj < 2; ++bj) {
                        f32x4 v0 = acc[ai][bj][m][0], v1 = acc[ai][bj][m][1];
                        if (pn == 2 && bj == 1) {
                            u32x4 w; w.x = cvt_pk_bf16(v0[0], v0[1]); w.y = cvt_pk_bf16(v0[2], v0[3]); w.z = cvt_pk_bf16(v1[0], v1[1]); w.w = cvt_pk_bf16(v1[2], v1[3]);
                            *(u32x4*)(rowp + bj * HALF) = w;
                        } else {
                            const f32x4 r0 = v0 * cs - v1 * sn, r1 = v0 * sn + v1 * cs;
                            v0 = r0; v1 = r1;
                            if (pn < 2) { v0 = v0 * qscale; v1 = v1 * qscale; }
                            u32x4 w; w.x = cvt_pk_bf16(v0[0], v0[1]); w.y = cvt_pk_bf16(v0[2], v0[3]); w.z = cvt_pk_bf16(v1[0], v1[1]); w.w = cvt_pk_bf16(v1[2], v1[3]);
                            *(u32x4*)(rowp + bj * HALF) = w;
                        }
                    }
                }
            }
    }
};
struct EpiY {
    static constexpr bool PERM = true, AFTER_DRAIN = false;
    bf16_t* Y; float* ssq;
    __device__ __forceinline__ void operator()(const f32x4 (&acc)[2][2][4][2], const Unit& u, int wr, int wc, int fr, int fq) const {
        const int row0 = u.pm * BM + wr * 64 + fr;
#pragma unroll
        for (int ai = 0; ai < 2; ++ai)
#pragma unroll
            for (int m = 0; m < 4; ++m) {
                const int row = row0 + ai * HALF + m * 16;
                bf16_t* rowp = Y + (size_t)row * 1024 + u.pn * BM + wc * 32 + 8 * fq;
                float s = 0.f;
#pragma unroll
                for (int bj = 0; bj < 2; ++bj) { const f32x4 v0 = acc[ai][bj][m][0], v1 = acc[ai][bj][m][1];
                    s += (v0[0] * v0[0] + v0[1] * v0[1]) + (v0[2] * v0[2] + v0[3] * v0[3]) + (v1[0] * v1[0] + v1[1] * v1[1]) + (v1[2] * v1[2] + v1[3] * v1[3]);
                    u32x4 w; w.x = cvt_pk_bf16(v0[0], v0[1]); w.y = cvt_pk_bf16(v0[2], v0[3]); w.z = cvt_pk_bf16(v1[0], v1[1]); w.w = cvt_pk_bf16(v1[2], v1[3]);
                    *(u32x4*)(rowp + bj * HALF) = w; }
                s += __shfl_xor(s, 16); s += __shfl_xor(s, 32);
                if (fq == 0) ssq[(size_t)row * 16 + u.pn * 4 + wc] = s;
            }
    }
};
template <class Epi, class Sched, bool ALIGN_EPI = false, bool SP2 = false>
__device__ __forceinline__ void gemm_phase(PG8_LAS unsigned char* lds, const Gemm g, const Sched& S, const Epi& E) {
    int tid_ = threadIdx.x; asm volatile("" : "+v"(tid_));
    const int tid = tid_, wid = __builtin_amdgcn_readfirstlane(tid >> 6), lane = tid & 63, wr = wid >> 2, wc = wid & 3, fr = lane & 15, fq = lane >> 4;
    const int K = g.K, nt = K / BK;
    unsigned voffA[2], voffB[2];
#pragma unroll
    for (int i = 0; i < 2; ++i) { int R, C; stage_rc(tid * 16 + i * 8192, R, C); const int Rb = Epi::PERM ? ((R & ~31) + perm32(R & 31)) : R;
        voffA[i] = (unsigned)(R * K + C) * 2u; voffB[i] = (unsigned)(Rb * K + C) * 2u; }
    const size_t kstep = (size_t)(BK * 2);
    const size_t hstep = (size_t)HALF * K * 2;
    const size_t tstep = 2 * hstep;
    const unsigned ldsw = (unsigned)wid * 1024u;
    const int aoff = lds_byte(wr * 64 + fr, fq * 8), boff = lds_byte(wc * 32 + fr, fq * 8);
#define PG8_SA(b, h) (((b) * 2 + (h)) * HTB)
#define PG8_SB(b, h) ((4 + (b) * 2 + (h)) * HTB)
#define PG8_STAGE(bufoff, gbase, voff) do { _Pragma("unroll") for (int _i = 0; _i < 2; ++_i) \
        __builtin_amdgcn_global_load_lds((const unsigned*)((const char*)(gbase) + (voff)[_i]), (PG8_LAS unsigned*)(lds + (bufoff) + ldsw + _i * 8192), 16, 0, 0); } while (0)
#define PG8_LDA(dst, b, h) do { _Pragma("unroll") for (int m = 0; m < 4; ++m) _Pragma("unroll") for (int k = 0; k < 2; ++k) dst[m][k] = *(const PG8_LAS bf16x8*)(lds + PG8_SA(b, h) + aoff + m * 2048 + k * 1024); } while (0)
#define PG8_LDB(dst, b, h) do { _Pragma("unroll") for (int n = 0; n < 2; ++n) _Pragma("unroll") for (int k = 0; k < 2; ++k) dst[n][k] = *(const PG8_LAS bf16x8*)(lds + PG8_SB(b, h) + boff + n * 2048 + k * 1024); } while (0)
#define PG8_MMA(ai, bj, At, Bt) do { __builtin_amdgcn_s_setprio(1); _Pragma("unroll") for (int m = 0; m < 4; ++m) _Pragma("unroll") for (int n = 0; n < 2; ++n) _Pragma("unroll") for (int k = 0; k < 2; ++k) \
        acc[ai][bj][m][n] = __builtin_amdgcn_mfma_f32_16x16x32_bf16(Bt[n][k], At[m][k], acc[ai][bj][m][n], 0, 0, 0); __builtin_amdgcn_s_setprio(0); } while (0)
#define PG8_WAIT_V(n) asm volatile("s_waitcnt vmcnt(" #n ")" ::: "memory")
#define PG8_WAIT_L(n) asm volatile("s_waitcnt lgkmcnt(" #n ")" ::: "memory")
#define PG8_BAR __builtin_amdgcn_s_barrier()
#define PG8_SCHED __builtin_amdgcn_sched_barrier(0)
    Unit cur, nxt; int ui = 0;
    if (!S.next(0, cur)) return;
    f32x4 acc[2][2][4][2];
#pragma unroll
    for (int a = 0; a < 2; ++a)
#pragma unroll
        for (int b = 0; b < 2; ++b)
#pragma unroll
            for (int m = 0; m < 4; ++m)
#pragma unroll
                for (int n = 0; n < 2; ++n) acc[a][b][m][n] = (f32x4){0.f, 0.f, 0.f, 0.f};
    bf16x8 At[4][2], B0[2][2], B1[2][2];
    const char* cA = (const char*)g.A + (size_t)cur.pm * tstep; const char* cB = (const char*)g.Bt + (size_t)cur.pn * tstep;
    S.a_ready(cur);
    if constexpr (SP2) {
        PG8_STAGE(PG8_SB(0, 0), cB, voffB); PG8_STAGE(PG8_SB(0, 1), cB + hstep, voffB); PG8_STAGE(PG8_SA(0, 0), cA, voffA); PG8_STAGE(PG8_SA(0, 1), cA + hstep, voffA);
        if (wr == 1) PG8_BAR;
        PG8_WAIT_V(2); PG8_BAR;
        PG8_STAGE(PG8_SB(1, 0), cB + kstep, voffB); PG8_STAGE(PG8_SA(1, 0), cA + kstep, voffA); PG8_STAGE(PG8_SB(1, 1), cB + hstep + kstep, voffB);
        PG8_WAIT_V(6); PG8_BAR;
    } else {
        PG8_STAGE(PG8_SB(0, 0), cB, voffB); PG8_STAGE(PG8_SA(0, 0), cA, voffA); PG8_STAGE(PG8_SB(0, 1), cB + hstep, voffB); PG8_STAGE(PG8_SA(0, 1), cA + hstep, voffA);
        if (wr == 1) PG8_BAR;
        PG8_WAIT_V(4); PG8_BAR;
        PG8_STAGE(PG8_SB(1, 0), cB + kstep, voffB); PG8_STAGE(PG8_SA(1, 0), cA + kstep, voffA); PG8_STAGE(PG8_SB(1, 1), cB + hstep + kstep, voffB);
        PG8_WAIT_V(6); PG8_BAR;
    }
    for (;;) {
        const bool has_next = S.next(ui + 1, nxt);
        const char* nA = has_next ? (const char*)g.A + (size_t)nxt.pm * tstep : cA; const char* nB = has_next ? (const char*)g.Bt + (size_t)nxt.pn * tstep : cB;
        for (int t = 0; t < nt; t += 2) {
            const bool last = (t == nt - 2);
            const char* a1 = cA + (size_t)(t + 1) * kstep;
            const char* a2 = last ? nA : cA + (size_t)(t + 2) * kstep; const char* b2 = last ? nB : cB + (size_t)(t + 2) * kstep;
            const char* a3 = a2 + kstep; const char* b3 = b2 + kstep;
            if (last && has_next) S.a_ready(nxt);
            if constexpr (SP2) {
            PG8_LDB(B0, 0, 0); PG8_LDB(B1, 0, 1); PG8_SCHED; PG8_LDA(At, 0, 0); PG8_STAGE(PG8_SA(1, 1), a1 + hstep, voffA);
            PG8_WAIT_V(8); PG8_WAIT_L(0); PG8_BAR; PG8_MMA(0, 0, At, B0); PG8_MMA(0, 1, At, B1); PG8_BAR; PG8_SCHED;
            PG8_LDA(At, 0, 1); PG8_STAGE(PG8_SB(0, 0), b2, voffB); PG8_STAGE(PG8_SB(0, 1), b2 + hstep, voffB); PG8_STAGE(PG8_SA(0, 0), a2, voffA);
            PG8_WAIT_V(8); PG8_WAIT_L(0); PG8_BAR; PG8_MMA(1, 0, At, B0); PG8_MMA(1, 1, At, B1); PG8_BAR; PG8_SCHED;
            PG8_LDB(B0, 1, 0); PG8_LDB(B1, 1, 1); PG8_SCHED; PG8_LDA(At, 1, 0); PG8_STAGE(PG8_SA(0, 1), a2 + hstep, voffA);
            PG8_WAIT_V(8); PG8_WAIT_L(0); PG8_BAR; PG8_MMA(0, 0, At, B0); PG8_MMA(0, 1, At, B1); PG8_BAR; PG8_SCHED;
            PG8_LDA(At, 1, 1); PG8_STAGE(PG8_SB(1, 0), b3, voffB); PG8_STAGE(PG8_SB(1, 1), b3 + hstep, voffB); PG8_STAGE(PG8_SA(1, 0), a3, voffA);
            PG8_WAIT_V(8); PG8_WAIT_L(0); PG8_BAR; PG8_MMA(1, 0, At, B0); PG8_MMA(1, 1, At, B1); PG8_BAR; PG8_SCHED;
            } else {
            PG8_LDB(B0, 0, 0); PG8_SCHED; PG8_LDA(At, 0, 0); PG8_STAGE(PG8_SA(1, 1), a1 + hstep, voffA);
            PG8_WAIT_L(8); PG8_BAR; PG8_WAIT_L(0); PG8_MMA(0, 0, At, B0); PG8_BAR; PG8_SCHED;
            PG8_LDB(B1, 0, 1); PG8_STAGE(PG8_SB(0, 0), b2, voffB);
            PG8_BAR; PG8_WAIT_L(0); PG8_MMA(0, 1, At, B1); PG8_BAR;
            PG8_LDA(At, 0, 1); PG8_STAGE(PG8_SA(0, 0), a2, voffA);
            PG8_BAR; PG8_WAIT_L(0); PG8_MMA(1, 0, At, B0); PG8_BAR; PG8_SCHED;
            PG8_STAGE(PG8_SB(0, 1), b2 + hstep, voffB);
            PG8_WAIT_V(6); PG8_BAR; PG8_MMA(1, 1, At, B1); PG8_BAR;
            PG8_LDB(B0, 1, 0); PG8_SCHED; PG8_LDA(At, 1, 0); PG8_STAGE(PG8_SA(0, 1), a2 + hstep, voffA);
            PG8_WAIT_L(8); PG8_BAR; PG8_WAIT_L(0); PG8_MMA(0, 0, At, B0); PG8_BAR; PG8_SCHED;
            PG8_LDB(B1, 1, 1); PG8_STAGE(PG8_SB(1, 0), b3, voffB);
            PG8_BAR; PG8_WAIT_L(0); PG8_MMA(0, 1, At, B1); PG8_BAR;
            PG8_LDA(At, 1, 1); PG8_STAGE(PG8_SA(1, 0), a3, voffA);
            PG8_BAR; PG8_WAIT_L(0); PG8_MMA(1, 0, At, B0); PG8_BAR; PG8_SCHED;
            PG8_STAGE(PG8_SB(1, 1), b3 + hstep, voffB);
            PG8_WAIT_V(6); PG8_BAR; PG8_MMA(1, 1, At, B1); PG8_BAR;
            }
        }
        if constexpr (ALIGN_EPI) { if (wr == 0) PG8_BAR; }
        if constexpr (!Epi::AFTER_DRAIN) { E(acc, cur, wr, wc, fr, fq); S.done(cur); }
        if (!has_next) break;
#pragma unroll
        for (int a = 0; a < 2; ++a)
#pragma unroll
            for (int b = 0; b < 2; ++b)
#pragma unroll
                for (int m = 0; m < 4; ++m)
#pragma unroll
                    for (int n = 0; n < 2; ++n) acc[a][b][m][n] = (f32x4){0.f, 0.f, 0.f, 0.f};
        cur = nxt; cA = nA; cB = nB; ++ui;
        if constexpr (ALIGN_EPI) { if (wr == 1) PG8_BAR; }
    }
    PG8_WAIT_V(0);
    if constexpr (!ALIGN_EPI) { if (wr == 0) PG8_BAR; }
    PG8_BAR;
    if constexpr (Epi::AFTER_DRAIN) { E.fused(acc, cur, wr, wc, fr, fq, lds, wid, lane); S.done(cur); }
#undef PG8_SA
#undef PG8_SB
#undef PG8_STAGE
#undef PG8_LDA
#undef PG8_LDB
#undef PG8_MMA
#undef PG8_WAIT_V
#undef PG8_WAIT_L
#undef PG8_BAR
#undef PG8_SCHED
}
}

typedef unsigned short bf16_t;
typedef short bf16x8 __attribute__((ext_vector_type(8)));
typedef float f32x4 __attribute__((ext_vector_type(4)));
typedef float f32x16 __attribute__((ext_vector_type(16)));
typedef unsigned u32x4 __attribute__((ext_vector_type(4)));
typedef unsigned u32x2 __attribute__((ext_vector_type(2)));
#define LAS __attribute__((address_space(3)))
__device__ __forceinline__ int opaque_tid() { int t = threadIdx.x; asm volatile("" : "+v"(t)); return t; }

constexpr int DM = 1024, NBATCH = 4, SEQ = 8192, NTOK = NBATCH * SEQ, CTXL = 256, NCTX = NBATCH * CTXL, MROWS = NTOK + NCTX;
constexpr int PW = 2816;
constexpr int C_Q = 0, C_K = 512, C_V = 640, C_GA = 768, C_UF = 1280, C_GF = 1536, C_ZC = 1792, C_BC = 2048, C_CC = 2304, C_GC = 2560;
constexpr int VT_PITCH = SEQ + CTXL;
constexpr float NORM_EPS = 1e-6f;
constexpr float LOG2E = 1.4426950408889634f;

constexpr size_t KiB = 1024, MiB = 1u << 20;
constexpr size_t WS_CTL = 0;
constexpr size_t WS_BAR = 16 * KiB;
constexpr size_t WS_ZERO_BYTES = 32 * KiB;
constexpr size_t WS_MOD = 64 * KiB;
constexpr size_t WS_ROPE = 256 * KiB;
constexpr size_t WS_TW = 320 * KiB;
constexpr size_t WS_T1R = 384 * KiB, WS_T1I = 416 * KiB;
constexpr size_t WS_T3R = 448 * KiB, WS_T3I = 464 * KiB;
constexpr size_t WS_T256R = 512 * KiB, WS_T256I = 640 * KiB;
constexpr size_t WS_GT = 768 * KiB;
constexpr size_t WS_SSQ = 1 * MiB;
constexpr size_t WS_WIN = 4 * MiB;
constexpr size_t WS_WOUT = 16 * MiB;
constexpr size_t WS_SSQ1 = 24 * MiB;
constexpr size_t WS_MODP = 28 * MiB;
constexpr size_t WS_HX = 32 * MiB;
constexpr size_t WS_P = 112 * MiB;
constexpr size_t WS_VT = 304 * MiB;
constexpr size_t WS_H = 320 * MiB;
constexpr size_t WS_Y = 392 * MiB;
constexpr size_t WS_YF = 464 * MiB;
constexpr size_t WS_CTX1 = 100 * MiB;
constexpr size_t WS_UFP = 496 * MiB;
constexpr size_t WS_END = 512 * MiB;
static_assert(WS_BAR + 3456 * 4 <= WS_ZERO_BYTES && WS_MODP + (size_t)2 * 8 * 5 * 3072 * 4 <= WS_HX && WS_SSQ + (size_t)MROWS * 16 * 4 <= WS_WIN && WS_WIN + (size_t)2 * PW * DM * 2 <= WS_WOUT && WS_HX + (size_t)MROWS * DM * 2 <= WS_P && WS_P + (size_t)MROWS * PW * 2 <= WS_VT &&
              WS_VT + (size_t)8 * 64 * VT_PITCH * 2 <= WS_H && WS_H + (size_t)MROWS * DM * 2 <= WS_Y && WS_Y + (size_t)MROWS * DM * 2 <= WS_YF && WS_YF + (size_t)4 * 128 * 64 * 512 * 2 <= WS_UFP && WS_UFP + (size_t)NTOK * 256 * 2 <= WS_END && WS_HX + (size_t)MROWS * DM * 2 <= WS_CTX1 && WS_CTX1 + (size_t)NCTX * DM * 4 <= WS_P, "ws map");

constexpr int LDS_BYTES = 147456;
constexpr int LDS_SCHED = LDS_BYTES - 64;
constexpr int LDS_BARST = LDS_BYTES - 32;
constexpr int NTHREADS = 512;

__device__ __forceinline__ float bf2f(unsigned h) { return __uint_as_float(h << 16); }
__device__ __forceinline__ unsigned pkbf(float lo, float hi) { unsigned r; asm volatile("v_cvt_pk_bf16_f32 %0, %1, %2" : "=v"(r) : "v"(lo), "v"(hi)); return r; }
__device__ __forceinline__ float silu_f(float x) { return x * __builtin_amdgcn_rcpf(1.f + __builtin_amdgcn_exp2f(-x * LOG2E)); }
__device__ __forceinline__ float wave_sum(float v) {
#pragma unroll
    for (int o = 1; o < 64; o <<= 1) v += __shfl_xor(v, o);
    return v;
}
__device__ __forceinline__ int swap23(int t) { return (t & ~12) | ((t & 4) << 1) | ((t & 8) >> 1); }
__device__ __forceinline__ int crow(int r, int hi) { return (r & 3) + 8 * (r >> 2) + 4 * hi; }
__device__ __forceinline__ bf16x8 pack8(const f32x16& p, int base) {
    u32x4 w; w.x = pkbf(p[base + 0], p[base + 1]); w.y = pkbf(p[base + 2], p[base + 3]); w.z = pkbf(p[base + 4], p[base + 5]); w.w = pkbf(p[base + 6], p[base + 7]);
    return __builtin_bit_cast(bf16x8, w);
}
#define MFMA32(a, b, c) __builtin_amdgcn_mfma_f32_32x32x16_bf16((a), (b), (c), 0, 0, 0)

struct KArgs {
    const float *x, *c, *ctx, *c_ctx, *w_mod, *b_mod, *g_pre, *g_post, *w_in, *w_out, *sink, *w_f, *conv_w, *conv_b;
    float* out; unsigned char* ws; int ph_lo, ph_hi;
};

__device__ __forceinline__ int prow_qk(int n) { return (n & ~31) | (8 * ((n >> 2) & 3) + 4 * ((n >> 4) & 1) + (n & 3)); }
__device__ __forceinline__ void p0_transpose_item(const float* W, int K, int N, bf16_t* WT, int nperm, float* scr, int item, int lane) {
    const int nblk = N / 32, kb = item / nblk, nb = item % nblk, k0 = 64 * kb, n0 = 32 * nb;
    { float wv[32];
#pragma unroll
      for (int i = 0; i < 32; ++i) wv[i] = W[(size_t)(k0 + 2 * i + (lane >> 5)) * N + n0 + (lane & 31)];
      __builtin_amdgcn_sched_barrier(0);
#pragma unroll
      for (int i = 0; i < 32; ++i) scr[(2 * i + (lane >> 5)) * 33 + (lane & 31)] = wv[i];
      __builtin_amdgcn_sched_barrier(0); }
    asm volatile("s_waitcnt lgkmcnt(0)" ::: "memory");
    const int c = lane & 7;
#pragma unroll
    for (int j = 0; j < 4; ++j) { const int n = (lane >> 3) + 8 * j; const float* s = scr + (8 * c) * 33 + n;
        u32x4 o; o.x = pkbf(s[0 * 33], s[1 * 33]); o.y = pkbf(s[2 * 33], s[3 * 33]); o.z = pkbf(s[4 * 33], s[5 * 33]); o.w = pkbf(s[6 * 33], s[7 * 33]);
        const int nl = n0 + n; const int np = nl < nperm ? prow_qk(nl) : nl;
        *(u32x4*)(WT + (size_t)np * K + k0 + 8 * c) = o; }
    asm volatile("s_waitcnt lgkmcnt(0)" ::: "memory");
}

__device__ __forceinline__ void p0_mod_gemv(const KArgs& a, int item, float* ldsf) {
    const int tid = opaque_tid(), lane = tid & 63, wave = tid >> 6;
    const int l = item / 96, col0 = (item % 96) * 32;
    float* s = ldsf;
    float* red = ldsf + 5 * 1024;
    for (int i = tid; i < 5 * 1024; i += NTHREADS) { const int bb = i >> 10, k = i & 1023; const float v = bb < 4 ? a.c[bb * 1024 + k] : a.c_ctx[k]; s[i] = v / (1.f + __expf(-v)); }
    __syncthreads();
    const int col = lane & 31, kh = lane >> 5;
    const float* W = a.w_mod + (size_t)l * 1024 * 3072 + (size_t)(wave * 128 + kh) * 3072 + col0 + col;
    float w[64];
#pragma unroll
    for (int i = 0; i < 64; ++i) w[i] = W[(size_t)(2 * i) * 3072];
    float acc[5] = {0.f, 0.f, 0.f, 0.f, 0.f};
#pragma unroll
    for (int i = 0; i < 64; ++i)
#pragma unroll
        for (int bb = 0; bb < 5; ++bb) acc[bb] += w[i] * s[bb * 1024 + wave * 128 + 2 * i + kh];
#pragma unroll
    for (int bb = 0; bb < 5; ++bb) red[((wave * 2 + kh) * 5 + bb) * 32 + col] = acc[bb];
    __syncthreads();
    if (tid < 160) { const int bb = tid >> 5, cc = tid & 31; float v = a.b_mod[l * 3072 + col0 + cc];
#pragma unroll
        for (int ww = 0; ww < 16; ++ww) v += red[(ww * 5 + bb) * 32 + cc];
        ((float*)(a.ws + WS_MOD))[(l * 5 + bb) * 3072 + col0 + cc] = v; }
    __syncthreads();
}

__device__ __forceinline__ void p0_prologue(const KArgs& a, unsigned char* lds) {
    const int tid = opaque_tid(), lane = tid & 63, wave = tid >> 6;
    const int G = gridDim.x, bx = blockIdx.x;
    unsigned char* ws = a.ws;
    if (bx < 192) p0_mod_gemv(a, bx, (float*)lds);
    {
        float* scr = (float*)(lds + wave * 16384);
        const int gw = bx * 8 + wave, NGW = G * 8;
        constexpr int I_IN = (DM / 64) * (PW / 32), I_OUT = (DM / 64) * (DM / 32);
        constexpr int NIT = 2 * (I_IN + I_OUT);
        for (int it = gw; it < NIT; it += NGW) {
            int r = it; const int l = r / (I_IN + I_OUT); r -= l * (I_IN + I_OUT);
            if (r < I_IN) p0_transpose_item(a.w_in + (size_t)l * DM * PW, DM, PW, (bf16_t*)(ws + WS_WIN) + (size_t)l * PW * DM, 640, scr, r, lane);
            else p0_transpose_item(a.w_out + (size_t)l * DM * DM, DM, DM, (bf16_t*)(ws + WS_WOUT) + (size_t)l * DM * DM, 0, scr, r - I_IN, lane);
        }
    }
    const int gt = bx * NTHREADS + tid, NGT = G * NTHREADS;
    for (int i = gt; i < 128 * 16; i += NGT) {
        const int pos = i >> 4, f = i & 15; const float inv = powf(10000.0f, -(float)f / 16.0f); const float ang = (float)pos * inv;
        float* rp = (float*)(ws + WS_ROPE) + pos * 32; rp[f] = cosf(ang); rp[16 + f] = sinf(ang);
    }
    for (int i = gt; i < 8192; i += NGT) { float sn, cs; sincospif((float)i * (2.0f / 8192.0f), &sn, &cs); float* t = (float*)(ws + WS_TW) + 2 * i; t[0] = cs; t[1] = sn; }
    for (int i = gt; i < 128 * 128; i += NGT) { const int k = i >> 7, n = i & 127; float sn, cs; sincospif((float)((k * n) & 127) * (2.0f / 128.0f), &sn, &cs);
        ((bf16_t*)(ws + WS_T1R))[i] = (bf16_t)(pkbf(cs, 0.f) & 0xffffu); ((bf16_t*)(ws + WS_T1I))[i] = (bf16_t)(pkbf(-sn, 0.f) & 0xffffu); }
    for (int i = gt; i < 64 * 128; i += NGT) { const int k = i >> 7, kk = i & 127, n = kk & 63; float sn, cs; sincospif((float)((k * n) & 63) * (2.0f / 64.0f), &sn, &cs);
        const float tr = kk < 64 ? cs : sn, ti = kk < 64 ? -sn : cs;
        const int fpos = ((((k >> 5) * 8 + (kk >> 4)) * 64 + ((k & 31) + 32 * ((kk >> 3) & 1))) * 8) + (kk & 7);
        ((bf16_t*)(ws + WS_T3R))[fpos] = (bf16_t)(pkbf(tr, 0.f) & 0xffffu); ((bf16_t*)(ws + WS_T3I))[fpos] = (bf16_t)(pkbf(ti, 0.f) & 0xffffu); }
    for (int i = gt; i < 256 * 256; i += NGT) { const int k = i >> 8, n = i & 255; float sn, cs; sincospif((float)((k * n) & 255) * (2.0f / 256.0f), &sn, &cs);
        ((bf16_t*)(ws + WS_T256R))[i] = (bf16_t)(pkbf(cs, 0.f) & 0xffffu); ((bf16_t*)(ws + WS_T256I))[i] = (bf16_t)(pkbf(-sn, 0.f) & 0xffffu); }
    {
        __syncthreads();
        float* trig = (float*)lds;
        if (tid < 64) { float sn, cs; sincospif((float)tid * (2.0f / 64.0f), &sn, &cs); trig[tid] = cs; trig[64 + tid] = sn; }
        __syncthreads();
        for (int i = gt; i < 2 * 4 * 64 * 128; i += NGT) {
            const int kk = i & 127, d = (i >> 7) & 63, g = (i >> 13) & 3, l = i >> 15; const int part = kk >> 6, c = swap23(kk & 63);
            const float* wf = a.w_f + ((size_t)(l * 4 + g) * 64) * 64 + d; float sacc = 0.f;
            float wfv[64];
#pragma unroll
            for (int j = 0; j < 64; ++j) wfv[j] = wf[j * 64];
            __builtin_amdgcn_sched_barrier(0);
#pragma unroll
            for (int j = 0; j < 64; ++j) sacc += trig[part * 64 + ((c * j) & 63)] * wfv[j];
            const int gpos = ((((((l * 4 + g) * 2 + (d >> 5)) * 8 + (kk >> 4)) * 64) + ((d & 31) + 32 * ((kk >> 3) & 1))) * 8) + (kk & 7);
            ((bf16_t*)(ws + WS_GT))[gpos] = (bf16_t)(pkbf(sacc * (1.0f / 724.0773439350246f), 0.f) & 0xffffu);
        }
        __syncthreads();
    }
}

__device__ __forceinline__ void norm_rows4(int mode, int lane, const float* src, float* dst, const bf16_t* y0, const float* ssq0, const bf16_t* y1, const float* ssq1, bf16_t* hx,
                                           const f32x4 (&GA0)[4], const f32x4 (&GA1)[4], const f32x4 (&GB)[4], const f32x4 (&GC)[4]) {
    f32x4 v[4][4];
#pragma unroll
    for (int rr = 0; rr < 4; ++rr)
#pragma unroll
        for (int j = 0; j < 4; ++j) v[rr][j] = *(const f32x4*)(src + (size_t)rr * DM + 4 * lane + 256 * j);
    if (mode != 0) {
        u32x2 yw[4][4], yx[4][4]; float p[4], p1[4];
#pragma unroll
        for (int rr = 0; rr < 4; ++rr) { p[rr] = ssq0[rr * 16 + (lane & 15)];
#pragma unroll
            for (int j = 0; j < 4; ++j) yw[rr][j] = *(const u32x2*)(y0 + (size_t)rr * DM + 4 * lane + 256 * j); }
        if (mode == 2) {
#pragma unroll
            for (int rr = 0; rr < 4; ++rr) { p1[rr] = ssq1[rr * 16 + (lane & 15)];
#pragma unroll
                for (int j = 0; j < 4; ++j) yx[rr][j] = *(const u32x2*)(y1 + (size_t)rr * DM + 4 * lane + 256 * j); }
        }
#pragma unroll
        for (int rr = 0; rr < 4; ++rr) {
            float q = p[rr]; q += __shfl_xor(q, 1); q += __shfl_xor(q, 2); q += __shfl_xor(q, 4); q += __shfl_xor(q, 8);
            const float rstd = 1.0f / sqrtf(q * (1.0f / DM) + NORM_EPS);
#pragma unroll
            for (int j = 0; j < 4; ++j) {
                f32x4 yy; yy[0] = bf2f(yw[rr][j].x & 0xffffu); yy[1] = bf2f(yw[rr][j].x >> 16); yy[2] = bf2f(yw[rr][j].y & 0xffffu); yy[3] = bf2f(yw[rr][j].y >> 16);
                v[rr][j] = v[rr][j] + GA0[j] * (yy * rstd);
            }
        }
        if (mode == 2) {
#pragma unroll
            for (int rr = 0; rr < 4; ++rr) {
                float q = p1[rr]; q += __shfl_xor(q, 1); q += __shfl_xor(q, 2); q += __shfl_xor(q, 4); q += __shfl_xor(q, 8);
                const float rstd = 1.0f / sqrtf(q * (1.0f / DM) + NORM_EPS);
#pragma unroll
                for (int j = 0; j < 4; ++j) {
                    f32x4 yy; yy[0] = bf2f(yx[rr][j].x & 0xffffu); yy[1] = bf2f(yx[rr][j].x >> 16); yy[2] = bf2f(yx[rr][j].y & 0xffffu); yy[3] = bf2f(yx[rr][j].y >> 16);
                    v[rr][j] = v[rr][j] + GA1[j] * (yy * rstd);
                    *(f32x4*)(dst + (size_t)rr * DM + 4 * lane + 256 * j) = v[rr][j];
                }
            }
        }
    }
    if (mode != 2) {
        float s[4];
#pragma unroll
        for (int rr = 0; rr < 4; ++rr) { float t = 0.f;
#pragma unroll
            for (int j = 0; j < 4; ++j) t += (v[rr][j][0] * v[rr][j][0] + v[rr][j][1] * v[rr][j][1]) + (v[rr][j][2] * v[rr][j][2] + v[rr][j][3] * v[rr][j][3]);
            s[rr] = t; }
#pragma unroll
        for (int o = 1; o < 64; o <<= 1) {
#pragma unroll
            for (int rr = 0; rr < 4; ++rr) s[rr] += __shfl_xor(s[rr], o); }
#pragma unroll
        for (int rr = 0; rr < 4; ++rr) {
            const float rstd = 1.0f / sqrtf(s[rr] * (1.0f / DM) + NORM_EPS);
#pragma unroll
            for (int j = 0; j < 4; ++j) {
                const f32x4 o = (v[rr][j] * rstd) * GB[j] + GC[j];
                u32x2 w; w.x = pkbf(o[0], o[1]); w.y = pkbf(o[2], o[3]);
                *(u32x2*)(hx + (size_t)rr * DM + 4 * lane + 256 * j) = w;
            }
        }
    }
}
__device__ __forceinline__ void norm_phase(const KArgs& a, int mode) {
    const int tid = opaque_tid(), lane = tid & 63, wave = tid >> 6;
    const int NGW = gridDim.x * 8;
    unsigned char* ws = a.ws;
    const float* mod = (const float*)(ws + WS_MOD);
    const int lp = (mode == 0) ? 0 : 1;
    bf16_t* HX = (bf16_t*)(ws + WS_HX); const bf16_t* Y0 = (const bf16_t*)(ws + WS_Y); const float* SSQ0 = (const float*)(ws + WS_SSQ);
    const bf16_t* Y1 = (const bf16_t*)(ws + WS_HX); const float* SSQ1 = (const float*)(ws + WS_SSQ1);
    const int gw2 = wave * (int)gridDim.x + (int)blockIdx.x;
    const int nlat = NTOK / 4;
    int curb = -1; f32x4 GA0[4], GA1[4], GB[4], GC[4];
    int base = gw2 * 4, sub = 0, itc = nlat + gw2; bool inctx = false;
    for (;;) {
        int it;
        if (!inctx) { if (base >= nlat) { inctx = true; continue; } it = base + sub; if (++sub == 4) { sub = 0; base += NGW * 4; } }
        else { if (mode == 2 || itc >= nlat + NCTX / 4) break; it = itc; itc += NGW; }
        const int r = it * 4;
        const int b = r < NTOK ? (r >> 13) : 4;
        if (b != curb) { curb = b;
            const float* mp = mod + (lp * 5 + b) * 3072; const float* m0 = mod + (0 * 5 + b) * 3072; const float* m1 = mod + (1 * 5 + b) * 3072;
#pragma unroll
            for (int j = 0; j < 4; ++j) { const int c = 4 * lane + 256 * j;
                GA0[j] = *(const f32x4*)(m0 + 2048 + c) * *(const f32x4*)(a.g_post + c);
                GA1[j] = *(const f32x4*)(m1 + 2048 + c) * *(const f32x4*)(a.g_post + DM + c);
                GB[j] = *(const f32x4*)(a.g_pre + lp * DM + c) * (*(const f32x4*)(mp + 1024 + c) + 1.0f);
                GC[j] = *(const f32x4*)(mp + c); } }
        const float* src = (r < NTOK) ? a.x + (size_t)r * DM : a.ctx + (size_t)(r - NTOK) * DM;
        norm_rows4(mode, lane, src, a.out + (size_t)r * DM, Y0 + (size_t)r * DM, SSQ0 + (size_t)r * 16, Y1 + (size_t)r * DM, SSQ1 + (size_t)r * 16, HX + (size_t)r * DM, GA0, GA1, GB, GC);
    }
}

typedef short v4i16_t __attribute__((ext_vector_type(4)));
__device__ __forceinline__ v4i16_t trrd(const unsigned char* p) { return __builtin_amdgcn_ds_read_tr16_b64_v4i16((LAS v4i16_t*)p); }
__device__ __forceinline__ bf16x8 cat8(v4i16_t lo, v4i16_t hi) { return (bf16x8){lo[0], lo[1], lo[2], lo[3], hi[0], hi[1], hi[2], hi[3]}; }
__device__ __forceinline__ void attn_unit(int u, const bf16_t* P, const bf16_t* Vt, bf16_t* H, const float* sink, unsigned char* lds) {
    const int tid = opaque_tid(), lane = tid & 63, wave = __builtin_amdgcn_readfirstlane(tid >> 6), r32 = lane & 31, hi = lane >> 5;
    const bool isctx = u >= 1024;
    int b, kvh, qb;
    if (isctx) { const int v = u - 1024; b = v >> 3; kvh = (v >> 2) & 1; qb = v & 3; } else { b = u >> 8; kvh = (u >> 7) & 1; qb = u & 127; }
    const int head = kvh * 4 + (wave >> 1);
    const int qtok = qb * 64 + (wave & 1) * 32 + r32;
    const size_t qrow = isctx ? (size_t)(NTOK + b * CTXL + qtok) : (size_t)(b * SEQ + qtok);
    const float sinkv = sink[head];
    unsigned char* qscr = lds + 45056 + wave * 4608;
    u32x4 qld[4];
#pragma unroll
    for (int i4 = 0; i4 < 4; ++i4) qld[i4] = *(const u32x4*)(P + (qrow - r32 + i4 * 8 + (lane >> 3)) * PW + C_Q + head * 64 + (lane & 7) * 8);
    int jlo = 0, jhi = -1;
    if (!isctx) { jlo = qb < 2 ? 2 - qb : 0; jhi = (129 - qb) < 4 ? (129 - qb) : 4; }
    const int ntiles = 4 + (jhi - jlo + 1);
    const int srow = tid >> 3, sch = tid & 7;
    const bf16_t* Kc = P + (size_t)(NTOK + b * CTXL + srow) * PW + C_K + kvh * 64 + sch * 8;
    const bf16_t* Kl = P + (size_t)(b * SEQ + srow) * PW + C_K + kvh * 64 + sch * 8;
    unsigned char* Ks = lds; unsigned char* Vs = lds + 2 * 9216;
    const int vsoff = srow * 192 + sch * 16;
    const int soff = srow * 144 + sch * 16;
    u32x4 kreg, vreg, kreg2, vreg2;
#define ATT_GLOAD(KR, VR, ti_) do { const int t_ = (ti_); \
        if (t_ < 4) { KR = *(const u32x4*)(Kc + (size_t)(64 * t_) * PW); VR = *(const u32x4*)(Kc + (size_t)(64 * t_) * PW + 128); } \
        else { const int kbase_ = qb * 64 - 128 + 64 * (jlo + t_ - 4); KR = *(const u32x4*)(Kl + (size_t)kbase_ * PW); VR = *(const u32x4*)(Kl + (size_t)kbase_ * PW + 128); } } while (0)
    const size_t qrow0 = qrow - r32;
    u32x4 gaw[4];
#pragma unroll
    for (int i4 = 0; i4 < 4; ++i4) gaw[i4] = *(const u32x4*)(P + (qrow0 + i4 * 8 + (lane >> 3)) * PW + C_GA + head * 64 + (lane & 7) * 8);
    ATT_GLOAD(kreg2, vreg2, 0);
    ATT_GLOAD(kreg, vreg, 1);
#pragma unroll
    for (int i4 = 0; i4 < 4; ++i4) *(u32x4*)(qscr + (i4 * 8 + (lane >> 3)) * 144 + (lane & 7) * 16) = qld[i4];
    *(u32x4*)(Ks + soff) = kreg2; *(u32x4*)(Vs + vsoff) = vreg2;
    __syncthreads();
    bf16x8 qf[4];
#pragma unroll
    for (int d0 = 0; d0 < 4; ++d0) qf[d0] = *(const bf16x8*)(qscr + r32 * 144 + (2 * d0 + hi) * 16);
    const float sink2 = sinkv * LOG2E;
    float mref = sink2, lsum = 0.f;
    f32x16 oT[2]; oT[0] = f32x16{}; oT[1] = f32x16{};
    const int qpos = qtok;
    for (int ti = 0; ti < ntiles; ++ti) {
        const int buf = ti & 1;
        if (ti + 2 < ntiles) ATT_GLOAD(kreg2, vreg2, ti + 2);
        const unsigned char* kb = Ks + buf * 9216 + r32 * 144 + hi * 16;
        const unsigned char* vb = Vs + buf * 12288 + (4 * hi + ((lane & 15) >> 2)) * 192 + (16 * ((lane >> 4) & 1) + 4 * (lane & 3)) * 2;
        bf16x8 kf[8];
#pragma unroll
        for (int d0 = 0; d0 < 4; ++d0) { kf[2 * d0] = *(const bf16x8*)(kb + d0 * 32); kf[2 * d0 + 1] = *(const bf16x8*)(kb + 32 * 144 + d0 * 32); }
        f32x16 p0, p1;
#pragma unroll
        for (int r = 0; r < 16; ++r) { p0[r] = -mref; p1[r] = -mref; }
        __builtin_amdgcn_sched_barrier(0);
#pragma unroll
        for (int d0 = 0; d0 < 4; ++d0) { p0 = MFMA32(kf[2 * d0], qf[d0], p0); p1 = MFMA32(kf[2 * d0 + 1], qf[d0], p1); }
        bf16x8 vf[8];
#pragma unroll
        for (int blk = 0; blk < 2; ++blk)
#pragma unroll
            for (int ks = 0; ks < 4; ++ks) vf[blk * 4 + ks] = cat8(trrd(vb + (16 * ks) * 192 + blk * 64), trrd(vb + (16 * ks + 8) * 192 + blk * 64));
        __builtin_amdgcn_sched_barrier(0);
        asm volatile("s_nop 15\n\ts_nop 7" : "+v"(p0), "+v"(p1));
        if (ti >= 4) {
            const int j = jlo + ti - 4; const int kbase = qb * 64 - 128 + 64 * j;
            if (j == 0) {
#pragma unroll
                for (int r = 0; r < 16; ++r) { const int kp = kbase + crow(r, hi); if (kp < qpos - 128) p0[r] = -INFINITY; if (kp + 32 < qpos - 128) p1[r] = -INFINITY; }
            } else if (j == 4) {
#pragma unroll
                for (int r = 0; r < 16; ++r) { const int kp = kbase + crow(r, hi); if (kp > qpos + 128) p0[r] = -INFINITY; if (kp + 32 > qpos + 128) p1[r] = -INFINITY; }
            }
        }
        float rma, rmb;
        asm("v_max3_f32 %0, %1, %2, %3" : "=v"(rma) : "v"(p0[0]), "v"(p0[1]), "v"(p1[0]));
        asm("v_max3_f32 %0, %1, %2, %3" : "=v"(rmb) : "v"(p0[2]), "v"(p0[3]), "v"(p1[1]));
        asm("v_max3_f32 %0, %1, %2, %3" : "=v"(rma) : "v"(rma), "v"(p1[2]), "v"(p1[3]));
#pragma unroll
        for (int r = 4; r < 16; r += 4) {
            asm("v_max3_f32 %0, %1, %2, %3" : "=v"(rma) : "v"(rma), "v"(p0[r]), "v"(p0[r + 1]));
            asm("v_max3_f32 %0, %1, %2, %3" : "=v"(rmb) : "v"(rmb), "v"(p0[r + 2]), "v"(p0[r + 3]));
            asm("v_max3_f32 %0, %1, %2, %3" : "=v"(rma) : "v"(rma), "v"(p1[r]), "v"(p1[r + 1]));
            asm("v_max3_f32 %0, %1, %2, %3" : "=v"(rmb) : "v"(rmb), "v"(p1[r + 2]), "v"(p1[r + 3]));
        }
        float rm; asm("v_max3_f32 %0, %1, %2, %3" : "=v"(rm) : "v"(rma), "v"(rmb), "v"(rmb));
        { const float rmo = __shfl_xor(rm, 32); asm("v_max3_f32 %0, %1, %2, %3" : "=v"(rm) : "v"(rm), "v"(rmo), "v"(rmo)); }
        if (__any(rm > 8.0f)) {
            const float dl = fmaxf(rm, 0.f);
            mref += dl;
            const float f = __builtin_amdgcn_exp2f(-dl);
            lsum *= f;
#pragma unroll
            for (int r = 0; r < 16; ++r) { p0[r] -= dl; p1[r] -= dl; oT[0][r] *= f; oT[1][r] *= f; }
        }
        float ls = 0.f;
#pragma unroll
        for (int r = 0; r < 16; ++r) { p0[r] = __builtin_amdgcn_exp2f(p0[r]); p1[r] = __builtin_amdgcn_exp2f(p1[r]); ls += p0[r] + p1[r]; }
        lsum += ls;
        bf16x8 pf[4]; pf[0] = pack8(p0, 0); pf[1] = pack8(p0, 8); pf[2] = pack8(p1, 0); pf[3] = pack8(p1, 8);
#pragma unroll
        for (int blk = 0; blk < 2; ++blk)
#pragma unroll
            for (int ks = 0; ks < 4; ++ks) oT[blk] = MFMA32(vf[blk * 4 + ks], pf[ks], oT[blk]);
        if (ti + 1 < ntiles) { *(u32x4*)(Ks + (buf ^ 1) * 9216 + soff) = kreg; *(u32x4*)(Vs + (buf ^ 1) * 12288 + vsoff) = vreg; }
        kreg = kreg2; vreg = vreg2;
        __syncthreads();
    }
    lsum += __shfl_xor(lsum, 32);
    lsum += __builtin_amdgcn_exp2f(sink2 - mref);
    const float inv = 1.0f / lsum;
    unsigned char* ow = qscr;
#pragma unroll
    for (int blk = 0; blk < 2; ++blk)
#pragma unroll
        for (int g4 = 0; g4 < 4; ++g4) {
            u32x2 w; w.x = pkbf(oT[blk][4 * g4 + 0] * inv, oT[blk][4 * g4 + 1] * inv); w.y = pkbf(oT[blk][4 * g4 + 2] * inv, oT[blk][4 * g4 + 3] * inv);
            *(u32x2*)(ow + r32 * 144 + (32 * blk + 8 * g4 + 4 * hi) * 2) = w;
        }
    asm volatile("s_waitcnt lgkmcnt(0)" ::: "memory");
#pragma unroll
    for (int i4 = 0; i4 < 4; ++i4) {
        const int rr = i4 * 8 + (lane >> 3), ch = lane & 7;
        const u32x4 ov = *(const u32x4*)(ow + rr * 144 + ch * 16);
        const unsigned ovv[4] = {ov.x, ov.y, ov.z, ov.w}, gvv[4] = {gaw[i4].x, gaw[i4].y, gaw[i4].z, gaw[i4].w};
        u32x4 w;
        unsigned wv[4];
#pragma unroll
        for (int e = 0; e < 4; ++e) wv[e] = pkbf(bf2f(ovv[e] & 0xffffu) * silu_f(bf2f(gvv[e] & 0xffffu)), bf2f(ovv[e] >> 16) * silu_f(bf2f(gvv[e] >> 16)));
        w.x = wv[0]; w.y = wv[1]; w.z = wv[2]; w.w = wv[3];
        *(u32x4*)(H + (qrow0 + rr) * DM + head * 64 + ch * 8) = w;
    }
    asm volatile("s_waitcnt lgkmcnt(0)" ::: "memory");
}

__device__ __forceinline__ void fft1_unit(int u, const bf16_t* P, bf16_t* YF, const unsigned char* ws, unsigned char* lds) {
    const int tid = opaque_tid(), lane = tid & 63, wave = __builtin_amdgcn_readfirstlane(tid >> 6), r32 = lane & 31, hi = lane >> 5;
    const int b = u >> 6, n2 = u & 63;
    constexpr int UPB = 576;
    const bf16_t* src = P + (size_t)(b * SEQ + n2) * PW + C_UF;
#pragma unroll
    for (int i = 0; i < 8; ++i) {
        const int id = tid + NTHREADS * i, n1 = id >> 5, cc = id & 31;
        *(u32x4*)(lds + n1 * UPB + cc * 16) = *(const u32x4*)(src + (size_t)n1 * 64 * PW + cc * 8);
    }
    __syncthreads();
    const bf16_t* T1R = (const bf16_t*)(ws + WS_T1R); const bf16_t* T1I = (const bf16_t*)(ws + WS_T1I);
    f32x16 aR[4], aI[4];
#pragma unroll
    for (int kb = 0; kb < 4; ++kb) { aR[kb] = f32x16{}; aI[kb] = f32x16{}; }
    const unsigned char* ap = lds + (8 * hi + ((lane & 15) >> 2)) * UPB + (32 * wave + 16 * ((lane >> 4) & 1) + 4 * (lane & 3)) * 2;
#pragma unroll 2
    for (int ks = 0; ks < 8; ++ks) {
        const bf16x8 av = cat8(trrd(ap + (16 * ks) * UPB), trrd(ap + (16 * ks + 4) * UPB));
#pragma unroll
        for (int kb = 0; kb < 4; ++kb) {
            const bf16x8 bR = *(const bf16x8*)(T1R + (32 * kb + r32) * 128 + 16 * ks + 8 * hi), bI = *(const bf16x8*)(T1I + (32 * kb + r32) * 128 + 16 * ks + 8 * hi);
            aR[kb] = MFMA32(av, bR, aR[kb]); aI[kb] = MFMA32(av, bI, aI[kb]);
        }
    }
    const float* TW = (const float*)(ws + WS_TW);
#pragma unroll
    for (int kb = 0; kb < 4; ++kb) {
        const int k1 = 32 * kb + r32;
        const float ct = TW[2 * (n2 * k1)], st = TW[2 * (n2 * k1) + 1];
        bf16_t* yp = YF + ((size_t)((b * 128 + k1) * 64 + n2)) * 512 + 32 * wave + 4 * hi;
#pragma unroll
        for (int g4 = 0; g4 < 4; ++g4) {
            float yr[4], yi[4];
#pragma unroll
            for (int e = 0; e < 4; ++e) { const float r_ = aR[kb][4 * g4 + e], i_ = aI[kb][4 * g4 + e]; yr[e] = r_ * ct + i_ * st; yi[e] = i_ * ct - r_ * st; }
            u32x2 wr_, wi_; wr_.x = pkbf(yr[0], yr[1]); wr_.y = pkbf(yr[2], yr[3]); wi_.x = pkbf(yi[0], yi[1]); wi_.y = pkbf(yi[2], yi[3]);
            *(u32x2*)(yp + 8 * g4) = wr_; *(u32x2*)(yp + 256 + 8 * g4) = wi_;
        }
    }
    __syncthreads();
}

template <int KK>
__device__ __forceinline__ void dftf_unit(const bf16_t* srcbase, int R, int pitchA, int pitchB, const bf16_t* Tr, const bf16_t* Ti, const bf16_t* Gt,
                                          const bf16_t* P, bf16_t* H, size_t row0, int rowstride, float oscale, unsigned char* lds) {
    const int tid = opaque_tid(), lane = tid & 63, wave = __builtin_amdgcn_readfirstlane(tid >> 6), r32 = lane & 31, hi = lane >> 5;
    constexpr int ZPB = (KK == 128) ? 576 : 544;
#pragma unroll 1
    for (int i0 = 0; i0 < KK / 16; i0 += 8) {
        u32x4 img[8];
#pragma unroll
        for (int i = 0; i < 8; ++i) { const int id = tid + NTHREADS * (i0 + i), kk = id >> 5, cc = id & 31; img[i] = *(const u32x4*)(srcbase + (size_t)(kk % R) * pitchA + (size_t)(kk / R) * pitchB + cc * 8); }
        __builtin_amdgcn_sched_barrier(0);
#pragma unroll
        for (int i = 0; i < 8; ++i) { const int id = tid + NTHREADS * (i0 + i), kk = id >> 5, cc = id & 31; *(u32x4*)(lds + kk * ZPB + cc * 16) = img[i]; }
        __builtin_amdgcn_sched_barrier(0);
    }
    __syncthreads();
    const int g = wave >> 1, kblk = wave & 1;
    f32x16 XR[2], XI[2];
#pragma unroll
    for (int cb = 0; cb < 2; ++cb) { XR[cb] = f32x16{}; XI[cb] = f32x16{}; }
    const bf16_t* trp = Tr + (size_t)(32 * kblk + r32) * KK + 8 * hi; const bf16_t* tip = Ti + (size_t)(32 * kblk + r32) * KK + 8 * hi;
    const unsigned char* zp = lds + (8 * hi + ((lane & 15) >> 2)) * ZPB + (64 * g + 16 * ((lane >> 4) & 1) + 4 * (lane & 3)) * 2;
#pragma unroll 2
    for (int ks = 0; ks < KK / 16; ++ks) {
        const bf16x8 bR = *(const bf16x8*)(trp + 16 * ks), bI = *(const bf16x8*)(tip + 16 * ks);
#pragma unroll
        for (int cb = 0; cb < 2; ++cb) { const bf16x8 av = cat8(trrd(zp + (16 * ks) * ZPB + cb * 64), trrd(zp + (16 * ks + 4) * ZPB + cb * 64)); XR[cb] = MFMA32(av, bR, XR[cb]); XI[cb] = MFMA32(av, bI, XI[cb]); }
    }
    f32x16 oa[2]; oa[0] = f32x16{}; oa[1] = f32x16{};
    const bf16_t* gp = Gt + (size_t)(g * 2 * 8 * 64 + lane) * 8;
    u32x2 gfw[8];
    { const size_t rowg = row0 + (size_t)(32 * kblk + r32) * rowstride;
#pragma unroll
      for (int i8 = 0; i8 < 8; ++i8) gfw[i8] = *(const u32x2*)(P + rowg * PW + C_GF + 64 * g + 32 * (i8 >> 2) + 8 * (i8 & 3) + 4 * hi); }
#pragma unroll
    for (int part = 0; part < 2; ++part)
#pragma unroll
        for (int cb = 0; cb < 2; ++cb)
#pragma unroll
            for (int s = 0; s < 2; ++s) {
                const bf16x8 bx = pack8(part ? XI[cb] : XR[cb], 8 * s);
                const int kko = part * 64 + 32 * cb + 16 * s;
#pragma unroll
                for (int lb = 0; lb < 2; ++lb) { const bf16x8 ag = *(const bf16x8*)(gp + (size_t)((lb * 8 + (kko >> 4)) * 64) * 8); oa[lb] = MFMA32(ag, bx, oa[lb]); }
            }
    const int k2 = 32 * kblk + r32;
    const size_t row = row0 + (size_t)k2 * rowstride;
    const bf16_t* gfrow = P + row * PW + C_GF + 64 * g;
    bf16_t* hrow = H + row * DM + 512 + 64 * g;
#pragma unroll
    for (int lb = 0; lb < 2; ++lb)
#pragma unroll
        for (int g4 = 0; g4 < 4; ++g4) {
            const int l0 = 32 * lb + 8 * g4 + 4 * hi;
            const u32x2 gw = gfw[lb * 4 + g4];
            const float o0 = oa[lb][4 * g4 + 0] * oscale * silu_f(bf2f(gw.x & 0xffffu)), o1 = oa[lb][4 * g4 + 1] * oscale * silu_f(bf2f(gw.x >> 16));
            const float o2 = oa[lb][4 * g4 + 2] * oscale * silu_f(bf2f(gw.y & 0xffffu)), o3 = oa[lb][4 * g4 + 3] * oscale * silu_f(bf2f(gw.y >> 16));
            u32x2 w; w.x = pkbf(o0, o1); w.y = pkbf(o2, o3);
            *(u32x2*)(hrow + l0) = w;
        }
    __syncthreads();
}

__device__ __forceinline__ void conv_unit(int u, const bf16_t* P, bf16_t* H, const float* cw, const float* cb) {
    const int tid = opaque_tid(), cgp = tid & 31, rg = tid >> 5;
    const int ch0 = cgp * 8;
    const int r0 = u * 64 + rg * 4;
    int pos, len; if (r0 < NTOK) { pos = r0 & (SEQ - 1); len = SEQ; } else { pos = (r0 - NTOK) & (CTXL - 1); len = CTXL; }
    float w0[8], w1[8], w2[8], bs[8];
#pragma unroll
    for (int e = 0; e < 8; ++e) { w0[e] = cw[ch0 + e]; w1[e] = cw[256 + ch0 + e]; w2[e] = cw[512 + ch0 + e]; bs[e] = cb[ch0 + e]; }
    float T[6][8];
#pragma unroll
    for (int i = 0; i < 6; ++i) {
        const int p = pos - 1 + i;
        if (p >= 0 && p < len) {
            const size_t row = (size_t)(r0 - 1 + i);
            const u32x4 z = *(const u32x4*)(P + row * PW + C_ZC + ch0), c = *(const u32x4*)(P + row * PW + C_CC + ch0);
            T[i][0] = bf2f(z.x & 0xffffu) * bf2f(c.x & 0xffffu); T[i][1] = bf2f(z.x >> 16) * bf2f(c.x >> 16);
            T[i][2] = bf2f(z.y & 0xffffu) * bf2f(c.y & 0xffffu); T[i][3] = bf2f(z.y >> 16) * bf2f(c.y >> 16);
            T[i][4] = bf2f(z.z & 0xffffu) * bf2f(c.z & 0xffffu); T[i][5] = bf2f(z.z >> 16) * bf2f(c.z >> 16);
            T[i][6] = bf2f(z.w & 0xffffu) * bf2f(c.w & 0xffffu); T[i][7] = bf2f(z.w >> 16) * bf2f(c.w >> 16);
        } else {
#pragma unroll
            for (int e = 0; e < 8; ++e) T[i][e] = 0.f;
        }
    }
#pragma unroll
    for (int i = 0; i < 4; ++i) {
        const size_t row = (size_t)(r0 + i);
        const u32x4 bw = *(const u32x4*)(P + row * PW + C_BC + ch0), gw = *(const u32x4*)(P + row * PW + C_GC + ch0);
        const unsigned bwv[4] = {bw.x, bw.y, bw.z, bw.w}, gwv[4] = {gw.x, gw.y, gw.z, gw.w};
        float o[8];
#pragma unroll
        for (int e = 0; e < 8; ++e) {
            const float bv = (e & 1) ? bf2f(bwv[e >> 1] >> 16) : bf2f(bwv[e >> 1] & 0xffffu);
            const float gv = (e & 1) ? bf2f(gwv[e >> 1] >> 16) : bf2f(gwv[e >> 1] & 0xffffu);
            const float y = T[i][e] * w0[e] + T[i + 1][e] * w1[e] + T[i + 2][e] * w2[e] + bs[e];
            o[e] = bv * y * silu_f(gv);
        }
        u32x4 w; w.x = pkbf(o[0], o[1]); w.y = pkbf(o[2], o[3]); w.z = pkbf(o[4], o[5]); w.w = pkbf(o[6], o[7]);
        *(u32x4*)(H + row * DM + 768 + ch0) = w;
    }
}

__device__ __forceinline__ void fft1_tables(const unsigned char* ws, unsigned char* tbl, int tid) {
    u32x4 tv[8];
#pragma unroll
    for (int i = 0; i < 8; ++i) { const int id = tid + NTHREADS * i, t = id >> 11, row = (id >> 4) & 127, ch = id & 15; tv[i] = *(const u32x4*)(ws + (t ? WS_T1I : WS_T1R) + row * 256 + ch * 16); }
    __builtin_amdgcn_sched_barrier(0);
#pragma unroll
    for (int i = 0; i < 8; ++i) { const int id = tid + NTHREADS * i, t = id >> 11, row = (id >> 4) & 127, ch = id & 15; *(u32x4*)(tbl + t * 34816 + row * 272 + ch * 16) = tv[i]; }
}
__device__ __forceinline__ void fft1_wave(int task, const bf16_t* P, bf16_t* YF, const unsigned char* ws, unsigned char* lds_w, const unsigned char* tbl, int lane, int pmode = 0) {
    const int r32 = lane & 31, hi = lane >> 5;
    const int cblk = task & 7, n2 = (task >> 3) & 63, b = task >> 9;
    const bf16_t* src = P + (size_t)((b * 64 + n2) * 128) * 256 + 32 * cblk + 8 * (lane & 3);
    { u32x4 img[8];
#pragma unroll
      for (int i = 0; i < 8; ++i) img[i] = *(const u32x4*)(src + (size_t)(16 * i + (lane >> 2)) * 256);
      __builtin_amdgcn_sched_barrier(0);
#pragma unroll
      for (int i = 0; i < 8; ++i) *(u32x4*)(lds_w + (16 * i + (lane >> 2)) * 64 + (lane & 3) * 16) = img[i];
      __builtin_amdgcn_sched_barrier(0); }
    asm volatile("s_waitcnt vmcnt(0) lgkmcnt(0)" ::: "memory");
    if (pmode == 2) return;
    const bf16_t* T1R = (const bf16_t*)(ws + WS_T1R); const bf16_t* T1I = (const bf16_t*)(ws + WS_T1I);
    f32x16 aR[4], aI[4];
#pragma unroll
    for (int kb = 0; kb < 4; ++kb) { aR[kb] = f32x16{}; aI[kb] = f32x16{}; }
    const unsigned char* ap = lds_w + (8 * hi + ((lane & 15) >> 2)) * 64 + (16 * ((lane >> 4) & 1) + 4 * (lane & 3)) * 2;
    const unsigned char* tb = tbl + r32 * 272 + hi * 16;
#pragma unroll 2
    for (int ks = 0; ks < 8; ++ks) {
        const bf16x8 av = cat8(trrd(ap + (16 * ks) * 64), trrd(ap + (16 * ks + 4) * 64));
        bf16x8 bq[8];
#pragma unroll
        for (int kb = 0; kb < 4; ++kb) { bq[2 * kb] = *(const bf16x8*)(tb + (32 * kb) * 272 + 32 * ks); bq[2 * kb + 1] = *(const bf16x8*)(tb + 34816 + (32 * kb) * 272 + 32 * ks); }
#pragma unroll
        for (int kb = 0; kb < 4; ++kb) { aR[kb] = MFMA32(av, bq[2 * kb], aR[kb]); aI[kb] = MFMA32(av, bq[2 * kb + 1], aI[kb]); }
    }
    const float* TW = (const float*)(ws + WS_TW);
    float ctw[4], stw[4];
#pragma unroll
    for (int kb = 0; kb < 4; ++kb) { const int k1 = 32 * kb + r32; ctw[kb] = TW[2 * (n2 * k1)]; stw[kb] = TW[2 * (n2 * k1) + 1]; }
    asm volatile("s_waitcnt lgkmcnt(0)" ::: "memory");
#pragma unroll
    for (int pr = 0; pr < 2; ++pr) {
#pragma unroll
        for (int kq = 0; kq < 2; ++kq) {
            const int kb = 2 * pr + kq; const int rowl = 32 * kq + r32; const float ct = ctw[kb], st = stw[kb];
#pragma unroll
            for (int g4 = 0; g4 < 4; ++g4) {
                float yr[4], yi[4];
#pragma unroll
                for (int e = 0; e < 4; ++e) { const float r_ = aR[kb][4 * g4 + e], i_ = aI[kb][4 * g4 + e]; yr[e] = r_ * ct + i_ * st; yi[e] = i_ * ct - r_ * st; }
                u32x2 wr_, wi_; wr_.x = pkbf(yr[0], yr[1]); wr_.y = pkbf(yr[2], yr[3]); wi_.x = pkbf(yi[0], yi[1]); wi_.y = pkbf(yi[2], yi[3]);
                *(u32x2*)(lds_w + rowl * 128 + ((g4 ^ (rowl & 7)) * 16) + hi * 8) = wr_;
                *(u32x2*)(lds_w + rowl * 128 + (((4 + g4) ^ (rowl & 7)) * 16) + hi * 8) = wi_;
            }
        }
        asm volatile("s_waitcnt lgkmcnt(0)" ::: "memory");
#pragma unroll
        for (int i8 = 0; i8 < 8; ++i8) {
            const int rowl = i8 * 8 + (lane >> 3), ch = lane & 7;
            const u32x4 v = *(const u32x4*)(lds_w + rowl * 128 + ((ch ^ (rowl & 7)) * 16));
            const int k1 = 64 * pr + rowl;
            bf16_t* dst = YF + ((size_t)((b * 128 + k1) * 64 + n2)) * 512 + (ch >> 2) * 256 + 32 * cblk + 8 * (ch & 3);
            *(u32x4*)dst = v;
        }
        asm volatile("s_waitcnt lgkmcnt(0)" ::: "memory");
    }
}
__device__ __forceinline__ void fft3_wave(int task, const bf16_t* YF, const bf16_t* Gt, const bf16_t* P, bf16_t* H, const unsigned char* ws, unsigned char* lds_w, int lane) {
    const int r32 = lane & 31, hi = lane >> 5;
    const int g = task & 3, k1 = (task >> 2) & 127, b = task >> 9;
    const bf16_t* src = YF + ((size_t)(b * 128 + k1) * 64) * 512 + 64 * g + 8 * (lane & 7);
    { u32x4 img[16];
#pragma unroll
      for (int i = 0; i < 16; ++i) { const int kk = 8 * i + (lane >> 3); img[i] = *(const u32x4*)(src + (size_t)(kk & 63) * 512 + (size_t)(kk >> 6) * 256); }
      __builtin_amdgcn_sched_barrier(0);
#pragma unroll
      for (int i = 0; i < 16; ++i) { const int kk = 8 * i + (lane >> 3), ch = lane & 7; *(u32x4*)(lds_w + kk * 128 + ((ch ^ (((kk >> 1) & 1) << 2)) * 16)) = img[i]; }
      __builtin_amdgcn_sched_barrier(0); }
    asm volatile("s_waitcnt vmcnt(0) lgkmcnt(0)" ::: "memory");
    const bf16_t* T3R = (const bf16_t*)(ws + WS_T3R); const bf16_t* T3I = (const bf16_t*)(ws + WS_T3I);
    const int q = (lane & 15) >> 2, sw = (q >> 1) & 1;
    const int chl = 2 * ((lane >> 4) & 1) + ((lane & 3) >> 1);
    const unsigned char* zb = lds_w + (8 * hi + q) * 128 + 8 * (lane & 1);
    const unsigned char* zp0 = zb + ((chl ^ (sw << 2)) * 16);
    const unsigned char* zp1 = zb + (((4 + chl) ^ (sw << 2)) * 16);
    const bf16_t* gp = Gt + (size_t)(g * 2 * 8 * 64 + lane) * 8;
    const size_t rowb = (size_t)(b * SEQ + k1);
    u32x2 hwA[8], hwB[8];
#pragma unroll
    for (int i8 = 0; i8 < 8; ++i8) { hwA[i8] = (u32x2){0u, 0u}; hwB[i8] = (u32x2){0u, 0u}; }
#pragma unroll 1
    for (int kblk = 0; kblk < 2; ++kblk) {
        f32x16 XR[2], XI[2];
#pragma unroll
        for (int cb = 0; cb < 2; ++cb) { XR[cb] = f32x16{}; XI[cb] = f32x16{}; }
        const bf16_t* trp = T3R + (size_t)(kblk * 8 * 64 + lane) * 8; const bf16_t* tip = T3I + (size_t)(kblk * 8 * 64 + lane) * 8;
        const size_t rowg = rowb + (size_t)(32 * kblk + r32) * 128;
        u32x2 gfw[8];
#pragma unroll
        for (int i8 = 0; i8 < 8; ++i8) gfw[i8] = *(const u32x2*)(P + rowg * PW + C_GF + 64 * g + 32 * (i8 >> 2) + 8 * (i8 & 3) + 4 * hi);
        bf16x8 bR[8], bI[8];
#pragma unroll
        for (int ks = 0; ks < 8; ++ks) { bR[ks] = *(const bf16x8*)(trp + 512 * ks); bI[ks] = *(const bf16x8*)(tip + 512 * ks); }
        __builtin_amdgcn_sched_barrier(0);
#pragma unroll
        for (int ks = 0; ks < 8; ++ks) {
            const bf16x8 a0 = cat8(trrd(zp0 + (16 * ks) * 128), trrd(zp0 + (16 * ks + 4) * 128));
            const bf16x8 a1 = cat8(trrd(zp1 + (16 * ks) * 128), trrd(zp1 + (16 * ks + 4) * 128));
            XR[0] = MFMA32(a0, bR[ks], XR[0]); XI[0] = MFMA32(a0, bI[ks], XI[0]); XR[1] = MFMA32(a1, bR[ks], XR[1]); XI[1] = MFMA32(a1, bI[ks], XI[1]);
        }
        __builtin_amdgcn_sched_barrier(0);
        bf16x8 gfr[2][8];
#pragma unroll
        for (int lb = 0; lb < 2; ++lb)
#pragma unroll
            for (int q8 = 0; q8 < 8; ++q8) gfr[lb][q8] = *(const bf16x8*)(gp + (size_t)((lb * 8 + q8) * 64) * 8);
        __builtin_amdgcn_sched_barrier(0);
        f32x16 oa[2]; oa[0] = f32x16{}; oa[1] = f32x16{};
#pragma unroll
        for (int part = 0; part < 2; ++part)
#pragma unroll
            for (int cb = 0; cb < 2; ++cb)
#pragma unroll
                for (int s = 0; s < 2; ++s) {
                    const bf16x8 bx = pack8(part ? XI[cb] : XR[cb], 8 * s);
                    const int kko = part * 64 + 32 * cb + 16 * s;
#pragma unroll
                    for (int lb = 0; lb < 2; ++lb) oa[lb] = MFMA32(gfr[lb][kko >> 4], bx, oa[lb]);
                }
#pragma unroll
        for (int lb = 0; lb < 2; ++lb)
#pragma unroll
            for (int g4 = 0; g4 < 4; ++g4) {
                const u32x2 gw = gfw[lb * 4 + g4];
                const float o0 = oa[lb][4 * g4 + 0] * silu_f(bf2f(gw.x & 0xffffu)), o1 = oa[lb][4 * g4 + 1] * silu_f(bf2f(gw.x >> 16));
                const float o2 = oa[lb][4 * g4 + 2] * silu_f(bf2f(gw.y & 0xffffu)), o3 = oa[lb][4 * g4 + 3] * silu_f(bf2f(gw.y >> 16));
                u32x2 pk; pk.x = pkbf(o0, o1); pk.y = pkbf(o2, o3);
                if (kblk == 0) hwA[lb * 4 + g4] = pk; else hwB[lb * 4 + g4] = pk;
            }
    }
    asm volatile("s_waitcnt lgkmcnt(0)" ::: "memory");
#pragma unroll
    for (int kblk = 0; kblk < 2; ++kblk)
#pragma unroll
        for (int lb = 0; lb < 2; ++lb)
#pragma unroll
            for (int g4 = 0; g4 < 4; ++g4) { const int rowl = 32 * kblk + r32;
                *(u32x2*)(lds_w + rowl * 128 + (((4 * lb + g4) ^ (rowl & 7)) * 16) + hi * 8) = kblk ? hwB[lb * 4 + g4] : hwA[lb * 4 + g4]; }
    asm volatile("s_waitcnt lgkmcnt(0)" ::: "memory");
#pragma unroll
    for (int i8 = 0; i8 < 8; ++i8) {
        const int rowl = i8 * 8 + (lane >> 3), ch = lane & 7;
        const u32x4 v = *(const u32x4*)(lds_w + rowl * 128 + ((ch ^ (rowl & 7)) * 16));
        *(u32x4*)(H + (rowb + (size_t)rowl * 128) * DM + 512 + 64 * g + 8 * ch) = v;
    }
    asm volatile("s_waitcnt lgkmcnt(0)" ::: "memory");
}
__device__ __forceinline__ void conv_wave(int task, const bf16_t* P, bf16_t* H, const float* cw, const float* cb, int lane) {
    const int cgp = lane & 31, ch0 = cgp * 8;
    const int r0 = task * 8 + (lane >> 5) * 4;
    int pos, len; if (r0 < NTOK) { pos = r0 & (SEQ - 1); len = SEQ; } else { pos = (r0 - NTOK) & (CTXL - 1); len = CTXL; }
    u32x4 zz[6], cc[6], bb[4], gg[4]; float okf[6];
#pragma unroll
    for (int i = 0; i < 6; ++i) { const int p = pos - 1 + i; const bool ok = p >= 0 && p < len; okf[i] = ok ? 1.f : 0.f; const size_t row = (size_t)(ok ? r0 - 1 + i : r0);
        zz[i] = *(const u32x4*)(P + row * PW + C_ZC + ch0); cc[i] = *(const u32x4*)(P + row * PW + C_CC + ch0); }
#pragma unroll
    for (int i = 0; i < 4; ++i) { const size_t row = (size_t)(r0 + i); bb[i] = *(const u32x4*)(P + row * PW + C_BC + ch0); gg[i] = *(const u32x4*)(P + row * PW + C_GC + ch0); }
    __builtin_amdgcn_sched_barrier(0);
    float w0[8], w1[8], w2[8], bs[8];
    { const f32x4 a0 = *(const f32x4*)(cw + ch0), a1 = *(const f32x4*)(cw + ch0 + 4), b0 = *(const f32x4*)(cw + 256 + ch0), b1 = *(const f32x4*)(cw + 256 + ch0 + 4);
      const f32x4 c0 = *(const f32x4*)(cw + 512 + ch0), c1 = *(const f32x4*)(cw + 512 + ch0 + 4), d0 = *(const f32x4*)(cb + ch0), d1 = *(const f32x4*)(cb + ch0 + 4);
#pragma unroll
      for (int e = 0; e < 4; ++e) { w0[e] = a0[e]; w0[4 + e] = a1[e]; w1[e] = b0[e]; w1[4 + e] = b1[e]; w2[e] = c0[e]; w2[4 + e] = c1[e]; bs[e] = d0[e]; bs[4 + e] = d1[e]; } }
    float T[6][8];
#pragma unroll
    for (int i = 0; i < 6; ++i) {
        const unsigned zv[4] = {zz[i].x, zz[i].y, zz[i].z, zz[i].w}, cv[4] = {cc[i].x, cc[i].y, cc[i].z, cc[i].w};
#pragma unroll
        for (int e = 0; e < 8; ++e) T[i][e] = okf[i] * ((e & 1) ? bf2f(zv[e >> 1] >> 16) : bf2f(zv[e >> 1] & 0xffffu)) * ((e & 1) ? bf2f(cv[e >> 1] >> 16) : bf2f(cv[e >> 1] & 0xffffu));
    }
#pragma unroll
    for (int i = 0; i < 4; ++i) {
        const size_t row = (size_t)(r0 + i);
        const unsigned bwv[4] = {bb[i].x, bb[i].y, bb[i].z, bb[i].w}, gwv[4] = {gg[i].x, gg[i].y, gg[i].z, gg[i].w};
        float o[8];
#pragma unroll
        for (int e = 0; e < 8; ++e) {
            const float bv = (e & 1) ? bf2f(bwv[e >> 1] >> 16) : bf2f(bwv[e >> 1] & 0xffffu);
            const float gv = (e & 1) ? bf2f(gwv[e >> 1] >> 16) : bf2f(gwv[e >> 1] & 0xffffu);
            const float y = T[i][e] * w0[e] + T[i + 1][e] * w1[e] + T[i + 2][e] * w2[e] + bs[e];
            o[e] = bv * y * silu_f(gv);
        }
        u32x4 w; w.x = pkbf(o[0], o[1]); w.y = pkbf(o[2], o[3]); w.z = pkbf(o[4], o[5]); w.w = pkbf(o[6], o[7]);
        *(u32x4*)(H + row * DM + 768 + ch0) = w;
    }
}

#define XB_TMO      128
#define XB_XCNT(j)  (256  + 64 * (j))
#define XB_XSUB(j)  (1280 + 64 * (j))
#define XB_XGEN(j)  (2304 + 64 * (j))
#define XB_TOP      3328
#define XB_TOPGEN   3392
#define XCD_BAR_WORDS 3456
#define XB_SPIN_CAP (1u << 18)

__device__ __forceinline__ unsigned xb_ld(unsigned* p)              { return __hip_atomic_load(p, __ATOMIC_RELAXED, __HIP_MEMORY_SCOPE_AGENT); }
__device__ __forceinline__ unsigned xb_add(unsigned* p, unsigned v) { return __hip_atomic_fetch_add(p, v, __ATOMIC_RELAXED, __HIP_MEMORY_SCOPE_AGENT); }
__device__ __forceinline__ unsigned xb_xcc_id() { return (unsigned)__builtin_amdgcn_s_getreg((3 << 11) | 20) & 0xFu; }
#define XB_SPIN(cond, bar) do { unsigned _sp = 0; while (cond) { __builtin_amdgcn_s_sleep(1); \
    if ((++_sp & 255u) == 0u) { if (xb_ld(&(bar)[XB_TMO])) break; if (_sp > XB_SPIN_CAP) { atomicAdd(&(bar)[XB_TMO], 1u); break; } } } } while (0)

struct XcdBarrier {
    unsigned* bar; unsigned x;
    volatile LAS unsigned* st;
};

__device__ __forceinline__ XcdBarrier xcd_barrier_post(unsigned* bar, volatile LAS unsigned* st) {
    XcdBarrier b; b.bar = bar; b.x = xb_xcc_id(); b.st = st;
    if (threadIdx.x == 0) (void)xb_add(&bar[XB_XCNT(b.x)], 1u);
    return b;
}
__device__ __forceinline__ void xcd_barrier_complete(unsigned* bar, unsigned x, unsigned& nloc, unsigned& nx) {
    const unsigned G = gridDim.x * gridDim.y * gridDim.z;
    unsigned sum, cnt, mine, sp = 0u;
    for (;;) {
        sum = 0u; cnt = 0u; mine = 0u;
#pragma unroll
        for (unsigned j = 0; j < 16; ++j) { const unsigned c = xb_ld(&bar[XB_XCNT(j)]); sum += c; cnt += (c > 0u) ? 1u : 0u; mine = (j == x) ? c : mine; }
        if (sum == G) break;
        __builtin_amdgcn_s_sleep(1);
        if ((++sp & 255u) == 0u) { if (xb_ld(&bar[XB_TMO])) break; if (sp > XB_SPIN_CAP) { atomicAdd(&bar[XB_TMO], 1u); break; } }
    }
    nloc = mine > 0u ? mine : 1u; nx = cnt > 0u ? cnt : 1u;
}

__device__ __forceinline__ void xcd_barrier(const XcdBarrier& b) {
    asm volatile("s_waitcnt vmcnt(0)" ::: "memory");
    __syncthreads();
    if (threadIdx.x == 0) {
        unsigned* bar = b.bar;
        __builtin_amdgcn_s_waitcnt(0);
        unsigned nloc = b.st[0], nx = b.st[1];
        if (nloc == 0u) { xcd_barrier_complete(bar, b.x, nloc, nx); b.st[0] = nloc; b.st[1] = nx; }
        const unsigned old = xb_add(&bar[XB_XSUB(b.x)], 1u);
        const unsigned gen = old / nloc;
        if (old + 1u == (gen + 1u) * nloc) {
            __builtin_amdgcn_fence(__ATOMIC_RELEASE, "agent");
            asm volatile("s_waitcnt vmcnt(0)" ::: "memory");
            const unsigned og = xb_add(&bar[XB_TOP], 1u);
            const unsigned tg = og / nx;
            if (og + 1u == (tg + 1u) * nx) xb_add(&bar[XB_TOPGEN], 1u);
            else XB_SPIN(xb_ld(&bar[XB_TOPGEN]) == tg, bar);
            __builtin_amdgcn_fence(__ATOMIC_ACQUIRE, "agent");
            xb_add(&bar[XB_XGEN(b.x)], 1u);
            asm volatile("s_waitcnt vmcnt(0)" ::: "memory");
        } else {
            XB_SPIN(xb_ld(&bar[XB_XGEN(b.x)]) == gen, bar);
            __builtin_amdgcn_fence(__ATOMIC_ACQUIRE, "agent");
            asm volatile("s_waitcnt vmcnt(0)" ::: "memory");
        }
    }
    __syncthreads();
}

__device__ __forceinline__ int next_unit(unsigned* ctr, unsigned char* lds) {
    volatile int* sw = (volatile int*)(lds + LDS_SCHED);
    if (threadIdx.x == 0) *sw = (int)atomicAdd(ctr, 1u);
    __syncthreads();
    const int u = *sw;
    __syncthreads();
    return u;
}

__global__ void __launch_bounds__(NTHREADS, 2) hybrid_fwd(KArgs a) {
    extern __shared__ __attribute__((aligned(16))) unsigned char lds[];
    cg::grid_group grid = cg::this_grid();
    unsigned char* ws = a.ws;
    const int lo = a.ph_lo, hi = a.ph_hi;
#ifndef PHMASK
#define PHMASK 0xfff
#endif
#define IN(k) (((PHMASK >> ((k) > 5 && (k) < 11 ? (k) - 5 : (k))) & 1) && lo <= (k) && (k) < hi)
#define SEAM(k) do { if (IN(k) && IN((k) + 1)) xcd_barrier(xbar); } while (0)
#ifndef REP_PHASE
#define REP_PHASE -1
#endif
#define REPS(j) for (int rep = 0, nrep = (REP_PHASE == (j)) ? 2 : 1; rep < nrep; ++rep, (rep < nrep ? xcd_barrier(xbar) : (void)0))
    bf16_t* HX = (bf16_t*)(ws + WS_HX); bf16_t* Pb = (bf16_t*)(ws + WS_P); bf16_t* Vt = (bf16_t*)(ws + WS_VT); bf16_t* Hb = (bf16_t*)(ws + WS_H);
    bf16_t* Yb = (bf16_t*)(ws + WS_Y); bf16_t* YF = (bf16_t*)(ws + WS_YF); float* SSQ = (float*)(ws + WS_SSQ);
    unsigned* ctl = (unsigned*)(ws + WS_CTL);

    if (threadIdx.x < 2) ((volatile LAS unsigned*)(lds + LDS_BARST))[threadIdx.x] = 0u;
    __syncthreads();
    const XcdBarrier xbar = xcd_barrier_post((unsigned*)(ws + WS_BAR), (volatile LAS unsigned*)(lds + LDS_BARST));
    if (a.ph_lo < 0) grid.sync();
    REPS(30) if (IN(0)) p0_prologue(a, lds);
    SEAM(0);
    for (int l = 0; l < 2; ++l) {
        const int pb = 1 + 5 * l;
        REPS(0) if (IN(pb)) norm_phase(a, l);
        SEAM(pb);
        REPS(1) if (IN(pb + 1)) {
            pg8::Gemm g{HX, (const bf16_t*)(ws + WS_WIN) + (size_t)l * PW * DM, MROWS, PW, DM};
            pg8::StaticOrder S; S.init(MROWS, PW, (int)gridDim.x, (int)blockIdx.x);
            pg8::EpiProj E{Pb, Vt, (const float*)(ws + WS_ROPE), (bf16_t*)(ws + WS_UFP), 0.125f * LOG2E};
            pg8::gemm_phase<pg8::EpiProj, pg8::StaticOrder, true, true>((PG8_LAS unsigned char*)lds, g, S, E);
        }
        SEAM(pb + 1);
        for (int rep = 0, nrep = (REP_PHASE >= 20 && REP_PHASE < 30) ? 2 : 1; rep < nrep; ++rep, (rep < nrep ? xcd_barrier(xbar) : (void)0)) if (IN(pb + 2)) {
            const int nAttn = (l == 0) ? 1056 : 1024, nCtxF = (l == 0) ? 16 : 0, nF1 = 256, nConv = ((l == 0) ? MROWS : NTOK) / 64;
            const int e0 = nF1, e1 = e0 + nCtxF, e2 = e1 + nAttn, e3 = e2 + nConv;
            for (;;) {
                const int u = next_unit(ctl + 2 * l + 8 * rep, lds);
                if (u >= e3) break;
                if (rep == 1) { const int ty = u < e0 ? 1 : u < e1 ? 3 : u < e2 ? 0 : 2; if (REP_PHASE == 25 ? (ty == 0) : (ty != REP_PHASE - 20)) continue; }
                if (u >= e1 && u < e2) attn_unit(u - e1, Pb, Vt, Hb, a.sink + 8 * l, lds);
                else if (u >= e0 && u < e1) { const int v = u - e0, b = v >> 2, kb = v & 3;
                    dftf_unit<256>(Pb + (size_t)(NTOK + b * CTXL) * PW + C_UF, 256, PW, 0, (const bf16_t*)(ws + WS_T256R) + (size_t)(64 * kb) * 256, (const bf16_t*)(ws + WS_T256I) + (size_t)(64 * kb) * 256,
                                   (const bf16_t*)(ws + WS_GT) + (size_t)l * 4 * 64 * 128, Pb, Hb, (size_t)(NTOK + b * CTXL + 64 * kb), 1, 5.656854249492381f, lds); }
                else {
                    const int tid = opaque_tid(), lane = tid & 63, wave = __builtin_amdgcn_readfirstlane(tid >> 6);
                    if (u < e0) { fft1_tables(ws, lds + 65536, tid); __syncthreads(); fft1_wave(u * 8 + wave, (const bf16_t*)(ws + WS_UFP), YF, ws, lds + wave * 8192, lds + 65536, lane); }
                    else conv_wave((u - e2) * 8 + wave, Pb, Hb, a.conv_w + l * 768, a.conv_b + l * 256, lane);
                }
            }
        }
        SEAM(pb + 2);
        REPS(3) if (IN(pb + 3)) {
            const bool gemmwg = (l == 0 && blockIdx.x < 16);
            if (gemmwg) {
                pg8::Gemm g{Hb + (size_t)NTOK * DM, (const bf16_t*)(ws + WS_WOUT) + (size_t)l * DM * DM, NCTX, DM, DM};
                pg8::StaticOrder S; S.init(NCTX, DM, 16, (int)blockIdx.x);
                pg8::EpiY E{Yb + (size_t)NTOK * DM, SSQ + (size_t)NTOK * 16};
                pg8::gemm_phase<pg8::EpiY, pg8::StaticOrder, true, true>((PG8_LAS unsigned char*)lds, g, S, E);
            } else {
                const int tid = opaque_tid(), lane = tid & 63, wave = __builtin_amdgcn_readfirstlane(tid >> 6);
                const int nb0 = (l == 0) ? 16 : 0;
                const int gw = ((int)blockIdx.x - nb0) + wave * ((int)gridDim.x - nb0), NGW = ((int)gridDim.x - nb0) * 8;
                unsigned char* lds_w = lds + wave * 16384;
                for (int t = gw; t < 2048; t += NGW) fft3_wave(t, YF, (const bf16_t*)(ws + WS_GT) + (size_t)l * 4 * 64 * 128, Pb, Hb, ws, lds_w, lane);
            }
            __syncthreads();
        }
        SEAM(pb + 3);
        REPS(4) if (IN(pb + 4)) {
            pg8::Gemm g{Hb, (const bf16_t*)(ws + WS_WOUT) + (size_t)l * DM * DM, NTOK, DM, DM};
            pg8::StaticOrder S; S.init(NTOK, DM, (int)gridDim.x, (int)blockIdx.x);
            pg8::EpiY E{l == 0 ? Yb : HX, l == 0 ? SSQ : (float*)(ws + WS_SSQ1)};
            pg8::gemm_phase<pg8::EpiY, pg8::StaticOrder, true, true>((PG8_LAS unsigned char*)lds, g, S, E);
        }
        SEAM(pb + 4);
    }
#if REP_PHASE == 9
    for (int i = 0; i < 10; ++i) xcd_barrier(xbar);
#endif
    if (IN(11)) norm_phase(a, 2);
#undef IN
#undef SEAM
}

#ifndef MK_MULTI
#define MK_MULTI 0
#endif
extern "C" void kernel_launch(void* const* d_in, const int* in_sizes, int n_in, void* d_out, int out_size, void* d_ws, size_t ws_size, hipStream_t stream) {
    static int grid = 0;
    if (grid == 0) {
        if (n_in != 14 || ws_size < WS_END) { fprintf(stderr, "kernel_launch: unexpected n_in %d or ws_size %zu (need %zu)\n", n_in, ws_size, (size_t)WS_END); grid = -1; return; }
        int dev = 0, cus = 0, per_cu = 0;
        hipGetDevice(&dev); hipDeviceGetAttribute(&cus, hipDeviceAttributeMultiprocessorCount, dev);
        if (hipFuncSetAttribute((const void*)hybrid_fwd, hipFuncAttributeMaxDynamicSharedMemorySize, LDS_BYTES) != hipSuccess) { fprintf(stderr, "kernel_launch: hipFuncSetAttribute failed\n"); grid = -1; return; }
        if (hipOccupancyMaxActiveBlocksPerMultiprocessor(&per_cu, (const void*)hybrid_fwd, NTHREADS, LDS_BYTES) != hipSuccess || per_cu < 1) { fprintf(stderr, "kernel_launch: occupancy query gave %d\n", per_cu); per_cu = 1; }
        (void)hipGetLastError();
        grid = cus * 1;
        fprintf(stderr, "kernel_launch: grid %d (cus %d, per_cu %d)\n", grid, cus, per_cu);
    }
    if (grid < 0) return;
    if (hipMemsetAsync((char*)d_ws + WS_CTL, 0, WS_ZERO_BYTES, stream) != hipSuccess) { fprintf(stderr, "kernel_launch: hipMemsetAsync failed\n"); return; }
    KArgs a{};
    a.x = (const float*)d_in[0]; a.c = (const float*)d_in[1]; a.ctx = (const float*)d_in[2]; a.c_ctx = (const float*)d_in[3]; a.w_mod = (const float*)d_in[4]; a.b_mod = (const float*)d_in[5];
    a.g_pre = (const float*)d_in[6]; a.g_post = (const float*)d_in[7]; a.w_in = (const float*)d_in[8]; a.w_out = (const float*)d_in[9]; a.sink = (const float*)d_in[10]; a.w_f = (const float*)d_in[11];
    a.conv_w = (const float*)d_in[12]; a.conv_b = (const float*)d_in[13];
    a.out = (float*)d_out; a.ws = (unsigned char*)d_ws;
#if MK_MULTI
    for (int ph = 0; ph < 12; ++ph) { a.ph_lo = ph; a.ph_hi = ph + 1; hipLaunchKernelGGL(hybrid_fwd, dim3(grid), dim3(NTHREADS), LDS_BYTES, stream, a); }
#else
    a.ph_lo = 0; a.ph_hi = 12;
    void* args[] = {&a};
    hipError_t e = hipLaunchCooperativeKernel((const void*)hybrid_fwd, dim3(grid), dim3(NTHREADS), args, LDS_BYTES, stream);
    if (e != hipSuccess) fprintf(stderr, "kernel_launch: cooperative launch failed: %s (grid %d)\n", hipGetErrorString(e), grid);
#endif
}
```

```cpp
#include <hip/hip_runtime.h>
#include <hip/hip_cooperative_groups.h>
#include <cstdio>
#include <cstdint>
namespace cg = cooperative_groups;
namespace pg8 {
#define PG8_LAS __attribute__((address_space(3)))
typedef unsigned short bf16_t;
typedef short bf16x8 __attribute__((ext_vector_type(8)));
typedef float f32x4 __attribute__((ext_vector_type(4)));
typedef unsigned u32x4 __attribute__((ext_vector_type(4)));
constexpr int BM = 256, BK = 64, HALF = 128, HTB = HALF * BK * 2  , STAGE_BYTES = 8 * HTB, NXCD = 8, WGM = 8;

__host__ __device__ __forceinline__ int lds_byte(int r, int c) { const int st = (r >> 4) * 2 + (c >> 5), rr = r & 15, cc = c & 31, ob = rr * 64 + cc * 2; return st * 1024 + (ob ^ (((ob >> 9) & 1) << 5)); }
__host__ __device__ __forceinline__ void stage_rc(int b, int& R, int& C) { const int st = b / 1024, sb = b % 1024, swz = sb ^ (((sb >> 9) & 1) << 5); R = (st >> 1) * 16 + swz / 64; C = (st & 1) * 32 + (swz % 64) / 2; }
__host__ __device__ __forceinline__ int perm32(int rho) { const int n = rho >> 4, i = rho & 15; return 8 * (i >> 2) + 4 * n + (i & 3); }

struct Unit { int pm, pn; };
struct Gemm { const bf16_t* A; const bf16_t* Bt; int M, N, K; };

struct StaticOrder {
    int nM, nN, nwg, G, c;
    __host__ __device__ void init(int M, int N, int G_, int c_) { nM = M / BM; nN = N / BM; nwg = nM * nN; G = G_; c = c_; }
    __host__ __device__ bool next(int i, Unit& u) const {
        const long L = (long)i * G + c; if (L >= nwg) return false;
        int wgid = (int)L; { const int q = nwg / NXCD, r = nwg % NXCD, xcd = wgid % NXCD, off = wgid / NXCD; wgid = (xcd < r ? xcd * (q + 1) : r * (q + 1) + (xcd - r) * q) + off; }
        const int nig = WGM * nN, gid = wgid / nig, fm = gid * WGM, gsz = (nM - fm) < WGM ? (nM - fm) : WGM;
        u.pm = fm + ((wgid % nig) % gsz); u.pn = (wgid % nig) / gsz; return true;
    }
    __device__ __forceinline__ void a_ready(const Unit&) const {}
    __device__ __forceinline__ void done(const Unit&) const {}
};

__device__ __forceinline__ unsigned cvt_pk_bf16(float lo, float hi) { unsigned r; asm volatile("v_cvt_pk_bf16_f32 %0, %1, %2" : "=v"(r) : "v"(lo), "v"(hi)); return r; }
typedef unsigned u32x2 __attribute__((ext_vector_type(2)));
__device__ __forceinline__ int swap23(int t) { return (t & ~12) | ((t & 4) << 1) | ((t & 8) >> 1); }
struct EpiProj {
    static constexpr bool PERM = true, AFTER_DRAIN = false;
    bf16_t* P; bf16_t* Vt; const float* rope; bf16_t* UFP; float qscale;
    __device__ __forceinline__ void operator()(const f32x4 (&acc)[2][2][4][2], const Unit& u, int wr, int wc, int fr, int fq) const {
        const int row0 = u.pm * BM + wr * 64 + fr;
        const int pn = u.pn;
        const bool ctxrow = u.pm >= 128;
        f32x4 CS[2][4], SN[2][4];
        if (pn <= 2) {
#pragma unroll
            for (int ai = 0; ai < 2; ++ai)
#pragma unroll
                for (int m = 0; m < 4; ++m) {
                    CS[ai][m] = (f32x4){1.f, 1.f, 1.f, 1.f}; SN[ai][m] = (f32x4){0.f, 0.f, 0.f, 0.f};
                    if (!ctxrow) { const int t = (row0 + ai * HALF + m * 16) & 8191; const int pos = (wc & 1) ? (t & 63) : (t >> 6);
                        CS[ai][m] = *(const f32x4*)(rope + pos * 32 + 4 * fq); SN[ai][m] = *(const f32x4*)(rope + pos * 32 + 16 + 4 * fq); }
                }
            __builtin_amdgcn_sched_barrier(0);
        }
#pragma unroll
        for (int ai = 0; ai < 2; ++ai)
#pragma unroll
            for (int m = 0; m < 4; ++m) {
                const int row = row0 + ai * HALF + m * 16;
                bf16_t* rowp = P + (size_t)row * 2816 + pn * BM + wc * 32 + 8 * fq;
                if (pn == 5 && !ctxrow) { const int t = row & 8191; rowp = UFP + ((size_t)(((row >> 13) * 64 + (t & 63)) * 128 + (t >> 6))) * 256 + wc * 32 + 8 * fq; }
                if (pn > 2) {
#pragma unroll
                    for (int bj = 0; bj < 2; ++bj) { const f32x4 v0 = acc[ai][bj][m][0], v1 = acc[ai][bj][m][1];
                        u32x4 w; w.x = cvt_pk_bf16(v0[0], v0[1]); w.y = cvt_pk_bf16(v0[2], v0[3]); w.z = cvt_pk_bf16(v1[0], v1[1]); w.w = cvt_pk_bf16(v1[2], v1[3]);
                        *(u32x4*)(rowp + bj * HALF) = w; }
                } else {
                    const f32x4 cs = CS[ai][m], sn = SN[ai][m];
#pragma unroll
                    for (int bj = 0; bj < 2; ++bj) {
                        f32x4 v0 = acc[ai][bj][m][0], v1 = acc[ai][bj][m][1];
                        if (pn == 2 && bj == 1) {
                            u32x4 w; w.x = cvt_pk_bf16(v0[0], v0[1]); w.y = cvt_pk_bf16(v0[2], v0[3]); w.z = cvt_pk_bf16(v1[0], v1[1]); w.w = cvt_pk_bf16(v1[2], v1[3]);
                            *(u32x4*)(rowp + bj * HALF) = w;
                        } else {
                            const f32x4 r0 = v0 * cs - v1 * sn, r1 = v0 * sn + v1 * cs;
                            v0 = r0; v1 = r1;
                            if (pn < 2) { v0 = v0 * qscale; v1 = v1 * qscale; }
                            u32x4 w; w.x = cvt_pk_bf16(v0[0], v0[1]); w.y = cvt_pk_bf16(v0[2], v0[3]); w.z = cvt_pk_bf16(v1[0], v1[1]); w.w = cvt_pk_bf16(v1[2], v1[3]);
                            *(u32x4*)(rowp + bj * HALF) = w;
                        }
                    }
                }
            }
    }
};
struct EpiY {
    static constexpr bool PERM = true, AFTER_DRAIN = false;
    bf16_t* Y; float* ssq;
    __device__ __forceinline__ void operator()(const f32x4 (&acc)[2][2][4][2], const Unit& u, int wr, int wc, int fr, int fq) const {
        const int row0 = u.pm * BM + wr * 64 + fr;
#pragma unroll
        for (int ai = 0; ai < 2; ++ai)
#pragma unroll
            for (int m = 0; m < 4; ++m) {
                const int row = row0 + ai * HALF + m * 16;
                bf16_t* rowp = Y + (size_t)row * 1024 + u.pn * BM + wc * 32 + 8 * fq;
                float s = 0.f;
#pragma unroll
                for (int bj = 0; bj < 2; ++bj) { const f32x4 v0 = acc[ai][bj][m][0], v1 = acc[ai][bj][m][1];
                    s += (v0[0] * v0[0] + v0[1] * v0[1]) + (v0[2] * v0[2] + v0[3] * v0[3]) + (v1[0] * v1[0] + v1[1] * v1[1]) + (v1[2] * v1[2] + v1[3] * v1[3]);
                    u32x4 w; w.x = cvt_pk_bf16(v0[0], v0[1]); w.y = cvt_pk_bf16(v0[2], v0[3]); w.z = cvt_pk_bf16(v1[0], v1[1]); w.w = cvt_pk_bf16(v1[2], v1[3]);
                    *(u32x4*)(rowp + bj * HALF) = w; }
                s += __shfl_xor(s, 16); s += __shfl_xor(s, 32);
                if (fq == 0) ssq[(size_t)row * 16 + u.pn * 4 + wc] = s;
            }
    }
};
template <class Epi, class Sched, bool ALIGN_EPI = false, bool SP2 = false>
__device__ __forceinline__ void gemm_phase(PG8_LAS unsigned char* lds, const Gemm g, const Sched& S, const Epi& E) {
    int tid_ = threadIdx.x; asm volatile("" : "+v"(tid_));
    const int tid = tid_, wid = __builtin_amdgcn_readfirstlane(tid >> 6), lane = tid & 63, wr = wid >> 2, wc = wid & 3, fr = lane & 15, fq = lane >> 4;
    const int K = g.K, nt = K / BK;
    unsigned voffA[2], voffB[2];
#pragma unroll
    for (int i = 0; i < 2; ++i) { int R, C; stage_rc(tid * 16 + i * 8192, R, C); const int Rb = Epi::PERM ? ((R & ~31) + perm32(R & 31)) : R;
        voffA[i] = (unsigned)(R * K + C) * 2u; voffB[i] = (unsigned)(Rb * K + C) * 2u; }
    const size_t kstep = (size_t)(BK * 2);
    const size_t hstep = (size_t)HALF * K * 2;
    const size_t tstep = 2 * hstep;
    const unsigned ldsw = (unsigned)wid * 1024u;
    const int aoff = lds_byte(wr * 64 + fr, fq * 8), boff = lds_byte(wc * 32 + fr, fq * 8);
#define PG8_SA(b, h) (((b) * 2 + (h)) * HTB)
#define PG8_SB(b, h) ((4 + (b) * 2 + (h)) * HTB)
#define PG8_STAGE(bufoff, gbase, voff) do { _Pragma("unroll") for (int _i = 0; _i < 2; ++_i) \
        __builtin_amdgcn_global_load_lds((const unsigned*)((const char*)(gbase) + (voff)[_i]), (PG8_LAS unsigned*)(lds + (bufoff) + ldsw + _i * 8192), 16, 0, 0); } while (0)
#define PG8_LDA(dst, b, h) do { _Pragma("unroll") for (int m = 0; m < 4; ++m) _Pragma("unroll") for (int k = 0; k < 2; ++k) dst[m][k] = *(const PG8_LAS bf16x8*)(lds + PG8_SA(b, h) + aoff + m * 2048 + k * 1024); } while (0)
#define PG8_LDB(dst, b, h) do { _Pragma("unroll") for (int n = 0; n < 2; ++n) _Pragma("unroll") for (int k = 0; k < 2; ++k) dst[n][k] = *(const PG8_LAS bf16x8*)(lds + PG8_SB(b, h) + boff + n * 2048 + k * 1024); } while (0)
#define PG8_MMA(ai, bj, At, Bt) do { __builtin_amdgcn_s_setprio(1); _Pragma("unroll") for (int m = 0; m < 4; ++m) _Pragma("unroll") for (int n = 0; n < 2; ++n) _Pragma("unroll") for (int k = 0; k < 2; ++k) \
        acc[ai][bj][m][n] = __builtin_amdgcn_mfma_f32_16x16x32_bf16(Bt[n][k], At[m][k], acc[ai][bj][m][n], 0, 0, 0); __builtin_amdgcn_s_setprio(0); } while (0)
#define PG8_WAIT_V(n) asm volatile("s_waitcnt vmcnt(" #n ")" ::: "memory")
#define PG8_WAIT_L(n) asm volatile("s_waitcnt lgkmcnt(" #n ")" ::: "memory")
#define PG8_BAR __builtin_amdgcn_s_barrier()
#define PG8_SCHED __builtin_amdgcn_sched_barrier(0)
    Unit cur, nxt; int ui = 0;
    if (!S.next(0, cur)) return;
    f32x4 acc[2][2][4][2];
#pragma unroll
    for (int a = 0; a < 2; ++a)
#pragma unroll
        for (int b = 0; b < 2; ++b)
#pragma unroll
            for (int m = 0; m < 4; ++m)
#pragma unroll
                for (int n = 0; n < 2; ++n) acc[a][b][m][n] = (f32x4){0.f, 0.f, 0.f, 0.f};
    bf16x8 At[4][2], B0[2][2], B1[2][2];
    const char* cA = (const char*)g.A + (size_t)cur.pm * tstep; const char* cB = (const char*)g.Bt + (size_t)cur.pn * tstep;
    S.a_ready(cur);
    if constexpr (SP2) {
        PG8_STAGE(PG8_SB(0, 0), cB, voffB); PG8_STAGE(PG8_SB(0, 1), cB + hstep, voffB); PG8_STAGE(PG8_SA(0, 0), cA, voffA); PG8_STAGE(PG8_SA(0, 1), cA + hstep, voffA);
        if (wr == 1) PG8_BAR;
        PG8_WAIT_V(2); PG8_BAR;
        PG8_STAGE(PG8_SB(1, 0), cB + kstep, voffB); PG8_STAGE(PG8_SA(1, 0), cA + kstep, voffA); PG8_STAGE(PG8_SB(1, 1), cB + hstep + kstep, voffB);
        PG8_WAIT_V(6); PG8_BAR;
    } else {
        PG8_STAGE(PG8_SB(0, 0), cB, voffB); PG8_STAGE(PG8_SA(0, 0), cA, voffA); PG8_STAGE(PG8_SB(0, 1), cB + hstep, voffB); PG8_STAGE(PG8_SA(0, 1), cA + hstep, voffA);
        if (wr == 1) PG8_BAR;
        PG8_WAIT_V(4); PG8_BAR;
        PG8_STAGE(PG8_SB(1, 0), cB + kstep, voffB); PG8_STAGE(PG8_SA(1, 0), cA + kstep, voffA); PG8_STAGE(PG8_SB(1, 1), cB + hstep + kstep, voffB);
        PG8_WAIT_V(6); PG8_BAR;
    }
    for (;;) {
        const bool has_next = S.next(ui + 1, nxt);
        const char* nA = has_next ? (const char*)g.A + (size_t)nxt.pm * tstep : cA; const char* nB = has_next ? (const char*)g.Bt + (size_t)nxt.pn * tstep : cB;
        for (int t = 0; t < nt; t += 2) {
            const bool last = (t == nt - 2);
            const char* a1 = cA + (size_t)(t + 1) * kstep;
            const char* a2 = last ? nA : cA + (size_t)(t + 2) * kstep; const char* b2 = last ? nB : cB + (size_t)(t + 2) * kstep;
            const char* a3 = a2 + kstep; const char* b3 = b2 + kstep;
            if (last && has_next) S.a_ready(nxt);
            if constexpr (SP2) {
            PG8_LDB(B0, 0, 0); PG8_LDB(B1, 0, 1); PG8_SCHED; PG8_LDA(At, 0, 0); PG8_STAGE(PG8_SA(1, 1), a1 + hstep, voffA);
            PG8_WAIT_V(8); PG8_WAIT_L(0); PG8_BAR; PG8_MMA(0, 0, At, B0); PG8_MMA(0, 1, At, B1); PG8_BAR; PG8_SCHED;
            PG8_LDA(At, 0, 1); PG8_STAGE(PG8_SB(0, 0), b2, voffB); PG8_STAGE(PG8_SB(0, 1), b2 + hstep, voffB); PG8_STAGE(PG8_SA(0, 0), a2, voffA);
            PG8_WAIT_V(8); PG8_WAIT_L(0); PG8_BAR; PG8_MMA(1, 0, At, B0); PG8_MMA(1, 1, At, B1); PG8_BAR; PG8_SCHED;
            PG8_LDB(B0, 1, 0); PG8_LDB(B1, 1, 1); PG8_SCHED; PG8_LDA(At, 1, 0); PG8_STAGE(PG8_SA(0, 1), a2 + hstep, voffA);
            PG8_WAIT_V(8); PG8_WAIT_L(0); PG8_BAR; PG8_MMA(0, 0, At, B0); PG8_MMA(0, 1, At, B1); PG8_BAR; PG8_SCHED;
            PG8_LDA(At, 1, 1); PG8_STAGE(PG8_SB(1, 0), b3, voffB); PG8_STAGE(PG8_SB(1, 1), b3 + hstep, voffB); PG8_STAGE(PG8_SA(1, 0), a3, voffA);
            PG8_WAIT_V(8); PG8_WAIT_L(0); PG8_BAR; PG8_MMA(1, 0, At, B0); PG8_MMA(1, 1, At, B1); PG8_BAR; PG8_SCHED;
            } else {
            PG8_LDB(B0, 0, 0); PG8_SCHED; PG8_LDA(At, 0, 0); PG8_STAGE(PG8_SA(1, 1), a1 + hstep, voffA);
            PG8_WAIT_L(8); PG8_BAR; PG8_WAIT_L(0); PG8_MMA(0, 0, At, B0); PG8_BAR; PG8_SCHED;
            PG8_LDB(B1, 0, 1); PG8_STAGE(PG8_SB(0, 0), b2, voffB);
            PG8_BAR; PG8_WAIT_L(0); PG8_MMA(0, 1, At, B1); PG8_BAR;
            PG8_LDA(At, 0, 1); PG8_STAGE(PG8_SA(0, 0), a2, voffA);
            PG8_BAR; PG8_WAIT_L(0); PG8_MMA(1, 0, At, B0); PG8_BAR; PG8_SCHED;
            PG8_STAGE(PG8_SB(0, 1), b2 + hstep, voffB);
            PG8_WAIT_V(6); PG8_BAR; PG8_MMA(1, 1, At, B1); PG8_BAR;
            PG8_LDB(B0, 1, 0); PG8_SCHED; PG8_LDA(At, 1, 0); PG8_STAGE(PG8_SA(0, 1), a2 + hstep, voffA);
            PG8_WAIT_L(8); PG8_BAR; PG8_WAIT_L(0); PG8_MMA(0, 0, At, B0); PG8_BAR; PG8_SCHED;
            PG8_LDB(B1, 1, 1); PG8_STAGE(PG8_SB(1, 0), b3, voffB);
            PG8_BAR; PG8_WAIT_L(0); PG8_MMA(0, 1, At, B1); PG8_BAR;
            PG8_LDA(At, 1, 1); PG8_STAGE(PG8_SA(1, 0), a3, voffA);
            PG8_BAR; PG8_WAIT_L(0); PG8_MMA(1, 0, At, B0); PG8_BAR; PG8_SCHED;
            PG8_STAGE(PG8_SB(1, 1), b3 + hstep, voffB);
            PG8_WAIT_V(6); PG8_BAR; PG8_MMA(1, 1, At, B1); PG8_BAR;
            }
        }
        if constexpr (ALIGN_EPI) { if (wr == 0) PG8_BAR; }
        if constexpr (!Epi::AFTER_DRAIN) { E(acc, cur, wr, wc, fr, fq); S.done(cur); }
        if (!has_next) break;
#pragma unroll
        for (int a = 0; a < 2; ++a)
#pragma unroll
            for (int b = 0; b < 2; ++b)
#pragma unroll
                for (int m = 0; m < 4; ++m)
#pragma unroll
                    for (int n = 0; n < 2; ++n) acc[a][b][m][n] = (f32x4){0.f, 0.f, 0.f, 0.f};
        cur = nxt; cA = nA; cB = nB; ++ui;
        if constexpr (ALIGN_EPI) { if (wr == 1) PG8_BAR; }
    }
    PG8_WAIT_V(0);
    if constexpr (!ALIGN_EPI) { if (wr == 0) PG8_BAR; }
    PG8_BAR;
    if constexpr (Epi::AFTER_DRAIN) { E.fused(acc, cur, wr, wc, fr, fq, lds, wid, lane); S.done(cur); }
#undef PG8_SA
#undef PG8_SB
#undef PG8_STAGE
#undef PG8_LDA
#undef PG8_LDB
#undef PG8_MMA
#undef PG8_WAIT_V
#undef PG8_WAIT_L
#undef PG8_BAR
#undef PG8_SCHED
}
}

typedef unsigned short bf16_t;
typedef short bf16x8 __attribute__((ext_vector_type(8)));
typedef float f32x4 __attribute__((ext_vector_type(4)));
typedef float f32x16 __attribute__((ext_vector_type(16)));
typedef unsigned u32x4 __attribute__((ext_vector_type(4)));
typedef unsigned u32x2 __attribute__((ext_vector_type(2)));
#define LAS __attribute__((address_space(3)))
__device__ __forceinline__ int opaque_tid() { int t = threadIdx.x; asm volatile("" : "+v"(t)); return t; }

constexpr int DM = 1024, NBATCH = 4, SEQ = 8192, NTOK = NBATCH * SEQ, CTXL = 256, NCTX = NBATCH * CTXL, MROWS = NTOK + NCTX;
constexpr int PW = 2816;
constexpr int C_Q = 0, C_K = 512, C_V = 640, C_GA = 768, C_UF = 1280, C_GF = 1536, C_ZC = 1792, C_BC = 2048, C_CC = 2304, C_GC = 2560;
constexpr int VT_PITCH = SEQ + CTXL;
constexpr float NORM_EPS = 1e-6f;
constexpr float LOG2E = 1.4426950408889634f;

constexpr size_t KiB = 1024, MiB = 1u << 20;
constexpr size_t WS_CTL = 0;
constexpr size_t WS_BAR = 16 * KiB;
constexpr size_t WS_ZERO_BYTES = 32 * KiB;
constexpr size_t WS_MOD = 64 * KiB;
constexpr size_t WS_ROPE = 256 * KiB;
constexpr size_t WS_TW = 320 * KiB;
constexpr size_t WS_T1R = 384 * KiB, WS_T1I = 416 * KiB;
constexpr size_t WS_T3R = 448 * KiB, WS_T3I = 464 * KiB;
constexpr size_t WS_T256R = 512 * KiB, WS_T256I = 640 * KiB;
constexpr size_t WS_GT = 768 * KiB;
constexpr size_t WS_SSQ = 1 * MiB;
constexpr size_t WS_WIN = 4 * MiB;
constexpr size_t WS_WOUT = 16 * MiB;
constexpr size_t WS_SSQ1 = 24 * MiB;
constexpr size_t WS_MODP = 28 * MiB;
constexpr size_t WS_HX = 32 * MiB;
constexpr size_t WS_P = 112 * MiB;
constexpr size_t WS_VT = 304 * MiB;
constexpr size_t WS_H = 320 * MiB;
constexpr size_t WS_Y = 392 * MiB;
constexpr size_t WS_YF = 464 * MiB;
constexpr size_t WS_CTX1 = 100 * MiB;
constexpr size_t WS_UFP = 496 * MiB;
constexpr size_t WS_END = 512 * MiB;
static_assert(WS_BAR + 3456 * 4 <= WS_ZERO_BYTES && WS_MODP + (size_t)2 * 8 * 5 * 3072 * 4 <= WS_HX && WS_SSQ + (size_t)MROWS * 16 * 4 <= WS_WIN && WS_WIN + (size_t)2 * PW * DM * 2 <= WS_WOUT && WS_HX + (size_t)MROWS * DM * 2 <= WS_P && WS_P + (size_t)MROWS * PW * 2 <= WS_VT &&
              WS_VT + (size_t)8 * 64 * VT_PITCH * 2 <= WS_H && WS_H + (size_t)MROWS * DM * 2 <= WS_Y && WS_Y + (size_t)MROWS * DM * 2 <= WS_YF && WS_YF + (size_t)4 * 128 * 64 * 512 * 2 <= WS_UFP && WS_UFP + (size_t)NTOK * 256 * 2 <= WS_END && WS_HX + (size_t)MROWS * DM * 2 <= WS_CTX1 && WS_CTX1 + (size_t)NCTX * DM * 4 <= WS_P, "ws map");

constexpr int LDS_BYTES = 147456;
constexpr int LDS_SCHED = LDS_BYTES - 64;
constexpr int LDS_BARST = LDS_BYTES - 32;
constexpr int NTHREADS = 512;

__device__ __forceinline__ float bf2f(unsigned h) { return __uint_as_float(h << 16); }
__device__ __forceinline__ unsigned pkbf(float lo, float hi) { unsigned r; asm volatile("v_cvt_pk_bf16_f32 %0, %1, %2" : "=v"(r) : "v"(lo), "v"(hi)); return r; }
__device__ __forceinline__ float silu_f(float x) { return x * __builtin_amdgcn_rcpf(1.f + __builtin_amdgcn_exp2f(-x * LOG2E)); }
__device__ __forceinline__ float wave_sum(float v) {
#pragma unroll
    for (int o = 1; o < 64; o <<= 1) v += __shfl_xor(v, o);
    return v;
}
__device__ __forceinline__ int swap23(int t) { return (t & ~12) | ((t & 4) << 1) | ((t & 8) >> 1); }
__device__ __forceinline__ int crow(int r, int hi) { return (r & 3) + 8 * (r >> 2) + 4 * hi; }
__device__ __forceinline__ bf16x8 pack8(const f32x16& p, int base) {
    u32x4 w; w.x = pkbf(p[base + 0], p[base + 1]); w.y = pkbf(p[base + 2], p[base + 3]); w.z = pkbf(p[base + 4], p[base + 5]); w.w = pkbf(p[base + 6], p[base + 7]);
    return __builtin_bit_cast(bf16x8, w);
}
#define MFMA32(a, b, c) __builtin_amdgcn_mfma_f32_32x32x16_bf16((a), (b), (c), 0, 0, 0)

struct KArgs {
    const float *x, *c, *ctx, *c_ctx, *w_mod, *b_mod, *g_pre, *g_post, *w_in, *w_out, *sink, *w_f, *conv_w, *conv_b;
    float* out; unsigned char* ws; int ph_lo, ph_hi;
};

__device__ __forceinline__ int prow_qk(int n) { return (n & ~31) | (8 * ((n >> 2) & 3) + 4 * ((n >> 4) & 1) + (n & 3)); }
__device__ __forceinline__ void p0_transpose_item(const float* W, int K, int N, bf16_t* WT, int nperm, float* scr, int item, int lane) {
    const int nblk = N / 32, kb = item / nblk, nb = item % nblk, k0 = 64 * kb, n0 = 32 * nb;
    { float wv[32];
#pragma unroll
      for (int i = 0; i < 32; ++i) wv[i] = W[(size_t)(k0 + 2 * i + (lane >> 5)) * N + n0 + (lane & 31)];
      __builtin_amdgcn_sched_barrier(0);
#pragma unroll
      for (int i = 0; i < 32; ++i) scr[(2 * i + (lane >> 5)) * 33 + (lane & 31)] = wv[i];
      __builtin_amdgcn_sched_barrier(0); }
    asm volatile("s_waitcnt lgkmcnt(0)" ::: "memory");
    const int c = lane & 7;
#pragma unroll
    for (int j = 0; j < 4; ++j) { const int n = (lane >> 3) + 8 * j; const float* s = scr + (8 * c) * 33 + n;
        u32x4 o; o.x = pkbf(s[0 * 33], s[1 * 33]); o.y = pkbf(s[2 * 33], s[3 * 33]); o.z = pkbf(s[4 * 33], s[5 * 33]); o.w = pkbf(s[6 * 33], s[7 * 33]);
        const int nl = n0 + n; const int np = nl < nperm ? prow_qk(nl) : nl;
        *(u32x4*)(WT + (size_t)np * K + k0 + 8 * c) = o; }
    asm volatile("s_waitcnt lgkmcnt(0)" ::: "memory");
}

__device__ __forceinline__ void p0_mod_gemv(const KArgs& a, int item, float* ldsf) {
    const int tid = opaque_tid(), lane = tid & 63, wave = tid >> 6;
    const int l = item / 96, col0 = (item % 96) * 32;
    float* s = ldsf;
    float* red = ldsf + 5 * 1024;
    for (int i = tid; i < 5 * 1024; i += NTHREADS) { const int bb = i >> 10, k = i & 1023; const float v = bb < 4 ? a.c[bb * 1024 + k] : a.c_ctx[k]; s[i] = v / (1.f + __expf(-v)); }
    __syncthreads();
    const int col = lane & 31, kh = lane >> 5;
    const float* W = a.w_mod + (size_t)l * 1024 * 3072 + (size_t)(wave * 128 + kh) * 3072 + col0 + col;
    float w[64];
#pragma unroll
    for (int i = 0; i < 64; ++i) w[i] = W[(size_t)(2 * i) * 3072];
    float acc[5] = {0.f, 0.f, 0.f, 0.f, 0.f};
#pragma unroll
    for (int i = 0; i < 64; ++i)
#pragma unroll
        for (int bb = 0; bb < 5; ++bb) acc[bb] += w[i] * s[bb * 1024 + wave * 128 + 2 * i + kh];
#pragma unroll
    for (int bb = 0; bb < 5; ++bb) red[((wave * 2 + kh) * 5 + bb) * 32 + col] = acc[bb];
    __syncthreads();
    if (tid < 160) { const int bb = tid >> 5, cc = tid & 31; float v = a.b_mod[l * 3072 + col0 + cc];
#pragma unroll
        for (int ww = 0; ww < 16; ++ww) v += red[(ww * 5 + bb) * 32 + cc];
        ((float*)(a.ws + WS_MOD))[(l * 5 + bb) * 3072 + col0 + cc] = v; }
    __syncthreads();
}

__device__ __forceinline__ void p0_prologue(const KArgs& a, unsigned char* lds) {
    const int tid = opaque_tid(), lane = tid & 63, wave = tid >> 6;
    const int G = gridDim.x, bx = blockIdx.x;
    unsigned char* ws = a.ws;
    if (bx < 192) p0_mod_gemv(a, bx, (float*)lds);
    {
        float* scr = (float*)(lds + wave * 16384);
        const int gw = bx * 8 + wave, NGW = G * 8;
        constexpr int I_IN = (DM / 64) * (PW / 32), I_OUT = (DM / 64) * (DM / 32);
        constexpr int NIT = 2 * (I_IN + I_OUT);
        for (int it = gw; it < NIT; it += NGW) {
            int r = it; const int l = r / (I_IN + I_OUT); r -= l * (I_IN + I_OUT);
            if (r < I_IN) p0_transpose_item(a.w_in + (size_t)l * DM * PW, DM, PW, (bf16_t*)(ws + WS_WIN) + (size_t)l * PW * DM, 640, scr, r, lane);
            else p0_transpose_item(a.w_out + (size_t)l * DM * DM, DM, DM, (bf16_t*)(ws + WS_WOUT) + (size_t)l * DM * DM, 0, scr, r - I_IN, lane);
        }
    }
    const int gt = bx * NTHREADS + tid, NGT = G * NTHREADS;
    for (int i = gt; i < 128 * 16; i += NGT) {
        const int pos = i >> 4, f = i & 15; const float inv = powf(10000.0f, -(float)f / 16.0f); const float ang = (float)pos * inv;
        float* rp = (float*)(ws + WS_ROPE) + pos * 32; rp[f] = cosf(ang); rp[16 + f] = sinf(ang);
    }
    for (int i = gt; i < 8192; i += NGT) { float sn, cs; sincospif((float)i * (2.0f / 8192.0f), &sn, &cs); float* t = (float*)(ws + WS_TW) + 2 * i; t[0] = cs; t[1] = sn; }
    for (int i = gt; i < 128 * 128; i += NGT) { const int k = i >> 7, n = i & 127; float sn, cs; sincospif((float)((k * n) & 127) * (2.0f / 128.0f), &sn, &cs);
        ((bf16_t*)(ws + WS_T1R))[i] = (bf16_t)(pkbf(cs, 0.f) & 0xffffu); ((bf16_t*)(ws + WS_T1I))[i] = (bf16_t)(pkbf(-sn, 0.f) & 0xffffu); }
    for (int i = gt; i < 64 * 128; i += NGT) { const int k = i >> 7, kk = i & 127, n = kk & 63; float sn, cs; sincospif((float)((k * n) & 63) * (2.0f / 64.0f), &sn, &cs);
        const float tr = kk < 64 ? cs : sn, ti = kk < 64 ? -sn : cs;
        const int fpos = ((((k >> 5) * 8 + (kk >> 4)) * 64 + ((k & 31) + 32 * ((kk >> 3) & 1))) * 8) + (kk & 7);
        ((bf16_t*)(ws + WS_T3R))[fpos] = (bf16_t)(pkbf(tr, 0.f) & 0xffffu); ((bf16_t*)(ws + WS_T3I))[fpos] = (bf16_t)(pkbf(ti, 0.f) & 0xffffu); }
    for (int i = gt; i < 256 * 256; i += NGT) { const int k = i >> 8, n = i & 255; float sn, cs; sincospif((float)((k * n) & 255) * (2.0f / 256.0f), &sn, &cs);
        ((bf16_t*)(ws + WS_T256R))[i] = (bf16_t)(pkbf(cs, 0.f) & 0xffffu); ((bf16_t*)(ws + WS_T256I))[i] = (bf16_t)(pkbf(-sn, 0.f) & 0xffffu); }
    {
        __syncthreads();
        float* trig = (float*)lds;
        if (tid < 64) { float sn, cs; sincospif((float)tid * (2.0f / 64.0f), &sn, &cs); trig[tid] = cs; trig[64 + tid] = sn; }
        __syncthreads();
        for (int i = gt; i < 2 * 4 * 64 * 128; i += NGT) {
            const int kk = i & 127, d = (i >> 7) & 63, g = (i >> 13) & 3, l = i >> 15; const int part = kk >> 6, c = swap23(kk & 63);
            const float* wf = a.w_f + ((size_t)(l * 4 + g) * 64) * 64 + d; float sacc = 0.f;
            float wfv[64];
#pragma unroll
            for (int j = 0; j < 64; ++j) wfv[j] = wf[j * 64];
            __builtin_amdgcn_sched_barrier(0);
#pragma unroll
            for (int j = 0; j < 64; ++j) sacc += trig[part * 64 + ((c * j) & 63)] * wfv[j];
            const int gpos = ((((((l * 4 + g) * 2 + (d >> 5)) * 8 + (kk >> 4)) * 64) + ((d & 31) + 32 * ((kk >> 3) & 1))) * 8) + (kk & 7);
            ((bf16_t*)(ws + WS_GT))[gpos] = (bf16_t)(pkbf(sacc * (1.0f / 724.0773439350246f), 0.f) & 0xffffu);
        }
        __syncthreads();
    }
}

__device__ __forceinline__ void norm_rows4(int mode, int lane, const float* src, float* dst, const bf16_t* y0, const float* ssq0, const bf16_t* y1, const float* ssq1, bf16_t* hx,
                                           const f32x4 (&GA0)[4], const f32x4 (&GA1)[4], const f32x4 (&GB)[4], const f32x4 (&GC)[4]) {
    f32x4 v[4][4];
#pragma unroll
    for (int rr = 0; rr < 4; ++rr)
#pragma unroll
        for (int j = 0; j < 4; ++j) v[rr][j] = __builtin_nontemporal_load((const f32x4*)(src + (size_t)rr * DM + 4 * lane + 256 * j));
    if (mode != 0) {
        u32x2 yw[4][4], yx[4][4]; float p[4], p1[4];
#pragma unroll
        for (int rr = 0; rr < 4; ++rr) { p[rr] = ssq0[rr * 16 + (lane & 15)];
#pragma unroll
            for (int j = 0; j < 4; ++j) yw[rr][j] = *(const u32x2*)(y0 + (size_t)rr * DM + 4 * lane + 256 * j); }
        if (mode == 2) {
#pragma unroll
            for (int rr = 0; rr < 4; ++rr) { p1[rr] = ssq1[rr * 16 + (lane & 15)];
#pragma unroll
                for (int j = 0; j < 4; ++j) yx[rr][j] = *(const u32x2*)(y1 + (size_t)rr * DM + 4 * lane + 256 * j); }
        }
#pragma unroll
        for (int rr = 0; rr < 4; ++rr) {
            float q = p[rr]; q += __shfl_xor(q, 1); q += __shfl_xor(q, 2); q += __shfl_xor(q, 4); q += __shfl_xor(q, 8);
            const float rstd = 1.0f / sqrtf(q * (1.0f / DM) + NORM_EPS);
#pragma unroll
            for (int j = 0; j < 4; ++j) {
                f32x4 yy; yy[0] = bf2f(yw[rr][j].x & 0xffffu); yy[1] = bf2f(yw[rr][j].x >> 16); yy[2] = bf2f(yw[rr][j].y & 0xffffu); yy[3] = bf2f(yw[rr][j].y >> 16);
                v[rr][j] = v[rr][j] + GA0[j] * (yy * rstd);
            }
        }
        if (mode == 2) {
#pragma unroll
            for (int rr = 0; rr < 4; ++rr) {
                float q = p1[rr]; q += __shfl_xor(q, 1); q += __shfl_xor(q, 2); q += __shfl_xor(q, 4); q += __shfl_xor(q, 8);
                const float rstd = 1.0f / sqrtf(q * (1.0f / DM) + NORM_EPS);
#pragma unroll
                for (int j = 0; j < 4; ++j) {
                    f32x4 yy; yy[0] = bf2f(yx[rr][j].x & 0xffffu); yy[1] = bf2f(yx[rr][j].x >> 16); yy[2] = bf2f(yx[rr][j].y & 0xffffu); yy[3] = bf2f(yx[rr][j].y >> 16);
                    v[rr][j] = v[rr][j] + GA1[j] * (yy * rstd);
                    *(f32x4*)(dst + (size_t)rr * DM + 4 * lane + 256 * j) = v[rr][j];
                }
            }
        }
    }
    if (mode != 2) {
        float s[4];
#pragma unroll
        for (int rr = 0; rr < 4; ++rr) { float t = 0.f;
#pragma unroll
            for (int j = 0; j < 4; ++j) t += (v[rr][j][0] * v[rr][j][0] + v[rr][j][1] * v[rr][j][1]) + (v[rr][j][2] * v[rr][j][2] + v[rr][j][3] * v[rr][j][3]);
            s[rr] = t; }
#pragma unroll
        for (int o = 1; o < 64; o <<= 1) {
#pragma unroll
            for (int rr = 0; rr < 4; ++rr) s[rr] += __shfl_xor(s[rr], o); }
#pragma unroll
        for (int rr = 0; rr < 4; ++rr) {
            const float rstd = 1.0f / sqrtf(s[rr] * (1.0f / DM) + NORM_EPS);
#pragma unroll
            for (int j = 0; j < 4; ++j) {
                const f32x4 o = (v[rr][j] * rstd) * GB[j] + GC[j];
                u32x2 w; w.x = pkbf(o[0], o[1]); w.y = pkbf(o[2], o[3]);
                *(u32x2*)(hx + (size_t)rr * DM + 4 * lane + 256 * j) = w;
            }
        }
    }
}
__device__ __forceinline__ void norm_phase(const KArgs& a, int mode) {
    const int tid = opaque_tid(), lane = tid & 63, wave = tid >> 6;
    const int NGW = gridDim.x * 8;
    unsigned char* ws = a.ws;
    const float* mod = (const float*)(ws + WS_MOD);
    const int lp = (mode == 0) ? 0 : 1;
    bf16_t* HX = (bf16_t*)(ws + WS_HX); const bf16_t* Y0 = (const bf16_t*)(ws + WS_Y); const float* SSQ0 = (const float*)(ws + WS_SSQ);
    const bf16_t* Y1 = (const bf16_t*)(ws + WS_HX); const float* SSQ1 = (const float*)(ws + WS_SSQ1);
    const int gw2 = wave * (int)gridDim.x + (int)blockIdx.x;
    const int nlat = NTOK / 4;
    int curb = -1; f32x4 GA0[4], GA1[4], GB[4], GC[4];
    int base = gw2 * 4, sub = 0, itc = nlat + gw2; bool inctx = false;
    for (;;) {
        int it;
        if (!inctx) { if (base >= nlat) { inctx = true; continue; } it = base + sub; if (++sub == 4) { sub = 0; base += NGW * 4; } }
        else { if (mode == 2 || itc >= nlat + NCTX / 4) break; it = itc; itc += NGW; }
        const int r = it * 4;
        const int b = r < NTOK ? (r >> 13) : 4;
        if (b != curb) { curb = b;
            const float* mp = mod + (lp * 5 + b) * 3072; const float* m0 = mod + (0 * 5 + b) * 3072; const float* m1 = mod + (1 * 5 + b) * 3072;
#pragma unroll
            for (int j = 0; j < 4; ++j) { const int c = 4 * lane + 256 * j;
                GA0[j] = *(const f32x4*)(m0 + 2048 + c) * *(const f32x4*)(a.g_post + c);
                GA1[j] = *(const f32x4*)(m1 + 2048 + c) * *(const f32x4*)(a.g_post + DM + c);
                GB[j] = *(const f32x4*)(a.g_pre + lp * DM + c) * (*(const f32x4*)(mp + 1024 + c) + 1.0f);
                GC[j] = *(const f32x4*)(mp + c); } }
        const float* src = (r < NTOK) ? a.x + (size_t)r * DM : a.ctx + (size_t)(r - NTOK) * DM;
        norm_rows4(mode, lane, src, a.out + (size_t)r * DM, Y0 + (size_t)r * DM, SSQ0 + (size_t)r * 16, Y1 + (size_t)r * DM, SSQ1 + (size_t)r * 16, HX + (size_t)r * DM, GA0, GA1, GB, GC);
    }
}

typedef short v4i16_t __attribute__((ext_vector_type(4)));
__device__ __forceinline__ v4i16_t trrd(const unsigned char* p) { return __builtin_amdgcn_ds_read_tr16_b64_v4i16((LAS v4i16_t*)p); }
__device__ __forceinline__ bf16x8 cat8(v4i16_t lo, v4i16_t hi) { return (bf16x8){lo[0], lo[1], lo[2], lo[3], hi[0], hi[1], hi[2], hi[3]}; }
__device__ __forceinline__ void attn_unit(int u, const bf16_t* P, const bf16_t* Vt, bf16_t* H, const float* sink, unsigned char* lds) {
    const int tid = opaque_tid(), lane = tid & 63, wave = __builtin_amdgcn_readfirstlane(tid >> 6), r32 = lane & 31, hi = lane >> 5;
    const bool isctx = u >= 1024;
    int b, kvh, qb;
    if (isctx) { const int v = u - 1024; b = v >> 3; kvh = (v >> 2) & 1; qb = v & 3; } else { b = u >> 8; kvh = (u >> 7) & 1; qb = u & 127; }
    const int head = kvh * 4 + (wave >> 1);
    const int qtok = qb * 64 + (wave & 1) * 32 + r32;
    const size_t qrow = isctx ? (size_t)(NTOK + b * CTXL + qtok) : (size_t)(b * SEQ + qtok);
    const float sinkv = sink[head];
    unsigned char* qscr = lds + 45056 + wave * 4608;
    u32x4 qld[4];
#pragma unroll
    for (int i4 = 0; i4 < 4; ++i4) qld[i4] = *(const u32x4*)(P + (qrow - r32 + i4 * 8 + (lane >> 3)) * PW + C_Q + head * 64 + (lane & 7) * 8);
    int jlo = 0, jhi = -1;
    if (!isctx) { jlo = qb < 2 ? 2 - qb : 0; jhi = (129 - qb) < 4 ? (129 - qb) : 4; }
    const int ntiles = 4 + (jhi - jlo + 1);
    const int srow = tid >> 3, sch = tid & 7;
    const bf16_t* Kc = P + (size_t)(NTOK + b * CTXL + srow) * PW + C_K + kvh * 64 + sch * 8;
    const bf16_t* Kl = P + (size_t)(b * SEQ + srow) * PW + C_K + kvh * 64 + sch * 8;
    unsigned char* Ks = lds; unsigned char* Vs = lds + 2 * 9216;
    const int vsoff = srow * 192 + sch * 16;
    const int soff = srow * 144 + sch * 16;
    u32x4 kreg, vreg, kreg2, vreg2;
#define ATT_GLOAD(KR, VR, ti_) do { const int t_ = (ti_); \
        if (t_ < 4) { KR = *(const u32x4*)(Kc + (size_t)(64 * t_) * PW); VR = *(const u32x4*)(Kc + (size_t)(64 * t_) * PW + 128); } \
        else { const int kbase_ = qb * 64 - 128 + 64 * (jlo + t_ - 4); KR = *(const u32x4*)(Kl + (size_t)kbase_ * PW); VR = *(const u32x4*)(Kl + (size_t)kbase_ * PW + 128); } } while (0)
    const size_t qrow0 = qrow - r32;
    u32x4 gaw[4];
#pragma unroll
    for (int i4 = 0; i4 < 4; ++i4) gaw[i4] = *(const u32x4*)(P + (qrow0 + i4 * 8 + (lane >> 3)) * PW + C_GA + head * 64 + (lane & 7) * 8);
    ATT_GLOAD(kreg2, vreg2, 0);
    ATT_GLOAD(kreg, vreg, 1);
#pragma unroll
    for (int i4 = 0; i4 < 4; ++i4) *(u32x4*)(qscr + (i4 * 8 + (lane >> 3)) * 144 + (lane & 7) * 16) = qld[i4];
    *(u32x4*)(Ks + soff) = kreg2; *(u32x4*)(Vs + vsoff) = vreg2;
    __syncthreads();
    bf16x8 qf[4];
#pragma unroll
    for (int d0 = 0; d0 < 4; ++d0) qf[d0] = *(const bf16x8*)(qscr + r32 * 144 + (2 * d0 + hi) * 16);
    const float sink2 = sinkv * LOG2E;
    float mref = sink2, lsum = 0.f;
    f32x16 oT[2]; oT[0] = f32x16{}; oT[1] = f32x16{};
    const int qpos = qtok;
    for (int ti = 0; ti < ntiles; ++ti) {
        const int buf = ti & 1;
        if (ti + 2 < ntiles) ATT_GLOAD(kreg2, vreg2, ti + 2);
        const unsigned char* kb = Ks + buf * 9216 + r32 * 144 + hi * 16;
        const unsigned char* vb = Vs + buf * 12288 + (4 * hi + ((lane & 15) >> 2)) * 192 + (16 * ((lane >> 4) & 1) + 4 * (lane & 3)) * 2;
        bf16x8 kf[8];
#pragma unroll
        for (int d0 = 0; d0 < 4; ++d0) { kf[2 * d0] = *(const bf16x8*)(kb + d0 * 32); kf[2 * d0 + 1] = *(const bf16x8*)(kb + 32 * 144 + d0 * 32); }
        f32x16 p0, p1;
#pragma unroll
        for (int r = 0; r < 16; ++r) { p0[r] = -mref; p1[r] = -mref; }
        __builtin_amdgcn_sched_barrier(0);
#pragma unroll
        for (int d0 = 0; d0 < 4; ++d0) { p0 = MFMA32(kf[2 * d0], qf[d0], p0); p1 = MFMA32(kf[2 * d0 + 1], qf[d0], p1); }
        bf16x8 vf[8];
#pragma unroll
        for (int blk = 0; blk < 2; ++blk)
#pragma unroll
            for (int ks = 0; ks < 4; ++ks) vf[blk * 4 + ks] = cat8(trrd(vb + (16 * ks) * 192 + blk * 64), trrd(vb + (16 * ks + 8) * 192 + blk * 64));
        __builtin_amdgcn_sched_barrier(0);
        asm volatile("s_nop 15\n\ts_nop 7" : "+v"(p0), "+v"(p1));
        if (ti >= 4) {
            const int j = jlo + ti - 4; const int kbase = qb * 64 - 128 + 64 * j;
            if (j == 0) {
#pragma unroll
                for (int r = 0; r < 16; ++r) { const int kp = kbase + crow(r, hi); if (kp < qpos - 128) p0[r] = -INFINITY; if (kp + 32 < qpos - 128) p1[r] = -INFINITY; }
            } else if (j == 4) {
#pragma unroll
                for (int r = 0; r < 16; ++r) { const int kp = kbase + crow(r, hi); if (kp > qpos + 128) p0[r] = -INFINITY; if (kp + 32 > qpos + 128) p1[r] = -INFINITY; }
            }
        }
        float rma, rmb;
        asm("v_max3_f32 %0, %1, %2, %3" : "=v"(rma) : "v"(p0[0]), "v"(p0[1]), "v"(p1[0]));
        asm("v_max3_f32 %0, %1, %2, %3" : "=v"(rmb) : "v"(p0[2]), "v"(p0[3]), "v"(p1[1]));
        asm("v_max3_f32 %0, %1, %2, %3" : "=v"(rma) : "v"(rma), "v"(p1[2]), "v"(p1[3]));
#pragma unroll
        for (int r = 4; r < 16; r += 4) {
            asm("v_max3_f32 %0, %1, %2, %3" : "=v"(rma) : "v"(rma), "v"(p0[r]), "v"(p0[r + 1]));
            asm("v_max3_f32 %0, %1, %2, %3" : "=v"(rmb) : "v"(rmb), "v"(p0[r + 2]), "v"(p0[r + 3]));
            asm("v_max3_f32 %0, %1, %2, %3" : "=v"(rma) : "v"(rma), "v"(p1[r]), "v"(p1[r + 1]));
            asm("v_max3_f32 %0, %1, %2, %3" : "=v"(rmb) : "v"(rmb), "v"(p1[r + 2]), "v"(p1[r + 3]));
        }
        float rm; asm("v_max3_f32 %0, %1, %2, %3" : "=v"(rm) : "v"(rma), "v"(rmb), "v"(rmb));
        { const float rmo = __shfl_xor(rm, 32); asm("v_max3_f32 %0, %1, %2, %3" : "=v"(rm) : "v"(rm), "v"(rmo), "v"(rmo)); }
        if (__any(rm > 8.0f)) {
            const float dl = fmaxf(rm, 0.f);
            mref += dl;
            const float f = __builtin_amdgcn_exp2f(-dl);
            lsum *= f;
#pragma unroll
            for (int r = 0; r < 16; ++r) { p0[r] -= dl; p1[r] -= dl; oT[0][r] *= f; oT[1][r] *= f; }
        }
        float ls = 0.f;
#pragma unroll
        for (int r = 0; r < 16; ++r) { p0[r] = __builtin_amdgcn_exp2f(p0[r]); p1[r] = __builtin_amdgcn_exp2f(p1[r]); ls += p0[r] + p1[r]; }
        lsum += ls;
        bf16x8 pf[4]; pf[0] = pack8(p0, 0); pf[1] = pack8(p0, 8); pf[2] = pack8(p1, 0); pf[3] = pack8(p1, 8);
#pragma unroll
        for (int blk = 0; blk < 2; ++blk)
#pragma unroll
            for (int ks = 0; ks < 4; ++ks) oT[blk] = MFMA32(vf[blk * 4 + ks], pf[ks], oT[blk]);
        if (ti + 1 < ntiles) { *(u32x4*)(Ks + (buf ^ 1) * 9216 + soff) = kreg; *(u32x4*)(Vs + (buf ^ 1) * 12288 + vsoff) = vreg; }
        kreg = kreg2; vreg = vreg2;
        __syncthreads();
    }
    lsum += __shfl_xor(lsum, 32);
    lsum += __builtin_amdgcn_exp2f(sink2 - mref);
    const float inv = 1.0f / lsum;
    unsigned char* ow = qscr;
#pragma unroll
    for (int blk = 0; blk < 2; ++blk)
#pragma unroll
        for (int g4 = 0; g4 < 4; ++g4) {
            u32x2 w; w.x = pkbf(oT[blk][4 * g4 + 0] * inv, oT[blk][4 * g4 + 1] * inv); w.y = pkbf(oT[blk][4 * g4 + 2] * inv, oT[blk][4 * g4 + 3] * inv);
            *(u32x2*)(ow + r32 * 144 + (32 * blk + 8 * g4 + 4 * hi) * 2) = w;
        }
    asm volatile("s_waitcnt lgkmcnt(0)" ::: "memory");
#pragma unroll
    for (int i4 = 0; i4 < 4; ++i4) {
        const int rr = i4 * 8 + (lane >> 3), ch = lane & 7;
        const u32x4 ov = *(const u32x4*)(ow + rr * 144 + ch * 16);
        const unsigned ovv[4] = {ov.x, ov.y, ov.z, ov.w}, gvv[4] = {gaw[i4].x, gaw[i4].y, gaw[i4].z, gaw[i4].w};
        u32x4 w;
        unsigned wv[4];
#pragma unroll
        for (int e = 0; e < 4; ++e) wv[e] = pkbf(bf2f(ovv[e] & 0xffffu) * silu_f(bf2f(gvv[e] & 0xffffu)), bf2f(ovv[e] >> 16) * silu_f(bf2f(gvv[e] >> 16)));
        w.x = wv[0]; w.y = wv[1]; w.z = wv[2]; w.w = wv[3];
        *(u32x4*)(H + (qrow0 + rr) * DM + head * 64 + ch * 8) = w;
    }
    asm volatile("s_waitcnt lgkmcnt(0)" ::: "memory");
}

__device__ __forceinline__ void fft1_unit(int u, const bf16_t* P, bf16_t* YF, const unsigned char* ws, unsigned char* lds) {
    const int tid = opaque_tid(), lane = tid & 63, wave = __builtin_amdgcn_readfirstlane(tid >> 6), r32 = lane & 31, hi = lane >> 5;
    const int b = u >> 6, n2 = u & 63;
    constexpr int UPB = 576;
    const bf16_t* src = P + (size_t)(b * SEQ + n2) * PW + C_UF;
#pragma unroll
    for (int i = 0; i < 8; ++i) {
        const int id = tid + NTHREADS * i, n1 = id >> 5, cc = id & 31;
        *(u32x4*)(lds + n1 * UPB + cc * 16) = *(const u32x4*)(src + (size_t)n1 * 64 * PW + cc * 8);
    }
    __syncthreads();
    const bf16_t* T1R = (const bf16_t*)(ws + WS_T1R); const bf16_t* T1I = (const bf16_t*)(ws + WS_T1I);
    f32x16 aR[4], aI[4];
#pragma unroll
    for (int kb = 0; kb < 4; ++kb) { aR[kb] = f32x16{}; aI[kb] = f32x16{}; }
    const unsigned char* ap = lds + (8 * hi + ((lane & 15) >> 2)) * UPB + (32 * wave + 16 * ((lane >> 4) & 1) + 4 * (lane & 3)) * 2;
#pragma unroll 2
    for (int ks = 0; ks < 8; ++ks) {
        const bf16x8 av = cat8(trrd(ap + (16 * ks) * UPB), trrd(ap + (16 * ks + 4) * UPB));
#pragma unroll
        for (int kb = 0; kb < 4; ++kb) {
            const bf16x8 bR = *(const bf16x8*)(T1R + (32 * kb + r32) * 128 + 16 * ks + 8 * hi), bI = *(const bf16x8*)(T1I + (32 * kb + r32) * 128 + 16 * ks + 8 * hi);
            aR[kb] = MFMA32(av, bR, aR[kb]); aI[kb] = MFMA32(av, bI, aI[kb]);
        }
    }
    const float* TW = (const float*)(ws + WS_TW);
#pragma unroll
    for (int kb = 0; kb < 4; ++kb) {
        const int k1 = 32 * kb + r32;
        const float ct = TW[2 * (n2 * k1)], st = TW[2 * (n2 * k1) + 1];
        bf16_t* yp = YF + ((size_t)((b * 128 + k1) * 64 + n2)) * 512 + 32 * wave + 4 * hi;
#pragma unroll
        for (int g4 = 0; g4 < 4; ++g4) {
            float yr[4], yi[4];
#pragma unroll
            for (int e = 0; e < 4; ++e) { const float r_ = aR[kb][4 * g4 + e], i_ = aI[kb][4 * g4 + e]; yr[e] = r_ * ct + i_ * st; yi[e] = i_ * ct - r_ * st; }
            u32x2 wr_, wi_; wr_.x = pkbf(yr[0], yr[1]); wr_.y = pkbf(yr[2], yr[3]); wi_.x = pkbf(yi[0], yi[1]); wi_.y = pkbf(yi[2], yi[3]);
            *(u32x2*)(yp + 8 * g4) = wr_; *(u32x2*)(yp + 256 + 8 * g4) = wi_;
        }
    }
    __syncthreads();
}

template <int KK>
__device__ __forceinline__ void dftf_unit(const bf16_t* srcbase, int R, int pitchA, int pitchB, const bf16_t* Tr, const bf16_t* Ti, const bf16_t* Gt,
                                          const bf16_t* P, bf16_t* H, size_t row0, int rowstride, float oscale, unsigned char* lds) {
    const int tid = opaque_tid(), lane = tid & 63, wave = __builtin_amdgcn_readfirstlane(tid >> 6), r32 = lane & 31, hi = lane >> 5;
    constexpr int ZPB = (KK == 128) ? 576 : 544;
#pragma unroll 1
    for (int i0 = 0; i0 < KK / 16; i0 += 8) {
        u32x4 img[8];
#pragma unroll
        for (int i = 0; i < 8; ++i) { const int id = tid + NTHREADS * (i0 + i), kk = id >> 5, cc = id & 31; img[i] = *(const u32x4*)(srcbase + (size_t)(kk % R) * pitchA + (size_t)(kk / R) * pitchB + cc * 8); }
        __builtin_amdgcn_sched_barrier(0);
#pragma unroll
        for (int i = 0; i < 8; ++i) { const int id = tid + NTHREADS * (i0 + i), kk = id >> 5, cc = id & 31; *(u32x4*)(lds + kk * ZPB + cc * 16) = img[i]; }
        __builtin_amdgcn_sched_barrier(0);
    }
    __syncthreads();
    const int g = wave >> 1, kblk = wave & 1;
    f32x16 XR[2], XI[2];
#pragma unroll
    for (int cb = 0; cb < 2; ++cb) { XR[cb] = f32x16{}; XI[cb] = f32x16{}; }
    const bf16_t* trp = Tr + (size_t)(32 * kblk + r32) * KK + 8 * hi; const bf16_t* tip = Ti + (size_t)(32 * kblk + r32) * KK + 8 * hi;
    const unsigned char* zp = lds + (8 * hi + ((lane & 15) >> 2)) * ZPB + (64 * g + 16 * ((lane >> 4) & 1) + 4 * (lane & 3)) * 2;
#pragma unroll 2
    for (int ks = 0; ks < KK / 16; ++ks) {
        const bf16x8 bR = *(const bf16x8*)(trp + 16 * ks), bI = *(const bf16x8*)(tip + 16 * ks);
#pragma unroll
        for (int cb = 0; cb < 2; ++cb) { const bf16x8 av = cat8(trrd(zp + (16 * ks) * ZPB + cb * 64), trrd(zp + (16 * ks + 4) * ZPB + cb * 64)); XR[cb] = MFMA32(av, bR, XR[cb]); XI[cb] = MFMA32(av, bI, XI[cb]); }
    }
    f32x16 oa[2]; oa[0] = f32x16{}; oa[1] = f32x16{};
    const bf16_t* gp = Gt + (size_t)(g * 2 * 8 * 64 + lane) * 8;
    u32x2 gfw[8];
    { const size_t rowg = row0 + (size_t)(32 * kblk + r32) * rowstride;
#pragma unroll
      for (int i8 = 0; i8 < 8; ++i8) gfw[i8] = *(const u32x2*)(P + rowg * PW + C_GF + 64 * g + 32 * (i8 >> 2) + 8 * (i8 & 3) + 4 * hi); }
#pragma unroll
    for (int part = 0; part < 2; ++part)
#pragma unroll
        for (int cb = 0; cb < 2; ++cb)
#pragma unroll
            for (int s = 0; s < 2; ++s) {
                const bf16x8 bx = pack8(part ? XI[cb] : XR[cb], 8 * s);
                const int kko = part * 64 + 32 * cb + 16 * s;
#pragma unroll
                for (int lb = 0; lb < 2; ++lb) { const bf16x8 ag = *(const bf16x8*)(gp + (size_t)((lb * 8 + (kko >> 4)) * 64) * 8); oa[lb] = MFMA32(ag, bx, oa[lb]); }
            }
    const int k2 = 32 * kblk + r32;
    const size_t row = row0 + (size_t)k2 * rowstride;
    const bf16_t* gfrow = P + row * PW + C_GF + 64 * g;
    bf16_t* hrow = H + row * DM + 512 + 64 * g;
#pragma unroll
    for (int lb = 0; lb < 2; ++lb)
#pragma unroll
        for (int g4 = 0; g4 < 4; ++g4) {
            const int l0 = 32 * lb + 8 * g4 + 4 * hi;
            const u32x2 gw = gfw[lb * 4 + g4];
            const float o0 = oa[lb][4 * g4 + 0] * oscale * silu_f(bf2f(gw.x & 0xffffu)), o1 = oa[lb][4 * g4 + 1] * oscale * silu_f(bf2f(gw.x >> 16));
            const float o2 = oa[lb][4 * g4 + 2] * oscale * silu_f(bf2f(gw.y & 0xffffu)), o3 = oa[lb][4 * g4 + 3] * oscale * silu_f(bf2f(gw.y >> 16));
            u32x2 w; w.x = pkbf(o0, o1); w.y = pkbf(o2, o3);
            *(u32x2*)(hrow + l0) = w;
        }
    __syncthreads();
}

__device__ __forceinline__ void conv_unit(int u, const bf16_t* P, bf16_t* H, const float* cw, const float* cb) {
    const int tid = opaque_tid(), cgp = tid & 31, rg = tid >> 5;
    const int ch0 = cgp * 8;
    const int r0 = u * 64 + rg * 4;
    int pos, len; if (r0 < NTOK) { pos = r0 & (SEQ - 1); len = SEQ; } else { pos = (r0 - NTOK) & (CTXL - 1); len = CTXL; }
    float w0[8], w1[8], w2[8], bs[8];
#pragma unroll
    for (int e = 0; e < 8; ++e) { w0[e] = cw[ch0 + e]; w1[e] = cw[256 + ch0 + e]; w2[e] = cw[512 + ch0 + e]; bs[e] = cb[ch0 + e]; }
    float T[6][8];
#pragma unroll
    for (int i = 0; i < 6; ++i) {
        const int p = pos - 1 + i;
        if (p >= 0 && p < len) {
            const size_t row = (size_t)(r0 - 1 + i);
            const u32x4 z = *(const u32x4*)(P + row * PW + C_ZC + ch0), c = *(const u32x4*)(P + row * PW + C_CC + ch0);
            T[i][0] = bf2f(z.x & 0xffffu) * bf2f(c.x & 0xffffu); T[i][1] = bf2f(z.x >> 16) * bf2f(c.x >> 16);
            T[i][2] = bf2f(z.y & 0xffffu) * bf2f(c.y & 0xffffu); T[i][3] = bf2f(z.y >> 16) * bf2f(c.y >> 16);
            T[i][4] = bf2f(z.z & 0xffffu) * bf2f(c.z & 0xffffu); T[i][5] = bf2f(z.z >> 16) * bf2f(c.z >> 16);
            T[i][6] = bf2f(z.w & 0xffffu) * bf2f(c.w & 0xffffu); T[i][7] = bf2f(z.w >> 16) * bf2f(c.w >> 16);
        } else {
#pragma unroll
            for (int e = 0; e < 8; ++e) T[i][e] = 0.f;
        }
    }
#pragma unroll
    for (int i = 0; i < 4; ++i) {
        const size_t row = (size_t)(r0 + i);
        const u32x4 bw = *(const u32x4*)(P + row * PW + C_BC + ch0), gw = *(const u32x4*)(P + row * PW + C_GC + ch0);
        const unsigned bwv[4] = {bw.x, bw.y, bw.z, bw.w}, gwv[4] = {gw.x, gw.y, gw.z, gw.w};
        float o[8];
#pragma unroll
        for (int e = 0; e < 8; ++e) {
            const float bv = (e & 1) ? bf2f(bwv[e >> 1] >> 16) : bf2f(bwv[e >> 1] & 0xffffu);
            const float gv = (e & 1) ? bf2f(gwv[e >> 1] >> 16) : bf2f(gwv[e >> 1] & 0xffffu);
            const float y = T[i][e] * w0[e] + T[i + 1][e] * w1[e] + T[i + 2][e] * w2[e] + bs[e];
            o[e] = bv * y * silu_f(gv);
        }
        u32x4 w; w.x = pkbf(o[0], o[1]); w.y = pkbf(o[2], o[3]); w.z = pkbf(o[4], o[5]); w.w = pkbf(o[6], o[7]);
        *(u32x4*)(H + row * DM + 768 + ch0) = w;
    }
}

__device__ __forceinline__ void fft1_tables(const unsigned char* ws, unsigned char* tbl, int tid) {
    u32x4 tv[8];
#pragma unroll
    for (int i = 0; i < 8; ++i) { const int id = tid + NTHREADS * i, t = id >> 11, row = (id >> 4) & 127, ch = id & 15; tv[i] = *(const u32x4*)(ws + (t ? WS_T1I : WS_T1R) + row * 256 + ch * 16); }
    __builtin_amdgcn_sched_barrier(0);
#pragma unroll
    for (int i = 0; i < 8; ++i) { const int id = tid + NTHREADS * i, t = id >> 11, row = (id >> 4) & 127, ch = id & 15; *(u32x4*)(tbl + t * 34816 + row * 272 + ch * 16) = tv[i]; }
}
__device__ __forceinline__ void fft1_wave(int task, const bf16_t* P, bf16_t* YF, const unsigned char* ws, unsigned char* lds_w, const unsigned char* tbl, int lane, int pmode = 0) {
    const int r32 = lane & 31, hi = lane >> 5;
    const int cblk = task & 7, n2 = (task >> 3) & 63, b = task >> 9;
    const bf16_t* src = P + (size_t)((b * 64 + n2) * 128) * 256 + 32 * cblk + 8 * (lane & 3);
    { u32x4 img[8];
#pragma unroll
      for (int i = 0; i < 8; ++i) img[i] = *(const u32x4*)(src + (size_t)(16 * i + (lane >> 2)) * 256);
      __builtin_amdgcn_sched_barrier(0);
#pragma unroll
      for (int i = 0; i < 8; ++i) *(u32x4*)(lds_w + (16 * i + (lane >> 2)) * 64 + (lane & 3) * 16) = img[i];
      __builtin_amdgcn_sched_barrier(0); }
    asm volatile("s_waitcnt vmcnt(0) lgkmcnt(0)" ::: "memory");
    if (pmode == 2) return;
    const bf16_t* T1R = (const bf16_t*)(ws + WS_T1R); const bf16_t* T1I = (const bf16_t*)(ws + WS_T1I);
    f32x16 aR[4], aI[4];
#pragma unroll
    for (int kb = 0; kb < 4; ++kb) { aR[kb] = f32x16{}; aI[kb] = f32x16{}; }
    const unsigned char* ap = lds_w + (8 * hi + ((lane & 15) >> 2)) * 64 + (16 * ((lane >> 4) & 1) + 4 * (lane & 3)) * 2;
    const unsigned char* tb = tbl + r32 * 272 + hi * 16;
#pragma unroll 2
    for (int ks = 0; ks < 8; ++ks) {
        const bf16x8 av = cat8(trrd(ap + (16 * ks) * 64), trrd(ap + (16 * ks + 4) * 64));
        bf16x8 bq[8];
#pragma unroll
        for (int kb = 0; kb < 4; ++kb) { bq[2 * kb] = *(const bf16x8*)(tb + (32 * kb) * 272 + 32 * ks); bq[2 * kb + 1] = *(const bf16x8*)(tb + 34816 + (32 * kb) * 272 + 32 * ks); }
#pragma unroll
        for (int kb = 0; kb < 4; ++kb) { aR[kb] = MFMA32(av, bq[2 * kb], aR[kb]); aI[kb] = MFMA32(av, bq[2 * kb + 1], aI[kb]); }
    }
    const float* TW = (const float*)(ws + WS_TW);
    float ctw[4], stw[4];
#pragma unroll
    for (int kb = 0; kb < 4; ++kb) { const int k1 = 32 * kb + r32; ctw[kb] = TW[2 * (n2 * k1)]; stw[kb] = TW[2 * (n2 * k1) + 1]; }
    asm volatile("s_waitcnt lgkmcnt(0)" ::: "memory");
#pragma unroll
    for (int pr = 0; pr < 2; ++pr) {
#pragma unroll
        for (int kq = 0; kq < 2; ++kq) {
            const int kb = 2 * pr + kq; const int rowl = 32 * kq + r32; const float ct = ctw[kb], st = stw[kb];
#pragma unroll
            for (int g4 = 0; g4 < 4; ++g4) {
                float yr[4], yi[4];
#pragma unroll
                for (int e = 0; e < 4; ++e) { const float r_ = aR[kb][4 * g4 + e], i_ = aI[kb][4 * g4 + e]; yr[e] = r_ * ct + i_ * st; yi[e] = i_ * ct - r_ * st; }
                u32x2 wr_, wi_; wr_.x = pkbf(yr[0], yr[1]); wr_.y = pkbf(yr[2], yr[3]); wi_.x = pkbf(yi[0], yi[1]); wi_.y = pkbf(yi[2], yi[3]);
                *(u32x2*)(lds_w + rowl * 128 + ((g4 ^ (rowl & 7)) * 16) + hi * 8) = wr_;
                *(u32x2*)(lds_w + rowl * 128 + (((4 + g4) ^ (rowl & 7)) * 16) + hi * 8) = wi_;
            }
        }
        asm volatile("s_waitcnt lgkmcnt(0)" ::: "memory");
#pragma unroll
        for (int i8 = 0; i8 < 8; ++i8) {
            const int rowl = i8 * 8 + (lane >> 3), ch = lane & 7;
            const u32x4 v = *(const u32x4*)(lds_w + rowl * 128 + ((ch ^ (rowl & 7)) * 16));
            const int k1 = 64 * pr + rowl;
            bf16_t* dst = YF + ((size_t)((b * 128 + k1) * 64 + n2)) * 512 + (ch >> 2) * 256 + 32 * cblk + 8 * (ch & 3);
            *(u32x4*)dst = v;
        }
        asm volatile("s_waitcnt lgkmcnt(0)" ::: "memory");
    }
}
__device__ __forceinline__ void fft3_wave(int task, const bf16_t* YF, const bf16_t* Gt, const bf16_t* P, bf16_t* H, const unsigned char* ws, unsigned char* lds_w, int lane) {
    const int r32 = lane & 31, hi = lane >> 5;
    const int g = task & 3, k1 = (task >> 2) & 127, b = task >> 9;
    const bf16_t* src = YF + ((size_t)(b * 128 + k1) * 64) * 512 + 64 * g + 8 * (lane & 7);
    { u32x4 img[16];
#pragma unroll
      for (int i = 0; i < 16; ++i) { const int kk = 8 * i + (lane >> 3); img[i] = *(const u32x4*)(src + (size_t)(kk & 63) * 512 + (size_t)(kk >> 6) * 256); }
      __builtin_amdgcn_sched_barrier(0);
#pragma unroll
      for (int i = 0; i < 16; ++i) { const int kk = 8 * i + (lane >> 3), ch = lane & 7; *(u32x4*)(lds_w + kk * 128 + ((ch ^ (((kk >> 1) & 1) << 2)) * 16)) = img[i]; }
      __builtin_amdgcn_sched_barrier(0); }
    asm volatile("s_waitcnt vmcnt(0) lgkmcnt(0)" ::: "memory");
    const bf16_t* T3R = (const bf16_t*)(ws + WS_T3R); const bf16_t* T3I = (const bf16_t*)(ws + WS_T3I);
    const int q = (lane & 15) >> 2, sw = (q >> 1) & 1;
    const int chl = 2 * ((lane >> 4) & 1) + ((lane & 3) >> 1);
    const unsigned char* zb = lds_w + (8 * hi + q) * 128 + 8 * (lane & 1);
    const unsigned char* zp0 = zb + ((chl ^ (sw << 2)) * 16);
    const unsigned char* zp1 = zb + (((4 + chl) ^ (sw << 2)) * 16);
    const bf16_t* gp = Gt + (size_t)(g * 2 * 8 * 64 + lane) * 8;
    const size_t rowb = (size_t)(b * SEQ + k1);
    u32x2 hwA[8], hwB[8];
#pragma unroll
    for (int i8 = 0; i8 < 8; ++i8) { hwA[i8] = (u32x2){0u, 0u}; hwB[i8] = (u32x2){0u, 0u}; }
#pragma unroll 1
    for (int kblk = 0; kblk < 2; ++kblk) {
        f32x16 XR[2], XI[2];
#pragma unroll
        for (int cb = 0; cb < 2; ++cb) { XR[cb] = f32x16{}; XI[cb] = f32x16{}; }
        const bf16_t* trp = T3R + (size_t)(kblk * 8 * 64 + lane) * 8; const bf16_t* tip = T3I + (size_t)(kblk * 8 * 64 + lane) * 8;
        const size_t rowg = rowb + (size_t)(32 * kblk + r32) * 128;
        u32x2 gfw[8];
#pragma unroll
        for (int i8 = 0; i8 < 8; ++i8) gfw[i8] = *(const u32x2*)(P + rowg * PW + C_GF + 64 * g + 32 * (i8 >> 2) + 8 * (i8 & 3) + 4 * hi);
        bf16x8 bR[8], bI[8];
#pragma unroll
        for (int ks = 0; ks < 8; ++ks) { bR[ks] = *(const bf16x8*)(trp + 512 * ks); bI[ks] = *(const bf16x8*)(tip + 512 * ks); }
        __builtin_amdgcn_sched_barrier(0);
#pragma unroll
        for (int ks = 0; ks < 8; ++ks) {
            const bf16x8 a0 = cat8(trrd(zp0 + (16 * ks) * 128), trrd(zp0 + (16 * ks + 4) * 128));
            const bf16x8 a1 = cat8(trrd(zp1 + (16 * ks) * 128), trrd(zp1 + (16 * ks + 4) * 128));
            XR[0] = MFMA32(a0, bR[ks], XR[0]); XI[0] = MFMA32(a0, bI[ks], XI[0]); XR[1] = MFMA32(a1, bR[ks], XR[1]); XI[1] = MFMA32(a1, bI[ks], XI[1]);
        }
        __builtin_amdgcn_sched_barrier(0);
        bf16x8 gfr[2][8];
#pragma unroll
        for (int lb = 0; lb < 2; ++lb)
#pragma unroll
            for (int q8 = 0; q8 < 8; ++q8) gfr[lb][q8] = *(const bf16x8*)(gp + (size_t)((lb * 8 + q8) * 64) * 8);
        __builtin_amdgcn_sched_barrier(0);
        f32x16 oa[2]; oa[0] = f32x16{}; oa[1] = f32x16{};
#pragma unroll
        for (int part = 0; part < 2; ++part)
#pragma unroll
            for (int cb = 0; cb < 2; ++cb)
#pragma unroll
                for (int s = 0; s < 2; ++s) {
                    const bf16x8 bx = pack8(part ? XI[cb] : XR[cb], 8 * s);
                    const int kko = part * 64 + 32 * cb + 16 * s;
#pragma unroll
                    for (int lb = 0; lb < 2; ++lb) oa[lb] = MFMA32(gfr[lb][kko >> 4], bx, oa[lb]);
                }
#pragma unroll
        for (int lb = 0; lb < 2; ++lb)
#pragma unroll
            for (int g4 = 0; g4 < 4; ++g4) {
                const u32x2 gw = gfw[lb * 4 + g4];
                const float o0 = oa[lb][4 * g4 + 0] * silu_f(bf2f(gw.x & 0xffffu)), o1 = oa[lb][4 * g4 + 1] * silu_f(bf2f(gw.x >> 16));
                const float o2 = oa[lb][4 * g4 + 2] * silu_f(bf2f(gw.y & 0xffffu)), o3 = oa[lb][4 * g4 + 3] * silu_f(bf2f(gw.y >> 16));
                u32x2 pk; pk.x = pkbf(o0, o1); pk.y = pkbf(o2, o3);
                if (kblk == 0) hwA[lb * 4 + g4] = pk; else hwB[lb * 4 + g4] = pk;
            }
    }
    asm volatile("s_waitcnt lgkmcnt(0)" ::: "memory");
#pragma unroll
    for (int kblk = 0; kblk < 2; ++kblk)
#pragma unroll
        for (int lb = 0; lb < 2; ++lb)
#pragma unroll
            for (int g4 = 0; g4 < 4; ++g4) { const int rowl = 32 * kblk + r32;
                *(u32x2*)(lds_w + rowl * 128 + (((4 * lb + g4) ^ (rowl & 7)) * 16) + hi * 8) = kblk ? hwB[lb * 4 + g4] : hwA[lb * 4 + g4]; }
    asm volatile("s_waitcnt lgkmcnt(0)" ::: "memory");
#pragma unroll
    for (int i8 = 0; i8 < 8; ++i8) {
        const int rowl = i8 * 8 + (lane >> 3), ch = lane & 7;
        const u32x4 v = *(const u32x4*)(lds_w + rowl * 128 + ((ch ^ (rowl & 7)) * 16));
        *(u32x4*)(H + (rowb + (size_t)rowl * 128) * DM + 512 + 64 * g + 8 * ch) = v;
    }
    asm volatile("s_waitcnt lgkmcnt(0)" ::: "memory");
}
__device__ __forceinline__ void conv_wave(int task, const bf16_t* P, bf16_t* H, const float* cw, const float* cb, int lane) {
    const int cgp = lane & 31, ch0 = cgp * 8;
    const int r0 = task * 8 + (lane >> 5) * 4;
    int pos, len; if (r0 < NTOK) { pos = r0 & (SEQ - 1); len = SEQ; } else { pos = (r0 - NTOK) & (CTXL - 1); len = CTXL; }
    u32x4 zz[6], cc[6], bb[4], gg[4]; float okf[6];
#pragma unroll
    for (int i = 0; i < 6; ++i) { const int p = pos - 1 + i; const bool ok = p >= 0 && p < len; okf[i] = ok ? 1.f : 0.f; const size_t row = (size_t)(ok ? r0 - 1 + i : r0);
        zz[i] = *(const u32x4*)(P + row * PW + C_ZC + ch0); cc[i] = *(const u32x4*)(P + row * PW + C_CC + ch0); }
#pragma unroll
    for (int i = 0; i < 4; ++i) { const size_t row = (size_t)(r0 + i); bb[i] = *(const u32x4*)(P + row * PW + C_BC + ch0); gg[i] = *(const u32x4*)(P + row * PW + C_GC + ch0); }
    __builtin_amdgcn_sched_barrier(0);
    float w0[8], w1[8], w2[8], bs[8];
    { const f32x4 a0 = *(const f32x4*)(cw + ch0), a1 = *(const f32x4*)(cw + ch0 + 4), b0 = *(const f32x4*)(cw + 256 + ch0), b1 = *(const f32x4*)(cw + 256 + ch0 + 4);
      const f32x4 c0 = *(const f32x4*)(cw + 512 + ch0), c1 = *(const f32x4*)(cw + 512 + ch0 + 4), d0 = *(const f32x4*)(cb + ch0), d1 = *(const f32x4*)(cb + ch0 + 4);
#pragma unroll
      for (int e = 0; e < 4; ++e) { w0[e] = a0[e]; w0[4 + e] = a1[e]; w1[e] = b0[e]; w1[4 + e] = b1[e]; w2[e] = c0[e]; w2[4 + e] = c1[e]; bs[e] = d0[e]; bs[4 + e] = d1[e]; } }
    float T[6][8];
#pragma unroll
    for (int i = 0; i < 6; ++i) {
        const unsigned zv[4] = {zz[i].x, zz[i].y, zz[i].z, zz[i].w}, cv[4] = {cc[i].x, cc[i].y, cc[i].z, cc[i].w};
#pragma unroll
        for (int e = 0; e < 8; ++e) T[i][e] = okf[i] * ((e & 1) ? bf2f(zv[e >> 1] >> 16) : bf2f(zv[e >> 1] & 0xffffu)) * ((e & 1) ? bf2f(cv[e >> 1] >> 16) : bf2f(cv[e >> 1] & 0xffffu));
    }
#pragma unroll
    for (int i = 0; i < 4; ++i) {
        const size_t row = (size_t)(r0 + i);
        const unsigned bwv[4] = {bb[i].x, bb[i].y, bb[i].z, bb[i].w}, gwv[4] = {gg[i].x, gg[i].y, gg[i].z, gg[i].w};
        float o[8];
#pragma unroll
        for (int e = 0; e < 8; ++e) {
            const float bv = (e & 1) ? bf2f(bwv[e >> 1] >> 16) : bf2f(bwv[e >> 1] & 0xffffu);
            const float gv = (e & 1) ? bf2f(gwv[e >> 1] >> 16) : bf2f(gwv[e >> 1] & 0xffffu);
            const float y = T[i][e] * w0[e] + T[i + 1][e] * w1[e] + T[i + 2][e] * w2[e] + bs[e];
            o[e] = bv * y * silu_f(gv);
        }
        u32x4 w; w.x = pkbf(o[0], o[1]); w.y = pkbf(o[2], o[3]); w.z = pkbf(o[4], o[5]); w.w = pkbf(o[6], o[7]);
        *(u32x4*)(H + row * DM + 768 + ch0) = w;
    }
}

#define XB_TMO      128
#define XB_XCNT(j)  (256  + 64 * (j))
#define XB_XSUB(j)  (1280 + 64 * (j))
#define XB_XGEN(j)  (2304 + 64 * (j))
#define XB_TOP      3328
#define XB_TOPGEN   3392
#define XCD_BAR_WORDS 3456
#define XB_SPIN_CAP (1u << 18)

__device__ __forceinline__ unsigned xb_ld(unsigned* p)              { return __hip_atomic_load(p, __ATOMIC_RELAXED, __HIP_MEMORY_SCOPE_AGENT); }
__device__ __forceinline__ unsigned xb_add(unsigned* p, unsigned v) { return __hip_atomic_fetch_add(p, v, __ATOMIC_RELAXED, __HIP_MEMORY_SCOPE_AGENT); }
__device__ __forceinline__ unsigned xb_xcc_id() { return (unsigned)__builtin_amdgcn_s_getreg((3 << 11) | 20) & 0xFu; }
#define XB_SPIN(cond, bar) do { unsigned _sp = 0; while (cond) { __builtin_amdgcn_s_sleep(1); \
    if ((++_sp & 255u) == 0u) { if (xb_ld(&(bar)[XB_TMO])) break; if (_sp > XB_SPIN_CAP) { atomicAdd(&(bar)[XB_TMO], 1u); break; } } } } while (0)

struct XcdBarrier {
    unsigned* bar; unsigned x;
    volatile LAS unsigned* st;
};

__device__ __forceinline__ XcdBarrier xcd_barrier_post(unsigned* bar, volatile LAS unsigned* st) {
    XcdBarrier b; b.bar = bar; b.x = xb_xcc_id(); b.st = st;
    if (threadIdx.x == 0) (void)xb_add(&bar[XB_XCNT(b.x)], 1u);
    return b;
}
__device__ __forceinline__ void xcd_barrier_complete(unsigned* bar, unsigned x, unsigned& nloc, unsigned& nx) {
    const unsigned G = gridDim.x * gridDim.y * gridDim.z;
    unsigned sum, cnt, mine, sp = 0u;
    for (;;) {
        sum = 0u; cnt = 0u; mine = 0u;
#pragma unroll
        for (unsigned j = 0; j < 16; ++j) { const unsigned c = xb_ld(&bar[XB_XCNT(j)]); sum += c; cnt += (c > 0u) ? 1u : 0u; mine = (j == x) ? c : mine; }
        if (sum == G) break;
        __builtin_amdgcn_s_sleep(1);
        if ((++sp & 255u) == 0u) { if (xb_ld(&bar[XB_TMO])) break; if (sp > XB_SPIN_CAP) { atomicAdd(&bar[XB_TMO], 1u); break; } }
    }
    nloc = mine > 0u ? mine : 1u; nx = cnt > 0u ? cnt : 1u;
}

__device__ __forceinline__ void xcd_barrier(const XcdBarrier& b) {
    asm volatile("s_waitcnt vmcnt(0)" ::: "memory");
    __syncthreads();
    if (threadIdx.x == 0) {
        unsigned* bar = b.bar;
        __builtin_amdgcn_s_waitcnt(0);
        unsigned nloc = b.st[0], nx = b.st[1];
        if (nloc == 0u) { xcd_barrier_complete(bar, b.x, nloc, nx); b.st[0] = nloc; b.st[1] = nx; }
        const unsigned old = xb_add(&bar[XB_XSUB(b.x)], 1u);
        const unsigned gen = old / nloc;
        if (old + 1u == (gen + 1u) * nloc) {
            __builtin_amdgcn_fence(__ATOMIC_RELEASE, "agent");
            asm volatile("s_waitcnt vmcnt(0)" ::: "memory");
            const unsigned og = xb_add(&bar[XB_TOP], 1u);
            const unsigned tg = og / nx;
            if (og + 1u == (tg + 1u) * nx) xb_add(&bar[XB_TOPGEN], 1u);
            else XB_SPIN(xb_ld(&bar[XB_TOPGEN]) == tg, bar);
            __builtin_amdgcn_fence(__ATOMIC_ACQUIRE, "agent");
            xb_add(&bar[XB_XGEN(b.x)], 1u);
            asm volatile("s_waitcnt vmcnt(0)" ::: "memory");
        } else {
            XB_SPIN(xb_ld(&bar[XB_XGEN(b.x)]) == gen, bar);
            __builtin_amdgcn_fence(__ATOMIC_ACQUIRE, "agent");
            asm volatile("s_waitcnt vmcnt(0)" ::: "memory");
        }
    }
    __syncthreads();
}

__device__ __forceinline__ int next_unit(unsigned* ctr, unsigned char* lds) {
    volatile int* sw = (volatile int*)(lds + LDS_SCHED);
    if (threadIdx.x == 0) *sw = (int)atomicAdd(ctr, 1u);
    __syncthreads();
    const int u = *sw;
    __syncthreads();
    return u;
}

__global__ void __launch_bounds__(NTHREADS, 2) hybrid_fwd(KArgs a) {
    extern __shared__ __attribute__((aligned(16))) unsigned char lds[];
    cg::grid_group grid = cg::this_grid();
    unsigned char* ws = a.ws;
    const int lo = a.ph_lo, hi = a.ph_hi;
#ifndef PHMASK
#define PHMASK 0xfff
#endif
#define IN(k) (((PHMASK >> ((k) > 5 && (k) < 11 ? (k) - 5 : (k))) & 1) && lo <= (k) && (k) < hi)
#define SEAM(k) do { if (IN(k) && IN((k) + 1)) xcd_barrier(xbar); } while (0)
#ifndef REP_PHASE
#define REP_PHASE -1
#endif
#define REPS(j) for (int rep = 0, nrep = (REP_PHASE == (j)) ? 2 : 1; rep < nrep; ++rep, (rep < nrep ? xcd_barrier(xbar) : (void)0))
    bf16_t* HX = (bf16_t*)(ws + WS_HX); bf16_t* Pb = (bf16_t*)(ws + WS_P); bf16_t* Vt = (bf16_t*)(ws + WS_VT); bf16_t* Hb = (bf16_t*)(ws + WS_H);
    bf16_t* Yb = (bf16_t*)(ws + WS_Y); bf16_t* YF = (bf16_t*)(ws + WS_YF); float* SSQ = (float*)(ws + WS_SSQ);
    unsigned* ctl = (unsigned*)(ws + WS_CTL);

    if (threadIdx.x < 2) ((volatile LAS unsigned*)(lds + LDS_BARST))[threadIdx.x] = 0u;
    __syncthreads();
    const XcdBarrier xbar = xcd_barrier_post((unsigned*)(ws + WS_BAR), (volatile LAS unsigned*)(lds + LDS_BARST));
    if (a.ph_lo < 0) grid.sync();
    REPS(30) if (IN(0)) p0_prologue(a, lds);
    SEAM(0);
    for (int l = 0; l < 2; ++l) {
        const int pb = 1 + 5 * l;
        REPS(0) if (IN(pb)) norm_phase(a, l);
        SEAM(pb);
        REPS(1) if (IN(pb + 1)) {
            pg8::Gemm g{HX, (const bf16_t*)(ws + WS_WIN) + (size_t)l * PW * DM, MROWS, PW, DM};
            pg8::StaticOrder S; S.init(MROWS, PW, (int)gridDim.x, (int)blockIdx.x);
            pg8::EpiProj E{Pb, Vt, (const float*)(ws + WS_ROPE), (bf16_t*)(ws + WS_UFP), 0.125f * LOG2E};
            pg8::gemm_phase<pg8::EpiProj, pg8::StaticOrder, true, true>((PG8_LAS unsigned char*)lds, g, S, E);
        }
        SEAM(pb + 1);
        for (int rep = 0, nrep = (REP_PHASE >= 20 && REP_PHASE < 30) ? 2 : 1; rep < nrep; ++rep, (rep < nrep ? xcd_barrier(xbar) : (void)0)) if (IN(pb + 2)) {
            const int nAttn = (l == 0) ? 1056 : 1024, nCtxF = (l == 0) ? 16 : 0, nF1 = 256, nConv = ((l == 0) ? MROWS : NTOK) / 64;
            const int e0 = nF1, e1 = e0 + nCtxF, e2 = e1 + nAttn, e3 = e2 + nConv;
            for (;;) {
                const int u = next_unit(ctl + 2 * l + 8 * rep, lds);
                if (u >= e3) break;
                if (rep == 1) { const int ty = u < e0 ? 1 : u < e1 ? 3 : u < e2 ? 0 : 2; if (REP_PHASE == 25 ? (ty == 0) : (ty != REP_PHASE - 20)) continue; }
                if (u >= e1 && u < e2) attn_unit(u - e1, Pb, Vt, Hb, a.sink + 8 * l, lds);
                else if (u >= e0 && u < e1) { const int v = u - e0, b = v >> 2, kb = v & 3;
                    dftf_unit<256>(Pb + (size_t)(NTOK + b * CTXL) * PW + C_UF, 256, PW, 0, (const bf16_t*)(ws + WS_T256R) + (size_t)(64 * kb) * 256, (const bf16_t*)(ws + WS_T256I) + (size_t)(64 * kb) * 256,
                                   (const bf16_t*)(ws + WS_GT) + (size_t)l * 4 * 64 * 128, Pb, Hb, (size_t)(NTOK + b * CTXL + 64 * kb), 1, 5.656854249492381f, lds); }
                else {
                    const int tid = opaque_tid(), lane = tid & 63, wave = __builtin_amdgcn_readfirstlane(tid >> 6);
                    if (u < e0) { fft1_tables(ws, lds + 65536, tid); __syncthreads(); fft1_wave(u * 8 + wave, (const bf16_t*)(ws + WS_UFP), YF, ws, lds + wave * 8192, lds + 65536, lane); }
                    else conv_wave((u - e2) * 8 + wave, Pb, Hb, a.conv_w + l * 768, a.conv_b + l * 256, lane);
                }
            }
        }
        SEAM(pb + 2);
        REPS(3) if (IN(pb + 3)) {
            const bool gemmwg = (l == 0 && blockIdx.x < 16);
            if (gemmwg) {
                pg8::Gemm g{Hb + (size_t)NTOK * DM, (const bf16_t*)(ws + WS_WOUT) + (size_t)l * DM * DM, NCTX, DM, DM};
                pg8::StaticOrder S; S.init(NCTX, DM, 16, (int)blockIdx.x);
                pg8::EpiY E{Yb + (size_t)NTOK * DM, SSQ + (size_t)NTOK * 16};
                pg8::gemm_phase<pg8::EpiY, pg8::StaticOrder, true, true>((PG8_LAS unsigned char*)lds, g, S, E);
            } else {
                const int tid = opaque_tid(), lane = tid & 63, wave = __builtin_amdgcn_readfirstlane(tid >> 6);
                const int nb0 = (l == 0) ? 16 : 0;
                const int gw = ((int)blockIdx.x - nb0) + wave * ((int)gridDim.x - nb0), NGW = ((int)gridDim.x - nb0) * 8;
                unsigned char* lds_w = lds + wave * 16384;
                for (int t = gw; t < 2048; t += NGW) fft3_wave(t, YF, (const bf16_t*)(ws + WS_GT) + (size_t)l * 4 * 64 * 128, Pb, Hb, ws, lds_w, lane);
            }
            __syncthreads();
        }
        SEAM(pb + 3);
        REPS(4) if (IN(pb + 4)) {
            pg8::Gemm g{Hb, (const bf16_t*)(ws + WS_WOUT) + (size_t)l * DM * DM, NTOK, DM, DM};
            pg8::StaticOrder S; S.init(NTOK, DM, (int)gridDim.x, (int)blockIdx.x);
            pg8::EpiY E{l == 0 ? Yb : HX, l == 0 ? SSQ : (float*)(ws + WS_SSQ1)};
            pg8::gemm_phase<pg8::EpiY, pg8::StaticOrder, true, true>((PG8_LAS unsigned char*)lds, g, S, E);
        }
        SEAM(pb + 4);
    }
#if REP_PHASE == 9
    for (int i = 0; i < 10; ++i) xcd_barrier(xbar);
#endif
    if (IN(11)) norm_phase(a, 2);
#undef IN
#undef SEAM
}

#ifndef MK_MULTI
#define MK_MULTI 0
#endif
extern "C" void kernel_launch(void* const* d_in, const int* in_sizes, int n_in, void* d_out, int out_size, void* d_ws, size_t ws_size, hipStream_t stream) {
    static int grid = 0;
    if (grid == 0) {
        if (n_in != 14 || ws_size < WS_END) { fprintf(stderr, "kernel_launch: unexpected n_in %d or ws_size %zu (need %zu)\n", n_in, ws_size, (size_t)WS_END); grid = -1; return; }
        int dev = 0, cus = 0, per_cu = 0;
        hipGetDevice(&dev); hipDeviceGetAttribute(&cus, hipDeviceAttributeMultiprocessorCount, dev);
        if (hipFuncSetAttribute((const void*)hybrid_fwd, hipFuncAttributeMaxDynamicSharedMemorySize, LDS_BYTES) != hipSuccess) { fprintf(stderr, "kernel_launch: hipFuncSetAttribute failed\n"); grid = -1; return; }
        if (hipOccupancyMaxActiveBlocksPerMultiprocessor(&per_cu, (const void*)hybrid_fwd, NTHREADS, LDS_BYTES) != hipSuccess || per_cu < 1) { fprintf(stderr, "kernel_launch: occupancy query gave %d\n", per_cu); per_cu = 1; }
        (void)hipGetLastError();
        grid = cus * 1;
        fprintf(stderr, "kernel_launch: grid %d (cus %d, per_cu %d)\n", grid, cus, per_cu);
    }
    if (grid < 0) return;
    if (hipMemsetAsync((char*)d_ws + WS_CTL, 0, WS_ZERO_BYTES, stream) != hipSuccess) { fprintf(stderr, "kernel_launch: hipMemsetAsync failed\n"); return; }
    KArgs a{};
    a.x = (const float*)d_in[0]; a.c = (const float*)d_in[1]; a.ctx = (const float*)d_in[2]; a.c_ctx = (const float*)d_in[3]; a.w_mod = (const float*)d_in[4]; a.b_mod = (const float*)d_in[5];
    a.g_pre = (const float*)d_in[6]; a.g_post = (const float*)d_in[7]; a.w_in = (const float*)d_in[8]; a.w_out = (const float*)d_in[9]; a.sink = (const float*)d_in[10]; a.w_f = (const float*)d_in[11];
    a.conv_w = (const float*)d_in[12]; a.conv_b = (const float*)d_in[13];
    a.out = (float*)d_out; a.ws = (unsigned char*)d_ws;
#if MK_MULTI
    for (int ph = 0; ph < 12; ++ph) { a.ph_lo = ph; a.ph_hi = ph + 1; hipLaunchKernelGGL(hybrid_fwd, dim3(grid), dim3(NTHREADS), LDS_BYTES, stream, a); }
#else
    a.ph_lo = 0; a.ph_hi = 12;
    void* args[] = {&a};
    hipError_t e = hipLaunchCooperativeKernel((const void*)hybrid_fwd, dim3(grid), dim3(NTHREADS), args, LDS_BYTES, stream);
    if (e != hipSuccess) fprintf(stderr, "kernel_launch: cooperative launch failed: %s (grid %d)\n", hipGetErrorString(e), grid);
#endif
}
```

```cpp
#include <hip/hip_runtime.h>
#include <hip/hip_cooperative_groups.h>
#include <cstdio>
#include <cstdint>
namespace cg = cooperative_groups;
namespace pg8 {
#define PG8_LAS __attribute__((address_space(3)))
typedef unsigned short bf16_t;
typedef short bf16x8 __attribute__((ext_vector_type(8)));
typedef float f32x4 __attribute__((ext_vector_type(4)));
typedef unsigned u32x4 __attribute__((ext_vector_type(4)));
constexpr int BM = 256, BK = 64, HALF = 128, HTB = HALF * BK * 2  , STAGE_BYTES = 8 * HTB, NXCD = 8, WGM = 8;

__host__ __device__ __forceinline__ int lds_byte(int r, int c) { const int st = (r >> 4) * 2 + (c >> 5), rr = r & 15, cc = c & 31, ob = rr * 64 + cc * 2; return st * 1024 + (ob ^ (((ob >> 9) & 1) << 5)); }
__host__ __device__ __forceinline__ void stage_rc(int b, int& R, int& C) { const int st = b / 1024, sb = b % 1024, swz = sb ^ (((sb >> 9) & 1) << 5); R = (st >> 1) * 16 + swz / 64; C = (st & 1) * 32 + (swz % 64) / 2; }
__host__ __device__ __forceinline__ int perm32(int rho) { const int n = rho >> 4, i = rho & 15; return 8 * (i >> 2) + 4 * n + (i & 3); }

struct Unit { int pm, pn; };
struct Gemm { const bf16_t* A; const bf16_t* Bt; int M, N, K; };

struct StaticOrder {
    int nM, nN, nwg, G, c;
    __host__ __device__ void init(int M, int N, int G_, int c_) { nM = M / BM; nN = N / BM; nwg = nM * nN; G = G_; c = c_; }
    __host__ __device__ bool next(int i, Unit& u) const {
        const long L = (long)i * G + c; if (L >= nwg) return false;
        int wgid = (int)L; { const int q = nwg / NXCD, r = nwg % NXCD, xcd = wgid % NXCD, off = wgid / NXCD; wgid = (xcd < r ? xcd * (q + 1) : r * (q + 1) + (xcd - r) * q) + off; }
        const int nig = WGM * nN, gid = wgid / nig, fm = gid * WGM, gsz = (nM - fm) < WGM ? (nM - fm) : WGM;
        u.pm = fm + ((wgid % nig) % gsz); u.pn = (wgid % nig) / gsz; return true;
    }
    __device__ __forceinline__ void a_ready(const Unit&) const {}
    __device__ __forceinline__ void done(const Unit&) const {}
};

__device__ __forceinline__ unsigned cvt_pk_bf16(float lo, float hi) { unsigned r; asm volatile("v_cvt_pk_bf16_f32 %0, %1, %2" : "=v"(r) : "v"(lo), "v"(hi)); return r; }
typedef unsigned u32x2 __attribute__((ext_vector_type(2)));
__device__ __forceinline__ int swap23(int t) { return (t & ~12) | ((t & 4) << 1) | ((t & 8) >> 1); }
struct EpiProj {
    static constexpr bool PERM = true, AFTER_DRAIN = false;
    bf16_t* P; bf16_t* Vt; const float* rope; bf16_t* UFP; float qscale;
    __device__ __forceinline__ void operator()(const f32x4 (&acc)[2][2][4][2], const Unit& u, int wr, int wc, int fr, int fq) const {
        const int row0 = u.pm * BM + wr * 64 + fr;
        const int pn = u.pn;
        const bool ctxrow = u.pm >= 128;
        f32x4 CS[2][4], SN[2][4];
        if (pn <= 2) {
#pragma unroll
            for (int ai = 0; ai < 2; ++ai)
#pragma unroll
                for (int m = 0; m < 4; ++m) {
                    CS[ai][m] = (f32x4){1.f, 1.f, 1.f, 1.f}; SN[ai][m] = (f32x4){0.f, 0.f, 0.f, 0.f};
                    if (!ctxrow) { const int t = (row0 + ai * HALF + m * 16) & 8191; const int pos = (wc & 1) ? (t & 63) : (t >> 6);
                        CS[ai][m] = *(const f32x4*)(rope + pos * 32 + 4 * fq); SN[ai][m] = *(const f32x4*)(rope + pos * 32 + 16 + 4 * fq); }
                }
            __builtin_amdgcn_sched_barrier(0);
        }
#pragma unroll
        for (int ai = 0; ai < 2; ++ai)
#pragma unroll
            for (int m = 0; m < 4; ++m) {
                const int row = row0 + ai * HALF + m * 16;
                bf16_t* rowp = P + (size_t)row * 2816 + pn * BM + wc * 32 + 8 * fq;
                if (pn == 5 && !ctxrow) { const int t = row & 8191; rowp = UFP + ((size_t)(((row >> 13) * 64 + (t & 63)) * 128 + (t >> 6))) * 256 + wc * 32 + 8 * fq; }
                if (pn > 2) {
#pragma unroll
                    for (int bj = 0; bj < 2; ++bj) { const f32x4 v0 = acc[ai][bj][m][0], v1 = acc[ai][bj][m][1];
                        u32x4 w; w.x = cvt_pk_bf16(v0[0], v0[1]); w.y = cvt_pk_bf16(v0[2], v0[3]); w.z = cvt_pk_bf16(v1[0], v1[1]); w.w = cvt_pk_bf16(v1[2], v1[3]);
                        *(u32x4*)(rowp + bj * HALF) = w; }
                } else {
                    const f32x4 cs = CS[ai][m], sn = SN[ai][m];
#pragma unroll
                    for (int bj = 0; bj < 2; ++bj) {
                        f32x4 v0 = acc[ai][bj][m][0], v1 = acc[ai][bj][m][1];
                        if (pn == 2 && bj == 1) {
                            u32x4 w; w.x = cvt_pk_bf16(v0[0], v0[1]); w.y = cvt_pk_bf16(v0[2], v0[3]); w.z = cvt_pk_bf16(v1[0], v1[1]); w.w = cvt_pk_bf16(v1[2], v1[3]);
                            *(u32x4*)(rowp + bj * HALF) = w;
                        } else {
                            const f32x4 r0 = v0 * cs - v1 * sn, r1 = v0 * sn + v1 * cs;
                            v0 = r0; v1 = r1;
                            if (pn < 2) { v0 = v0 * qscale; v1 = v1 * qscale; }
                            u32x4 w; w.x = cvt_pk_bf16(v0[0], v0[1]); w.y = cvt_pk_bf16(v0[2], v0[3]); w.z = cvt_pk_bf16(v1[0], v1[1]); w.w = cvt_pk_bf16(v1[2], v1[3]);
                            *(u32x4*)(rowp + bj * HALF) = w;
                        }
                    }
                }
            }
    }
};
struct EpiY {
    static constexpr bool PERM = true, AFTER_DRAIN = false;
    bf16_t* Y; float* ssq;
    __device__ __forceinline__ void operator()(const f32x4 (&acc)[2][2][4][2], const Unit& u, int wr, int wc, int fr, int fq) const {
        const int row0 = u.pm * BM + wr * 64 + fr;
#pragma unroll
        for (int ai = 0; ai < 2; ++ai)
#pragma unroll
            for (int m = 0; m < 4; ++m) {
                const int row = row0 + ai * HALF + m * 16;
                bf16_t* rowp = Y + (size_t)row * 1024 + u.pn * BM + wc * 32 + 8 * fq;
                float s = 0.f;
#pragma unroll
                for (int bj = 0; bj < 2; ++bj) { const f32x4 v0 = acc[ai][bj][m][0], v1 = acc[ai][bj][m][1];
                    s += (v0[0] * v0[0] + v0[1] * v0[1]) + (v0[2] * v0[2] + v0[3] * v0[3]) + (v1[0] * v1[0] + v1[1] * v1[1]) + (v1[2] * v1[2] + v1[3] * v1[3]);
                    u32x4 w; w.x = cvt_pk_bf16(v0[0], v0[1]); w.y = cvt_pk_bf16(v0[2], v0[3]); w.z = cvt_pk_bf16(v1[0], v1[1]); w.w = cvt_pk_bf16(v1[2], v1[3]);
                    *(u32x4*)(rowp + bj * HALF) = w; }
                s += __shfl_xor(s, 16); s += __shfl_xor(s, 32);
                if (fq == 0) ssq[(size_t)row * 16 + u.pn * 4 + wc] = s;
            }
    }
};
template <class Epi, class Sched, bool ALIGN_EPI = false, bool SP2 = false>
__device__ __forceinline__ void gemm_phase(PG8_LAS unsigned char* lds, const Gemm g, const Sched& S, const Epi& E) {
    int tid_ = threadIdx.x; asm volatile("" : "+v"(tid_));
    const int tid = tid_, wid = __builtin_amdgcn_readfirstlane(tid >> 6), lane = tid & 63, wr = wid >> 2, wc = wid & 3, fr = lane & 15, fq = lane >> 4;
    const int K = g.K, nt = K / BK;
    unsigned voffA[2], voffB[2];
#pragma unroll
    for (int i = 0; i < 2; ++i) { int R, C; stage_rc(tid * 16 + i * 8192, R, C); const int Rb = Epi::PERM ? ((R & ~31) + perm32(R & 31)) : R;
        voffA[i] = (unsigned)(R * K + C) * 2u; voffB[i] = (unsigned)(Rb * K + C) * 2u; }
    const size_t kstep = (size_t)(BK * 2);
    const size_t hstep = (size_t)HALF * K * 2;
    const size_t tstep = 2 * hstep;
    const unsigned ldsw = (unsigned)wid * 1024u;
    const int aoff = lds_byte(wr * 64 + fr, fq * 8), boff = lds_byte(wc * 32 + fr, fq * 8);
#define PG8_SA(b, h) (((b) * 2 + (h)) * HTB)
#define PG8_SB(b, h) ((4 + (b) * 2 + (h)) * HTB)
#define PG8_STAGE(bufoff, gbase, voff) do { _Pragma("unroll") for (int _i = 0; _i < 2; ++_i) \
        __builtin_amdgcn_global_load_lds((const unsigned*)((const char*)(gbase) + (voff)[_i]), (PG8_LAS unsigned*)(lds + (bufoff) + ldsw + _i * 8192), 16, 0, 0); } while (0)
#define PG8_LDA(dst, b, h) do { _Pragma("unroll") for (int m = 0; m < 4; ++m) _Pragma("unroll") for (int k = 0; k < 2; ++k) dst[m][k] = *(const PG8_LAS bf16x8*)(lds + PG8_SA(b, h) + aoff + m * 2048 + k * 1024); } while (0)
#define PG8_LDB(dst, b, h) do { _Pragma("unroll") for (int n = 0; n < 2; ++n) _Pragma("unroll") for (int k = 0; k < 2; ++k) dst[n][k] = *(const PG8_LAS bf16x8*)(lds + PG8_SB(b, h) + boff + n * 2048 + k * 1024); } while (0)
#define PG8_MMA(ai, bj, At, Bt) do { __builtin_amdgcn_s_setprio(1); _Pragma("unroll") for (int m = 0; m < 4; ++m) _Pragma("unroll") for (int n = 0; n < 2; ++n) _Pragma("unroll") for (int k = 0; k < 2; ++k) \
        acc[ai][bj][m][n] = __builtin_amdgcn_mfma_f32_16x16x32_bf16(Bt[n][k], At[m][k], acc[ai][bj][m][n], 0, 0, 0); __builtin_amdgcn_s_setprio(0); } while (0)
#define PG8_WAIT_V(n) asm volatile("s_waitcnt vmcnt(" #n ")" ::: "memory")
#define PG8_WAIT_L(n) asm volatile("s_waitcnt lgkmcnt(" #n ")" ::: "memory")
#define PG8_BAR __builtin_amdgcn_s_barrier()
#define PG8_SCHED __builtin_amdgcn_sched_barrier(0)
    Unit cur, nxt; int ui = 0;
    if (!S.next(0, cur)) return;
    f32x4 acc[2][2][4][2];
#pragma unroll
    for (int a = 0; a < 2; ++a)
#pragma unroll
        for (int b = 0; b < 2; ++b)
#pragma unroll
            for (int m = 0; m < 4; ++m)
#pragma unroll
                for (int n = 0; n < 2; ++n) acc[a][b][m][n] = (f32x4){0.f, 0.f, 0.f, 0.f};
    bf16x8 At[4][2], B0[2][2], B1[2][2];
    const char* cA = (const char*)g.A + (size_t)cur.pm * tstep; const char* cB = (const char*)g.Bt + (size_t)cur.pn * tstep;
    S.a_ready(cur);
    if constexpr (SP2) {
        PG8_STAGE(PG8_SB(0, 0), cB, voffB); PG8_STAGE(PG8_SB(0, 1), cB + hstep, voffB); PG8_STAGE(PG8_SA(0, 0), cA, voffA); PG8_STAGE(PG8_SA(0, 1), cA + hstep, voffA);
        if (wr == 1) PG8_BAR;
        PG8_WAIT_V(2); PG8_BAR;
        PG8_STAGE(PG8_SB(1, 0), cB + kstep, voffB); PG8_STAGE(PG8_SA(1, 0), cA + kstep, voffA); PG8_STAGE(PG8_SB(1, 1), cB + hstep + kstep, voffB);
        PG8_WAIT_V(6); PG8_BAR;
    } else {
        PG8_STAGE(PG8_SB(0, 0), cB, voffB); PG8_STAGE(PG8_SA(0, 0), cA, voffA); PG8_STAGE(PG8_SB(0, 1), cB + hstep, voffB); PG8_STAGE(PG8_SA(0, 1), cA + hstep, voffA);
        if (wr == 1) PG8_BAR;
        PG8_WAIT_V(4); PG8_BAR;
        PG8_STAGE(PG8_SB(1, 0), cB + kstep, voffB); PG8_STAGE(PG8_SA(1, 0), cA + kstep, voffA); PG8_STAGE(PG8_SB(1, 1), cB + hstep + kstep, voffB);
        PG8_WAIT_V(6); PG8_BAR;
    }
    for (;;) {
        const bool has_next = S.next(ui + 1, nxt);
        const char* nA = has_next ? (const char*)g.A + (size_t)nxt.pm * tstep : cA; const char* nB = has_next ? (const char*)g.Bt + (size_t)nxt.pn * tstep : cB;
        for (int t = 0; t < nt; t += 2) {
            const bool last = (t == nt - 2);
            const char* a1 = cA + (size_t)(t + 1) * kstep;
            const char* a2 = last ? nA : cA + (size_t)(t + 2) * kstep; const char* b2 = last ? nB : cB + (size_t)(t + 2) * kstep;
            const char* a3 = a2 + kstep; const char* b3 = b2 + kstep;
            if (last && has_next) S.a_ready(nxt);
            if constexpr (SP2) {
            PG8_LDB(B0, 0, 0); PG8_LDB(B1, 0, 1); PG8_SCHED; PG8_LDA(At, 0, 0); PG8_STAGE(PG8_SA(1, 1), a1 + hstep, voffA);
            PG8_WAIT_V(8); PG8_WAIT_L(0); PG8_BAR; PG8_MMA(0, 0, At, B0); PG8_MMA(0, 1, At, B1); PG8_BAR; PG8_SCHED;
            PG8_LDA(At, 0, 1); PG8_STAGE(PG8_SB(0, 0), b2, voffB); PG8_STAGE(PG8_SB(0, 1), b2 + hstep, voffB); PG8_STAGE(PG8_SA(0, 0), a2, voffA);
            PG8_WAIT_V(8); PG8_WAIT_L(0); PG8_BAR; PG8_MMA(1, 0, At, B0); PG8_MMA(1, 1, At, B1); PG8_BAR; PG8_SCHED;
            PG8_LDB(B0, 1, 0); PG8_LDB(B1, 1, 1); PG8_SCHED; PG8_LDA(At, 1, 0); PG8_STAGE(PG8_SA(0, 1), a2 + hstep, voffA);
            PG8_WAIT_V(8); PG8_WAIT_L(0); PG8_BAR; PG8_MMA(0, 0, At, B0); PG8_MMA(0, 1, At, B1); PG8_BAR; PG8_SCHED;
            PG8_LDA(At, 1, 1); PG8_STAGE(PG8_SB(1, 0), b3, voffB); PG8_STAGE(PG8_SB(1, 1), b3 + hstep, voffB); PG8_STAGE(PG8_SA(1, 0), a3, voffA);
            PG8_WAIT_V(8); PG8_WAIT_L(0); PG8_BAR; PG8_MMA(1, 0, At, B0); PG8_MMA(1, 1, At, B1); PG8_BAR; PG8_SCHED;
            } else {
            PG8_LDB(B0, 0, 0); PG8_SCHED; PG8_LDA(At, 0, 0); PG8_STAGE(PG8_SA(1, 1), a1 + hstep, voffA);
            PG8_WAIT_L(8); PG8_BAR; PG8_WAIT_L(0); PG8_MMA(0, 0, At, B0); PG8_BAR; PG8_SCHED;
            PG8_LDB(B1, 0, 1); PG8_STAGE(PG8_SB(0, 0), b2, voffB);
            PG8_BAR; PG8_WAIT_L(0); PG8_MMA(0, 1, At, B1); PG8_BAR;
            PG8_LDA(At, 0, 1); PG8_STAGE(PG8_SA(0, 0), a2, voffA);
            PG8_BAR; PG8_WAIT_L(0); PG8_MMA(1, 0, At, B0); PG8_BAR; PG8_SCHED;
            PG8_STAGE(PG8_SB(0, 1), b2 + hstep, voffB);
            PG8_WAIT_V(6); PG8_BAR; PG8_MMA(1, 1, At, B1); PG8_BAR;
            PG8_LDB(B0, 1, 0); PG8_SCHED; PG8_LDA(At, 1, 0); PG8_STAGE(PG8_SA(0, 1), a2 + hstep, voffA);
            PG8_WAIT_L(8); PG8_BAR; PG8_WAIT_L(0); PG8_MMA(0, 0, At, B0); PG8_BAR; PG8_SCHED;
            PG8_LDB(B1, 1, 1); PG8_STAGE(PG8_SB(1, 0), b3, voffB);
            PG8_BAR; PG8_WAIT_L(0); PG8_MMA(0, 1, At, B1); PG8_BAR;
            PG8_LDA(At, 1, 1); PG8_STAGE(PG8_SA(1, 0), a3, voffA);
            PG8_BAR; PG8_WAIT_L(0); PG8_MMA(1, 0, At, B0); PG8_BAR; PG8_SCHED;
            PG8_STAGE(PG8_SB(1, 1), b3 + hstep, voffB);
            PG8_WAIT_V(6); PG8_BAR; PG8_MMA(1, 1, At, B1); PG8_BAR;
            }
        }
        if constexpr (ALIGN_EPI) { if (wr == 0) PG8_BAR; }
        if constexpr (!Epi::AFTER_DRAIN) { E(acc, cur, wr, wc, fr, fq); S.done(cur); }
        if (!has_next) break;
#pragma unroll
        for (int a = 0; a < 2; ++a)
#pragma unroll
            for (int b = 0; b < 2; ++b)
#pragma unroll
                for (int m = 0; m < 4; ++m)
#pragma unroll
                    for (int n = 0; n < 2; ++n) acc[a][b][m][n] = (f32x4){0.f, 0.f, 0.f, 0.f};
        cur = nxt; cA = nA; cB = nB; ++ui;
        if constexpr (ALIGN_EPI) { if (wr == 1) PG8_BAR; }
    }
    PG8_WAIT_V(0);
    if constexpr (!ALIGN_EPI) { if (wr == 0) PG8_BAR; }
    PG8_BAR;
    if constexpr (Epi::AFTER_DRAIN) { E.fused(acc, cur, wr, wc, fr, fq, lds, wid, lane); S.done(cur); }
#undef PG8_SA
#undef PG8_SB
#undef PG8_STAGE
#undef PG8_LDA
#undef PG8_LDB
#undef PG8_MMA
#undef PG8_WAIT_V
#undef PG8_WAIT_L
#undef PG8_BAR
#undef PG8_SCHED
}
}

typedef unsigned short bf16_t;
typedef short bf16x8 __attribute__((ext_vector_type(8)));
typedef float f32x4 __attribute__((ext_vector_type(4)));
typedef float f32x16 __attribute__((ext_vector_type(16)));
typedef unsigned u32x4 __attribute__((ext_vector_type(4)));
typedef unsigned u32x2 __attribute__((ext_vector_type(2)));
#define LAS __attribute__((address_space(3)))
__device__ __forceinline__ int opaque_tid() { int t = threadIdx.x; asm volatile("" : "+v"(t)); return t; }

constexpr int DM = 1024, NBATCH = 4, SEQ = 8192, NTOK = NBATCH * SEQ, CTXL = 256, NCTX = NBATCH * CTXL, MROWS = NTOK + NCTX;
constexpr int PW = 2816;
constexpr int C_Q = 0, C_K = 512, C_V = 640, C_GA = 768, C_UF = 1280, C_GF = 1536, C_ZC = 1792, C_BC = 2048, C_CC = 2304, C_GC = 2560;
constexpr int VT_PITCH = SEQ + CTXL;
constexpr float NORM_EPS = 1e-6f;
constexpr float LOG2E = 1.4426950408889634f;

constexpr size_t KiB = 1024, MiB = 1u << 20;
constexpr size_t WS_CTL = 0;
constexpr size_t WS_BAR = 16 * KiB;
constexpr size_t WS_ZERO_BYTES = 32 * KiB;
constexpr size_t WS_MOD = 64 * KiB;
constexpr size_t WS_ROPE = 256 * KiB;
constexpr size_t WS_TW = 320 * KiB;
constexpr size_t WS_T1R = 384 * KiB, WS_T1I = 416 * KiB;
constexpr size_t WS_T3R = 448 * KiB, WS_T3I = 464 * KiB;
constexpr size_t WS_T256R = 512 * KiB, WS_T256I = 640 * KiB;
constexpr size_t WS_GT = 768 * KiB;
constexpr size_t WS_SSQ = 1 * MiB;
constexpr size_t WS_WIN = 4 * MiB;
constexpr size_t WS_WOUT = 16 * MiB;
constexpr size_t WS_SSQ1 = 24 * MiB;
constexpr size_t WS_MODP = 28 * MiB;
constexpr size_t WS_HX = 32 * MiB;
constexpr size_t WS_P = 112 * MiB;
constexpr size_t WS_VT = 304 * MiB;
constexpr size_t WS_H = 320 * MiB;
constexpr size_t WS_Y = 392 * MiB;
constexpr size_t WS_YF = 464 * MiB;
constexpr size_t WS_CTX1 = 100 * MiB;
constexpr size_t WS_UFP = 496 * MiB;
constexpr size_t WS_END = 512 * MiB;
static_assert(WS_BAR + 3456 * 4 <= WS_ZERO_BYTES && WS_MODP + (size_t)2 * 8 * 5 * 3072 * 4 <= WS_HX && WS_SSQ + (size_t)MROWS * 16 * 4 <= WS_WIN && WS_WIN + (size_t)2 * PW * DM * 2 <= WS_WOUT && WS_HX + (size_t)MROWS * DM * 2 <= WS_P && WS_P + (size_t)MROWS * PW * 2 <= WS_VT &&
              WS_VT + (size_t)8 * 64 * VT_PITCH * 2 <= WS_H && WS_H + (size_t)MROWS * DM * 2 <= WS_Y && WS_Y + (size_t)MROWS * DM * 2 <= WS_YF && WS_YF + (size_t)4 * 128 * 64 * 512 * 2 <= WS_UFP && WS_UFP + (size_t)NTOK * 256 * 2 <= WS_END && WS_HX + (size_t)MROWS * DM * 2 <= WS_CTX1 && WS_CTX1 + (size_t)NCTX * DM * 4 <= WS_P, "ws map");

constexpr int LDS_BYTES = 147456;
constexpr int LDS_SCHED = LDS_BYTES - 64;
constexpr int LDS_BARST = LDS_BYTES - 32;
constexpr int NTHREADS = 512;

__device__ __forceinline__ float bf2f(unsigned h) { return __uint_as_float(h << 16); }
__device__ __forceinline__ unsigned pkbf(float lo, float hi) { unsigned r; asm volatile("v_cvt_pk_bf16_f32 %0, %1, %2" : "=v"(r) : "v"(lo), "v"(hi)); return r; }
__device__ __forceinline__ float silu_f(float x) { return x * __builtin_amdgcn_rcpf(1.f + __builtin_amdgcn_exp2f(-x * LOG2E)); }
__device__ __forceinline__ float wave_sum(float v) {
#pragma unroll
    for (int o = 1; o < 64; o <<= 1) v += __shfl_xor(v, o);
    return v;
}
__device__ __forceinline__ int swap23(int t) { return (t & ~12) | ((t & 4) << 1) | ((t & 8) >> 1); }
__device__ __forceinline__ int crow(int r, int hi) { return (r & 3) + 8 * (r >> 2) + 4 * hi; }
__device__ __forceinline__ bf16x8 pack8(const f32x16& p, int base) {
    u32x4 w; w.x = pkbf(p[base + 0], p[base + 1]); w.y = pkbf(p[base + 2], p[base + 3]); w.z = pkbf(p[base + 4], p[base + 5]); w.w = pkbf(p[base + 6], p[base + 7]);
    return __builtin_bit_cast(bf16x8, w);
}
#define MFMA32(a, b, c) __builtin_amdgcn_mfma_f32_32x32x16_bf16((a), (b), (c), 0, 0, 0)

struct KArgs {
    const float *x, *c, *ctx, *c_ctx, *w_mod, *b_mod, *g_pre, *g_post, *w_in, *w_out, *sink, *w_f, *conv_w, *conv_b;
    float* out; unsigned char* ws; int ph_lo, ph_hi;
};

__device__ __forceinline__ int prow_qk(int n) { return (n & ~31) | (8 * ((n >> 2) & 3) + 4 * ((n >> 4) & 1) + (n & 3)); }
__device__ __forceinline__ void p0_transpose_item(const float* W, int K, int N, bf16_t* WT, int nperm, float* scr, int item, int lane) {
    const int nblk = N / 32, kb = item / nblk, nb = item % nblk, k0 = 64 * kb, n0 = 32 * nb;
    { float wv[32];
#pragma unroll
      for (int i = 0; i < 32; ++i) wv[i] = W[(size_t)(k0 + 2 * i + (lane >> 5)) * N + n0 + (lane & 31)];
      __builtin_amdgcn_sched_barrier(0);
#pragma unroll
      for (int i = 0; i < 32; ++i) scr[(2 * i + (lane >> 5)) * 33 + (lane & 31)] = wv[i];
      __builtin_amdgcn_sched_barrier(0); }
    asm volatile("s_waitcnt lgkmcnt(0)" ::: "memory");
    const int c = lane & 7;
#pragma unroll
    for (int j = 0; j < 4; ++j) { const int n = (lane >> 3) + 8 * j; const float* s = scr + (8 * c) * 33 + n;
        u32x4 o; o.x = pkbf(s[0 * 33], s[1 * 33]); o.y = pkbf(s[2 * 33], s[3 * 33]); o.z = pkbf(s[4 * 33], s[5 * 33]); o.w = pkbf(s[6 * 33], s[7 * 33]);
        const int nl = n0 + n; const int np = nl < nperm ? prow_qk(nl) : nl;
        *(u32x4*)(WT + (size_t)np * K + k0 + 8 * c) = o; }
    asm volatile("s_waitcnt lgkmcnt(0)" ::: "memory");
}

__device__ __forceinline__ void p0_mod_gemv(const KArgs& a, int item, float* ldsf) {
    const int tid = opaque_tid(), lane = tid & 63, wave = tid >> 6;
    const int l = item / 96, col0 = (item % 96) * 32;
    float* s = ldsf;
    float* red = ldsf + 5 * 1024;
    for (int i = tid; i < 5 * 1024; i += NTHREADS) { const int bb = i >> 10, k = i & 1023; const float v = bb < 4 ? a.c[bb * 1024 + k] : a.c_ctx[k]; s[i] = v / (1.f + __expf(-v)); }
    __syncthreads();
    const int col = lane & 31, kh = lane >> 5;
    const float* W = a.w_mod + (size_t)l * 1024 * 3072 + (size_t)(wave * 128 + kh) * 3072 + col0 + col;
    float w[64];
#pragma unroll
    for (int i = 0; i < 64; ++i) w[i] = W[(size_t)(2 * i) * 3072];
    float acc[5] = {0.f, 0.f, 0.f, 0.f, 0.f};
#pragma unroll
    for (int i = 0; i < 64; ++i)
#pragma unroll
        for (int bb = 0; bb < 5; ++bb) acc[bb] += w[i] * s[bb * 1024 + wave * 128 + 2 * i + kh];
#pragma unroll
    for (int bb = 0; bb < 5; ++bb) red[((wave * 2 + kh) * 5 + bb) * 32 + col] = acc[bb];
    __syncthreads();
    if (tid < 160) { const int bb = tid >> 5, cc = tid & 31; float v = a.b_mod[l * 3072 + col0 + cc];
#pragma unroll
        for (int ww = 0; ww < 16; ++ww) v += red[(ww * 5 + bb) * 32 + cc];
        ((float*)(a.ws + WS_MOD))[(l * 5 + bb) * 3072 + col0 + cc] = v; }
    __syncthreads();
}

__device__ __forceinline__ void p0_prologue(const KArgs& a, unsigned char* lds) {
    const int tid = opaque_tid(), lane = tid & 63, wave = tid >> 6;
    const int G = gridDim.x, bx = blockIdx.x;
    unsigned char* ws = a.ws;
    if (bx < 192) p0_mod_gemv(a, bx, (float*)lds);
    {
        float* scr = (float*)(lds + wave * 16384);
        const int gw = bx * 8 + wave, NGW = G * 8;
        constexpr int I_IN = (DM / 64) * (PW / 32), I_OUT = (DM / 64) * (DM / 32);
        constexpr int NIT = 2 * (I_IN + I_OUT);
        for (int it = gw; it < NIT; it += NGW) {
            int r = it; const int l = r / (I_IN + I_OUT); r -= l * (I_IN + I_OUT);
            if (r < I_IN) p0_transpose_item(a.w_in + (size_t)l * DM * PW, DM, PW, (bf16_t*)(ws + WS_WIN) + (size_t)l * PW * DM, 640, scr, r, lane);
            else p0_transpose_item(a.w_out + (size_t)l * DM * DM, DM, DM, (bf16_t*)(ws + WS_WOUT) + (size_t)l * DM * DM, 0, scr, r - I_IN, lane);
        }
    }
    const int gt = bx * NTHREADS + tid, NGT = G * NTHREADS;
    for (int i = gt; i < 128 * 16; i += NGT) {
        const int pos = i >> 4, f = i & 15; const float inv = powf(10000.0f, -(float)f / 16.0f); const float ang = (float)pos * inv;
        float* rp = (float*)(ws + WS_ROPE) + pos * 32; rp[f] = cosf(ang); rp[16 + f] = sinf(ang);
    }
    for (int i = gt; i < 8192; i += NGT) { float sn, cs; sincospif((float)i * (2.0f / 8192.0f), &sn, &cs); float* t = (float*)(ws + WS_TW) + 2 * i; t[0] = cs; t[1] = sn; }
    for (int i = gt; i < 128 * 128; i += NGT) { const int k = i >> 7, n = i & 127; float sn, cs; sincospif((float)((k * n) & 127) * (2.0f / 128.0f), &sn, &cs);
        ((bf16_t*)(ws + WS_T1R))[i] = (bf16_t)(pkbf(cs, 0.f) & 0xffffu); ((bf16_t*)(ws + WS_T1I))[i] = (bf16_t)(pkbf(-sn, 0.f) & 0xffffu); }
    for (int i = gt; i < 64 * 128; i += NGT) { const int k = i >> 7, kk = i & 127, n = kk & 63; float sn, cs; sincospif((float)((k * n) & 63) * (2.0f / 64.0f), &sn, &cs);
        const float tr = kk < 64 ? cs : sn, ti = kk < 64 ? -sn : cs;
        const int fpos = ((((k >> 5) * 8 + (kk >> 4)) * 64 + ((k & 31) + 32 * ((kk >> 3) & 1))) * 8) + (kk & 7);
        ((bf16_t*)(ws + WS_T3R))[fpos] = (bf16_t)(pkbf(tr, 0.f) & 0xffffu); ((bf16_t*)(ws + WS_T3I))[fpos] = (bf16_t)(pkbf(ti, 0.f) & 0xffffu); }
    for (int i = gt; i < 256 * 256; i += NGT) { const int k = i >> 8, n = i & 255; float sn, cs; sincospif((float)((k * n) & 255) * (2.0f / 256.0f), &sn, &cs);
        ((bf16_t*)(ws + WS_T256R))[i] = (bf16_t)(pkbf(cs, 0.f) & 0xffffu); ((bf16_t*)(ws + WS_T256I))[i] = (bf16_t)(pkbf(-sn, 0.f) & 0xffffu); }
    {
        __syncthreads();
        float* trig = (float*)lds;
        if (tid < 64) { float sn, cs; sincospif((float)tid * (2.0f / 64.0f), &sn, &cs); trig[tid] = cs; trig[64 + tid] = sn; }
        __syncthreads();
        for (int i = gt; i < 2 * 4 * 64 * 128; i += NGT) {
            const int kk = i & 127, d = (i >> 7) & 63, g = (i >> 13) & 3, l = i >> 15; const int part = kk >> 6, c = swap23(kk & 63);
            const float* wf = a.w_f + ((size_t)(l * 4 + g) * 64) * 64 + d; float sacc = 0.f;
            float wfv[64];
#pragma unroll
            for (int j = 0; j < 64; ++j) wfv[j] = wf[j * 64];
            __builtin_amdgcn_sched_barrier(0);
#pragma unroll
            for (int j = 0; j < 64; ++j) sacc += trig[part * 64 + ((c * j) & 63)] * wfv[j];
            const int gpos = ((((((l * 4 + g) * 2 + (d >> 5)) * 8 + (kk >> 4)) * 64) + ((d & 31) + 32 * ((kk >> 3) & 1))) * 8) + (kk & 7);
            ((bf16_t*)(ws + WS_GT))[gpos] = (bf16_t)(pkbf(sacc * (1.0f / 724.0773439350246f), 0.f) & 0xffffu);
        }
        __syncthreads();
    }
}

__device__ __forceinline__ void norm_rows4(int mode, int lane, const float* src, float* dst, const bf16_t* y0, const float* ssq0, const bf16_t* y1, const float* ssq1, bf16_t* hx,
                                           const f32x4 (&GA0)[4], const f32x4 (&GA1)[4], const f32x4 (&GB)[4], const f32x4 (&GC)[4]) {
    f32x4 v[4][4];
#pragma unroll
    for (int rr = 0; rr < 4; ++rr)
#pragma unroll
        for (int j = 0; j < 4; ++j) v[rr][j] = __builtin_nontemporal_load((const f32x4*)(src + (size_t)rr * DM + 4 * lane + 256 * j));
    if (mode != 0) {
        u32x2 yw[4][4], yx[4][4]; float p[4], p1[4];
#pragma unroll
        for (int rr = 0; rr < 4; ++rr) { p[rr] = ssq0[rr * 16 + (lane & 15)];
#pragma unroll
            for (int j = 0; j < 4; ++j) yw[rr][j] = __builtin_nontemporal_load((const u32x2*)(y0 + (size_t)rr * DM + 4 * lane + 256 * j)); }
        if (mode == 2) {
#pragma unroll
            for (int rr = 0; rr < 4; ++rr) { p1[rr] = ssq1[rr * 16 + (lane & 15)];
#pragma unroll
                for (int j = 0; j < 4; ++j) yx[rr][j] = __builtin_nontemporal_load((const u32x2*)(y1 + (size_t)rr * DM + 4 * lane + 256 * j)); }
        }
#pragma unroll
        for (int rr = 0; rr < 4; ++rr) {
            float q = p[rr]; q += __shfl_xor(q, 1); q += __shfl_xor(q, 2); q += __shfl_xor(q, 4); q += __shfl_xor(q, 8);
            const float rstd = 1.0f / sqrtf(q * (1.0f / DM) + NORM_EPS);
#pragma unroll
            for (int j = 0; j < 4; ++j) {
                f32x4 yy; yy[0] = bf2f(yw[rr][j].x & 0xffffu); yy[1] = bf2f(yw[rr][j].x >> 16); yy[2] = bf2f(yw[rr][j].y & 0xffffu); yy[3] = bf2f(yw[rr][j].y >> 16);
                v[rr][j] = v[rr][j] + GA0[j] * (yy * rstd);
            }
        }
        if (mode == 2) {
#pragma unroll
            for (int rr = 0; rr < 4; ++rr) {
                float q = p1[rr]; q += __shfl_xor(q, 1); q += __shfl_xor(q, 2); q += __shfl_xor(q, 4); q += __shfl_xor(q, 8);
                const float rstd = 1.0f / sqrtf(q * (1.0f / DM) + NORM_EPS);
#pragma unroll
                for (int j = 0; j < 4; ++j) {
                    f32x4 yy; yy[0] = bf2f(yx[rr][j].x & 0xffffu); yy[1] = bf2f(yx[rr][j].x >> 16); yy[2] = bf2f(yx[rr][j].y & 0xffffu); yy[3] = bf2f(yx[rr][j].y >> 16);
                    v[rr][j] = v[rr][j] + GA1[j] * (yy * rstd);
                    __builtin_nontemporal_store(v[rr][j], (f32x4*)(dst + (size_t)rr * DM + 4 * lane + 256 * j));
                }
            }
        }
    }
    if (mode != 2) {
        float s[4];
#pragma unroll
        for (int rr = 0; rr < 4; ++rr) { float t = 0.f;
#pragma unroll
            for (int j = 0; j < 4; ++j) t += (v[rr][j][0] * v[rr][j][0] + v[rr][j][1] * v[rr][j][1]) + (v[rr][j][2] * v[rr][j][2] + v[rr][j][3] * v[rr][j][3]);
            s[rr] = t; }
#pragma unroll
        for (int o = 1; o < 64; o <<= 1) {
#pragma unroll
            for (int rr = 0; rr < 4; ++rr) s[rr] += __shfl_xor(s[rr], o); }
#pragma unroll
        for (int rr = 0; rr < 4; ++rr) {
            const float rstd = 1.0f / sqrtf(s[rr] * (1.0f / DM) + NORM_EPS);
#pragma unroll
            for (int j = 0; j < 4; ++j) {
                const f32x4 o = (v[rr][j] * rstd) * GB[j] + GC[j];
                u32x2 w; w.x = pkbf(o[0], o[1]); w.y = pkbf(o[2], o[3]);
                *(u32x2*)(hx + (size_t)rr * DM + 4 * lane + 256 * j) = w;
            }
        }
    }
}
__device__ __forceinline__ void norm_phase(const KArgs& a, int mode) {
    const int tid = opaque_tid(), lane = tid & 63, wave = tid >> 6;
    const int NGW = gridDim.x * 8;
    unsigned char* ws = a.ws;
    const float* mod = (const float*)(ws + WS_MOD);
    const int lp = (mode == 0) ? 0 : 1;
    bf16_t* HX = (bf16_t*)(ws + WS_HX); const bf16_t* Y0 = (const bf16_t*)(ws + WS_Y); const float* SSQ0 = (const float*)(ws + WS_SSQ);
    const bf16_t* Y1 = (const bf16_t*)(ws + WS_HX); const float* SSQ1 = (const float*)(ws + WS_SSQ1);
    const int gw2 = wave * (int)gridDim.x + (int)blockIdx.x;
    const int nlat = NTOK / 4;
    int curb = -1; f32x4 GA0[4], GA1[4], GB[4], GC[4];
    int base = gw2 * 4, sub = 0, itc = nlat + gw2; bool inctx = false;
    for (;;) {
        int it;
        if (!inctx) { if (base >= nlat) { inctx = true; continue; } it = base + sub; if (++sub == 4) { sub = 0; base += NGW * 4; } }
        else { if (mode == 2 || itc >= nlat + NCTX / 4) break; it = itc; itc += NGW; }
        const int r = it * 4;
        const int b = r < NTOK ? (r >> 13) : 4;
        if (b != curb) { curb = b;
            const float* mp = mod + (lp * 5 + b) * 3072; const float* m0 = mod + (0 * 5 + b) * 3072; const float* m1 = mod + (1 * 5 + b) * 3072;
#pragma unroll
            for (int j = 0; j < 4; ++j) { const int c = 4 * lane + 256 * j;
                GA0[j] = *(const f32x4*)(m0 + 2048 + c) * *(const f32x4*)(a.g_post + c);
                GA1[j] = *(const f32x4*)(m1 + 2048 + c) * *(const f32x4*)(a.g_post + DM + c);
                GB[j] = *(const f32x4*)(a.g_pre + lp * DM + c) * (*(const f32x4*)(mp + 1024 + c) + 1.0f);
                GC[j] = *(const f32x4*)(mp + c); } }
        const float* src = (r < NTOK) ? a.x + (size_t)r * DM : a.ctx + (size_t)(r - NTOK) * DM;
        norm_rows4(mode, lane, src, a.out + (size_t)r * DM, Y0 + (size_t)r * DM, SSQ0 + (size_t)r * 16, Y1 + (size_t)r * DM, SSQ1 + (size_t)r * 16, HX + (size_t)r * DM, GA0, GA1, GB, GC);
    }
}

typedef short v4i16_t __attribute__((ext_vector_type(4)));
__device__ __forceinline__ v4i16_t trrd(const unsigned char* p) { return __builtin_amdgcn_ds_read_tr16_b64_v4i16((LAS v4i16_t*)p); }
__device__ __forceinline__ bf16x8 cat8(v4i16_t lo, v4i16_t hi) { return (bf16x8){lo[0], lo[1], lo[2], lo[3], hi[0], hi[1], hi[2], hi[3]}; }
__device__ __forceinline__ void attn_unit(int u, const bf16_t* P, const bf16_t* Vt, bf16_t* H, const float* sink, unsigned char* lds) {
    const int tid = opaque_tid(), lane = tid & 63, wave = __builtin_amdgcn_readfirstlane(tid >> 6), r32 = lane & 31, hi = lane >> 5;
    const bool isctx = u >= 1024;
    int b, kvh, qb;
    if (isctx) { const int v = u - 1024; b = v >> 3; kvh = (v >> 2) & 1; qb = v & 3; } else { b = u >> 8; kvh = (u >> 7) & 1; qb = u & 127; }
    const int head = kvh * 4 + (wave >> 1);
    const int qtok = qb * 64 + (wave & 1) * 32 + r32;
    const size_t qrow = isctx ? (size_t)(NTOK + b * CTXL + qtok) : (size_t)(b * SEQ + qtok);
    const float sinkv = sink[head];
    unsigned char* qscr = lds + 45056 + wave * 4608;
    u32x4 qld[4];
#pragma unroll
    for (int i4 = 0; i4 < 4; ++i4) qld[i4] = __builtin_nontemporal_load((const u32x4*)(P + (qrow - r32 + i4 * 8 + (lane >> 3)) * PW + C_Q + head * 64 + (lane & 7) * 8));
    int jlo = 0, jhi = -1;
    if (!isctx) { jlo = qb < 2 ? 2 - qb : 0; jhi = (129 - qb) < 4 ? (129 - qb) : 4; }
    const int ntiles = 4 + (jhi - jlo + 1);
    const int srow = tid >> 3, sch = tid & 7;
    const bf16_t* Kc = P + (size_t)(NTOK + b * CTXL + srow) * PW + C_K + kvh * 64 + sch * 8;
    const bf16_t* Kl = P + (size_t)(b * SEQ + srow) * PW + C_K + kvh * 64 + sch * 8;
    unsigned char* Ks = lds; unsigned char* Vs = lds + 2 * 9216;
    const int vsoff = srow * 192 + sch * 16;
    const int soff = srow * 144 + sch * 16;
    u32x4 kreg, vreg, kreg2, vreg2;
#define ATT_GLOAD(KR, VR, ti_) do { const int t_ = (ti_); \
        if (t_ < 4) { KR = *(const u32x4*)(Kc + (size_t)(64 * t_) * PW); VR = *(const u32x4*)(Kc + (size_t)(64 * t_) * PW + 128); } \
        else { const int kbase_ = qb * 64 - 128 + 64 * (jlo + t_ - 4); KR = *(const u32x4*)(Kl + (size_t)kbase_ * PW); VR = *(const u32x4*)(Kl + (size_t)kbase_ * PW + 128); } } while (0)
    const size_t qrow0 = qrow - r32;
    u32x4 gaw[4];
#pragma unroll
    for (int i4 = 0; i4 < 4; ++i4) gaw[i4] = __builtin_nontemporal_load((const u32x4*)(P + (qrow0 + i4 * 8 + (lane >> 3)) * PW + C_GA + head * 64 + (lane & 7) * 8));
    ATT_GLOAD(kreg2, vreg2, 0);
    ATT_GLOAD(kreg, vreg, 1);
#pragma unroll
    for (int i4 = 0; i4 < 4; ++i4) *(u32x4*)(qscr + (i4 * 8 + (lane >> 3)) * 144 + (lane & 7) * 16) = qld[i4];
    *(u32x4*)(Ks + soff) = kreg2; *(u32x4*)(Vs + vsoff) = vreg2;
    __syncthreads();
    bf16x8 qf[4];
#pragma unroll
    for (int d0 = 0; d0 < 4; ++d0) qf[d0] = *(const bf16x8*)(qscr + r32 * 144 + (2 * d0 + hi) * 16);
    const float sink2 = sinkv * LOG2E;
    float mref = sink2, lsum = 0.f;
    f32x16 oT[2]; oT[0] = f32x16{}; oT[1] = f32x16{};
    const int qpos = qtok;
    for (int ti = 0; ti < ntiles; ++ti) {
        const int buf = ti & 1;
        if (ti + 2 < ntiles) ATT_GLOAD(kreg2, vreg2, ti + 2);
        const unsigned char* kb = Ks + buf * 9216 + r32 * 144 + hi * 16;
        const unsigned char* vb = Vs + buf * 12288 + (4 * hi + ((lane & 15) >> 2)) * 192 + (16 * ((lane >> 4) & 1) + 4 * (lane & 3)) * 2;
        bf16x8 kf[8];
#pragma unroll
        for (int d0 = 0; d0 < 4; ++d0) { kf[2 * d0] = *(const bf16x8*)(kb + d0 * 32); kf[2 * d0 + 1] = *(const bf16x8*)(kb + 32 * 144 + d0 * 32); }
        f32x16 p0, p1;
#pragma unroll
        for (int r = 0; r < 16; ++r) { p0[r] = -mref; p1[r] = -mref; }
        __builtin_amdgcn_sched_barrier(0);
#pragma unroll
        for (int d0 = 0; d0 < 4; ++d0) { p0 = MFMA32(kf[2 * d0], qf[d0], p0); p1 = MFMA32(kf[2 * d0 + 1], qf[d0], p1); }
        bf16x8 vf[8];
#pragma unroll
        for (int blk = 0; blk < 2; ++blk)
#pragma unroll
            for (int ks = 0; ks < 4; ++ks) vf[blk * 4 + ks] = cat8(trrd(vb + (16 * ks) * 192 + blk * 64), trrd(vb + (16 * ks + 8) * 192 + blk * 64));
        __builtin_amdgcn_sched_barrier(0);
        asm volatile("s_nop 15\n\ts_nop 7" : "+v"(p0), "+v"(p1));
        if (ti >= 4) {
            const int j = jlo + ti - 4; const int kbase = qb * 64 - 128 + 64 * j;
            if (j == 0) {
#pragma unroll
                for (int r = 0; r < 16; ++r) { const int kp = kbase + crow(r, hi); if (kp < qpos - 128) p0[r] = -INFINITY; if (kp + 32 < qpos - 128) p1[r] = -INFINITY; }
            } else if (j == 4) {
#pragma unroll
                for (int r = 0; r < 16; ++r) { const int kp = kbase + crow(r, hi); if (kp > qpos + 128) p0[r] = -INFINITY; if (kp + 32 > qpos + 128) p1[r] = -INFINITY; }
            }
        }
        float rma, rmb;
        asm("v_max3_f32 %0, %1, %2, %3" : "=v"(rma) : "v"(p0[0]), "v"(p0[1]), "v"(p1[0]));
        asm("v_max3_f32 %0, %1, %2, %3" : "=v"(rmb) : "v"(p0[2]), "v"(p0[3]), "v"(p1[1]));
        asm("v_max3_f32 %0, %1, %2, %3" : "=v"(rma) : "v"(rma), "v"(p1[2]), "v"(p1[3]));
#pragma unroll
        for (int r = 4; r < 16; r += 4) {
            asm("v_max3_f32 %0, %1, %2, %3" : "=v"(rma) : "v"(rma), "v"(p0[r]), "v"(p0[r + 1]));
            asm("v_max3_f32 %0, %1, %2, %3" : "=v"(rmb) : "v"(rmb), "v"(p0[r + 2]), "v"(p0[r + 3]));
            asm("v_max3_f32 %0, %1, %2, %3" : "=v"(rma) : "v"(rma), "v"(p1[r]), "v"(p1[r + 1]));
            asm("v_max3_f32 %0, %1, %2, %3" : "=v"(rmb) : "v"(rmb), "v"(p1[r + 2]), "v"(p1[r + 3]));
        }
        float rm; asm("v_max3_f32 %0, %1, %2, %3" : "=v"(rm) : "v"(rma), "v"(rmb), "v"(rmb));
        { const float rmo = __shfl_xor(rm, 32); asm("v_max3_f32 %0, %1, %2, %3" : "=v"(rm) : "v"(rm), "v"(rmo), "v"(rmo)); }
        if (__any(rm > 8.0f)) {
            const float dl = fmaxf(rm, 0.f);
            mref += dl;
            const float f = __builtin_amdgcn_exp2f(-dl);
            lsum *= f;
#pragma unroll
            for (int r = 0; r < 16; ++r) { p0[r] -= dl; p1[r] -= dl; oT[0][r] *= f; oT[1][r] *= f; }
        }
        float ls = 0.f;
#pragma unroll
        for (int r = 0; r < 16; ++r) { p0[r] = __builtin_amdgcn_exp2f(p0[r]); p1[r] = __builtin_amdgcn_exp2f(p1[r]); ls += p0[r] + p1[r]; }
        lsum += ls;
        bf16x8 pf[4]; pf[0] = pack8(p0, 0); pf[1] = pack8(p0, 8); pf[2] = pack8(p1, 0); pf[3] = pack8(p1, 8);
#pragma unroll
        for (int blk = 0; blk < 2; ++blk)
#pragma unroll
            for (int ks = 0; ks < 4; ++ks) oT[blk] = MFMA32(vf[blk * 4 + ks], pf[ks], oT[blk]);
        if (ti + 1 < ntiles) { *(u32x4*)(Ks + (buf ^ 1) * 9216 + soff) = kreg; *(u32x4*)(Vs + (buf ^ 1) * 12288 + vsoff) = vreg; }
        kreg = kreg2; vreg = vreg2;
        __syncthreads();
    }
    lsum += __shfl_xor(lsum, 32);
    lsum += __builtin_amdgcn_exp2f(sink2 - mref);
    const float inv = 1.0f / lsum;
    unsigned char* ow = qscr;
#pragma unroll
    for (int blk = 0; blk < 2; ++blk)
#pragma unroll
        for (int g4 = 0; g4 < 4; ++g4) {
            u32x2 w; w.x = pkbf(oT[blk][4 * g4 + 0] * inv, oT[blk][4 * g4 + 1] * inv); w.y = pkbf(oT[blk][4 * g4 + 2] * inv, oT[blk][4 * g4 + 3] * inv);
            *(u32x2*)(ow + r32 * 144 + (32 * blk + 8 * g4 + 4 * hi) * 2) = w;
        }
    asm volatile("s_waitcnt lgkmcnt(0)" ::: "memory");
#pragma unroll
    for (int i4 = 0; i4 < 4; ++i4) {
        const int rr = i4 * 8 + (lane >> 3), ch = lane & 7;
        const u32x4 ov = *(const u32x4*)(ow + rr * 144 + ch * 16);
        const unsigned ovv[4] = {ov.x, ov.y, ov.z, ov.w}, gvv[4] = {gaw[i4].x, gaw[i4].y, gaw[i4].z, gaw[i4].w};
        u32x4 w;
        unsigned wv[4];
#pragma unroll
        for (int e = 0; e < 4; ++e) wv[e] = pkbf(bf2f(ovv[e] & 0xffffu) * silu_f(bf2f(gvv[e] & 0xffffu)), bf2f(ovv[e] >> 16) * silu_f(bf2f(gvv[e] >> 16)));
        w.x = wv[0]; w.y = wv[1]; w.z = wv[2]; w.w = wv[3];
        *(u32x4*)(H + (qrow0 + rr) * DM + head * 64 + ch * 8) = w;
    }
    asm volatile("s_waitcnt lgkmcnt(0)" ::: "memory");
}

__device__ __forceinline__ void fft1_unit(int u, const bf16_t* P, bf16_t* YF, const unsigned char* ws, unsigned char* lds) {
    const int tid = opaque_tid(), lane = tid & 63, wave = __builtin_amdgcn_readfirstlane(tid >> 6), r32 = lane & 31, hi = lane >> 5;
    const int b = u >> 6, n2 = u & 63;
    constexpr int UPB = 576;
    const bf16_t* src = P + (size_t)(b * SEQ + n2) * PW + C_UF;
#pragma unroll
    for (int i = 0; i < 8; ++i) {
        const int id = tid + NTHREADS * i, n1 = id >> 5, cc = id & 31;
        *(u32x4*)(lds + n1 * UPB + cc * 16) = *(const u32x4*)(src + (size_t)n1 * 64 * PW + cc * 8);
    }
    __syncthreads();
    const bf16_t* T1R = (const bf16_t*)(ws + WS_T1R); const bf16_t* T1I = (const bf16_t*)(ws + WS_T1I);
    f32x16 aR[4], aI[4];
#pragma unroll
    for (int kb = 0; kb < 4; ++kb) { aR[kb] = f32x16{}; aI[kb] = f32x16{}; }
    const unsigned char* ap = lds + (8 * hi + ((lane & 15) >> 2)) * UPB + (32 * wave + 16 * ((lane >> 4) & 1) + 4 * (lane & 3)) * 2;
#pragma unroll 2
    for (int ks = 0; ks < 8; ++ks) {
        const bf16x8 av = cat8(trrd(ap + (16 * ks) * UPB), trrd(ap + (16 * ks + 4) * UPB));
#pragma unroll
        for (int kb = 0; kb < 4; ++kb) {
            const bf16x8 bR = *(const bf16x8*)(T1R + (32 * kb + r32) * 128 + 16 * ks + 8 * hi), bI = *(const bf16x8*)(T1I + (32 * kb + r32) * 128 + 16 * ks + 8 * hi);
            aR[kb] = MFMA32(av, bR, aR[kb]); aI[kb] = MFMA32(av, bI, aI[kb]);
        }
    }
    const float* TW = (const float*)(ws + WS_TW);
#pragma unroll
    for (int kb = 0; kb < 4; ++kb) {
        const int k1 = 32 * kb + r32;
        const float ct = TW[2 * (n2 * k1)], st = TW[2 * (n2 * k1) + 1];
        bf16_t* yp = YF + ((size_t)((b * 128 + k1) * 64 + n2)) * 512 + 32 * wave + 4 * hi;
#pragma unroll
        for (int g4 = 0; g4 < 4; ++g4) {
            float yr[4], yi[4];
#pragma unroll
            for (int e = 0; e < 4; ++e) { const float r_ = aR[kb][4 * g4 + e], i_ = aI[kb][4 * g4 + e]; yr[e] = r_ * ct + i_ * st; yi[e] = i_ * ct - r_ * st; }
            u32x2 wr_, wi_; wr_.x = pkbf(yr[0], yr[1]); wr_.y = pkbf(yr[2], yr[3]); wi_.x = pkbf(yi[0], yi[1]); wi_.y = pkbf(yi[2], yi[3]);
            *(u32x2*)(yp + 8 * g4) = wr_; *(u32x2*)(yp + 256 + 8 * g4) = wi_;
        }
    }
    __syncthreads();
}

template <int KK>
__device__ __forceinline__ void dftf_unit(const bf16_t* srcbase, int R, int pitchA, int pitchB, const bf16_t* Tr, const bf16_t* Ti, const bf16_t* Gt,
                                          const bf16_t* P, bf16_t* H, size_t row0, int rowstride, float oscale, unsigned char* lds) {
    const int tid = opaque_tid(), lane = tid & 63, wave = __builtin_amdgcn_readfirstlane(tid >> 6), r32 = lane & 31, hi = lane >> 5;
    constexpr int ZPB = (KK == 128) ? 576 : 544;
#pragma unroll 1
    for (int i0 = 0; i0 < KK / 16; i0 += 8) {
        u32x4 img[8];
#pragma unroll
        for (int i = 0; i < 8; ++i) { const int id = tid + NTHREADS * (i0 + i), kk = id >> 5, cc = id & 31; img[i] = *(const u32x4*)(srcbase + (size_t)(kk % R) * pitchA + (size_t)(kk / R) * pitchB + cc * 8); }
        __builtin_amdgcn_sched_barrier(0);
#pragma unroll
        for (int i = 0; i < 8; ++i) { const int id = tid + NTHREADS * (i0 + i), kk = id >> 5, cc = id & 31; *(u32x4*)(lds + kk * ZPB + cc * 16) = img[i]; }
        __builtin_amdgcn_sched_barrier(0);
    }
    __syncthreads();
    const int g = wave >> 1, kblk = wave & 1;
    f32x16 XR[2], XI[2];
#pragma unroll
    for (int cb = 0; cb < 2; ++cb) { XR[cb] = f32x16{}; XI[cb] = f32x16{}; }
    const bf16_t* trp = Tr + (size_t)(32 * kblk + r32) * KK + 8 * hi; const bf16_t* tip = Ti + (size_t)(32 * kblk + r32) * KK + 8 * hi;
    const unsigned char* zp = lds + (8 * hi + ((lane & 15) >> 2)) * ZPB + (64 * g + 16 * ((lane >> 4) & 1) + 4 * (lane & 3)) * 2;
#pragma unroll 2
    for (int ks = 0; ks < KK / 16; ++ks) {
        const bf16x8 bR = *(const bf16x8*)(trp + 16 * ks), bI = *(const bf16x8*)(tip + 16 * ks);
#pragma unroll
        for (int cb = 0; cb < 2; ++cb) { const bf16x8 av = cat8(trrd(zp + (16 * ks) * ZPB + cb * 64), trrd(zp + (16 * ks + 4) * ZPB + cb * 64)); XR[cb] = MFMA32(av, bR, XR[cb]); XI[cb] = MFMA32(av, bI, XI[cb]); }
    }
    f32x16 oa[2]; oa[0] = f32x16{}; oa[1] = f32x16{};
    const bf16_t* gp = Gt + (size_t)(g * 2 * 8 * 64 + lane) * 8;
    u32x2 gfw[8];
    { const size_t rowg = row0 + (size_t)(32 * kblk + r32) * rowstride;
#pragma unroll
      for (int i8 = 0; i8 < 8; ++i8) gfw[i8] = *(const u32x2*)(P + rowg * PW + C_GF + 64 * g + 32 * (i8 >> 2) + 8 * (i8 & 3) + 4 * hi); }
#pragma unroll
    for (int part = 0; part < 2; ++part)
#pragma unroll
        for (int cb = 0; cb < 2; ++cb)
#pragma unroll
            for (int s = 0; s < 2; ++s) {
                const bf16x8 bx = pack8(part ? XI[cb] : XR[cb], 8 * s);
                const int kko = part * 64 + 32 * cb + 16 * s;
#pragma unroll
                for (int lb = 0; lb < 2; ++lb) { const bf16x8 ag = *(const bf16x8*)(gp + (size_t)((lb * 8 + (kko >> 4)) * 64) * 8); oa[lb] = MFMA32(ag, bx, oa[lb]); }
            }
    const int k2 = 32 * kblk + r32;
    const size_t row = row0 + (size_t)k2 * rowstride;
    const bf16_t* gfrow = P + row * PW + C_GF + 64 * g;
    bf16_t* hrow = H + row * DM + 512 + 64 * g;
#pragma unroll
    for (int lb = 0; lb < 2; ++lb)
#pragma unroll
        for (int g4 = 0; g4 < 4; ++g4) {
            const int l0 = 32 * lb + 8 * g4 + 4 * hi;
            const u32x2 gw = gfw[lb * 4 + g4];
            const float o0 = oa[lb][4 * g4 + 0] * oscale * silu_f(bf2f(gw.x & 0xffffu)), o1 = oa[lb][4 * g4 + 1] * oscale * silu_f(bf2f(gw.x >> 16));
            const float o2 = oa[lb][4 * g4 + 2] * oscale * silu_f(bf2f(gw.y & 0xffffu)), o3 = oa[lb][4 * g4 + 3] * oscale * silu_f(bf2f(gw.y >> 16));
            u32x2 w; w.x = pkbf(o0, o1); w.y = pkbf(o2, o3);
            *(u32x2*)(hrow + l0) = w;
        }
    __syncthreads();
}

__device__ __forceinline__ void conv_unit(int u, const bf16_t* P, bf16_t* H, const float* cw, const float* cb) {
    const int tid = opaque_tid(), cgp = tid & 31, rg = tid >> 5;
    const int ch0 = cgp * 8;
    const int r0 = u * 64 + rg * 4;
    int pos, len; if (r0 < NTOK) { pos = r0 & (SEQ - 1); len = SEQ; } else { pos = (r0 - NTOK) & (CTXL - 1); len = CTXL; }
    float w0[8], w1[8], w2[8], bs[8];
#pragma unroll
    for (int e = 0; e < 8; ++e) { w0[e] = cw[ch0 + e]; w1[e] = cw[256 + ch0 + e]; w2[e] = cw[512 + ch0 + e]; bs[e] = cb[ch0 + e]; }
    float T[6][8];
#pragma unroll
    for (int i = 0; i < 6; ++i) {
        const int p = pos - 1 + i;
        if (p >= 0 && p < len) {
            const size_t row = (size_t)(r0 - 1 + i);
            const u32x4 z = *(const u32x4*)(P + row * PW + C_ZC + ch0), c = *(const u32x4*)(P + row * PW + C_CC + ch0);
            T[i][0] = bf2f(z.x & 0xffffu) * bf2f(c.x & 0xffffu); T[i][1] = bf2f(z.x >> 16) * bf2f(c.x >> 16);
            T[i][2] = bf2f(z.y & 0xffffu) * bf2f(c.y & 0xffffu); T[i][3] = bf2f(z.y >> 16) * bf2f(c.y >> 16);
            T[i][4] = bf2f(z.z & 0xffffu) * bf2f(c.z & 0xffffu); T[i][5] = bf2f(z.z >> 16) * bf2f(c.z >> 16);
            T[i][6] = bf2f(z.w & 0xffffu) * bf2f(c.w & 0xffffu); T[i][7] = bf2f(z.w >> 16) * bf2f(c.w >> 16);
        } else {
#pragma unroll
            for (int e = 0; e < 8; ++e) T[i][e] = 0.f;
        }
    }
#pragma unroll
    for (int i = 0; i < 4; ++i) {
        const size_t row = (size_t)(r0 + i);
        const u32x4 bw = *(const u32x4*)(P + row * PW + C_BC + ch0), gw = *(const u32x4*)(P + row * PW + C_GC + ch0);
        const unsigned bwv[4] = {bw.x, bw.y, bw.z, bw.w}, gwv[4] = {gw.x, gw.y, gw.z, gw.w};
        float o[8];
#pragma unroll
        for (int e = 0; e < 8; ++e) {
            const float bv = (e & 1) ? bf2f(bwv[e >> 1] >> 16) : bf2f(bwv[e >> 1] & 0xffffu);
            const float gv = (e & 1) ? bf2f(gwv[e >> 1] >> 16) : bf2f(gwv[e >> 1] & 0xffffu);
            const float y = T[i][e] * w0[e] + T[i + 1][e] * w1[e] + T[i + 2][e] * w2[e] + bs[e];
            o[e] = bv * y * silu_f(gv);
        }
        u32x4 w; w.x = pkbf(o[0], o[1]); w.y = pkbf(o[2], o[3]); w.z = pkbf(o[4], o[5]); w.w = pkbf(o[6], o[7]);
        *(u32x4*)(H + row * DM + 768 + ch0) = w;
    }
}

__device__ __forceinline__ void fft1_tables(const unsigned char* ws, unsigned char* tbl, int tid) {
    u32x4 tv[8];
#pragma unroll
    for (int i = 0; i < 8; ++i) { const int id = tid + NTHREADS * i, t = id >> 11, row = (id >> 4) & 127, ch = id & 15; tv[i] = *(const u32x4*)(ws + (t ? WS_T1I : WS_T1R) + row * 256 + ch * 16); }
    __builtin_amdgcn_sched_barrier(0);
#pragma unroll
    for (int i = 0; i < 8; ++i) { const int id = tid + NTHREADS * i, t = id >> 11, row = (id >> 4) & 127, ch = id & 15; *(u32x4*)(tbl + t * 34816 + row * 272 + ch * 16) = tv[i]; }
}
__device__ __forceinline__ void fft1_wave(int task, const bf16_t* P, bf16_t* YF, const unsigned char* ws, unsigned char* lds_w, const unsigned char* tbl, int lane, int pmode = 0) {
    const int r32 = lane & 31, hi = lane >> 5;
    const int cblk = task & 7, n2 = (task >> 3) & 63, b = task >> 9;
    const bf16_t* src = P + (size_t)((b * 64 + n2) * 128) * 256 + 32 * cblk + 8 * (lane & 3);
    { u32x4 img[8];
#pragma unroll
      for (int i = 0; i < 8; ++i) img[i] = __builtin_nontemporal_load((const u32x4*)(src + (size_t)(16 * i + (lane >> 2)) * 256));
      __builtin_amdgcn_sched_barrier(0);
#pragma unroll
      for (int i = 0; i < 8; ++i) *(u32x4*)(lds_w + (16 * i + (lane >> 2)) * 64 + (lane & 3) * 16) = img[i];
      __builtin_amdgcn_sched_barrier(0); }
    asm volatile("s_waitcnt vmcnt(0) lgkmcnt(0)" ::: "memory");
    if (pmode == 2) return;
    const bf16_t* T1R = (const bf16_t*)(ws + WS_T1R); const bf16_t* T1I = (const bf16_t*)(ws + WS_T1I);
    f32x16 aR[4], aI[4];
#pragma unroll
    for (int kb = 0; kb < 4; ++kb) { aR[kb] = f32x16{}; aI[kb] = f32x16{}; }
    const unsigned char* ap = lds_w + (8 * hi + ((lane & 15) >> 2)) * 64 + (16 * ((lane >> 4) & 1) + 4 * (lane & 3)) * 2;
    const unsigned char* tb = tbl + r32 * 272 + hi * 16;
#pragma unroll 2
    for (int ks = 0; ks < 8; ++ks) {
        const bf16x8 av = cat8(trrd(ap + (16 * ks) * 64), trrd(ap + (16 * ks + 4) * 64));
        bf16x8 bq[8];
#pragma unroll
        for (int kb = 0; kb < 4; ++kb) { bq[2 * kb] = *(const bf16x8*)(tb + (32 * kb) * 272 + 32 * ks); bq[2 * kb + 1] = *(const bf16x8*)(tb + 34816 + (32 * kb) * 272 + 32 * ks); }
#pragma unroll
        for (int kb = 0; kb < 4; ++kb) { aR[kb] = MFMA32(av, bq[2 * kb], aR[kb]); aI[kb] = MFMA32(av, bq[2 * kb + 1], aI[kb]); }
    }
    const float* TW = (const float*)(ws + WS_TW);
    float ctw[4], stw[4];
#pragma unroll
    for (int kb = 0; kb < 4; ++kb) { const int k1 = 32 * kb + r32; ctw[kb] = TW[2 * (n2 * k1)]; stw[kb] = TW[2 * (n2 * k1) + 1]; }
    asm volatile("s_waitcnt lgkmcnt(0)" ::: "memory");
#pragma unroll
    for (int pr = 0; pr < 2; ++pr) {
#pragma unroll
        for (int kq = 0; kq < 2; ++kq) {
            const int kb = 2 * pr + kq; const int rowl = 32 * kq + r32; const float ct = ctw[kb], st = stw[kb];
#pragma unroll
            for (int g4 = 0; g4 < 4; ++g4) {
                float yr[4], yi[4];
#pragma unroll
                for (int e = 0; e < 4; ++e) { const float r_ = aR[kb][4 * g4 + e], i_ = aI[kb][4 * g4 + e]; yr[e] = r_ * ct + i_ * st; yi[e] = i_ * ct - r_ * st; }
                u32x2 wr_, wi_; wr_.x = pkbf(yr[0], yr[1]); wr_.y = pkbf(yr[2], yr[3]); wi_.x = pkbf(yi[0], yi[1]); wi_.y = pkbf(yi[2], yi[3]);
                *(u32x2*)(lds_w + rowl * 128 + ((g4 ^ (rowl & 7)) * 16) + hi * 8) = wr_;
                *(u32x2*)(lds_w + rowl * 128 + (((4 + g4) ^ (rowl & 7)) * 16) + hi * 8) = wi_;
            }
        }
        asm volatile("s_waitcnt lgkmcnt(0)" ::: "memory");
#pragma unroll
        for (int i8 = 0; i8 < 8; ++i8) {
            const int rowl = i8 * 8 + (lane >> 3), ch = lane & 7;
            const u32x4 v = *(const u32x4*)(lds_w + rowl * 128 + ((ch ^ (rowl & 7)) * 16));
            const int k1 = 64 * pr + rowl;
            bf16_t* dst = YF + ((size_t)((b * 128 + k1) * 64 + n2)) * 512 + (ch >> 2) * 256 + 32 * cblk + 8 * (ch & 3);
            *(u32x4*)dst = v;
        }
        asm volatile("s_waitcnt lgkmcnt(0)" ::: "memory");
    }
}
__device__ __forceinline__ void fft3_wave(int task, const bf16_t* YF, const bf16_t* Gt, const bf16_t* P, bf16_t* H, const unsigned char* ws, unsigned char* lds_w, int lane) {
    const int r32 = lane & 31, hi = lane >> 5;
    const int g = task & 3, k1 = (task >> 2) & 127, b = task >> 9;
    const bf16_t* src = YF + ((size_t)(b * 128 + k1) * 64) * 512 + 64 * g + 8 * (lane & 7);
    { u32x4 img[16];
#pragma unroll
      for (int i = 0; i < 16; ++i) { const int kk = 8 * i + (lane >> 3); img[i] = __builtin_nontemporal_load((const u32x4*)(src + (size_t)(kk & 63) * 512 + (size_t)(kk >> 6) * 256)); }
      __builtin_amdgcn_sched_barrier(0);
#pragma unroll
      for (int i = 0; i < 16; ++i) { const int kk = 8 * i + (lane >> 3), ch = lane & 7; *(u32x4*)(lds_w + kk * 128 + ((ch ^ (((kk >> 1) & 1) << 2)) * 16)) = img[i]; }
      __builtin_amdgcn_sched_barrier(0); }
    asm volatile("s_waitcnt vmcnt(0) lgkmcnt(0)" ::: "memory");
    const bf16_t* T3R = (const bf16_t*)(ws + WS_T3R); const bf16_t* T3I = (const bf16_t*)(ws + WS_T3I);
    const int q = (lane & 15) >> 2, sw = (q >> 1) & 1;
    const int chl = 2 * ((lane >> 4) & 1) + ((lane & 3) >> 1);
    const unsigned char* zb = lds_w + (8 * hi + q) * 128 + 8 * (lane & 1);
    const unsigned char* zp0 = zb + ((chl ^ (sw << 2)) * 16);
    const unsigned char* zp1 = zb + (((4 + chl) ^ (sw << 2)) * 16);
    const bf16_t* gp = Gt + (size_t)(g * 2 * 8 * 64 + lane) * 8;
    const size_t rowb = (size_t)(b * SEQ + k1);
    u32x2 hwA[8], hwB[8];
#pragma unroll
    for (int i8 = 0; i8 < 8; ++i8) { hwA[i8] = (u32x2){0u, 0u}; hwB[i8] = (u32x2){0u, 0u}; }
#pragma unroll 1
    for (int kblk = 0; kblk < 2; ++kblk) {
        f32x16 XR[2], XI[2];
#pragma unroll
        for (int cb = 0; cb < 2; ++cb) { XR[cb] = f32x16{}; XI[cb] = f32x16{}; }
        const bf16_t* trp = T3R + (size_t)(kblk * 8 * 64 + lane) * 8; const bf16_t* tip = T3I + (size_t)(kblk * 8 * 64 + lane) * 8;
        const size_t rowg = rowb + (size_t)(32 * kblk + r32) * 128;
        u32x2 gfw[8];
#pragma unroll
        for (int i8 = 0; i8 < 8; ++i8) gfw[i8] = *(const u32x2*)(P + rowg * PW + C_GF + 64 * g + 32 * (i8 >> 2) + 8 * (i8 & 3) + 4 * hi);
        bf16x8 bR[8], bI[8];
#pragma unroll
        for (int ks = 0; ks < 8; ++ks) { bR[ks] = *(const bf16x8*)(trp + 512 * ks); bI[ks] = *(const bf16x8*)(tip + 512 * ks); }
        __builtin_amdgcn_sched_barrier(0);
#pragma unroll
        for (int ks = 0; ks < 8; ++ks) {
            const bf16x8 a0 = cat8(trrd(zp0 + (16 * ks) * 128), trrd(zp0 + (16 * ks + 4) * 128));
            const bf16x8 a1 = cat8(trrd(zp1 + (16 * ks) * 128), trrd(zp1 + (16 * ks + 4) * 128));
            XR[0] = MFMA32(a0, bR[ks], XR[0]); XI[0] = MFMA32(a0, bI[ks], XI[0]); XR[1] = MFMA32(a1, bR[ks], XR[1]); XI[1] = MFMA32(a1, bI[ks], XI[1]);
        }
        __builtin_amdgcn_sched_barrier(0);
        bf16x8 gfr[2][8];
#pragma unroll
        for (int lb = 0; lb < 2; ++lb)
#pragma unroll
            for (int q8 = 0; q8 < 8; ++q8) gfr[lb][q8] = *(const bf16x8*)(gp + (size_t)((lb * 8 + q8) * 64) * 8);
        __builtin_amdgcn_sched_barrier(0);
        f32x16 oa[2]; oa[0] = f32x16{}; oa[1] = f32x16{};
#pragma unroll
        for (int part = 0; part < 2; ++part)
#pragma unroll
            for (int cb = 0; cb < 2; ++cb)
#pragma unroll
                for (int s = 0; s < 2; ++s) {
                    const bf16x8 bx = pack8(part ? XI[cb] : XR[cb], 8 * s);
                    const int kko = part * 64 + 32 * cb + 16 * s;
#pragma unroll
                    for (int lb = 0; lb < 2; ++lb) oa[lb] = MFMA32(gfr[lb][kko >> 4], bx, oa[lb]);
                }
#pragma unroll
        for (int lb = 0; lb < 2; ++lb)
#pragma unroll
            for (int g4 = 0; g4 < 4; ++g4) {
                const u32x2 gw = gfw[lb * 4 + g4];
                const float o0 = oa[lb][4 * g4 + 0] * silu_f(bf2f(gw.x & 0xffffu)), o1 = oa[lb][4 * g4 + 1] * silu_f(bf2f(gw.x >> 16));
                const float o2 = oa[lb][4 * g4 + 2] * silu_f(bf2f(gw.y & 0xffffu)), o3 = oa[lb][4 * g4 + 3] * silu_f(bf2f(gw.y >> 16));
                u32x2 pk; pk.x = pkbf(o0, o1); pk.y = pkbf(o2, o3);
                if (kblk == 0) hwA[lb * 4 + g4] = pk; else hwB[lb * 4 + g4] = pk;
            }
    }
    asm volatile("s_waitcnt lgkmcnt(0)" ::: "memory");
#pragma unroll
    for (int kblk = 0; kblk < 2; ++kblk)
#pragma unroll
        for (int lb = 0; lb < 2; ++lb)
#pragma unroll
            for (int g4 = 0; g4 < 4; ++g4) { const int rowl = 32 * kblk + r32;
                *(u32x2*)(lds_w + rowl * 128 + (((4 * lb + g4) ^ (rowl & 7)) * 16) + hi * 8) = kblk ? hwB[lb * 4 + g4] : hwA[lb * 4 + g4]; }
    asm volatile("s_waitcnt lgkmcnt(0)" ::: "memory");
#pragma unroll
    for (int i8 = 0; i8 < 8; ++i8) {
        const int rowl = i8 * 8 + (lane >> 3), ch = lane & 7;
        const u32x4 v = *(const u32x4*)(lds_w + rowl * 128 + ((ch ^ (rowl & 7)) * 16));
        *(u32x4*)(H + (rowb + (size_t)rowl * 128) * DM + 512 + 64 * g + 8 * ch) = v;
    }
    asm volatile("s_waitcnt lgkmcnt(0)" ::: "memory");
}
__device__ __forceinline__ void conv_wave(int task, const bf16_t* P, bf16_t* H, const float* cw, const float* cb, int lane) {
    const int cgp = lane & 31, ch0 = cgp * 8;
    const int r0 = task * 8 + (lane >> 5) * 4;
    int pos, len; if (r0 < NTOK) { pos = r0 & (SEQ - 1); len = SEQ; } else { pos = (r0 - NTOK) & (CTXL - 1); len = CTXL; }
    u32x4 zz[6], cc[6], bb[4], gg[4]; float okf[6];
#pragma unroll
    for (int i = 0; i < 6; ++i) { const int p = pos - 1 + i; const bool ok = p >= 0 && p < len; okf[i] = ok ? 1.f : 0.f; const size_t row = (size_t)(ok ? r0 - 1 + i : r0);
        zz[i] = __builtin_nontemporal_load((const u32x4*)(P + row * PW + C_ZC + ch0)); cc[i] = __builtin_nontemporal_load((const u32x4*)(P + row * PW + C_CC + ch0)); }
#pragma unroll
    for (int i = 0; i < 4; ++i) { const size_t row = (size_t)(r0 + i); bb[i] = __builtin_nontemporal_load((const u32x4*)(P + row * PW + C_BC + ch0)); gg[i] = __builtin_nontemporal_load((const u32x4*)(P + row * PW + C_GC + ch0)); }
    __builtin_amdgcn_sched_barrier(0);
    float w0[8], w1[8], w2[8], bs[8];
    { const f32x4 a0 = *(const f32x4*)(cw + ch0), a1 = *(const f32x4*)(cw + ch0 + 4), b0 = *(const f32x4*)(cw + 256 + ch0), b1 = *(const f32x4*)(cw + 256 + ch0 + 4);
      const f32x4 c0 = *(const f32x4*)(cw + 512 + ch0), c1 = *(const f32x4*)(cw + 512 + ch0 + 4), d0 = *(const f32x4*)(cb + ch0), d1 = *(const f32x4*)(cb + ch0 + 4);
#pragma unroll
      for (int e = 0; e < 4; ++e) { w0[e] = a0[e]; w0[4 + e] = a1[e]; w1[e] = b0[e]; w1[4 + e] = b1[e]; w2[e] = c0[e]; w2[4 + e] = c1[e]; bs[e] = d0[e]; bs[4 + e] = d1[e]; } }
    float T[6][8];
#pragma unroll
    for (int i = 0; i < 6; ++i) {
        const unsigned zv[4] = {zz[i].x, zz[i].y, zz[i].z, zz[i].w}, cv[4] = {cc[i].x, cc[i].y, cc[i].z, cc[i].w};
#pragma unroll
        for (int e = 0; e < 8; ++e) T[i][e] = okf[i] * ((e & 1) ? bf2f(zv[e >> 1] >> 16) : bf2f(zv[e >> 1] & 0xffffu)) * ((e & 1) ? bf2f(cv[e >> 1] >> 16) : bf2f(cv[e >> 1] & 0xffffu));
    }
#pragma unroll
    for (int i = 0; i < 4; ++i) {
        const size_t row = (size_t)(r0 + i);
        const unsigned bwv[4] = {bb[i].x, bb[i].y, bb[i].z, bb[i].w}, gwv[4] = {gg[i].x, gg[i].y, gg[i].z, gg[i].w};
        float o[8];
#pragma unroll
        for (int e = 0; e < 8; ++e) {
            const float bv = (e & 1) ? bf2f(bwv[e >> 1] >> 16) : bf2f(bwv[e >> 1] & 0xffffu);
            const float gv = (e & 1) ? bf2f(gwv[e >> 1] >> 16) : bf2f(gwv[e >> 1] & 0xffffu);
            const float y = T[i][e] * w0[e] + T[i + 1][e] * w1[e] + T[i + 2][e] * w2[e] + bs[e];
            o[e] = bv * y * silu_f(gv);
        }
        u32x4 w; w.x = pkbf(o[0], o[1]); w.y = pkbf(o[2], o[3]); w.z = pkbf(o[4], o[5]); w.w = pkbf(o[6], o[7]);
        *(u32x4*)(H + row * DM + 768 + ch0) = w;
    }
}

#define XB_TMO      128
#define XB_XCNT(j)  (256  + 64 * (j))
#define XB_XSUB(j)  (1280 + 64 * (j))
#define XB_XGEN(j)  (2304 + 64 * (j))
#define XB_TOP      3328
#define XB_TOPGEN   3392
#define XCD_BAR_WORDS 3456
#define XB_SPIN_CAP (1u << 18)

__device__ __forceinline__ unsigned xb_ld(unsigned* p)              { return __hip_atomic_load(p, __ATOMIC_RELAXED, __HIP_MEMORY_SCOPE_AGENT); }
__device__ __forceinline__ unsigned xb_add(unsigned* p, unsigned v) { return __hip_atomic_fetch_add(p, v, __ATOMIC_RELAXED, __HIP_MEMORY_SCOPE_AGENT); }
__device__ __forceinline__ unsigned xb_xcc_id() { return (unsigned)__builtin_amdgcn_s_getreg((3 << 11) | 20) & 0xFu; }
#define XB_SPIN(cond, bar) do { unsigned _sp = 0; while (cond) { __builtin_amdgcn_s_sleep(1); \
    if ((++_sp & 255u) == 0u) { if (xb_ld(&(bar)[XB_TMO])) break; if (_sp > XB_SPIN_CAP) { atomicAdd(&(bar)[XB_TMO], 1u); break; } } } } while (0)

struct XcdBarrier {
    unsigned* bar; unsigned x;
    volatile LAS unsigned* st;
};

__device__ __forceinline__ XcdBarrier xcd_barrier_post(unsigned* bar, volatile LAS unsigned* st) {
    XcdBarrier b; b.bar = bar; b.x = xb_xcc_id(); b.st = st;
    if (threadIdx.x == 0) (void)xb_add(&bar[XB_XCNT(b.x)], 1u);
    return b;
}
__device__ __forceinline__ void xcd_barrier_complete(unsigned* bar, unsigned x, unsigned& nloc, unsigned& nx) {
    const unsigned G = gridDim.x * gridDim.y * gridDim.z;
    unsigned sum, cnt, mine, sp = 0u;
    for (;;) {
        sum = 0u; cnt = 0u; mine = 0u;
#pragma unroll
        for (unsigned j = 0; j < 16; ++j) { const unsigned c = xb_ld(&bar[XB_XCNT(j)]); sum += c; cnt += (c > 0u) ? 1u : 0u; mine = (j == x) ? c : mine; }
        if (sum == G) break;
        __builtin_amdgcn_s_sleep(1);
        if ((++sp & 255u) == 0u) { if (xb_ld(&bar[XB_TMO])) break; if (sp > XB_SPIN_CAP) { atomicAdd(&bar[XB_TMO], 1u); break; } }
    }
    nloc = mine > 0u ? mine : 1u; nx = cnt > 0u ? cnt : 1u;
}

__device__ __forceinline__ void xcd_barrier(const XcdBarrier& b) {
    asm volatile("s_waitcnt vmcnt(0)" ::: "memory");
    __syncthreads();
    if (threadIdx.x == 0) {
        unsigned* bar = b.bar;
        __builtin_amdgcn_s_waitcnt(0);
        unsigned nloc = b.st[0], nx = b.st[1];
        if (nloc == 0u) { xcd_barrier_complete(bar, b.x, nloc, nx); b.st[0] = nloc; b.st[1] = nx; }
        const unsigned old = xb_add(&bar[XB_XSUB(b.x)], 1u);
        const unsigned gen = old / nloc;
        if (old + 1u == (gen + 1u) * nloc) {
            __builtin_amdgcn_fence(__ATOMIC_RELEASE, "agent");
            asm volatile("s_waitcnt vmcnt(0)" ::: "memory");
            const unsigned og = xb_add(&bar[XB_TOP], 1u);
            const unsigned tg = og / nx;
            if (og + 1u == (tg + 1u) * nx) xb_add(&bar[XB_TOPGEN], 1u);
            else XB_SPIN(xb_ld(&bar[XB_TOPGEN]) == tg, bar);
            __builtin_amdgcn_fence(__ATOMIC_ACQUIRE, "agent");
            xb_add(&bar[XB_XGEN(b.x)], 1u);
            asm volatile("s_waitcnt vmcnt(0)" ::: "memory");
        } else {
            XB_SPIN(xb_ld(&bar[XB_XGEN(b.x)]) == gen, bar);
            __builtin_amdgcn_fence(__ATOMIC_ACQUIRE, "agent");
            asm volatile("s_waitcnt vmcnt(0)" ::: "memory");
        }
    }
    __syncthreads();
}

__device__ __forceinline__ int next_unit(unsigned* ctr, unsigned char* lds) {
    volatile int* sw = (volatile int*)(lds + LDS_SCHED);
    if (threadIdx.x == 0) *sw = (int)atomicAdd(ctr, 1u);
    __syncthreads();
    const int u = *sw;
    __syncthreads();
    return u;
}

__global__ void __launch_bounds__(NTHREADS, 2) hybrid_fwd(KArgs a) {
    extern __shared__ __attribute__((aligned(16))) unsigned char lds[];
    cg::grid_group grid = cg::this_grid();
    unsigned char* ws = a.ws;
    const int lo = a.ph_lo, hi = a.ph_hi;
#ifndef PHMASK
#define PHMASK 0xfff
#endif
#define IN(k) (((PHMASK >> ((k) > 5 && (k) < 11 ? (k) - 5 : (k))) & 1) && lo <= (k) && (k) < hi)
#define SEAM(k) do { if (IN(k) && IN((k) + 1)) xcd_barrier(xbar); } while (0)
#ifndef REP_PHASE
#define REP_PHASE -1
#endif
#define REPS(j) for (int rep = 0, nrep = (REP_PHASE == (j)) ? 2 : 1; rep < nrep; ++rep, (rep < nrep ? xcd_barrier(xbar) : (void)0))
    bf16_t* HX = (bf16_t*)(ws + WS_HX); bf16_t* Pb = (bf16_t*)(ws + WS_P); bf16_t* Vt = (bf16_t*)(ws + WS_VT); bf16_t* Hb = (bf16_t*)(ws + WS_H);
    bf16_t* Yb = (bf16_t*)(ws + WS_Y); bf16_t* YF = (bf16_t*)(ws + WS_YF); float* SSQ = (float*)(ws + WS_SSQ);
    unsigned* ctl = (unsigned*)(ws + WS_CTL);

    if (threadIdx.x < 2) ((volatile LAS unsigned*)(lds + LDS_BARST))[threadIdx.x] = 0u;
    __syncthreads();
    const XcdBarrier xbar = xcd_barrier_post((unsigned*)(ws + WS_BAR), (volatile LAS unsigned*)(lds + LDS_BARST));
    if (a.ph_lo < 0) grid.sync();
    REPS(30) if (IN(0)) p0_prologue(a, lds);
    SEAM(0);
    for (int l = 0; l < 2; ++l) {
        const int pb = 1 + 5 * l;
        REPS(0) if (IN(pb)) norm_phase(a, l);
        SEAM(pb);
        REPS(1) if (IN(pb + 1)) {
            pg8::Gemm g{HX, (const bf16_t*)(ws + WS_WIN) + (size_t)l * PW * DM, MROWS, PW, DM};
            pg8::StaticOrder S; S.init(MROWS, PW, (int)gridDim.x, (int)blockIdx.x);
            pg8::EpiProj E{Pb, Vt, (const float*)(ws + WS_ROPE), (bf16_t*)(ws + WS_UFP), 0.125f * LOG2E};
            pg8::gemm_phase<pg8::EpiProj, pg8::StaticOrder, true, true>((PG8_LAS unsigned char*)lds, g, S, E);
        }
        SEAM(pb + 1);
        for (int rep = 0, nrep = (REP_PHASE >= 20 && REP_PHASE < 30) ? 2 : 1; rep < nrep; ++rep, (rep < nrep ? xcd_barrier(xbar) : (void)0)) if (IN(pb + 2)) {
            const int nAttn = (l == 0) ? 1056 : 1024, nCtxF = (l == 0) ? 16 : 0, nF1 = 256, nConv = ((l == 0) ? MROWS : NTOK) / 64;
            const int e0 = nF1, e1 = e0 + nCtxF, e2 = e1 + nAttn, e3 = e2 + nConv;
            for (;;) {
                const int u = next_unit(ctl + 2 * l + 8 * rep, lds);
                if (u >= e3) break;
                if (rep == 1) { const int ty = u < e0 ? 1 : u < e1 ? 3 : u < e2 ? 0 : 2; if (REP_PHASE == 25 ? (ty == 0) : (ty != REP_PHASE - 20)) continue; }
                if (u >= e1 && u < e2) attn_unit(u - e1, Pb, Vt, Hb, a.sink + 8 * l, lds);
                else if (u >= e0 && u < e1) { const int v = u - e0, b = v >> 2, kb = v & 3;
                    dftf_unit<256>(Pb + (size_t)(NTOK + b * CTXL) * PW + C_UF, 256, PW, 0, (const bf16_t*)(ws + WS_T256R) + (size_t)(64 * kb) * 256, (const bf16_t*)(ws + WS_T256I) + (size_t)(64 * kb) * 256,
                                   (const bf16_t*)(ws + WS_GT) + (size_t)l * 4 * 64 * 128, Pb, Hb, (size_t)(NTOK + b * CTXL + 64 * kb), 1, 5.656854249492381f, lds); }
                else {
                    const int tid = opaque_tid(), lane = tid & 63, wave = __builtin_amdgcn_readfirstlane(tid >> 6);
                    if (u < e0) { fft1_tables(ws, lds + 65536, tid); __syncthreads(); fft1_wave(u * 8 + wave, (const bf16_t*)(ws + WS_UFP), YF, ws, lds + wave * 8192, lds + 65536, lane); }
                    else conv_wave((u - e2) * 8 + wave, Pb, Hb, a.conv_w + l * 768, a.conv_b + l * 256, lane);
                }
            }
        }
        SEAM(pb + 2);
        REPS(3) if (IN(pb + 3)) {
            const bool gemmwg = (l == 0 && blockIdx.x < 16);
            if (gemmwg) {
                pg8::Gemm g{Hb + (size_t)NTOK * DM, (const bf16_t*)(ws + WS_WOUT) + (size_t)l * DM * DM, NCTX, DM, DM};
                pg8::StaticOrder S; S.init(NCTX, DM, 16, (int)blockIdx.x);
                pg8::EpiY E{Yb + (size_t)NTOK * DM, SSQ + (size_t)NTOK * 16};
                pg8::gemm_phase<pg8::EpiY, pg8::StaticOrder, true, true>((PG8_LAS unsigned char*)lds, g, S, E);
            } else {
                const int tid = opaque_tid(), lane = tid & 63, wave = __builtin_amdgcn_readfirstlane(tid >> 6);
                const int nb0 = (l == 0) ? 16 : 0;
                const int gw = ((int)blockIdx.x - nb0) + wave * ((int)gridDim.x - nb0), NGW = ((int)gridDim.x - nb0) * 8;
                unsigned char* lds_w = lds + wave * 16384;
                for (int t = gw; t < 2048; t += NGW) fft3_wave(t, YF, (const bf16_t*)(ws + WS_GT) + (size_t)l * 4 * 64 * 128, Pb, Hb, ws, lds_w, lane);
            }
            __syncthreads();
        }
        SEAM(pb + 3);
        REPS(4) if (IN(pb + 4)) {
            pg8::Gemm g{Hb, (const bf16_t*)(ws + WS_WOUT) + (size_t)l * DM * DM, NTOK, DM, DM};
            pg8::StaticOrder S; S.init(NTOK, DM, (int)gridDim.x, (int)blockIdx.x);
            pg8::EpiY E{l == 0 ? Yb : HX, l == 0 ? SSQ : (float*)(ws + WS_SSQ1)};
            pg8::gemm_phase<pg8::EpiY, pg8::StaticOrder, true, true>((PG8_LAS unsigned char*)lds, g, S, E);
        }
        SEAM(pb + 4);
    }
#if REP_PHASE == 9
    for (int i = 0; i < 10; ++i) xcd_barrier(xbar);
#endif
    if (IN(11)) norm_phase(a, 2);
#undef IN
#undef SEAM
}

#ifndef MK_MULTI
#define MK_MULTI 0
#endif
extern "C" void kernel_launch(void* const* d_in, const int* in_sizes, int n_in, void* d_out, int out_size, void* d_ws, size_t ws_size, hipStream_t stream) {
    static int grid = 0;
    if (grid == 0) {
        if (n_in != 14 || ws_size < WS_END) { fprintf(stderr, "kernel_launch: unexpected n_in %d or ws_size %zu (need %zu)\n", n_in, ws_size, (size_t)WS_END); grid = -1; return; }
        int dev = 0, cus = 0, per_cu = 0;
        hipGetDevice(&dev); hipDeviceGetAttribute(&cus, hipDeviceAttributeMultiprocessorCount, dev);
        if (hipFuncSetAttribute((const void*)hybrid_fwd, hipFuncAttributeMaxDynamicSharedMemorySize, LDS_BYTES) != hipSuccess) { fprintf(stderr, "kernel_launch: hipFuncSetAttribute failed\n"); grid = -1; return; }
        if (hipOccupancyMaxActiveBlocksPerMultiprocessor(&per_cu, (const void*)hybrid_fwd, NTHREADS, LDS_BYTES) != hipSuccess || per_cu < 1) { fprintf(stderr, "kernel_launch: occupancy query gave %d\n", per_cu); per_cu = 1; }
        (void)hipGetLastError();
        grid = cus * 1;
        fprintf(stderr, "kernel_launch: grid %d (cus %d, per_cu %d)\n", grid, cus, per_cu);
    }
    if (grid < 0) return;
    if (hipMemsetAsync((char*)d_ws + WS_CTL, 0, WS_ZERO_BYTES, stream) != hipSuccess) { fprintf(stderr, "kernel_launch: hipMemsetAsync failed\n"); return; }
    KArgs a{};
    a.x = (const float*)d_in[0]; a.c = (const float*)d_in[1]; a.ctx = (const float*)d_in[2]; a.c_ctx = (const float*)d_in[3]; a.w_mod = (const float*)d_in[4]; a.b_mod = (const float*)d_in[5];
    a.g_pre = (const float*)d_in[6]; a.g_post = (const float*)d_in[7]; a.w_in = (const float*)d_in[8]; a.w_out = (const float*)d_in[9]; a.sink = (const float*)d_in[10]; a.w_f = (const float*)d_in[11];
    a.conv_w = (const float*)d_in[12]; a.conv_b = (const float*)d_in[13];
    a.out = (float*)d_out; a.ws = (unsigned char*)d_ws;
#if MK_MULTI
    for (int ph = 0; ph < 12; ++ph) { a.ph_lo = ph; a.ph_hi = ph + 1; hipLaunchKernelGGL(hybrid_fwd, dim3(grid), dim3(NTHREADS), LDS_BYTES, stream, a); }
#else
    a.ph_lo = 0; a.ph_hi = 12;
    void* args[] = {&a};
    hipError_t e = hipLaunchCooperativeKernel((const void*)hybrid_fwd, dim3(grid), dim3(NTHREADS), args, LDS_BYTES, stream);
    if (e != hipSuccess) fprintf(stderr, "kernel_launch: cooperative launch failed: %s (grid %d)\n", hipGetErrorString(e), grid);
#endif
}
```

```cpp
#include <hip/hip_runtime.h>
#include <hip/hip_cooperative_groups.h>
#include <cstdio>
#include <cstdint>
namespace cg = cooperative_groups;
namespace pg8 {
#define PG8_LAS __attribute__((address_space(3)))
typedef unsigned short bf16_t;
typedef short bf16x8 __attribute__((ext_vector_type(8)));
typedef float f32x4 __attribute__((ext_vector_type(4)));
typedef unsigned u32x4 __attribute__((ext_vector_type(4)));
constexpr int BM = 256, BK = 64, HALF = 128, HTB = HALF * BK * 2  , STAGE_BYTES = 8 * HTB, NXCD = 8, WGM = 8;

__host__ __device__ __forceinline__ int lds_byte(int r, int c) { const int st = (r >> 4) * 2 + (c >> 5), rr = r & 15, cc = c & 31, ob = rr * 64 + cc * 2; return st * 1024 + (ob ^ (((ob >> 9) & 1) << 5)); }
__host__ __device__ __forceinline__ void stage_rc(int b, int& R, int& C) { const int st = b / 1024, sb = b % 1024, swz = sb ^ (((sb >> 9) & 1) << 5); R = (st >> 1) * 16 + swz / 64; C = (st & 1) * 32 + (swz % 64) / 2; }
__host__ __device__ __forceinline__ int perm32(int rho) { const int n = rho >> 4, i = rho & 15; return 8 * (i >> 2) + 4 * n + (i & 3); }

struct Unit { int pm, pn; };
struct Gemm { const bf16_t* A; const bf16_t* Bt; int M, N, K; };

struct StaticOrder {
    int nM, nN, nwg, G, c;
    __host__ __device__ void init(int M, int N, int G_, int c_) { nM = M / BM; nN = N / BM; nwg = nM * nN; G = G_; c = c_; }
    __host__ __device__ bool next(int i, Unit& u) const {
        const long L = (long)i * G + c; if (L >= nwg) return false;
        int wgid = (int)L; { const int q = nwg / NXCD, r = nwg % NXCD, xcd = wgid % NXCD, off = wgid / NXCD; wgid = (xcd < r ? xcd * (q + 1) : r * (q + 1) + (xcd - r) * q) + off; }
        const int nig = WGM * nN, gid = wgid / nig, fm = gid * WGM, gsz = (nM - fm) < WGM ? (nM - fm) : WGM;
        u.pm = fm + ((wgid % nig) % gsz); u.pn = (wgid % nig) / gsz; return true;
    }
    __device__ __forceinline__ void a_ready(const Unit&) const {}
    __device__ __forceinline__ void done(const Unit&) const {}
};

__device__ __forceinline__ unsigned cvt_pk_bf16(float lo, float hi) { unsigned r; asm volatile("v_cvt_pk_bf16_f32 %0, %1, %2" : "=v"(r) : "v"(lo), "v"(hi)); return r; }
typedef unsigned u32x2 __attribute__((ext_vector_type(2)));
__device__ __forceinline__ int swap23(int t) { return (t & ~12) | ((t & 4) << 1) | ((t & 8) >> 1); }
struct EpiProj {
    static constexpr bool PERM = true, AFTER_DRAIN = false;
    bf16_t* P; bf16_t* Vt; const float* rope; bf16_t* UFP; float qscale;
    __device__ __forceinline__ void operator()(const f32x4 (&acc)[2][2][4][2], const Unit& u, int wr, int wc, int fr, int fq) const {
        const int row0 = u.pm * BM + wr * 64 + fr;
        const int pn = u.pn;
        const bool ctxrow = u.pm >= 128;
        f32x4 CS[2][4], SN[2][4];
        if (pn <= 2) {
#pragma unroll
            for (int ai = 0; ai < 2; ++ai)
#pragma unroll
                for (int m = 0; m < 4; ++m) {
                    CS[ai][m] = (f32x4){1.f, 1.f, 1.f, 1.f}; SN[ai][m] = (f32x4){0.f, 0.f, 0.f, 0.f};
                    if (!ctxrow) { const int t = (row0 + ai * HALF + m * 16) & 8191; const int pos = (wc & 1) ? (t & 63) : (t >> 6);
                        CS[ai][m] = *(const f32x4*)(rope + pos * 32 + 4 * fq); SN[ai][m] = *(const f32x4*)(rope + pos * 32 + 16 + 4 * fq); }
                }
            __builtin_amdgcn_sched_barrier(0);
        }
#pragma unroll
        for (int ai = 0; ai < 2; ++ai)
#pragma unroll
            for (int m = 0; m < 4; ++m) {
                const int row = row0 + ai * HALF + m * 16;
                bf16_t* rowp = P + (size_t)row * 2816 + pn * BM + wc * 32 + 8 * fq;
                if (pn == 5 && !ctxrow) { const int t = row & 8191; rowp = UFP + ((size_t)(((row >> 13) * 64 + (t & 63)) * 128 + (t >> 6))) * 256 + wc * 32 + 8 * fq; }
                if (pn > 2) {
#pragma unroll
                    for (int bj = 0; bj < 2; ++bj) { const f32x4 v0 = acc[ai][bj][m][0], v1 = acc[ai][bj][m][1];
                        u32x4 w; w.x = cvt_pk_bf16(v0[0], v0[1]); w.y = cvt_pk_bf16(v0[2], v0[3]); w.z = cvt_pk_bf16(v1[0], v1[1]); w.w = cvt_pk_bf16(v1[2], v1[3]);
                        *(u32x4*)(rowp + bj * HALF) = w; }
                } else {
                    const f32x4 cs = CS[ai][m], sn = SN[ai][m];
#pragma unroll
                    for (int bj = 0; bj < 2; ++bj) {
                        f32x4 v0 = acc[ai][bj][m][0], v1 = acc[ai][bj][m][1];
                        if (pn == 2 && bj == 1) {
                            u32x4 w; w.x = cvt_pk_bf16(v0[0], v0[1]); w.y = cvt_pk_bf16(v0[2], v0[3]); w.z = cvt_pk_bf16(v1[0], v1[1]); w.w = cvt_pk_bf16(v1[2], v1[3]);
                            *(u32x4*)(rowp + bj * HALF) = w;
                        } else {
                            const f32x4 r0 = v0 * cs - v1 * sn, r1 = v0 * sn + v1 * cs;
                            v0 = r0; v1 = r1;
                            if (pn < 2) { v0 = v0 * qscale; v1 = v1 * qscale; }
                            u32x4 w; w.x = cvt_pk_bf16(v0[0], v0[1]); w.y = cvt_pk_bf16(v0[2], v0[3]); w.z = cvt_pk_bf16(v1[0], v1[1]); w.w = cvt_pk_bf16(v1[2], v1[3]);
                            *(u32x4*)(rowp + bj * HALF) = w;
                        }
                    }
                }
            }
    }
};
struct EpiY {
    static constexpr bool PERM = true, AFTER_DRAIN = false;
    bf16_t* Y; float* ssq;
    __device__ __forceinline__ void operator()(const f32x4 (&acc)[2][2][4][2], const Unit& u, int wr, int wc, int fr, int fq) const {
        const int row0 = u.pm * BM + wr * 64 + fr;
#pragma unroll
        for (int ai = 0; ai < 2; ++ai)
#pragma unroll
            for (int m = 0; m < 4; ++m) {
                const int row = row0 + ai * HALF + m * 16;
                bf16_t* rowp = Y + (size_t)row * 1024 + u.pn * BM + wc * 32 + 8 * fq;
                float s = 0.f;
#pragma unroll
                for (int bj = 0; bj < 2; ++bj) { const f32x4 v0 = acc[ai][bj][m][0], v1 = acc[ai][bj][m][1];
                    s += (v0[0] * v0[0] + v0[1] * v0[1]) + (v0[2] * v0[2] + v0[3] * v0[3]) + (v1[0] * v1[0] + v1[1] * v1[1]) + (v1[2] * v1[2] + v1[3] * v1[3]);
                    u32x4 w; w.x = cvt_pk_bf16(v0[0], v0[1]); w.y = cvt_pk_bf16(v0[2], v0[3]); w.z = cvt_pk_bf16(v1[0], v1[1]); w.w = cvt_pk_bf16(v1[2], v1[3]);
                    *(u32x4*)(rowp + bj * HALF) = w; }
                s += __shfl_xor(s, 16); s += __shfl_xor(s, 32);
                if (fq == 0) ssq[(size_t)row * 16 + u.pn * 4 + wc] = s;
            }
    }
};
template <class Epi, class Sched, bool ALIGN_EPI = false, bool SP2 = false>
__device__ __forceinline__ void gemm_phase(PG8_LAS unsigned char* lds, const Gemm g, const Sched& S, const Epi& E) {
    int tid_ = threadIdx.x; asm volatile("" : "+v"(tid_));
    const int tid = tid_, wid = __builtin_amdgcn_readfirstlane(tid >> 6), lane = tid & 63, wr = wid >> 2, wc = wid & 3, fr = lane & 15, fq = lane >> 4;
    const int K = g.K, nt = K / BK;
    unsigned voffA[2], voffB[2];
#pragma unroll
    for (int i = 0; i < 2; ++i) { int R, C; stage_rc(tid * 16 + i * 8192, R, C); const int Rb = Epi::PERM ? ((R & ~31) + perm32(R & 31)) : R;
        voffA[i] = (unsigned)(R * K + C) * 2u; voffB[i] = (unsigned)(Rb * K + C) * 2u; }
    const size_t kstep = (size_t)(BK * 2);
    const size_t hstep = (size_t)HALF * K * 2;
    const size_t tstep = 2 * hstep;
    const unsigned ldsw = (unsigned)wid * 1024u;
    const int aoff = lds_byte(wr * 64 + fr, fq * 8), boff = lds_byte(wc * 32 + fr, fq * 8);
#define PG8_SA(b, h) (((b) * 2 + (h)) * HTB)
#define PG8_SB(b, h) ((4 + (b) * 2 + (h)) * HTB)
#define PG8_STAGE(bufoff, gbase, voff) do { _Pragma("unroll") for (int _i = 0; _i < 2; ++_i) \
        __builtin_amdgcn_global_load_lds((const unsigned*)((const char*)(gbase) + (voff)[_i]), (PG8_LAS unsigned*)(lds + (bufoff) + ldsw + _i * 8192), 16, 0, 0); } while (0)
#define PG8_LDA(dst, b, h) do { _Pragma("unroll") for (int m = 0; m < 4; ++m) _Pragma("unroll") for (int k = 0; k < 2; ++k) dst[m][k] = *(const PG8_LAS bf16x8*)(lds + PG8_SA(b, h) + aoff + m * 2048 + k * 1024); } while (0)
#define PG8_LDB(dst, b, h) do { _Pragma("unroll") for (int n = 0; n < 2; ++n) _Pragma("unroll") for (int k = 0; k < 2; ++k) dst[n][k] = *(const PG8_LAS bf16x8*)(lds + PG8_SB(b, h) + boff + n * 2048 + k * 1024); } while (0)
#define PG8_MMA(ai, bj, At, Bt) do { __builtin_amdgcn_s_setprio(1); _Pragma("unroll") for (int m = 0; m < 4; ++m) _Pragma("unroll") for (int n = 0; n < 2; ++n) _Pragma("unroll") for (int k = 0; k < 2; ++k) \
        acc[ai][bj][m][n] = __builtin_amdgcn_mfma_f32_16x16x32_bf16(Bt[n][k], At[m][k], acc[ai][bj][m][n], 0, 0, 0); __builtin_amdgcn_s_setprio(0); } while (0)
#define PG8_WAIT_V(n) asm volatile("s_waitcnt vmcnt(" #n ")" ::: "memory")
#define PG8_WAIT_L(n) asm volatile("s_waitcnt lgkmcnt(" #n ")" ::: "memory")
#define PG8_BAR __builtin_amdgcn_s_barrier()
#define PG8_SCHED __builtin_amdgcn_sched_barrier(0)
    Unit cur, nxt; int ui = 0;
    if (!S.next(0, cur)) return;
    f32x4 acc[2][2][4][2];
#pragma unroll
    for (int a = 0; a < 2; ++a)
#pragma unroll
        for (int b = 0; b < 2; ++b)
#pragma unroll
            for (int m = 0; m < 4; ++m)
#pragma unroll
                for (int n = 0; n < 2; ++n) acc[a][b][m][n] = (f32x4){0.f, 0.f, 0.f, 0.f};
    bf16x8 At[4][2], B0[2][2], B1[2][2];
    const char* cA = (const char*)g.A + (size_t)cur.pm * tstep; const char* cB = (const char*)g.Bt + (size_t)cur.pn * tstep;
    S.a_ready(cur);
    if constexpr (SP2) {
        PG8_STAGE(PG8_SB(0, 0), cB, voffB); PG8_STAGE(PG8_SB(0, 1), cB + hstep, voffB); PG8_STAGE(PG8_SA(0, 0), cA, voffA); PG8_STAGE(PG8_SA(0, 1), cA + hstep, voffA);
        if (wr == 1) PG8_BAR;
        PG8_WAIT_V(2); PG8_BAR;
        PG8_STAGE(PG8_SB(1, 0), cB + kstep, voffB); PG8_STAGE(PG8_SA(1, 0), cA + kstep, voffA); PG8_STAGE(PG8_SB(1, 1), cB + hstep + kstep, voffB);
        PG8_WAIT_V(6); PG8_BAR;
    } else {
        PG8_STAGE(PG8_SB(0, 0), cB, voffB); PG8_STAGE(PG8_SA(0, 0), cA, voffA); PG8_STAGE(PG8_SB(0, 1), cB + hstep, voffB); PG8_STAGE(PG8_SA(0, 1), cA + hstep, voffA);
        if (wr == 1) PG8_BAR;
        PG8_WAIT_V(4); PG8_BAR;
        PG8_STAGE(PG8_SB(1, 0), cB + kstep, voffB); PG8_STAGE(PG8_SA(1, 0), cA + kstep, voffA); PG8_STAGE(PG8_SB(1, 1), cB + hstep + kstep, voffB);
        PG8_WAIT_V(6); PG8_BAR;
    }
    for (;;) {
        const bool has_next = S.next(ui + 1, nxt);
        const char* nA = has_next ? (const char*)g.A + (size_t)nxt.pm * tstep : cA; const char* nB = has_next ? (const char*)g.Bt + (size_t)nxt.pn * tstep : cB;
        for (int t = 0; t < nt; t += 2) {
            const bool last = (t == nt - 2);
            const char* a1 = cA + (size_t)(t + 1) * kstep;
            const char* a2 = last ? nA : cA + (size_t)(t + 2) * kstep; const char* b2 = last ? nB : cB + (size_t)(t + 2) * kstep;
            const char* a3 = a2 + kstep; const char* b3 = b2 + kstep;
            if (last && has_next) S.a_ready(nxt);
            if constexpr (SP2) {
            PG8_LDB(B0, 0, 0); PG8_LDB(B1, 0, 1); PG8_SCHED; PG8_LDA(At, 0, 0); PG8_STAGE(PG8_SA(1, 1), a1 + hstep, voffA);
            PG8_WAIT_V(8); PG8_WAIT_L(0); PG8_BAR; PG8_MMA(0, 0, At, B0); PG8_MMA(0, 1, At, B1); PG8_BAR; PG8_SCHED;
            PG8_LDA(At, 0, 1); PG8_STAGE(PG8_SB(0, 0), b2, voffB); PG8_STAGE(PG8_SB(0, 1), b2 + hstep, voffB); PG8_STAGE(PG8_SA(0, 0), a2, voffA);
            PG8_WAIT_V(8); PG8_WAIT_L(0); PG8_BAR; PG8_MMA(1, 0, At, B0); PG8_MMA(1, 1, At, B1); PG8_BAR; PG8_SCHED;
            PG8_LDB(B0, 1, 0); PG8_LDB(B1, 1, 1); PG8_SCHED; PG8_LDA(At, 1, 0); PG8_STAGE(PG8_SA(0, 1), a2 + hstep, voffA);
            PG8_WAIT_V(8); PG8_WAIT_L(0); PG8_BAR; PG8_MMA(0, 0, At, B0); PG8_MMA(0, 1, At, B1); PG8_BAR; PG8_SCHED;
            PG8_LDA(At, 1, 1); PG8_STAGE(PG8_SB(1, 0), b3, voffB); PG8_STAGE(PG8_SB(1, 1), b3 + hstep, voffB); PG8_STAGE(PG8_SA(1, 0), a3, voffA);
            PG8_WAIT_V(8); PG8_WAIT_L(0); PG8_BAR; PG8_MMA(1, 0, At, B0); PG8_MMA(1, 1, At, B1); PG8_BAR; PG8_SCHED;
            } else {
            PG8_LDB(B0, 0, 0); PG8_SCHED; PG8_LDA(At, 0, 0); PG8_STAGE(PG8_SA(1, 1), a1 + hstep, voffA);
            PG8_WAIT_L(8); PG8_BAR; PG8_WAIT_L(0); PG8_MMA(0, 0, At, B0); PG8_BAR; PG8_SCHED;
            PG8_LDB(B1, 0, 1); PG8_STAGE(PG8_SB(0, 0), b2, voffB);
            PG8_BAR; PG8_WAIT_L(0); PG8_MMA(0, 1, At, B1); PG8_BAR;
            PG8_LDA(At, 0, 1); PG8_STAGE(PG8_SA(0, 0), a2, voffA);
            PG8_BAR; PG8_WAIT_L(0); PG8_MMA(1, 0, At, B0); PG8_BAR; PG8_SCHED;
            PG8_STAGE(PG8_SB(0, 1), b2 + hstep, voffB);
            PG8_WAIT_V(6); PG8_BAR; PG8_MMA(1, 1, At, B1); PG8_BAR;
            PG8_LDB(B0, 1, 0); PG8_SCHED; PG8_LDA(At, 1, 0); PG8_STAGE(PG8_SA(0, 1), a2 + hstep, voffA);
            PG8_WAIT_L(8); PG8_BAR; PG8_WAIT_L(0); PG8_MMA(0, 0, At, B0); PG8_BAR; PG8_SCHED;
            PG8_LDB(B1, 1, 1); PG8_STAGE(PG8_SB(1, 0), b3, voffB);
            PG8_BAR; PG8_WAIT_L(0); PG8_MMA(0, 1, At, B1); PG8_BAR;
            PG8_LDA(At, 1, 1); PG8_STAGE(PG8_SA(1, 0), a3, voffA);
            PG8_BAR; PG8_WAIT_L(0); PG8_MMA(1, 0, At, B0); PG8_BAR; PG8_SCHED;
            PG8_STAGE(PG8_SB(1, 1), b3 + hstep, voffB);
            PG8_WAIT_V(6); PG8_BAR; PG8_MMA(1, 1, At, B1); PG8_BAR;
            }
        }
        if constexpr (ALIGN_EPI) { if (wr == 0) PG8_BAR; }
        if constexpr (!Epi::AFTER_DRAIN) { E(acc, cur, wr, wc, fr, fq); S.done(cur); }
        if (!has_next) break;
#pragma unroll
        for (int a = 0; a < 2; ++a)
#pragma unroll
            for (int b = 0; b < 2; ++b)
#pragma unroll
                for (int m = 0; m < 4; ++m)
#pragma unroll
                    for (int n = 0; n < 2; ++n) acc[a][b][m][n] = (f32x4){0.f, 0.f, 0.f, 0.f};
        cur = nxt; cA = nA; cB = nB; ++ui;
        if constexpr (ALIGN_EPI) { if (wr == 1) PG8_BAR; }
    }
    PG8_WAIT_V(0);
    if constexpr (!ALIGN_EPI) { if (wr == 0) PG8_BAR; }
    PG8_BAR;
    if constexpr (Epi::AFTER_DRAIN) { E.fused(acc, cur, wr, wc, fr, fq, lds, wid, lane); S.done(cur); }
#undef PG8_SA
#undef PG8_SB
#undef PG8_STAGE
#undef PG8_LDA
#undef PG8_LDB
#undef PG8_MMA
#undef PG8_WAIT_V
#undef PG8_WAIT_L
#undef PG8_BAR
#undef PG8_SCHED
}
}

typedef unsigned short bf16_t;
typedef short bf16x8 __attribute__((ext_vector_type(8)));
typedef float f32x4 __attribute__((ext_vector_type(4)));
typedef float f32x16 __attribute__((ext_vector_type(16)));
typedef unsigned u32x4 __attribute__((ext_vector_type(4)));
typedef unsigned u32x2 __attribute__((ext_vector_type(2)));
#define LAS __attribute__((address_space(3)))
__device__ __forceinline__ int opaque_tid() { int t = threadIdx.x; asm volatile("" : "+v"(t)); return t; }

constexpr int DM = 1024, NBATCH = 4, SEQ = 8192, NTOK = NBATCH * SEQ, CTXL = 256, NCTX = NBATCH * CTXL, MROWS = NTOK + NCTX;
constexpr int PW = 2816;
constexpr int C_Q = 0, C_K = 512, C_V = 640, C_GA = 768, C_UF = 1280, C_GF = 1536, C_ZC = 1792, C_BC = 2048, C_CC = 2304, C_GC = 2560;
constexpr int VT_PITCH = SEQ + CTXL;
constexpr float NORM_EPS = 1e-6f;
constexpr float LOG2E = 1.4426950408889634f;

constexpr size_t KiB = 1024, MiB = 1u << 20;
constexpr size_t WS_CTL = 0;
constexpr size_t WS_BAR = 16 * KiB;
constexpr size_t WS_ZERO_BYTES = 32 * KiB;
constexpr size_t WS_MOD = 64 * KiB;
constexpr size_t WS_ROPE = 256 * KiB;
constexpr size_t WS_TW = 320 * KiB;
constexpr size_t WS_T1R = 384 * KiB, WS_T1I = 416 * KiB;
constexpr size_t WS_T3R = 448 * KiB, WS_T3I = 464 * KiB;
constexpr size_t WS_T256R = 512 * KiB, WS_T256I = 640 * KiB;
constexpr size_t WS_GT = 768 * KiB;
constexpr size_t WS_SSQ = 1 * MiB;
constexpr size_t WS_WIN = 4 * MiB;
constexpr size_t WS_WOUT = 16 * MiB;
constexpr size_t WS_SSQ1 = 24 * MiB;
constexpr size_t WS_MODP = 28 * MiB;
constexpr size_t WS_HX = 32 * MiB;
constexpr size_t WS_P = 112 * MiB;
constexpr size_t WS_VT = 304 * MiB;
constexpr size_t WS_H = 320 * MiB;
constexpr size_t WS_Y = 392 * MiB;
constexpr size_t WS_YF = 464 * MiB;
constexpr size_t WS_CTX1 = 100 * MiB;
constexpr size_t WS_UFP = 496 * MiB;
constexpr size_t WS_END = 512 * MiB;
static_assert(WS_BAR + 3456 * 4 <= WS_ZERO_BYTES && WS_MODP + (size_t)2 * 8 * 5 * 3072 * 4 <= WS_HX && WS_SSQ + (size_t)MROWS * 16 * 4 <= WS_WIN && WS_WIN + (size_t)2 * PW * DM * 2 <= WS_WOUT && WS_HX + (size_t)MROWS * DM * 2 <= WS_P && WS_P + (size_t)MROWS * PW * 2 <= WS_VT &&
              WS_VT + (size_t)8 * 64 * VT_PITCH * 2 <= WS_H && WS_H + (size_t)MROWS * DM * 2 <= WS_Y && WS_Y + (size_t)MROWS * DM * 2 <= WS_YF && WS_YF + (size_t)4 * 128 * 64 * 512 * 2 <= WS_UFP && WS_UFP + (size_t)NTOK * 256 * 2 <= WS_END && WS_HX + (size_t)MROWS * DM * 2 <= WS_CTX1 && WS_CTX1 + (size_t)NCTX * DM * 4 <= WS_P, "ws map");

constexpr int LDS_BYTES = 147456;
constexpr int LDS_SCHED = LDS_BYTES - 64;
constexpr int LDS_BARST = LDS_BYTES - 32;
constexpr int NTHREADS = 512;

__device__ __forceinline__ float bf2f(unsigned h) { return __uint_as_float(h << 16); }
__device__ __forceinline__ unsigned pkbf(float lo, float hi) { unsigned r; asm volatile("v_cvt_pk_bf16_f32 %0, %1, %2" : "=v"(r) : "v"(lo), "v"(hi)); return r; }
__device__ __forceinline__ float silu_f(float x) { return x * __builtin_amdgcn_rcpf(1.f + __builtin_amdgcn_exp2f(-x * LOG2E)); }
__device__ __forceinline__ float wave_sum(float v) {
#pragma unroll
    for (int o = 1; o < 64; o <<= 1) v += __shfl_xor(v, o);
    return v;
}
__device__ __forceinline__ int swap23(int t) { return (t & ~12) | ((t & 4) << 1) | ((t & 8) >> 1); }
__device__ __forceinline__ int crow(int r, int hi) { return (r & 3) + 8 * (r >> 2) + 4 * hi; }
__device__ __forceinline__ bf16x8 pack8(const f32x16& p, int base) {
    u32x4 w; w.x = pkbf(p[base + 0], p[base + 1]); w.y = pkbf(p[base + 2], p[base + 3]); w.z = pkbf(p[base + 4], p[base + 5]); w.w = pkbf(p[base + 6], p[base + 7]);
    return __builtin_bit_cast(bf16x8, w);
}
#define MFMA32(a, b, c) __builtin_amdgcn_mfma_f32_32x32x16_bf16((a), (b), (c), 0, 0, 0)

struct KArgs {
    const float *x, *c, *ctx, *c_ctx, *w_mod, *b_mod, *g_pre, *g_post, *w_in, *w_out, *sink, *w_f, *conv_w, *conv_b;
    float* out; unsigned char* ws; int ph_lo, ph_hi;
};

__device__ __forceinline__ int prow_qk(int n) { return (n & ~31) | (8 * ((n >> 2) & 3) + 4 * ((n >> 4) & 1) + (n & 3)); }
__device__ __forceinline__ void p0_transpose_item(const float* W, int K, int N, bf16_t* WT, int nperm, float* scr, int item, int lane) {
    const int nblk = N / 32, kb = item / nblk, nb = item % nblk, k0 = 64 * kb, n0 = 32 * nb;
    { float wv[32];
#pragma unroll
      for (int i = 0; i < 32; ++i) wv[i] = __builtin_nontemporal_load(W + (size_t)(k0 + 2 * i + (lane >> 5)) * N + n0 + (lane & 31));
      __builtin_amdgcn_sched_barrier(0);
#pragma unroll
      for (int i = 0; i < 32; ++i) scr[(2 * i + (lane >> 5)) * 33 + (lane & 31)] = wv[i];
      __builtin_amdgcn_sched_barrier(0); }
    asm volatile("s_waitcnt lgkmcnt(0)" ::: "memory");
    const int c = lane & 7;
#pragma unroll
    for (int j = 0; j < 4; ++j) { const int n = (lane >> 3) + 8 * j; const float* s = scr + (8 * c) * 33 + n;
        u32x4 o; o.x = pkbf(s[0 * 33], s[1 * 33]); o.y = pkbf(s[2 * 33], s[3 * 33]); o.z = pkbf(s[4 * 33], s[5 * 33]); o.w = pkbf(s[6 * 33], s[7 * 33]);
        const int nl = n0 + n; const int np = nl < nperm ? prow_qk(nl) : nl;
        *(u32x4*)(WT + (size_t)np * K + k0 + 8 * c) = o; }
    asm volatile("s_waitcnt lgkmcnt(0)" ::: "memory");
}

__device__ __forceinline__ void p0_mod_gemv(const KArgs& a, int item, float* ldsf) {
    const int tid = opaque_tid(), lane = tid & 63, wave = tid >> 6;
    const int l = item / 96, col0 = (item % 96) * 32;
    float* s = ldsf;
    float* red = ldsf + 5 * 1024;
    for (int i = tid; i < 5 * 1024; i += NTHREADS) { const int bb = i >> 10, k = i & 1023; const float v = bb < 4 ? a.c[bb * 1024 + k] : a.c_ctx[k]; s[i] = v / (1.f + __expf(-v)); }
    __syncthreads();
    const int col = lane & 31, kh = lane >> 5;
    const float* W = a.w_mod + (size_t)l * 1024 * 3072 + (size_t)(wave * 128 + kh) * 3072 + col0 + col;
    float w[64];
#pragma unroll
    for (int i = 0; i < 64; ++i) w[i] = __builtin_nontemporal_load(W + (size_t)(2 * i) * 3072);
    float acc[5] = {0.f, 0.f, 0.f, 0.f, 0.f};
#pragma unroll
    for (int i = 0; i < 64; ++i)
#pragma unroll
        for (int bb = 0; bb < 5; ++bb) acc[bb] += w[i] * s[bb * 1024 + wave * 128 + 2 * i + kh];
#pragma unroll
    for (int bb = 0; bb < 5; ++bb) red[((wave * 2 + kh) * 5 + bb) * 32 + col] = acc[bb];
    __syncthreads();
    if (tid < 160) { const int bb = tid >> 5, cc = tid & 31; float v = a.b_mod[l * 3072 + col0 + cc];
#pragma unroll
        for (int ww = 0; ww < 16; ++ww) v += red[(ww * 5 + bb) * 32 + cc];
        ((float*)(a.ws + WS_MOD))[(l * 5 + bb) * 3072 + col0 + cc] = v; }
    __syncthreads();
}

__device__ __forceinline__ void p0_prologue(const KArgs& a, unsigned char* lds) {
    const int tid = opaque_tid(), lane = tid & 63, wave = tid >> 6;
    const int G = gridDim.x, bx = blockIdx.x;
    unsigned char* ws = a.ws;
    if (bx < 192) p0_mod_gemv(a, bx, (float*)lds);
    {
        float* scr = (float*)(lds + wave * 16384);
        const int gw = bx * 8 + wave, NGW = G * 8;
        constexpr int I_IN = (DM / 64) * (PW / 32), I_OUT = (DM / 64) * (DM / 32);
        constexpr int NIT = 2 * (I_IN + I_OUT);
        for (int it = gw; it < NIT; it += NGW) {
            int r = it; const int l = r / (I_IN + I_OUT); r -= l * (I_IN + I_OUT);
            if (r < I_IN) p0_transpose_item(a.w_in + (size_t)l * DM * PW, DM, PW, (bf16_t*)(ws + WS_WIN) + (size_t)l * PW * DM, 640, scr, r, lane);
            else p0_transpose_item(a.w_out + (size_t)l * DM * DM, DM, DM, (bf16_t*)(ws + WS_WOUT) + (size_t)l * DM * DM, 0, scr, r - I_IN, lane);
        }
    }
    const int gt = bx * NTHREADS + tid, NGT = G * NTHREADS;
    for (int i = gt; i < 128 * 16; i += NGT) {
        const int pos = i >> 4, f = i & 15; const float inv = powf(10000.0f, -(float)f / 16.0f); const float ang = (float)pos * inv;
        float* rp = (float*)(ws + WS_ROPE) + pos * 32; rp[f] = cosf(ang); rp[16 + f] = sinf(ang);
    }
    for (int i = gt; i < 8192; i += NGT) { float sn, cs; sincospif((float)i * (2.0f / 8192.0f), &sn, &cs); float* t = (float*)(ws + WS_TW) + 2 * i; t[0] = cs; t[1] = sn; }
    for (int i = gt; i < 128 * 128; i += NGT) { const int k = i >> 7, n = i & 127; float sn, cs; sincospif((float)((k * n) & 127) * (2.0f / 128.0f), &sn, &cs);
        ((bf16_t*)(ws + WS_T1R))[i] = (bf16_t)(pkbf(cs, 0.f) & 0xffffu); ((bf16_t*)(ws + WS_T1I))[i] = (bf16_t)(pkbf(-sn, 0.f) & 0xffffu); }
    for (int i = gt; i < 64 * 128; i += NGT) { const int k = i >> 7, kk = i & 127, n = kk & 63; float sn, cs; sincospif((float)((k * n) & 63) * (2.0f / 64.0f), &sn, &cs);
        const float tr = kk < 64 ? cs : sn, ti = kk < 64 ? -sn : cs;
        const int fpos = ((((k >> 5) * 8 + (kk >> 4)) * 64 + ((k & 31) + 32 * ((kk >> 3) & 1))) * 8) + (kk & 7);
        ((bf16_t*)(ws + WS_T3R))[fpos] = (bf16_t)(pkbf(tr, 0.f) & 0xffffu); ((bf16_t*)(ws + WS_T3I))[fpos] = (bf16_t)(pkbf(ti, 0.f) & 0xffffu); }
    for (int i = gt; i < 256 * 256; i += NGT) { const int k = i >> 8, n = i & 255; float sn, cs; sincospif((float)((k * n) & 255) * (2.0f / 256.0f), &sn, &cs);
        ((bf16_t*)(ws + WS_T256R))[i] = (bf16_t)(pkbf(cs, 0.f) & 0xffffu); ((bf16_t*)(ws + WS_T256I))[i] = (bf16_t)(pkbf(-sn, 0.f) & 0xffffu); }
    {
        __syncthreads();
        float* trig = (float*)lds;
        if (tid < 64) { float sn, cs; sincospif((float)tid * (2.0f / 64.0f), &sn, &cs); trig[tid] = cs; trig[64 + tid] = sn; }
        __syncthreads();
        for (int i = gt; i < 2 * 4 * 64 * 128; i += NGT) {
            const int kk = i & 127, d = (i >> 7) & 63, g = (i >> 13) & 3, l = i >> 15; const int part = kk >> 6, c = swap23(kk & 63);
            const float* wf = a.w_f + ((size_t)(l * 4 + g) * 64) * 64 + d; float sacc = 0.f;
            float wfv[64];
#pragma unroll
            for (int j = 0; j < 64; ++j) wfv[j] = wf[j * 64];
            __builtin_amdgcn_sched_barrier(0);
#pragma unroll
            for (int j = 0; j < 64; ++j) sacc += trig[part * 64 + ((c * j) & 63)] * wfv[j];
            const int gpos = ((((((l * 4 + g) * 2 + (d >> 5)) * 8 + (kk >> 4)) * 64) + ((d & 31) + 32 * ((kk >> 3) & 1))) * 8) + (kk & 7);
            ((bf16_t*)(ws + WS_GT))[gpos] = (bf16_t)(pkbf(sacc * (1.0f / 724.0773439350246f), 0.f) & 0xffffu);
        }
        __syncthreads();
    }
}

__device__ __forceinline__ void norm_rows4(int mode, int lane, const float* src, float* dst, const bf16_t* y0, const float* ssq0, const bf16_t* y1, const float* ssq1, bf16_t* hx,
                                           const f32x4 (&GA0)[4], const f32x4 (&GA1)[4], const f32x4 (&GB)[4], const f32x4 (&GC)[4]) {
    f32x4 v[4][4];
#pragma unroll
    for (int rr = 0; rr < 4; ++rr)
#pragma unroll
        for (int j = 0; j < 4; ++j) v[rr][j] = __builtin_nontemporal_load((const f32x4*)(src + (size_t)rr * DM + 4 * lane + 256 * j));
    if (mode != 0) {
        u32x2 yw[4][4], yx[4][4]; float p[4], p1[4];
#pragma unroll
        for (int rr = 0; rr < 4; ++rr) { p[rr] = ssq0[rr * 16 + (lane & 15)];
#pragma unroll
            for (int j = 0; j < 4; ++j) yw[rr][j] = __builtin_nontemporal_load((const u32x2*)(y0 + (size_t)rr * DM + 4 * lane + 256 * j)); }
        if (mode == 2) {
#pragma unroll
            for (int rr = 0; rr < 4; ++rr) { p1[rr] = ssq1[rr * 16 + (lane & 15)];
#pragma unroll
                for (int j = 0; j < 4; ++j) yx[rr][j] = __builtin_nontemporal_load((const u32x2*)(y1 + (size_t)rr * DM + 4 * lane + 256 * j)); }
        }
#pragma unroll
        for (int rr = 0; rr < 4; ++rr) {
            float q = p[rr]; q += __shfl_xor(q, 1); q += __shfl_xor(q, 2); q += __shfl_xor(q, 4); q += __shfl_xor(q, 8);
            const float rstd = 1.0f / sqrtf(q * (1.0f / DM) + NORM_EPS);
#pragma unroll
            for (int j = 0; j < 4; ++j) {
                f32x4 yy; yy[0] = bf2f(yw[rr][j].x & 0xffffu); yy[1] = bf2f(yw[rr][j].x >> 16); yy[2] = bf2f(yw[rr][j].y & 0xffffu); yy[3] = bf2f(yw[rr][j].y >> 16);
                v[rr][j] = v[rr][j] + GA0[j] * (yy * rstd);
            }
        }
        if (mode == 2) {
#pragma unroll
            for (int rr = 0; rr < 4; ++rr) {
                float q = p1[rr]; q += __shfl_xor(q, 1); q += __shfl_xor(q, 2); q += __shfl_xor(q, 4); q += __shfl_xor(q, 8);
                const float rstd = 1.0f / sqrtf(q * (1.0f / DM) + NORM_EPS);
#pragma unroll
                for (int j = 0; j < 4; ++j) {
                    f32x4 yy; yy[0] = bf2f(yx[rr][j].x & 0xffffu); yy[1] = bf2f(yx[rr][j].x >> 16); yy[2] = bf2f(yx[rr][j].y & 0xffffu); yy[3] = bf2f(yx[rr][j].y >> 16);
                    v[rr][j] = v[rr][j] + GA1[j] * (yy * rstd);
                    __builtin_nontemporal_store(v[rr][j], (f32x4*)(dst + (size_t)rr * DM + 4 * lane + 256 * j));
                }
            }
        }
    }
    if (mode != 2) {
        float s[4];
#pragma unroll
        for (int rr = 0; rr < 4; ++rr) { float t = 0.f;
#pragma unroll
            for (int j = 0; j < 4; ++j) t += (v[rr][j][0] * v[rr][j][0] + v[rr][j][1] * v[rr][j][1]) + (v[rr][j][2] * v[rr][j][2] + v[rr][j][3] * v[rr][j][3]);
            s[rr] = t; }
#pragma unroll
        for (int o = 1; o < 64; o <<= 1) {
#pragma unroll
            for (int rr = 0; rr < 4; ++rr) s[rr] += __shfl_xor(s[rr], o); }
#pragma unroll
        for (int rr = 0; rr < 4; ++rr) {
            const float rstd = 1.0f / sqrtf(s[rr] * (1.0f / DM) + NORM_EPS);
#pragma unroll
            for (int j = 0; j < 4; ++j) {
                const f32x4 o = (v[rr][j] * rstd) * GB[j] + GC[j];
                u32x2 w; w.x = pkbf(o[0], o[1]); w.y = pkbf(o[2], o[3]);
                *(u32x2*)(hx + (size_t)rr * DM + 4 * lane + 256 * j) = w;
            }
        }
    }
}
__device__ __forceinline__ void norm_phase(const KArgs& a, int mode) {
    const int tid = opaque_tid(), lane = tid & 63, wave = tid >> 6;
    const int NGW = gridDim.x * 8;
    unsigned char* ws = a.ws;
    const float* mod = (const float*)(ws + WS_MOD);
    const int lp = (mode == 0) ? 0 : 1;
    bf16_t* HX = (bf16_t*)(ws + WS_HX); const bf16_t* Y0 = (const bf16_t*)(ws + WS_Y); const float* SSQ0 = (const float*)(ws + WS_SSQ);
    const bf16_t* Y1 = (const bf16_t*)(ws + WS_HX); const float* SSQ1 = (const float*)(ws + WS_SSQ1);
    const int gw2 = wave * (int)gridDim.x + (int)blockIdx.x;
    const int nlat = NTOK / 4;
    int curb = -1; f32x4 GA0[4], GA1[4], GB[4], GC[4];
    int base = gw2 * 4, sub = 0, itc = nlat + gw2; bool inctx = false;
    for (;;) {
        int it;
        if (!inctx) { if (base >= nlat) { inctx = true; continue; } it = base + sub; if (++sub == 4) { sub = 0; base += NGW * 4; } }
        else { if (mode == 2 || itc >= nlat + NCTX / 4) break; it = itc; itc += NGW; }
        const int r = it * 4;
        const int b = r < NTOK ? (r >> 13) : 4;
        if (b != curb) { curb = b;
            const float* mp = mod + (lp * 5 + b) * 3072; const float* m0 = mod + (0 * 5 + b) * 3072; const float* m1 = mod + (1 * 5 + b) * 3072;
#pragma unroll
            for (int j = 0; j < 4; ++j) { const int c = 4 * lane + 256 * j;
                GA0[j] = *(const f32x4*)(m0 + 2048 + c) * *(const f32x4*)(a.g_post + c);
                GA1[j] = *(const f32x4*)(m1 + 2048 + c) * *(const f32x4*)(a.g_post + DM + c);
                GB[j] = *(const f32x4*)(a.g_pre + lp * DM + c) * (*(const f32x4*)(mp + 1024 + c) + 1.0f);
                GC[j] = *(const f32x4*)(mp + c); } }
        const float* src = (r < NTOK) ? a.x + (size_t)r * DM : a.ctx + (size_t)(r - NTOK) * DM;
        norm_rows4(mode, lane, src, a.out + (size_t)r * DM, Y0 + (size_t)r * DM, SSQ0 + (size_t)r * 16, Y1 + (size_t)r * DM, SSQ1 + (size_t)r * 16, HX + (size_t)r * DM, GA0, GA1, GB, GC);
    }
}

typedef short v4i16_t __attribute__((ext_vector_type(4)));
__device__ __forceinline__ v4i16_t trrd(const unsigned char* p) { return __builtin_amdgcn_ds_read_tr16_b64_v4i16((LAS v4i16_t*)p); }
__device__ __forceinline__ bf16x8 cat8(v4i16_t lo, v4i16_t hi) { return (bf16x8){lo[0], lo[1], lo[2], lo[3], hi[0], hi[1], hi[2], hi[3]}; }
__device__ __forceinline__ void attn_unit(int u, const bf16_t* P, const bf16_t* Vt, bf16_t* H, const float* sink, unsigned char* lds) {
    const int tid = opaque_tid(), lane = tid & 63, wave = __builtin_amdgcn_readfirstlane(tid >> 6), r32 = lane & 31, hi = lane >> 5;
    const bool isctx = u >= 1024;
    int b, kvh, qb;
    if (isctx) { const int v = u - 1024; b = v >> 3; kvh = (v >> 2) & 1; qb = v & 3; } else { b = u >> 8; kvh = (u >> 7) & 1; qb = u & 127; }
    const int head = kvh * 4 + (wave >> 1);
    const int qtok = qb * 64 + (wave & 1) * 32 + r32;
    const size_t qrow = isctx ? (size_t)(NTOK + b * CTXL + qtok) : (size_t)(b * SEQ + qtok);
    const float sinkv = sink[head];
    unsigned char* qscr = lds + 45056 + wave * 4608;
    u32x4 qld[4];
#pragma unroll
    for (int i4 = 0; i4 < 4; ++i4) qld[i4] = __builtin_nontemporal_load((const u32x4*)(P + (qrow - r32 + i4 * 8 + (lane >> 3)) * PW + C_Q + head * 64 + (lane & 7) * 8));
    int jlo = 0, jhi = -1;
    if (!isctx) { jlo = qb < 2 ? 2 - qb : 0; jhi = (129 - qb) < 4 ? (129 - qb) : 4; }
    const int ntiles = 4 + (jhi - jlo + 1);
    const int srow = tid >> 3, sch = tid & 7;
    const bf16_t* Kc = P + (size_t)(NTOK + b * CTXL + srow) * PW + C_K + kvh * 64 + sch * 8;
    const bf16_t* Kl = P + (size_t)(b * SEQ + srow) * PW + C_K + kvh * 64 + sch * 8;
    unsigned char* Ks = lds; unsigned char* Vs = lds + 2 * 9216;
    const int vsoff = srow * 192 + sch * 16;
    const int soff = srow * 144 + sch * 16;
    u32x4 kreg, vreg, kreg2, vreg2;
#define ATT_GLOAD(KR, VR, ti_) do { const int t_ = (ti_); \
        if (t_ < 4) { KR = *(const u32x4*)(Kc + (size_t)(64 * t_) * PW); VR = *(const u32x4*)(Kc + (size_t)(64 * t_) * PW + 128); } \
        else { const int kbase_ = qb * 64 - 128 + 64 * (jlo + t_ - 4); KR = *(const u32x4*)(Kl + (size_t)kbase_ * PW); VR = *(const u32x4*)(Kl + (size_t)kbase_ * PW + 128); } } while (0)
    const size_t qrow0 = qrow - r32;
    u32x4 gaw[4];
#pragma unroll
    for (int i4 = 0; i4 < 4; ++i4) gaw[i4] = __builtin_nontemporal_load((const u32x4*)(P + (qrow0 + i4 * 8 + (lane >> 3)) * PW + C_GA + head * 64 + (lane & 7) * 8));
    ATT_GLOAD(kreg2, vreg2, 0);
    ATT_GLOAD(kreg, vreg, 1);
#pragma unroll
    for (int i4 = 0; i4 < 4; ++i4) *(u32x4*)(qscr + (i4 * 8 + (lane >> 3)) * 144 + (lane & 7) * 16) = qld[i4];
    *(u32x4*)(Ks + soff) = kreg2; *(u32x4*)(Vs + vsoff) = vreg2;
    __syncthreads();
    bf16x8 qf[4];
#pragma unroll
    for (int d0 = 0; d0 < 4; ++d0) qf[d0] = *(const bf16x8*)(qscr + r32 * 144 + (2 * d0 + hi) * 16);
    const float sink2 = sinkv * LOG2E;
    float mref = sink2, lsum = 0.f;
    f32x16 oT[2]; oT[0] = f32x16{}; oT[1] = f32x16{};
    const int qpos = qtok;
    for (int ti = 0; ti < ntiles; ++ti) {
        const int buf = ti & 1;
        if (ti + 2 < ntiles) ATT_GLOAD(kreg2, vreg2, ti + 2);
        const unsigned char* kb = Ks + buf * 9216 + r32 * 144 + hi * 16;
        const unsigned char* vb = Vs + buf * 12288 + (4 * hi + ((lane & 15) >> 2)) * 192 + (16 * ((lane >> 4) & 1) + 4 * (lane & 3)) * 2;
        bf16x8 kf[8];
#pragma unroll
        for (int d0 = 0; d0 < 4; ++d0) { kf[2 * d0] = *(const bf16x8*)(kb + d0 * 32); kf[2 * d0 + 1] = *(const bf16x8*)(kb + 32 * 144 + d0 * 32); }
        f32x16 p0, p1;
#pragma unroll
        for (int r = 0; r < 16; ++r) { p0[r] = -mref; p1[r] = -mref; }
        __builtin_amdgcn_sched_barrier(0);
#pragma unroll
        for (int d0 = 0; d0 < 4; ++d0) { p0 = MFMA32(kf[2 * d0], qf[d0], p0); p1 = MFMA32(kf[2 * d0 + 1], qf[d0], p1); }
        bf16x8 vf[8];
#pragma unroll
        for (int blk = 0; blk < 2; ++blk)
#pragma unroll
            for (int ks = 0; ks < 4; ++ks) vf[blk * 4 + ks] = cat8(trrd(vb + (16 * ks) * 192 + blk * 64), trrd(vb + (16 * ks + 8) * 192 + blk * 64));
        __builtin_amdgcn_sched_barrier(0);
        asm volatile("s_nop 15\n\ts_nop 7" : "+v"(p0), "+v"(p1));
        if (ti >= 4) {
            const int j = jlo + ti - 4; const int kbase = qb * 64 - 128 + 64 * j;
            if (j == 0) {
#pragma unroll
                for (int r = 0; r < 16; ++r) { const int kp = kbase + crow(r, hi); if (kp < qpos - 128) p0[r] = -INFINITY; if (kp + 32 < qpos - 128) p1[r] = -INFINITY; }
            } else if (j == 4) {
#pragma unroll
                for (int r = 0; r < 16; ++r) { const int kp = kbase + crow(r, hi); if (kp > qpos + 128) p0[r] = -INFINITY; if (kp + 32 > qpos + 128) p1[r] = -INFINITY; }
            }
        }
        float rma, rmb;
        asm("v_max3_f32 %0, %1, %2, %3" : "=v"(rma) : "v"(p0[0]), "v"(p0[1]), "v"(p1[0]));
        asm("v_max3_f32 %0, %1, %2, %3" : "=v"(rmb) : "v"(p0[2]), "v"(p0[3]), "v"(p1[1]));
        asm("v_max3_f32 %0, %1, %2, %3" : "=v"(rma) : "v"(rma), "v"(p1[2]), "v"(p1[3]));
#pragma unroll
        for (int r = 4; r < 16; r += 4) {
            asm("v_max3_f32 %0, %1, %2, %3" : "=v"(rma) : "v"(rma), "v"(p0[r]), "v"(p0[r + 1]));
            asm("v_max3_f32 %0, %1, %2, %3" : "=v"(rmb) : "v"(rmb), "v"(p0[r + 2]), "v"(p0[r + 3]));
            asm("v_max3_f32 %0, %1, %2, %3" : "=v"(rma) : "v"(rma), "v"(p1[r]), "v"(p1[r + 1]));
            asm("v_max3_f32 %0, %1, %2, %3" : "=v"(rmb) : "v"(rmb), "v"(p1[r + 2]), "v"(p1[r + 3]));
        }
        float rm; asm("v_max3_f32 %0, %1, %2, %3" : "=v"(rm) : "v"(rma), "v"(rmb), "v"(rmb));
        { const float rmo = __shfl_xor(rm, 32); asm("v_max3_f32 %0, %1, %2, %3" : "=v"(rm) : "v"(rm), "v"(rmo), "v"(rmo)); }
        if (__any(rm > 8.0f)) {
            const float dl = fmaxf(rm, 0.f);
            mref += dl;
            const float f = __builtin_amdgcn_exp2f(-dl);
            lsum *= f;
#pragma unroll
            for (int r = 0; r < 16; ++r) { p0[r] -= dl; p1[r] -= dl; oT[0][r] *= f; oT[1][r] *= f; }
        }
        float ls = 0.f;
#pragma unroll
        for (int r = 0; r < 16; ++r) { p0[r] = __builtin_amdgcn_exp2f(p0[r]); p1[r] = __builtin_amdgcn_exp2f(p1[r]); ls += p0[r] + p1[r]; }
        lsum += ls;
        bf16x8 pf[4]; pf[0] = pack8(p0, 0); pf[1] = pack8(p0, 8); pf[2] = pack8(p1, 0); pf[3] = pack8(p1, 8);
#pragma unroll
        for (int blk = 0; blk < 2; ++blk)
#pragma unroll
            for (int ks = 0; ks < 4; ++ks) oT[blk] = MFMA32(vf[blk * 4 + ks], pf[ks], oT[blk]);
        if (ti + 1 < ntiles) { *(u32x4*)(Ks + (buf ^ 1) * 9216 + soff) = kreg; *(u32x4*)(Vs + (buf ^ 1) * 12288 + vsoff) = vreg; }
        kreg = kreg2; vreg = vreg2;
        __syncthreads();
    }
    lsum += __shfl_xor(lsum, 32);
    lsum += __builtin_amdgcn_exp2f(sink2 - mref);
    const float inv = 1.0f / lsum;
    unsigned char* ow = qscr;
#pragma unroll
    for (int blk = 0; blk < 2; ++blk)
#pragma unroll
        for (int g4 = 0; g4 < 4; ++g4) {
            u32x2 w; w.x = pkbf(oT[blk][4 * g4 + 0] * inv, oT[blk][4 * g4 + 1] * inv); w.y = pkbf(oT[blk][4 * g4 + 2] * inv, oT[blk][4 * g4 + 3] * inv);
            *(u32x2*)(ow + r32 * 144 + (32 * blk + 8 * g4 + 4 * hi) * 2) = w;
        }
    asm volatile("s_waitcnt lgkmcnt(0)" ::: "memory");
#pragma unroll
    for (int i4 = 0; i4 < 4; ++i4) {
        const int rr = i4 * 8 + (lane >> 3), ch = lane & 7;
        const u32x4 ov = *(const u32x4*)(ow + rr * 144 + ch * 16);
        const unsigned ovv[4] = {ov.x, ov.y, ov.z, ov.w}, gvv[4] = {gaw[i4].x, gaw[i4].y, gaw[i4].z, gaw[i4].w};
        u32x4 w;
        unsigned wv[4];
#pragma unroll
        for (int e = 0; e < 4; ++e) wv[e] = pkbf(bf2f(ovv[e] & 0xffffu) * silu_f(bf2f(gvv[e] & 0xffffu)), bf2f(ovv[e] >> 16) * silu_f(bf2f(gvv[e] >> 16)));
        w.x = wv[0]; w.y = wv[1]; w.z = wv[2]; w.w = wv[3];
        *(u32x4*)(H + (qrow0 + rr) * DM + head * 64 + ch * 8) = w;
    }
    asm volatile("s_waitcnt lgkmcnt(0)" ::: "memory");
}

__device__ __forceinline__ void fft1_unit(int u, const bf16_t* P, bf16_t* YF, const unsigned char* ws, unsigned char* lds) {
    const int tid = opaque_tid(), lane = tid & 63, wave = __builtin_amdgcn_readfirstlane(tid >> 6), r32 = lane & 31, hi = lane >> 5;
    const int b = u >> 6, n2 = u & 63;
    constexpr int UPB = 576;
    const bf16_t* src = P + (size_t)(b * SEQ + n2) * PW + C_UF;
#pragma unroll
    for (int i = 0; i < 8; ++i) {
        const int id = tid + NTHREADS * i, n1 = id >> 5, cc = id & 31;
        *(u32x4*)(lds + n1 * UPB + cc * 16) = *(const u32x4*)(src + (size_t)n1 * 64 * PW + cc * 8);
    }
    __syncthreads();
    const bf16_t* T1R = (const bf16_t*)(ws + WS_T1R); const bf16_t* T1I = (const bf16_t*)(ws + WS_T1I);
    f32x16 aR[4], aI[4];
#pragma unroll
    for (int kb = 0; kb < 4; ++kb) { aR[kb] = f32x16{}; aI[kb] = f32x16{}; }
    const unsigned char* ap = lds + (8 * hi + ((lane & 15) >> 2)) * UPB + (32 * wave + 16 * ((lane >> 4) & 1) + 4 * (lane & 3)) * 2;
#pragma unroll 2
    for (int ks = 0; ks < 8; ++ks) {
        const bf16x8 av = cat8(trrd(ap + (16 * ks) * UPB), trrd(ap + (16 * ks + 4) * UPB));
#pragma unroll
        for (int kb = 0; kb < 4; ++kb) {
            const bf16x8 bR = *(const bf16x8*)(T1R + (32 * kb + r32) * 128 + 16 * ks + 8 * hi), bI = *(const bf16x8*)(T1I + (32 * kb + r32) * 128 + 16 * ks + 8 * hi);
            aR[kb] = MFMA32(av, bR, aR[kb]); aI[kb] = MFMA32(av, bI, aI[kb]);
        }
    }
    const float* TW = (const float*)(ws + WS_TW);
#pragma unroll
    for (int kb = 0; kb < 4; ++kb) {
        const int k1 = 32 * kb + r32;
        const float ct = TW[2 * (n2 * k1)], st = TW[2 * (n2 * k1) + 1];
        bf16_t* yp = YF + ((size_t)((b * 128 + k1) * 64 + n2)) * 512 + 32 * wave + 4 * hi;
#pragma unroll
        for (int g4 = 0; g4 < 4; ++g4) {
            float yr[4], yi[4];
#pragma unroll
            for (int e = 0; e < 4; ++e) { const float r_ = aR[kb][4 * g4 + e], i_ = aI[kb][4 * g4 + e]; yr[e] = r_ * ct + i_ * st; yi[e] = i_ * ct - r_ * st; }
            u32x2 wr_, wi_; wr_.x = pkbf(yr[0], yr[1]); wr_.y = pkbf(yr[2], yr[3]); wi_.x = pkbf(yi[0], yi[1]); wi_.y = pkbf(yi[2], yi[3]);
            *(u32x2*)(yp + 8 * g4) = wr_; *(u32x2*)(yp + 256 + 8 * g4) = wi_;
        }
    }
    __syncthreads();
}

template <int KK>
__device__ __forceinline__ void dftf_unit(const bf16_t* srcbase, int R, int pitchA, int pitchB, const bf16_t* Tr, const bf16_t* Ti, const bf16_t* Gt,
                                          const bf16_t* P, bf16_t* H, size_t row0, int rowstride, float oscale, unsigned char* lds) {
    const int tid = opaque_tid(), lane = tid & 63, wave = __builtin_amdgcn_readfirstlane(tid >> 6), r32 = lane & 31, hi = lane >> 5;
    constexpr int ZPB = (KK == 128) ? 576 : 544;
#pragma unroll 1
    for (int i0 = 0; i0 < KK / 16; i0 += 8) {
        u32x4 img[8];
#pragma unroll
        for (int i = 0; i < 8; ++i) { const int id = tid + NTHREADS * (i0 + i), kk = id >> 5, cc = id & 31; img[i] = *(const u32x4*)(srcbase + (size_t)(kk % R) * pitchA + (size_t)(kk / R) * pitchB + cc * 8); }
        __builtin_amdgcn_sched_barrier(0);
#pragma unroll
        for (int i = 0; i < 8; ++i) { const int id = tid + NTHREADS * (i0 + i), kk = id >> 5, cc = id & 31; *(u32x4*)(lds + kk * ZPB + cc * 16) = img[i]; }
        __builtin_amdgcn_sched_barrier(0);
    }
    __syncthreads();
    const int g = wave >> 1, kblk = wave & 1;
    f32x16 XR[2], XI[2];
#pragma unroll
    for (int cb = 0; cb < 2; ++cb) { XR[cb] = f32x16{}; XI[cb] = f32x16{}; }
    const bf16_t* trp = Tr + (size_t)(32 * kblk + r32) * KK + 8 * hi; const bf16_t* tip = Ti + (size_t)(32 * kblk + r32) * KK + 8 * hi;
    const unsigned char* zp = lds + (8 * hi + ((lane & 15) >> 2)) * ZPB + (64 * g + 16 * ((lane >> 4) & 1) + 4 * (lane & 3)) * 2;
#pragma unroll 2
    for (int ks = 0; ks < KK / 16; ++ks) {
        const bf16x8 bR = *(const bf16x8*)(trp + 16 * ks), bI = *(const bf16x8*)(tip + 16 * ks);
#pragma unroll
        for (int cb = 0; cb < 2; ++cb) { const bf16x8 av = cat8(trrd(zp + (16 * ks) * ZPB + cb * 64), trrd(zp + (16 * ks + 4) * ZPB + cb * 64)); XR[cb] = MFMA32(av, bR, XR[cb]); XI[cb] = MFMA32(av, bI, XI[cb]); }
    }
    f32x16 oa[2]; oa[0] = f32x16{}; oa[1] = f32x16{};
    const bf16_t* gp = Gt + (size_t)(g * 2 * 8 * 64 + lane) * 8;
    u32x2 gfw[8];
    { const size_t rowg = row0 + (size_t)(32 * kblk + r32) * rowstride;
#pragma unroll
      for (int i8 = 0; i8 < 8; ++i8) gfw[i8] = *(const u32x2*)(P + rowg * PW + C_GF + 64 * g + 32 * (i8 >> 2) + 8 * (i8 & 3) + 4 * hi); }
#pragma unroll
    for (int part = 0; part < 2; ++part)
#pragma unroll
        for (int cb = 0; cb < 2; ++cb)
#pragma unroll
            for (int s = 0; s < 2; ++s) {
                const bf16x8 bx = pack8(part ? XI[cb] : XR[cb], 8 * s);
                const int kko = part * 64 + 32 * cb + 16 * s;
#pragma unroll
                for (int lb = 0; lb < 2; ++lb) { const bf16x8 ag = *(const bf16x8*)(gp + (size_t)((lb * 8 + (kko >> 4)) * 64) * 8); oa[lb] = MFMA32(ag, bx, oa[lb]); }
            }
    const int k2 = 32 * kblk + r32;
    const size_t row = row0 + (size_t)k2 * rowstride;
    const bf16_t* gfrow = P + row * PW + C_GF + 64 * g;
    bf16_t* hrow = H + row * DM + 512 + 64 * g;
#pragma unroll
    for (int lb = 0; lb < 2; ++lb)
#pragma unroll
        for (int g4 = 0; g4 < 4; ++g4) {
            const int l0 = 32 * lb + 8 * g4 + 4 * hi;
            const u32x2 gw = gfw[lb * 4 + g4];
            const float o0 = oa[lb][4 * g4 + 0] * oscale * silu_f(bf2f(gw.x & 0xffffu)), o1 = oa[lb][4 * g4 + 1] * oscale * silu_f(bf2f(gw.x >> 16));
            const float o2 = oa[lb][4 * g4 + 2] * oscale * silu_f(bf2f(gw.y & 0xffffu)), o3 = oa[lb][4 * g4 + 3] * oscale * silu_f(bf2f(gw.y >> 16));
            u32x2 w; w.x = pkbf(o0, o1); w.y = pkbf(o2, o3);
            *(u32x2*)(hrow + l0) = w;
        }
    __syncthreads();
}

__device__ __forceinline__ void conv_unit(int u, const bf16_t* P, bf16_t* H, const float* cw, const float* cb) {
    const int tid = opaque_tid(), cgp = tid & 31, rg = tid >> 5;
    const int ch0 = cgp * 8;
    const int r0 = u * 64 + rg * 4;
    int pos, len; if (r0 < NTOK) { pos = r0 & (SEQ - 1); len = SEQ; } else { pos = (r0 - NTOK) & (CTXL - 1); len = CTXL; }
    float w0[8], w1[8], w2[8], bs[8];
#pragma unroll
    for (int e = 0; e < 8; ++e) { w0[e] = cw[ch0 + e]; w1[e] = cw[256 + ch0 + e]; w2[e] = cw[512 + ch0 + e]; bs[e] = cb[ch0 + e]; }
    float T[6][8];
#pragma unroll
    for (int i = 0; i < 6; ++i) {
        const int p = pos - 1 + i;
        if (p >= 0 && p < len) {
            const size_t row = (size_t)(r0 - 1 + i);
            const u32x4 z = *(const u32x4*)(P + row * PW + C_ZC + ch0), c = *(const u32x4*)(P + row * PW + C_CC + ch0);
            T[i][0] = bf2f(z.x & 0xffffu) * bf2f(c.x & 0xffffu); T[i][1] = bf2f(z.x >> 16) * bf2f(c.x >> 16);
            T[i][2] = bf2f(z.y & 0xffffu) * bf2f(c.y & 0xffffu); T[i][3] = bf2f(z.y >> 16) * bf2f(c.y >> 16);
            T[i][4] = bf2f(z.z & 0xffffu) * bf2f(c.z & 0xffffu); T[i][5] = bf2f(z.z >> 16) * bf2f(c.z >> 16);
            T[i][6] = bf2f(z.w & 0xffffu) * bf2f(c.w & 0xffffu); T[i][7] = bf2f(z.w >> 16) * bf2f(c.w >> 16);
        } else {
#pragma unroll
            for (int e = 0; e < 8; ++e) T[i][e] = 0.f;
        }
    }
#pragma unroll
    for (int i = 0; i < 4; ++i) {
        const size_t row = (size_t)(r0 + i);
        const u32x4 bw = *(const u32x4*)(P + row * PW + C_BC + ch0), gw = *(const u32x4*)(P + row * PW + C_GC + ch0);
        const unsigned bwv[4] = {bw.x, bw.y, bw.z, bw.w}, gwv[4] = {gw.x, gw.y, gw.z, gw.w};
        float o[8];
#pragma unroll
        for (int e = 0; e < 8; ++e) {
            const float bv = (e & 1) ? bf2f(bwv[e >> 1] >> 16) : bf2f(bwv[e >> 1] & 0xffffu);
            const float gv = (e & 1) ? bf2f(gwv[e >> 1] >> 16) : bf2f(gwv[e >> 1] & 0xffffu);
            const float y = T[i][e] * w0[e] + T[i + 1][e] * w1[e] + T[i + 2][e] * w2[e] + bs[e];
            o[e] = bv * y * silu_f(gv);
        }
        u32x4 w; w.x = pkbf(o[0], o[1]); w.y = pkbf(o[2], o[3]); w.z = pkbf(o[4], o[5]); w.w = pkbf(o[6], o[7]);
        *(u32x4*)(H + row * DM + 768 + ch0) = w;
    }
}

__device__ __forceinline__ void fft1_tables(const unsigned char* ws, unsigned char* tbl, int tid) {
    u32x4 tv[8];
#pragma unroll
    for (int i = 0; i < 8; ++i) { const int id = tid + NTHREADS * i, t = id >> 11, row = (id >> 4) & 127, ch = id & 15; tv[i] = *(const u32x4*)(ws + (t ? WS_T1I : WS_T1R) + row * 256 + ch * 16); }
    __builtin_amdgcn_sched_barrier(0);
#pragma unroll
    for (int i = 0; i < 8; ++i) { const int id = tid + NTHREADS * i, t = id >> 11, row = (id >> 4) & 127, ch = id & 15; *(u32x4*)(tbl + t * 34816 + row * 272 + ch * 16) = tv[i]; }
}
__device__ __forceinline__ void fft1_wave(int task, const bf16_t* P, bf16_t* YF, const unsigned char* ws, unsigned char* lds_w, const unsigned char* tbl, int lane, int pmode = 0) {
    const int r32 = lane & 31, hi = lane >> 5;
    const int cblk = task & 7, n2 = (task >> 3) & 63, b = task >> 9;
    const bf16_t* src = P + (size_t)((b * 64 + n2) * 128) * 256 + 32 * cblk + 8 * (lane & 3);
    { u32x4 img[8];
#pragma unroll
      for (int i = 0; i < 8; ++i) img[i] = __builtin_nontemporal_load((const u32x4*)(src + (size_t)(16 * i + (lane >> 2)) * 256));
      __builtin_amdgcn_sched_barrier(0);
#pragma unroll
      for (int i = 0; i < 8; ++i) *(u32x4*)(lds_w + (16 * i + (lane >> 2)) * 64 + (lane & 3) * 16) = img[i];
      __builtin_amdgcn_sched_barrier(0); }
    asm volatile("s_waitcnt vmcnt(0) lgkmcnt(0)" ::: "memory");
    if (pmode == 2) return;
    const bf16_t* T1R = (const bf16_t*)(ws + WS_T1R); const bf16_t* T1I = (const bf16_t*)(ws + WS_T1I);
    f32x16 aR[4], aI[4];
#pragma unroll
    for (int kb = 0; kb < 4; ++kb) { aR[kb] = f32x16{}; aI[kb] = f32x16{}; }
    const unsigned char* ap = lds_w + (8 * hi + ((lane & 15) >> 2)) * 64 + (16 * ((lane >> 4) & 1) + 4 * (lane & 3)) * 2;
    const unsigned char* tb = tbl + r32 * 272 + hi * 16;
#pragma unroll 2
    for (int ks = 0; ks < 8; ++ks) {
        const bf16x8 av = cat8(trrd(ap + (16 * ks) * 64), trrd(ap + (16 * ks + 4) * 64));
        bf16x8 bq[8];
#pragma unroll
        for (int kb = 0; kb < 4; ++kb) { bq[2 * kb] = *(const bf16x8*)(tb + (32 * kb) * 272 + 32 * ks); bq[2 * kb + 1] = *(const bf16x8*)(tb + 34816 + (32 * kb) * 272 + 32 * ks); }
#pragma unroll
        for (int kb = 0; kb < 4; ++kb) { aR[kb] = MFMA32(av, bq[2 * kb], aR[kb]); aI[kb] = MFMA32(av, bq[2 * kb + 1], aI[kb]); }
    }
    const float* TW = (const float*)(ws + WS_TW);
    float ctw[4], stw[4];
#pragma unroll
    for (int kb = 0; kb < 4; ++kb) { const int k1 = 32 * kb + r32; ctw[kb] = TW[2 * (n2 * k1)]; stw[kb] = TW[2 * (n2 * k1) + 1]; }
    asm volatile("s_waitcnt lgkmcnt(0)" ::: "memory");
#pragma unroll
    for (int pr = 0; pr < 2; ++pr) {
#pragma unroll
        for (int kq = 0; kq < 2; ++kq) {
            const int kb = 2 * pr + kq; const int rowl = 32 * kq + r32; const float ct = ctw[kb], st = stw[kb];
#pragma unroll
            for (int g4 = 0; g4 < 4; ++g4) {
                float yr[4], yi[4];
#pragma unroll
                for (int e = 0; e < 4; ++e) { const float r_ = aR[kb][4 * g4 + e], i_ = aI[kb][4 * g4 + e]; yr[e] = r_ * ct + i_ * st; yi[e] = i_ * ct - r_ * st; }
                u32x2 wr_, wi_; wr_.x = pkbf(yr[0], yr[1]); wr_.y = pkbf(yr[2], yr[3]); wi_.x = pkbf(yi[0], yi[1]); wi_.y = pkbf(yi[2], yi[3]);
                *(u32x2*)(lds_w + rowl * 128 + ((g4 ^ (rowl & 7)) * 16) + hi * 8) = wr_;
                *(u32x2*)(lds_w + rowl * 128 + (((4 + g4) ^ (rowl & 7)) * 16) + hi * 8) = wi_;
            }
        }
        asm volatile("s_waitcnt lgkmcnt(0)" ::: "memory");
#pragma unroll
        for (int i8 = 0; i8 < 8; ++i8) {
            const int rowl = i8 * 8 + (lane >> 3), ch = lane & 7;
            const u32x4 v = *(const u32x4*)(lds_w + rowl * 128 + ((ch ^ (rowl & 7)) * 16));
            const int k1 = 64 * pr + rowl;
            bf16_t* dst = YF + ((size_t)((b * 128 + k1) * 64 + n2)) * 512 + (ch >> 2) * 256 + 32 * cblk + 8 * (ch & 3);
            *(u32x4*)dst = v;
        }
        asm volatile("s_waitcnt lgkmcnt(0)" ::: "memory");
    }
}
__device__ __forceinline__ void fft3_wave(int task, const bf16_t* YF, const bf16_t* Gt, const bf16_t* P, bf16_t* H, const unsigned char* ws, unsigned char* lds_w, int lane) {
    const int r32 = lane & 31, hi = lane >> 5;
    const int g = task & 3, k1 = (task >> 2) & 127, b = task >> 9;
    const bf16_t* src = YF + ((size_t)(b * 128 + k1) * 64) * 512 + 64 * g + 8 * (lane & 7);
    { u32x4 img[16];
#pragma unroll
      for (int i = 0; i < 16; ++i) { const int kk = 8 * i + (lane >> 3); img[i] = __builtin_nontemporal_load((const u32x4*)(src + (size_t)(kk & 63) * 512 + (size_t)(kk >> 6) * 256)); }
      __builtin_amdgcn_sched_barrier(0);
#pragma unroll
      for (int i = 0; i < 16; ++i) { const int kk = 8 * i + (lane >> 3), ch = lane & 7; *(u32x4*)(lds_w + kk * 128 + ((ch ^ (((kk >> 1) & 1) << 2)) * 16)) = img[i]; }
      __builtin_amdgcn_sched_barrier(0); }
    asm volatile("s_waitcnt vmcnt(0) lgkmcnt(0)" ::: "memory");
    const bf16_t* T3R = (const bf16_t*)(ws + WS_T3R); const bf16_t* T3I = (const bf16_t*)(ws + WS_T3I);
    const int q = (lane & 15) >> 2, sw = (q >> 1) & 1;
    const int chl = 2 * ((lane >> 4) & 1) + ((lane & 3) >> 1);
    const unsigned char* zb = lds_w + (8 * hi + q) * 128 + 8 * (lane & 1);
    const unsigned char* zp0 = zb + ((chl ^ (sw << 2)) * 16);
    const unsigned char* zp1 = zb + (((4 + chl) ^ (sw << 2)) * 16);
    const bf16_t* gp = Gt + (size_t)(g * 2 * 8 * 64 + lane) * 8;
    const size_t rowb = (size_t)(b * SEQ + k1);
    u32x2 hwA[8], hwB[8];
#pragma unroll
    for (int i8 = 0; i8 < 8; ++i8) { hwA[i8] = (u32x2){0u, 0u}; hwB[i8] = (u32x2){0u, 0u}; }
#pragma unroll 1
    for (int kblk = 0; kblk < 2; ++kblk) {
        f32x16 XR[2], XI[2];
#pragma unroll
        for (int cb = 0; cb < 2; ++cb) { XR[cb] = f32x16{}; XI[cb] = f32x16{}; }
        const bf16_t* trp = T3R + (size_t)(kblk * 8 * 64 + lane) * 8; const bf16_t* tip = T3I + (size_t)(kblk * 8 * 64 + lane) * 8;
        const size_t rowg = rowb + (size_t)(32 * kblk + r32) * 128;
        u32x2 gfw[8];
#pragma unroll
        for (int i8 = 0; i8 < 8; ++i8) gfw[i8] = *(const u32x2*)(P + rowg * PW + C_GF + 64 * g + 32 * (i8 >> 2) + 8 * (i8 & 3) + 4 * hi);
        bf16x8 bR[8], bI[8];
#pragma unroll
        for (int ks = 0; ks < 8; ++ks) { bR[ks] = *(const bf16x8*)(trp + 512 * ks); bI[ks] = *(const bf16x8*)(tip + 512 * ks); }
        __builtin_amdgcn_sched_barrier(0);
#pragma unroll
        for (int ks = 0; ks < 8; ++ks) {
            const bf16x8 a0 = cat8(trrd(zp0 + (16 * ks) * 128), trrd(zp0 + (16 * ks + 4) * 128));
            const bf16x8 a1 = cat8(trrd(zp1 + (16 * ks) * 128), trrd(zp1 + (16 * ks + 4) * 128));
            XR[0] = MFMA32(a0, bR[ks], XR[0]); XI[0] = MFMA32(a0, bI[ks], XI[0]); XR[1] = MFMA32(a1, bR[ks], XR[1]); XI[1] = MFMA32(a1, bI[ks], XI[1]);
        }
        __builtin_amdgcn_sched_barrier(0);
        bf16x8 gfr[2][8];
#pragma unroll
        for (int lb = 0; lb < 2; ++lb)
#pragma unroll
            for (int q8 = 0; q8 < 8; ++q8) gfr[lb][q8] = *(const bf16x8*)(gp + (size_t)((lb * 8 + q8) * 64) * 8);
        __builtin_amdgcn_sched_barrier(0);
        f32x16 oa[2]; oa[0] = f32x16{}; oa[1] = f32x16{};
#pragma unroll
        for (int part = 0; part < 2; ++part)
#pragma unroll
            for (int cb = 0; cb < 2; ++cb)
#pragma unroll
                for (int s = 0; s < 2; ++s) {
                    const bf16x8 bx = pack8(part ? XI[cb] : XR[cb], 8 * s);
                    const int kko = part * 64 + 32 * cb + 16 * s;
#pragma unroll
                    for (int lb = 0; lb < 2; ++lb) oa[lb] = MFMA32(gfr[lb][kko >> 4], bx, oa[lb]);
                }
#pragma unroll
        for (int lb = 0; lb < 2; ++lb)
#pragma unroll
            for (int g4 = 0; g4 < 4; ++g4) {
                const u32x2 gw = gfw[lb * 4 + g4];
                const float o0 = oa[lb][4 * g4 + 0] * silu_f(bf2f(gw.x & 0xffffu)), o1 = oa[lb][4 * g4 + 1] * silu_f(bf2f(gw.x >> 16));
                const float o2 = oa[lb][4 * g4 + 2] * silu_f(bf2f(gw.y & 0xffffu)), o3 = oa[lb][4 * g4 + 3] * silu_f(bf2f(gw.y >> 16));
                u32x2 pk; pk.x = pkbf(o0, o1); pk.y = pkbf(o2, o3);
                if (kblk == 0) hwA[lb * 4 + g4] = pk; else hwB[lb * 4 + g4] = pk;
            }
    }
    asm volatile("s_waitcnt lgkmcnt(0)" ::: "memory");
#pragma unroll
    for (int kblk = 0; kblk < 2; ++kblk)
#pragma unroll
        for (int lb = 0; lb < 2; ++lb)
#pragma unroll
            for (int g4 = 0; g4 < 4; ++g4) { const int rowl = 32 * kblk + r32;
                *(u32x2*)(lds_w + rowl * 128 + (((4 * lb + g4) ^ (rowl & 7)) * 16) + hi * 8) = kblk ? hwB[lb * 4 + g4] : hwA[lb * 4 + g4]; }
    asm volatile("s_waitcnt lgkmcnt(0)" ::: "memory");
#pragma unroll
    for (int i8 = 0; i8 < 8; ++i8) {
        const int rowl = i8 * 8 + (lane >> 3), ch = lane & 7;
        const u32x4 v = *(const u32x4*)(lds_w + rowl * 128 + ((ch ^ (rowl & 7)) * 16));
        *(u32x4*)(H + (rowb + (size_t)rowl * 128) * DM + 512 + 64 * g + 8 * ch) = v;
    }
    asm volatile("s_waitcnt lgkmcnt(0)" ::: "memory");
}
__device__ __forceinline__ void conv_wave(int task, const bf16_t* P, bf16_t* H, const float* cw, const float* cb, int lane) {
    const int cgp = lane & 31, ch0 = cgp * 8;
    const int r0 = task * 8 + (lane >> 5) * 4;
    int pos, len; if (r0 < NTOK) { pos = r0 & (SEQ - 1); len = SEQ; } else { pos = (r0 - NTOK) & (CTXL - 1); len = CTXL; }
    u32x4 zz[6], cc[6], bb[4], gg[4]; float okf[6];
#pragma unroll
    for (int i = 0; i < 6; ++i) { const int p = pos - 1 + i; const bool ok = p >= 0 && p < len; okf[i] = ok ? 1.f : 0.f; const size_t row = (size_t)(ok ? r0 - 1 + i : r0);
        zz[i] = __builtin_nontemporal_load((const u32x4*)(P + row * PW + C_ZC + ch0)); cc[i] = __builtin_nontemporal_load((const u32x4*)(P + row * PW + C_CC + ch0)); }
#pragma unroll
    for (int i = 0; i < 4; ++i) { const size_t row = (size_t)(r0 + i); bb[i] = __builtin_nontemporal_load((const u32x4*)(P + row * PW + C_BC + ch0)); gg[i] = __builtin_nontemporal_load((const u32x4*)(P + row * PW + C_GC + ch0)); }
    __builtin_amdgcn_sched_barrier(0);
    float w0[8], w1[8], w2[8], bs[8];
    { const f32x4 a0 = *(const f32x4*)(cw + ch0), a1 = *(const f32x4*)(cw + ch0 + 4), b0 = *(const f32x4*)(cw + 256 + ch0), b1 = *(const f32x4*)(cw + 256 + ch0 + 4);
      const f32x4 c0 = *(const f32x4*)(cw + 512 + ch0), c1 = *(const f32x4*)(cw + 512 + ch0 + 4), d0 = *(const f32x4*)(cb + ch0), d1 = *(const f32x4*)(cb + ch0 + 4);
#pragma unroll
      for (int e = 0; e < 4; ++e) { w0[e] = a0[e]; w0[4 + e] = a1[e]; w1[e] = b0[e]; w1[4 + e] = b1[e]; w2[e] = c0[e]; w2[4 + e] = c1[e]; bs[e] = d0[e]; bs[4 + e] = d1[e]; } }
    float T[6][8];
#pragma unroll
    for (int i = 0; i < 6; ++i) {
        const unsigned zv[4] = {zz[i].x, zz[i].y, zz[i].z, zz[i].w}, cv[4] = {cc[i].x, cc[i].y, cc[i].z, cc[i].w};
#pragma unroll
        for (int e = 0; e < 8; ++e) T[i][e] = okf[i] * ((e & 1) ? bf2f(zv[e >> 1] >> 16) : bf2f(zv[e >> 1] & 0xffffu)) * ((e & 1) ? bf2f(cv[e >> 1] >> 16) : bf2f(cv[e >> 1] & 0xffffu));
    }
#pragma unroll
    for (int i = 0; i < 4; ++i) {
        const size_t row = (size_t)(r0 + i);
        const unsigned bwv[4] = {bb[i].x, bb[i].y, bb[i].z, bb[i].w}, gwv[4] = {gg[i].x, gg[i].y, gg[i].z, gg[i].w};
        float o[8];
#pragma unroll
        for (int e = 0; e < 8; ++e) {
            const float bv = (e & 1) ? bf2f(bwv[e >> 1] >> 16) : bf2f(bwv[e >> 1] & 0xffffu);
            const float gv = (e & 1) ? bf2f(gwv[e >> 1] >> 16) : bf2f(gwv[e >> 1] & 0xffffu);
            const float y = T[i][e] * w0[e] + T[i + 1][e] * w1[e] + T[i + 2][e] * w2[e] + bs[e];
            o[e] = bv * y * silu_f(gv);
        }
        u32x4 w; w.x = pkbf(o[0], o[1]); w.y = pkbf(o[2], o[3]); w.z = pkbf(o[4], o[5]); w.w = pkbf(o[6], o[7]);
        *(u32x4*)(H + row * DM + 768 + ch0) = w;
    }
}

#define XB_TMO      128
#define XB_XCNT(j)  (256  + 64 * (j))
#define XB_XSUB(j)  (1280 + 64 * (j))
#define XB_XGEN(j)  (2304 + 64 * (j))
#define XB_TOP      3328
#define XB_TOPGEN   3392
#define XCD_BAR_WORDS 3456
#define XB_SPIN_CAP (1u << 18)

__device__ __forceinline__ unsigned xb_ld(unsigned* p)              { return __hip_atomic_load(p, __ATOMIC_RELAXED, __HIP_MEMORY_SCOPE_AGENT); }
__device__ __forceinline__ unsigned xb_add(unsigned* p, unsigned v) { return __hip_atomic_fetch_add(p, v, __ATOMIC_RELAXED, __HIP_MEMORY_SCOPE_AGENT); }
__device__ __forceinline__ unsigned xb_xcc_id() { return (unsigned)__builtin_amdgcn_s_getreg((3 << 11) | 20) & 0xFu; }
#define XB_SPIN(cond, bar) do { unsigned _sp = 0; while (cond) { __builtin_amdgcn_s_sleep(1); \
    if ((++_sp & 255u) == 0u) { if (xb_ld(&(bar)[XB_TMO])) break; if (_sp > XB_SPIN_CAP) { atomicAdd(&(bar)[XB_TMO], 1u); break; } } } } while (0)

struct XcdBarrier {
    unsigned* bar; unsigned x;
    volatile LAS unsigned* st;
};

__device__ __forceinline__ XcdBarrier xcd_barrier_post(unsigned* bar, volatile LAS unsigned* st) {
    XcdBarrier b; b.bar = bar; b.x = xb_xcc_id(); b.st = st;
    if (threadIdx.x == 0) (void)xb_add(&bar[XB_XCNT(b.x)], 1u);
    return b;
}
__device__ __forceinline__ void xcd_barrier_complete(unsigned* bar, unsigned x, unsigned& nloc, unsigned& nx) {
    const unsigned G = gridDim.x * gridDim.y * gridDim.z;
    unsigned sum, cnt, mine, sp = 0u;
    for (;;) {
        sum = 0u; cnt = 0u; mine = 0u;
#pragma unroll
        for (unsigned j = 0; j < 16; ++j) { const unsigned c = xb_ld(&bar[XB_XCNT(j)]); sum += c; cnt += (c > 0u) ? 1u : 0u; mine = (j == x) ? c : mine; }
        if (sum == G) break;
        __builtin_amdgcn_s_sleep(1);
        if ((++sp & 255u) == 0u) { if (xb_ld(&bar[XB_TMO])) break; if (sp > XB_SPIN_CAP) { atomicAdd(&bar[XB_TMO], 1u); break; } }
    }
    nloc = mine > 0u ? mine : 1u; nx = cnt > 0u ? cnt : 1u;
}

__device__ __forceinline__ void xcd_barrier(const XcdBarrier& b) {
    asm volatile("s_waitcnt vmcnt(0)" ::: "memory");
    __syncthreads();
    if (threadIdx.x == 0) {
        unsigned* bar = b.bar;
        __builtin_amdgcn_s_waitcnt(0);
        unsigned nloc = b.st[0], nx = b.st[1];
        if (nloc == 0u) { xcd_barrier_complete(bar, b.x, nloc, nx); b.st[0] = nloc; b.st[1] = nx; }
        const unsigned old = xb_add(&bar[XB_XSUB(b.x)], 1u);
        const unsigned gen = old / nloc;
        if (old + 1u == (gen + 1u) * nloc) {
            __builtin_amdgcn_fence(__ATOMIC_RELEASE, "agent");
            asm volatile("s_waitcnt vmcnt(0)" ::: "memory");
            const unsigned og = xb_add(&bar[XB_TOP], 1u);
            const unsigned tg = og / nx;
            if (og + 1u == (tg + 1u) * nx) xb_add(&bar[XB_TOPGEN], 1u);
            else XB_SPIN(xb_ld(&bar[XB_TOPGEN]) == tg, bar);
            __builtin_amdgcn_fence(__ATOMIC_ACQUIRE, "agent");
            xb_add(&bar[XB_XGEN(b.x)], 1u);
            asm volatile("s_waitcnt vmcnt(0)" ::: "memory");
        } else {
            XB_SPIN(xb_ld(&bar[XB_XGEN(b.x)]) == gen, bar);
            __builtin_amdgcn_fence(__ATOMIC_ACQUIRE, "agent");
            asm volatile("s_waitcnt vmcnt(0)" ::: "memory");
        }
    }
    __syncthreads();
}

__device__ __forceinline__ int next_unit(unsigned* ctr, unsigned char* lds) {
    volatile int* sw = (volatile int*)(lds + LDS_SCHED);
    if (threadIdx.x == 0) *sw = (int)atomicAdd(ctr, 1u);
    __syncthreads();
    const int u = *sw;
    __syncthreads();
    return u;
}

__global__ void __launch_bounds__(NTHREADS, 2) hybrid_fwd(KArgs a) {
    extern __shared__ __attribute__((aligned(16))) unsigned char lds[];
    cg::grid_group grid = cg::this_grid();
    unsigned char* ws = a.ws;
    const int lo = a.ph_lo, hi = a.ph_hi;
#ifndef PHMASK
#define PHMASK 0xfff
#endif
#define IN(k) (((PHMASK >> ((k) > 5 && (k) < 11 ? (k) - 5 : (k))) & 1) && lo <= (k) && (k) < hi)
#define SEAM(k) do { if (IN(k) && IN((k) + 1)) xcd_barrier(xbar); } while (0)
#ifndef REP_PHASE
#define REP_PHASE -1
#endif
#define REPS(j) for (int rep = 0, nrep = (REP_PHASE == (j)) ? 2 : 1; rep < nrep; ++rep, (rep < nrep ? xcd_barrier(xbar) : (void)0))
    bf16_t* HX = (bf16_t*)(ws + WS_HX); bf16_t* Pb = (bf16_t*)(ws + WS_P); bf16_t* Vt = (bf16_t*)(ws + WS_VT); bf16_t* Hb = (bf16_t*)(ws + WS_H);
    bf16_t* Yb = (bf16_t*)(ws + WS_Y); bf16_t* YF = (bf16_t*)(ws + WS_YF); float* SSQ = (float*)(ws + WS_SSQ);
    unsigned* ctl = (unsigned*)(ws + WS_CTL);

    if (threadIdx.x < 2) ((volatile LAS unsigned*)(lds + LDS_BARST))[threadIdx.x] = 0u;
    __syncthreads();
    const XcdBarrier xbar = xcd_barrier_post((unsigned*)(ws + WS_BAR), (volatile LAS unsigned*)(lds + LDS_BARST));
    if (a.ph_lo < 0) grid.sync();
    REPS(30) if (IN(0)) p0_prologue(a, lds);
    SEAM(0);
    for (int l = 0; l < 2; ++l) {
        const int pb = 1 + 5 * l;
        REPS(0) if (IN(pb)) norm_phase(a, l);
        SEAM(pb);
        REPS(1) if (IN(pb + 1)) {
            pg8::Gemm g{HX, (const bf16_t*)(ws + WS_WIN) + (size_t)l * PW * DM, MROWS, PW, DM};
            pg8::StaticOrder S; S.init(MROWS, PW, (int)gridDim.x, (int)blockIdx.x);
            pg8::EpiProj E{Pb, Vt, (const float*)(ws + WS_ROPE), (bf16_t*)(ws + WS_UFP), 0.125f * LOG2E};
            pg8::gemm_phase<pg8::EpiProj, pg8::StaticOrder, true, true>((PG8_LAS unsigned char*)lds, g, S, E);
        }
        SEAM(pb + 1);
        for (int rep = 0, nrep = (REP_PHASE >= 20 && REP_PHASE < 30) ? 2 : 1; rep < nrep; ++rep, (rep < nrep ? xcd_barrier(xbar) : (void)0)) if (IN(pb + 2)) {
            const int nAttn = (l == 0) ? 1056 : 1024, nCtxF = (l == 0) ? 16 : 0, nF1 = 256, nConv = ((l == 0) ? MROWS : NTOK) / 64;
            const int e0 = nF1, e1 = e0 + nCtxF, e2 = e1 + nAttn, e3 = e2 + nConv;
            for (;;) {
                const int u = next_unit(ctl + 2 * l + 8 * rep, lds);
                if (u >= e3) break;
                if (rep == 1) { const int ty = u < e0 ? 1 : u < e1 ? 3 : u < e2 ? 0 : 2; if (REP_PHASE == 25 ? (ty == 0) : (ty != REP_PHASE - 20)) continue; }
                if (u >= e1 && u < e2) attn_unit(u - e1, Pb, Vt, Hb, a.sink + 8 * l, lds);
                else if (u >= e0 && u < e1) { const int v = u - e0, b = v >> 2, kb = v & 3;
                    dftf_unit<256>(Pb + (size_t)(NTOK + b * CTXL) * PW + C_UF, 256, PW, 0, (const bf16_t*)(ws + WS_T256R) + (size_t)(64 * kb) * 256, (const bf16_t*)(ws + WS_T256I) + (size_t)(64 * kb) * 256,
                                   (const bf16_t*)(ws + WS_GT) + (size_t)l * 4 * 64 * 128, Pb, Hb, (size_t)(NTOK + b * CTXL + 64 * kb), 1, 5.656854249492381f, lds); }
                else {
                    const int tid = opaque_tid(), lane = tid & 63, wave = __builtin_amdgcn_readfirstlane(tid >> 6);
                    if (u < e0) { fft1_tables(ws, lds + 65536, tid); __syncthreads(); fft1_wave(u * 8 + wave, (const bf16_t*)(ws + WS_UFP), YF, ws, lds + wave * 8192, lds + 65536, lane); }
                    else conv_wave((u - e2) * 8 + wave, Pb, Hb, a.conv_w + l * 768, a.conv_b + l * 256, lane);
                }
            }
        }
        SEAM(pb + 2);
        REPS(3) if (IN(pb + 3)) {
            const bool gemmwg = (l == 0 && blockIdx.x < 16);
            if (gemmwg) {
                pg8::Gemm g{Hb + (size_t)NTOK * DM, (const bf16_t*)(ws + WS_WOUT) + (size_t)l * DM * DM, NCTX, DM, DM};
                pg8::StaticOrder S; S.init(NCTX, DM, 16, (int)blockIdx.x);
                pg8::EpiY E{Yb + (size_t)NTOK * DM, SSQ + (size_t)NTOK * 16};
                pg8::gemm_phase<pg8::EpiY, pg8::StaticOrder, true, true>((PG8_LAS unsigned char*)lds, g, S, E);
            } else {
                const int tid = opaque_tid(), lane = tid & 63, wave = __builtin_amdgcn_readfirstlane(tid >> 6);
                const int nb0 = (l == 0) ? 16 : 0;
                const int gw = ((int)blockIdx.x - nb0) + wave * ((int)gridDim.x - nb0), NGW = ((int)gridDim.x - nb0) * 8;
                unsigned char* lds_w = lds + wave * 16384;
                for (int t = gw; t < 2048; t += NGW) fft3_wave(t, YF, (const bf16_t*)(ws + WS_GT) + (size_t)l * 4 * 64 * 128, Pb, Hb, ws, lds_w, lane);
            }
            __syncthreads();
        }
        SEAM(pb + 3);
        REPS(4) if (IN(pb + 4)) {
            pg8::Gemm g{Hb, (const bf16_t*)(ws + WS_WOUT) + (size_t)l * DM * DM, NTOK, DM, DM};
            pg8::StaticOrder S; S.init(NTOK, DM, (int)gridDim.x, (int)blockIdx.x);
            pg8::EpiY E{l == 0 ? Yb : HX, l == 0 ? SSQ : (float*)(ws + WS_SSQ1)};
            pg8::gemm_phase<pg8::EpiY, pg8::StaticOrder, true, true>((PG8_LAS unsigned char*)lds, g, S, E);
        }
        SEAM(pb + 4);
    }
#if REP_PHASE == 9
    for (int i = 0; i < 10; ++i) xcd_barrier(xbar);
#endif
    if (IN(11)) norm_phase(a, 2);
#undef IN
#undef SEAM
}

#ifndef MK_MULTI
#define MK_MULTI 0
#endif
extern "C" void kernel_launch(void* const* d_in, const int* in_sizes, int n_in, void* d_out, int out_size, void* d_ws, size_t ws_size, hipStream_t stream) {
    static int grid = 0;
    if (grid == 0) {
        if (n_in != 14 || ws_size < WS_END) { fprintf(stderr, "kernel_launch: unexpected n_in %d or ws_size %zu (need %zu)\n", n_in, ws_size, (size_t)WS_END); grid = -1; return; }
        int dev = 0, cus = 0, per_cu = 0;
        hipGetDevice(&dev); hipDeviceGetAttribute(&cus, hipDeviceAttributeMultiprocessorCount, dev);
        if (hipFuncSetAttribute((const void*)hybrid_fwd, hipFuncAttributeMaxDynamicSharedMemorySize, LDS_BYTES) != hipSuccess) { fprintf(stderr, "kernel_launch: hipFuncSetAttribute failed\n"); grid = -1; return; }
        if (hipOccupancyMaxActiveBlocksPerMultiprocessor(&per_cu, (const void*)hybrid_fwd, NTHREADS, LDS_BYTES) != hipSuccess || per_cu < 1) { fprintf(stderr, "kernel_launch: occupancy query gave %d\n", per_cu); per_cu = 1; }
        (void)hipGetLastError();
        grid = cus * 1;
        fprintf(stderr, "kernel_launch: grid %d (cus %d, per_cu %d)\n", grid, cus, per_cu);
    }
    if (grid < 0) return;
    if (hipMemsetAsync((char*)d_ws + WS_CTL, 0, WS_ZERO_BYTES, stream) != hipSuccess) { fprintf(stderr, "kernel_launch: hipMemsetAsync failed\n"); return; }
    KArgs a{};
    a.x = (const float*)d_in[0]; a.c = (const float*)d_in[1]; a.ctx = (const float*)d_in[2]; a.c_ctx = (const float*)d_in[3]; a.w_mod = (const float*)d_in[4]; a.b_mod = (const float*)d_in[5];
    a.g_pre = (const float*)d_in[6]; a.g_post = (const float*)d_in[7]; a.w_in = (const float*)d_in[8]; a.w_out = (const float*)d_in[9]; a.sink = (const float*)d_in[10]; a.w_f = (const float*)d_in[11];
    a.conv_w = (const float*)d_in[12]; a.conv_b = (const float*)d_in[13];
    a.out = (float*)d_out; a.ws = (unsigned char*)d_ws;
#if MK_MULTI
    for (int ph = 0; ph < 12; ++ph) { a.ph_lo = ph; a.ph_hi = ph + 1; hipLaunchKernelGGL(hybrid_fwd, dim3(grid), dim3(NTHREADS), LDS_BYTES, stream, a); }
#else
    a.ph_lo = 0; a.ph_hi = 12;
    void* args[] = {&a};
    hipError_t e = hipLaunchCooperativeKernel((const void*)hybrid_fwd, dim3(grid), dim3(NTHREADS), args, LDS_BYTES, stream);
    if (e != hipSuccess) fprintf(stderr, "kernel_launch: cooperative launch failed: %s (grid %d)\n", hipGetErrorString(e), grid);
#endif
}
```

```cpp
#include <hip/hip_runtime.h>
#include <hip/hip_cooperative_groups.h>
#include <cstdio>
#include <cstdint>
namespace cg = cooperative_groups;
namespace pg8 {
#define PG8_LAS __attribute__((address_space(3)))
typedef unsigned short bf16_t;
typedef short bf16x8 __attribute__((ext_vector_type(8)));
typedef float f32x4 __attribute__((ext_vector_type(4)));
typedef unsigned u32x4 __attribute__((ext_vector_type(4)));
constexpr int BM = 256, BK = 64, HALF = 128, HTB = HALF * BK * 2  , STAGE_BYTES = 8 * HTB, NXCD = 8, WGM = 8;

__host__ __device__ __forceinline__ int lds_byte(int r, int c) { const int st = (r >> 4) * 2 + (c >> 5), rr = r & 15, cc = c & 31, ob = rr * 64 + cc * 2; return st * 1024 + (ob ^ (((ob >> 9) & 1) << 5)); }
__host__ __device__ __forceinline__ void stage_rc(int b, int& R, int& C) { const int st = b / 1024, sb = b % 1024, swz = sb ^ (((sb >> 9) & 1) << 5); R = (st >> 1) * 16 + swz / 64; C = (st & 1) * 32 + (swz % 64) / 2; }
__host__ __device__ __forceinline__ int perm32(int rho) { const int n = rho >> 4, i = rho & 15; return 8 * (i >> 2) + 4 * n + (i & 3); }

struct Unit { int pm, pn; };
struct Gemm { const bf16_t* A; const bf16_t* Bt; int M, N, K; };

struct StaticOrder {
    int nM, nN, nwg, G, c;
    __host__ __device__ void init(int M, int N, int G_, int c_) { nM = M / BM; nN = N / BM; nwg = nM * nN; G = G_; c = c_; }
    __host__ __device__ bool next(int i, Unit& u) const {
        const long L = (long)i * G + c; if (L >= nwg) return false;
        int wgid = (int)L; { const int q = nwg / NXCD, r = nwg % NXCD, xcd = wgid % NXCD, off = wgid / NXCD; wgid = (xcd < r ? xcd * (q + 1) : r * (q + 1) + (xcd - r) * q) + off; }
        const int nig = WGM * nN, gid = wgid / nig, fm = gid * WGM, gsz = (nM - fm) < WGM ? (nM - fm) : WGM;
        u.pm = fm + ((wgid % nig) % gsz); u.pn = (wgid % nig) / gsz; return true;
    }
    __device__ __forceinline__ void a_ready(const Unit&) const {}
    __device__ __forceinline__ void done(const Unit&) const {}
};

__device__ __forceinline__ unsigned cvt_pk_bf16(float lo, float hi) { unsigned r; asm volatile("v_cvt_pk_bf16_f32 %0, %1, %2" : "=v"(r) : "v"(lo), "v"(hi)); return r; }
typedef unsigned u32x2 __attribute__((ext_vector_type(2)));
__device__ __forceinline__ int swap23(int t) { return (t & ~12) | ((t & 4) << 1) | ((t & 8) >> 1); }
struct EpiProj {
    static constexpr bool PERM = true, AFTER_DRAIN = false;
    bf16_t* P; bf16_t* Vt; const float* rope; bf16_t* UFP; float qscale;
    __device__ __forceinline__ void operator()(const f32x4 (&acc)[2][2][4][2], const Unit& u, int wr, int wc, int fr, int fq) const {
        const int row0 = u.pm * BM + wr * 64 + fr;
        const int pn = u.pn;
        const bool ctxrow = u.pm >= 128;
        f32x4 CS[2][4], SN[2][4];
        if (pn <= 2) {
#pragma unroll
            for (int ai = 0; ai < 2; ++ai)
#pragma unroll
                for (int m = 0; m < 4; ++m) {
                    CS[ai][m] = (f32x4){1.f, 1.f, 1.f, 1.f}; SN[ai][m] = (f32x4){0.f, 0.f, 0.f, 0.f};
                    if (!ctxrow) { const int t = (row0 + ai * HALF + m * 16) & 8191; const int pos = (wc & 1) ? (t & 63) : (t >> 6);
                        CS[ai][m] = *(const f32x4*)(rope + pos * 32 + 4 * fq); SN[ai][m] = *(const f32x4*)(rope + pos * 32 + 16 + 4 * fq); }
                }
            __builtin_amdgcn_sched_barrier(0);
        }
#pragma unroll
        for (int ai = 0; ai < 2; ++ai)
#pragma unroll
            for (int m = 0; m < 4; ++m) {
                const int row = row0 + ai * HALF + m * 16;
                bf16_t* rowp = P + (size_t)row * 2816 + pn * BM + wc * 32 + 8 * fq;
                if (pn == 5 && !ctxrow) { const int t = row & 8191; rowp = UFP + ((size_t)(((row >> 13) * 64 + (t & 63)) * 128 + (t >> 6))) * 256 + wc * 32 + 8 * fq; }
                if (pn > 2) {
#pragma unroll
                    for (int bj = 0; bj < 2; ++bj) { const f32x4 v0 = acc[ai][bj][m][0], v1 = acc[ai][bj][m][1];
                        u32x4 w; w.x = cvt_pk_bf16(v0[0], v0[1]); w.y = cvt_pk_bf16(v0[2], v0[3]); w.z = cvt_pk_bf16(v1[0], v1[1]); w.w = cvt_pk_bf16(v1[2], v1[3]);
                        *(u32x4*)(rowp + bj * HALF) = w; }
                } else {
                    const f32x4 cs = CS[ai][m], sn = SN[ai][m];
#pragma unroll
                    for (int bj = 0; bj < 2; ++bj) {
                        f32x4 v0 = acc[ai][bj][m][0], v1 = acc[ai][bj][m][1];
                        if (pn == 2 && bj == 1) {
                            u32x4 w; w.x = cvt_pk_bf16(v0[0], v0[1]); w.y = cvt_pk_bf16(v0[2], v0[3]); w.z = cvt_pk_bf16(v1[0], v1[1]); w.w = cvt_pk_bf16(v1[2], v1[3]);
                            *(u32x4*)(rowp + bj * HALF) = w;
                        } else {
                            const f32x4 r0 = v0 * cs - v1 * sn, r1 = v0 * sn + v1 * cs;
                            v0 = r0; v1 = r1;
                            if (pn < 2) { v0 = v0 * qscale; v1 = v1 * qscale; }
                            u32x4 w; w.x = cvt_pk_bf16(v0[0], v0[1]); w.y = cvt_pk_bf16(v0[2], v0[3]); w.z = cvt_pk_bf16(v1[0], v1[1]); w.w = cvt_pk_bf16(v1[2], v1[3]);
                            *(u32x4*)(rowp + bj * HALF) = w;
                        }
                    }
                }
            }
    }
};
struct EpiY {
    static constexpr bool PERM = true, AFTER_DRAIN = false;
    bf16_t* Y; float* ssq;
    __device__ __forceinline__ void operator()(const f32x4 (&acc)[2][2][4][2], const Unit& u, int wr, int wc, int fr, int fq) const {
        const int row0 = u.pm * BM + wr * 64 + fr;
#pragma unroll
        for (int ai = 0; ai < 2; ++ai)
#pragma unroll
            for (int m = 0; m < 4; ++m) {
                const int row = row0 + ai * HALF + m * 16;
                bf16_t* rowp = Y + (size_t)row * 1024 + u.pn * BM + wc * 32 + 8 * fq;
                float s = 0.f;
#pragma unroll
                for (int bj = 0; bj < 2; ++bj) { const f32x4 v0 = acc[ai][bj][m][0], v1 = acc[ai][bj][m][1];
                    s += (v0[0] * v0[0] + v0[1] * v0[1]) + (v0[2] * v0[2] + v0[3] * v0[3]) + (v1[0] * v1[0] + v1[1] * v1[1]) + (v1[2] * v1[2] + v1[3] * v1[3]);
                    u32x4 w; w.x = cvt_pk_bf16(v0[0], v0[1]); w.y = cvt_pk_bf16(v0[2], v0[3]); w.z = cvt_pk_bf16(v1[0], v1[1]); w.w = cvt_pk_bf16(v1[2], v1[3]);
                    *(u32x4*)(rowp + bj * HALF) = w; }
                s += __shfl_xor(s, 16); s += __shfl_xor(s, 32);
                if (fq == 0) ssq[(size_t)row * 16 + u.pn * 4 + wc] = s;
            }
    }
};
template <class Epi, class Sched, bool ALIGN_EPI = false, bool SP2 = false>
__device__ __forceinline__ void gemm_phase(PG8_LAS unsigned char* lds, const Gemm g, const Sched& S, const Epi& E) {
    int tid_ = threadIdx.x; asm volatile("" : "+v"(tid_));
    const int tid = tid_, wid = __builtin_amdgcn_readfirstlane(tid >> 6), lane = tid & 63, wr = wid >> 2, wc = wid & 3, fr = lane & 15, fq = lane >> 4;
    const int K = g.K, nt = K / BK;
    unsigned voffA[2], voffB[2];
#pragma unroll
    for (int i = 0; i < 2; ++i) { int R, C; stage_rc(tid * 16 + i * 8192, R, C); const int Rb = Epi::PERM ? ((R & ~31) + perm32(R & 31)) : R;
        voffA[i] = (unsigned)(R * K + C) * 2u; voffB[i] = (unsigned)(Rb * K + C) * 2u; }
    const size_t kstep = (size_t)(BK * 2);
    const size_t hstep = (size_t)HALF * K * 2;
    const size_t tstep = 2 * hstep;
    const unsigned ldsw = (unsigned)wid * 1024u;
    const int aoff = lds_byte(wr * 64 + fr, fq * 8), boff = lds_byte(wc * 32 + fr, fq * 8);
#define PG8_SA(b, h) (((b) * 2 + (h)) * HTB)
#define PG8_SB(b, h) ((4 + (b) * 2 + (h)) * HTB)
#define PG8_STAGE(bufoff, gbase, voff) do { _Pragma("unroll") for (int _i = 0; _i < 2; ++_i) \
        __builtin_amdgcn_global_load_lds((const unsigned*)((const char*)(gbase) + (voff)[_i]), (PG8_LAS unsigned*)(lds + (bufoff) + ldsw + _i * 8192), 16, 0, 0); } while (0)
#define PG8_LDA(dst, b, h) do { _Pragma("unroll") for (int m = 0; m < 4; ++m) _Pragma("unroll") for (int k = 0; k < 2; ++k) dst[m][k] = *(const PG8_LAS bf16x8*)(lds + PG8_SA(b, h) + aoff + m * 2048 + k * 1024); } while (0)
#define PG8_LDB(dst, b, h) do { _Pragma("unroll") for (int n = 0; n < 2; ++n) _Pragma("unroll") for (int k = 0; k < 2; ++k) dst[n][k] = *(const PG8_LAS bf16x8*)(lds + PG8_SB(b, h) + boff + n * 2048 + k * 1024); } while (0)
#define PG8_MMA(ai, bj, At, Bt) do { __builtin_amdgcn_s_setprio(1); _Pragma("unroll") for (int m = 0; m < 4; ++m) _Pragma("unroll") for (int n = 0; n < 2; ++n) _Pragma("unroll") for (int k = 0; k < 2; ++k) \
        acc[ai][bj][m][n] = __builtin_amdgcn_mfma_f32_16x16x32_bf16(Bt[n][k], At[m][k], acc[ai][bj][m][n], 0, 0, 0); __builtin_amdgcn_s_setprio(0); } while (0)
#define PG8_WAIT_V(n) asm volatile("s_waitcnt vmcnt(" #n ")" ::: "memory")
#define PG8_WAIT_L(n) asm volatile("s_waitcnt lgkmcnt(" #n ")" ::: "memory")
#define PG8_BAR __builtin_amdgcn_s_barrier()
#define PG8_SCHED __builtin_amdgcn_sched_barrier(0)
    Unit cur, nxt; int ui = 0;
    if (!S.next(0, cur)) return;
    f32x4 acc[2][2][4][2];
#pragma unroll
    for (int a = 0; a < 2; ++a)
#pragma unroll
        for (int b = 0; b < 2; ++b)
#pragma unroll
            for (int m = 0; m < 4; ++m)
#pragma unroll
                for (int n = 0; n < 2; ++n) acc[a][b][m][n] = (f32x4){0.f, 0.f, 0.f, 0.f};
    bf16x8 At[4][2], B0[2][2], B1[2][2];
    const char* cA = (const char*)g.A + (size_t)cur.pm * tstep; const char* cB = (const char*)g.Bt + (size_t)cur.pn * tstep;
    S.a_ready(cur);
    if constexpr (SP2) {
        PG8_STAGE(PG8_SB(0, 0), cB, voffB); PG8_STAGE(PG8_SB(0, 1), cB + hstep, voffB); PG8_STAGE(PG8_SA(0, 0), cA, voffA); PG8_STAGE(PG8_SA(0, 1), cA + hstep, voffA);
        if (wr == 1) PG8_BAR;
        PG8_WAIT_V(2); PG8_BAR;
        PG8_STAGE(PG8_SB(1, 0), cB + kstep, voffB); PG8_STAGE(PG8_SA(1, 0), cA + kstep, voffA); PG8_STAGE(PG8_SB(1, 1), cB + hstep + kstep, voffB);
        PG8_WAIT_V(6); PG8_BAR;
    } else {
        PG8_STAGE(PG8_SB(0, 0), cB, voffB); PG8_STAGE(PG8_SA(0, 0), cA, voffA); PG8_STAGE(PG8_SB(0, 1), cB + hstep, voffB); PG8_STAGE(PG8_SA(0, 1), cA + hstep, voffA);
        if (wr == 1) PG8_BAR;
        PG8_WAIT_V(4); PG8_BAR;
        PG8_STAGE(PG8_SB(1, 0), cB + kstep, voffB); PG8_STAGE(PG8_SA(1, 0), cA + kstep, voffA); PG8_STAGE(PG8_SB(1, 1), cB + hstep + kstep, voffB);
        PG8_WAIT_V(6); PG8_BAR;
    }
    for (;;) {
        const bool has_next = S.next(ui + 1, nxt);
        const char* nA = has_next ? (const char*)g.A + (size_t)nxt.pm * tstep : cA; const char* nB = has_next ? (const char*)g.Bt + (size_t)nxt.pn * tstep : cB;
        for (int t = 0; t < nt; t += 2) {
            const bool last = (t == nt - 2);
            const char* a1 = cA + (size_t)(t + 1) * kstep;
            const char* a2 = last ? nA : cA + (size_t)(t + 2) * kstep; const char* b2 = last ? nB : cB + (size_t)(t + 2) * kstep;
            const char* a3 = a2 + kstep; const char* b3 = b2 + kstep;
            if (last && has_next) S.a_ready(nxt);
            if constexpr (SP2) {
            PG8_LDB(B0, 0, 0); PG8_LDB(B1, 0, 1); PG8_SCHED; PG8_LDA(At, 0, 0); PG8_STAGE(PG8_SA(1, 1), a1 + hstep, voffA);
            PG8_WAIT_V(8); PG8_WAIT_L(0); PG8_BAR; PG8_MMA(0, 0, At, B0); PG8_MMA(0, 1, At, B1); PG8_BAR; PG8_SCHED;
            PG8_LDA(At, 0, 1); PG8_STAGE(PG8_SB(0, 0), b2, voffB); PG8_STAGE(PG8_SB(0, 1), b2 + hstep, voffB); PG8_STAGE(PG8_SA(0, 0), a2, voffA);
            PG8_WAIT_V(8); PG8_WAIT_L(0); PG8_BAR; PG8_MMA(1, 0, At, B0); PG8_MMA(1, 1, At, B1); PG8_BAR; PG8_SCHED;
            PG8_LDB(B0, 1, 0); PG8_LDB(B1, 1, 1); PG8_SCHED; PG8_LDA(At, 1, 0); PG8_STAGE(PG8_SA(0, 1), a2 + hstep, voffA);
            PG8_WAIT_V(8); PG8_WAIT_L(0); PG8_BAR; PG8_MMA(0, 0, At, B0); PG8_MMA(0, 1, At, B1); PG8_BAR; PG8_SCHED;
            PG8_LDA(At, 1, 1); PG8_STAGE(PG8_SB(1, 0), b3, voffB); PG8_STAGE(PG8_SB(1, 1), b3 + hstep, voffB); PG8_STAGE(PG8_SA(1, 0), a3, voffA);
            PG8_WAIT_V(8); PG8_WAIT_L(0); PG8_BAR; PG8_MMA(1, 0, At, B0); PG8_MMA(1, 1, At, B1); PG8_BAR; PG8_SCHED;
            } else {
            PG8_LDB(B0, 0, 0); PG8_SCHED; PG8_LDA(At, 0, 0); PG8_STAGE(PG8_SA(1, 1), a1 + hstep, voffA);
            PG8_WAIT_L(8); PG8_BAR; PG8_WAIT_L(0); PG8_MMA(0, 0, At, B0); PG8_BAR; PG8_SCHED;
            PG8_LDB(B1, 0, 1); PG8_STAGE(PG8_SB(0, 0), b2, voffB);
            PG8_BAR; PG8_WAIT_L(0); PG8_MMA(0, 1, At, B1); PG8_BAR;
            PG8_LDA(At, 0, 1); PG8_STAGE(PG8_SA(0, 0), a2, voffA);
            PG8_BAR; PG8_WAIT_L(0); PG8_MMA(1, 0, At, B0); PG8_BAR; PG8_SCHED;
            PG8_STAGE(PG8_SB(0, 1), b2 + hstep, voffB);
            PG8_WAIT_V(6); PG8_BAR; PG8_MMA(1, 1, At, B1); PG8_BAR;
            PG8_LDB(B0, 1, 0); PG8_SCHED; PG8_LDA(At, 1, 0); PG8_STAGE(PG8_SA(0, 1), a2 + hstep, voffA);
            PG8_WAIT_L(8); PG8_BAR; PG8_WAIT_L(0); PG8_MMA(0, 0, At, B0); PG8_BAR; PG8_SCHED;
            PG8_LDB(B1, 1, 1); PG8_STAGE(PG8_SB(1, 0), b3, voffB);
            PG8_BAR; PG8_WAIT_L(0); PG8_MMA(0, 1, At, B1); PG8_BAR;
            PG8_LDA(At, 1, 1); PG8_STAGE(PG8_SA(1, 0), a3, voffA);
            PG8_BAR; PG8_WAIT_L(0); PG8_MMA(1, 0, At, B0); PG8_BAR; PG8_SCHED;
            PG8_STAGE(PG8_SB(1, 1), b3 + hstep, voffB);
            PG8_WAIT_V(6); PG8_BAR; PG8_MMA(1, 1, At, B1); PG8_BAR;
            }
        }
        if constexpr (ALIGN_EPI) { if (wr == 0) PG8_BAR; }
        if constexpr (!Epi::AFTER_DRAIN) { E(acc, cur, wr, wc, fr, fq); S.done(cur); }
        if (!has_next) break;
#pragma unroll
        for (int a = 0; a < 2; ++a)
#pragma unroll
            for (int b = 0; b < 2; ++b)
#pragma unroll
                for (int m = 0; m < 4; ++m)
#pragma unroll
                    for (int n = 0; n < 2; ++n) acc[a][b][m][n] = (f32x4){0.f, 0.f, 0.f, 0.f};
        cur = nxt; cA = nA; cB = nB; ++ui;
        if constexpr (ALIGN_EPI) { if (wr == 1) PG8_BAR; }
    }
    PG8_WAIT_V(0);
    if constexpr (!ALIGN_EPI) { if (wr == 0) PG8_BAR; }
    PG8_BAR;
    if constexpr (Epi::AFTER_DRAIN) { E.fused(acc, cur, wr, wc, fr, fq, lds, wid, lane); S.done(cur); }
#undef PG8_SA
#undef PG8_SB
#undef PG8_STAGE
#undef PG8_LDA
#undef PG8_LDB
#undef PG8_MMA
#undef PG8_WAIT_V
#undef PG8_WAIT_L
#undef PG8_BAR
#undef PG8_SCHED
}
}

typedef unsigned short bf16_t;
typedef short bf16x8 __attribute__((ext_vector_type(8)));
typedef float f32x4 __attribute__((ext_vector_type(4)));
typedef float f32x16 __attribute__((ext_vector_type(16)));
typedef unsigned u32x4 __attribute__((ext_vector_type(4)));
typedef unsigned u32x2 __attribute__((ext_vector_type(2)));
#define LAS __attribute__((address_space(3)))
__device__ __forceinline__ int opaque_tid() { int t = threadIdx.x; asm volatile("" : "+v"(t)); return t; }

constexpr int DM = 1024, NBATCH = 4, SEQ = 8192, NTOK = NBATCH * SEQ, CTXL = 256, NCTX = NBATCH * CTXL, MROWS = NTOK + NCTX;
constexpr int PW = 2816;
constexpr int C_Q = 0, C_K = 512, C_V = 640, C_GA = 768, C_UF = 1280, C_GF = 1536, C_ZC = 1792, C_BC = 2048, C_CC = 2304, C_GC = 2560;
constexpr int VT_PITCH = SEQ + CTXL;
constexpr float NORM_EPS = 1e-6f;
constexpr float LOG2E = 1.4426950408889634f;

constexpr size_t KiB = 1024, MiB = 1u << 20;
constexpr size_t WS_CTL = 0;
constexpr size_t WS_BAR = 16 * KiB;
constexpr size_t WS_ZERO_BYTES = 32 * KiB;
constexpr size_t WS_MOD = 64 * KiB;
constexpr size_t WS_ROPE = 256 * KiB;
constexpr size_t WS_TW = 320 * KiB;
constexpr size_t WS_T1R = 384 * KiB, WS_T1I = 416 * KiB;
constexpr size_t WS_T3R = 448 * KiB, WS_T3I = 464 * KiB;
constexpr size_t WS_T256R = 512 * KiB, WS_T256I = 640 * KiB;
constexpr size_t WS_GT = 768 * KiB;
constexpr size_t WS_SSQ = 1 * MiB;
constexpr size_t WS_WIN = 4 * MiB;
constexpr size_t WS_WOUT = 16 * MiB;
constexpr size_t WS_SSQ1 = 24 * MiB;
constexpr size_t WS_MODP = 28 * MiB;
constexpr size_t WS_HX = 32 * MiB;
constexpr size_t WS_P = 112 * MiB;
constexpr size_t WS_VT = 304 * MiB;
constexpr size_t WS_H = 320 * MiB;
constexpr size_t WS_Y = 392 * MiB;
constexpr size_t WS_YF = 464 * MiB;
constexpr size_t WS_CTX1 = 100 * MiB;
constexpr size_t WS_UFP = 496 * MiB;
constexpr size_t WS_END = 512 * MiB;
static_assert(WS_BAR + 3456 * 4 <= WS_ZERO_BYTES && WS_MODP + (size_t)2 * 8 * 5 * 3072 * 4 <= WS_HX && WS_SSQ + (size_t)MROWS * 16 * 4 <= WS_WIN && WS_WIN + (size_t)2 * PW * DM * 2 <= WS_WOUT && WS_HX + (size_t)MROWS * DM * 2 <= WS_P && WS_P + (size_t)MROWS * PW * 2 <= WS_VT &&
              WS_VT + (size_t)8 * 64 * VT_PITCH * 2 <= WS_H && WS_H + (size_t)MROWS * DM * 2 <= WS_Y && WS_Y + (size_t)MROWS * DM * 2 <= WS_YF && WS_YF + (size_t)4 * 128 * 64 * 512 * 2 <= WS_UFP && WS_UFP + (size_t)NTOK * 256 * 2 <= WS_END && WS_HX + (size_t)MROWS * DM * 2 <= WS_CTX1 && WS_CTX1 + (size_t)NCTX * DM * 4 <= WS_P, "ws map");

constexpr int LDS_BYTES = 147456;
constexpr int LDS_SCHED = LDS_BYTES - 64;
constexpr int LDS_BARST = LDS_BYTES - 32;
constexpr int NTHREADS = 512;

__device__ __forceinline__ float bf2f(unsigned h) { return __uint_as_float(h << 16); }
__device__ __forceinline__ unsigned pkbf(float lo, float hi) { unsigned r; asm volatile("v_cvt_pk_bf16_f32 %0, %1, %2" : "=v"(r) : "v"(lo), "v"(hi)); return r; }
__device__ __forceinline__ float silu_f(float x) { return x * __builtin_amdgcn_rcpf(1.f + __builtin_amdgcn_exp2f(-x * LOG2E)); }
__device__ __forceinline__ float wave_sum(float v) {
#pragma unroll
    for (int o = 1; o < 64; o <<= 1) v += __shfl_xor(v, o);
    return v;
}
__device__ __forceinline__ int swap23(int t) { return (t & ~12) | ((t & 4) << 1) | ((t & 8) >> 1); }
__device__ __forceinline__ int crow(int r, int hi) { return (r & 3) + 8 * (r >> 2) + 4 * hi; }
__device__ __forceinline__ bf16x8 pack8(const f32x16& p, int base) {
    u32x4 w; w.x = pkbf(p[base + 0], p[base + 1]); w.y = pkbf(p[base + 2], p[base + 3]); w.z = pkbf(p[base + 4], p[base + 5]); w.w = pkbf(p[base + 6], p[base + 7]);
    return __builtin_bit_cast(bf16x8, w);
}
#define MFMA32(a, b, c) __builtin_amdgcn_mfma_f32_32x32x16_bf16((a), (b), (c), 0, 0, 0)

struct KArgs {
    const float *x, *c, *ctx, *c_ctx, *w_mod, *b_mod, *g_pre, *g_post, *w_in, *w_out, *sink, *w_f, *conv_w, *conv_b;
    float* out; unsigned char* ws; int ph_lo, ph_hi;
};

__device__ __forceinline__ int prow_qk(int n) { return (n & ~31) | (8 * ((n >> 2) & 3) + 4 * ((n >> 4) & 1) + (n & 3)); }
__device__ __forceinline__ void p0_transpose_item(const float* W, int K, int N, bf16_t* WT, int nperm, float* scr, int item, int lane) {
    const int nblk = N / 32, kb = item / nblk, nb = item % nblk, k0 = 64 * kb, n0 = 32 * nb;
    { float wv[32];
#pragma unroll
      for (int i = 0; i < 32; ++i) wv[i] = __builtin_nontemporal_load(W + (size_t)(k0 + 2 * i + (lane >> 5)) * N + n0 + (lane & 31));
      __builtin_amdgcn_sched_barrier(0);
#pragma unroll
      for (int i = 0; i < 32; ++i) scr[(2 * i + (lane >> 5)) * 33 + (lane & 31)] = wv[i];
      __builtin_amdgcn_sched_barrier(0); }
    asm volatile("s_waitcnt lgkmcnt(0)" ::: "memory");
    const int c = lane & 7;
#pragma unroll
    for (int j = 0; j < 4; ++j) { const int n = (lane >> 3) + 8 * j; const float* s = scr + (8 * c) * 33 + n;
        u32x4 o; o.x = pkbf(s[0 * 33], s[1 * 33]); o.y = pkbf(s[2 * 33], s[3 * 33]); o.z = pkbf(s[4 * 33], s[5 * 33]); o.w = pkbf(s[6 * 33], s[7 * 33]);
        const int nl = n0 + n; const int np = nl < nperm ? prow_qk(nl) : nl;
        *(u32x4*)(WT + (size_t)np * K + k0 + 8 * c) = o; }
    asm volatile("s_waitcnt lgkmcnt(0)" ::: "memory");
}

__device__ __forceinline__ void p0_mod_gemv(const KArgs& a, int item, float* ldsf) {
    const int tid = opaque_tid(), lane = tid & 63, wave = tid >> 6;
    const int l = item / 96, col0 = (item % 96) * 32;
    float* s = ldsf;
    float* red = ldsf + 5 * 1024;
    for (int i = tid; i < 5 * 1024; i += NTHREADS) { const int bb = i >> 10, k = i & 1023; const float v = bb < 4 ? a.c[bb * 1024 + k] : a.c_ctx[k]; s[i] = v / (1.f + __expf(-v)); }
    __syncthreads();
    const int col = lane & 31, kh = lane >> 5;
    const float* W = a.w_mod + (size_t)l * 1024 * 3072 + (size_t)(wave * 128 + kh) * 3072 + col0 + col;
    float w[64];
#pragma unroll
    for (int i = 0; i < 64; ++i) w[i] = __builtin_nontemporal_load(W + (size_t)(2 * i) * 3072);
    float acc[5] = {0.f, 0.f, 0.f, 0.f, 0.f};
#pragma unroll
    for (int i = 0; i < 64; ++i)
#pragma unroll
        for (int bb = 0; bb < 5; ++bb) acc[bb] += w[i] * s[bb * 1024 + wave * 128 + 2 * i + kh];
#pragma unroll
    for (int bb = 0; bb < 5; ++bb) red[((wave * 2 + kh) * 5 + bb) * 32 + col] = acc[bb];
    __syncthreads();
    if (tid < 160) { const int bb = tid >> 5, cc = tid & 31; float v = a.b_mod[l * 3072 + col0 + cc];
#pragma unroll
        for (int ww = 0; ww < 16; ++ww) v += red[(ww * 5 + bb) * 32 + cc];
        ((float*)(a.ws + WS_MOD))[(l * 5 + bb) * 3072 + col0 + cc] = v; }
    __syncthreads();
}

__device__ __forceinline__ void p0_prologue(const KArgs& a, unsigned char* lds) {
    const int tid = opaque_tid(), lane = tid & 63, wave = tid >> 6;
    const int G = gridDim.x, bx = blockIdx.x;
    unsigned char* ws = a.ws;
    if (bx < 192) p0_mod_gemv(a, bx, (float*)lds);
    {
        float* scr = (float*)(lds + wave * 16384);
        const int gw = bx * 8 + wave, NGW = G * 8;
        constexpr int I_IN = (DM / 64) * (PW / 32), I_OUT = (DM / 64) * (DM / 32);
        constexpr int NIT = 2 * (I_IN + I_OUT);
        for (int it = gw; it < NIT; it += NGW) {
            int r = it; const int l = r / (I_IN + I_OUT); r -= l * (I_IN + I_OUT);
            if (r < I_IN) p0_transpose_item(a.w_in + (size_t)l * DM * PW, DM, PW, (bf16_t*)(ws + WS_WIN) + (size_t)l * PW * DM, 640, scr, r, lane);
            else p0_transpose_item(a.w_out + (size_t)l * DM * DM, DM, DM, (bf16_t*)(ws + WS_WOUT) + (size_t)l * DM * DM, 0, scr, r - I_IN, lane);
        }
    }
    const int gt = bx * NTHREADS + tid, NGT = G * NTHREADS;
    for (int i = gt; i < 128 * 16; i += NGT) {
        const int pos = i >> 4, f = i & 15; const float inv = powf(10000.0f, -(float)f / 16.0f); const float ang = (float)pos * inv;
        float* rp = (float*)(ws + WS_ROPE) + pos * 32; rp[f] = cosf(ang); rp[16 + f] = sinf(ang);
    }
    for (int i = gt; i < 8192; i += NGT) { float sn, cs; sincospif((float)i * (2.0f / 8192.0f), &sn, &cs); float* t = (float*)(ws + WS_TW) + 2 * i; t[0] = cs; t[1] = sn; }
    for (int i = gt; i < 128 * 128; i += NGT) { const int k = i >> 7, n = i & 127; float sn, cs; sincospif((float)((k * n) & 127) * (2.0f / 128.0f), &sn, &cs);
        ((bf16_t*)(ws + WS_T1R))[i] = (bf16_t)(pkbf(cs, 0.f) & 0xffffu); ((bf16_t*)(ws + WS_T1I))[i] = (bf16_t)(pkbf(-sn, 0.f) & 0xffffu); }
    for (int i = gt; i < 64 * 128; i += NGT) { const int k = i >> 7, kk = i & 127, n = kk & 63; float sn, cs; sincospif((float)((k * n) & 63) * (2.0f / 64.0f), &sn, &cs);
        const float tr = kk < 64 ? cs : sn, ti = kk < 64 ? -sn : cs;
        const int fpos = ((((k >> 5) * 8 + (kk >> 4)) * 64 + ((k & 31) + 32 * ((kk >> 3) & 1))) * 8) + (kk & 7);
        ((bf16_t*)(ws + WS_T3R))[fpos] = (bf16_t)(pkbf(tr, 0.f) & 0xffffu); ((bf16_t*)(ws + WS_T3I))[fpos] = (bf16_t)(pkbf(ti, 0.f) & 0xffffu); }
    for (int i = gt; i < 256 * 256; i += NGT) { const int k = i >> 8, n = i & 255; float sn, cs; sincospif((float)((k * n) & 255) * (2.0f / 256.0f), &sn, &cs);
        ((bf16_t*)(ws + WS_T256R))[i] = (bf16_t)(pkbf(cs, 0.f) & 0xffffu); ((bf16_t*)(ws + WS_T256I))[i] = (bf16_t)(pkbf(-sn, 0.f) & 0xffffu); }
    {
        __syncthreads();
        float* trig = (float*)lds;
        if (tid < 64) { float sn, cs; sincospif((float)tid * (2.0f / 64.0f), &sn, &cs); trig[tid] = cs; trig[64 + tid] = sn; }
        __syncthreads();
        for (int i = gt; i < 2 * 4 * 64 * 128; i += NGT) {
            const int kk = i & 127, d = (i >> 7) & 63, g = (i >> 13) & 3, l = i >> 15; const int part = kk >> 6, c = swap23(kk & 63);
            const float* wf = a.w_f + ((size_t)(l * 4 + g) * 64) * 64 + d; float sacc = 0.f;
            float wfv[64];
#pragma unroll
            for (int j = 0; j < 64; ++j) wfv[j] = wf[j * 64];
            __builtin_amdgcn_sched_barrier(0);
#pragma unroll
            for (int j = 0; j < 64; ++j) sacc += trig[part * 64 + ((c * j) & 63)] * wfv[j];
            const int gpos = ((((((l * 4 + g) * 2 + (d >> 5)) * 8 + (kk >> 4)) * 64) + ((d & 31) + 32 * ((kk >> 3) & 1))) * 8) + (kk & 7);
            ((bf16_t*)(ws + WS_GT))[gpos] = (bf16_t)(pkbf(sacc * (1.0f / 724.0773439350246f), 0.f) & 0xffffu);
        }
        __syncthreads();
    }
}

__device__ __forceinline__ void norm_rows4(int mode, int lane, const float* src, float* dst, const bf16_t* y0, const float* ssq0, const bf16_t* y1, const float* ssq1, bf16_t* hx,
                                           const f32x4 (&GA0)[4], const f32x4 (&GA1)[4], const f32x4 (&GB)[4], const f32x4 (&GC)[4]) {
    f32x4 v[4][4];
#pragma unroll
    for (int rr = 0; rr < 4; ++rr)
#pragma unroll
        for (int j = 0; j < 4; ++j) v[rr][j] = __builtin_nontemporal_load((const f32x4*)(src + (size_t)rr * DM + 4 * lane + 256 * j));
    if (mode != 0) {
        u32x2 yw[4][4], yx[4][4]; float p[4], p1[4];
#pragma unroll
        for (int rr = 0; rr < 4; ++rr) { p[rr] = ssq0[rr * 16 + (lane & 15)];
#pragma unroll
            for (int j = 0; j < 4; ++j) yw[rr][j] = __builtin_nontemporal_load((const u32x2*)(y0 + (size_t)rr * DM + 4 * lane + 256 * j)); }
        if (mode == 2) {
#pragma unroll
            for (int rr = 0; rr < 4; ++rr) { p1[rr] = ssq1[rr * 16 + (lane & 15)];
#pragma unroll
                for (int j = 0; j < 4; ++j) yx[rr][j] = __builtin_nontemporal_load((const u32x2*)(y1 + (size_t)rr * DM + 4 * lane + 256 * j)); }
        }
#pragma unroll
        for (int rr = 0; rr < 4; ++rr) {
            float q = p[rr]; q += __shfl_xor(q, 1); q += __shfl_xor(q, 2); q += __shfl_xor(q, 4); q += __shfl_xor(q, 8);
            const float rstd = 1.0f / sqrtf(q * (1.0f / DM) + NORM_EPS);
#pragma unroll
            for (int j = 0; j < 4; ++j) {
                f32x4 yy; yy[0] = bf2f(yw[rr][j].x & 0xffffu); yy[1] = bf2f(yw[rr][j].x >> 16); yy[2] = bf2f(yw[rr][j].y & 0xffffu); yy[3] = bf2f(yw[rr][j].y >> 16);
                v[rr][j] = v[rr][j] + GA0[j] * (yy * rstd);
            }
        }
        if (mode == 2) {
#pragma unroll
            for (int rr = 0; rr < 4; ++rr) {
                float q = p1[rr]; q += __shfl_xor(q, 1); q += __shfl_xor(q, 2); q += __shfl_xor(q, 4); q += __shfl_xor(q, 8);
                const float rstd = 1.0f / sqrtf(q * (1.0f / DM) + NORM_EPS);
#pragma unroll
                for (int j = 0; j < 4; ++j) {
                    f32x4 yy; yy[0] = bf2f(yx[rr][j].x & 0xffffu); yy[1] = bf2f(yx[rr][j].x >> 16); yy[2] = bf2f(yx[rr][j].y & 0xffffu); yy[3] = bf2f(yx[rr][j].y >> 16);
                    v[rr][j] = v[rr][j] + GA1[j] * (yy * rstd);
                    __builtin_nontemporal_store(v[rr][j], (f32x4*)(dst + (size_t)rr * DM + 4 * lane + 256 * j));
                }
            }
        }
    }
    if (mode != 2) {
        float s[4];
#pragma unroll
        for (int rr = 0; rr < 4; ++rr) { float t = 0.f;
#pragma unroll
            for (int j = 0; j < 4; ++j) t += (v[rr][j][0] * v[rr][j][0] + v[rr][j][1] * v[rr][j][1]) + (v[rr][j][2] * v[rr][j][2] + v[rr][j][3] * v[rr][j][3]);
            s[rr] = t; }
#pragma unroll
        for (int o = 1; o < 64; o <<= 1) {
#pragma unroll
            for (int rr = 0; rr < 4; ++rr) s[rr] += __shfl_xor(s[rr], o); }
#pragma unroll
        for (int rr = 0; rr < 4; ++rr) {
            const float rstd = 1.0f / sqrtf(s[rr] * (1.0f / DM) + NORM_EPS);
#pragma unroll
            for (int j = 0; j < 4; ++j) {
                const f32x4 o = (v[rr][j] * rstd) * GB[j] + GC[j];
                u32x2 w; w.x = pkbf(o[0], o[1]); w.y = pkbf(o[2], o[3]);
                *(u32x2*)(hx + (size_t)rr * DM + 4 * lane + 256 * j) = w;
            }
        }
    }
}
__device__ __forceinline__ void norm_phase(const KArgs& a, int mode) {
    const int tid = opaque_tid(), lane = tid & 63, wave = tid >> 6;
    const int NGW = gridDim.x * 8;
    unsigned char* ws = a.ws;
    const float* mod = (const float*)(ws + WS_MOD);
    const int lp = (mode == 0) ? 0 : 1;
    bf16_t* HX = (bf16_t*)(ws + WS_HX); const bf16_t* Y0 = (const bf16_t*)(ws + WS_Y); const float* SSQ0 = (const float*)(ws + WS_SSQ);
    const bf16_t* Y1 = (const bf16_t*)(ws + WS_HX); const float* SSQ1 = (const float*)(ws + WS_SSQ1);
    const int gw2 = wave * (int)gridDim.x + (int)blockIdx.x;
    const int nlat = NTOK / 4;
    int curb = -1; f32x4 GA0[4], GA1[4], GB[4], GC[4];
    int base = gw2 * 4, sub = 0, itc = nlat + gw2; bool inctx = false;
    for (;;) {
        int it;
        if (!inctx) { if (base >= nlat) { inctx = true; continue; } it = base + sub; if (++sub == 4) { sub = 0; base += NGW * 4; } }
        else { if (mode == 2 || itc >= nlat + NCTX / 4) break; it = itc; itc += NGW; }
        const int r = it * 4;
        const int b = r < NTOK ? (r >> 13) : 4;
        if (b != curb) { curb = b;
            const float* mp = mod + (lp * 5 + b) * 3072; const float* m0 = mod + (0 * 5 + b) * 3072; const float* m1 = mod + (1 * 5 + b) * 3072;
#pragma unroll
            for (int j = 0; j < 4; ++j) { const int c = 4 * lane + 256 * j;
                GA0[j] = *(const f32x4*)(m0 + 2048 + c) * *(const f32x4*)(a.g_post + c);
                GA1[j] = *(const f32x4*)(m1 + 2048 + c) * *(const f32x4*)(a.g_post + DM + c);
                GB[j] = *(const f32x4*)(a.g_pre + lp * DM + c) * (*(const f32x4*)(mp + 1024 + c) + 1.0f);
                GC[j] = *(const f32x4*)(mp + c); } }
        const float* src = (r < NTOK) ? a.x + (size_t)r * DM : a.ctx + (size_t)(r - NTOK) * DM;
        norm_rows4(mode, lane, src, a.out + (size_t)r * DM, Y0 + (size_t)r * DM, SSQ0 + (size_t)r * 16, Y1 + (size_t)r * DM, SSQ1 + (size_t)r * 16, HX + (size_t)r * DM, GA0, GA1, GB, GC);
    }
}

typedef short v4i16_t __attribute__((ext_vector_type(4)));
__device__ __forceinline__ v4i16_t trrd(const unsigned char* p) { return __builtin_amdgcn_ds_read_tr16_b64_v4i16((LAS v4i16_t*)p); }
__device__ __forceinline__ bf16x8 cat8(v4i16_t lo, v4i16_t hi) { return (bf16x8){lo[0], lo[1], lo[2], lo[3], hi[0], hi[1], hi[2], hi[3]}; }
__device__ __forceinline__ void attn_unit(int u, const bf16_t* P, const bf16_t* Vt, bf16_t* H, const float* sink, unsigned char* lds) {
    const int tid = opaque_tid(), lane = tid & 63, wave = __builtin_amdgcn_readfirstlane(tid >> 6), r32 = lane & 31, hi = lane >> 5;
    const bool isctx = u >= 1024;
    int b, kvh, qb;
    if (isctx) { const int v = u - 1024; b = v >> 3; kvh = (v >> 2) & 1; qb = v & 3; } else { b = u >> 8; kvh = (u >> 7) & 1; qb = u & 127; }
    const int head = kvh * 4 + (wave >> 1);
    const int qtok = qb * 64 + (wave & 1) * 32 + r32;
    const size_t qrow = isctx ? (size_t)(NTOK + b * CTXL + qtok) : (size_t)(b * SEQ + qtok);
    const float sinkv = sink[head];
    unsigned char* qscr = lds + 45056 + wave * 4608;
    u32x4 qld[4];
#pragma unroll
    for (int i4 = 0; i4 < 4; ++i4) qld[i4] = __builtin_nontemporal_load((const u32x4*)(P + (qrow - r32 + i4 * 8 + (lane >> 3)) * PW + C_Q + head * 64 + (lane & 7) * 8));
    int jlo = 0, jhi = -1;
    if (!isctx) { jlo = qb < 2 ? 2 - qb : 0; jhi = (129 - qb) < 4 ? (129 - qb) : 4; }
    const int ntiles = 4 + (jhi - jlo + 1);
    const int srow = tid >> 3, sch = tid & 7;
    const bf16_t* Kc = P + (size_t)(NTOK + b * CTXL + srow) * PW + C_K + kvh * 64 + sch * 8;
    const bf16_t* Kl = P + (size_t)(b * SEQ + srow) * PW + C_K + kvh * 64 + sch * 8;
    unsigned char* Ks = lds; unsigned char* Vs = lds + 2 * 9216;
    const int vsoff = srow * 192 + sch * 16;
    const int soff = srow * 144 + sch * 16;
    u32x4 kreg, vreg, kreg2, vreg2;
#define ATT_GLOAD(KR, VR, ti_) do { const int t_ = (ti_); \
        if (t_ < 4) { KR = *(const u32x4*)(Kc + (size_t)(64 * t_) * PW); VR = *(const u32x4*)(Kc + (size_t)(64 * t_) * PW + 128); } \
        else { const int kbase_ = qb * 64 - 128 + 64 * (jlo + t_ - 4); KR = *(const u32x4*)(Kl + (size_t)kbase_ * PW); VR = *(const u32x4*)(Kl + (size_t)kbase_ * PW + 128); } } while (0)
    const size_t qrow0 = qrow - r32;
    u32x4 gaw[4];
#pragma unroll
    for (int i4 = 0; i4 < 4; ++i4) gaw[i4] = __builtin_nontemporal_load((const u32x4*)(P + (qrow0 + i4 * 8 + (lane >> 3)) * PW + C_GA + head * 64 + (lane & 7) * 8));
    ATT_GLOAD(kreg2, vreg2, 0);
    ATT_GLOAD(kreg, vreg, 1);
#pragma unroll
    for (int i4 = 0; i4 < 4; ++i4) *(u32x4*)(qscr + (i4 * 8 + (lane >> 3)) * 144 + (lane & 7) * 16) = qld[i4];
    *(u32x4*)(Ks + soff) = kreg2; *(u32x4*)(Vs + vsoff) = vreg2;
    __syncthreads();
    bf16x8 qf[4];
#pragma unroll
    for (int d0 = 0; d0 < 4; ++d0) qf[d0] = *(const bf16x8*)(qscr + r32 * 144 + (2 * d0 + hi) * 16);
    const float sink2 = sinkv * LOG2E;
    float mref = sink2, lsum = 0.f;
    f32x16 oT[2]; oT[0] = f32x16{}; oT[1] = f32x16{};
    const int qpos = qtok;
    for (int ti = 0; ti < ntiles; ++ti) {
        const int buf = ti & 1;
        if (ti + 2 < ntiles) ATT_GLOAD(kreg2, vreg2, ti + 2);
        const unsigned char* kb = Ks + buf * 9216 + r32 * 144 + hi * 16;
        const unsigned char* vb = Vs + buf * 12288 + (4 * hi + ((lane & 15) >> 2)) * 192 + (16 * ((lane >> 4) & 1) + 4 * (lane & 3)) * 2;
        bf16x8 kf[8];
#pragma unroll
        for (int d0 = 0; d0 < 4; ++d0) { kf[2 * d0] = *(const bf16x8*)(kb + d0 * 32); kf[2 * d0 + 1] = *(const bf16x8*)(kb + 32 * 144 + d0 * 32); }
        f32x16 p0, p1;
#pragma unroll
        for (int r = 0; r < 16; ++r) { p0[r] = -mref; p1[r] = -mref; }
        __builtin_amdgcn_sched_barrier(0);
#pragma unroll
        for (int d0 = 0; d0 < 4; ++d0) { p0 = MFMA32(kf[2 * d0], qf[d0], p0); p1 = MFMA32(kf[2 * d0 + 1], qf[d0], p1); }
        bf16x8 vf[8];
#pragma unroll
        for (int blk = 0; blk < 2; ++blk)
#pragma unroll
            for (int ks = 0; ks < 4; ++ks) vf[blk * 4 + ks] = cat8(trrd(vb + (16 * ks) * 192 + blk * 64), trrd(vb + (16 * ks + 8) * 192 + blk * 64));
        __builtin_amdgcn_sched_barrier(0);
        asm volatile("s_nop 15\n\ts_nop 7" : "+v"(p0), "+v"(p1));
        if (ti >= 4) {
            const int j = jlo + ti - 4; const int kbase = qb * 64 - 128 + 64 * j;
            if (j == 0) {
#pragma unroll
                for (int r = 0; r < 16; ++r) { const int kp = kbase + crow(r, hi); if (kp < qpos - 128) p0[r] = -INFINITY; if (kp + 32 < qpos - 128) p1[r] = -INFINITY; }
            } else if (j == 4) {
#pragma unroll
                for (int r = 0; r < 16; ++r) { const int kp = kbase + crow(r, hi); if (kp > qpos + 128) p0[r] = -INFINITY; if (kp + 32 > qpos + 128) p1[r] = -INFINITY; }
            }
        }
        float rma, rmb;
        asm("v_max3_f32 %0, %1, %2, %3" : "=v"(rma) : "v"(p0[0]), "v"(p0[1]), "v"(p1[0]));
        asm("v_max3_f32 %0, %1, %2, %3" : "=v"(rmb) : "v"(p0[2]), "v"(p0[3]), "v"(p1[1]));
        asm("v_max3_f32 %0, %1, %2, %3" : "=v"(rma) : "v"(rma), "v"(p1[2]), "v"(p1[3]));
#pragma unroll
        for (int r = 4; r < 16; r += 4) {
            asm("v_max3_f32 %0, %1, %2, %3" : "=v"(rma) : "v"(rma), "v"(p0[r]), "v"(p0[r + 1]));
            asm("v_max3_f32 %0, %1, %2, %3" : "=v"(rmb) : "v"(rmb), "v"(p0[r + 2]), "v"(p0[r + 3]));
            asm("v_max3_f32 %0, %1, %2, %3" : "=v"(rma) : "v"(rma), "v"(p1[r]), "v"(p1[r + 1]));
            asm("v_max3_f32 %0, %1, %2, %3" : "=v"(rmb) : "v"(rmb), "v"(p1[r + 2]), "v"(p1[r + 3]));
        }
        float rm; asm("v_max3_f32 %0, %1, %2, %3" : "=v"(rm) : "v"(rma), "v"(rmb), "v"(rmb));
        { const float rmo = __shfl_xor(rm, 32); asm("v_max3_f32 %0, %1, %2, %3" : "=v"(rm) : "v"(rm), "v"(rmo), "v"(rmo)); }
        if (__any(rm > 8.0f)) {
            const float dl = fmaxf(rm, 0.f);
            mref += dl;
            const float f = __builtin_amdgcn_exp2f(-dl);
            lsum *= f;
#pragma unroll
            for (int r = 0; r < 16; ++r) { p0[r] -= dl; p1[r] -= dl; oT[0][r] *= f; oT[1][r] *= f; }
        }
        float ls = 0.f;
#pragma unroll
        for (int r = 0; r < 16; ++r) { p0[r] = __builtin_amdgcn_exp2f(p0[r]); p1[r] = __builtin_amdgcn_exp2f(p1[r]); ls += p0[r] + p1[r]; }
        lsum += ls;
        bf16x8 pf[4]; pf[0] = pack8(p0, 0); pf[1] = pack8(p0, 8); pf[2] = pack8(p1, 0); pf[3] = pack8(p1, 8);
#pragma unroll
        for (int blk = 0; blk < 2; ++blk)
#pragma unroll
            for (int ks = 0; ks < 4; ++ks) oT[blk] = MFMA32(vf[blk * 4 + ks], pf[ks], oT[blk]);
        if (ti + 1 < ntiles) { *(u32x4*)(Ks + (buf ^ 1) * 9216 + soff) = kreg; *(u32x4*)(Vs + (buf ^ 1) * 12288 + vsoff) = vreg; }
        kreg = kreg2; vreg = vreg2;
        __syncthreads();
    }
    lsum += __shfl_xor(lsum, 32);
    lsum += __builtin_amdgcn_exp2f(sink2 - mref);
    const float inv = 1.0f / lsum;
    unsigned char* ow = qscr;
#pragma unroll
    for (int blk = 0; blk < 2; ++blk)
#pragma unroll
        for (int g4 = 0; g4 < 4; ++g4) {
            u32x2 w; w.x = pkbf(oT[blk][4 * g4 + 0] * inv, oT[blk][4 * g4 + 1] * inv); w.y = pkbf(oT[blk][4 * g4 + 2] * inv, oT[blk][4 * g4 + 3] * inv);
            *(u32x2*)(ow + r32 * 144 + (32 * blk + 8 * g4 + 4 * hi) * 2) = w;
        }
    asm volatile("s_waitcnt lgkmcnt(0)" ::: "memory");
#pragma unroll
    for (int i4 = 0; i4 < 4; ++i4) {
        const int rr = i4 * 8 + (lane >> 3), ch = lane & 7;
        const u32x4 ov = *(const u32x4*)(ow + rr * 144 + ch * 16);
        const unsigned ovv[4] = {ov.x, ov.y, ov.z, ov.w}, gvv[4] = {gaw[i4].x, gaw[i4].y, gaw[i4].z, gaw[i4].w};
        u32x4 w;
        unsigned wv[4];
#pragma unroll
        for (int e = 0; e < 4; ++e) wv[e] = pkbf(bf2f(ovv[e] & 0xffffu) * silu_f(bf2f(gvv[e] & 0xffffu)), bf2f(ovv[e] >> 16) * silu_f(bf2f(gvv[e] >> 16)));
        w.x = wv[0]; w.y = wv[1]; w.z = wv[2]; w.w = wv[3];
        *(u32x4*)(H + (qrow0 + rr) * DM + head * 64 + ch * 8) = w;
    }
    asm volatile("s_waitcnt lgkmcnt(0)" ::: "memory");
}

__device__ __forceinline__ void fft1_unit(int u, const bf16_t* P, bf16_t* YF, const unsigned char* ws, unsigned char* lds) {
    const int tid = opaque_tid(), lane = tid & 63, wave = __builtin_amdgcn_readfirstlane(tid >> 6), r32 = lane & 31, hi = lane >> 5;
    const int b = u >> 6, n2 = u & 63;
    constexpr int UPB = 576;
    const bf16_t* src = P + (size_t)(b * SEQ + n2) * PW + C_UF;
#pragma unroll
    for (int i = 0; i < 8; ++i) {
        const int id = tid + NTHREADS * i, n1 = id >> 5, cc = id & 31;
        *(u32x4*)(lds + n1 * UPB + cc * 16) = *(const u32x4*)(src + (size_t)n1 * 64 * PW + cc * 8);
    }
    __syncthreads();
    const bf16_t* T1R = (const bf16_t*)(ws + WS_T1R); const bf16_t* T1I = (const bf16_t*)(ws + WS_T1I);
    f32x16 aR[4], aI[4];
#pragma unroll
    for (int kb = 0; kb < 4; ++kb) { aR[kb] = f32x16{}; aI[kb] = f32x16{}; }
    const unsigned char* ap = lds + (8 * hi + ((lane & 15) >> 2)) * UPB + (32 * wave + 16 * ((lane >> 4) & 1) + 4 * (lane & 3)) * 2;
#pragma unroll 2
    for (int ks = 0; ks < 8; ++ks) {
        const bf16x8 av = cat8(trrd(ap + (16 * ks) * UPB), trrd(ap + (16 * ks + 4) * UPB));
#pragma unroll
        for (int kb = 0; kb < 4; ++kb) {
            const bf16x8 bR = *(const bf16x8*)(T1R + (32 * kb + r32) * 128 + 16 * ks + 8 * hi), bI = *(const bf16x8*)(T1I + (32 * kb + r32) * 128 + 16 * ks + 8 * hi);
            aR[kb] = MFMA32(av, bR, aR[kb]); aI[kb] = MFMA32(av, bI, aI[kb]);
        }
    }
    const float* TW = (const float*)(ws + WS_TW);
#pragma unroll
    for (int kb = 0; kb < 4; ++kb) {
        const int k1 = 32 * kb + r32;
        const float ct = TW[2 * (n2 * k1)], st = TW[2 * (n2 * k1) + 1];
        bf16_t* yp = YF + ((size_t)((b * 128 + k1) * 64 + n2)) * 512 + 32 * wave + 4 * hi;
#pragma unroll
        for (int g4 = 0; g4 < 4; ++g4) {
            float yr[4], yi[4];
#pragma unroll
            for (int e = 0; e < 4; ++e) { const float r_ = aR[kb][4 * g4 + e], i_ = aI[kb][4 * g4 + e]; yr[e] = r_ * ct + i_ * st; yi[e] = i_ * ct - r_ * st; }
            u32x2 wr_, wi_; wr_.x = pkbf(yr[0], yr[1]); wr_.y = pkbf(yr[2], yr[3]); wi_.x = pkbf(yi[0], yi[1]); wi_.y = pkbf(yi[2], yi[3]);
            *(u32x2*)(yp + 8 * g4) = wr_; *(u32x2*)(yp + 256 + 8 * g4) = wi_;
        }
    }
    __syncthreads();
}

template <int KK>
__device__ __forceinline__ void dftf_unit(const bf16_t* srcbase, int R, int pitchA, int pitchB, const bf16_t* Tr, const bf16_t* Ti, const bf16_t* Gt,
                                          const bf16_t* P, bf16_t* H, size_t row0, int rowstride, float oscale, unsigned char* lds) {
    const int tid = opaque_tid(), lane = tid & 63, wave = __builtin_amdgcn_readfirstlane(tid >> 6), r32 = lane & 31, hi = lane >> 5;
    constexpr int ZPB = (KK == 128) ? 576 : 544;
#pragma unroll 1
    for (int i0 = 0; i0 < KK / 16; i0 += 8) {
        u32x4 img[8];
#pragma unroll
        for (int i = 0; i < 8; ++i) { const int id = tid + NTHREADS * (i0 + i), kk = id >> 5, cc = id & 31; img[i] = *(const u32x4*)(srcbase + (size_t)(kk % R) * pitchA + (size_t)(kk / R) * pitchB + cc * 8); }
        __builtin_amdgcn_sched_barrier(0);
#pragma unroll
        for (int i = 0; i < 8; ++i) { const int id = tid + NTHREADS * (i0 + i), kk = id >> 5, cc = id & 31; *(u32x4*)(lds + kk * ZPB + cc * 16) = img[i]; }
        __builtin_amdgcn_sched_barrier(0);
    }
    __syncthreads();
    const int g = wave >> 1, kblk = wave & 1;
    f32x16 XR[2], XI[2];
#pragma unroll
    for (int cb = 0; cb < 2; ++cb) { XR[cb] = f32x16{}; XI[cb] = f32x16{}; }
    const bf16_t* trp = Tr + (size_t)(32 * kblk + r32) * KK + 8 * hi; const bf16_t* tip = Ti + (size_t)(32 * kblk + r32) * KK + 8 * hi;
    const unsigned char* zp = lds + (8 * hi + ((lane & 15) >> 2)) * ZPB + (64 * g + 16 * ((lane >> 4) & 1) + 4 * (lane & 3)) * 2;
#pragma unroll 2
    for (int ks = 0; ks < KK / 16; ++ks) {
        const bf16x8 bR = *(const bf16x8*)(trp + 16 * ks), bI = *(const bf16x8*)(tip + 16 * ks);
#pragma unroll
        for (int cb = 0; cb < 2; ++cb) { const bf16x8 av = cat8(trrd(zp + (16 * ks) * ZPB + cb * 64), trrd(zp + (16 * ks + 4) * ZPB + cb * 64)); XR[cb] = MFMA32(av, bR, XR[cb]); XI[cb] = MFMA32(av, bI, XI[cb]); }
    }
    f32x16 oa[2]; oa[0] = f32x16{}; oa[1] = f32x16{};
    const bf16_t* gp = Gt + (size_t)(g * 2 * 8 * 64 + lane) * 8;
    u32x2 gfw[8];
    { const size_t rowg = row0 + (size_t)(32 * kblk + r32) * rowstride;
#pragma unroll
      for (int i8 = 0; i8 < 8; ++i8) gfw[i8] = *(const u32x2*)(P + rowg * PW + C_GF + 64 * g + 32 * (i8 >> 2) + 8 * (i8 & 3) + 4 * hi); }
#pragma unroll
    for (int part = 0; part < 2; ++part)
#pragma unroll
        for (int cb = 0; cb < 2; ++cb)
#pragma unroll
            for (int s = 0; s < 2; ++s) {
                const bf16x8 bx = pack8(part ? XI[cb] : XR[cb], 8 * s);
                const int kko = part * 64 + 32 * cb + 16 * s;
#pragma unroll
                for (int lb = 0; lb < 2; ++lb) { const bf16x8 ag = *(const bf16x8*)(gp + (size_t)((lb * 8 + (kko >> 4)) * 64) * 8); oa[lb] = MFMA32(ag, bx, oa[lb]); }
            }
    const int k2 = 32 * kblk + r32;
    const size_t row = row0 + (size_t)k2 * rowstride;
    const bf16_t* gfrow = P + row * PW + C_GF + 64 * g;
    bf16_t* hrow = H + row * DM + 512 + 64 * g;
#pragma unroll
    for (int lb = 0; lb < 2; ++lb)
#pragma unroll
        for (int g4 = 0; g4 < 4; ++g4) {
            const int l0 = 32 * lb + 8 * g4 + 4 * hi;
            const u32x2 gw = gfw[lb * 4 + g4];
            const float o0 = oa[lb][4 * g4 + 0] * oscale * silu_f(bf2f(gw.x & 0xffffu)), o1 = oa[lb][4 * g4 + 1] * oscale * silu_f(bf2f(gw.x >> 16));
            const float o2 = oa[lb][4 * g4 + 2] * oscale * silu_f(bf2f(gw.y & 0xffffu)), o3 = oa[lb][4 * g4 + 3] * oscale * silu_f(bf2f(gw.y >> 16));
            u32x2 w; w.x = pkbf(o0, o1); w.y = pkbf(o2, o3);
            *(u32x2*)(hrow + l0) = w;
        }
    __syncthreads();
}

__device__ __forceinline__ void conv_unit(int u, const bf16_t* P, bf16_t* H, const float* cw, const float* cb) {
    const int tid = opaque_tid(), cgp = tid & 31, rg = tid >> 5;
    const int ch0 = cgp * 8;
    const int r0 = u * 64 + rg * 4;
    int pos, len; if (r0 < NTOK) { pos = r0 & (SEQ - 1); len = SEQ; } else { pos = (r0 - NTOK) & (CTXL - 1); len = CTXL; }
    float w0[8], w1[8], w2[8], bs[8];
#pragma unroll
    for (int e = 0; e < 8; ++e) { w0[e] = cw[ch0 + e]; w1[e] = cw[256 + ch0 + e]; w2[e] = cw[512 + ch0 + e]; bs[e] = cb[ch0 + e]; }
    float T[6][8];
#pragma unroll
    for (int i = 0; i < 6; ++i) {
        const int p = pos - 1 + i;
        if (p >= 0 && p < len) {
            const size_t row = (size_t)(r0 - 1 + i);
            const u32x4 z = *(const u32x4*)(P + row * PW + C_ZC + ch0), c = *(const u32x4*)(P + row * PW + C_CC + ch0);
            T[i][0] = bf2f(z.x & 0xffffu) * bf2f(c.x & 0xffffu); T[i][1] = bf2f(z.x >> 16) * bf2f(c.x >> 16);
            T[i][2] = bf2f(z.y & 0xffffu) * bf2f(c.y & 0xffffu); T[i][3] = bf2f(z.y >> 16) * bf2f(c.y >> 16);
            T[i][4] = bf2f(z.z & 0xffffu) * bf2f(c.z & 0xffffu); T[i][5] = bf2f(z.z >> 16) * bf2f(c.z >> 16);
            T[i][6] = bf2f(z.w & 0xffffu) * bf2f(c.w & 0xffffu); T[i][7] = bf2f(z.w >> 16) * bf2f(c.w >> 16);
        } else {
#pragma unroll
            for (int e = 0; e < 8; ++e) T[i][e] = 0.f;
        }
    }
#pragma unroll
    for (int i = 0; i < 4; ++i) {
        const size_t row = (size_t)(r0 + i);
        const u32x4 bw = *(const u32x4*)(P + row * PW + C_BC + ch0), gw = *(const u32x4*)(P + row * PW + C_GC + ch0);
        const unsigned bwv[4] = {bw.x, bw.y, bw.z, bw.w}, gwv[4] = {gw.x, gw.y, gw.z, gw.w};
        float o[8];
#pragma unroll
        for (int e = 0; e < 8; ++e) {
            const float bv = (e & 1) ? bf2f(bwv[e >> 1] >> 16) : bf2f(bwv[e >> 1] & 0xffffu);
            const float gv = (e & 1) ? bf2f(gwv[e >> 1] >> 16) : bf2f(gwv[e >> 1] & 0xffffu);
            const float y = T[i][e] * w0[e] + T[i + 1][e] * w1[e] + T[i + 2][e] * w2[e] + bs[e];
            o[e] = bv * y * silu_f(gv);
        }
        u32x4 w; w.x = pkbf(o[0], o[1]); w.y = pkbf(o[2], o[3]); w.z = pkbf(o[4], o[5]); w.w = pkbf(o[6], o[7]);
        *(u32x4*)(H + row * DM + 768 + ch0) = w;
    }
}

__device__ __forceinline__ void fft1_tables(const unsigned char* ws, unsigned char* tbl, int tid) {
    u32x4 tv[8];
#pragma unroll
    for (int i = 0; i < 8; ++i) { const int id = tid + NTHREADS * i, t = id >> 11, row = (id >> 4) & 127, ch = id & 15; tv[i] = *(const u32x4*)(ws + (t ? WS_T1I : WS_T1R) + row * 256 + ch * 16); }
    __builtin_amdgcn_sched_barrier(0);
#pragma unroll
    for (int i = 0; i < 8; ++i) { const int id = tid + NTHREADS * i, t = id >> 11, row = (id >> 4) & 127, ch = id & 15; *(u32x4*)(tbl + t * 34816 + row * 272 + ch * 16) = tv[i]; }
}
__device__ __forceinline__ void fft1_wave(int task, const bf16_t* P, bf16_t* YF, const unsigned char* ws, unsigned char* lds_w, const unsigned char* tbl, int lane, int pmode = 0) {
    const int r32 = lane & 31, hi = lane >> 5;
    const int cblk = task & 7, n2 = (task >> 3) & 63, b = task >> 9;
    const bf16_t* src = P + (size_t)((b * 64 + n2) * 128) * 256 + 32 * cblk + 8 * (lane & 3);
    { u32x4 img[8];
#pragma unroll
      for (int i = 0; i < 8; ++i) img[i] = __builtin_nontemporal_load((const u32x4*)(src + (size_t)(16 * i + (lane >> 2)) * 256));
      __builtin_amdgcn_sched_barrier(0);
#pragma unroll
      for (int i = 0; i < 8; ++i) *(u32x4*)(lds_w + (16 * i + (lane >> 2)) * 64 + (lane & 3) * 16) = img[i];
      __builtin_amdgcn_sched_barrier(0); }
    asm volatile("s_waitcnt vmcnt(0) lgkmcnt(0)" ::: "memory");
    if (pmode == 2) return;
    const bf16_t* T1R = (const bf16_t*)(ws + WS_T1R); const bf16_t* T1I = (const bf16_t*)(ws + WS_T1I);
    f32x16 aR[4], aI[4];
#pragma unroll
    for (int kb = 0; kb < 4; ++kb) { aR[kb] = f32x16{}; aI[kb] = f32x16{}; }
    const unsigned char* ap = lds_w + (8 * hi + ((lane & 15) >> 2)) * 64 + (16 * ((lane >> 4) & 1) + 4 * (lane & 3)) * 2;
    const unsigned char* tb = tbl + r32 * 272 + hi * 16;
#pragma unroll 2
    for (int ks = 0; ks < 8; ++ks) {
        const bf16x8 av = cat8(trrd(ap + (16 * ks) * 64), trrd(ap + (16 * ks + 4) * 64));
        bf16x8 bq[8];
#pragma unroll
        for (int kb = 0; kb < 4; ++kb) { bq[2 * kb] = *(const bf16x8*)(tb + (32 * kb) * 272 + 32 * ks); bq[2 * kb + 1] = *(const bf16x8*)(tb + 34816 + (32 * kb) * 272 + 32 * ks); }
#pragma unroll
        for (int kb = 0; kb < 4; ++kb) { aR[kb] = MFMA32(av, bq[2 * kb], aR[kb]); aI[kb] = MFMA32(av, bq[2 * kb + 1], aI[kb]); }
    }
    const float* TW = (const float*)(ws + WS_TW);
    float ctw[4], stw[4];
#pragma unroll
    for (int kb = 0; kb < 4; ++kb) { const int k1 = 32 * kb + r32; ctw[kb] = TW[2 * (n2 * k1)]; stw[kb] = TW[2 * (n2 * k1) + 1]; }
    asm volatile("s_waitcnt lgkmcnt(0)" ::: "memory");
#pragma unroll
    for (int pr = 0; pr < 2; ++pr) {
#pragma unroll
        for (int kq = 0; kq < 2; ++kq) {
            const int kb = 2 * pr + kq; const int rowl = 32 * kq + r32; const float ct = ctw[kb], st = stw[kb];
#pragma unroll
            for (int g4 = 0; g4 < 4; ++g4) {
                float yr[4], yi[4];
#pragma unroll
                for (int e = 0; e < 4; ++e) { const float r_ = aR[kb][4 * g4 + e], i_ = aI[kb][4 * g4 + e]; yr[e] = r_ * ct + i_ * st; yi[e] = i_ * ct - r_ * st; }
                u32x2 wr_, wi_; wr_.x = pkbf(yr[0], yr[1]); wr_.y = pkbf(yr[2], yr[3]); wi_.x = pkbf(yi[0], yi[1]); wi_.y = pkbf(yi[2], yi[3]);
                *(u32x2*)(lds_w + rowl * 128 + ((g4 ^ (rowl & 7)) * 16) + hi * 8) = wr_;
                *(u32x2*)(lds_w + rowl * 128 + (((4 + g4) ^ (rowl & 7)) * 16) + hi * 8) = wi_;
            }
        }
        asm volatile("s_waitcnt lgkmcnt(0)" ::: "memory");
#pragma unroll
        for (int i8 = 0; i8 < 8; ++i8) {
            const int rowl = i8 * 8 + (lane >> 3), ch = lane & 7;
            const u32x4 v = *(const u32x4*)(lds_w + rowl * 128 + ((ch ^ (rowl & 7)) * 16));
            const int k1 = 64 * pr + rowl;
            bf16_t* dst = YF + ((size_t)((b * 128 + k1) * 64 + n2)) * 512 + (ch >> 2) * 256 + 32 * cblk + 8 * (ch & 3);
            *(u32x4*)dst = v;
        }
        asm volatile("s_waitcnt lgkmcnt(0)" ::: "memory");
    }
}
__device__ __forceinline__ void fft3_wave(int task, const bf16_t* YF, const bf16_t* Gt, const bf16_t* P, bf16_t* H, const unsigned char* ws, unsigned char* lds_w, int lane) {
    const int r32 = lane & 31, hi = lane >> 5;
    const int g = task & 3, k1 = (task >> 2) & 127, b = task >> 9;
    const bf16_t* src = YF + ((size_t)(b * 128 + k1) * 64) * 512 + 64 * g + 8 * (lane & 7);
    { u32x4 img[16];
#pragma unroll
      for (int i = 0; i < 16; ++i) { const int kk = 8 * i + (lane >> 3); img[i] = __builtin_nontemporal_load((const u32x4*)(src + (size_t)(kk & 63) * 512 + (size_t)(kk >> 6) * 256)); }
      __builtin_amdgcn_sched_barrier(0);
#pragma unroll
      for (int i = 0; i < 16; ++i) { const int kk = 8 * i + (lane >> 3), ch = lane & 7; *(u32x4*)(lds_w + kk * 128 + ((ch ^ (((kk >> 1) & 1) << 2)) * 16)) = img[i]; }
      __builtin_amdgcn_sched_barrier(0); }
    asm volatile("s_waitcnt vmcnt(0) lgkmcnt(0)" ::: "memory");
    const bf16_t* T3R = (const bf16_t*)(ws + WS_T3R); const bf16_t* T3I = (const bf16_t*)(ws + WS_T3I);
    const int q = (lane & 15) >> 2, sw = (q >> 1) & 1;
    const int chl = 2 * ((lane >> 4) & 1) + ((lane & 3) >> 1);
    const unsigned char* zb = lds_w + (8 * hi + q) * 128 + 8 * (lane & 1);
    const unsigned char* zp0 = zb + ((chl ^ (sw << 2)) * 16);
    const unsigned char* zp1 = zb + (((4 + chl) ^ (sw << 2)) * 16);
    const bf16_t* gp = Gt + (size_t)(g * 2 * 8 * 64 + lane) * 8;
    const size_t rowb = (size_t)(b * SEQ + k1);
    u32x2 hwA[8], hwB[8];
#pragma unroll
    for (int i8 = 0; i8 < 8; ++i8) { hwA[i8] = (u32x2){0u, 0u}; hwB[i8] = (u32x2){0u, 0u}; }
#pragma unroll 1
    for (int kblk = 0; kblk < 2; ++kblk) {
        f32x16 XR[2], XI[2];
#pragma unroll
        for (int cb = 0; cb < 2; ++cb) { XR[cb] = f32x16{}; XI[cb] = f32x16{}; }
        const bf16_t* trp = T3R + (size_t)(kblk * 8 * 64 + lane) * 8; const bf16_t* tip = T3I + (size_t)(kblk * 8 * 64 + lane) * 8;
        const size_t rowg = rowb + (size_t)(32 * kblk + r32) * 128;
        u32x2 gfw[8];
#pragma unroll
        for (int i8 = 0; i8 < 8; ++i8) gfw[i8] = *(const u32x2*)(P + rowg * PW + C_GF + 64 * g + 32 * (i8 >> 2) + 8 * (i8 & 3) + 4 * hi);
        bf16x8 bR[8], bI[8];
#pragma unroll
        for (int ks = 0; ks < 8; ++ks) { bR[ks] = *(const bf16x8*)(trp + 512 * ks); bI[ks] = *(const bf16x8*)(tip + 512 * ks); }
        __builtin_amdgcn_sched_barrier(0);
#pragma unroll
        for (int ks = 0; ks < 8; ++ks) {
            const bf16x8 a0 = cat8(trrd(zp0 + (16 * ks) * 128), trrd(zp0 + (16 * ks + 4) * 128));
            const bf16x8 a1 = cat8(trrd(zp1 + (16 * ks) * 128), trrd(zp1 + (16 * ks + 4) * 128));
            XR[0] = MFMA32(a0, bR[ks], XR[0]); XI[0] = MFMA32(a0, bI[ks], XI[0]); XR[1] = MFMA32(a1, bR[ks], XR[1]); XI[1] = MFMA32(a1, bI[ks], XI[1]);
        }
        __builtin_amdgcn_sched_barrier(0);
        bf16x8 gfr[2][8];
#pragma unroll
        for (int lb = 0; lb < 2; ++lb)
#pragma unroll
            for (int q8 = 0; q8 < 8; ++q8) gfr[lb][q8] = *(const bf16x8*)(gp + (size_t)((lb * 8 + q8) * 64) * 8);
        __builtin_amdgcn_sched_barrier(0);
        f32x16 oa[2]; oa[0] = f32x16{}; oa[1] = f32x16{};
#pragma unroll
        for (int part = 0; part < 2; ++part)
#pragma unroll
            for (int cb = 0; cb < 2; ++cb)
#pragma unroll
                for (int s = 0; s < 2; ++s) {
                    const bf16x8 bx = pack8(part ? XI[cb] : XR[cb], 8 * s);
                    const int kko = part * 64 + 32 * cb + 16 * s;
#pragma unroll
                    for (int lb = 0; lb < 2; ++lb) oa[lb] = MFMA32(gfr[lb][kko >> 4], bx, oa[lb]);
                }
#pragma unroll
        for (int lb = 0; lb < 2; ++lb)
#pragma unroll
            for (int g4 = 0; g4 < 4; ++g4) {
                const u32x2 gw = gfw[lb * 4 + g4];
                const float o0 = oa[lb][4 * g4 + 0] * silu_f(bf2f(gw.x & 0xffffu)), o1 = oa[lb][4 * g4 + 1] * silu_f(bf2f(gw.x >> 16));
                const float o2 = oa[lb][4 * g4 + 2] * silu_f(bf2f(gw.y & 0xffffu)), o3 = oa[lb][4 * g4 + 3] * silu_f(bf2f(gw.y >> 16));
                u32x2 pk; pk.x = pkbf(o0, o1); pk.y = pkbf(o2, o3);
                if (kblk == 0) hwA[lb * 4 + g4] = pk; else hwB[lb * 4 + g4] = pk;
            }
    }
    asm volatile("s_waitcnt lgkmcnt(0)" ::: "memory");
#pragma unroll
    for (int kblk = 0; kblk < 2; ++kblk)
#pragma unroll
        for (int lb = 0; lb < 2; ++lb)
#pragma unroll
            for (int g4 = 0; g4 < 4; ++g4) { const int rowl = 32 * kblk + r32;
                *(u32x2*)(lds_w + rowl * 128 + (((4 * lb + g4) ^ (rowl & 7)) * 16) + hi * 8) = kblk ? hwB[lb * 4 + g4] : hwA[lb * 4 + g4]; }
    asm volatile("s_waitcnt lgkmcnt(0)" ::: "memory");
#pragma unroll
    for (int i8 = 0; i8 < 8; ++i8) {
        const int rowl = i8 * 8 + (lane >> 3), ch = lane & 7;
        const u32x4 v = *(const u32x4*)(lds_w + rowl * 128 + ((ch ^ (rowl & 7)) * 16));
        *(u32x4*)(H + (rowb + (size_t)rowl * 128) * DM + 512 + 64 * g + 8 * ch) = v;
    }
    asm volatile("s_waitcnt lgkmcnt(0)" ::: "memory");
}
__device__ __forceinline__ void conv_wave(int task, const bf16_t* P, bf16_t* H, const float* cw, const float* cb, int lane) {
    const int cgp = lane & 31, ch0 = cgp * 8;
    const int r0 = task * 8 + (lane >> 5) * 4;
    int pos, len; if (r0 < NTOK) { pos = r0 & (SEQ - 1); len = SEQ; } else { pos = (r0 - NTOK) & (CTXL - 1); len = CTXL; }
    u32x4 zz[6], cc[6], bb[4], gg[4]; float okf[6];
#pragma unroll
    for (int i = 0; i < 6; ++i) { const int p = pos - 1 + i; const bool ok = p >= 0 && p < len; okf[i] = ok ? 1.f : 0.f; const size_t row = (size_t)(ok ? r0 - 1 + i : r0);
        zz[i] = __builtin_nontemporal_load((const u32x4*)(P + row * PW + C_ZC + ch0)); cc[i] = __builtin_nontemporal_load((const u32x4*)(P + row * PW + C_CC + ch0)); }
#pragma unroll
    for (int i = 0; i < 4; ++i) { const size_t row = (size_t)(r0 + i); bb[i] = __builtin_nontemporal_load((const u32x4*)(P + row * PW + C_BC + ch0)); gg[i] = __builtin_nontemporal_load((const u32x4*)(P + row * PW + C_GC + ch0)); }
    __builtin_amdgcn_sched_barrier(0);
    float w0[8], w1[8], w2[8], bs[8];
    { const f32x4 a0 = *(const f32x4*)(cw + ch0), a1 = *(const f32x4*)(cw + ch0 + 4), b0 = *(const f32x4*)(cw + 256 + ch0), b1 = *(const f32x4*)(cw + 256 + ch0 + 4);
      const f32x4 c0 = *(const f32x4*)(cw + 512 + ch0), c1 = *(const f32x4*)(cw + 512 + ch0 + 4), d0 = *(const f32x4*)(cb + ch0), d1 = *(const f32x4*)(cb + ch0 + 4);
#pragma unroll
      for (int e = 0; e < 4; ++e) { w0[e] = a0[e]; w0[4 + e] = a1[e]; w1[e] = b0[e]; w1[4 + e] = b1[e]; w2[e] = c0[e]; w2[4 + e] = c1[e]; bs[e] = d0[e]; bs[4 + e] = d1[e]; } }
    float T[6][8];
#pragma unroll
    for (int i = 0; i < 6; ++i) {
        const unsigned zv[4] = {zz[i].x, zz[i].y, zz[i].z, zz[i].w}, cv[4] = {cc[i].x, cc[i].y, cc[i].z, cc[i].w};
#pragma unroll
        for (int e = 0; e < 8; ++e) T[i][e] = okf[i] * ((e & 1) ? bf2f(zv[e >> 1] >> 16) : bf2f(zv[e >> 1] & 0xffffu)) * ((e & 1) ? bf2f(cv[e >> 1] >> 16) : bf2f(cv[e >> 1] & 0xffffu));
    }
#pragma unroll
    for (int i = 0; i < 4; ++i) {
        const size_t row = (size_t)(r0 + i);
        const unsigned bwv[4] = {bb[i].x, bb[i].y, bb[i].z, bb[i].w}, gwv[4] = {gg[i].x, gg[i].y, gg[i].z, gg[i].w};
        float o[8];
#pragma unroll
        for (int e = 0; e < 8; ++e) {
            const float bv = (e & 1) ? bf2f(bwv[e >> 1] >> 16) : bf2f(bwv[e >> 1] & 0xffffu);
            const float gv = (e & 1) ? bf2f(gwv[e >> 1] >> 16) : bf2f(gwv[e >> 1] & 0xffffu);
            const float y = T[i][e] * w0[e] + T[i + 1][e] * w1[e] + T[i + 2][e] * w2[e] + bs[e];
            o[e] = bv * y * silu_f(gv);
        }
        u32x4 w; w.x = pkbf(o[0], o[1]); w.y = pkbf(o[2], o[3]); w.z = pkbf(o[4], o[5]); w.w = pkbf(o[6], o[7]);
        *(u32x4*)(H + row * DM + 768 + ch0) = w;
    }
}

#define XB_TMO      128
#define XB_XCNT(j)  (256  + 64 * (j))
#define XB_XSUB(j)  (1280 + 64 * (j))
#define XB_XGEN(j)  (2304 + 64 * (j))
#define XB_TOP      3328
#define XB_TOPGEN   3392
#define XCD_BAR_WORDS 3456
#define XB_SPIN_CAP (1u << 18)

__device__ __forceinline__ unsigned xb_ld(unsigned* p)              { return __hip_atomic_load(p, __ATOMIC_RELAXED, __HIP_MEMORY_SCOPE_AGENT); }
__device__ __forceinline__ unsigned xb_add(unsigned* p, unsigned v) { return __hip_atomic_fetch_add(p, v, __ATOMIC_RELAXED, __HIP_MEMORY_SCOPE_AGENT); }
__device__ __forceinline__ unsigned xb_xcc_id() { return (unsigned)__builtin_amdgcn_s_getreg((3 << 11) | 20) & 0xFu; }
#define XB_SPIN(cond, bar) do { unsigned _sp = 0; while (cond) { __builtin_amdgcn_s_sleep(1); \
    if ((++_sp & 255u) == 0u) { if (xb_ld(&(bar)[XB_TMO])) break; if (_sp > XB_SPIN_CAP) { atomicAdd(&(bar)[XB_TMO], 1u); break; } } } } while (0)

struct XcdBarrier {
    unsigned* bar; unsigned x;
    volatile LAS unsigned* st;
};

__device__ __forceinline__ XcdBarrier xcd_barrier_post(unsigned* bar, volatile LAS unsigned* st) {
    XcdBarrier b; b.bar = bar; b.x = xb_xcc_id(); b.st = st;
    if (threadIdx.x == 0) (void)xb_add(&bar[XB_XCNT(b.x)], 1u);
    return b;
}
__device__ __forceinline__ void xcd_barrier_complete(unsigned* bar, unsigned x, unsigned& nloc, unsigned& nx) {
    const unsigned G = gridDim.x * gridDim.y * gridDim.z;
    unsigned sum, cnt, mine, sp = 0u;
    for (;;) {
        sum = 0u; cnt = 0u; mine = 0u;
#pragma unroll
        for (unsigned j = 0; j < 16; ++j) { const unsigned c = xb_ld(&bar[XB_XCNT(j)]); sum += c; cnt += (c > 0u) ? 1u : 0u; mine = (j == x) ? c : mine; }
        if (sum == G) break;
        __builtin_amdgcn_s_sleep(1);
        if ((++sp & 255u) == 0u) { if (xb_ld(&bar[XB_TMO])) break; if (sp > XB_SPIN_CAP) { atomicAdd(&bar[XB_TMO], 1u); break; } }
    }
    nloc = mine > 0u ? mine : 1u; nx = cnt > 0u ? cnt : 1u;
}

__device__ __forceinline__ void xcd_barrier(const XcdBarrier& b) {
    asm volatile("s_waitcnt vmcnt(0)" ::: "memory");
    __syncthreads();
    if (threadIdx.x == 0) {
        unsigned* bar = b.bar;
        __builtin_amdgcn_s_waitcnt(0);
        unsigned nloc = b.st[0], nx = b.st[1];
        if (nloc == 0u) { xcd_barrier_complete(bar, b.x, nloc, nx); b.st[0] = nloc; b.st[1] = nx; }
        const unsigned old = xb_add(&bar[XB_XSUB(b.x)], 1u);
        const unsigned gen = old / nloc;
        if (old + 1u == (gen + 1u) * nloc) {
            __builtin_amdgcn_fence(__ATOMIC_RELEASE, "agent");
            asm volatile("s_waitcnt vmcnt(0)" ::: "memory");
            const unsigned og = xb_add(&bar[XB_TOP], 1u);
            const unsigned tg = og / nx;
            if (og + 1u == (tg + 1u) * nx) xb_add(&bar[XB_TOPGEN], 1u);
            else XB_SPIN(xb_ld(&bar[XB_TOPGEN]) == tg, bar);
            __builtin_amdgcn_fence(__ATOMIC_ACQUIRE, "agent");
            xb_add(&bar[XB_XGEN(b.x)], 1u);
            asm volatile("s_waitcnt vmcnt(0)" ::: "memory");
        } else {
            XB_SPIN(xb_ld(&bar[XB_XGEN(b.x)]) == gen, bar);
            __builtin_amdgcn_fence(__ATOMIC_ACQUIRE, "agent");
            asm volatile("s_waitcnt vmcnt(0)" ::: "memory");
        }
    }
    __syncthreads();
}

__device__ __forceinline__ int next_unit(unsigned* ctr, unsigned char* lds) {
    volatile int* sw = (volatile int*)(lds + LDS_SCHED);
    if (threadIdx.x == 0) *sw = (int)atomicAdd(ctr, 1u);
    __syncthreads();
    const int u = *sw;
    __syncthreads();
    return u;
}

__global__ void __launch_bounds__(NTHREADS, 2) hybrid_fwd(KArgs a) {
    extern __shared__ __attribute__((aligned(16))) unsigned char lds[];
    cg::grid_group grid = cg::this_grid();
    unsigned char* ws = a.ws;
    const int lo = a.ph_lo, hi = a.ph_hi;
#ifndef PHMASK
#define PHMASK 0xfff
#endif
#define IN(k) (((PHMASK >> ((k) > 5 && (k) < 11 ? (k) - 5 : (k))) & 1) && lo <= (k) && (k) < hi)
#define SEAM(k) do { if (IN(k) && IN((k) + 1)) xcd_barrier(xbar); } while (0)
#ifndef REP_PHASE
#define REP_PHASE -1
#endif
#define REPS(j) for (int rep = 0, nrep = (REP_PHASE == (j)) ? 2 : 1; rep < nrep; ++rep, (rep < nrep ? xcd_barrier(xbar) : (void)0))
    bf16_t* HX = (bf16_t*)(ws + WS_HX); bf16_t* Pb = (bf16_t*)(ws + WS_P); bf16_t* Vt = (bf16_t*)(ws + WS_VT); bf16_t* Hb = (bf16_t*)(ws + WS_H);
    bf16_t* Yb = (bf16_t*)(ws + WS_Y); bf16_t* YF = (bf16_t*)(ws + WS_YF); float* SSQ = (float*)(ws + WS_SSQ);
    unsigned* ctl = (unsigned*)(ws + WS_CTL);

    if (threadIdx.x < 2) ((volatile LAS unsigned*)(lds + LDS_BARST))[threadIdx.x] = 0u;
    __syncthreads();
    const XcdBarrier xbar = xcd_barrier_post((unsigned*)(ws + WS_BAR), (volatile LAS unsigned*)(lds + LDS_BARST));
    if (a.ph_lo < 0) grid.sync();
    REPS(30) if (IN(0)) p0_prologue(a, lds);
    SEAM(0);
    for (int l = 0; l < 2; ++l) {
        const int pb = 1 + 5 * l;
        REPS(0) if (IN(pb)) norm_phase(a, l);
        SEAM(pb);
        REPS(1) if (IN(pb + 1)) {
            pg8::Gemm g{HX, (const bf16_t*)(ws + WS_WIN) + (size_t)l * PW * DM, MROWS, PW, DM};
            pg8::StaticOrder S; S.init(MROWS, PW, (int)gridDim.x, (int)blockIdx.x);
            pg8::EpiProj E{Pb, Vt, (const float*)(ws + WS_ROPE), (bf16_t*)(ws + WS_UFP), 0.125f * LOG2E};
            pg8::gemm_phase<pg8::EpiProj, pg8::StaticOrder, true, true>((PG8_LAS unsigned char*)lds, g, S, E);
        }
        SEAM(pb + 1);
        for (int rep = 0, nrep = (REP_PHASE >= 20 && REP_PHASE < 30) ? 2 : 1; rep < nrep; ++rep, (rep < nrep ? xcd_barrier(xbar) : (void)0)) if (IN(pb + 2)) {
            const int nAttn = (l == 0) ? 1056 : 1024, nCtxF = (l == 0) ? 16 : 0, nF1 = 256, nConv = ((l == 0) ? MROWS : NTOK) / 64;
            const int e0 = nF1, e1 = e0 + nCtxF, e2 = e1 + nAttn, e3 = e2 + nConv;
            for (;;) {
                const int u = next_unit(ctl + 2 * l + 8 * rep, lds);
                if (u >= e3) break;
                if (rep == 1) { const int ty = u < e0 ? 1 : u < e1 ? 3 : u < e2 ? 0 : 2; if (REP_PHASE == 25 ? (ty == 0) : (ty != REP_PHASE - 20)) continue; }
                int au = -1, cu = -1;
                if (u >= e1) { const int k = u - e1, C1 = nConv - 256, T = nAttn + C1;
                    if (k >= T) cu = C1 + (k - T);
                    else { const int c0 = (k * C1) / T, c1 = ((k + 1) * C1) / T; if (c1 > c0) cu = c0; else au = k - c0; } }
                if (au >= 0) attn_unit(au, Pb, Vt, Hb, a.sink + 8 * l, lds);
                else if (u >= e0 && u < e1) { const int v = u - e0, b = v >> 2, kb = v & 3;
                    dftf_unit<256>(Pb + (size_t)(NTOK + b * CTXL) * PW + C_UF, 256, PW, 0, (const bf16_t*)(ws + WS_T256R) + (size_t)(64 * kb) * 256, (const bf16_t*)(ws + WS_T256I) + (size_t)(64 * kb) * 256,
                                   (const bf16_t*)(ws + WS_GT) + (size_t)l * 4 * 64 * 128, Pb, Hb, (size_t)(NTOK + b * CTXL + 64 * kb), 1, 5.656854249492381f, lds); }
                else {
                    const int tid = opaque_tid(), lane = tid & 63, wave = __builtin_amdgcn_readfirstlane(tid >> 6);
                    if (u < e0) { fft1_tables(ws, lds + 65536, tid); __syncthreads(); fft1_wave(u * 8 + wave, (const bf16_t*)(ws + WS_UFP), YF, ws, lds + wave * 8192, lds + 65536, lane); }
                    else conv_wave(cu * 8 + wave, Pb, Hb, a.conv_w + l * 768, a.conv_b + l * 256, lane);
                }
            }
        }
        SEAM(pb + 2);
        REPS(3) if (IN(pb + 3)) {
            const bool gemmwg = (l == 0 && blockIdx.x < 16);
            if (gemmwg) {
                pg8::Gemm g{Hb + (size_t)NTOK * DM, (const bf16_t*)(ws + WS_WOUT) + (size_t)l * DM * DM, NCTX, DM, DM};
                pg8::StaticOrder S; S.init(NCTX, DM, 16, (int)blockIdx.x);
                pg8::EpiY E{Yb + (size_t)NTOK * DM, SSQ + (size_t)NTOK * 16};
                pg8::gemm_phase<pg8::EpiY, pg8::StaticOrder, true, true>((PG8_LAS unsigned char*)lds, g, S, E);
            } else {
                const int tid = opaque_tid(), lane = tid & 63, wave = __builtin_amdgcn_readfirstlane(tid >> 6);
                const int nb0 = (l == 0) ? 16 : 0;
                const int gw = ((int)blockIdx.x - nb0) + wave * ((int)gridDim.x - nb0), NGW = ((int)gridDim.x - nb0) * 8;
                unsigned char* lds_w = lds + wave * 16384;
                for (int t = gw; t < 2048; t += NGW) fft3_wave(t, YF, (const bf16_t*)(ws + WS_GT) + (size_t)l * 4 * 64 * 128, Pb, Hb, ws, lds_w, lane);
            }
            __syncthreads();
        }
        SEAM(pb + 3);
        REPS(4) if (IN(pb + 4)) {
            pg8::Gemm g{Hb, (const bf16_t*)(ws + WS_WOUT) + (size_t)l * DM * DM, NTOK, DM, DM};
            pg8::StaticOrder S; S.init(NTOK, DM, (int)gridDim.x, (int)blockIdx.x);
            pg8::EpiY E{l == 0 ? Yb : HX, l == 0 ? SSQ : (float*)(ws + WS_SSQ1)};
            pg8::gemm_phase<pg8::EpiY, pg8::StaticOrder, true, true>((PG8_LAS unsigned char*)lds, g, S, E);
        }
        SEAM(pb + 4);
    }
#if REP_PHASE == 9
    for (int i = 0; i < 10; ++i) xcd_barrier(xbar);
#endif
    if (IN(11)) norm_phase(a, 2);
#undef IN
#undef SEAM
}

#ifndef MK_MULTI
#define MK_MULTI 0
#endif
extern "C" void kernel_launch(void* const* d_in, const int* in_sizes, int n_in, void* d_out, int out_size, void* d_ws, size_t ws_size, hipStream_t stream) {
    static int grid = 0;
    if (grid == 0) {
        if (n_in != 14 || ws_size < WS_END) { fprintf(stderr, "kernel_launch: unexpected n_in %d or ws_size %zu (need %zu)\n", n_in, ws_size, (size_t)WS_END); grid = -1; return; }
        int dev = 0, cus = 0, per_cu = 0;
        hipGetDevice(&dev); hipDeviceGetAttribute(&cus, hipDeviceAttributeMultiprocessorCount, dev);
        if (hipFuncSetAttribute((const void*)hybrid_fwd, hipFuncAttributeMaxDynamicSharedMemorySize, LDS_BYTES) != hipSuccess) { fprintf(stderr, "kernel_launch: hipFuncSetAttribute failed\n"); grid = -1; return; }
        if (hipOccupancyMaxActiveBlocksPerMultiprocessor(&per_cu, (const void*)hybrid_fwd, NTHREADS, LDS_BYTES) != hipSuccess || per_cu < 1) { fprintf(stderr, "kernel_launch: occupancy query gave %d\n", per_cu); per_cu = 1; }
        (void)hipGetLastError();
        grid = cus * 1;
        fprintf(stderr, "kernel_launch: grid %d (cus %d, per_cu %d)\n", grid, cus, per_cu);
    }
    if (grid < 0) return;
    if (hipMemsetAsync((char*)d_ws + WS_CTL, 0, WS_ZERO_BYTES, stream) != hipSuccess) { fprintf(stderr, "kernel_launch: hipMemsetAsync failed\n"); return; }
    KArgs a{};
    a.x = (const float*)d_in[0]; a.c = (const float*)d_in[1]; a.ctx = (const float*)d_in[2]; a.c_ctx = (const float*)d_in[3]; a.w_mod = (const float*)d_in[4]; a.b_mod = (const float*)d_in[5];
    a.g_pre = (const float*)d_in[6]; a.g_post = (const float*)d_in[7]; a.w_in = (const float*)d_in[8]; a.w_out = (const float*)d_in[9]; a.sink = (const float*)d_in[10]; a.w_f = (const float*)d_in[11];
    a.conv_w = (const float*)d_in[12]; a.conv_b = (const float*)d_in[13];
    a.out = (float*)d_out; a.ws = (unsigned char*)d_ws;
#if MK_MULTI
    for (int ph = 0; ph < 12; ++ph) { a.ph_lo = ph; a.ph_hi = ph + 1; hipLaunchKernelGGL(hybrid_fwd, dim3(grid), dim3(NTHREADS), LDS_BYTES, stream, a); }
#else
    a.ph_lo = 0; a.ph_hi = 12;
    void* args[] = {&a};
    hipError_t e = hipLaunchCooperativeKernel((const void*)hybrid_fwd, dim3(grid), dim3(NTHREADS), args, LDS_BYTES, stream);
    if (e != hipSuccess) fprintf(stderr, "kernel_launch: cooperative launch failed: %s (grid %d)\n", hipGetErrorString(e), grid);
#endif
}
```

```cpp
#include <hip/hip_runtime.h>
#include <hip/hip_cooperative_groups.h>
#include <cstdio>
#include <cstdint>
namespace cg = cooperative_groups;
namespace pg8 {
#define PG8_LAS __attribute__((address_space(3)))
typedef unsigned short bf16_t;
typedef short bf16x8 __attribute__((ext_vector_type(8)));
typedef float f32x4 __attribute__((ext_vector_type(4)));
typedef unsigned u32x4 __attribute__((ext_vector_type(4)));
constexpr int BM = 256, BK = 64, HALF = 128, HTB = HALF * BK * 2  , STAGE_BYTES = 8 * HTB, NXCD = 8, WGM = 8;

__host__ __device__ __forceinline__ int lds_byte(int r, int c) { const int st = (r >> 4) * 2 + (c >> 5), rr = r & 15, cc = c & 31, ob = rr * 64 + cc * 2; return st * 1024 + (ob ^ (((ob >> 9) & 1) << 5)); }
__host__ __device__ __forceinline__ void stage_rc(int b, int& R, int& C) { const int st = b / 1024, sb = b % 1024, swz = sb ^ (((sb >> 9) & 1) << 5); R = (st >> 1) * 16 + swz / 64; C = (st & 1) * 32 + (swz % 64) / 2; }
__host__ __device__ __forceinline__ int perm32(int rho) { const int n = rho >> 4, i = rho & 15; return 8 * (i >> 2) + 4 * n + (i & 3); }

struct Unit { int pm, pn; };
struct Gemm { const bf16_t* A; const bf16_t* Bt; int M, N, K; };

struct StaticOrder {
    int nM, nN, nwg, G, c;
    __host__ __device__ void init(int M, int N, int G_, int c_) { nM = M / BM; nN = N / BM; nwg = nM * nN; G = G_; c = c_; }
    __host__ __device__ bool next(int i, Unit& u) const {
        const long L = (long)i * G + c; if (L >= nwg) return false;
        int wgid = (int)L; { const int q = nwg / NXCD, r = nwg % NXCD, xcd = wgid % NXCD, off = wgid / NXCD; wgid = (xcd < r ? xcd * (q + 1) : r * (q + 1) + (xcd - r) * q) + off; }
        const int nig = WGM * nN, gid = wgid / nig, fm = gid * WGM, gsz = (nM - fm) < WGM ? (nM - fm) : WGM;
        u.pm = fm + ((wgid % nig) % gsz); u.pn = (wgid % nig) / gsz; return true;
    }
    __device__ __forceinline__ void a_ready(const Unit&) const {}
    __device__ __forceinline__ void done(const Unit&) const {}
};

__device__ __forceinline__ unsigned cvt_pk_bf16(float lo, float hi) { unsigned r; asm volatile("v_cvt_pk_bf16_f32 %0, %1, %2" : "=v"(r) : "v"(lo), "v"(hi)); return r; }
typedef unsigned u32x2 __attribute__((ext_vector_type(2)));
__device__ __forceinline__ int swap23(int t) { return (t & ~12) | ((t & 4) << 1) | ((t & 8) >> 1); }
struct EpiProj {
    static constexpr bool PERM = true, AFTER_DRAIN = false;
    bf16_t* P; bf16_t* Vt; const float* rope; bf16_t* UFP; float qscale;
    __device__ __forceinline__ void operator()(const f32x4 (&acc)[2][2][4][2], const Unit& u, int wr, int wc, int fr, int fq) const {
        const int row0 = u.pm * BM + wr * 64 + fr;
        const int pn = u.pn;
        const bool ctxrow = u.pm >= 128;
        f32x4 CS[2][4], SN[2][4];
        if (pn <= 2) {
#pragma unroll
            for (int ai = 0; ai < 2; ++ai)
#pragma unroll
                for (int m = 0; m < 4; ++m) {
                    CS[ai][m] = (f32x4){1.f, 1.f, 1.f, 1.f}; SN[ai][m] = (f32x4){0.f, 0.f, 0.f, 0.f};
                    if (!ctxrow) { const int t = (row0 + ai * HALF + m * 16) & 8191; const int pos = (wc & 1) ? (t & 63) : (t >> 6);
                        CS[ai][m] = *(const f32x4*)(rope + pos * 32 + 4 * fq); SN[ai][m] = *(const f32x4*)(rope + pos * 32 + 16 + 4 * fq); }
                }
            __builtin_amdgcn_sched_barrier(0);
        }
#pragma unroll
        for (int ai = 0; ai < 2; ++ai)
#pragma unroll
            for (int m = 0; m < 4; ++m) {
                const int row = row0 + ai * HALF + m * 16;
                bf16_t* rowp = P + (size_t)row * 2816 + pn * BM + wc * 32 + 8 * fq;
                if (pn == 5 && !ctxrow) { const int t = row & 8191; rowp = UFP + ((size_t)(((row >> 13) * 64 + (t & 63)) * 128 + (t >> 6))) * 256 + wc * 32 + 8 * fq; }
                if (pn > 2) {
#pragma unroll
                    for (int bj = 0; bj < 2; ++bj) { const f32x4 v0 = acc[ai][bj][m][0], v1 = acc[ai][bj][m][1];
                        u32x4 w; w.x = cvt_pk_bf16(v0[0], v0[1]); w.y = cvt_pk_bf16(v0[2], v0[3]); w.z = cvt_pk_bf16(v1[0], v1[1]); w.w = cvt_pk_bf16(v1[2], v1[3]);
                        *(u32x4*)(rowp + bj * HALF) = w; }
                } else {
                    const f32x4 cs = CS[ai][m], sn = SN[ai][m];
#pragma unroll
                    for (int bj = 0; bj < 2; ++bj) {
                        f32x4 v0 = acc[ai][bj][m][0], v1 = acc[ai][bj][m][1];
                        if (pn == 2 && bj == 1) {
                            u32x4 w; w.x = cvt_pk_bf16(v0[0], v0[1]); w.y = cvt_pk_bf16(v0[2], v0[3]); w.z = cvt_pk_bf16(v1[0], v1[1]); w.w = cvt_pk_bf16(v1[2], v1[3]);
                            *(u32x4*)(rowp + bj * HALF) = w;
                        } else {
                            const f32x4 r0 = v0 * cs - v1 * sn, r1 = v0 * sn + v1 * cs;
                            v0 = r0; v1 = r1;
                            if (pn < 2) { v0 = v0 * qscale; v1 = v1 * qscale; }
                            u32x4 w; w.x = cvt_pk_bf16(v0[0], v0[1]); w.y = cvt_pk_bf16(v0[2], v0[3]); w.z = cvt_pk_bf16(v1[0], v1[1]); w.w = cvt_pk_bf16(v1[2], v1[3]);
                            *(u32x4*)(rowp + bj * HALF) = w;
                        }
                    }
                }
            }
    }
};
struct EpiY {
    static constexpr bool PERM = true, AFTER_DRAIN = false;
    bf16_t* Y; float* ssq;
    __device__ __forceinline__ void operator()(const f32x4 (&acc)[2][2][4][2], const Unit& u, int wr, int wc, int fr, int fq) const {
        const int row0 = u.pm * BM + wr * 64 + fr;
#pragma unroll
        for (int ai = 0; ai < 2; ++ai)
#pragma unroll
            for (int m = 0; m < 4; ++m) {
                const int row = row0 + ai * HALF + m * 16;
                bf16_t* rowp = Y + (size_t)row * 1024 + u.pn * BM + wc * 32 + 8 * fq;
                float s = 0.f;
#pragma unroll
                for (int bj = 0; bj < 2; ++bj) { const f32x4 v0 = acc[ai][bj][m][0], v1 = acc[ai][bj][m][1];
                    s += (v0[0] * v0[0] + v0[1] * v0[1]) + (v0[2] * v0[2] + v0[3] * v0[3]) + (v1[0] * v1[0] + v1[1] * v1[1]) + (v1[2] * v1[2] + v1[3] * v1[3]);
                    u32x4 w; w.x = cvt_pk_bf16(v0[0], v0[1]); w.y = cvt_pk_bf16(v0[2], v0[3]); w.z = cvt_pk_bf16(v1[0], v1[1]); w.w = cvt_pk_bf16(v1[2], v1[3]);
                    *(u32x4*)(rowp + bj * HALF) = w; }
                s += __shfl_xor(s, 16); s += __shfl_xor(s, 32);
                if (fq == 0) ssq[(size_t)row * 16 + u.pn * 4 + wc] = s;
            }
    }
};
template <class Epi, class Sched, bool ALIGN_EPI = false, bool SP2 = false>
__device__ __forceinline__ void gemm_phase(PG8_LAS unsigned char* lds, const Gemm g, const Sched& S, const Epi& E) {
    int tid_ = threadIdx.x; asm volatile("" : "+v"(tid_));
    const int tid = tid_, wid = __builtin_amdgcn_readfirstlane(tid >> 6), lane = tid & 63, wr = wid >> 2, wc = wid & 3, fr = lane & 15, fq = lane >> 4;
    const int K = g.K, nt = K / BK;
    unsigned voffA[2], voffB[2];
#pragma unroll
    for (int i = 0; i < 2; ++i) { int R, C; stage_rc(tid * 16 + i * 8192, R, C); const int Rb = Epi::PERM ? ((R & ~31) + perm32(R & 31)) : R;
        voffA[i] = (unsigned)(R * K + C) * 2u; voffB[i] = (unsigned)(Rb * K + C) * 2u; }
    const size_t kstep = (size_t)(BK * 2);
    const size_t hstep = (size_t)HALF * K * 2;
    const size_t tstep = 2 * hstep;
    const unsigned ldsw = (unsigned)wid * 1024u;
    const int aoff = lds_byte(wr * 64 + fr, fq * 8), boff = lds_byte(wc * 32 + fr, fq * 8);
#define PG8_SA(b, h) (((b) * 2 + (h)) * HTB)
#define PG8_SB(b, h) ((4 + (b) * 2 + (h)) * HTB)
#define PG8_STAGE(bufoff, gbase, voff) do { _Pragma("unroll") for (int _i = 0; _i < 2; ++_i) \
        __builtin_amdgcn_global_load_lds((const unsigned*)((const char*)(gbase) + (voff)[_i]), (PG8_LAS unsigned*)(lds + (bufoff) + ldsw + _i * 8192), 16, 0, 0); } while (0)
#define PG8_LDA(dst, b, h) do { _Pragma("unroll") for (int m = 0; m < 4; ++m) _Pragma("unroll") for (int k = 0; k < 2; ++k) dst[m][k] = *(const PG8_LAS bf16x8*)(lds + PG8_SA(b, h) + aoff + m * 2048 + k * 1024); } while (0)
#define PG8_LDB(dst, b, h) do { _Pragma("unroll") for (int n = 0; n < 2; ++n) _Pragma("unroll") for (int k = 0; k < 2; ++k) dst[n][k] = *(const PG8_LAS bf16x8*)(lds + PG8_SB(b, h) + boff + n * 2048 + k * 1024); } while (0)
#define PG8_MMA(ai, bj, At, Bt) do { __builtin_amdgcn_s_setprio(1); _Pragma("unroll") for (int m = 0; m < 4; ++m) _Pragma("unroll") for (int n = 0; n < 2; ++n) _Pragma("unroll") for (int k = 0; k < 2; ++k) \
        acc[ai][bj][m][n] = __builtin_amdgcn_mfma_f32_16x16x32_bf16(Bt[n][k], At[m][k], acc[ai][bj][m][n], 0, 0, 0); __builtin_amdgcn_s_setprio(0); } while (0)
#define PG8_WAIT_V(n) asm volatile("s_waitcnt vmcnt(" #n ")" ::: "memory")
#define PG8_WAIT_L(n) asm volatile("s_waitcnt lgkmcnt(" #n ")" ::: "memory")
#define PG8_BAR __builtin_amdgcn_s_barrier()
#define PG8_SCHED __builtin_amdgcn_sched_barrier(0)
    Unit cur, nxt; int ui = 0;
    if (!S.next(0, cur)) return;
    f32x4 acc[2][2][4][2];
#pragma unroll
    for (int a = 0; a < 2; ++a)
#pragma unroll
        for (int b = 0; b < 2; ++b)
#pragma unroll
            for (int m = 0; m < 4; ++m)
#pragma unroll
                for (int n = 0; n < 2; ++n) acc[a][b][m][n] = (f32x4){0.f, 0.f, 0.f, 0.f};
    bf16x8 At[4][2], B0[2][2], B1[2][2];
    const char* cA = (const char*)g.A + (size_t)cur.pm * tstep; const char* cB = (const char*)g.Bt + (size_t)cur.pn * tstep;
    S.a_ready(cur);
    if constexpr (SP2) {
        PG8_STAGE(PG8_SB(0, 0), cB, voffB); PG8_STAGE(PG8_SB(0, 1), cB + hstep, voffB); PG8_STAGE(PG8_SA(0, 0), cA, voffA); PG8_STAGE(PG8_SA(0, 1), cA + hstep, voffA);
        if (wr == 1) PG8_BAR;
        PG8_WAIT_V(2); PG8_BAR;
        PG8_STAGE(PG8_SB(1, 0), cB + kstep, voffB); PG8_STAGE(PG8_SA(1, 0), cA + kstep, voffA); PG8_STAGE(PG8_SB(1, 1), cB + hstep + kstep, voffB);
        PG8_WAIT_V(6); PG8_BAR;
    } else {
        PG8_STAGE(PG8_SB(0, 0), cB, voffB); PG8_STAGE(PG8_SA(0, 0), cA, voffA); PG8_STAGE(PG8_SB(0, 1), cB + hstep, voffB); PG8_STAGE(PG8_SA(0, 1), cA + hstep, voffA);
        if (wr == 1) PG8_BAR;
        PG8_WAIT_V(4); PG8_BAR;
        PG8_STAGE(PG8_SB(1, 0), cB + kstep, voffB); PG8_STAGE(PG8_SA(1, 0), cA + kstep, voffA); PG8_STAGE(PG8_SB(1, 1), cB + hstep + kstep, voffB);
        PG8_WAIT_V(6); PG8_BAR;
    }
    for (;;) {
        const bool has_next = S.next(ui + 1, nxt);
        const char* nA = has_next ? (const char*)g.A + (size_t)nxt.pm * tstep : cA; const char* nB = has_next ? (const char*)g.Bt + (size_t)nxt.pn * tstep : cB;
        for (int t = 0; t < nt; t += 2) {
            const bool last = (t == nt - 2);
            const char* a1 = cA + (size_t)(t + 1) * kstep;
            const char* a2 = last ? nA : cA + (size_t)(t + 2) * kstep; const char* b2 = last ? nB : cB + (size_t)(t + 2) * kstep;
            const char* a3 = a2 + kstep; const char* b3 = b2 + kstep;
            if (last && has_next) S.a_ready(nxt);
            if constexpr (SP2) {
            PG8_LDB(B0, 0, 0); PG8_LDB(B1, 0, 1); PG8_SCHED; PG8_LDA(At, 0, 0); PG8_STAGE(PG8_SA(1, 1), a1 + hstep, voffA);
            PG8_WAIT_V(8); PG8_WAIT_L(0); PG8_BAR; PG8_MMA(0, 0, At, B0); PG8_MMA(0, 1, At, B1); PG8_BAR; PG8_SCHED;
            PG8_LDA(At, 0, 1); PG8_STAGE(PG8_SB(0, 0), b2, voffB); PG8_STAGE(PG8_SB(0, 1), b2 + hstep, voffB); PG8_STAGE(PG8_SA(0, 0), a2, voffA);
            PG8_WAIT_V(8); PG8_WAIT_L(0); PG8_BAR; PG8_MMA(1, 0, At, B0); PG8_MMA(1, 1, At, B1); PG8_BAR; PG8_SCHED;
            PG8_LDB(B0, 1, 0); PG8_LDB(B1, 1, 1); PG8_SCHED; PG8_LDA(At, 1, 0); PG8_STAGE(PG8_SA(0, 1), a2 + hstep, voffA);
            PG8_WAIT_V(8); PG8_WAIT_L(0); PG8_BAR; PG8_MMA(0, 0, At, B0); PG8_MMA(0, 1, At, B1); PG8_BAR; PG8_SCHED;
            PG8_LDA(At, 1, 1); PG8_STAGE(PG8_SB(1, 0), b3, voffB); PG8_STAGE(PG8_SB(1, 1), b3 + hstep, voffB); PG8_STAGE(PG8_SA(1, 0), a3, voffA);
            PG8_WAIT_V(8); PG8_WAIT_L(0); PG8_BAR; PG8_MMA(1, 0, At, B0); PG8_MMA(1, 1, At, B1); PG8_BAR; PG8_SCHED;
            } else {
            PG8_LDB(B0, 0, 0); PG8_SCHED; PG8_LDA(At, 0, 0); PG8_STAGE(PG8_SA(1, 1), a1 + hstep, voffA);
            PG8_WAIT_L(8); PG8_BAR; PG8_WAIT_L(0); PG8_MMA(0, 0, At, B0); PG8_BAR; PG8_SCHED;
            PG8_LDB(B1, 0, 1); PG8_STAGE(PG8_SB(0, 0), b2, voffB);
            PG8_BAR; PG8_WAIT_L(0); PG8_MMA(0, 1, At, B1); PG8_BAR;
            PG8_LDA(At, 0, 1); PG8_STAGE(PG8_SA(0, 0), a2, voffA);
            PG8_BAR; PG8_WAIT_L(0); PG8_MMA(1, 0, At, B0); PG8_BAR; PG8_SCHED;
            PG8_STAGE(PG8_SB(0, 1), b2 + hstep, voffB);
            PG8_WAIT_V(6); PG8_BAR; PG8_MMA(1, 1, At, B1); PG8_BAR;
            PG8_LDB(B0, 1, 0); PG8_SCHED; PG8_LDA(At, 1, 0); PG8_STAGE(PG8_SA(0, 1), a2 + hstep, voffA);
            PG8_WAIT_L(8); PG8_BAR; PG8_WAIT_L(0); PG8_MMA(0, 0, At, B0); PG8_BAR; PG8_SCHED;
            PG8_LDB(B1, 1, 1); PG8_STAGE(PG8_SB(1, 0), b3, voffB);
            PG8_BAR; PG8_WAIT_L(0); PG8_MMA(0, 1, At, B1); PG8_BAR;
            PG8_LDA(At, 1, 1); PG8_STAGE(PG8_SA(1, 0), a3, voffA);
            PG8_BAR; PG8_WAIT_L(0); PG8_MMA(1, 0, At, B0); PG8_BAR; PG8_SCHED;
            PG8_STAGE(PG8_SB(1, 1), b3 + hstep, voffB);
            PG8_WAIT_V(6); PG8_BAR; PG8_MMA(1, 1, At, B1); PG8_BAR;
            }
        }
        if constexpr (ALIGN_EPI) { if (wr == 0) PG8_BAR; }
        if constexpr (!Epi::AFTER_DRAIN) { E(acc, cur, wr, wc, fr, fq); S.done(cur); }
        if (!has_next) break;
#pragma unroll
        for (int a = 0; a < 2; ++a)
#pragma unroll
            for (int b = 0; b < 2; ++b)
#pragma unroll
                for (int m = 0; m < 4; ++m)
#pragma unroll
                    for (int n = 0; n < 2; ++n) acc[a][b][m][n] = (f32x4){0.f, 0.f, 0.f, 0.f};
        cur = nxt; cA = nA; cB = nB; ++ui;
        if constexpr (ALIGN_EPI) { if (wr == 1) PG8_BAR; }
    }
    PG8_WAIT_V(0);
    if constexpr (!ALIGN_EPI) { if (wr == 0) PG8_BAR; }
    PG8_BAR;
    if constexpr (Epi::AFTER_DRAIN) { E.fused(acc, cur, wr, wc, fr, fq, lds, wid, lane); S.done(cur); }
#undef PG8_SA
#undef PG8_SB
#undef PG8_STAGE
#undef PG8_LDA
#undef PG8_LDB
#undef PG8_MMA
#undef PG8_WAIT_V
#undef PG8_WAIT_L
#undef PG8_BAR
#undef PG8_SCHED
}
}

typedef unsigned short bf16_t;
typedef short bf16x8 __attribute__((ext_vector_type(8)));
typedef float f32x4 __attribute__((ext_vector_type(4)));
typedef float f32x16 __attribute__((ext_vector_type(16)));
typedef unsigned u32x4 __attribute__((ext_vector_type(4)));
typedef unsigned u32x2 __attribute__((ext_vector_type(2)));
#define LAS __attribute__((address_space(3)))
__device__ __forceinline__ int opaque_tid() { int t = threadIdx.x; asm volatile("" : "+v"(t)); return t; }

constexpr int DM = 1024, NBATCH = 4, SEQ = 8192, NTOK = NBATCH * SEQ, CTXL = 256, NCTX = NBATCH * CTXL, MROWS = NTOK + NCTX;
constexpr int PW = 2816;
constexpr int C_Q = 0, C_K = 512, C_V = 640, C_GA = 768, C_UF = 1280, C_GF = 1536, C_ZC = 1792, C_BC = 2048, C_CC = 2304, C_GC = 2560;
constexpr int VT_PITCH = SEQ + CTXL;
constexpr float NORM_EPS = 1e-6f;
constexpr float LOG2E = 1.4426950408889634f;

constexpr size_t KiB = 1024, MiB = 1u << 20;
constexpr size_t WS_CTL = 0;
constexpr size_t WS_BAR = 16 * KiB;
constexpr size_t WS_ZERO_BYTES = 32 * KiB;
constexpr size_t WS_MOD = 64 * KiB;
constexpr size_t WS_ROPE = 256 * KiB;
constexpr size_t WS_TW = 320 * KiB;
constexpr size_t WS_T1R = 384 * KiB, WS_T1I = 416 * KiB;
constexpr size_t WS_T3R = 448 * KiB, WS_T3I = 464 * KiB;
constexpr size_t WS_T256R = 512 * KiB, WS_T256I = 640 * KiB;
constexpr size_t WS_GT = 768 * KiB;
constexpr size_t WS_SSQ = 1 * MiB;
constexpr size_t WS_WIN = 4 * MiB;
constexpr size_t WS_WOUT = 16 * MiB;
constexpr size_t WS_SSQ1 = 24 * MiB;
constexpr size_t WS_MODP = 28 * MiB;
constexpr size_t WS_HX = 32 * MiB;
constexpr size_t WS_P = 112 * MiB;
constexpr size_t WS_VT = 304 * MiB;
constexpr size_t WS_H = 320 * MiB;
constexpr size_t WS_Y = 392 * MiB;
constexpr size_t WS_YF = 464 * MiB;
constexpr size_t WS_CTX1 = 100 * MiB;
constexpr size_t WS_UFP = 496 * MiB;
constexpr size_t WS_END = 512 * MiB;
static_assert(WS_BAR + 3456 * 4 <= WS_ZERO_BYTES && WS_MODP + (size_t)2 * 8 * 5 * 3072 * 4 <= WS_HX && WS_SSQ + (size_t)MROWS * 16 * 4 <= WS_WIN && WS_WIN + (size_t)2 * PW * DM * 2 <= WS_WOUT && WS_HX + (size_t)MROWS * DM * 2 <= WS_P && WS_P + (size_t)MROWS * PW * 2 <= WS_VT &&
              WS_VT + (size_t)8 * 64 * VT_PITCH * 2 <= WS_H && WS_H + (size_t)MROWS * DM * 2 <= WS_Y && WS_Y + (size_t)MROWS * DM * 2 <= WS_YF && WS_YF + (size_t)4 * 128 * 64 * 512 * 2 <= WS_UFP && WS_UFP + (size_t)NTOK * 256 * 2 <= WS_END && WS_HX + (size_t)MROWS * DM * 2 <= WS_CTX1 && WS_CTX1 + (size_t)NCTX * DM * 4 <= WS_P, "ws map");

constexpr int LDS_BYTES = 147456;
constexpr int LDS_SCHED = LDS_BYTES - 64;
constexpr int LDS_BARST = LDS_BYTES - 32;
constexpr int NTHREADS = 512;

__device__ __forceinline__ float bf2f(unsigned h) { return __uint_as_float(h << 16); }
__device__ __forceinline__ unsigned pkbf(float lo, float hi) { unsigned r; asm volatile("v_cvt_pk_bf16_f32 %0, %1, %2" : "=v"(r) : "v"(lo), "v"(hi)); return r; }
__device__ __forceinline__ float silu_f(float x) { return x * __builtin_amdgcn_rcpf(1.f + __builtin_amdgcn_exp2f(-x * LOG2E)); }
__device__ __forceinline__ float wave_sum(float v) {
#pragma unroll
    for (int o = 1; o < 64; o <<= 1) v += __shfl_xor(v, o);
    return v;
}
__device__ __forceinline__ int swap23(int t) { return (t & ~12) | ((t & 4) << 1) | ((t & 8) >> 1); }
__device__ __forceinline__ int crow(int r, int hi) { return (r & 3) + 8 * (r >> 2) + 4 * hi; }
__device__ __forceinline__ bf16x8 pack8(const f32x16& p, int base) {
    u32x4 w; w.x = pkbf(p[base + 0], p[base + 1]); w.y = pkbf(p[base + 2], p[base + 3]); w.z = pkbf(p[base + 4], p[base + 5]); w.w = pkbf(p[base + 6], p[base + 7]);
    return __builtin_bit_cast(bf16x8, w);
}
#define MFMA32(a, b, c) __builtin_amdgcn_mfma_f32_32x32x16_bf16((a), (b), (c), 0, 0, 0)

struct KArgs {
    const float *x, *c, *ctx, *c_ctx, *w_mod, *b_mod, *g_pre, *g_post, *w_in, *w_out, *sink, *w_f, *conv_w, *conv_b;
    float* out; unsigned char* ws; int ph_lo, ph_hi;
};

__device__ __forceinline__ int prow_qk(int n) { return (n & ~31) | (8 * ((n >> 2) & 3) + 4 * ((n >> 4) & 1) + (n & 3)); }
__device__ __forceinline__ void p0_transpose_item(const float* W, int K, int N, bf16_t* WT, int nperm, float* scr, int item, int lane) {
    const int nblk = N / 32, kb = item / nblk, nb = item % nblk, k0 = 64 * kb, n0 = 32 * nb;
    { float wv[32];
#pragma unroll
      for (int i = 0; i < 32; ++i) wv[i] = __builtin_nontemporal_load(W + (size_t)(k0 + 2 * i + (lane >> 5)) * N + n0 + (lane & 31));
      __builtin_amdgcn_sched_barrier(0);
#pragma unroll
      for (int i = 0; i < 32; ++i) scr[(2 * i + (lane >> 5)) * 33 + (lane & 31)] = wv[i];
      __builtin_amdgcn_sched_barrier(0); }
    asm volatile("s_waitcnt lgkmcnt(0)" ::: "memory");
    const int c = lane & 7;
#pragma unroll
    for (int j = 0; j < 4; ++j) { const int n = (lane >> 3) + 8 * j; const float* s = scr + (8 * c) * 33 + n;
        u32x4 o; o.x = pkbf(s[0 * 33], s[1 * 33]); o.y = pkbf(s[2 * 33], s[3 * 33]); o.z = pkbf(s[4 * 33], s[5 * 33]); o.w = pkbf(s[6 * 33], s[7 * 33]);
        const int nl = n0 + n; const int np = nl < nperm ? prow_qk(nl) : nl;
        *(u32x4*)(WT + (size_t)np * K + k0 + 8 * c) = o; }
    asm volatile("s_waitcnt lgkmcnt(0)" ::: "memory");
}

__device__ __forceinline__ void p0_mod_gemv(const KArgs& a, int item, float* ldsf) {
    const int tid = opaque_tid(), lane = tid & 63, wave = tid >> 6;
    const int l = item / 96, col0 = (item % 96) * 32;
    float* s = ldsf;
    float* red = ldsf + 5 * 1024;
    for (int i = tid; i < 5 * 1024; i += NTHREADS) { const int bb = i >> 10, k = i & 1023; const float v = bb < 4 ? a.c[bb * 1024 + k] : a.c_ctx[k]; s[i] = v / (1.f + __expf(-v)); }
    __syncthreads();
    const int col = lane & 31, kh = lane >> 5;
    const float* W = a.w_mod + (size_t)l * 1024 * 3072 + (size_t)(wave * 128 + kh) * 3072 + col0 + col;
    float w[64];
#pragma unroll
    for (int i = 0; i < 64; ++i) w[i] = __builtin_nontemporal_load(W + (size_t)(2 * i) * 3072);
    float acc[5] = {0.f, 0.f, 0.f, 0.f, 0.f};
#pragma unroll
    for (int i = 0; i < 64; ++i)
#pragma unroll
        for (int bb = 0; bb < 5; ++bb) acc[bb] += w[i] * s[bb * 1024 + wave * 128 + 2 * i + kh];
#pragma unroll
    for (int bb = 0; bb < 5; ++bb) red[((wave * 2 + kh) * 5 + bb) * 32 + col] = acc[bb];
    __syncthreads();
    if (tid < 160) { const int bb = tid >> 5, cc = tid & 31; float v = a.b_mod[l * 3072 + col0 + cc];
#pragma unroll
        for (int ww = 0; ww < 16; ++ww) v += red[(ww * 5 + bb) * 32 + cc];
        ((float*)(a.ws + WS_MOD))[(l * 5 + bb) * 3072 + col0 + cc] = v; }
    __syncthreads();
}

__device__ __forceinline__ void p0_transposes(const KArgs& a, unsigned char* lds, int l, int gwi, int ngw, int lane, int wave) {
    float* scr = (float*)(lds + wave * 16384);
    unsigned char* ws = a.ws;
    constexpr int I_IN = (DM / 64) * (PW / 32), I_OUT = (DM / 64) * (DM / 32);
    for (int r = gwi; r < I_IN + I_OUT; r += ngw) {
        if (r < I_IN) p0_transpose_item(a.w_in + (size_t)l * DM * PW, DM, PW, (bf16_t*)(ws + WS_WIN) + (size_t)l * PW * DM, 640, scr, r, lane);
        else p0_transpose_item(a.w_out + (size_t)l * DM * DM, DM, DM, (bf16_t*)(ws + WS_WOUT) + (size_t)l * DM * DM, 0, scr, r - I_IN, lane);
    }
}
__device__ __forceinline__ void p0_prologue(const KArgs& a, unsigned char* lds) {
    const int tid = opaque_tid(), lane = tid & 63, wave = tid >> 6;
    const int G = gridDim.x, bx = blockIdx.x;
    unsigned char* ws = a.ws;
    if (bx < 192) p0_mod_gemv(a, bx, (float*)lds);
    p0_transposes(a, lds, 0, bx * 8 + wave, G * 8, lane, wave);
    const int gt = bx * NTHREADS + tid, NGT = G * NTHREADS;
    for (int i = gt; i < 128 * 16; i += NGT) {
        const int pos = i >> 4, f = i & 15; const float inv = powf(10000.0f, -(float)f / 16.0f); const float ang = (float)pos * inv;
        float* rp = (float*)(ws + WS_ROPE) + pos * 32; rp[f] = cosf(ang); rp[16 + f] = sinf(ang);
    }
    for (int i = gt; i < 8192; i += NGT) { float sn, cs; sincospif((float)i * (2.0f / 8192.0f), &sn, &cs); float* t = (float*)(ws + WS_TW) + 2 * i; t[0] = cs; t[1] = sn; }
    for (int i = gt; i < 128 * 128; i += NGT) { const int k = i >> 7, n = i & 127; float sn, cs; sincospif((float)((k * n) & 127) * (2.0f / 128.0f), &sn, &cs);
        ((bf16_t*)(ws + WS_T1R))[i] = (bf16_t)(pkbf(cs, 0.f) & 0xffffu); ((bf16_t*)(ws + WS_T1I))[i] = (bf16_t)(pkbf(-sn, 0.f) & 0xffffu); }
    for (int i = gt; i < 64 * 128; i += NGT) { const int k = i >> 7, kk = i & 127, n = kk & 63; float sn, cs; sincospif((float)((k * n) & 63) * (2.0f / 64.0f), &sn, &cs);
        const float tr = kk < 64 ? cs : sn, ti = kk < 64 ? -sn : cs;
        const int fpos = ((((k >> 5) * 8 + (kk >> 4)) * 64 + ((k & 31) + 32 * ((kk >> 3) & 1))) * 8) + (kk & 7);
        ((bf16_t*)(ws + WS_T3R))[fpos] = (bf16_t)(pkbf(tr, 0.f) & 0xffffu); ((bf16_t*)(ws + WS_T3I))[fpos] = (bf16_t)(pkbf(ti, 0.f) & 0xffffu); }
    for (int i = gt; i < 256 * 256; i += NGT) { const int k = i >> 8, n = i & 255; float sn, cs; sincospif((float)((k * n) & 255) * (2.0f / 256.0f), &sn, &cs);
        ((bf16_t*)(ws + WS_T256R))[i] = (bf16_t)(pkbf(cs, 0.f) & 0xffffu); ((bf16_t*)(ws + WS_T256I))[i] = (bf16_t)(pkbf(-sn, 0.f) & 0xffffu); }
    {
        __syncthreads();
        float* trig = (float*)lds;
        if (tid < 64) { float sn, cs; sincospif((float)tid * (2.0f / 64.0f), &sn, &cs); trig[tid] = cs; trig[64 + tid] = sn; }
        __syncthreads();
        for (int i = gt; i < 2 * 4 * 64 * 128; i += NGT) {
            const int kk = i & 127, d = (i >> 7) & 63, g = (i >> 13) & 3, l = i >> 15; const int part = kk >> 6, c = swap23(kk & 63);
            const float* wf = a.w_f + ((size_t)(l * 4 + g) * 64) * 64 + d; float sacc = 0.f;
            float wfv[64];
#pragma unroll
            for (int j = 0; j < 64; ++j) wfv[j] = wf[j * 64];
            __builtin_amdgcn_sched_barrier(0);
#pragma unroll
            for (int j = 0; j < 64; ++j) sacc += trig[part * 64 + ((c * j) & 63)] * wfv[j];
            const int gpos = ((((((l * 4 + g) * 2 + (d >> 5)) * 8 + (kk >> 4)) * 64) + ((d & 31) + 32 * ((kk >> 3) & 1))) * 8) + (kk & 7);
            ((bf16_t*)(ws + WS_GT))[gpos] = (bf16_t)(pkbf(sacc * (1.0f / 724.0773439350246f), 0.f) & 0xffffu);
        }
        __syncthreads();
    }
}

__device__ __forceinline__ void norm_rows4(int mode, int lane, const float* src, float* dst, const bf16_t* y0, const float* ssq0, const bf16_t* y1, const float* ssq1, bf16_t* hx,
                                           const f32x4 (&GA0)[4], const f32x4 (&GA1)[4], const f32x4 (&GB)[4], const f32x4 (&GC)[4]) {
    f32x4 v[4][4];
#pragma unroll
    for (int rr = 0; rr < 4; ++rr)
#pragma unroll
        for (int j = 0; j < 4; ++j) v[rr][j] = __builtin_nontemporal_load((const f32x4*)(src + (size_t)rr * DM + 4 * lane + 256 * j));
    if (mode != 0) {
        u32x2 yw[4][4], yx[4][4]; float p[4], p1[4];
#pragma unroll
        for (int rr = 0; rr < 4; ++rr) { p[rr] = ssq0[rr * 16 + (lane & 15)];
#pragma unroll
            for (int j = 0; j < 4; ++j) yw[rr][j] = __builtin_nontemporal_load((const u32x2*)(y0 + (size_t)rr * DM + 4 * lane + 256 * j)); }
        if (mode == 2) {
#pragma unroll
            for (int rr = 0; rr < 4; ++rr) { p1[rr] = ssq1[rr * 16 + (lane & 15)];
#pragma unroll
                for (int j = 0; j < 4; ++j) yx[rr][j] = __builtin_nontemporal_load((const u32x2*)(y1 + (size_t)rr * DM + 4 * lane + 256 * j)); }
        }
#pragma unroll
        for (int rr = 0; rr < 4; ++rr) {
            float q = p[rr]; q += __shfl_xor(q, 1); q += __shfl_xor(q, 2); q += __shfl_xor(q, 4); q += __shfl_xor(q, 8);
            const float rstd = 1.0f / sqrtf(q * (1.0f / DM) + NORM_EPS);
#pragma unroll
            for (int j = 0; j < 4; ++j) {
                f32x4 yy; yy[0] = bf2f(yw[rr][j].x & 0xffffu); yy[1] = bf2f(yw[rr][j].x >> 16); yy[2] = bf2f(yw[rr][j].y & 0xffffu); yy[3] = bf2f(yw[rr][j].y >> 16);
                v[rr][j] = v[rr][j] + GA0[j] * (yy * rstd);
            }
        }
        if (mode == 2) {
#pragma unroll
            for (int rr = 0; rr < 4; ++rr) {
                float q = p1[rr]; q += __shfl_xor(q, 1); q += __shfl_xor(q, 2); q += __shfl_xor(q, 4); q += __shfl_xor(q, 8);
                const float rstd = 1.0f / sqrtf(q * (1.0f / DM) + NORM_EPS);
#pragma unroll
                for (int j = 0; j < 4; ++j) {
                    f32x4 yy; yy[0] = bf2f(yx[rr][j].x & 0xffffu); yy[1] = bf2f(yx[rr][j].x >> 16); yy[2] = bf2f(yx[rr][j].y & 0xffffu); yy[3] = bf2f(yx[rr][j].y >> 16);
                    v[rr][j] = v[rr][j] + GA1[j] * (yy * rstd);
                    __builtin_nontemporal_store(v[rr][j], (f32x4*)(dst + (size_t)rr * DM + 4 * lane + 256 * j));
                }
            }
        }
    }
    if (mode != 2) {
        float s[4];
#pragma unroll
        for (int rr = 0; rr < 4; ++rr) { float t = 0.f;
#pragma unroll
            for (int j = 0; j < 4; ++j) t += (v[rr][j][0] * v[rr][j][0] + v[rr][j][1] * v[rr][j][1]) + (v[rr][j][2] * v[rr][j][2] + v[rr][j][3] * v[rr][j][3]);
            s[rr] = t; }
#pragma unroll
        for (int o = 1; o < 64; o <<= 1) {
#pragma unroll
            for (int rr = 0; rr < 4; ++rr) s[rr] += __shfl_xor(s[rr], o); }
#pragma unroll
        for (int rr = 0; rr < 4; ++rr) {
            const float rstd = 1.0f / sqrtf(s[rr] * (1.0f / DM) + NORM_EPS);
#pragma unroll
            for (int j = 0; j < 4; ++j) {
                const f32x4 o = (v[rr][j] * rstd) * GB[j] + GC[j];
                u32x2 w; w.x = pkbf(o[0], o[1]); w.y = pkbf(o[2], o[3]);
                *(u32x2*)(hx + (size_t)rr * DM + 4 * lane + 256 * j) = w;
            }
        }
    }
}
__device__ __forceinline__ void norm_phase(const KArgs& a, int mode) {
    const int tid = opaque_tid(), lane = tid & 63, wave = tid >> 6;
    const int NGW = gridDim.x * 8;
    unsigned char* ws = a.ws;
    const float* mod = (const float*)(ws + WS_MOD);
    const int lp = (mode == 0) ? 0 : 1;
    bf16_t* HX = (bf16_t*)(ws + WS_HX); const bf16_t* Y0 = (const bf16_t*)(ws + WS_Y); const float* SSQ0 = (const float*)(ws + WS_SSQ);
    const bf16_t* Y1 = (const bf16_t*)(ws + WS_HX); const float* SSQ1 = (const float*)(ws + WS_SSQ1);
    const int gw2 = wave * (int)gridDim.x + (int)blockIdx.x;
    const int nlat = NTOK / 4;
    int curb = -1; f32x4 GA0[4], GA1[4], GB[4], GC[4];
    int base = gw2 * 4, sub = 0, itc = nlat + gw2; bool inctx = false;
    for (;;) {
        int it;
        if (!inctx) { if (base >= nlat) { inctx = true; continue; } it = base + sub; if (++sub == 4) { sub = 0; base += NGW * 4; } }
        else { if (mode == 2 || itc >= nlat + NCTX / 4) break; it = itc; itc += NGW; }
        const int r = it * 4;
        const int b = r < NTOK ? (r >> 13) : 4;
        if (b != curb) { curb = b;
            const float* mp = mod + (lp * 5 + b) * 3072; const float* m0 = mod + (0 * 5 + b) * 3072; const float* m1 = mod + (1 * 5 + b) * 3072;
#pragma unroll
            for (int j = 0; j < 4; ++j) { const int c = 4 * lane + 256 * j;
                GA0[j] = *(const f32x4*)(m0 + 2048 + c) * *(const f32x4*)(a.g_post + c);
                GA1[j] = *(const f32x4*)(m1 + 2048 + c) * *(const f32x4*)(a.g_post + DM + c);
                GB[j] = *(const f32x4*)(a.g_pre + lp * DM + c) * (*(const f32x4*)(mp + 1024 + c) + 1.0f);
                GC[j] = *(const f32x4*)(mp + c); } }
        const float* src = (r < NTOK) ? a.x + (size_t)r * DM : a.ctx + (size_t)(r - NTOK) * DM;
        norm_rows4(mode, lane, src, a.out + (size_t)r * DM, Y0 + (size_t)r * DM, SSQ0 + (size_t)r * 16, Y1 + (size_t)r * DM, SSQ1 + (size_t)r * 16, HX + (size_t)r * DM, GA0, GA1, GB, GC);
    }
}

typedef short v4i16_t __attribute__((ext_vector_type(4)));
__device__ __forceinline__ v4i16_t trrd(const unsigned char* p) { return __builtin_amdgcn_ds_read_tr16_b64_v4i16((LAS v4i16_t*)p); }
__device__ __forceinline__ bf16x8 cat8(v4i16_t lo, v4i16_t hi) { return (bf16x8){lo[0], lo[1], lo[2], lo[3], hi[0], hi[1], hi[2], hi[3]}; }
__device__ __forceinline__ void attn_unit(int u, const bf16_t* P, const bf16_t* Vt, bf16_t* H, const float* sink, unsigned char* lds) {
    const int tid = opaque_tid(), lane = tid & 63, wave = __builtin_amdgcn_readfirstlane(tid >> 6), r32 = lane & 31, hi = lane >> 5;
    const bool isctx = u >= 1024;
    int b, kvh, qb;
    if (isctx) { const int v = u - 1024; b = v >> 3; kvh = (v >> 2) & 1; qb = v & 3; } else { b = u >> 8; kvh = (u >> 7) & 1; qb = u & 127; }
    const int head = kvh * 4 + (wave >> 1);
    const int qtok = qb * 64 + (wave & 1) * 32 + r32;
    const size_t qrow = isctx ? (size_t)(NTOK + b * CTXL + qtok) : (size_t)(b * SEQ + qtok);
    const float sinkv = sink[head];
    unsigned char* qscr = lds + 45056 + wave * 4608;
    u32x4 qld[4];
#pragma unroll
    for (int i4 = 0; i4 < 4; ++i4) qld[i4] = __builtin_nontemporal_load((const u32x4*)(P + (qrow - r32 + i4 * 8 + (lane >> 3)) * PW + C_Q + head * 64 + (lane & 7) * 8));
    int jlo = 0, jhi = -1;
    if (!isctx) { jlo = qb < 2 ? 2 - qb : 0; jhi = (129 - qb) < 4 ? (129 - qb) : 4; }
    const int ntiles = 4 + (jhi - jlo + 1);
    const int srow = tid >> 3, sch = tid & 7;
    const bf16_t* Kc = P + (size_t)(NTOK + b * CTXL + srow) * PW + C_K + kvh * 64 + sch * 8;
    const bf16_t* Kl = P + (size_t)(b * SEQ + srow) * PW + C_K + kvh * 64 + sch * 8;
    unsigned char* Ks = lds; unsigned char* Vs = lds + 2 * 9216;
    const int vsoff = srow * 192 + sch * 16;
    const int soff = srow * 144 + sch * 16;
    u32x4 kreg, vreg, kreg2, vreg2;
#define ATT_GLOAD(KR, VR, ti_) do { const int t_ = (ti_); \
        if (t_ < 4) { KR = *(const u32x4*)(Kc + (size_t)(64 * t_) * PW); VR = *(const u32x4*)(Kc + (size_t)(64 * t_) * PW + 128); } \
        else { const int kbase_ = qb * 64 - 128 + 64 * (jlo + t_ - 4); KR = *(const u32x4*)(Kl + (size_t)kbase_ * PW); VR = *(const u32x4*)(Kl + (size_t)kbase_ * PW + 128); } } while (0)
    const size_t qrow0 = qrow - r32;
    u32x4 gaw[4];
#pragma unroll
    for (int i4 = 0; i4 < 4; ++i4) gaw[i4] = __builtin_nontemporal_load((const u32x4*)(P + (qrow0 + i4 * 8 + (lane >> 3)) * PW + C_GA + head * 64 + (lane & 7) * 8));
    ATT_GLOAD(kreg2, vreg2, 0);
    ATT_GLOAD(kreg, vreg, 1);
#pragma unroll
    for (int i4 = 0; i4 < 4; ++i4) *(u32x4*)(qscr + (i4 * 8 + (lane >> 3)) * 144 + (lane & 7) * 16) = qld[i4];
    *(u32x4*)(Ks + soff) = kreg2; *(u32x4*)(Vs + vsoff) = vreg2;
    __syncthreads();
    bf16x8 qf[4];
#pragma unroll
    for (int d0 = 0; d0 < 4; ++d0) qf[d0] = *(const bf16x8*)(qscr + r32 * 144 + (2 * d0 + hi) * 16);
    const float sink2 = sinkv * LOG2E;
    float mref = sink2, lsum = 0.f;
    f32x16 oT[2]; oT[0] = f32x16{}; oT[1] = f32x16{};
    const int qpos = qtok;
    for (int ti = 0; ti < ntiles; ++ti) {
        const int buf = ti & 1;
        if (ti + 2 < ntiles) ATT_GLOAD(kreg2, vreg2, ti + 2);
        const unsigned char* kb = Ks + buf * 9216 + r32 * 144 + hi * 16;
        const unsigned char* vb = Vs + buf * 12288 + (4 * hi + ((lane & 15) >> 2)) * 192 + (16 * ((lane >> 4) & 1) + 4 * (lane & 3)) * 2;
        bf16x8 kf[8];
#pragma unroll
        for (int d0 = 0; d0 < 4; ++d0) { kf[2 * d0] = *(const bf16x8*)(kb + d0 * 32); kf[2 * d0 + 1] = *(const bf16x8*)(kb + 32 * 144 + d0 * 32); }
        f32x16 p0, p1;
#pragma unroll
        for (int r = 0; r < 16; ++r) { p0[r] = -mref; p1[r] = -mref; }
        __builtin_amdgcn_sched_barrier(0);
#pragma unroll
        for (int d0 = 0; d0 < 4; ++d0) { p0 = MFMA32(kf[2 * d0], qf[d0], p0); p1 = MFMA32(kf[2 * d0 + 1], qf[d0], p1); }
        bf16x8 vf[8];
#pragma unroll
        for (int blk = 0; blk < 2; ++blk)
#pragma unroll
            for (int ks = 0; ks < 4; ++ks) vf[blk * 4 + ks] = cat8(trrd(vb + (16 * ks) * 192 + blk * 64), trrd(vb + (16 * ks + 8) * 192 + blk * 64));
        __builtin_amdgcn_sched_barrier(0);
        asm volatile("s_nop 15\n\ts_nop 7" : "+v"(p0), "+v"(p1));
        if (ti >= 4) {
            const int j = jlo + ti - 4; const int kbase = qb * 64 - 128 + 64 * j;
            if (j == 0) {
#pragma unroll
                for (int r = 0; r < 16; ++r) { const int kp = kbase + crow(r, hi); if (kp < qpos - 128) p0[r] = -INFINITY; if (kp + 32 < qpos - 128) p1[r] = -INFINITY; }
            } else if (j == 4) {
#pragma unroll
                for (int r = 0; r < 16; ++r) { const int kp = kbase + crow(r, hi); if (kp > qpos + 128) p0[r] = -INFINITY; if (kp + 32 > qpos + 128) p1[r] = -INFINITY; }
            }
        }
        float rma, rmb;
        asm("v_max3_f32 %0, %1, %2, %3" : "=v"(rma) : "v"(p0[0]), "v"(p0[1]), "v"(p1[0]));
        asm("v_max3_f32 %0, %1, %2, %3" : "=v"(rmb) : "v"(p0[2]), "v"(p0[3]), "v"(p1[1]));
        asm("v_max3_f32 %0, %1, %2, %3" : "=v"(rma) : "v"(rma), "v"(p1[2]), "v"(p1[3]));
#pragma unroll
        for (int r = 4; r < 16; r += 4) {
            asm("v_max3_f32 %0, %1, %2, %3" : "=v"(rma) : "v"(rma), "v"(p0[r]), "v"(p0[r + 1]));
            asm("v_max3_f32 %0, %1, %2, %3" : "=v"(rmb) : "v"(rmb), "v"(p0[r + 2]), "v"(p0[r + 3]));
            asm("v_max3_f32 %0, %1, %2, %3" : "=v"(rma) : "v"(rma), "v"(p1[r]), "v"(p1[r + 1]));
            asm("v_max3_f32 %0, %1, %2, %3" : "=v"(rmb) : "v"(rmb), "v"(p1[r + 2]), "v"(p1[r + 3]));
        }
        float rm; asm("v_max3_f32 %0, %1, %2, %3" : "=v"(rm) : "v"(rma), "v"(rmb), "v"(rmb));
        { const float rmo = __shfl_xor(rm, 32); asm("v_max3_f32 %0, %1, %2, %3" : "=v"(rm) : "v"(rm), "v"(rmo), "v"(rmo)); }
        if (__any(rm > 8.0f)) {
            const float dl = fmaxf(rm, 0.f);
            mref += dl;
            const float f = __builtin_amdgcn_exp2f(-dl);
            lsum *= f;
#pragma unroll
            for (int r = 0; r < 16; ++r) { p0[r] -= dl; p1[r] -= dl; oT[0][r] *= f; oT[1][r] *= f; }
        }
        float ls = 0.f;
#pragma unroll
        for (int r = 0; r < 16; ++r) { p0[r] = __builtin_amdgcn_exp2f(p0[r]); p1[r] = __builtin_amdgcn_exp2f(p1[r]); ls += p0[r] + p1[r]; }
        lsum += ls;
        bf16x8 pf[4]; pf[0] = pack8(p0, 0); pf[1] = pack8(p0, 8); pf[2] = pack8(p1, 0); pf[3] = pack8(p1, 8);
#pragma unroll
        for (int blk = 0; blk < 2; ++blk)
#pragma unroll
            for (int ks = 0; ks < 4; ++ks) oT[blk] = MFMA32(vf[blk * 4 + ks], pf[ks], oT[blk]);
        if (ti + 1 < ntiles) { *(u32x4*)(Ks + (buf ^ 1) * 9216 + soff) = kreg; *(u32x4*)(Vs + (buf ^ 1) * 12288 + vsoff) = vreg; }
        kreg = kreg2; vreg = vreg2;
        __syncthreads();
    }
    lsum += __shfl_xor(lsum, 32);
    lsum += __builtin_amdgcn_exp2f(sink2 - mref);
    const float inv = 1.0f / lsum;
    unsigned char* ow = qscr;
#pragma unroll
    for (int blk = 0; blk < 2; ++blk)
#pragma unroll
        for (int g4 = 0; g4 < 4; ++g4) {
            u32x2 w; w.x = pkbf(oT[blk][4 * g4 + 0] * inv, oT[blk][4 * g4 + 1] * inv); w.y = pkbf(oT[blk][4 * g4 + 2] * inv, oT[blk][4 * g4 + 3] * inv);
            *(u32x2*)(ow + r32 * 144 + (32 * blk + 8 * g4 + 4 * hi) * 2) = w;
        }
    asm volatile("s_waitcnt lgkmcnt(0)" ::: "memory");
#pragma unroll
    for (int i4 = 0; i4 < 4; ++i4) {
        const int rr = i4 * 8 + (lane >> 3), ch = lane & 7;
        const u32x4 ov = *(const u32x4*)(ow + rr * 144 + ch * 16);
        const unsigned ovv[4] = {ov.x, ov.y, ov.z, ov.w}, gvv[4] = {gaw[i4].x, gaw[i4].y, gaw[i4].z, gaw[i4].w};
        u32x4 w;
        unsigned wv[4];
#pragma unroll
        for (int e = 0; e < 4; ++e) wv[e] = pkbf(bf2f(ovv[e] & 0xffffu) * silu_f(bf2f(gvv[e] & 0xffffu)), bf2f(ovv[e] >> 16) * silu_f(bf2f(gvv[e] >> 16)));
        w.x = wv[0]; w.y = wv[1]; w.z = wv[2]; w.w = wv[3];
        *(u32x4*)(H + (qrow0 + rr) * DM + head * 64 + ch * 8) = w;
    }
    asm volatile("s_waitcnt lgkmcnt(0)" ::: "memory");
}

__device__ __forceinline__ void fft1_unit(int u, const bf16_t* P, bf16_t* YF, const unsigned char* ws, unsigned char* lds) {
    const int tid = opaque_tid(), lane = tid & 63, wave = __builtin_amdgcn_readfirstlane(tid >> 6), r32 = lane & 31, hi = lane >> 5;
    const int b = u >> 6, n2 = u & 63;
    constexpr int UPB = 576;
    const bf16_t* src = P + (size_t)(b * SEQ + n2) * PW + C_UF;
#pragma unroll
    for (int i = 0; i < 8; ++i) {
        const int id = tid + NTHREADS * i, n1 = id >> 5, cc = id & 31;
        *(u32x4*)(lds + n1 * UPB + cc * 16) = *(const u32x4*)(src + (size_t)n1 * 64 * PW + cc * 8);
    }
    __syncthreads();
    const bf16_t* T1R = (const bf16_t*)(ws + WS_T1R); const bf16_t* T1I = (const bf16_t*)(ws + WS_T1I);
    f32x16 aR[4], aI[4];
#pragma unroll
    for (int kb = 0; kb < 4; ++kb) { aR[kb] = f32x16{}; aI[kb] = f32x16{}; }
    const unsigned char* ap = lds + (8 * hi + ((lane & 15) >> 2)) * UPB + (32 * wave + 16 * ((lane >> 4) & 1) + 4 * (lane & 3)) * 2;
#pragma unroll 2
    for (int ks = 0; ks < 8; ++ks) {
        const bf16x8 av = cat8(trrd(ap + (16 * ks) * UPB), trrd(ap + (16 * ks + 4) * UPB));
#pragma unroll
        for (int kb = 0; kb < 4; ++kb) {
            const bf16x8 bR = *(const bf16x8*)(T1R + (32 * kb + r32) * 128 + 16 * ks + 8 * hi), bI = *(const bf16x8*)(T1I + (32 * kb + r32) * 128 + 16 * ks + 8 * hi);
            aR[kb] = MFMA32(av, bR, aR[kb]); aI[kb] = MFMA32(av, bI, aI[kb]);
        }
    }
    const float* TW = (const float*)(ws + WS_TW);
#pragma unroll
    for (int kb = 0; kb < 4; ++kb) {
        const int k1 = 32 * kb + r32;
        const float ct = TW[2 * (n2 * k1)], st = TW[2 * (n2 * k1) + 1];
        bf16_t* yp = YF + ((size_t)((b * 128 + k1) * 64 + n2)) * 512 + 32 * wave + 4 * hi;
#pragma unroll
        for (int g4 = 0; g4 < 4; ++g4) {
            float yr[4], yi[4];
#pragma unroll
            for (int e = 0; e < 4; ++e) { const float r_ = aR[kb][4 * g4 + e], i_ = aI[kb][4 * g4 + e]; yr[e] = r_ * ct + i_ * st; yi[e] = i_ * ct - r_ * st; }
            u32x2 wr_, wi_; wr_.x = pkbf(yr[0], yr[1]); wr_.y = pkbf(yr[2], yr[3]); wi_.x = pkbf(yi[0], yi[1]); wi_.y = pkbf(yi[2], yi[3]);
            *(u32x2*)(yp + 8 * g4) = wr_; *(u32x2*)(yp + 256 + 8 * g4) = wi_;
        }
    }
    __syncthreads();
}

template <int KK>
__device__ __forceinline__ void dftf_unit(const bf16_t* srcbase, int R, int pitchA, int pitchB, const bf16_t* Tr, const bf16_t* Ti, const bf16_t* Gt,
                                          const bf16_t* P, bf16_t* H, size_t row0, int rowstride, float oscale, unsigned char* lds) {
    const int tid = opaque_tid(), lane = tid & 63, wave = __builtin_amdgcn_readfirstlane(tid >> 6), r32 = lane & 31, hi = lane >> 5;
    constexpr int ZPB = (KK == 128) ? 576 : 544;
#pragma unroll 1
    for (int i0 = 0; i0 < KK / 16; i0 += 8) {
        u32x4 img[8];
#pragma unroll
        for (int i = 0; i < 8; ++i) { const int id = tid + NTHREADS * (i0 + i), kk = id >> 5, cc = id & 31; img[i] = *(const u32x4*)(srcbase + (size_t)(kk % R) * pitchA + (size_t)(kk / R) * pitchB + cc * 8); }
        __builtin_amdgcn_sched_barrier(0);
#pragma unroll
        for (int i = 0; i < 8; ++i) { const int id = tid + NTHREADS * (i0 + i), kk = id >> 5, cc = id & 31; *(u32x4*)(lds + kk * ZPB + cc * 16) = img[i]; }
        __builtin_amdgcn_sched_barrier(0);
    }
    __syncthreads();
    const int g = wave >> 1, kblk = wave & 1;
    f32x16 XR[2], XI[2];
#pragma unroll
    for (int cb = 0; cb < 2; ++cb) { XR[cb] = f32x16{}; XI[cb] = f32x16{}; }
    const bf16_t* trp = Tr + (size_t)(32 * kblk + r32) * KK + 8 * hi; const bf16_t* tip = Ti + (size_t)(32 * kblk + r32) * KK + 8 * hi;
    const unsigned char* zp = lds + (8 * hi + ((lane & 15) >> 2)) * ZPB + (64 * g + 16 * ((lane >> 4) & 1) + 4 * (lane & 3)) * 2;
#pragma unroll 2
    for (int ks = 0; ks < KK / 16; ++ks) {
        const bf16x8 bR = *(const bf16x8*)(trp + 16 * ks), bI = *(const bf16x8*)(tip + 16 * ks);
#pragma unroll
        for (int cb = 0; cb < 2; ++cb) { const bf16x8 av = cat8(trrd(zp + (16 * ks) * ZPB + cb * 64), trrd(zp + (16 * ks + 4) * ZPB + cb * 64)); XR[cb] = MFMA32(av, bR, XR[cb]); XI[cb] = MFMA32(av, bI, XI[cb]); }
    }
    f32x16 oa[2]; oa[0] = f32x16{}; oa[1] = f32x16{};
    const bf16_t* gp = Gt + (size_t)(g * 2 * 8 * 64 + lane) * 8;
    u32x2 gfw[8];
    { const size_t rowg = row0 + (size_t)(32 * kblk + r32) * rowstride;
#pragma unroll
      for (int i8 = 0; i8 < 8; ++i8) gfw[i8] = *(const u32x2*)(P + rowg * PW + C_GF + 64 * g + 32 * (i8 >> 2) + 8 * (i8 & 3) + 4 * hi); }
#pragma unroll
    for (int part = 0; part < 2; ++part)
#pragma unroll
        for (int cb = 0; cb < 2; ++cb)
#pragma unroll
            for (int s = 0; s < 2; ++s) {
                const bf16x8 bx = pack8(part ? XI[cb] : XR[cb], 8 * s);
                const int kko = part * 64 + 32 * cb + 16 * s;
#pragma unroll
                for (int lb = 0; lb < 2; ++lb) { const bf16x8 ag = *(const bf16x8*)(gp + (size_t)((lb * 8 + (kko >> 4)) * 64) * 8); oa[lb] = MFMA32(ag, bx, oa[lb]); }
            }
    const int k2 = 32 * kblk + r32;
    const size_t row = row0 + (size_t)k2 * rowstride;
    const bf16_t* gfrow = P + row * PW + C_GF + 64 * g;
    bf16_t* hrow = H + row * DM + 512 + 64 * g;
#pragma unroll
    for (int lb = 0; lb < 2; ++lb)
#pragma unroll
        for (int g4 = 0; g4 < 4; ++g4) {
            const int l0 = 32 * lb + 8 * g4 + 4 * hi;
            const u32x2 gw = gfw[lb * 4 + g4];
            const float o0 = oa[lb][4 * g4 + 0] * oscale * silu_f(bf2f(gw.x & 0xffffu)), o1 = oa[lb][4 * g4 + 1] * oscale * silu_f(bf2f(gw.x >> 16));
            const float o2 = oa[lb][4 * g4 + 2] * oscale * silu_f(bf2f(gw.y & 0xffffu)), o3 = oa[lb][4 * g4 + 3] * oscale * silu_f(bf2f(gw.y >> 16));
            u32x2 w; w.x = pkbf(o0, o1); w.y = pkbf(o2, o3);
            *(u32x2*)(hrow + l0) = w;
        }
    __syncthreads();
}

__device__ __forceinline__ void conv_unit(int u, const bf16_t* P, bf16_t* H, const float* cw, const float* cb) {
    const int tid = opaque_tid(), cgp = tid & 31, rg = tid >> 5;
    const int ch0 = cgp * 8;
    const int r0 = u * 64 + rg * 4;
    int pos, len; if (r0 < NTOK) { pos = r0 & (SEQ - 1); len = SEQ; } else { pos = (r0 - NTOK) & (CTXL - 1); len = CTXL; }
    float w0[8], w1[8], w2[8], bs[8];
#pragma unroll
    for (int e = 0; e < 8; ++e) { w0[e] = cw[ch0 + e]; w1[e] = cw[256 + ch0 + e]; w2[e] = cw[512 + ch0 + e]; bs[e] = cb[ch0 + e]; }
    float T[6][8];
#pragma unroll
    for (int i = 0; i < 6; ++i) {
        const int p = pos - 1 + i;
        if (p >= 0 && p < len) {
            const size_t row = (size_t)(r0 - 1 + i);
            const u32x4 z = *(const u32x4*)(P + row * PW + C_ZC + ch0), c = *(const u32x4*)(P + row * PW + C_CC + ch0);
            T[i][0] = bf2f(z.x & 0xffffu) * bf2f(c.x & 0xffffu); T[i][1] = bf2f(z.x >> 16) * bf2f(c.x >> 16);
            T[i][2] = bf2f(z.y & 0xffffu) * bf2f(c.y & 0xffffu); T[i][3] = bf2f(z.y >> 16) * bf2f(c.y >> 16);
            T[i][4] = bf2f(z.z & 0xffffu) * bf2f(c.z & 0xffffu); T[i][5] = bf2f(z.z >> 16) * bf2f(c.z >> 16);
            T[i][6] = bf2f(z.w & 0xffffu) * bf2f(c.w & 0xffffu); T[i][7] = bf2f(z.w >> 16) * bf2f(c.w >> 16);
        } else {
#pragma unroll
            for (int e = 0; e < 8; ++e) T[i][e] = 0.f;
        }
    }
#pragma unroll
    for (int i = 0; i < 4; ++i) {
        const size_t row = (size_t)(r0 + i);
        const u32x4 bw = *(const u32x4*)(P + row * PW + C_BC + ch0), gw = *(const u32x4*)(P + row * PW + C_GC + ch0);
        const unsigned bwv[4] = {bw.x, bw.y, bw.z, bw.w}, gwv[4] = {gw.x, gw.y, gw.z, gw.w};
        float o[8];
#pragma unroll
        for (int e = 0; e < 8; ++e) {
            const float bv = (e & 1) ? bf2f(bwv[e >> 1] >> 16) : bf2f(bwv[e >> 1] & 0xffffu);
            const float gv = (e & 1) ? bf2f(gwv[e >> 1] >> 16) : bf2f(gwv[e >> 1] & 0xffffu);
            const float y = T[i][e] * w0[e] + T[i + 1][e] * w1[e] + T[i + 2][e] * w2[e] + bs[e];
            o[e] = bv * y * silu_f(gv);
        }
        u32x4 w; w.x = pkbf(o[0], o[1]); w.y = pkbf(o[2], o[3]); w.z = pkbf(o[4], o[5]); w.w = pkbf(o[6], o[7]);
        *(u32x4*)(H + row * DM + 768 + ch0) = w;
    }
}

__device__ __forceinline__ void fft1_tables(const unsigned char* ws, unsigned char* tbl, int tid) {
    u32x4 tv[8];
#pragma unroll
    for (int i = 0; i < 8; ++i) { const int id = tid + NTHREADS * i, t = id >> 11, row = (id >> 4) & 127, ch = id & 15; tv[i] = *(const u32x4*)(ws + (t ? WS_T1I : WS_T1R) + row * 256 + ch * 16); }
    __builtin_amdgcn_sched_barrier(0);
#pragma unroll
    for (int i = 0; i < 8; ++i) { const int id = tid + NTHREADS * i, t = id >> 11, row = (id >> 4) & 127, ch = id & 15; *(u32x4*)(tbl + t * 34816 + row * 272 + ch * 16) = tv[i]; }
}
__device__ __forceinline__ void fft1_wave(int task, const bf16_t* P, bf16_t* YF, const unsigned char* ws, unsigned char* lds_w, const unsigned char* tbl, int lane, int pmode = 0) {
    const int r32 = lane & 31, hi = lane >> 5;
    const int cblk = task & 7, n2 = (task >> 3) & 63, b = task >> 9;
    const bf16_t* src = P + (size_t)((b * 64 + n2) * 128) * 256 + 32 * cblk + 8 * (lane & 3);
    { u32x4 img[8];
#pragma unroll
      for (int i = 0; i < 8; ++i) img[i] = __builtin_nontemporal_load((const u32x4*)(src + (size_t)(16 * i + (lane >> 2)) * 256));
      __builtin_amdgcn_sched_barrier(0);
#pragma unroll
      for (int i = 0; i < 8; ++i) *(u32x4*)(lds_w + (16 * i + (lane >> 2)) * 64 + (lane & 3) * 16) = img[i];
      __builtin_amdgcn_sched_barrier(0); }
    asm volatile("s_waitcnt vmcnt(0) lgkmcnt(0)" ::: "memory");
    if (pmode == 2) return;
    const bf16_t* T1R = (const bf16_t*)(ws + WS_T1R); const bf16_t* T1I = (const bf16_t*)(ws + WS_T1I);
    f32x16 aR[4], aI[4];
#pragma unroll
    for (int kb = 0; kb < 4; ++kb) { aR[kb] = f32x16{}; aI[kb] = f32x16{}; }
    const unsigned char* ap = lds_w + (8 * hi + ((lane & 15) >> 2)) * 64 + (16 * ((lane >> 4) & 1) + 4 * (lane & 3)) * 2;
    const unsigned char* tb = tbl + r32 * 272 + hi * 16;
#pragma unroll 2
    for (int ks = 0; ks < 8; ++ks) {
        const bf16x8 av = cat8(trrd(ap + (16 * ks) * 64), trrd(ap + (16 * ks + 4) * 64));
        bf16x8 bq[8];
#pragma unroll
        for (int kb = 0; kb < 4; ++kb) { bq[2 * kb] = *(const bf16x8*)(tb + (32 * kb) * 272 + 32 * ks); bq[2 * kb + 1] = *(const bf16x8*)(tb + 34816 + (32 * kb) * 272 + 32 * ks); }
#pragma unroll
        for (int kb = 0; kb < 4; ++kb) { aR[kb] = MFMA32(av, bq[2 * kb], aR[kb]); aI[kb] = MFMA32(av, bq[2 * kb + 1], aI[kb]); }
    }
    const float* TW = (const float*)(ws + WS_TW);
    float ctw[4], stw[4];
#pragma unroll
    for (int kb = 0; kb < 4; ++kb) { const int k1 = 32 * kb + r32; ctw[kb] = TW[2 * (n2 * k1)]; stw[kb] = TW[2 * (n2 * k1) + 1]; }
    asm volatile("s_waitcnt lgkmcnt(0)" ::: "memory");
#pragma unroll
    for (int pr = 0; pr < 2; ++pr) {
#pragma unroll
        for (int kq = 0; kq < 2; ++kq) {
            const int kb = 2 * pr + kq; const int rowl = 32 * kq + r32; const float ct = ctw[kb], st = stw[kb];
#pragma unroll
            for (int g4 = 0; g4 < 4; ++g4) {
                float yr[4], yi[4];
#pragma unroll
                for (int e = 0; e < 4; ++e) { const float r_ = aR[kb][4 * g4 + e], i_ = aI[kb][4 * g4 + e]; yr[e] = r_ * ct + i_ * st; yi[e] = i_ * ct - r_ * st; }
                u32x2 wr_, wi_; wr_.x = pkbf(yr[0], yr[1]); wr_.y = pkbf(yr[2], yr[3]); wi_.x = pkbf(yi[0], yi[1]); wi_.y = pkbf(yi[2], yi[3]);
                *(u32x2*)(lds_w + rowl * 128 + ((g4 ^ (rowl & 7)) * 16) + hi * 8) = wr_;
                *(u32x2*)(lds_w + rowl * 128 + (((4 + g4) ^ (rowl & 7)) * 16) + hi * 8) = wi_;
            }
        }
        asm volatile("s_waitcnt lgkmcnt(0)" ::: "memory");
#pragma unroll
        for (int i8 = 0; i8 < 8; ++i8) {
            const int rowl = i8 * 8 + (lane >> 3), ch = lane & 7;
            const u32x4 v = *(const u32x4*)(lds_w + rowl * 128 + ((ch ^ (rowl & 7)) * 16));
            const int k1 = 64 * pr + rowl;
            bf16_t* dst = YF + ((size_t)((b * 128 + k1) * 64 + n2)) * 512 + (ch >> 2) * 256 + 32 * cblk + 8 * (ch & 3);
            *(u32x4*)dst = v;
        }
        asm volatile("s_waitcnt lgkmcnt(0)" ::: "memory");
    }
}
__device__ __forceinline__ void fft3_wave(int task, const bf16_t* YF, const bf16_t* Gt, const bf16_t* P, bf16_t* H, const unsigned char* ws, unsigned char* lds_w, int lane) {
    const int r32 = lane & 31, hi = lane >> 5;
    const int g = task & 3, k1 = (task >> 2) & 127, b = task >> 9;
    const bf16_t* src = YF + ((size_t)(b * 128 + k1) * 64) * 512 + 64 * g + 8 * (lane & 7);
    { u32x4 img[16];
#pragma unroll
      for (int i = 0; i < 16; ++i) { const int kk = 8 * i + (lane >> 3); img[i] = __builtin_nontemporal_load((const u32x4*)(src + (size_t)(kk & 63) * 512 + (size_t)(kk >> 6) * 256)); }
      __builtin_amdgcn_sched_barrier(0);
#pragma unroll
      for (int i = 0; i < 16; ++i) { const int kk = 8 * i + (lane >> 3), ch = lane & 7; *(u32x4*)(lds_w + kk * 128 + ((ch ^ (((kk >> 1) & 1) << 2)) * 16)) = img[i]; }
      __builtin_amdgcn_sched_barrier(0); }
    asm volatile("s_waitcnt vmcnt(0) lgkmcnt(0)" ::: "memory");
    const bf16_t* T3R = (const bf16_t*)(ws + WS_T3R); const bf16_t* T3I = (const bf16_t*)(ws + WS_T3I);
    const int q = (lane & 15) >> 2, sw = (q >> 1) & 1;
    const int chl = 2 * ((lane >> 4) & 1) + ((lane & 3) >> 1);
    const unsigned char* zb = lds_w + (8 * hi + q) * 128 + 8 * (lane & 1);
    const unsigned char* zp0 = zb + ((chl ^ (sw << 2)) * 16);
    const unsigned char* zp1 = zb + (((4 + chl) ^ (sw << 2)) * 16);
    const bf16_t* gp = Gt + (size_t)(g * 2 * 8 * 64 + lane) * 8;
    const size_t rowb = (size_t)(b * SEQ + k1);
    u32x2 hwA[8], hwB[8];
#pragma unroll
    for (int i8 = 0; i8 < 8; ++i8) { hwA[i8] = (u32x2){0u, 0u}; hwB[i8] = (u32x2){0u, 0u}; }
#pragma unroll 1
    for (int kblk = 0; kblk < 2; ++kblk) {
        f32x16 XR[2], XI[2];
#pragma unroll
        for (int cb = 0; cb < 2; ++cb) { XR[cb] = f32x16{}; XI[cb] = f32x16{}; }
        const bf16_t* trp = T3R + (size_t)(kblk * 8 * 64 + lane) * 8; const bf16_t* tip = T3I + (size_t)(kblk * 8 * 64 + lane) * 8;
        const size_t rowg = rowb + (size_t)(32 * kblk + r32) * 128;
        u32x2 gfw[8];
#pragma unroll
        for (int i8 = 0; i8 < 8; ++i8) gfw[i8] = *(const u32x2*)(P + rowg * PW + C_GF + 64 * g + 32 * (i8 >> 2) + 8 * (i8 & 3) + 4 * hi);
        bf16x8 bR[8], bI[8];
#pragma unroll
        for (int ks = 0; ks < 8; ++ks) { bR[ks] = *(const bf16x8*)(trp + 512 * ks); bI[ks] = *(const bf16x8*)(tip + 512 * ks); }
        __builtin_amdgcn_sched_barrier(0);
#pragma unroll
        for (int ks = 0; ks < 8; ++ks) {
            const bf16x8 a0 = cat8(trrd(zp0 + (16 * ks) * 128), trrd(zp0 + (16 * ks + 4) * 128));
            const bf16x8 a1 = cat8(trrd(zp1 + (16 * ks) * 128), trrd(zp1 + (16 * ks + 4) * 128));
            XR[0] = MFMA32(a0, bR[ks], XR[0]); XI[0] = MFMA32(a0, bI[ks], XI[0]); XR[1] = MFMA32(a1, bR[ks], XR[1]); XI[1] = MFMA32(a1, bI[ks], XI[1]);
        }
        __builtin_amdgcn_sched_barrier(0);
        bf16x8 gfr[2][8];
#pragma unroll
        for (int lb = 0; lb < 2; ++lb)
#pragma unroll
            for (int q8 = 0; q8 < 8; ++q8) gfr[lb][q8] = *(const bf16x8*)(gp + (size_t)((lb * 8 + q8) * 64) * 8);
        __builtin_amdgcn_sched_barrier(0);
        f32x16 oa[2]; oa[0] = f32x16{}; oa[1] = f32x16{};
#pragma unroll
        for (int part = 0; part < 2; ++part)
#pragma unroll
            for (int cb = 0; cb < 2; ++cb)
#pragma unroll
                for (int s = 0; s < 2; ++s) {
                    const bf16x8 bx = pack8(part ? XI[cb] : XR[cb], 8 * s);
                    const int kko = part * 64 + 32 * cb + 16 * s;
#pragma unroll
                    for (int lb = 0; lb < 2; ++lb) oa[lb] = MFMA32(gfr[lb][kko >> 4], bx, oa[lb]);
                }
#pragma unroll
        for (int lb = 0; lb < 2; ++lb)
#pragma unroll
            for (int g4 = 0; g4 < 4; ++g4) {
                const u32x2 gw = gfw[lb * 4 + g4];
                const float o0 = oa[lb][4 * g4 + 0] * silu_f(bf2f(gw.x & 0xffffu)), o1 = oa[lb][4 * g4 + 1] * silu_f(bf2f(gw.x >> 16));
                const float o2 = oa[lb][4 * g4 + 2] * silu_f(bf2f(gw.y & 0xffffu)), o3 = oa[lb][4 * g4 + 3] * silu_f(bf2f(gw.y >> 16));
                u32x2 pk; pk.x = pkbf(o0, o1); pk.y = pkbf(o2, o3);
                if (kblk == 0) hwA[lb * 4 + g4] = pk; else hwB[lb * 4 + g4] = pk;
            }
    }
    asm volatile("s_waitcnt lgkmcnt(0)" ::: "memory");
#pragma unroll
    for (int kblk = 0; kblk < 2; ++kblk)
#pragma unroll
        for (int lb = 0; lb < 2; ++lb)
#pragma unroll
            for (int g4 = 0; g4 < 4; ++g4) { const int rowl = 32 * kblk + r32;
                *(u32x2*)(lds_w + rowl * 128 + (((4 * lb + g4) ^ (rowl & 7)) * 16) + hi * 8) = kblk ? hwB[lb * 4 + g4] : hwA[lb * 4 + g4]; }
    asm volatile("s_waitcnt lgkmcnt(0)" ::: "memory");
#pragma unroll
    for (int i8 = 0; i8 < 8; ++i8) {
        const int rowl = i8 * 8 + (lane >> 3), ch = lane & 7;
        const u32x4 v = *(const u32x4*)(lds_w + rowl * 128 + ((ch ^ (rowl & 7)) * 16));
        *(u32x4*)(H + (rowb + (size_t)rowl * 128) * DM + 512 + 64 * g + 8 * ch) = v;
    }
    asm volatile("s_waitcnt lgkmcnt(0)" ::: "memory");
}
__device__ __forceinline__ void conv_wave(int task, const bf16_t* P, bf16_t* H, const float* cw, const float* cb, int lane) {
    const int cgp = lane & 31, ch0 = cgp * 8;
    const int r0 = task * 8 + (lane >> 5) * 4;
    int pos, len; if (r0 < NTOK) { pos = r0 & (SEQ - 1); len = SEQ; } else { pos = (r0 - NTOK) & (CTXL - 1); len = CTXL; }
    u32x4 zz[6], cc[6], bb[4], gg[4]; float okf[6];
#pragma unroll
    for (int i = 0; i < 6; ++i) { const int p = pos - 1 + i; const bool ok = p >= 0 && p < len; okf[i] = ok ? 1.f : 0.f; const size_t row = (size_t)(ok ? r0 - 1 + i : r0);
        zz[i] = __builtin_nontemporal_load((const u32x4*)(P + row * PW + C_ZC + ch0)); cc[i] = __builtin_nontemporal_load((const u32x4*)(P + row * PW + C_CC + ch0)); }
#pragma unroll
    for (int i = 0; i < 4; ++i) { const size_t row = (size_t)(r0 + i); bb[i] = __builtin_nontemporal_load((const u32x4*)(P + row * PW + C_BC + ch0)); gg[i] = __builtin_nontemporal_load((const u32x4*)(P + row * PW + C_GC + ch0)); }
    __builtin_amdgcn_sched_barrier(0);
    float w0[8], w1[8], w2[8], bs[8];
    { const f32x4 a0 = *(const f32x4*)(cw + ch0), a1 = *(const f32x4*)(cw + ch0 + 4), b0 = *(const f32x4*)(cw + 256 + ch0), b1 = *(const f32x4*)(cw + 256 + ch0 + 4);
      const f32x4 c0 = *(const f32x4*)(cw + 512 + ch0), c1 = *(const f32x4*)(cw + 512 + ch0 + 4), d0 = *(const f32x4*)(cb + ch0), d1 = *(const f32x4*)(cb + ch0 + 4);
#pragma unroll
      for (int e = 0; e < 4; ++e) { w0[e] = a0[e]; w0[4 + e] = a1[e]; w1[e] = b0[e]; w1[4 + e] = b1[e]; w2[e] = c0[e]; w2[4 + e] = c1[e]; bs[e] = d0[e]; bs[4 + e] = d1[e]; } }
    float T[6][8];
#pragma unroll
    for (int i = 0; i < 6; ++i) {
        const unsigned zv[4] = {zz[i].x, zz[i].y, zz[i].z, zz[i].w}, cv[4] = {cc[i].x, cc[i].y, cc[i].z, cc[i].w};
#pragma unroll
        for (int e = 0; e < 8; ++e) T[i][e] = okf[i] * ((e & 1) ? bf2f(zv[e >> 1] >> 16) : bf2f(zv[e >> 1] & 0xffffu)) * ((e & 1) ? bf2f(cv[e >> 1] >> 16) : bf2f(cv[e >> 1] & 0xffffu));
    }
#pragma unroll
    for (int i = 0; i < 4; ++i) {
        const size_t row = (size_t)(r0 + i);
        const unsigned bwv[4] = {bb[i].x, bb[i].y, bb[i].z, bb[i].w}, gwv[4] = {gg[i].x, gg[i].y, gg[i].z, gg[i].w};
        float o[8];
#pragma unroll
        for (int e = 0; e < 8; ++e) {
            const float bv = (e & 1) ? bf2f(bwv[e >> 1] >> 16) : bf2f(bwv[e >> 1] & 0xffffu);
            const float gv = (e & 1) ? bf2f(gwv[e >> 1] >> 16) : bf2f(gwv[e >> 1] & 0xffffu);
            const float y = T[i][e] * w0[e] + T[i + 1][e] * w1[e] + T[i + 2][e] * w2[e] + bs[e];
            o[e] = bv * y * silu_f(gv);
        }
        u32x4 w; w.x = pkbf(o[0], o[1]); w.y = pkbf(o[2], o[3]); w.z = pkbf(o[4], o[5]); w.w = pkbf(o[6], o[7]);
        *(u32x4*)(H + row * DM + 768 + ch0) = w;
    }
}

#define XB_TMO      128
#define XB_XCNT(j)  (256  + 64 * (j))
#define XB_XSUB(j)  (1280 + 64 * (j))
#define XB_XGEN(j)  (2304 + 64 * (j))
#define XB_TOP      3328
#define XB_TOPGEN   3392
#define XCD_BAR_WORDS 3456
#define XB_SPIN_CAP (1u << 18)

__device__ __forceinline__ unsigned xb_ld(unsigned* p)              { return __hip_atomic_load(p, __ATOMIC_RELAXED, __HIP_MEMORY_SCOPE_AGENT); }
__device__ __forceinline__ unsigned xb_add(unsigned* p, unsigned v) { return __hip_atomic_fetch_add(p, v, __ATOMIC_RELAXED, __HIP_MEMORY_SCOPE_AGENT); }
__device__ __forceinline__ unsigned xb_xcc_id() { return (unsigned)__builtin_amdgcn_s_getreg((3 << 11) | 20) & 0xFu; }
#define XB_SPIN(cond, bar) do { unsigned _sp = 0; while (cond) { __builtin_amdgcn_s_sleep(1); \
    if ((++_sp & 255u) == 0u) { if (xb_ld(&(bar)[XB_TMO])) break; if (_sp > XB_SPIN_CAP) { atomicAdd(&(bar)[XB_TMO], 1u); break; } } } } while (0)

struct XcdBarrier {
    unsigned* bar; unsigned x;
    volatile LAS unsigned* st;
};

__device__ __forceinline__ XcdBarrier xcd_barrier_post(unsigned* bar, volatile LAS unsigned* st) {
    XcdBarrier b; b.bar = bar; b.x = xb_xcc_id(); b.st = st;
    if (threadIdx.x == 0) (void)xb_add(&bar[XB_XCNT(b.x)], 1u);
    return b;
}
__device__ __forceinline__ void xcd_barrier_complete(unsigned* bar, unsigned x, unsigned& nloc, unsigned& nx) {
    const unsigned G = gridDim.x * gridDim.y * gridDim.z;
    unsigned sum, cnt, mine, sp = 0u;
    for (;;) {
        sum = 0u; cnt = 0u; mine = 0u;
#pragma unroll
        for (unsigned j = 0; j < 16; ++j) { const unsigned c = xb_ld(&bar[XB_XCNT(j)]); sum += c; cnt += (c > 0u) ? 1u : 0u; mine = (j == x) ? c : mine; }
        if (sum == G) break;
        __builtin_amdgcn_s_sleep(1);
        if ((++sp & 255u) == 0u) { if (xb_ld(&bar[XB_TMO])) break; if (sp > XB_SPIN_CAP) { atomicAdd(&bar[XB_TMO], 1u); break; } }
    }
    nloc = mine > 0u ? mine : 1u; nx = cnt > 0u ? cnt : 1u;
}

__device__ __forceinline__ void xcd_barrier(const XcdBarrier& b) {
    asm volatile("s_waitcnt vmcnt(0)" ::: "memory");
    __syncthreads();
    if (threadIdx.x == 0) {
        unsigned* bar = b.bar;
        __builtin_amdgcn_s_waitcnt(0);
        unsigned nloc = b.st[0], nx = b.st[1];
        if (nloc == 0u) { xcd_barrier_complete(bar, b.x, nloc, nx); b.st[0] = nloc; b.st[1] = nx; }
        const unsigned old = xb_add(&bar[XB_XSUB(b.x)], 1u);
        const unsigned gen = old / nloc;
        if (old + 1u == (gen + 1u) * nloc) {
            __builtin_amdgcn_fence(__ATOMIC_RELEASE, "agent");
            asm volatile("s_waitcnt vmcnt(0)" ::: "memory");
            const unsigned og = xb_add(&bar[XB_TOP], 1u);
            const unsigned tg = og / nx;
            if (og + 1u == (tg + 1u) * nx) xb_add(&bar[XB_TOPGEN], 1u);
            else XB_SPIN(xb_ld(&bar[XB_TOPGEN]) == tg, bar);
            __builtin_amdgcn_fence(__ATOMIC_ACQUIRE, "agent");
            xb_add(&bar[XB_XGEN(b.x)], 1u);
            asm volatile("s_waitcnt vmcnt(0)" ::: "memory");
        } else {
            XB_SPIN(xb_ld(&bar[XB_XGEN(b.x)]) == gen, bar);
            __builtin_amdgcn_fence(__ATOMIC_ACQUIRE, "agent");
            asm volatile("s_waitcnt vmcnt(0)" ::: "memory");
        }
    }
    __syncthreads();
}

__device__ __forceinline__ int next_unit(unsigned* ctr, unsigned char* lds) {
    volatile int* sw = (volatile int*)(lds + LDS_SCHED);
    if (threadIdx.x == 0) *sw = (int)atomicAdd(ctr, 1u);
    __syncthreads();
    const int u = *sw;
    __syncthreads();
    return u;
}

__global__ void __launch_bounds__(NTHREADS, 2) hybrid_fwd(KArgs a) {
    extern __shared__ __attribute__((aligned(16))) unsigned char lds[];
    cg::grid_group grid = cg::this_grid();
    unsigned char* ws = a.ws;
    const int lo = a.ph_lo, hi = a.ph_hi;
#ifndef PHMASK
#define PHMASK 0xfff
#endif
#define IN(k) (((PHMASK >> ((k) > 5 && (k) < 11 ? (k) - 5 : (k))) & 1) && lo <= (k) && (k) < hi)
#define SEAM(k) do { if (IN(k) && IN((k) + 1)) xcd_barrier(xbar); } while (0)
#ifndef REP_PHASE
#define REP_PHASE -1
#endif
#define REPS(j) for (int rep = 0, nrep = (REP_PHASE == (j)) ? 2 : 1; rep < nrep; ++rep, (rep < nrep ? xcd_barrier(xbar) : (void)0))
    bf16_t* HX = (bf16_t*)(ws + WS_HX); bf16_t* Pb = (bf16_t*)(ws + WS_P); bf16_t* Vt = (bf16_t*)(ws + WS_VT); bf16_t* Hb = (bf16_t*)(ws + WS_H);
    bf16_t* Yb = (bf16_t*)(ws + WS_Y); bf16_t* YF = (bf16_t*)(ws + WS_YF); float* SSQ = (float*)(ws + WS_SSQ);
    unsigned* ctl = (unsigned*)(ws + WS_CTL);

    if (threadIdx.x < 2) ((volatile LAS unsigned*)(lds + LDS_BARST))[threadIdx.x] = 0u;
    __syncthreads();
    const XcdBarrier xbar = xcd_barrier_post((unsigned*)(ws + WS_BAR), (volatile LAS unsigned*)(lds + LDS_BARST));
    if (a.ph_lo < 0) grid.sync();
    REPS(30) if (IN(0)) p0_prologue(a, lds);
    SEAM(0);
    for (int l = 0; l < 2; ++l) {
        const int pb = 1 + 5 * l;
        REPS(0) if (IN(pb)) norm_phase(a, l);
        SEAM(pb);
        REPS(1) if (IN(pb + 1)) {
            pg8::Gemm g{HX, (const bf16_t*)(ws + WS_WIN) + (size_t)l * PW * DM, MROWS, PW, DM};
            pg8::StaticOrder S; S.init(MROWS, PW, (int)gridDim.x, (int)blockIdx.x);
            pg8::EpiProj E{Pb, Vt, (const float*)(ws + WS_ROPE), (bf16_t*)(ws + WS_UFP), 0.125f * LOG2E};
            pg8::gemm_phase<pg8::EpiProj, pg8::StaticOrder, true, true>((PG8_LAS unsigned char*)lds, g, S, E);
            if (l == 0) {
                const int G = (int)gridDim.x, nun = (MROWS / 256) * (PW / 256), fi = nun - (nun / G) * G;
                const bool all = (fi == 0) || (G - fi < 16);
                if (all || (int)blockIdx.x >= fi) {
                    const int tid = opaque_tid(), lane = tid & 63, wave = tid >> 6;
                    __syncthreads();
                    p0_transposes(a, lds, 1, ((int)blockIdx.x - (all ? 0 : fi)) * 8 + wave, (G - (all ? 0 : fi)) * 8, lane, wave);
                }
            }
        }
        SEAM(pb + 1);
        for (int rep = 0, nrep = (REP_PHASE >= 20 && REP_PHASE < 30) ? 2 : 1; rep < nrep; ++rep, (rep < nrep ? xcd_barrier(xbar) : (void)0)) if (IN(pb + 2)) {
            const int nAttn = (l == 0) ? 1056 : 1024, nCtxF = (l == 0) ? 16 : 0, nF1 = 256, nConv = ((l == 0) ? MROWS : NTOK) / 64;
            const int e0 = nF1, e1 = e0 + nCtxF, e2 = e1 + nAttn, e3 = e2 + nConv;
            for (;;) {
                const int u = next_unit(ctl + 2 * l + 8 * rep, lds);
                if (u >= e3) break;
                if (rep == 1) { const int ty = u < e0 ? 1 : u < e1 ? 3 : u < e2 ? 0 : 2; if (REP_PHASE == 25 ? (ty == 0) : (ty != REP_PHASE - 20)) continue; }
                int au = -1, cu = -1;
                if (u >= e1) { const int k = u - e1, C1 = nConv - 256, T = nAttn + C1;
                    if (k >= T) cu = C1 + (k - T);
                    else { const int c0 = (k * C1) / T, c1 = ((k + 1) * C1) / T; if (c1 > c0) cu = c0; else au = k - c0; } }
                if (au >= 0) attn_unit(au, Pb, Vt, Hb, a.sink + 8 * l, lds);
                else if (u >= e0 && u < e1) { const int v = u - e0, b = v >> 2, kb = v & 3;
                    dftf_unit<256>(Pb + (size_t)(NTOK + b * CTXL) * PW + C_UF, 256, PW, 0, (const bf16_t*)(ws + WS_T256R) + (size_t)(64 * kb) * 256, (const bf16_t*)(ws + WS_T256I) + (size_t)(64 * kb) * 256,
                                   (const bf16_t*)(ws + WS_GT) + (size_t)l * 4 * 64 * 128, Pb, Hb, (size_t)(NTOK + b * CTXL + 64 * kb), 1, 5.656854249492381f, lds); }
                else {
                    const int tid = opaque_tid(), lane = tid & 63, wave = __builtin_amdgcn_readfirstlane(tid >> 6);
                    if (u < e0) { fft1_tables(ws, lds + 65536, tid); __syncthreads(); fft1_wave(u * 8 + wave, (const bf16_t*)(ws + WS_UFP), YF, ws, lds + wave * 8192, lds + 65536, lane); }
                    else conv_wave(cu * 8 + wave, Pb, Hb, a.conv_w + l * 768, a.conv_b + l * 256, lane);
                }
            }
        }
        SEAM(pb + 2);
        REPS(3) if (IN(pb + 3)) {
            const bool gemmwg = (l == 0 && blockIdx.x < 16);
            if (gemmwg) {
                pg8::Gemm g{Hb + (size_t)NTOK * DM, (const bf16_t*)(ws + WS_WOUT) + (size_t)l * DM * DM, NCTX, DM, DM};
                pg8::StaticOrder S; S.init(NCTX, DM, 16, (int)blockIdx.x);
                pg8::EpiY E{Yb + (size_t)NTOK * DM, SSQ + (size_t)NTOK * 16};
                pg8::gemm_phase<pg8::EpiY, pg8::StaticOrder, true, true>((PG8_LAS unsigned char*)lds, g, S, E);
            } else {
                const int tid = opaque_tid(), lane = tid & 63, wave = __builtin_amdgcn_readfirstlane(tid >> 6);
                const int nb0 = (l == 0) ? 16 : 0;
                const int gw = ((int)blockIdx.x - nb0) + wave * ((int)gridDim.x - nb0), NGW = ((int)gridDim.x - nb0) * 8;
                unsigned char* lds_w = lds + wave * 16384;
                for (int t = gw; t < 2048; t += NGW) fft3_wave(t, YF, (const bf16_t*)(ws + WS_GT) + (size_t)l * 4 * 64 * 128, Pb, Hb, ws, lds_w, lane);
            }
            __syncthreads();
        }
        SEAM(pb + 3);
        REPS(4) if (IN(pb + 4)) {
            pg8::Gemm g{Hb, (const bf16_t*)(ws + WS_WOUT) + (size_t)l * DM * DM, NTOK, DM, DM};
            pg8::StaticOrder S; S.init(NTOK, DM, (int)gridDim.x, (int)blockIdx.x);
            pg8::EpiY E{l == 0 ? Yb : HX, l == 0 ? SSQ : (float*)(ws + WS_SSQ1)};
            pg8::gemm_phase<pg8::EpiY, pg8::StaticOrder, true, true>((PG8_LAS unsigned char*)lds, g, S, E);
        }
        SEAM(pb + 4);
    }
#if REP_PHASE == 9
    for (int i = 0; i < 10; ++i) xcd_barrier(xbar);
#endif
    if (IN(11)) norm_phase(a, 2);
#undef IN
#undef SEAM
}

#ifndef MK_MULTI
#define MK_MULTI 0
#endif
extern "C" void kernel_launch(void* const* d_in, const int* in_sizes, int n_in, void* d_out, int out_size, void* d_ws, size_t ws_size, hipStream_t stream) {
    static int grid = 0;
    if (grid == 0) {
        if (n_in != 14 || ws_size < WS_END) { fprintf(stderr, "kernel_launch: unexpected n_in %d or ws_size %zu (need %zu)\n", n_in, ws_size, (size_t)WS_END); grid = -1; return; }
        int dev = 0, cus = 0, per_cu = 0;
        hipGetDevice(&dev); hipDeviceGetAttribute(&cus, hipDeviceAttributeMultiprocessorCount, dev);
        if (hipFuncSetAttribute((const void*)hybrid_fwd, hipFuncAttributeMaxDynamicSharedMemorySize, LDS_BYTES) != hipSuccess) { fprintf(stderr, "kernel_launch: hipFuncSetAttribute failed\n"); grid = -1; return; }
        if (hipOccupancyMaxActiveBlocksPerMultiprocessor(&per_cu, (const void*)hybrid_fwd, NTHREADS, LDS_BYTES) != hipSuccess || per_cu < 1) { fprintf(stderr, "kernel_launch: occupancy query gave %d\n", per_cu); per_cu = 1; }
        (void)hipGetLastError();
        grid = cus * 1;
        fprintf(stderr, "kernel_launch: grid %d (cus %d, per_cu %d)\n", grid, cus, per_cu);
    }
    if (grid < 0) return;
    if (hipMemsetAsync((char*)d_ws + WS_CTL, 0, WS_ZERO_BYTES, stream) != hipSuccess) { fprintf(stderr, "kernel_launch: hipMemsetAsync failed\n"); return; }
    KArgs a{};
    a.x = (const float*)d_in[0]; a.c = (const float*)d_in[1]; a.ctx = (const float*)d_in[2]; a.c_ctx = (const float*)d_in[3]; a.w_mod = (const float*)d_in[4]; a.b_mod = (const float*)d_in[5];
    a.g_pre = (const float*)d_in[6]; a.g_post = (const float*)d_in[7]; a.w_in = (const float*)d_in[8]; a.w_out = (const float*)d_in[9]; a.sink = (const float*)d_in[10]; a.w_f = (const float*)d_in[11];
    a.conv_w = (const float*)d_in[12]; a.conv_b = (const float*)d_in[13];
    a.out = (float*)d_out; a.ws = (unsigned char*)d_ws;
#if MK_MULTI
    for (int ph = 0; ph < 12; ++ph) { a.ph_lo = ph; a.ph_hi = ph + 1; hipLaunchKernelGGL(hybrid_fwd, dim3(grid), dim3(NTHREADS), LDS_BYTES, stream, a); }
#else
    a.ph_lo = 0; a.ph_hi = 12;
    void* args[] = {&a};
    hipError_t e = hipLaunchCooperativeKernel((const void*)hybrid_fwd, dim3(grid), dim3(NTHREADS), args, LDS_BYTES, stream);
    if (e != hipSuccess) fprintf(stderr, "kernel_launch: cooperative launch failed: %s (grid %d)\n", hipGetErrorString(e), grid);
#endif
}
```

```cpp
#include <hip/hip_runtime.h>
#include <hip/hip_cooperative_groups.h>
#include <cstdio>
#include <cstdint>
namespace cg = cooperative_groups;
namespace pg8 {
#define PG8_LAS __attribute__((address_space(3)))
typedef unsigned short bf16_t;
typedef short bf16x8 __attribute__((ext_vector_type(8)));
typedef float f32x4 __attribute__((ext_vector_type(4)));
typedef unsigned u32x4 __attribute__((ext_vector_type(4)));
constexpr int BM = 256, BK = 64, HALF = 128, HTB = HALF * BK * 2  , STAGE_BYTES = 8 * HTB, NXCD = 8, WGM = 8;

__host__ __device__ __forceinline__ int lds_byte(int r, int c) { const int st = (r >> 4) * 2 + (c >> 5), rr = r & 15, cc = c & 31, ob = rr * 64 + cc * 2; return st * 1024 + (ob ^ (((ob >> 9) & 1) << 5)); }
__host__ __device__ __forceinline__ void stage_rc(int b, int& R, int& C) { const int st = b / 1024, sb = b % 1024, swz = sb ^ (((sb >> 9) & 1) << 5); R = (st >> 1) * 16 + swz / 64; C = (st & 1) * 32 + (swz % 64) / 2; }
__host__ __device__ __forceinline__ int perm32(int rho) { const int n = rho >> 4, i = rho & 15; return 8 * (i >> 2) + 4 * n + (i & 3); }

struct Unit { int pm, pn; };
struct Gemm { const bf16_t* A; const bf16_t* Bt; int M, N, K; };

struct StaticOrder {
    int nM, nN, nwg, G, c;
    __host__ __device__ void init(int M, int N, int G_, int c_) { nM = M / BM; nN = N / BM; nwg = nM * nN; G = G_; c = c_; }
    __host__ __device__ bool next(int i, Unit& u) const {
        const long L = (long)i * G + c; if (L >= nwg) return false;
        int wgid = (int)L; { const int q = nwg / NXCD, r = nwg % NXCD, xcd = wgid % NXCD, off = wgid / NXCD; wgid = (xcd < r ? xcd * (q + 1) : r * (q + 1) + (xcd - r) * q) + off; }
        const int nig = WGM * nN, gid = wgid / nig, fm = gid * WGM, gsz = (nM - fm) < WGM ? (nM - fm) : WGM;
        u.pm = fm + ((wgid % nig) % gsz); u.pn = (wgid % nig) / gsz; return true;
    }
    __device__ __forceinline__ void a_ready(const Unit&) const {}
    __device__ __forceinline__ void done(const Unit&) const {}
};

__device__ __forceinline__ unsigned cvt_pk_bf16(float lo, float hi) { unsigned r; asm volatile("v_cvt_pk_bf16_f32 %0, %1, %2" : "=v"(r) : "v"(lo), "v"(hi)); return r; }
typedef unsigned u32x2 __attribute__((ext_vector_type(2)));
__device__ __forceinline__ int swap23(int t) { return (t & ~12) | ((t & 4) << 1) | ((t & 8) >> 1); }
struct EpiProj {
    static constexpr bool PERM = true, AFTER_DRAIN = false;
    bf16_t* P; bf16_t* Vt; const float* rope; bf16_t* UFP; float qscale;
    __device__ __forceinline__ void operator()(const f32x4 (&acc)[2][2][4][2], const Unit& u, int wr, int wc, int fr, int fq) const {
        const int row0 = u.pm * BM + wr * 64 + fr;
        const int pn = u.pn;
        const bool ctxrow = u.pm >= 128;
        f32x4 CS[2][4], SN[2][4];
        if (pn <= 2) {
#pragma unroll
            for (int ai = 0; ai < 2; ++ai)
#pragma unroll
                for (int m = 0; m < 4; ++m) {
                    CS[ai][m] = (f32x4){1.f, 1.f, 1.f, 1.f}; SN[ai][m] = (f32x4){0.f, 0.f, 0.f, 0.f};
                    if (!ctxrow) { const int t = (row0 + ai * HALF + m * 16) & 8191; const int pos = (wc & 1) ? (t & 63) : (t >> 6);
                        CS[ai][m] = *(const f32x4*)(rope + pos * 32 + 4 * fq); SN[ai][m] = *(const f32x4*)(rope + pos * 32 + 16 + 4 * fq); }
                }
            __builtin_amdgcn_sched_barrier(0);
        }
#pragma unroll
        for (int ai = 0; ai < 2; ++ai)
#pragma unroll
            for (int m = 0; m < 4; ++m) {
                const int row = row0 + ai * HALF + m * 16;
                bf16_t* rowp = P + (size_t)row * 2816 + pn * BM + wc * 32 + 8 * fq;
                if (pn == 5 && !ctxrow) { const int t = row & 8191; rowp = UFP + ((size_t)(((row >> 13) * 64 + (t & 63)) * 128 + (t >> 6))) * 256 + wc * 32 + 8 * fq; }
                if (pn > 2) {
#pragma unroll
                    for (int bj = 0; bj < 2; ++bj) { const f32x4 v0 = acc[ai][bj][m][0], v1 = acc[ai][bj][m][1];
                        u32x4 w; w.x = cvt_pk_bf16(v0[0], v0[1]); w.y = cvt_pk_bf16(v0[2], v0[3]); w.z = cvt_pk_bf16(v1[0], v1[1]); w.w = cvt_pk_bf16(v1[2], v1[3]);
                        *(u32x4*)(rowp + bj * HALF) = w; }
                } else {
                    const f32x4 cs = CS[ai][m], sn = SN[ai][m];
#pragma unroll
                    for (int bj = 0; bj < 2; ++bj) {
                        f32x4 v0 = acc[ai][bj][m][0], v1 = acc[ai][bj][m][1];
                        if (pn == 2 && bj == 1) {
                            u32x4 w; w.x = cvt_pk_bf16(v0[0], v0[1]); w.y = cvt_pk_bf16(v0[2], v0[3]); w.z = cvt_pk_bf16(v1[0], v1[1]); w.w = cvt_pk_bf16(v1[2], v1[3]);
                            *(u32x4*)(rowp + bj * HALF) = w;
                        } else {
                            const f32x4 r0 = v0 * cs - v1 * sn, r1 = v0 * sn + v1 * cs;
                            v0 = r0; v1 = r1;
                            if (pn < 2) { v0 = v0 * qscale; v1 = v1 * qscale; }
                            u32x4 w; w.x = cvt_pk_bf16(v0[0], v0[1]); w.y = cvt_pk_bf16(v0[2], v0[3]); w.z = cvt_pk_bf16(v1[0], v1[1]); w.w = cvt_pk_bf16(v1[2], v1[3]);
                            *(u32x4*)(rowp + bj * HALF) = w;
                        }
                    }
                }
            }
    }
};
struct EpiY {
    static constexpr bool PERM = true, AFTER_DRAIN = false;
    bf16_t* Y; float* ssq;
    __device__ __forceinline__ void operator()(const f32x4 (&acc)[2][2][4][2], const Unit& u, int wr, int wc, int fr, int fq) const {
        const int row0 = u.pm * BM + wr * 64 + fr;
#pragma unroll
        for (int ai = 0; ai < 2; ++ai)
#pragma unroll
            for (int m = 0; m < 4; ++m) {
                const int row = row0 + ai * HALF + m * 16;
                bf16_t* rowp = Y + (size_t)row * 1024 + u.pn * BM + wc * 32 + 8 * fq;
                float s = 0.f;
#pragma unroll
                for (int bj = 0; bj < 2; ++bj) { const f32x4 v0 = acc[ai][bj][m][0], v1 = acc[ai][bj][m][1];
                    s += (v0[0] * v0[0] + v0[1] * v0[1]) + (v0[2] * v0[2] + v0[3] * v0[3]) + (v1[0] * v1[0] + v1[1] * v1[1]) + (v1[2] * v1[2] + v1[3] * v1[3]);
                    u32x4 w; w.x = cvt_pk_bf16(v0[0], v0[1]); w.y = cvt_pk_bf16(v0[2], v0[3]); w.z = cvt_pk_bf16(v1[0], v1[1]); w.w = cvt_pk_bf16(v1[2], v1[3]);
                    *(u32x4*)(rowp + bj * HALF) = w; }
                s += __shfl_xor(s, 16); s += __shfl_xor(s, 32);
                if (fq == 0) ssq[(size_t)row * 16 + u.pn * 4 + wc] = s;
            }
    }
};
template <class Epi, class Sched, bool ALIGN_EPI = false, bool SP2 = false>
__device__ __forceinline__ void gemm_phase(PG8_LAS unsigned char* lds, const Gemm g, const Sched& S, const Epi& E) {
    int tid_ = threadIdx.x; asm volatile("" : "+v"(tid_));
    const int tid = tid_, wid = __builtin_amdgcn_readfirstlane(tid >> 6), lane = tid & 63, wr = wid >> 2, wc = wid & 3, fr = lane & 15, fq = lane >> 4;
    const int K = g.K, nt = K / BK;
    unsigned voffA[2], voffB[2];
#pragma unroll
    for (int i = 0; i < 2; ++i) { int R, C; stage_rc(tid * 16 + i * 8192, R, C); const int Rb = Epi::PERM ? ((R & ~31) + perm32(R & 31)) : R;
        voffA[i] = (unsigned)(R * K + C) * 2u; voffB[i] = (unsigned)(Rb * K + C) * 2u; }
    const size_t kstep = (size_t)(BK * 2);
    const size_t hstep = (size_t)HALF * K * 2;
    const size_t tstep = 2 * hstep;
    const unsigned ldsw = (unsigned)wid * 1024u;
    const int aoff = lds_byte(wr * 64 + fr, fq * 8), boff = lds_byte(wc * 32 + fr, fq * 8);
#define PG8_SA(b, h) (((b) * 2 + (h)) * HTB)
#define PG8_SB(b, h) ((4 + (b) * 2 + (h)) * HTB)
#define PG8_STAGE(bufoff, gbase, voff) do { _Pragma("unroll") for (int _i = 0; _i < 2; ++_i) \
        __builtin_amdgcn_global_load_lds((const unsigned*)((const char*)(gbase) + (voff)[_i]), (PG8_LAS unsigned*)(lds + (bufoff) + ldsw + _i * 8192), 16, 0, 0); } while (0)
#define PG8_LDA(dst, b, h) do { _Pragma("unroll") for (int m = 0; m < 4; ++m) _Pragma("unroll") for (int k = 0; k < 2; ++k) dst[m][k] = *(const PG8_LAS bf16x8*)(lds + PG8_SA(b, h) + aoff + m * 2048 + k * 1024); } while (0)
#define PG8_LDB(dst, b, h) do { _Pragma("unroll") for (int n = 0; n < 2; ++n) _Pragma("unroll") for (int k = 0; k < 2; ++k) dst[n][k] = *(const PG8_LAS bf16x8*)(lds + PG8_SB(b, h) + boff + n * 2048 + k * 1024); } while (0)
#define PG8_MMA(ai, bj, At, Bt) do { __builtin_amdgcn_s_setprio(1); _Pragma("unroll") for (int m = 0; m < 4; ++m) _Pragma("unroll") for (int n = 0; n < 2; ++n) _Pragma("unroll") for (int k = 0; k < 2; ++k) \
        acc[ai][bj][m][n] = __builtin_amdgcn_mfma_f32_16x16x32_bf16(Bt[n][k], At[m][k], acc[ai][bj][m][n], 0, 0, 0); __builtin_amdgcn_s_setprio(0); } while (0)
#define PG8_WAIT_V(n) asm volatile("s_waitcnt vmcnt(" #n ")" ::: "memory")
#define PG8_WAIT_L(n) asm volatile("s_waitcnt lgkmcnt(" #n ")" ::: "memory")
#define PG8_BAR __builtin_amdgcn_s_barrier()
#define PG8_SCHED __builtin_amdgcn_sched_barrier(0)
    Unit cur, nxt; int ui = 0;
    if (!S.next(0, cur)) return;
    f32x4 acc[2][2][4][2];
#pragma unroll
    for (int a = 0; a < 2; ++a)
#pragma unroll
        for (int b = 0; b < 2; ++b)
#pragma unroll
            for (int m = 0; m < 4; ++m)
#pragma unroll
                for (int n = 0; n < 2; ++n) acc[a][b][m][n] = (f32x4){0.f, 0.f, 0.f, 0.f};
    bf16x8 At[4][2], B0[2][2], B1[2][2];
    const char* cA = (const char*)g.A + (size_t)cur.pm * tstep; const char* cB = (const char*)g.Bt + (size_t)cur.pn * tstep;
    S.a_ready(cur);
    if constexpr (SP2) {
        PG8_STAGE(PG8_SB(0, 0), cB, voffB); PG8_STAGE(PG8_SB(0, 1), cB + hstep, voffB); PG8_STAGE(PG8_SA(0, 0), cA, voffA); PG8_STAGE(PG8_SA(0, 1), cA + hstep, voffA);
        if (wr == 1) PG8_BAR;
        PG8_WAIT_V(2); PG8_BAR;
        PG8_STAGE(PG8_SB(1, 0), cB + kstep, voffB); PG8_STAGE(PG8_SA(1, 0), cA + kstep, voffA); PG8_STAGE(PG8_SB(1, 1), cB + hstep + kstep, voffB);
        PG8_WAIT_V(6); PG8_BAR;
    } else {
        PG8_STAGE(PG8_SB(0, 0), cB, voffB); PG8_STAGE(PG8_SA(0, 0), cA, voffA); PG8_STAGE(PG8_SB(0, 1), cB + hstep, voffB); PG8_STAGE(PG8_SA(0, 1), cA + hstep, voffA);
        if (wr == 1) PG8_BAR;
        PG8_WAIT_V(4); PG8_BAR;
        PG8_STAGE(PG8_SB(1, 0), cB + kstep, voffB); PG8_STAGE(PG8_SA(1, 0), cA + kstep, voffA); PG8_STAGE(PG8_SB(1, 1), cB + hstep + kstep, voffB);
        PG8_WAIT_V(6); PG8_BAR;
    }
    for (;;) {
        const bool has_next = S.next(ui + 1, nxt);
        const char* nA = has_next ? (const char*)g.A + (size_t)nxt.pm * tstep : cA; const char* nB = has_next ? (const char*)g.Bt + (size_t)nxt.pn * tstep : cB;
        for (int t = 0; t < nt; t += 2) {
            const bool last = (t == nt - 2);
            const char* a1 = cA + (size_t)(t + 1) * kstep;
            const char* a2 = last ? nA : cA + (size_t)(t + 2) * kstep; const char* b2 = last ? nB : cB + (size_t)(t + 2) * kstep;
            const char* a3 = a2 + kstep; const char* b3 = b2 + kstep;
            if (last && has_next) S.a_ready(nxt);
            if constexpr (SP2) {
            PG8_LDB(B0, 0, 0); PG8_LDB(B1, 0, 1); PG8_SCHED; PG8_LDA(At, 0, 0); PG8_STAGE(PG8_SA(1, 1), a1 + hstep, voffA);
            PG8_WAIT_V(8); PG8_WAIT_L(0); PG8_BAR; PG8_MMA(0, 0, At, B0); PG8_MMA(0, 1, At, B1); PG8_BAR; PG8_SCHED;
            PG8_LDA(At, 0, 1); PG8_STAGE(PG8_SB(0, 0), b2, voffB); PG8_STAGE(PG8_SB(0, 1), b2 + hstep, voffB); PG8_STAGE(PG8_SA(0, 0), a2, voffA);
            PG8_WAIT_V(8); PG8_WAIT_L(0); PG8_BAR; PG8_MMA(1, 0, At, B0); PG8_MMA(1, 1, At, B1); PG8_BAR; PG8_SCHED;
            PG8_LDB(B0, 1, 0); PG8_LDB(B1, 1, 1); PG8_SCHED; PG8_LDA(At, 1, 0); PG8_STAGE(PG8_SA(0, 1), a2 + hstep, voffA);
            PG8_WAIT_V(8); PG8_WAIT_L(0); PG8_BAR; PG8_MMA(0, 0, At, B0); PG8_MMA(0, 1, At, B1); PG8_BAR; PG8_SCHED;
            PG8_LDA(At, 1, 1); PG8_STAGE(PG8_SB(1, 0), b3, voffB); PG8_STAGE(PG8_SB(1, 1), b3 + hstep, voffB); PG8_STAGE(PG8_SA(1, 0), a3, voffA);
            PG8_WAIT_V(8); PG8_WAIT_L(0); PG8_BAR; PG8_MMA(1, 0, At, B0); PG8_MMA(1, 1, At, B1); PG8_BAR; PG8_SCHED;
            } else {
            PG8_LDB(B0, 0, 0); PG8_SCHED; PG8_LDA(At, 0, 0); PG8_STAGE(PG8_SA(1, 1), a1 + hstep, voffA);
            PG8_WAIT_L(8); PG8_BAR; PG8_WAIT_L(0); PG8_MMA(0, 0, At, B0); PG8_BAR; PG8_SCHED;
            PG8_LDB(B1, 0, 1); PG8_STAGE(PG8_SB(0, 0), b2, voffB);
            PG8_BAR; PG8_WAIT_L(0); PG8_MMA(0, 1, At, B1); PG8_BAR;
            PG8_LDA(At, 0, 1); PG8_STAGE(PG8_SA(0, 0), a2, voffA);
            PG8_BAR; PG8_WAIT_L(0); PG8_MMA(1, 0, At, B0); PG8_BAR; PG8_SCHED;
            PG8_STAGE(PG8_SB(0, 1), b2 + hstep, voffB);
            PG8_WAIT_V(6); PG8_BAR; PG8_MMA(1, 1, At, B1); PG8_BAR;
            PG8_LDB(B0, 1, 0); PG8_SCHED; PG8_LDA(At, 1, 0); PG8_STAGE(PG8_SA(0, 1), a2 + hstep, voffA);
            PG8_WAIT_L(8); PG8_BAR; PG8_WAIT_L(0); PG8_MMA(0, 0, At, B0); PG8_BAR; PG8_SCHED;
            PG8_LDB(B1, 1, 1); PG8_STAGE(PG8_SB(1, 0), b3, voffB);
            PG8_BAR; PG8_WAIT_L(0); PG8_MMA(0, 1, At, B1); PG8_BAR;
            PG8_LDA(At, 1, 1); PG8_STAGE(PG8_SA(1, 0), a3, voffA);
            PG8_BAR; PG8_WAIT_L(0); PG8_MMA(1, 0, At, B0); PG8_BAR; PG8_SCHED;
            PG8_STAGE(PG8_SB(1, 1), b3 + hstep, voffB);
            PG8_WAIT_V(6); PG8_BAR; PG8_MMA(1, 1, At, B1); PG8_BAR;
            }
        }
        if constexpr (ALIGN_EPI) { if (wr == 0) PG8_BAR; }
        if constexpr (!Epi::AFTER_DRAIN) { E(acc, cur, wr, wc, fr, fq); S.done(cur); }
        if (!has_next) break;
#pragma unroll
        for (int a = 0; a < 2; ++a)
#pragma unroll
            for (int b = 0; b < 2; ++b)
#pragma unroll
                for (int m = 0; m < 4; ++m)
#pragma unroll
                    for (int n = 0; n < 2; ++n) acc[a][b][m][n] = (f32x4){0.f, 0.f, 0.f, 0.f};
        cur = nxt; cA = nA; cB = nB; ++ui;
        if constexpr (ALIGN_EPI) { if (wr == 1) PG8_BAR; }
    }
    PG8_WAIT_V(0);
    if constexpr (!ALIGN_EPI) { if (wr == 0) PG8_BAR; }
    PG8_BAR;
    if constexpr (Epi::AFTER_DRAIN) { E.fused(acc, cur, wr, wc, fr, fq, lds, wid, lane); S.done(cur); }
#undef PG8_SA
#undef PG8_SB
#undef PG8_STAGE
#undef PG8_LDA
#undef PG8_LDB
#undef PG8_MMA
#undef PG8_WAIT_V
#undef PG8_WAIT_L
#undef PG8_BAR
#undef PG8_SCHED
}
}

typedef unsigned short bf16_t;
typedef short bf16x8 __attribute__((ext_vector_type(8)));
typedef float f32x4 __attribute__((ext_vector_type(4)));
typedef float f32x16 __attribute__((ext_vector_type(16)));
typedef unsigned u32x4 __attribute__((ext_vector_type(4)));
typedef unsigned u32x2 __attribute__((ext_vector_type(2)));
#define LAS __attribute__((address_space(3)))
__device__ __forceinline__ int opaque_tid() { int t = threadIdx.x; asm volatile("" : "+v"(t)); return t; }

constexpr int DM = 1024, NBATCH = 4, SEQ = 8192, NTOK = NBATCH * SEQ, CTXL = 256, NCTX = NBATCH * CTXL, MROWS = NTOK + NCTX;
constexpr int PW = 2816;
constexpr int C_Q = 0, C_K = 512, C_V = 640, C_GA = 768, C_UF = 1280, C_GF = 1536, C_ZC = 1792, C_BC = 2048, C_CC = 2304, C_GC = 2560;
constexpr int VT_PITCH = SEQ + CTXL;
constexpr float NORM_EPS = 1e-6f;
constexpr float LOG2E = 1.4426950408889634f;

constexpr size_t KiB = 1024, MiB = 1u << 20;
constexpr size_t WS_CTL = 0;
constexpr size_t WS_BAR = 16 * KiB;
constexpr size_t WS_ZERO_BYTES = 32 * KiB;
constexpr size_t WS_MOD = 64 * KiB;
constexpr size_t WS_ROPE = 256 * KiB;
constexpr size_t WS_TW = 320 * KiB;
constexpr size_t WS_T1R = 384 * KiB, WS_T1I = 416 * KiB;
constexpr size_t WS_T3R = 448 * KiB, WS_T3I = 464 * KiB;
constexpr size_t WS_T256R = 512 * KiB, WS_T256I = 640 * KiB;
constexpr size_t WS_GT = 768 * KiB;
constexpr size_t WS_SSQ = 1 * MiB;
constexpr size_t WS_WIN = 4 * MiB;
constexpr size_t WS_WOUT = 16 * MiB;
constexpr size_t WS_SSQ1 = 24 * MiB;
constexpr size_t WS_MODP = 28 * MiB;
constexpr size_t WS_HX = 32 * MiB;
constexpr size_t WS_P = 112 * MiB;
constexpr size_t WS_VT = 304 * MiB;
constexpr size_t WS_H = 320 * MiB;
constexpr size_t WS_Y = 392 * MiB;
constexpr size_t WS_YF = 464 * MiB;
constexpr size_t WS_CTX1 = 100 * MiB;
constexpr size_t WS_UFP = 496 * MiB;
constexpr size_t WS_END = 512 * MiB;
static_assert(WS_BAR + 3456 * 4 <= WS_ZERO_BYTES && WS_MODP + (size_t)2 * 8 * 5 * 3072 * 4 <= WS_HX && WS_SSQ + (size_t)MROWS * 16 * 4 <= WS_WIN && WS_WIN + (size_t)2 * PW * DM * 2 <= WS_WOUT && WS_HX + (size_t)MROWS * DM * 2 <= WS_P && WS_P + (size_t)MROWS * PW * 2 <= WS_VT &&
              WS_VT + (size_t)8 * 64 * VT_PITCH * 2 <= WS_H && WS_H + (size_t)MROWS * DM * 2 <= WS_Y && WS_Y + (size_t)MROWS * DM * 2 <= WS_YF && WS_YF + (size_t)4 * 128 * 64 * 512 * 2 <= WS_UFP && WS_UFP + (size_t)NTOK * 256 * 2 <= WS_END && WS_HX + (size_t)MROWS * DM * 2 <= WS_CTX1 && WS_CTX1 + (size_t)NCTX * DM * 4 <= WS_P, "ws map");

constexpr int LDS_BYTES = 147456;
constexpr int LDS_SCHED = LDS_BYTES - 64;
constexpr int LDS_BARST = LDS_BYTES - 32;
constexpr int NTHREADS = 512;

__device__ __forceinline__ float bf2f(unsigned h) { return __uint_as_float(h << 16); }
__device__ __forceinline__ unsigned pkbf(float lo, float hi) { unsigned r; asm volatile("v_cvt_pk_bf16_f32 %0, %1, %2" : "=v"(r) : "v"(lo), "v"(hi)); return r; }
__device__ __forceinline__ float silu_f(float x) { return x * __builtin_amdgcn_rcpf(1.f + __builtin_amdgcn_exp2f(-x * LOG2E)); }
__device__ __forceinline__ float wave_sum(float v) {
#pragma unroll
    for (int o = 1; o < 64; o <<= 1) v += __shfl_xor(v, o);
    return v;
}
__device__ __forceinline__ int swap23(int t) { return (t & ~12) | ((t & 4) << 1) | ((t & 8) >> 1); }
__device__ __forceinline__ int crow(int r, int hi) { return (r & 3) + 8 * (r >> 2) + 4 * hi; }
__device__ __forceinline__ bf16x8 pack8(const f32x16& p, int base) {
    u32x4 w; w.x = pkbf(p[base + 0], p[base + 1]); w.y = pkbf(p[base + 2], p[base + 3]); w.z = pkbf(p[base + 4], p[base + 5]); w.w = pkbf(p[base + 6], p[base + 7]);
    return __builtin_bit_cast(bf16x8, w);
}
#define MFMA32(a, b, c) __builtin_amdgcn_mfma_f32_32x32x16_bf16((a), (b), (c), 0, 0, 0)

struct KArgs {
    const float *x, *c, *ctx, *c_ctx, *w_mod, *b_mod, *g_pre, *g_post, *w_in, *w_out, *sink, *w_f, *conv_w, *conv_b;
    float* out; unsigned char* ws; int ph_lo, ph_hi;
};

__device__ __forceinline__ int prow_qk(int n) { return (n & ~31) | (8 * ((n >> 2) & 3) + 4 * ((n >> 4) & 1) + (n & 3)); }
__device__ __forceinline__ void p0_transpose_item(const float* W, int K, int N, bf16_t* WT, int nperm, float* scr, int item, int lane) {
    const int nblk = N / 32, kb = item / nblk, nb = item % nblk, k0 = 64 * kb, n0 = 32 * nb;
    { float wv[32];
#pragma unroll
      for (int i = 0; i < 32; ++i) wv[i] = __builtin_nontemporal_load(W + (size_t)(k0 + 2 * i + (lane >> 5)) * N + n0 + (lane & 31));
      __builtin_amdgcn_sched_barrier(0);
#pragma unroll
      for (int i = 0; i < 32; ++i) scr[(2 * i + (lane >> 5)) * 33 + (lane & 31)] = wv[i];
      __builtin_amdgcn_sched_barrier(0); }
    asm volatile("s_waitcnt lgkmcnt(0)" ::: "memory");
    const int c = lane & 7;
#pragma unroll
    for (int j = 0; j < 4; ++j) { const int n = (lane >> 3) + 8 * j; const float* s = scr + (8 * c) * 33 + n;
        u32x4 o; o.x = pkbf(s[0 * 33], s[1 * 33]); o.y = pkbf(s[2 * 33], s[3 * 33]); o.z = pkbf(s[4 * 33], s[5 * 33]); o.w = pkbf(s[6 * 33], s[7 * 33]);
        const int nl = n0 + n; const int np = nl < nperm ? prow_qk(nl) : nl;
        *(u32x4*)(WT + (size_t)np * K + k0 + 8 * c) = o; }
    asm volatile("s_waitcnt lgkmcnt(0)" ::: "memory");
}

__device__ __forceinline__ void p0_mod_gemv(const KArgs& a, int item, float* ldsf) {
    const int tid = opaque_tid(), lane = tid & 63, wave = tid >> 6;
    const int l = item / 96, col0 = (item % 96) * 32;
    float* s = ldsf;
    float* red = ldsf + 5 * 1024;
    for (int i = tid; i < 5 * 1024; i += NTHREADS) { const int bb = i >> 10, k = i & 1023; const float v = bb < 4 ? a.c[bb * 1024 + k] : a.c_ctx[k]; s[i] = v / (1.f + __expf(-v)); }
    __syncthreads();
    const int col = lane & 31, kh = lane >> 5;
    const float* W = a.w_mod + (size_t)l * 1024 * 3072 + (size_t)(wave * 128 + kh) * 3072 + col0 + col;
    float w[64];
#pragma unroll
    for (int i = 0; i < 64; ++i) w[i] = __builtin_nontemporal_load(W + (size_t)(2 * i) * 3072);
    float acc[5] = {0.f, 0.f, 0.f, 0.f, 0.f};
#pragma unroll
    for (int i = 0; i < 64; ++i)
#pragma unroll
        for (int bb = 0; bb < 5; ++bb) acc[bb] += w[i] * s[bb * 1024 + wave * 128 + 2 * i + kh];
#pragma unroll
    for (int bb = 0; bb < 5; ++bb) red[((wave * 2 + kh) * 5 + bb) * 32 + col] = acc[bb];
    __syncthreads();
    if (tid < 160) { const int bb = tid >> 5, cc = tid & 31; float v = a.b_mod[l * 3072 + col0 + cc];
#pragma unroll
        for (int ww = 0; ww < 16; ++ww) v += red[(ww * 5 + bb) * 32 + cc];
        ((float*)(a.ws + WS_MOD))[(l * 5 + bb) * 3072 + col0 + cc] = v; }
    __syncthreads();
}

__device__ __forceinline__ void p0_transposes(const KArgs& a, unsigned char* lds, int l, int gwi, int ngw, int lane, int wave) {
    float* scr = (float*)(lds + wave * 16384);
    unsigned char* ws = a.ws;
    constexpr int I_IN = (DM / 64) * (PW / 32), I_OUT = (DM / 64) * (DM / 32);
    for (int r = gwi; r < I_IN + I_OUT; r += ngw) {
        if (r < I_IN) p0_transpose_item(a.w_in + (size_t)l * DM * PW, DM, PW, (bf16_t*)(ws + WS_WIN) + (size_t)l * PW * DM, 640, scr, r, lane);
        else p0_transpose_item(a.w_out + (size_t)l * DM * DM, DM, DM, (bf16_t*)(ws + WS_WOUT) + (size_t)l * DM * DM, 0, scr, r - I_IN, lane);
    }
}
__device__ __forceinline__ void p0_gt(const KArgs& a, unsigned char* lds, int gt, int NGT) {
    const int tid = opaque_tid();
    unsigned char* ws = a.ws;
    {
        __syncthreads();
        float* trig = (float*)lds;
        if (tid < 64) { float sn, cs; sincospif((float)tid * (2.0f / 64.0f), &sn, &cs); trig[tid] = cs; trig[64 + tid] = sn; }
        __syncthreads();
        for (int i = gt; i < 2 * 4 * 64 * 128; i += NGT) {
            const int kk = i & 127, d = (i >> 7) & 63, g = (i >> 13) & 3, l = i >> 15; const int part = kk >> 6, c = swap23(kk & 63);
            const float* wf = a.w_f + ((size_t)(l * 4 + g) * 64) * 64 + d; float sacc = 0.f;
            float wfv[64];
#pragma unroll
            for (int j = 0; j < 64; ++j) wfv[j] = wf[j * 64];
            __builtin_amdgcn_sched_barrier(0);
#pragma unroll
            for (int j = 0; j < 64; ++j) sacc += trig[part * 64 + ((c * j) & 63)] * wfv[j];
            const int gpos = ((((((l * 4 + g) * 2 + (d >> 5)) * 8 + (kk >> 4)) * 64) + ((d & 31) + 32 * ((kk >> 3) & 1))) * 8) + (kk & 7);
            ((bf16_t*)(ws + WS_GT))[gpos] = (bf16_t)(pkbf(sacc * (1.0f / 724.0773439350246f), 0.f) & 0xffffu);
        }
        __syncthreads();
    }
}
__device__ __forceinline__ void p0_prologue(const KArgs& a, unsigned char* lds) {
    const int tid = opaque_tid(), lane = tid & 63, wave = tid >> 6;
    const int G = gridDim.x, bx = blockIdx.x;
    unsigned char* ws = a.ws;
    if (bx < 192) p0_mod_gemv(a, bx, (float*)lds);
    p0_transposes(a, lds, 0, bx * 8 + wave, G * 8, lane, wave);
    const int gt = bx * NTHREADS + tid, NGT = G * NTHREADS;
    for (int i = gt; i < 128 * 16; i += NGT) {
        const int pos = i >> 4, f = i & 15; const float inv = powf(10000.0f, -(float)f / 16.0f); const float ang = (float)pos * inv;
        float* rp = (float*)(ws + WS_ROPE) + pos * 32; rp[f] = cosf(ang); rp[16 + f] = sinf(ang);
    }
    for (int i = gt; i < 8192; i += NGT) { float sn, cs; sincospif((float)i * (2.0f / 8192.0f), &sn, &cs); float* t = (float*)(ws + WS_TW) + 2 * i; t[0] = cs; t[1] = sn; }
    for (int i = gt; i < 128 * 128; i += NGT) { const int k = i >> 7, n = i & 127; float sn, cs; sincospif((float)((k * n) & 127) * (2.0f / 128.0f), &sn, &cs);
        ((bf16_t*)(ws + WS_T1R))[i] = (bf16_t)(pkbf(cs, 0.f) & 0xffffu); ((bf16_t*)(ws + WS_T1I))[i] = (bf16_t)(pkbf(-sn, 0.f) & 0xffffu); }
    for (int i = gt; i < 64 * 128; i += NGT) { const int k = i >> 7, kk = i & 127, n = kk & 63; float sn, cs; sincospif((float)((k * n) & 63) * (2.0f / 64.0f), &sn, &cs);
        const float tr = kk < 64 ? cs : sn, ti = kk < 64 ? -sn : cs;
        const int fpos = ((((k >> 5) * 8 + (kk >> 4)) * 64 + ((k & 31) + 32 * ((kk >> 3) & 1))) * 8) + (kk & 7);
        ((bf16_t*)(ws + WS_T3R))[fpos] = (bf16_t)(pkbf(tr, 0.f) & 0xffffu); ((bf16_t*)(ws + WS_T3I))[fpos] = (bf16_t)(pkbf(ti, 0.f) & 0xffffu); }
    for (int i = gt; i < 256 * 256; i += NGT) { const int k = i >> 8, n = i & 255; float sn, cs; sincospif((float)((k * n) & 255) * (2.0f / 256.0f), &sn, &cs);
        ((bf16_t*)(ws + WS_T256R))[i] = (bf16_t)(pkbf(cs, 0.f) & 0xffffu); ((bf16_t*)(ws + WS_T256I))[i] = (bf16_t)(pkbf(-sn, 0.f) & 0xffffu); }
}

__device__ __forceinline__ void norm_rows4(int mode, int lane, const float* src, float* dst, const bf16_t* y0, const float* ssq0, const bf16_t* y1, const float* ssq1, bf16_t* hx,
                                           const f32x4 (&GA0)[4], const f32x4 (&GA1)[4], const f32x4 (&GB)[4], const f32x4 (&GC)[4]) {
    f32x4 v[4][4];
#pragma unroll
    for (int rr = 0; rr < 4; ++rr)
#pragma unroll
        for (int j = 0; j < 4; ++j) v[rr][j] = __builtin_nontemporal_load((const f32x4*)(src + (size_t)rr * DM + 4 * lane + 256 * j));
    if (mode != 0) {
        u32x2 yw[4][4], yx[4][4]; float p[4], p1[4];
#pragma unroll
        for (int rr = 0; rr < 4; ++rr) { p[rr] = ssq0[rr * 16 + (lane & 15)];
#pragma unroll
            for (int j = 0; j < 4; ++j) yw[rr][j] = __builtin_nontemporal_load((const u32x2*)(y0 + (size_t)rr * DM + 4 * lane + 256 * j)); }
        if (mode == 2) {
#pragma unroll
            for (int rr = 0; rr < 4; ++rr) { p1[rr] = ssq1[rr * 16 + (lane & 15)];
#pragma unroll
                for (int j = 0; j < 4; ++j) yx[rr][j] = __builtin_nontemporal_load((const u32x2*)(y1 + (size_t)rr * DM + 4 * lane + 256 * j)); }
        }
#pragma unroll
        for (int rr = 0; rr < 4; ++rr) {
            float q = p[rr]; q += __shfl_xor(q, 1); q += __shfl_xor(q, 2); q += __shfl_xor(q, 4); q += __shfl_xor(q, 8);
            const float rstd = 1.0f / sqrtf(q * (1.0f / DM) + NORM_EPS);
#pragma unroll
            for (int j = 0; j < 4; ++j) {
                f32x4 yy; yy[0] = bf2f(yw[rr][j].x & 0xffffu); yy[1] = bf2f(yw[rr][j].x >> 16); yy[2] = bf2f(yw[rr][j].y & 0xffffu); yy[3] = bf2f(yw[rr][j].y >> 16);
                v[rr][j] = v[rr][j] + GA0[j] * (yy * rstd);
            }
        }
        if (mode == 2) {
#pragma unroll
            for (int rr = 0; rr < 4; ++rr) {
                float q = p1[rr]; q += __shfl_xor(q, 1); q += __shfl_xor(q, 2); q += __shfl_xor(q, 4); q += __shfl_xor(q, 8);
                const float rstd = 1.0f / sqrtf(q * (1.0f / DM) + NORM_EPS);
#pragma unroll
                for (int j = 0; j < 4; ++j) {
                    f32x4 yy; yy[0] = bf2f(yx[rr][j].x & 0xffffu); yy[1] = bf2f(yx[rr][j].x >> 16); yy[2] = bf2f(yx[rr][j].y & 0xffffu); yy[3] = bf2f(yx[rr][j].y >> 16);
                    v[rr][j] = v[rr][j] + GA1[j] * (yy * rstd);
                    __builtin_nontemporal_store(v[rr][j], (f32x4*)(dst + (size_t)rr * DM + 4 * lane + 256 * j));
                }
            }
        }
    }
    if (mode != 2) {
        float s[4];
#pragma unroll
        for (int rr = 0; rr < 4; ++rr) { float t = 0.f;
#pragma unroll
            for (int j = 0; j < 4; ++j) t += (v[rr][j][0] * v[rr][j][0] + v[rr][j][1] * v[rr][j][1]) + (v[rr][j][2] * v[rr][j][2] + v[rr][j][3] * v[rr][j][3]);
            s[rr] = t; }
#pragma unroll
        for (int o = 1; o < 64; o <<= 1) {
#pragma unroll
            for (int rr = 0; rr < 4; ++rr) s[rr] += __shfl_xor(s[rr], o); }
#pragma unroll
        for (int rr = 0; rr < 4; ++rr) {
            const float rstd = 1.0f / sqrtf(s[rr] * (1.0f / DM) + NORM_EPS);
#pragma unroll
            for (int j = 0; j < 4; ++j) {
                const f32x4 o = (v[rr][j] * rstd) * GB[j] + GC[j];
                u32x2 w; w.x = pkbf(o[0], o[1]); w.y = pkbf(o[2], o[3]);
                *(u32x2*)(hx + (size_t)rr * DM + 4 * lane + 256 * j) = w;
            }
        }
    }
}
__device__ __forceinline__ void norm_phase(const KArgs& a, int mode) {
    const int tid = opaque_tid(), lane = tid & 63, wave = tid >> 6;
    const int NGW = gridDim.x * 8;
    unsigned char* ws = a.ws;
    const float* mod = (const float*)(ws + WS_MOD);
    const int lp = (mode == 0) ? 0 : 1;
    bf16_t* HX = (bf16_t*)(ws + WS_HX); const bf16_t* Y0 = (const bf16_t*)(ws + WS_Y); const float* SSQ0 = (const float*)(ws + WS_SSQ);
    const bf16_t* Y1 = (const bf16_t*)(ws + WS_HX); const float* SSQ1 = (const float*)(ws + WS_SSQ1);
    const int gw2 = wave * (int)gridDim.x + (int)blockIdx.x;
    const int nlat = NTOK / 4;
    int curb = -1; f32x4 GA0[4], GA1[4], GB[4], GC[4];
    int base = gw2 * 4, sub = 0, itc = nlat + gw2; bool inctx = false;
    for (;;) {
        int it;
        if (!inctx) { if (base >= nlat) { inctx = true; continue; } it = base + sub; if (++sub == 4) { sub = 0; base += NGW * 4; } }
        else { if (mode == 2 || itc >= nlat + NCTX / 4) break; it = itc; itc += NGW; }
        const int r = it * 4;
        const int b = r < NTOK ? (r >> 13) : 4;
        if (b != curb) { curb = b;
            const float* mp = mod + (lp * 5 + b) * 3072; const float* m0 = mod + (0 * 5 + b) * 3072; const float* m1 = mod + (1 * 5 + b) * 3072;
#pragma unroll
            for (int j = 0; j < 4; ++j) { const int c = 4 * lane + 256 * j;
                GA0[j] = *(const f32x4*)(m0 + 2048 + c) * *(const f32x4*)(a.g_post + c);
                GA1[j] = *(const f32x4*)(m1 + 2048 + c) * *(const f32x4*)(a.g_post + DM + c);
                GB[j] = *(const f32x4*)(a.g_pre + lp * DM + c) * (*(const f32x4*)(mp + 1024 + c) + 1.0f);
                GC[j] = *(const f32x4*)(mp + c); } }
        const float* src = (r < NTOK) ? a.x + (size_t)r * DM : a.ctx + (size_t)(r - NTOK) * DM;
        norm_rows4(mode, lane, src, a.out + (size_t)r * DM, Y0 + (size_t)r * DM, SSQ0 + (size_t)r * 16, Y1 + (size_t)r * DM, SSQ1 + (size_t)r * 16, HX + (size_t)r * DM, GA0, GA1, GB, GC);
    }
}

typedef short v4i16_t __attribute__((ext_vector_type(4)));
__device__ __forceinline__ v4i16_t trrd(const unsigned char* p) { return __builtin_amdgcn_ds_read_tr16_b64_v4i16((LAS v4i16_t*)p); }
__device__ __forceinline__ bf16x8 cat8(v4i16_t lo, v4i16_t hi) { return (bf16x8){lo[0], lo[1], lo[2], lo[3], hi[0], hi[1], hi[2], hi[3]}; }
__device__ __forceinline__ void attn_unit(int u, const bf16_t* P, const bf16_t* Vt, bf16_t* H, const float* sink, unsigned char* lds) {
    const int tid = opaque_tid(), lane = tid & 63, wave = __builtin_amdgcn_readfirstlane(tid >> 6), r32 = lane & 31, hi = lane >> 5;
    const bool isctx = u >= 1024;
    int b, kvh, qb;
    if (isctx) { const int v = u - 1024; b = v >> 3; kvh = (v >> 2) & 1; qb = v & 3; } else { b = u >> 8; kvh = (u >> 7) & 1; qb = u & 127; }
    const int head = kvh * 4 + (wave >> 1);
    const int qtok = qb * 64 + (wave & 1) * 32 + r32;
    const size_t qrow = isctx ? (size_t)(NTOK + b * CTXL + qtok) : (size_t)(b * SEQ + qtok);
    const float sinkv = sink[head];
    unsigned char* qscr = lds + 45056 + wave * 4608;
    u32x4 qld[4];
#pragma unroll
    for (int i4 = 0; i4 < 4; ++i4) qld[i4] = __builtin_nontemporal_load((const u32x4*)(P + (qrow - r32 + i4 * 8 + (lane >> 3)) * PW + C_Q + head * 64 + (lane & 7) * 8));
    int jlo = 0, jhi = -1;
    if (!isctx) { jlo = qb < 2 ? 2 - qb : 0; jhi = (129 - qb) < 4 ? (129 - qb) : 4; }
    const int ntiles = 4 + (jhi - jlo + 1);
    const int srow = tid >> 3, sch = tid & 7;
    const bf16_t* Kc = P + (size_t)(NTOK + b * CTXL + srow) * PW + C_K + kvh * 64 + sch * 8;
    const bf16_t* Kl = P + (size_t)(b * SEQ + srow) * PW + C_K + kvh * 64 + sch * 8;
    unsigned char* Ks = lds; unsigned char* Vs = lds + 2 * 9216;
    const int vsoff = srow * 192 + sch * 16;
    const int soff = srow * 144 + sch * 16;
    u32x4 kreg, vreg, kreg2, vreg2;
#define ATT_GLOAD(KR, VR, ti_) do { const int t_ = (ti_); \
        if (t_ < 4) { KR = *(const u32x4*)(Kc + (size_t)(64 * t_) * PW); VR = *(const u32x4*)(Kc + (size_t)(64 * t_) * PW + 128); } \
        else { const int kbase_ = qb * 64 - 128 + 64 * (jlo + t_ - 4); KR = *(const u32x4*)(Kl + (size_t)kbase_ * PW); VR = *(const u32x4*)(Kl + (size_t)kbase_ * PW + 128); } } while (0)
    const size_t qrow0 = qrow - r32;
    u32x4 gaw[4];
#pragma unroll
    for (int i4 = 0; i4 < 4; ++i4) gaw[i4] = __builtin_nontemporal_load((const u32x4*)(P + (qrow0 + i4 * 8 + (lane >> 3)) * PW + C_GA + head * 64 + (lane & 7) * 8));
    ATT_GLOAD(kreg2, vreg2, 0);
    ATT_GLOAD(kreg, vreg, 1);
#pragma unroll
    for (int i4 = 0; i4 < 4; ++i4) *(u32x4*)(qscr + (i4 * 8 + (lane >> 3)) * 144 + (lane & 7) * 16) = qld[i4];
    *(u32x4*)(Ks + soff) = kreg2; *(u32x4*)(Vs + vsoff) = vreg2;
    __syncthreads();
    bf16x8 qf[4];
#pragma unroll
    for (int d0 = 0; d0 < 4; ++d0) qf[d0] = *(const bf16x8*)(qscr + r32 * 144 + (2 * d0 + hi) * 16);
    const float sink2 = sinkv * LOG2E;
    float mref = sink2, lsum = 0.f;
    f32x16 oT[2]; oT[0] = f32x16{}; oT[1] = f32x16{};
    const int qpos = qtok;
    for (int ti = 0; ti < ntiles; ++ti) {
        const int buf = ti & 1;
        if (ti + 2 < ntiles) ATT_GLOAD(kreg2, vreg2, ti + 2);
        const unsigned char* kb = Ks + buf * 9216 + r32 * 144 + hi * 16;
        const unsigned char* vb = Vs + buf * 12288 + (4 * hi + ((lane & 15) >> 2)) * 192 + (16 * ((lane >> 4) & 1) + 4 * (lane & 3)) * 2;
        bf16x8 kf[8];
#pragma unroll
        for (int d0 = 0; d0 < 4; ++d0) { kf[2 * d0] = *(const bf16x8*)(kb + d0 * 32); kf[2 * d0 + 1] = *(const bf16x8*)(kb + 32 * 144 + d0 * 32); }
        f32x16 p0, p1;
#pragma unroll
        for (int r = 0; r < 16; ++r) { p0[r] = -mref; p1[r] = -mref; }
        __builtin_amdgcn_sched_barrier(0);
#pragma unroll
        for (int d0 = 0; d0 < 4; ++d0) { p0 = MFMA32(kf[2 * d0], qf[d0], p0); p1 = MFMA32(kf[2 * d0 + 1], qf[d0], p1); }
        bf16x8 vf[8];
#pragma unroll
        for (int blk = 0; blk < 2; ++blk)
#pragma unroll
            for (int ks = 0; ks < 4; ++ks) vf[blk * 4 + ks] = cat8(trrd(vb + (16 * ks) * 192 + blk * 64), trrd(vb + (16 * ks + 8) * 192 + blk * 64));
        __builtin_amdgcn_sched_barrier(0);
        asm volatile("s_nop 15\n\ts_nop 7" : "+v"(p0), "+v"(p1));
        if (ti >= 4) {
            const int j = jlo + ti - 4; const int kbase = qb * 64 - 128 + 64 * j;
            if (j == 0) {
#pragma unroll
                for (int r = 0; r < 16; ++r) { const int kp = kbase + crow(r, hi); if (kp < qpos - 128) p0[r] = -INFINITY; if (kp + 32 < qpos - 128) p1[r] = -INFINITY; }
            } else if (j == 4) {
#pragma unroll
                for (int r = 0; r < 16; ++r) { const int kp = kbase + crow(r, hi); if (kp > qpos + 128) p0[r] = -INFINITY; if (kp + 32 > qpos + 128) p1[r] = -INFINITY; }
            }
        }
        float rma, rmb;
        asm("v_max3_f32 %0, %1, %2, %3" : "=v"(rma) : "v"(p0[0]), "v"(p0[1]), "v"(p1[0]));
        asm("v_max3_f32 %0, %1, %2, %3" : "=v"(rmb) : "v"(p0[2]), "v"(p0[3]), "v"(p1[1]));
        asm("v_max3_f32 %0, %1, %2, %3" : "=v"(rma) : "v"(rma), "v"(p1[2]), "v"(p1[3]));
#pragma unroll
        for (int r = 4; r < 16; r += 4) {
            asm("v_max3_f32 %0, %1, %2, %3" : "=v"(rma) : "v"(rma), "v"(p0[r]), "v"(p0[r + 1]));
            asm("v_max3_f32 %0, %1, %2, %3" : "=v"(rmb) : "v"(rmb), "v"(p0[r + 2]), "v"(p0[r + 3]));
            asm("v_max3_f32 %0, %1, %2, %3" : "=v"(rma) : "v"(rma), "v"(p1[r]), "v"(p1[r + 1]));
            asm("v_max3_f32 %0, %1, %2, %3" : "=v"(rmb) : "v"(rmb), "v"(p1[r + 2]), "v"(p1[r + 3]));
        }
        float rm; asm("v_max3_f32 %0, %1, %2, %3" : "=v"(rm) : "v"(rma), "v"(rmb), "v"(rmb));
        { const float rmo = __shfl_xor(rm, 32); asm("v_max3_f32 %0, %1, %2, %3" : "=v"(rm) : "v"(rm), "v"(rmo), "v"(rmo)); }
        if (__any(rm > 8.0f)) {
            const float dl = fmaxf(rm, 0.f);
            mref += dl;
            const float f = __builtin_amdgcn_exp2f(-dl);
            lsum *= f;
#pragma unroll
            for (int r = 0; r < 16; ++r) { p0[r] -= dl; p1[r] -= dl; oT[0][r] *= f; oT[1][r] *= f; }
        }
        float ls = 0.f;
#pragma unroll
        for (int r = 0; r < 16; ++r) { p0[r] = __builtin_amdgcn_exp2f(p0[r]); p1[r] = __builtin_amdgcn_exp2f(p1[r]); ls += p0[r] + p1[r]; }
        lsum += ls;
        bf16x8 pf[4]; pf[0] = pack8(p0, 0); pf[1] = pack8(p0, 8); pf[2] = pack8(p1, 0); pf[3] = pack8(p1, 8);
#pragma unroll
        for (int blk = 0; blk < 2; ++blk)
#pragma unroll
            for (int ks = 0; ks < 4; ++ks) oT[blk] = MFMA32(vf[blk * 4 + ks], pf[ks], oT[blk]);
        if (ti + 1 < ntiles) { *(u32x4*)(Ks + (buf ^ 1) * 9216 + soff) = kreg; *(u32x4*)(Vs + (buf ^ 1) * 12288 + vsoff) = vreg; }
        kreg = kreg2; vreg = vreg2;
        __syncthreads();
    }
    lsum += __shfl_xor(lsum, 32);
    lsum += __builtin_amdgcn_exp2f(sink2 - mref);
    const float inv = 1.0f / lsum;
    unsigned char* ow = qscr;
#pragma unroll
    for (int blk = 0; blk < 2; ++blk)
#pragma unroll
        for (int g4 = 0; g4 < 4; ++g4) {
            u32x2 w; w.x = pkbf(oT[blk][4 * g4 + 0] * inv, oT[blk][4 * g4 + 1] * inv); w.y = pkbf(oT[blk][4 * g4 + 2] * inv, oT[blk][4 * g4 + 3] * inv);
            *(u32x2*)(ow + r32 * 144 + (32 * blk + 8 * g4 + 4 * hi) * 2) = w;
        }
    asm volatile("s_waitcnt lgkmcnt(0)" ::: "memory");
#pragma unroll
    for (int i4 = 0; i4 < 4; ++i4) {
        const int rr = i4 * 8 + (lane >> 3), ch = lane & 7;
        const u32x4 ov = *(const u32x4*)(ow + rr * 144 + ch * 16);
        const unsigned ovv[4] = {ov.x, ov.y, ov.z, ov.w}, gvv[4] = {gaw[i4].x, gaw[i4].y, gaw[i4].z, gaw[i4].w};
        u32x4 w;
        unsigned wv[4];
#pragma unroll
        for (int e = 0; e < 4; ++e) wv[e] = pkbf(bf2f(ovv[e] & 0xffffu) * silu_f(bf2f(gvv[e] & 0xffffu)), bf2f(ovv[e] >> 16) * silu_f(bf2f(gvv[e] >> 16)));
        w.x = wv[0]; w.y = wv[1]; w.z = wv[2]; w.w = wv[3];
        *(u32x4*)(H + (qrow0 + rr) * DM + head * 64 + ch * 8) = w;
    }
    asm volatile("s_waitcnt lgkmcnt(0)" ::: "memory");
}

__device__ __forceinline__ void fft1_unit(int u, const bf16_t* P, bf16_t* YF, const unsigned char* ws, unsigned char* lds) {
    const int tid = opaque_tid(), lane = tid & 63, wave = __builtin_amdgcn_readfirstlane(tid >> 6), r32 = lane & 31, hi = lane >> 5;
    const int b = u >> 6, n2 = u & 63;
    constexpr int UPB = 576;
    const bf16_t* src = P + (size_t)(b * SEQ + n2) * PW + C_UF;
#pragma unroll
    for (int i = 0; i < 8; ++i) {
        const int id = tid + NTHREADS * i, n1 = id >> 5, cc = id & 31;
        *(u32x4*)(lds + n1 * UPB + cc * 16) = *(const u32x4*)(src + (size_t)n1 * 64 * PW + cc * 8);
    }
    __syncthreads();
    const bf16_t* T1R = (const bf16_t*)(ws + WS_T1R); const bf16_t* T1I = (const bf16_t*)(ws + WS_T1I);
    f32x16 aR[4], aI[4];
#pragma unroll
    for (int kb = 0; kb < 4; ++kb) { aR[kb] = f32x16{}; aI[kb] = f32x16{}; }
    const unsigned char* ap = lds + (8 * hi + ((lane & 15) >> 2)) * UPB + (32 * wave + 16 * ((lane >> 4) & 1) + 4 * (lane & 3)) * 2;
#pragma unroll 2
    for (int ks = 0; ks < 8; ++ks) {
        const bf16x8 av = cat8(trrd(ap + (16 * ks) * UPB), trrd(ap + (16 * ks + 4) * UPB));
#pragma unroll
        for (int kb = 0; kb < 4; ++kb) {
            const bf16x8 bR = *(const bf16x8*)(T1R + (32 * kb + r32) * 128 + 16 * ks + 8 * hi), bI = *(const bf16x8*)(T1I + (32 * kb + r32) * 128 + 16 * ks + 8 * hi);
            aR[kb] = MFMA32(av, bR, aR[kb]); aI[kb] = MFMA32(av, bI, aI[kb]);
        }
    }
    const float* TW = (const float*)(ws + WS_TW);
#pragma unroll
    for (int kb = 0; kb < 4; ++kb) {
        const int k1 = 32 * kb + r32;
        const float ct = TW[2 * (n2 * k1)], st = TW[2 * (n2 * k1) + 1];
        bf16_t* yp = YF + ((size_t)((b * 128 + k1) * 64 + n2)) * 512 + 32 * wave + 4 * hi;
#pragma unroll
        for (int g4 = 0; g4 < 4; ++g4) {
            float yr[4], yi[4];
#pragma unroll
            for (int e = 0; e < 4; ++e) { const float r_ = aR[kb][4 * g4 + e], i_ = aI[kb][4 * g4 + e]; yr[e] = r_ * ct + i_ * st; yi[e] = i_ * ct - r_ * st; }
            u32x2 wr_, wi_; wr_.x = pkbf(yr[0], yr[1]); wr_.y = pkbf(yr[2], yr[3]); wi_.x = pkbf(yi[0], yi[1]); wi_.y = pkbf(yi[2], yi[3]);
            *(u32x2*)(yp + 8 * g4) = wr_; *(u32x2*)(yp + 256 + 8 * g4) = wi_;
        }
    }
    __syncthreads();
}

template <int KK>
__device__ __forceinline__ void dftf_unit(const bf16_t* srcbase, int R, int pitchA, int pitchB, const bf16_t* Tr, const bf16_t* Ti, const bf16_t* Gt,
                                          const bf16_t* P, bf16_t* H, size_t row0, int rowstride, float oscale, unsigned char* lds) {
    const int tid = opaque_tid(), lane = tid & 63, wave = __builtin_amdgcn_readfirstlane(tid >> 6), r32 = lane & 31, hi = lane >> 5;
    constexpr int ZPB = (KK == 128) ? 576 : 544;
#pragma unroll 1
    for (int i0 = 0; i0 < KK / 16; i0 += 8) {
        u32x4 img[8];
#pragma unroll
        for (int i = 0; i < 8; ++i) { const int id = tid + NTHREADS * (i0 + i), kk = id >> 5, cc = id & 31; img[i] = *(const u32x4*)(srcbase + (size_t)(kk % R) * pitchA + (size_t)(kk / R) * pitchB + cc * 8); }
        __builtin_amdgcn_sched_barrier(0);
#pragma unroll
        for (int i = 0; i < 8; ++i) { const int id = tid + NTHREADS * (i0 + i), kk = id >> 5, cc = id & 31; *(u32x4*)(lds + kk * ZPB + cc * 16) = img[i]; }
        __builtin_amdgcn_sched_barrier(0);
    }
    __syncthreads();
    const int g = wave >> 1, kblk = wave & 1;
    f32x16 XR[2], XI[2];
#pragma unroll
    for (int cb = 0; cb < 2; ++cb) { XR[cb] = f32x16{}; XI[cb] = f32x16{}; }
    const bf16_t* trp = Tr + (size_t)(32 * kblk + r32) * KK + 8 * hi; const bf16_t* tip = Ti + (size_t)(32 * kblk + r32) * KK + 8 * hi;
    const unsigned char* zp = lds + (8 * hi + ((lane & 15) >> 2)) * ZPB + (64 * g + 16 * ((lane >> 4) & 1) + 4 * (lane & 3)) * 2;
#pragma unroll 2
    for (int ks = 0; ks < KK / 16; ++ks) {
        const bf16x8 bR = *(const bf16x8*)(trp + 16 * ks), bI = *(const bf16x8*)(tip + 16 * ks);
#pragma unroll
        for (int cb = 0; cb < 2; ++cb) { const bf16x8 av = cat8(trrd(zp + (16 * ks) * ZPB + cb * 64), trrd(zp + (16 * ks + 4) * ZPB + cb * 64)); XR[cb] = MFMA32(av, bR, XR[cb]); XI[cb] = MFMA32(av, bI, XI[cb]); }
    }
    f32x16 oa[2]; oa[0] = f32x16{}; oa[1] = f32x16{};
    const bf16_t* gp = Gt + (size_t)(g * 2 * 8 * 64 + lane) * 8;
    u32x2 gfw[8];
    { const size_t rowg = row0 + (size_t)(32 * kblk + r32) * rowstride;
#pragma unroll
      for (int i8 = 0; i8 < 8; ++i8) gfw[i8] = *(const u32x2*)(P + rowg * PW + C_GF + 64 * g + 32 * (i8 >> 2) + 8 * (i8 & 3) + 4 * hi); }
#pragma unroll
    for (int part = 0; part < 2; ++part)
#pragma unroll
        for (int cb = 0; cb < 2; ++cb)
#pragma unroll
            for (int s = 0; s < 2; ++s) {
                const bf16x8 bx = pack8(part ? XI[cb] : XR[cb], 8 * s);
                const int kko = part * 64 + 32 * cb + 16 * s;
#pragma unroll
                for (int lb = 0; lb < 2; ++lb) { const bf16x8 ag = *(const bf16x8*)(gp + (size_t)((lb * 8 + (kko >> 4)) * 64) * 8); oa[lb] = MFMA32(ag, bx, oa[lb]); }
            }
    const int k2 = 32 * kblk + r32;
    const size_t row = row0 + (size_t)k2 * rowstride;
    const bf16_t* gfrow = P + row * PW + C_GF + 64 * g;
    bf16_t* hrow = H + row * DM + 512 + 64 * g;
#pragma unroll
    for (int lb = 0; lb < 2; ++lb)
#pragma unroll
        for (int g4 = 0; g4 < 4; ++g4) {
            const int l0 = 32 * lb + 8 * g4 + 4 * hi;
            const u32x2 gw = gfw[lb * 4 + g4];
            const float o0 = oa[lb][4 * g4 + 0] * oscale * silu_f(bf2f(gw.x & 0xffffu)), o1 = oa[lb][4 * g4 + 1] * oscale * silu_f(bf2f(gw.x >> 16));
            const float o2 = oa[lb][4 * g4 + 2] * oscale * silu_f(bf2f(gw.y & 0xffffu)), o3 = oa[lb][4 * g4 + 3] * oscale * silu_f(bf2f(gw.y >> 16));
            u32x2 w; w.x = pkbf(o0, o1); w.y = pkbf(o2, o3);
            *(u32x2*)(hrow + l0) = w;
        }
    __syncthreads();
}

__device__ __forceinline__ void conv_unit(int u, const bf16_t* P, bf16_t* H, const float* cw, const float* cb) {
    const int tid = opaque_tid(), cgp = tid & 31, rg = tid >> 5;
    const int ch0 = cgp * 8;
    const int r0 = u * 64 + rg * 4;
    int pos, len; if (r0 < NTOK) { pos = r0 & (SEQ - 1); len = SEQ; } else { pos = (r0 - NTOK) & (CTXL - 1); len = CTXL; }
    float w0[8], w1[8], w2[8], bs[8];
#pragma unroll
    for (int e = 0; e < 8; ++e) { w0[e] = cw[ch0 + e]; w1[e] = cw[256 + ch0 + e]; w2[e] = cw[512 + ch0 + e]; bs[e] = cb[ch0 + e]; }
    float T[6][8];
#pragma unroll
    for (int i = 0; i < 6; ++i) {
        const int p = pos - 1 + i;
        if (p >= 0 && p < len) {
            const size_t row = (size_t)(r0 - 1 + i);
            const u32x4 z = *(const u32x4*)(P + row * PW + C_ZC + ch0), c = *(const u32x4*)(P + row * PW + C_CC + ch0);
            T[i][0] = bf2f(z.x & 0xffffu) * bf2f(c.x & 0xffffu); T[i][1] = bf2f(z.x >> 16) * bf2f(c.x >> 16);
            T[i][2] = bf2f(z.y & 0xffffu) * bf2f(c.y & 0xffffu); T[i][3] = bf2f(z.y >> 16) * bf2f(c.y >> 16);
            T[i][4] = bf2f(z.z & 0xffffu) * bf2f(c.z & 0xffffu); T[i][5] = bf2f(z.z >> 16) * bf2f(c.z >> 16);
            T[i][6] = bf2f(z.w & 0xffffu) * bf2f(c.w & 0xffffu); T[i][7] = bf2f(z.w >> 16) * bf2f(c.w >> 16);
        } else {
#pragma unroll
            for (int e = 0; e < 8; ++e) T[i][e] = 0.f;
        }
    }
#pragma unroll
    for (int i = 0; i < 4; ++i) {
        const size_t row = (size_t)(r0 + i);
        const u32x4 bw = *(const u32x4*)(P + row * PW + C_BC + ch0), gw = *(const u32x4*)(P + row * PW + C_GC + ch0);
        const unsigned bwv[4] = {bw.x, bw.y, bw.z, bw.w}, gwv[4] = {gw.x, gw.y, gw.z, gw.w};
        float o[8];
#pragma unroll
        for (int e = 0; e < 8; ++e) {
            const float bv = (e & 1) ? bf2f(bwv[e >> 1] >> 16) : bf2f(bwv[e >> 1] & 0xffffu);
            const float gv = (e & 1) ? bf2f(gwv[e >> 1] >> 16) : bf2f(gwv[e >> 1] & 0xffffu);
            const float y = T[i][e] * w0[e] + T[i + 1][e] * w1[e] + T[i + 2][e] * w2[e] + bs[e];
            o[e] = bv * y * silu_f(gv);
        }
        u32x4 w; w.x = pkbf(o[0], o[1]); w.y = pkbf(o[2], o[3]); w.z = pkbf(o[4], o[5]); w.w = pkbf(o[6], o[7]);
        *(u32x4*)(H + row * DM + 768 + ch0) = w;
    }
}

__device__ __forceinline__ void fft1_tables(const unsigned char* ws, unsigned char* tbl, int tid) {
    u32x4 tv[8];
#pragma unroll
    for (int i = 0; i < 8; ++i) { const int id = tid + NTHREADS * i, t = id >> 11, row = (id >> 4) & 127, ch = id & 15; tv[i] = *(const u32x4*)(ws + (t ? WS_T1I : WS_T1R) + row * 256 + ch * 16); }
    __builtin_amdgcn_sched_barrier(0);
#pragma unroll
    for (int i = 0; i < 8; ++i) { const int id = tid + NTHREADS * i, t = id >> 11, row = (id >> 4) & 127, ch = id & 15; *(u32x4*)(tbl + t * 34816 + row * 272 + ch * 16) = tv[i]; }
}
__device__ __forceinline__ void fft1_wave(int task, const bf16_t* P, bf16_t* YF, const unsigned char* ws, unsigned char* lds_w, const unsigned char* tbl, int lane, int pmode = 0) {
    const int r32 = lane & 31, hi = lane >> 5;
    const int cblk = task & 7, n2 = (task >> 3) & 63, b = task >> 9;
    const bf16_t* src = P + (size_t)((b * 64 + n2) * 128) * 256 + 32 * cblk + 8 * (lane & 3);
    { u32x4 img[8];
#pragma unroll
      for (int i = 0; i < 8; ++i) img[i] = __builtin_nontemporal_load((const u32x4*)(src + (size_t)(16 * i + (lane >> 2)) * 256));
      __builtin_amdgcn_sched_barrier(0);
#pragma unroll
      for (int i = 0; i < 8; ++i) *(u32x4*)(lds_w + (16 * i + (lane >> 2)) * 64 + (lane & 3) * 16) = img[i];
      __builtin_amdgcn_sched_barrier(0); }
    asm volatile("s_waitcnt vmcnt(0) lgkmcnt(0)" ::: "memory");
    if (pmode == 2) return;
    const bf16_t* T1R = (const bf16_t*)(ws + WS_T1R); const bf16_t* T1I = (const bf16_t*)(ws + WS_T1I);
    f32x16 aR[4], aI[4];
#pragma unroll
    for (int kb = 0; kb < 4; ++kb) { aR[kb] = f32x16{}; aI[kb] = f32x16{}; }
    const unsigned char* ap = lds_w + (8 * hi + ((lane & 15) >> 2)) * 64 + (16 * ((lane >> 4) & 1) + 4 * (lane & 3)) * 2;
    const unsigned char* tb = tbl + r32 * 272 + hi * 16;
#pragma unroll 2
    for (int ks = 0; ks < 8; ++ks) {
        const bf16x8 av = cat8(trrd(ap + (16 * ks) * 64), trrd(ap + (16 * ks + 4) * 64));
        bf16x8 bq[8];
#pragma unroll
        for (int kb = 0; kb < 4; ++kb) { bq[2 * kb] = *(const bf16x8*)(tb + (32 * kb) * 272 + 32 * ks); bq[2 * kb + 1] = *(const bf16x8*)(tb + 34816 + (32 * kb) * 272 + 32 * ks); }
#pragma unroll
        for (int kb = 0; kb < 4; ++kb) { aR[kb] = MFMA32(av, bq[2 * kb], aR[kb]); aI[kb] = MFMA32(av, bq[2 * kb + 1], aI[kb]); }
    }
    const float* TW = (const float*)(ws + WS_TW);
    float ctw[4], stw[4];
#pragma unroll
    for (int kb = 0; kb < 4; ++kb) { const int k1 = 32 * kb + r32; ctw[kb] = TW[2 * (n2 * k1)]; stw[kb] = TW[2 * (n2 * k1) + 1]; }
    asm volatile("s_waitcnt lgkmcnt(0)" ::: "memory");
#pragma unroll
    for (int pr = 0; pr < 2; ++pr) {
#pragma unroll
        for (int kq = 0; kq < 2; ++kq) {
            const int kb = 2 * pr + kq; const int rowl = 32 * kq + r32; const float ct = ctw[kb], st = stw[kb];
#pragma unroll
            for (int g4 = 0; g4 < 4; ++g4) {
                float yr[4], yi[4];
#pragma unroll
                for (int e = 0; e < 4; ++e) { const float r_ = aR[kb][4 * g4 + e], i_ = aI[kb][4 * g4 + e]; yr[e] = r_ * ct + i_ * st; yi[e] = i_ * ct - r_ * st; }
                u32x2 wr_, wi_; wr_.x = pkbf(yr[0], yr[1]); wr_.y = pkbf(yr[2], yr[3]); wi_.x = pkbf(yi[0], yi[1]); wi_.y = pkbf(yi[2], yi[3]);
                *(u32x2*)(lds_w + rowl * 128 + ((g4 ^ (rowl & 7)) * 16) + hi * 8) = wr_;
                *(u32x2*)(lds_w + rowl * 128 + (((4 + g4) ^ (rowl & 7)) * 16) + hi * 8) = wi_;
            }
        }
        asm volatile("s_waitcnt lgkmcnt(0)" ::: "memory");
#pragma unroll
        for (int i8 = 0; i8 < 8; ++i8) {
            const int rowl = i8 * 8 + (lane >> 3), ch = lane & 7;
            const u32x4 v = *(const u32x4*)(lds_w + rowl * 128 + ((ch ^ (rowl & 7)) * 16));
            const int k1 = 64 * pr + rowl;
            bf16_t* dst = YF + ((size_t)((b * 128 + k1) * 64 + n2)) * 512 + (ch >> 2) * 256 + 32 * cblk + 8 * (ch & 3);
            *(u32x4*)dst = v;
        }
        asm volatile("s_waitcnt lgkmcnt(0)" ::: "memory");
    }
}
__device__ __forceinline__ void fft3_wave(int task, const bf16_t* YF, const bf16_t* Gt, const bf16_t* P, bf16_t* H, const unsigned char* ws, unsigned char* lds_w, int lane) {
    const int r32 = lane & 31, hi = lane >> 5;
    const int g = task & 3, k1 = (task >> 2) & 127, b = task >> 9;
    const bf16_t* src = YF + ((size_t)(b * 128 + k1) * 64) * 512 + 64 * g + 8 * (lane & 7);
    { u32x4 img[16];
#pragma unroll
      for (int i = 0; i < 16; ++i) { const int kk = 8 * i + (lane >> 3); img[i] = __builtin_nontemporal_load((const u32x4*)(src + (size_t)(kk & 63) * 512 + (size_t)(kk >> 6) * 256)); }
      __builtin_amdgcn_sched_barrier(0);
#pragma unroll
      for (int i = 0; i < 16; ++i) { const int kk = 8 * i + (lane >> 3), ch = lane & 7; *(u32x4*)(lds_w + kk * 128 + ((ch ^ (((kk >> 1) & 1) << 2)) * 16)) = img[i]; }
      __builtin_amdgcn_sched_barrier(0); }
    asm volatile("s_waitcnt vmcnt(0) lgkmcnt(0)" ::: "memory");
    const bf16_t* T3R = (const bf16_t*)(ws + WS_T3R); const bf16_t* T3I = (const bf16_t*)(ws + WS_T3I);
    const int q = (lane & 15) >> 2, sw = (q >> 1) & 1;
    const int chl = 2 * ((lane >> 4) & 1) + ((lane & 3) >> 1);
    const unsigned char* zb = lds_w + (8 * hi + q) * 128 + 8 * (lane & 1);
    const unsigned char* zp0 = zb + ((chl ^ (sw << 2)) * 16);
    const unsigned char* zp1 = zb + (((4 + chl) ^ (sw << 2)) * 16);
    const bf16_t* gp = Gt + (size_t)(g * 2 * 8 * 64 + lane) * 8;
    const size_t rowb = (size_t)(b * SEQ + k1);
    u32x2 hwA[8], hwB[8];
#pragma unroll
    for (int i8 = 0; i8 < 8; ++i8) { hwA[i8] = (u32x2){0u, 0u}; hwB[i8] = (u32x2){0u, 0u}; }
#pragma unroll 1
    for (int kblk = 0; kblk < 2; ++kblk) {
        f32x16 XR[2], XI[2];
#pragma unroll
        for (int cb = 0; cb < 2; ++cb) { XR[cb] = f32x16{}; XI[cb] = f32x16{}; }
        const bf16_t* trp = T3R + (size_t)(kblk * 8 * 64 + lane) * 8; const bf16_t* tip = T3I + (size_t)(kblk * 8 * 64 + lane) * 8;
        const size_t rowg = rowb + (size_t)(32 * kblk + r32) * 128;
        u32x2 gfw[8];
#pragma unroll
        for (int i8 = 0; i8 < 8; ++i8) gfw[i8] = *(const u32x2*)(P + rowg * PW + C_GF + 64 * g + 32 * (i8 >> 2) + 8 * (i8 & 3) + 4 * hi);
        bf16x8 bR[8], bI[8];
#pragma unroll
        for (int ks = 0; ks < 8; ++ks) { bR[ks] = *(const bf16x8*)(trp + 512 * ks); bI[ks] = *(const bf16x8*)(tip + 512 * ks); }
        __builtin_amdgcn_sched_barrier(0);
#pragma unroll
        for (int ks = 0; ks < 8; ++ks) {
            const bf16x8 a0 = cat8(trrd(zp0 + (16 * ks) * 128), trrd(zp0 + (16 * ks + 4) * 128));
            const bf16x8 a1 = cat8(trrd(zp1 + (16 * ks) * 128), trrd(zp1 + (16 * ks + 4) * 128));
            XR[0] = MFMA32(a0, bR[ks], XR[0]); XI[0] = MFMA32(a0, bI[ks], XI[0]); XR[1] = MFMA32(a1, bR[ks], XR[1]); XI[1] = MFMA32(a1, bI[ks], XI[1]);
        }
        __builtin_amdgcn_sched_barrier(0);
        bf16x8 gfr[2][8];
#pragma unroll
        for (int lb = 0; lb < 2; ++lb)
#pragma unroll
            for (int q8 = 0; q8 < 8; ++q8) gfr[lb][q8] = *(const bf16x8*)(gp + (size_t)((lb * 8 + q8) * 64) * 8);
        __builtin_amdgcn_sched_barrier(0);
        f32x16 oa[2]; oa[0] = f32x16{}; oa[1] = f32x16{};
#pragma unroll
        for (int part = 0; part < 2; ++part)
#pragma unroll
            for (int cb = 0; cb < 2; ++cb)
#pragma unroll
                for (int s = 0; s < 2; ++s) {
                    const bf16x8 bx = pack8(part ? XI[cb] : XR[cb], 8 * s);
                    const int kko = part * 64 + 32 * cb + 16 * s;
#pragma unroll
                    for (int lb = 0; lb < 2; ++lb) oa[lb] = MFMA32(gfr[lb][kko >> 4], bx, oa[lb]);
                }
#pragma unroll
        for (int lb = 0; lb < 2; ++lb)
#pragma unroll
            for (int g4 = 0; g4 < 4; ++g4) {
                const u32x2 gw = gfw[lb * 4 + g4];
                const float o0 = oa[lb][4 * g4 + 0] * silu_f(bf2f(gw.x & 0xffffu)), o1 = oa[lb][4 * g4 + 1] * silu_f(bf2f(gw.x >> 16));
                const float o2 = oa[lb][4 * g4 + 2] * silu_f(bf2f(gw.y & 0xffffu)), o3 = oa[lb][4 * g4 + 3] * silu_f(bf2f(gw.y >> 16));
                u32x2 pk; pk.x = pkbf(o0, o1); pk.y = pkbf(o2, o3);
                if (kblk == 0) hwA[lb * 4 + g4] = pk; else hwB[lb * 4 + g4] = pk;
            }
    }
    asm volatile("s_waitcnt lgkmcnt(0)" ::: "memory");
#pragma unroll
    for (int kblk = 0; kblk < 2; ++kblk)
#pragma unroll
        for (int lb = 0; lb < 2; ++lb)
#pragma unroll
            for (int g4 = 0; g4 < 4; ++g4) { const int rowl = 32 * kblk + r32;
                *(u32x2*)(lds_w + rowl * 128 + (((4 * lb + g4) ^ (rowl & 7)) * 16) + hi * 8) = kblk ? hwB[lb * 4 + g4] : hwA[lb * 4 + g4]; }
    asm volatile("s_waitcnt lgkmcnt(0)" ::: "memory");
#pragma unroll
    for (int i8 = 0; i8 < 8; ++i8) {
        const int rowl = i8 * 8 + (lane >> 3), ch = lane & 7;
        const u32x4 v = *(const u32x4*)(lds_w + rowl * 128 + ((ch ^ (rowl & 7)) * 16));
        *(u32x4*)(H + (rowb + (size_t)rowl * 128) * DM + 512 + 64 * g + 8 * ch) = v;
    }
    asm volatile("s_waitcnt lgkmcnt(0)" ::: "memory");
}
__device__ __forceinline__ void conv_wave(int task, const bf16_t* P, bf16_t* H, const float* cw, const float* cb, int lane) {
    const int cgp = lane & 31, ch0 = cgp * 8;
    const int r0 = task * 8 + (lane >> 5) * 4;
    int pos, len; if (r0 < NTOK) { pos = r0 & (SEQ - 1); len = SEQ; } else { pos = (r0 - NTOK) & (CTXL - 1); len = CTXL; }
    u32x4 zz[6], cc[6], bb[4], gg[4]; float okf[6];
#pragma unroll
    for (int i = 0; i < 6; ++i) { const int p = pos - 1 + i; const bool ok = p >= 0 && p < len; okf[i] = ok ? 1.f : 0.f; const size_t row = (size_t)(ok ? r0 - 1 + i : r0);
        zz[i] = __builtin_nontemporal_load((const u32x4*)(P + row * PW + C_ZC + ch0)); cc[i] = __builtin_nontemporal_load((const u32x4*)(P + row * PW + C_CC + ch0)); }
#pragma unroll
    for (int i = 0; i < 4; ++i) { const size_t row = (size_t)(r0 + i); bb[i] = __builtin_nontemporal_load((const u32x4*)(P + row * PW + C_BC + ch0)); gg[i] = __builtin_nontemporal_load((const u32x4*)(P + row * PW + C_GC + ch0)); }
    __builtin_amdgcn_sched_barrier(0);
    float w0[8], w1[8], w2[8], bs[8];
    { const f32x4 a0 = *(const f32x4*)(cw + ch0), a1 = *(const f32x4*)(cw + ch0 + 4), b0 = *(const f32x4*)(cw + 256 + ch0), b1 = *(const f32x4*)(cw + 256 + ch0 + 4);
      const f32x4 c0 = *(const f32x4*)(cw + 512 + ch0), c1 = *(const f32x4*)(cw + 512 + ch0 + 4), d0 = *(const f32x4*)(cb + ch0), d1 = *(const f32x4*)(cb + ch0 + 4);
#pragma unroll
      for (int e = 0; e < 4; ++e) { w0[e] = a0[e]; w0[4 + e] = a1[e]; w1[e] = b0[e]; w1[4 + e] = b1[e]; w2[e] = c0[e]; w2[4 + e] = c1[e]; bs[e] = d0[e]; bs[4 + e] = d1[e]; } }
    float T[6][8];
#pragma unroll
    for (int i = 0; i < 6; ++i) {
        const unsigned zv[4] = {zz[i].x, zz[i].y, zz[i].z, zz[i].w}, cv[4] = {cc[i].x, cc[i].y, cc[i].z, cc[i].w};
#pragma unroll
        for (int e = 0; e < 8; ++e) T[i][e] = okf[i] * ((e & 1) ? bf2f(zv[e >> 1] >> 16) : bf2f(zv[e >> 1] & 0xffffu)) * ((e & 1) ? bf2f(cv[e >> 1] >> 16) : bf2f(cv[e >> 1] & 0xffffu));
    }
#pragma unroll
    for (int i = 0; i < 4; ++i) {
        const size_t row = (size_t)(r0 + i);
        const unsigned bwv[4] = {bb[i].x, bb[i].y, bb[i].z, bb[i].w}, gwv[4] = {gg[i].x, gg[i].y, gg[i].z, gg[i].w};
        float o[8];
#pragma unroll
        for (int e = 0; e < 8; ++e) {
            const float bv = (e & 1) ? bf2f(bwv[e >> 1] >> 16) : bf2f(bwv[e >> 1] & 0xffffu);
            const float gv = (e & 1) ? bf2f(gwv[e >> 1] >> 16) : bf2f(gwv[e >> 1] & 0xffffu);
            const float y = T[i][e] * w0[e] + T[i + 1][e] * w1[e] + T[i + 2][e] * w2[e] + bs[e];
            o[e] = bv * y * silu_f(gv);
        }
        u32x4 w; w.x = pkbf(o[0], o[1]); w.y = pkbf(o[2], o[3]); w.z = pkbf(o[4], o[5]); w.w = pkbf(o[6], o[7]);
        *(u32x4*)(H + row * DM + 768 + ch0) = w;
    }
}

#define XB_TMO      128
#define XB_XCNT(j)  (256  + 64 * (j))
#define XB_XSUB(j)  (1280 + 64 * (j))
#define XB_XGEN(j)  (2304 + 64 * (j))
#define XB_TOP      3328
#define XB_TOPGEN   3392
#define XCD_BAR_WORDS 3456
#define XB_SPIN_CAP (1u << 18)

__device__ __forceinline__ unsigned xb_ld(unsigned* p)              { return __hip_atomic_load(p, __ATOMIC_RELAXED, __HIP_MEMORY_SCOPE_AGENT); }
__device__ __forceinline__ unsigned xb_add(unsigned* p, unsigned v) { return __hip_atomic_fetch_add(p, v, __ATOMIC_RELAXED, __HIP_MEMORY_SCOPE_AGENT); }
__device__ __forceinline__ unsigned xb_xcc_id() { return (unsigned)__builtin_amdgcn_s_getreg((3 << 11) | 20) & 0xFu; }
#define XB_SPIN(cond, bar) do { unsigned _sp = 0; while (cond) { __builtin_amdgcn_s_sleep(1); \
    if ((++_sp & 255u) == 0u) { if (xb_ld(&(bar)[XB_TMO])) break; if (_sp > XB_SPIN_CAP) { atomicAdd(&(bar)[XB_TMO], 1u); break; } } } } while (0)

struct XcdBarrier {
    unsigned* bar; unsigned x;
    volatile LAS unsigned* st;
};

__device__ __forceinline__ XcdBarrier xcd_barrier_post(unsigned* bar, volatile LAS unsigned* st) {
    XcdBarrier b; b.bar = bar; b.x = xb_xcc_id(); b.st = st;
    if (threadIdx.x == 0) (void)xb_add(&bar[XB_XCNT(b.x)], 1u);
    return b;
}
__device__ __forceinline__ void xcd_barrier_complete(unsigned* bar, unsigned x, unsigned& nloc, unsigned& nx) {
    const unsigned G = gridDim.x * gridDim.y * gridDim.z;
    unsigned sum, cnt, mine, sp = 0u;
    for (;;) {
        sum = 0u; cnt = 0u; mine = 0u;
#pragma unroll
        for (unsigned j = 0; j < 16; ++j) { const unsigned c = xb_ld(&bar[XB_XCNT(j)]); sum += c; cnt += (c > 0u) ? 1u : 0u; mine = (j == x) ? c : mine; }
        if (sum == G) break;
        __builtin_amdgcn_s_sleep(1);
        if ((++sp & 255u) == 0u) { if (xb_ld(&bar[XB_TMO])) break; if (sp > XB_SPIN_CAP) { atomicAdd(&bar[XB_TMO], 1u); break; } }
    }
    nloc = mine > 0u ? mine : 1u; nx = cnt > 0u ? cnt : 1u;
}

__device__ __forceinline__ void xcd_barrier(const XcdBarrier& b) {
    asm volatile("s_waitcnt vmcnt(0)" ::: "memory");
    __syncthreads();
    if (threadIdx.x == 0) {
        unsigned* bar = b.bar;
        __builtin_amdgcn_s_waitcnt(0);
        unsigned nloc = b.st[0], nx = b.st[1];
        if (nloc == 0u) { xcd_barrier_complete(bar, b.x, nloc, nx); b.st[0] = nloc; b.st[1] = nx; }
        const unsigned old = xb_add(&bar[XB_XSUB(b.x)], 1u);
        const unsigned gen = old / nloc;
        if (old + 1u == (gen + 1u) * nloc) {
            __builtin_amdgcn_fence(__ATOMIC_RELEASE, "agent");
            asm volatile("s_waitcnt vmcnt(0)" ::: "memory");
            const unsigned og = xb_add(&bar[XB_TOP], 1u);
            const unsigned tg = og / nx;
            if (og + 1u == (tg + 1u) * nx) xb_add(&bar[XB_TOPGEN], 1u);
            else XB_SPIN(xb_ld(&bar[XB_TOPGEN]) == tg, bar);
            __builtin_amdgcn_fence(__ATOMIC_ACQUIRE, "agent");
            xb_add(&bar[XB_XGEN(b.x)], 1u);
            asm volatile("s_waitcnt vmcnt(0)" ::: "memory");
        } else {
            XB_SPIN(xb_ld(&bar[XB_XGEN(b.x)]) == gen, bar);
            __builtin_amdgcn_fence(__ATOMIC_ACQUIRE, "agent");
            asm volatile("s_waitcnt vmcnt(0)" ::: "memory");
        }
    }
    __syncthreads();
}

__device__ __forceinline__ int next_unit(unsigned* ctr, unsigned char* lds) {
    volatile int* sw = (volatile int*)(lds + LDS_SCHED);
    if (threadIdx.x == 0) *sw = (int)atomicAdd(ctr, 1u);
    __syncthreads();
    const int u = *sw;
    __syncthreads();
    return u;
}

__global__ void __launch_bounds__(NTHREADS, 2) hybrid_fwd(KArgs a) {
    extern __shared__ __attribute__((aligned(16))) unsigned char lds[];
    cg::grid_group grid = cg::this_grid();
    unsigned char* ws = a.ws;
    const int lo = a.ph_lo, hi = a.ph_hi;
#ifndef PHMASK
#define PHMASK 0xfff
#endif
#define IN(k) (((PHMASK >> ((k) > 5 && (k) < 11 ? (k) - 5 : (k))) & 1) && lo <= (k) && (k) < hi)
#define SEAM(k) do { if (IN(k) && IN((k) + 1)) xcd_barrier(xbar); } while (0)
#ifndef REP_PHASE
#define REP_PHASE -1
#endif
#define REPS(j) for (int rep = 0, nrep = (REP_PHASE == (j)) ? 2 : 1; rep < nrep; ++rep, (rep < nrep ? xcd_barrier(xbar) : (void)0))
    bf16_t* HX = (bf16_t*)(ws + WS_HX); bf16_t* Pb = (bf16_t*)(ws + WS_P); bf16_t* Vt = (bf16_t*)(ws + WS_VT); bf16_t* Hb = (bf16_t*)(ws + WS_H);
    bf16_t* Yb = (bf16_t*)(ws + WS_Y); bf16_t* YF = (bf16_t*)(ws + WS_YF); float* SSQ = (float*)(ws + WS_SSQ);
    unsigned* ctl = (unsigned*)(ws + WS_CTL);

    if (threadIdx.x < 2) ((volatile LAS unsigned*)(lds + LDS_BARST))[threadIdx.x] = 0u;
    __syncthreads();
    const XcdBarrier xbar = xcd_barrier_post((unsigned*)(ws + WS_BAR), (volatile LAS unsigned*)(lds + LDS_BARST));
    if (a.ph_lo < 0) grid.sync();
    REPS(30) if (IN(0)) p0_prologue(a, lds);
    SEAM(0);
    for (int l = 0; l < 2; ++l) {
        const int pb = 1 + 5 * l;
        REPS(0) if (IN(pb)) norm_phase(a, l);
        SEAM(pb);
        REPS(1) if (IN(pb + 1)) {
            pg8::Gemm g{HX, (const bf16_t*)(ws + WS_WIN) + (size_t)l * PW * DM, MROWS, PW, DM};
            pg8::StaticOrder S; S.init(MROWS, PW, (int)gridDim.x, (int)blockIdx.x);
            pg8::EpiProj E{Pb, Vt, (const float*)(ws + WS_ROPE), (bf16_t*)(ws + WS_UFP), 0.125f * LOG2E};
            pg8::gemm_phase<pg8::EpiProj, pg8::StaticOrder, true, true>((PG8_LAS unsigned char*)lds, g, S, E);
            if (l == 0) {
                const int G = (int)gridDim.x, nun = (MROWS / 256) * (PW / 256), fi = nun - (nun / G) * G;
                const bool all = (fi == 0) || (G - fi < 16);
                if (all || (int)blockIdx.x >= fi) {
                    const int tid = opaque_tid(), lane = tid & 63, wave = tid >> 6;
                    __syncthreads();
                    p0_transposes(a, lds, 1, ((int)blockIdx.x - (all ? 0 : fi)) * 8 + wave, (G - (all ? 0 : fi)) * 8, lane, wave);
                    p0_gt(a, lds, ((int)blockIdx.x - (all ? 0 : fi)) * NTHREADS + tid, (G - (all ? 0 : fi)) * NTHREADS);
                }
            }
        }
        SEAM(pb + 1);
        for (int rep = 0, nrep = (REP_PHASE >= 20 && REP_PHASE < 30) ? 2 : 1; rep < nrep; ++rep, (rep < nrep ? xcd_barrier(xbar) : (void)0)) if (IN(pb + 2)) {
            const int nAttn = (l == 0) ? 1056 : 1024, nCtxF = (l == 0) ? 16 : 0, nF1 = 256, nConv = ((l == 0) ? MROWS : NTOK) / 64;
            const int e0 = nF1, e1 = e0 + nCtxF, e2 = e1 + nAttn, e3 = e2 + nConv;
            for (;;) {
                const int u = next_unit(ctl + 2 * l + 8 * rep, lds);
                if (u >= e3) break;
                if (rep == 1) { const int ty = u < e0 ? 1 : u < e1 ? 3 : u < e2 ? 0 : 2; if (REP_PHASE == 25 ? (ty == 0) : (ty != REP_PHASE - 20)) continue; }
                int au = -1, cu = -1;
                if (u >= e1) { const int k = u - e1, C1 = nConv - 256, T = nAttn + C1;
                    if (k >= T) cu = C1 + (k - T);
                    else { const int c0 = (k * C1) / T, c1 = ((k + 1) * C1) / T; if (c1 > c0) cu = c0; else au = k - c0; } }
                if (au >= 0) attn_unit(au, Pb, Vt, Hb, a.sink + 8 * l, lds);
                else if (u >= e0 && u < e1) { const int v = u - e0, b = v >> 2, kb = v & 3;
                    dftf_unit<256>(Pb + (size_t)(NTOK + b * CTXL) * PW + C_UF, 256, PW, 0, (const bf16_t*)(ws + WS_T256R) + (size_t)(64 * kb) * 256, (const bf16_t*)(ws + WS_T256I) + (size_t)(64 * kb) * 256,
                                   (const bf16_t*)(ws + WS_GT) + (size_t)l * 4 * 64 * 128, Pb, Hb, (size_t)(NTOK + b * CTXL + 64 * kb), 1, 5.656854249492381f, lds); }
                else {
                    const int tid = opaque_tid(), lane = tid & 63, wave = __builtin_amdgcn_readfirstlane(tid >> 6);
                    if (u < e0) { fft1_tables(ws, lds + 65536, tid); __syncthreads(); fft1_wave(u * 8 + wave, (const bf16_t*)(ws + WS_UFP), YF, ws, lds + wave * 8192, lds + 65536, lane); }
                    else conv_wave(cu * 8 + wave, Pb, Hb, a.conv_w + l * 768, a.conv_b + l * 256, lane);
                }
            }
        }
        SEAM(pb + 2);
        REPS(3) if (IN(pb + 3)) {
            const bool gemmwg = (l == 0 && blockIdx.x < 16);
            if (gemmwg) {
                pg8::Gemm g{Hb + (size_t)NTOK * DM, (const bf16_t*)(ws + WS_WOUT) + (size_t)l * DM * DM, NCTX, DM, DM};
                pg8::StaticOrder S; S.init(NCTX, DM, 16, (int)blockIdx.x);
                pg8::EpiY E{Yb + (size_t)NTOK * DM, SSQ + (size_t)NTOK * 16};
                pg8::gemm_phase<pg8::EpiY, pg8::StaticOrder, true, true>((PG8_LAS unsigned char*)lds, g, S, E);
            } else {
                const int tid = opaque_tid(), lane = tid & 63, wave = __builtin_amdgcn_readfirstlane(tid >> 6);
                const int nb0 = (l == 0) ? 16 : 0;
                const int gw = ((int)blockIdx.x - nb0) + wave * ((int)gridDim.x - nb0), NGW = ((int)gridDim.x - nb0) * 8;
                unsigned char* lds_w = lds + wave * 16384;
                for (int t = gw; t < 2048; t += NGW) fft3_wave(t, YF, (const bf16_t*)(ws + WS_GT) + (size_t)l * 4 * 64 * 128, Pb, Hb, ws, lds_w, lane);
            }
            __syncthreads();
        }
        SEAM(pb + 3);
        REPS(4) if (IN(pb + 4)) {
            pg8::Gemm g{Hb, (const bf16_t*)(ws + WS_WOUT) + (size_t)l * DM * DM, NTOK, DM, DM};
            pg8::StaticOrder S; S.init(NTOK, DM, (int)gridDim.x, (int)blockIdx.x);
            pg8::EpiY E{l == 0 ? Yb : HX, l == 0 ? SSQ : (float*)(ws + WS_SSQ1)};
            pg8::gemm_phase<pg8::EpiY, pg8::StaticOrder, true, true>((PG8_LAS unsigned char*)lds, g, S, E);
        }
        SEAM(pb + 4);
    }
#if REP_PHASE == 9
    for (int i = 0; i < 10; ++i) xcd_barrier(xbar);
#endif
    if (IN(11)) norm_phase(a, 2);
#undef IN
#undef SEAM
}

#ifndef MK_MULTI
#define MK_MULTI 0
#endif
extern "C" void kernel_launch(void* const* d_in, const int* in_sizes, int n_in, void* d_out, int out_size, void* d_ws, size_t ws_size, hipStream_t stream) {
    static int grid = 0;
    if (grid == 0) {
        if (n_in != 14 || ws_size < WS_END) { fprintf(stderr, "kernel_launch: unexpected n_in %d or ws_size %zu (need %zu)\n", n_in, ws_size, (size_t)WS_END); grid = -1; return; }
        int dev = 0, cus = 0, per_cu = 0;
        hipGetDevice(&dev); hipDeviceGetAttribute(&cus, hipDeviceAttributeMultiprocessorCount, dev);
        if (hipFuncSetAttribute((const void*)hybrid_fwd, hipFuncAttributeMaxDynamicSharedMemorySize, LDS_BYTES) != hipSuccess) { fprintf(stderr, "kernel_launch: hipFuncSetAttribute failed\n"); grid = -1; return; }
        if (hipOccupancyMaxActiveBlocksPerMultiprocessor(&per_cu, (const void*)hybrid_fwd, NTHREADS, LDS_BYTES) != hipSuccess || per_cu < 1) { fprintf(stderr, "kernel_launch: occupancy query gave %d\n", per_cu); per_cu = 1; }
        (void)hipGetLastError();
        grid = cus * 1;
        fprintf(stderr, "kernel_launch: grid %d (cus %d, per_cu %d)\n", grid, cus, per_cu);
    }
    if (grid < 0) return;
    if (hipMemsetAsync((char*)d_ws + WS_CTL, 0, WS_ZERO_BYTES, stream) != hipSuccess) { fprintf(stderr, "kernel_launch: hipMemsetAsync failed\n"); return; }
    KArgs a{};
    a.x = (const float*)d_in[0]; a.c = (const float*)d_in[1]; a.ctx = (const float*)d_in[2]; a.c_ctx = (const float*)d_in[3]; a.w_mod = (const float*)d_in[4]; a.b_mod = (const float*)d_in[5];
    a.g_pre = (const float*)d_in[6]; a.g_post = (const float*)d_in[7]; a.w_in = (const float*)d_in[8]; a.w_out = (const float*)d_in[9]; a.sink = (const float*)d_in[10]; a.w_f = (const float*)d_in[11];
    a.conv_w = (const float*)d_in[12]; a.conv_b = (const float*)d_in[13];
    a.out = (float*)d_out; a.ws = (unsigned char*)d_ws;
#if MK_MULTI
    for (int ph = 0; ph < 12; ++ph) { a.ph_lo = ph; a.ph_hi = ph + 1; hipLaunchKernelGGL(hybrid_fwd, dim3(grid), dim3(NTHREADS), LDS_BYTES, stream, a); }
#else
    a.ph_lo = 0; a.ph_hi = 12;
    void* args[] = {&a};
    hipError_t e = hipLaunchCooperativeKernel((const void*)hybrid_fwd, dim3(grid), dim3(NTHREADS), args, LDS_BYTES, stream);
    if (e != hipSuccess) fprintf(stderr, "kernel_launch: cooperative launch failed: %s (grid %d)\n", hipGetErrorString(e), grid);
#endif
}
```
